# Optimizing an MI355X kernel written in HIP

```python
import math
import jax, jax.numpy as jnp
from jax import lax
import numpy as np

D_MODEL = 1024
BATCH = 8
SEQ = 4096
DEPTH = 4

GRID_W = 64
CTX_LEN = 256
N_MIXERS = 4
BLOCK = 128
EPS = 1e-6
ROPE_BASE = 10000.0
ADALN_CHUNKS = 6

ATT_HEADS = 16
ATT_KV_HEADS = 4
ATT_GROUP = ATT_HEADS // ATT_KV_HEADS
ATT_HEAD_DIM = D_MODEL // ATT_HEADS
ATT_IN_DIM = (ATT_HEADS + 2 * ATT_KV_HEADS) * ATT_HEAD_DIM
WINDOW = 128

SSM_D_INNER = 2 * D_MODEL
SSM_HEAD_DIM = 64
SSM_HEADS = SSM_D_INNER // SSM_HEAD_DIM
SSM_GROUPS = 4
SSM_HPG = SSM_HEADS // SSM_GROUPS
SSM_STATE = 128
SSM_CONV = 5
SSM_CONV_DIM = SSM_D_INNER + 2 * SSM_GROUPS * SSM_STATE
SSM_IN_DIM = SSM_D_INNER + SSM_CONV_DIM + 2 * SSM_HEADS

ML_HEADS = 8
ML_QK_DIM = D_MODEL // (2 * ML_HEADS)
ML_V_DIM = D_MODEL // ML_HEADS
ML_IN_DIM = 2 * ML_HEADS * ML_QK_DIM + 2 * ML_HEADS * ML_V_DIM + 4 * ML_HEADS

MLA_HEADS = 16
MLA_Q_RANK = D_MODEL // 4
MLA_KV_RANK = D_MODEL // 4
MLA_NOPE = 64
MLA_ROPE = 32
MLA_V = 64
MLA_IN_DIM = MLA_Q_RANK + MLA_KV_RANK + MLA_ROPE

MOE_GROUPS = 4
MOE_PER_GROUP = 4
MOE_EXPERTS = MOE_GROUPS * MOE_PER_GROUP
MOE_FF = D_MODEL // 4
MOE_TOPK = 2

N_ATT = (DEPTH + 3) // 4
N_SSM = (DEPTH + 2) // 4
N_ML = (DEPTH + 1) // 4
N_MLA = DEPTH // 4

kernel_name = "hybrid_interleaved_diffusion_trunk"


def rmsnorm(x, g):
    xf = x.astype(jnp.float32)
    y = xf * lax.rsqrt(jnp.mean(xf * xf, axis=-1, keepdims=True) + EPS)
    return (y * g.astype(jnp.float32)).astype(x.dtype)


def group_rmsnorm(x, g, n_groups):
    shp = x.shape
    xf = x.astype(jnp.float32).reshape(*shp[:-1], n_groups, shp[-1] // n_groups)
    y = xf * lax.rsqrt(jnp.mean(xf * xf, axis=-1, keepdims=True) + EPS)
    return (y.reshape(shp) * g.astype(jnp.float32)).astype(x.dtype)


def axial_rope(n_tokens, rot_dim):
    rows = n_tokens // GRID_W
    row = jnp.repeat(jnp.arange(rows), GRID_W).astype(jnp.float32)
    col = jnp.tile(jnp.arange(GRID_W), rows).astype(jnp.float32)
    quarter = rot_dim // 4
    inv = ROPE_BASE ** (-jnp.arange(quarter, dtype=jnp.float32) / quarter)
    ang = jnp.concatenate([row[:, None] * inv, col[:, None] * inv], axis=-1)
    return jnp.cos(ang), jnp.sin(ang)


def apply_rope(x, cos, sin):
    shape = (1, cos.shape[0]) + (1,) * (x.ndim - 3) + (cos.shape[1],)
    cos = cos.reshape(shape).astype(x.dtype)
    sin = sin.reshape(shape).astype(x.dtype)
    x1, x2 = jnp.split(x, 2, axis=-1)
    return jnp.concatenate([x1 * cos - x2 * sin, x2 * cos + x1 * sin], axis=-1)


def softmax_with_sink(logits, sink):
    s = jnp.broadcast_to(sink[:, :, None, None], logits.shape[:-1] + (1,))
    p = jax.nn.softmax(jnp.concatenate([logits, s], axis=-1), axis=-1)
    return p[..., :-1]


def centred_dwconv(x, w, b):
    k_w = w.shape[0]
    pad = k_w // 2
    n = x.shape[1]
    xp = jnp.pad(x, ((0, 0), (pad, pad), (0, 0)))
    return b + sum(xp[:, t:t + n] * w[t] for t in range(k_w))


def to_chunks(t):
    bsz, n = t.shape[:2]
    return jnp.moveaxis(t.reshape(bsz, n // BLOCK, BLOCK, *t.shape[2:]), 1, 0)


def from_chunks(t):
    t = jnp.moveaxis(t, 0, 1)
    return t.reshape(t.shape[0], t.shape[1] * t.shape[2], *t.shape[3:])


def windowed_gqa(hc, hx, w_in, sink, w_out, need_ctx):
    bsz, n_lat, _ = hx.shape
    n_blk = n_lat // BLOCK
    scale = ATT_HEAD_DIM ** -0.5
    sink = sink.astype(jnp.float32).reshape(ATT_KV_HEADS, ATT_GROUP)

    def project(h):
        qkv = h @ w_in
        q, k, v = jnp.split(qkv, [ATT_HEADS * ATT_HEAD_DIM, (ATT_HEADS + ATT_KV_HEADS) * ATT_HEAD_DIM], axis=-1)
        lead = h.shape[:2]
        return (q.reshape(*lead, ATT_KV_HEADS, ATT_GROUP, ATT_HEAD_DIM),
                k.reshape(*lead, ATT_KV_HEADS, ATT_HEAD_DIM),
                v.reshape(*lead, ATT_KV_HEADS, ATT_HEAD_DIM))

    qc, kc, vc = project(hc)
    qx, kx, vx = project(hx)
    cos, sin = axial_rope(n_lat, ATT_HEAD_DIM)
    qx = apply_rope(qx, cos, sin)
    kx = apply_rope(kx, cos, sin)

    yc = None
    if need_ctx:
        lg = jnp.einsum('bqhgd,bkhd->bhgqk', qc, kc).astype(jnp.float32) * scale
        p = softmax_with_sink(lg, sink).astype(vc.dtype)
        oc = jnp.einsum('bhgqk,bkhd->bqhgd', p, vc)
        yc = oc.reshape(bsz, hc.shape[1], ATT_HEADS * ATT_HEAD_DIM) @ w_out

    def band(t):
        tp = jnp.pad(t, ((0, 0), (BLOCK, BLOCK), (0, 0), (0, 0)))
        tb = tp.reshape(bsz, n_blk + 2, BLOCK, ATT_KV_HEADS, ATT_HEAD_DIM)
        tb = jnp.concatenate([tb[:, :-2], tb[:, 1:-1], tb[:, 2:]], axis=2)
        return jnp.moveaxis(tb, 1, 0)

    kb, vb = band(kx), band(vx)
    qb = to_chunks(qx)
    qi = jnp.arange(BLOCK)[:, None]
    kj = jnp.arange(3 * BLOCK)[None, :]
    in_win = (kj >= qi + BLOCK - WINDOW) & (kj <= qi + BLOCK + WINDOW)
    kpos = (jnp.arange(n_blk)[:, None] - 1) * BLOCK + jnp.arange(3 * BLOCK)[None, :]
    valid = (kpos >= 0) & (kpos < n_lat)
    mask = in_win[None] & valid[:, None, :]

    def block_attn(args):
        q, k, v, m = args
        ll = jnp.einsum('bqhgd,bkhd->bhgqk', q, k).astype(jnp.float32) * scale
        ll = jnp.where(m, ll, -jnp.inf)
        lcx = jnp.einsum('bqhgd,bkhd->bhgqk', q, kc).astype(jnp.float32) * scale
        p = softmax_with_sink(jnp.concatenate([ll, lcx], axis=-1), sink).astype(v.dtype)
        return (jnp.einsum('bhgqk,bkhd->bqhgd', p[..., :3 * BLOCK], v)
                + jnp.einsum('bhgqk,bkhd->bqhgd', p[..., 3 * BLOCK:], vc))

    ob = lax.map(block_attn, (qb, kb, vb, mask))
    yx = from_chunks(ob).reshape(bsz, n_lat, ATT_HEADS * ATT_HEAD_DIM) @ w_out
    return yc, yx


def ssd_scan(u, a, bm, cm, state0):
    tri = jnp.tril(jnp.ones((BLOCK, BLOCK), bool))

    def step(state, inp):
        uq, aq, bq, cq = inp
        acum = jnp.cumsum(aq, axis=1)
        seg = acum[:, :, None] - acum[:, None, :]
        lmat = jnp.exp(jnp.where(tri[None, :, :, None, None], seg, -jnp.inf))
        cb = jnp.einsum('blgn,bsgn->blsg', cq, bq)
        y = jnp.einsum('blsg,blsge,bsgep->blgep', cb, lmat, uq)
        y = y + jnp.einsum('blgn,bgepn->blgep', cq, state) * jnp.exp(acum)[..., None]
        decay_end = jnp.exp(acum[:, -1:] - acum)
        state = (state * jnp.exp(acum[:, -1])[..., None, None]
                 + jnp.einsum('bsgn,bsge,bsgep->bgepn', bq, decay_end, uq))
        return state, y

    state, ys = lax.scan(step, state0, (to_chunks(u), to_chunks(a), to_chunks(bm), to_chunks(cm)))
    return from_chunks(ys), state


def mamba2_bidir(hc, hx, w_in, conv_w, conv_b, dt_bias, a_log, d_skip, norm_g, w_out, need_ctx):
    a_neg = -jnp.exp(a_log.astype(jnp.float32))

    def project(h):
        p = h @ w_in
        z, xbc, dt = jnp.split(p, [SSM_D_INNER, SSM_D_INNER + SSM_CONV_DIM], axis=-1)
        xbc = jax.nn.silu(centred_dwconv(xbc, conv_w, conv_b))
        xs, bm, cm = jnp.split(xbc, [SSM_D_INNER, SSM_D_INNER + SSM_GROUPS * SSM_STATE], axis=-1)
        return z, xs, bm, cm, dt.reshape(*h.shape[:2], 2, SSM_HEADS)

    def run(xs, bm, cm, dt, d, state0):
        bsz, n = xs.shape[:2]
        dtd = jax.nn.softplus(dt[:, :, d].astype(jnp.float32) + dt_bias[d].astype(jnp.float32))
        dtg = dtd.reshape(bsz, n, SSM_GROUPS, SSM_HPG)
        xh = xs.reshape(bsz, n, SSM_GROUPS, SSM_HPG, SSM_HEAD_DIM)
        u = xh * dtg[..., None]
        a = dtg * a_neg[d].reshape(SSM_GROUPS, SSM_HPG)
        bg = bm.reshape(bsz, n, SSM_GROUPS, SSM_STATE)
        cg = cm.reshape(bsz, n, SSM_GROUPS, SSM_STATE)
        if d == 1:
            u, a, bg, cg = (jnp.flip(t, axis=1) for t in (u, a, bg, cg))
        y, st = ssd_scan(u, a, bg, cg, state0)
        if d == 1:
            y = jnp.flip(y, axis=1)
        y = y + d_skip[d].reshape(SSM_GROUPS, SSM_HPG)[:, :, None] * xh
        return y.reshape(bsz, n, SSM_D_INNER), st

    zc, xc, bc, cc, dtc = project(hc)
    zx, xx, bx, cx, dtx = project(hx)
    bsz = hx.shape[0]
    zero = jnp.zeros((bsz, SSM_GROUPS, SSM_HPG, SSM_HEAD_DIM, SSM_STATE), jnp.float32)
    yc_f, st_f = run(xc, bc, cc, dtc, 0, zero)
    yc_b, st_b = run(xc, bc, cc, dtc, 1, zero)
    yx_f, _ = run(xx, bx, cx, dtx, 0, st_f)
    yx_b, _ = run(xx, bx, cx, dtx, 1, st_b)

    def out(y, z):
        return group_rmsnorm(y * jax.nn.silu(z), norm_g, SSM_GROUPS) @ w_out

    yc = out(yc_f + yc_b, zc) if need_ctx else None
    return yc, out(yx_f + yx_b, zx)


def mlstm_scan(q, k, v, ig, lf, state0):
    tri = jnp.tril(jnp.ones((BLOCK, BLOCK), bool))

    def step(carry, inp):
        cs, ns, ms = carry
        qq, kq, vq, iq, fq = inp
        bcum = jnp.cumsum(fq, axis=1)
        logd = bcum[:, :, None] - bcum[:, None, :] + iq[:, None, :]
        logd = jnp.where(tri[None, :, :, None], logd, -jnp.inf)
        inter = bcum + ms[:, None]
        mt = jnp.maximum(inter, jnp.max(logd, axis=2))
        dmat = jnp.exp(logd - mt[:, :, None])
        sc = jnp.einsum('bthd,bshd->btsh', qq, kq) * dmat
        w_int = jnp.exp(inter - mt)
        num = (jnp.einsum('btsh,bshv->bthv', sc, vq)
               + w_int[..., None] * jnp.einsum('bthd,bhdv->bthv', qq, cs))
        den = jnp.sum(sc, axis=2) + w_int * jnp.einsum('bthd,bhd->bth', qq, ns)
        h = num / jnp.maximum(jnp.abs(den), jnp.exp(-mt))[..., None]
        tot = bcum[:, -1]
        logw = tot[:, None] - bcum + iq
        m_new = jnp.maximum(tot + ms, jnp.max(logw, axis=1))
        ws = jnp.exp(logw - m_new[:, None])
        cw = jnp.exp(tot + ms - m_new)
        c_new = cw[..., None, None] * cs + jnp.einsum('bsh,bshd,bshv->bhdv', ws, kq, vq)
        n_new = cw[..., None] * ns + jnp.einsum('bsh,bshd->bhd', ws, kq)
        return (c_new, n_new, m_new), h

    state, hs = lax.scan(step, state0, tuple(to_chunks(t) for t in (q, k, v, ig, lf)))
    return from_chunks(hs), state


def mlstm_bidir(hc, hx, w_in, gate_b, norm_g, w_out, need_ctx):
    qk = ML_HEADS * ML_QK_DIM
    vd = ML_HEADS * ML_V_DIM

    def project(h):
        p = h @ w_in
        q, k, v, o, g = jnp.split(p, [qk, 2 * qk, 2 * qk + vd, 2 * qk + 2 * vd], axis=-1)
        lead = h.shape[:2]
        q = q.reshape(*lead, ML_HEADS, ML_QK_DIM)
        k = k.reshape(*lead, ML_HEADS, ML_QK_DIM) * (ML_QK_DIM ** -0.5)
        v = v.reshape(*lead, ML_HEADS, ML_V_DIM)
        g = g.reshape(*lead, 4, ML_HEADS).astype(jnp.float32) + gate_b.astype(jnp.float32)
        return q, k, v, o, g

    def run(q, k, v, g, d, state0):
        ig = g[:, :, 2 * d]
        lf = jax.nn.log_sigmoid(g[:, :, 2 * d + 1])
        if d == 1:
            q, k, v, ig, lf = (jnp.flip(t, axis=1) for t in (q, k, v, ig, lf))
        h, st = mlstm_scan(q, k, v, ig, lf, state0)
        if d == 1:
            h = jnp.flip(h, axis=1)
        return h, st

    qc, kc, vc, oc, gc = project(hc)
    qx, kx, vx, ox, gx = project(hx)
    bsz = hx.shape[0]
    zero = (jnp.zeros((bsz, ML_HEADS, ML_QK_DIM, ML_V_DIM), jnp.float32),
            jnp.zeros((bsz, ML_HEADS, ML_QK_DIM), jnp.float32),
            jnp.zeros((bsz, ML_HEADS), jnp.float32))
    hc_f, st_f = run(qc, kc, vc, gc, 0, zero)
    hc_b, st_b = run(qc, kc, vc, gc, 1, zero)
    hx_f, _ = run(qx, kx, vx, gx, 0, st_f)
    hx_b, _ = run(qx, kx, vx, gx, 1, st_b)

    def out(h, o):
        h = h.reshape(*h.shape[:2], vd)
        return (group_rmsnorm(h, norm_g, ML_HEADS) * jax.nn.sigmoid(o)) @ w_out

    yc = out(hc_f + hc_b, oc) if need_ctx else None
    return yc, out(hx_f + hx_b, ox)


def mla(hc, hx, w_in, q_norm_g, w_q_up, kv_norm_g, w_kv_up, w_out, need_ctx):
    bsz, n_lat, _ = hx.shape
    n_blk = n_lat // BLOCK
    scale = (MLA_NOPE + MLA_ROPE) ** -0.5

    def project(h, rope):
        p = h @ w_in
        cq, ckv, kr = jnp.split(p, [MLA_Q_RANK, MLA_Q_RANK + MLA_KV_RANK], axis=-1)
        lead = h.shape[:2]
        q = (rmsnorm(cq, q_norm_g) @ w_q_up).reshape(*lead, MLA_HEADS, MLA_NOPE + MLA_ROPE)
        kv = (rmsnorm(ckv, kv_norm_g) @ w_kv_up).reshape(*lead, MLA_HEADS, MLA_NOPE + MLA_V)
        qn, qr = jnp.split(q, [MLA_NOPE], axis=-1)
        kn, v = jnp.split(kv, [MLA_NOPE], axis=-1)
        if rope is not None:
            qr = apply_rope(qr, *rope)
            kr = apply_rope(kr, *rope)
        return qn, qr, kn, kr, v

    qn_c, qr_c, kn_c, kr_c, v_c = project(hc, None)
    qn_x, qr_x, kn_x, kr_x, v_x = project(hx, axial_rope(n_lat, MLA_ROPE))

    def scores(qn, qr, kn, kr):
        return (jnp.einsum('bqhd,bkhd->bhqk', qn, kn)
                + jnp.einsum('bqhd,bkd->bhqk', qr, kr)).astype(jnp.float32) * scale

    yc = None
    if need_ctx:
        p = jax.nn.softmax(scores(qn_c, qr_c, kn_c, kr_c), axis=-1).astype(v_c.dtype)
        oc = jnp.einsum('bhqk,bkhd->bqhd', p, v_c)
        yc = oc.reshape(bsz, hc.shape[1], MLA_HEADS * MLA_V) @ w_out

    def block_attn(args):
        qn, qr = args
        s = jnp.concatenate([scores(qn, qr, kn_x, kr_x), scores(qn, qr, kn_c, kr_c)], axis=-1)
        p = jax.nn.softmax(s, axis=-1).astype(v_x.dtype)
        return (jnp.einsum('bhqk,bkhd->bqhd', p[..., :n_lat], v_x)
                + jnp.einsum('bhqk,bkhd->bqhd', p[..., n_lat:], v_c))

    ob = lax.map(block_attn, (to_chunks(qn_x), to_chunks(qr_x)))
    yx = from_chunks(ob).reshape(bsz, n_lat, MLA_HEADS * MLA_V) @ w_out
    return yc, yx


def hier_moe(h, w_rg, b_rg, w_re, b_re, w_gate, w_up, w_down):
    lead = h.shape[:-1]
    lg = (h @ w_rg + b_rg).astype(jnp.float32)
    g_sel = jnp.argmax(lg, axis=-1)
    p_g = jnp.take_along_axis(jax.nn.softmax(lg, axis=-1), g_sel[..., None], axis=-1)
    le = (h @ w_re + b_re).astype(jnp.float32).reshape(*lead, MOE_GROUPS, MOE_PER_GROUP)
    le_sel = jnp.take_along_axis(le, g_sel[..., None, None], axis=-2)[..., 0, :]
    top_v, top_i = lax.top_k(le_sel, MOE_TOPK)
    w = jax.nn.softmax(top_v, axis=-1) * p_g
    eid = g_sel[..., None] * MOE_PER_GROUP + top_i
    combine = jnp.sum(jax.nn.one_hot(eid, MOE_EXPERTS, dtype=jnp.float32) * w[..., None], axis=-2)
    combine = combine.astype(h.dtype)
    out = jnp.zeros_like(h)
    for e in range(MOE_EXPERTS):
        act = jax.nn.silu(h @ w_gate[e]) * (h @ w_up[e])
        out = out + combine[..., e:e + 1] * (act @ w_down[e])
    return out


def setup_inputs(seed: int = 0) -> dict:
    key = jax.random.key(seed)
    ks = iter(jax.random.split(key, 64))
    D = D_MODEL

    def nrm(shape, scale):
        return jax.random.normal(next(ks), shape, jnp.float32) * scale

    def gain(shape):
        return 1.0 + nrm(shape, 0.02)

    def unif(shape, lo, hi):
        return jax.random.uniform(next(ks), shape, jnp.float32, lo, hi)

    dt0 = jnp.exp(unif((N_SSM, 2, SSM_HEADS), math.log(1e-3), math.log(1e-1)))
    gate_b = jnp.stack([nrm((N_ML, ML_HEADS), 0.1), 3.0 + unif((N_ML, ML_HEADS), 0.0, 3.0),
                        nrm((N_ML, ML_HEADS), 0.1), 3.0 + unif((N_ML, ML_HEADS), 0.0, 3.0)], axis=1)
    return {
        "x": nrm((BATCH, SEQ, D), 1.0),
        "c": nrm((BATCH, D), 1.0),
        "ctx": nrm((BATCH, CTX_LEN, D), 1.0),
        "c_ctx": nrm((D,), 1.0),
        "norm1_g": gain((DEPTH, D)),
        "norm2_g": gain((DEPTH, D)),
        "w_mod": nrm((DEPTH, D, ADALN_CHUNKS * D), 0.5 * D ** -0.5),
        "b_mod": nrm((DEPTH, ADALN_CHUNKS * D), 0.02),
        "moe_w_group": nrm((DEPTH, D, MOE_GROUPS), D ** -0.5),
        "moe_b_group": nrm((DEPTH, MOE_GROUPS), 0.01),
        "moe_w_expert": nrm((DEPTH, D, MOE_EXPERTS), D ** -0.5),
        "moe_b_expert": nrm((DEPTH, MOE_EXPERTS), 0.01),
        "moe_w_gate": nrm((DEPTH, MOE_EXPERTS, D, MOE_FF), D ** -0.5),
        "moe_w_up": nrm((DEPTH, MOE_EXPERTS, D, MOE_FF), D ** -0.5),
        "moe_w_down": nrm((DEPTH, MOE_EXPERTS, MOE_FF, D), MOE_FF ** -0.5),
        "attn_w_in": nrm((N_ATT, D, ATT_IN_DIM), D ** -0.5),
        "attn_sink": nrm((N_ATT, ATT_HEADS), 0.5),
        "attn_w_out": nrm((N_ATT, ATT_HEADS * ATT_HEAD_DIM, D), (ATT_HEADS * ATT_HEAD_DIM) ** -0.5),
        "ssm_w_in": nrm((N_SSM, D, SSM_IN_DIM), D ** -0.5),
        "ssm_conv_w": nrm((N_SSM, SSM_CONV, SSM_CONV_DIM), SSM_CONV ** -0.5),
        "ssm_conv_b": nrm((N_SSM, SSM_CONV_DIM), 0.02),
        "ssm_dt_bias": dt0 + jnp.log(-jnp.expm1(-dt0)),
        "ssm_a_log": jnp.log(unif((N_SSM, 2, SSM_HEADS), 1.0, 16.0)),
        "ssm_d": 1.0 + nrm((N_SSM, 2, SSM_HEADS), 0.1),
        "ssm_norm_g": gain((N_SSM, SSM_D_INNER)),
        "ssm_w_out": nrm((N_SSM, SSM_D_INNER, D), SSM_D_INNER ** -0.5),
        "mlstm_w_in": nrm((N_ML, D, ML_IN_DIM), D ** -0.5),
        "mlstm_gate_b": gate_b,
        "mlstm_norm_g": gain((N_ML, ML_HEADS * ML_V_DIM)),
        "mlstm_w_out": nrm((N_ML, ML_HEADS * ML_V_DIM, D), (ML_HEADS * ML_V_DIM) ** -0.5),
        "mla_w_in": nrm((N_MLA, D, MLA_IN_DIM), D ** -0.5),
        "mla_q_norm_g": gain((N_MLA, MLA_Q_RANK)),
        "mla_w_q_up": nrm((N_MLA, MLA_Q_RANK, MLA_HEADS * (MLA_NOPE + MLA_ROPE)), MLA_Q_RANK ** -0.5),
        "mla_kv_norm_g": gain((N_MLA, MLA_KV_RANK)),
        "mla_w_kv_up": nrm((N_MLA, MLA_KV_RANK, MLA_HEADS * (MLA_NOPE + MLA_V)), MLA_KV_RANK ** -0.5),
        "mla_w_out": nrm((N_MLA, MLA_HEADS * MLA_V, D), (MLA_HEADS * MLA_V) ** -0.5),
        "final_norm_g": gain((D,)),
    }


def reference(x, c, ctx, c_ctx, norm1_g, norm2_g, w_mod, b_mod,
              moe_w_group, moe_b_group, moe_w_expert, moe_b_expert, moe_w_gate, moe_w_up, moe_w_down,
              attn_w_in, attn_sink, attn_w_out,
              ssm_w_in, ssm_conv_w, ssm_conv_b, ssm_dt_bias, ssm_a_log, ssm_d, ssm_norm_g, ssm_w_out,
              mlstm_w_in, mlstm_gate_b, mlstm_norm_g, mlstm_w_out,
              mla_w_in, mla_q_norm_g, mla_w_q_up, mla_kv_norm_g, mla_w_kv_up, mla_w_out,
              final_norm_g):
    xs, cs = x, ctx
    for i in range(DEPTH):
        kind, j = i % N_MIXERS, i // N_MIXERS
        need_ctx = i < DEPTH - 1
        mod_x = jax.nn.silu(c) @ w_mod[i] + b_mod[i]
        mod_c = jax.nn.silu(c_ctx) @ w_mod[i] + b_mod[i]
        sh1x, sc1x, g1x, sh2x, sc2x, g2x = jnp.split(mod_x[:, None, :], ADALN_CHUNKS, axis=-1)
        sh1c, sc1c, g1c, sh2c, sc2c, g2c = jnp.split(mod_c, ADALN_CHUNKS, axis=-1)

        hx = rmsnorm(xs, norm1_g[i]) * (1.0 + sc1x) + sh1x
        hc = rmsnorm(cs, norm1_g[i]) * (1.0 + sc1c) + sh1c
        if kind == 0:
            yc, yx = windowed_gqa(hc, hx, attn_w_in[j], attn_sink[j], attn_w_out[j], need_ctx)
        elif kind == 1:
            yc, yx = mamba2_bidir(hc, hx, ssm_w_in[j], ssm_conv_w[j], ssm_conv_b[j], ssm_dt_bias[j],
                                  ssm_a_log[j], ssm_d[j], ssm_norm_g[j], ssm_w_out[j], need_ctx)
        elif kind == 2:
            yc, yx = mlstm_bidir(hc, hx, mlstm_w_in[j], mlstm_gate_b[j], mlstm_norm_g[j],
                                 mlstm_w_out[j], need_ctx)
        else:
            yc, yx = mla(hc, hx, mla_w_in[j], mla_q_norm_g[j], mla_w_q_up[j], mla_kv_norm_g[j],
                         mla_w_kv_up[j], mla_w_out[j], need_ctx)
        xs = xs + g1x * yx

        moe_args = (moe_w_group[i], moe_b_group[i], moe_w_expert[i], moe_b_expert[i],
                    moe_w_gate[i], moe_w_up[i], moe_w_down[i])
        hx = rmsnorm(xs, norm2_g[i]) * (1.0 + sc2x) + sh2x
        xs = xs + g2x * hier_moe(hx, *moe_args)
        if need_ctx:
            cs = cs + g1c * yc
            hc = rmsnorm(cs, norm2_g[i]) * (1.0 + sc2c) + sh2c
            cs = cs + g2c * hier_moe(hc, *moe_args)
    return rmsnorm(xs, final_norm_g)
```

```cpp
#include <hip/hip_runtime.h>
#include <cstdio>
#include <cstdint>

#define GAS __attribute__((address_space(1)))
#define LAS __attribute__((address_space(3)))
typedef unsigned short bf16;
typedef unsigned v4u __attribute__((ext_vector_type(4)));
typedef unsigned v2u __attribute__((ext_vector_type(2)));
typedef float f32x4 __attribute__((ext_vector_type(4)));
typedef float f32x2 __attribute__((ext_vector_type(2)));
typedef short bf16x8 __attribute__((ext_vector_type(8)));
typedef short s16x4 __attribute__((ext_vector_type(4)));
#define RLX_AGENT __ATOMIC_RELAXED, __HIP_MEMORY_SCOPE_AGENT

constexpr int D = 1024, NB = 8, SEQ = 4096, CTX = 256, TPB = SEQ + CTX  , M = NB * TPB  ;
constexpr int NWAVES = 8, NTHR = 512, GRID = 256;
constexpr float EPS = 1e-6f;
constexpr float LOG2E = 1.4426950408889634f;

__device__ __forceinline__ unsigned f2bf(float f) { unsigned u = __builtin_bit_cast(unsigned, f); return (u + 0x7fffu + ((u >> 16) & 1u)) >> 16; }
__device__ __forceinline__ float bf2f(unsigned b) { return __builtin_bit_cast(float, b << 16); }
__device__ __forceinline__ float bflo(unsigned w) { return __builtin_bit_cast(float, w << 16); }
__device__ __forceinline__ float bfhi(unsigned w) { return __builtin_bit_cast(float, w & 0xffff0000u); }
__device__ __forceinline__ unsigned cvt_pk_bf16(float lo, float hi) { unsigned r; asm volatile("v_cvt_pk_bf16_f32 %0, %1, %2" : "=v"(r) : "v"(lo), "v"(hi)); return r; }
__device__ __forceinline__ float fast_exp2(float x) { return __builtin_amdgcn_exp2f(x); }
__device__ __forceinline__ float fast_rcp(float x) { return __builtin_amdgcn_rcpf(x); }
__device__ __forceinline__ float silu_f(float x) { return x * fast_rcp(1.0f + fast_exp2(-x * LOG2E)); }
__device__ __forceinline__ float sigmoid_f(float x) { return fast_rcp(1.0f + fast_exp2(-x * LOG2E)); }
__device__ __forceinline__ float fast_log(float x) { return __builtin_amdgcn_logf(x) * 0.6931471805599453f; }
__device__ __forceinline__ float fast_exp(float x) { return __builtin_amdgcn_exp2f(x * LOG2E); }
__device__ __forceinline__ float softplus_f(float x) { if (x > 20.f) return x; const float e = fast_exp(x); return e < 0.01f ? e * (1.0f - e * (0.5f - e * (1.0f / 3.0f))) : fast_log(1.0f + e); }
__device__ __forceinline__ float wave_sum(float v) {
#pragma unroll
    for (int o = 1; o < 64; o <<= 1) v += __shfl_xor(v, o);
    return v;
}
__device__ __forceinline__ int opaque_tid() { int t = threadIdx.x; asm volatile("" : "+v"(t)); return t; }
#define LDS_WAIT() asm volatile("s_waitcnt lgkmcnt(0)" ::: "memory")
#define VM_WAIT() asm volatile("s_waitcnt vmcnt(0)" ::: "memory")

namespace pg8 {
constexpr int BM = 256, BK = 64, HALF = 128, HTB = HALF * BK * 2, STAGE_BYTES = 8 * HTB, NXCD = 8, WGM = 8;
__host__ __device__ __forceinline__ int lds_byte(int r, int c) { const int st = (r >> 4) * 2 + (c >> 5), rr = r & 15, cc = c & 31, ob = rr * 64 + cc * 2; return st * 1024 + (ob ^ (((ob >> 9) & 1) << 5)); }
__host__ __device__ __forceinline__ void stage_rc(int b, int& R, int& C) { const int st = b / 1024, sb = b % 1024, swz = sb ^ (((sb >> 9) & 1) << 5); R = (st >> 1) * 16 + swz / 64; C = (st & 1) * 32 + (swz % 64) / 2; }
__host__ __device__ __forceinline__ int perm32(int rho) { const int n = rho >> 4, i = rho & 15; return 8 * (i >> 2) + 4 * n + (i & 3); }

struct Unit { int pm, pn, aux; };
struct Gemm { const bf16* A; int K; int ldb; int ksplit; };

struct StaticOrder {
    static constexpr bool GATHER = false;
    int nM, nN, nwg, G, c; const bf16* Bt; int ldb;
    __device__ void init(int M_, int N_, int G_, int c_, const bf16* Bt_, int ldb_) { nM = M_ / BM; nN = N_ / BM; nwg = nM * nN; G = G_; c = c_; Bt = Bt_; ldb = ldb_; }
    __device__ __forceinline__ bool next(int i, Unit& u) const {
        const long L = (long)i * G + c; if (L >= nwg) return false;
        int wgid = (int)L; { const int q = nwg / NXCD, r = nwg % NXCD, xcd = wgid % NXCD, off = wgid / NXCD; wgid = (xcd < r ? xcd * (q + 1) : r * (q + 1) + (xcd - r) * q) + off; }
        const int nig = WGM * nN, gid = wgid / nig, fm = gid * WGM, gsz = (nM - fm) < WGM ? (nM - fm) : WGM;
        u.pm = fm + ((wgid % nig) % gsz); u.pn = (wgid % nig) / gsz; u.aux = 0; return true;
    }
    __device__ __forceinline__ int a_row(const Unit& u, int r) const { return u.pm * BM + r; }
    __device__ __forceinline__ const char* b_seg(const Unit& u, int seg) const { return (const char*)(Bt + (size_t)u.pn * BM * ldb); }
};

template <class Epi, class Sched>
__device__ __forceinline__ void gemm_phase(LAS unsigned char* lds, const Gemm g, const Sched& S, const Epi& E) {
    const int tid = opaque_tid(), wid = __builtin_amdgcn_readfirstlane(tid >> 6), lane = tid & 63, wr = wid >> 2, wc = wid & 3, fr = lane & 15, fq = lane >> 4;
    const int K = g.K, nt = K / BK, ldb = g.ldb, ksplit = g.ksplit;
    int Rst[2], Cst[2]; unsigned voffB[2], voffA[2];
#pragma unroll
    for (int i = 0; i < 2; ++i) { int R, C; stage_rc(tid * 16 + i * 8192, R, C); const int Rb = Epi::PERM ? ((R & ~31) + perm32(R & 31)) : R; Rst[i] = R; Cst[i] = C;
        voffB[i] = (unsigned)(Rb * ldb + C) * 2u; voffA[i] = (unsigned)(R * K + C) * 2u; }
    const size_t hstepA = (size_t)HALF * K * 2;
    const size_t kstep = (size_t)(BK * 2);
    const size_t hstepB = (size_t)HALF * ldb * 2;
    const unsigned ldsw = (unsigned)wid * 1024u;
    const int aoff = lds_byte(wr * 64 + fr, fq * 8), boff = lds_byte(wc * 32 + fr, fq * 8);
#define PG8_SA(b, h) (((b) * 2 + (h)) * HTB)
#define PG8_SB(b, h) ((4 + (b) * 2 + (h)) * HTB)
#define PG8_STAGEB(bufoff, gbase) do { _Pragma("unroll") for (int _i = 0; _i < 2; ++_i) \
        __builtin_amdgcn_global_load_lds((const unsigned*)((const char*)(gbase) + voffB[_i]), (LAS unsigned*)(lds + (bufoff) + ldsw + _i * 8192), 16, 0, 0); } while (0)
#define PG8_STAGEA(bufoff, nextsel, h, kt) do { if constexpr (Sched::GATHER) { _Pragma("unroll") for (int _i = 0; _i < 2; ++_i) \
        __builtin_amdgcn_global_load_lds((const unsigned*)(gA + (size_t)(kt) * kstep + ((nextsel) ? vN[h][_i] : vA[h][_i])), (LAS unsigned*)(lds + (bufoff) + ldsw + _i * 8192), 16, 0, 0); } \
      else { const char* _ab = ((nextsel) ? nA : cA) + (size_t)(h) * hstepA + (size_t)(kt) * kstep; _Pragma("unroll") for (int _i = 0; _i < 2; ++_i) \
        __builtin_amdgcn_global_load_lds((const unsigned*)(_ab + voffA[_i]), (LAS unsigned*)(lds + (bufoff) + ldsw + _i * 8192), 16, 0, 0); } } while (0)
#define PG8_LDA(dst, b, h) do { _Pragma("unroll") for (int m = 0; m < 4; ++m) _Pragma("unroll") for (int k = 0; k < 2; ++k) dst[m][k] = *(const LAS bf16x8*)(lds + PG8_SA(b, h) + aoff + m * 2048 + k * 1024); } while (0)
#define PG8_LDB(dst, b, h) do { _Pragma("unroll") for (int n = 0; n < 2; ++n) _Pragma("unroll") for (int k = 0; k < 2; ++k) dst[n][k] = *(const LAS bf16x8*)(lds + PG8_SB(b, h) + boff + n * 2048 + k * 1024); } while (0)
#define PG8_MMA(ai, bj, At, Bt) do { __builtin_amdgcn_s_setprio(1); _Pragma("unroll") for (int m = 0; m < 4; ++m) _Pragma("unroll") for (int n = 0; n < 2; ++n) _Pragma("unroll") for (int k = 0; k < 2; ++k) \
        acc[ai][bj][m][n] = __builtin_amdgcn_mfma_f32_16x16x32_bf16(Bt[n][k], At[m][k], acc[ai][bj][m][n], 0, 0, 0); __builtin_amdgcn_s_setprio(0); } while (0)
#define PG8_WAIT_V(n) asm volatile("s_waitcnt vmcnt(" #n ")" ::: "memory")
#define PG8_WAIT_L(n) asm volatile("s_waitcnt lgkmcnt(" #n ")" ::: "memory")
#define PG8_BAR __builtin_amdgcn_s_barrier()
#define PG8_SCHED __builtin_amdgcn_sched_barrier(0)
#define PG8_AOFFS(dst, u) do { _Pragma("unroll") for (int _h = 0; _h < 2; ++_h) _Pragma("unroll") for (int _i = 0; _i < 2; ++_i) \
        dst[_h][_i] = (unsigned)S.a_row(u, _h * HALF + Rst[_i]) * (unsigned)(K * 2) + (unsigned)(Cst[_i] * 2); } while (0)
    Unit cur, nxt; int ui = 0;
    if (!S.next(0, cur)) return;
    const char* const gA = (const char*)g.A;
    f32x4 acc[2][2][4][2];
#pragma unroll
    for (int a = 0; a < 2; ++a)
#pragma unroll
        for (int b = 0; b < 2; ++b)
#pragma unroll
            for (int m = 0; m < 4; ++m)
#pragma unroll
                for (int n = 0; n < 2; ++n) acc[a][b][m][n] = (f32x4){0.f, 0.f, 0.f, 0.f};
    bf16x8 At[4][2], B0[2][2], B1[2][2];
    unsigned vA[2][2], vN[2][2];
    const char* cA = gA; const char* nA = gA;
    if constexpr (Sched::GATHER) { PG8_AOFFS(vA, cur); } else { cA = gA + (size_t)S.a_row(cur, 0) * K * 2; }
    const char* cB0 = S.b_seg(cur, 0); const char* cB1 = S.b_seg(cur, 1);
    PG8_STAGEB(PG8_SB(0, 0), cB0); PG8_STAGEB(PG8_SB(0, 1), cB0 + hstepB); PG8_STAGEA(PG8_SA(0, 0), false, 0, 0); PG8_STAGEA(PG8_SA(0, 1), false, 1, 0);
    if (wr == 1) PG8_BAR;
    PG8_WAIT_V(2); PG8_BAR;
    PG8_STAGEB(PG8_SB(1, 0), cB0 + kstep); PG8_STAGEA(PG8_SA(1, 0), false, 0, 1); PG8_STAGEB(PG8_SB(1, 1), cB0 + hstepB + kstep);
    PG8_WAIT_V(6); PG8_BAR;
    for (;;) {
        const bool has_next = S.next(ui + 1, nxt);
        const char* nB0 = cB0;
        nA = cA;
        if (has_next) { nB0 = S.b_seg(nxt, 0); if constexpr (Sched::GATHER) { PG8_AOFFS(vN, nxt); } else { nA = gA + (size_t)S.a_row(nxt, 0) * K * 2; } }
        else { if constexpr (Sched::GATHER) {
#pragma unroll
            for (int h = 0; h < 2; ++h)
#pragma unroll
                for (int i = 0; i < 2; ++i) vN[h][i] = vA[h][i]; } }
#pragma unroll 1
        for (int t = 0; t < nt; t += 2) {
            const bool last = (t == nt - 2);
            const char* b2 = last ? nB0 : ((t + 2 < ksplit) ? cB0 + (size_t)(t + 2) * kstep : cB1 + (size_t)(t + 2 - ksplit) * kstep);
            const char* b3 = b2 + kstep;
            const int kt2 = last ? 0 : t + 2;
            PG8_LDB(B0, 0, 0); PG8_LDB(B1, 0, 1); PG8_SCHED; PG8_LDA(At, 0, 0); PG8_STAGEA(PG8_SA(1, 1), false, 1, t + 1);
            PG8_WAIT_V(8); PG8_WAIT_L(0); PG8_BAR; PG8_MMA(0, 0, At, B0); PG8_MMA(0, 1, At, B1); PG8_BAR; PG8_SCHED;
            PG8_LDA(At, 0, 1); PG8_STAGEB(PG8_SB(0, 0), b2); PG8_STAGEB(PG8_SB(0, 1), b2 + hstepB); PG8_STAGEA(PG8_SA(0, 0), last, 0, kt2);
            PG8_WAIT_V(8); PG8_WAIT_L(0); PG8_BAR; PG8_MMA(1, 0, At, B0); PG8_MMA(1, 1, At, B1); PG8_BAR; PG8_SCHED;
            PG8_LDB(B0, 1, 0); PG8_LDB(B1, 1, 1); PG8_SCHED; PG8_LDA(At, 1, 0); PG8_STAGEA(PG8_SA(0, 1), last, 1, kt2);
            PG8_WAIT_V(8); PG8_WAIT_L(0); PG8_BAR; PG8_MMA(0, 0, At, B0); PG8_MMA(0, 1, At, B1); PG8_BAR; PG8_SCHED;
            PG8_LDA(At, 1, 1); PG8_STAGEB(PG8_SB(1, 0), b3); PG8_STAGEB(PG8_SB(1, 1), b3 + hstepB); PG8_STAGEA(PG8_SA(1, 0), last, 0, kt2 + 1);
            PG8_WAIT_V(8); PG8_WAIT_L(0); PG8_BAR; PG8_MMA(1, 0, At, B0); PG8_MMA(1, 1, At, B1); PG8_BAR; PG8_SCHED;
        }
        if (wr == 0) PG8_BAR;
        { int tz = tid; asm volatile("" : "+v"(tz));
          const int lz = tz & 63; E(acc, cur, ui, wr, wc, lz & 15, lz >> 4); }
        if (!has_next) break;
#pragma unroll
        for (int a = 0; a < 2; ++a)
#pragma unroll
            for (int b = 0; b < 2; ++b)
#pragma unroll
                for (int m = 0; m < 4; ++m)
#pragma unroll
                    for (int n = 0; n < 2; ++n) acc[a][b][m][n] = (f32x4){0.f, 0.f, 0.f, 0.f};
        cur = nxt; cB0 = nB0; cB1 = S.b_seg(cur, 1); cA = nA; ++ui;
        if constexpr (Sched::GATHER) {
#pragma unroll
        for (int h = 0; h < 2; ++h)
#pragma unroll
            for (int i = 0; i < 2; ++i) vA[h][i] = vN[h][i]; }
        if (wr == 1) PG8_BAR;
    }
    PG8_WAIT_V(0);
    PG8_BAR;
#undef PG8_SA
#undef PG8_SB
#undef PG8_STAGEA
#undef PG8_STAGEB
#undef PG8_LDA
#undef PG8_LDB
#undef PG8_MMA
#undef PG8_WAIT_V
#undef PG8_WAIT_L
#undef PG8_BAR
#undef PG8_SCHED
#undef PG8_AOFFS
}
}
#define XB_TMO      128
#define XB_XCNT(j)  (256  + 64 * (j))
#define XB_XSUB(j)  (1280 + 64 * (j))
#define XB_XGEN(j)  (2304 + 64 * (j))
#define XB_TOP      3328
#define XB_TOPGEN   3392
#define XCD_BAR_WORDS 3456
#define XB_SPIN_CAP (1u << 22)
__device__ __forceinline__ unsigned xb_ld(unsigned* p)              { return __hip_atomic_load(p, __ATOMIC_RELAXED, __HIP_MEMORY_SCOPE_AGENT); }
__device__ __forceinline__ unsigned xb_add(unsigned* p, unsigned v) { return __hip_atomic_fetch_add(p, v, __ATOMIC_RELAXED, __HIP_MEMORY_SCOPE_AGENT); }
__device__ __forceinline__ unsigned xb_xcc_id() { return (unsigned)__builtin_amdgcn_s_getreg((3 << 11) | 20) & 0xFu; }
#define XB_SPIN(cond, bar) do { unsigned _sp = 0; while (cond) { __builtin_amdgcn_s_sleep(1); \
    if ((++_sp & 255u) == 0u) { if (xb_ld(&(bar)[XB_TMO])) break; if (_sp > XB_SPIN_CAP) { atomicAdd(&(bar)[XB_TMO], 1u); break; } } } } while (0)
struct XcdBarrier { unsigned* bar; unsigned x; volatile LAS unsigned* st; };
__device__ __forceinline__ XcdBarrier xcd_barrier_post(unsigned* bar, volatile LAS unsigned* st) {
    XcdBarrier b; b.bar = bar; b.x = xb_xcc_id(); b.st = st;
    if (threadIdx.x == 0) (void)xb_add(&bar[XB_XCNT(b.x)], 1u);
    return b;
}
__device__ __forceinline__ void xcd_barrier_complete(unsigned* bar, unsigned x, unsigned& nloc, unsigned& nx) {
    const unsigned G = gridDim.x * gridDim.y * gridDim.z;
    unsigned sum, cnt, mine, sp = 0u;
    for (;;) {
        sum = 0u; cnt = 0u; mine = 0u;
#pragma unroll
        for (unsigned j = 0; j < 16; ++j) { const unsigned c = xb_ld(&bar[XB_XCNT(j)]); sum += c; cnt += (c > 0u) ? 1u : 0u; mine = (j == x) ? c : mine; }
        if (sum == G) break;
        __builtin_amdgcn_s_sleep(1);
        if ((++sp & 255u) == 0u) { if (xb_ld(&bar[XB_TMO])) break; if (sp > XB_SPIN_CAP) { atomicAdd(&bar[XB_TMO], 1u); break; } }
    }
    nloc = mine > 0u ? mine : 1u; nx = cnt > 0u ? cnt : 1u;
}
__device__ __forceinline__ void xcd_barrier(const XcdBarrier& b) {
    asm volatile("s_waitcnt vmcnt(0)" ::: "memory");
    __syncthreads();
    if (threadIdx.x == 0) {
        unsigned* bar = b.bar;
        __builtin_amdgcn_s_waitcnt(0);
        unsigned nloc = b.st[0], nx = b.st[1];
        if (nloc == 0u) { xcd_barrier_complete(bar, b.x, nloc, nx); b.st[0] = nloc; b.st[1] = nx; }
        const unsigned old = xb_add(&bar[XB_XSUB(b.x)], 1u);
        const unsigned gen = old / nloc;
        if (old + 1u == (gen + 1u) * nloc) {
            __builtin_amdgcn_fence(__ATOMIC_RELEASE, "agent");
            asm volatile("s_waitcnt vmcnt(0)" ::: "memory");
            const unsigned og = xb_add(&bar[XB_TOP], 1u);
            const unsigned tg = og / nx;
            if (og + 1u == (tg + 1u) * nx) xb_add(&bar[XB_TOPGEN], 1u);
            else XB_SPIN(xb_ld(&bar[XB_TOPGEN]) == tg, bar);
            __builtin_amdgcn_fence(__ATOMIC_ACQUIRE, "agent");
            xb_add(&bar[XB_XGEN(b.x)], 1u);
            asm volatile("s_waitcnt vmcnt(0)" ::: "memory");
        } else {
            XB_SPIN(xb_ld(&bar[XB_XGEN(b.x)]) == gen, bar);
            __builtin_amdgcn_fence(__ATOMIC_ACQUIRE, "agent");
            asm volatile("s_waitcnt vmcnt(0)" ::: "memory");
        }
    }
    __syncthreads();
}

constexpr size_t MiB = 1u << 20;
constexpr size_t WS_CTL = 0, CTL_ZERO_BYTES = 1 * MiB;
constexpr size_t WS_MOD = 1 * MiB;
constexpr size_t WS_TABA = 2 * MiB;
constexpr size_t WS_TABM = 3 * MiB;
constexpr size_t WS_WGU = 4 * MiB;
constexpr size_t WS_WDN = 20 * MiB;
constexpr size_t WS_WMIX = 28 * MiB;
constexpr size_t WS_X = 52 * MiB;
constexpr size_t WS_H = 188 * MiB;
constexpr size_t WS_SCR = 256 * MiB;
constexpr size_t WS_END = 512 * MiB;
constexpr size_t MOE_ACT = WS_SCR;
constexpr size_t MOE_SL = WS_SCR + 48 * MiB;
constexpr size_t MOE_WT = WS_SCR + 52 * MiB;
constexpr int CW_BAR = 4096;
constexpr int CW_MOECNT = 16384;
constexpr int CW_POISON = 20000;

constexpr int RING_BYTES = 131072;
constexpr int LDS_MISC = RING_BYTES;
constexpr int LDS_TB = RING_BYTES + 512;
constexpr int LDS_TBL = RING_BYTES + 1024;
constexpr int LDS_BYTES = RING_BYTES + 1024 + 16384;

struct Frame {
    LAS unsigned char* lds;
    unsigned* ctl;
    unsigned char* ws;
    float* out;
    int tid, lane, wave, vcu;
};

__device__ __forceinline__ void refresh(Frame& F) { F.tid = opaque_tid(); F.lane = F.tid & 63; F.wave = __builtin_amdgcn_readfirstlane(F.tid >> 6); }
#define SYNC_GRID() do { xcd_barrier(bar); refresh(F); } while (0)
__device__ __forceinline__ int modrow_of(int row) { const int b = row / TPB, t = row - b * TPB; return t < CTX ? 8 : b; }

enum { MAP_ID = 0, MAP_ATTN_IN, MAP_SSM_IN, MAP_MLA_IN, MAP_MLA_QUP, MAP_MOE_G, MAP_MOE_U };
template <int KIND> __device__ __forceinline__ int map_row(int n, int aux) {
    if (KIND == MAP_ID) return aux + n;
    if (KIND == MAP_ATTN_IN) { if (n >= 1280) return n; const int hb = n & ~63, d = n & 63; return hb + (d < 32 ? 2 * d : 2 * (d - 32) + 1); }
    if (KIND == MAP_SSM_IN) {
        if (n < 2048) { const int gp = n >> 10; return gp * 2816 + (n & 1023); }
        if (n < 4096) { const int c = n - 2048, gp = c >> 10; return gp * 2816 + 1024 + (c & 1023); }
        if (n < 4608) { const int c = n - 4096, gp = c >> 8; return gp * 2816 + 2048 + (c & 255); }
        if (n < 5120) { const int c = n - 4608, gp = c >> 8; return gp * 2816 + 2304 + (c & 255); }
        { const int c = n - 5120, dir = c >> 5, h = c & 31, gp = h >> 4; return gp * 2816 + 2560 + dir * 16 + (h & 15); }
    }
    if (KIND == MAP_MLA_IN) { if (n < 512) return n; const int d = n - 512; return 512 + (d < 16 ? 2 * d : 2 * (d - 16) + 1); }
    if (KIND == MAP_MLA_QUP) { const int h = n / 96, e = n - h * 96; if (e < 64) return n; const int d = e - 64; return h * 96 + 64 + (d < 16 ? 2 * d : 2 * (d - 16) + 1); }
    if (KIND == MAP_MOE_G) return aux + (n >> 7) * 256 + (n & 127);
    if (KIND == MAP_MOE_U) return aux + (n >> 7) * 256 + 128 + (n & 127);
    return n;
}
template <int KIND>
__device__ __forceinline__ void transpose_item(const float* W, int K, int N, bf16* WT, int aux, const float* kscale, LAS float* scr, int item, int lane) {
    const int nblk = N / 32, kb = item / nblk, nb = item % nblk, k0 = 64 * kb, n0 = 32 * nb;
#pragma unroll 8
    for (int i = 0; i < 32; ++i) { const int kk = 2 * i + (lane >> 5); float v = W[(size_t)(k0 + kk) * N + n0 + (lane & 31)]; if (kscale) v *= kscale[k0 + kk]; scr[kk * 33 + (lane & 31)] = v; }
    LDS_WAIT(); asm volatile("" ::: "memory");
    const int c = lane & 7;
#pragma unroll
    for (int j = 0; j < 4; ++j) { const int n = (lane >> 3) + 8 * j; const LAS float* s = scr + (8 * c) * 33 + n;
        v4u o; o.x = cvt_pk_bf16(s[0 * 33], s[1 * 33]); o.y = cvt_pk_bf16(s[2 * 33], s[3 * 33]); o.z = cvt_pk_bf16(s[4 * 33], s[5 * 33]); o.w = cvt_pk_bf16(s[6 * 33], s[7 * 33]);
        *(v4u*)(WT + (size_t)map_row<KIND>(n0 + n, aux) * K + k0 + 8 * c) = o; }
    LDS_WAIT(); asm volatile("" ::: "memory");
}
template <int KIND>
__device__ __forceinline__ void convert_matrix(Frame& F, const float* W, int K, int N, bf16* WT, int aux, const float* kscale) {
    LAS float* scr = (LAS float*)(F.lds + F.wave * 16384);
    const int gw = F.vcu * NWAVES + F.wave, NGW = GRID * NWAVES, nitems = (K / 64) * (N / 32);
    for (int it = gw; it < nitems; it += NGW) transpose_item<KIND>(W, K, N, WT, aux, kscale, scr, it, F.lane);
}
__device__ __forceinline__ void zero_rows(Frame& F, bf16* WT, int row0, int nrows, int K) {
    const size_t n16 = (size_t)nrows * K / 8; v4u* p = (v4u*)(WT + (size_t)row0 * K);
    for (size_t i = (size_t)blockIdx.x * NTHR + F.tid; i < n16; i += (size_t)GRID * NTHR) p[i] = (v4u){0u, 0u, 0u, 0u};
}
__device__ __forceinline__ void convert_moe(Frame& F, const float* const* in, int layer) {
    bf16* GU = (bf16*)(F.ws + WS_WGU); bf16* DN = (bf16*)(F.ws + WS_WDN);
    const float* wg = in[12] + (size_t)layer * 16 * 1024 * 256; const float* wu = in[13] + (size_t)layer * 16 * 1024 * 256; const float* wd = in[14] + (size_t)layer * 16 * 256 * 1024;
    for (int e = 0; e < 16; ++e) {
        convert_matrix<MAP_MOE_G>(F, wg + (size_t)e * 1024 * 256, 1024, 256, GU, e * 512, nullptr);
        convert_matrix<MAP_MOE_U>(F, wu + (size_t)e * 1024 * 256, 1024, 256, GU, e * 512, nullptr);
        convert_matrix<MAP_ID>(F, wd + (size_t)e * 256 * 1024, 256, 1024, DN, e * 1024, nullptr);
    }
}

__device__ __forceinline__ void norm_mod_row(const float* xrow, const float* g, const float* sc, const float* sh, bf16* orow, int lane, f32x4 (&hv)[4]) {
    const f32x4* xr = (const f32x4*)xrow + lane;
    f32x4 v[4]; float s = 0.f;
#pragma unroll
    for (int j = 0; j < 4; ++j) { v[j] = xr[64 * j]; s += (v[j].x * v[j].x + v[j].y * v[j].y) + (v[j].z * v[j].z + v[j].w * v[j].w); }
    const float rstd = rsqrtf(wave_sum(s) * (1.f / D) + EPS);
    unsigned long long* o8 = (unsigned long long*)orow + lane;
#pragma unroll
    for (int j = 0; j < 4; ++j) {
        const f32x4 gg = ((const f32x4*)g)[lane + 64 * j], ss = ((const f32x4*)sc)[lane + 64 * j], hh = ((const f32x4*)sh)[lane + 64 * j];
        f32x4 h = v[j] * rstd * gg * (ss + 1.0f) + hh; hv[j] = h;
        o8[64 * j] = (unsigned long long)cvt_pk_bf16(h.x, h.y) | ((unsigned long long)cvt_pk_bf16(h.z, h.w) << 32);
    }
}
__device__ __forceinline__ void phase_norm1(Frame& F, const float* const* in, int layer) {
    const float* X = (const float*)(F.ws + WS_X); bf16* H = (bf16*)(F.ws + WS_H);
    const float* g = in[4] + layer * D; const float* mod = (const float*)(F.ws + WS_MOD) + (size_t)layer * 9 * 6144;
    const int gw = F.vcu * NWAVES + F.wave, NGW = GRID * NWAVES;
    for (int r = gw; r < M; r += NGW) { const float* mr = mod + (size_t)modrow_of(r) * 6144; f32x4 hv[4];
        norm_mod_row(X + (size_t)r * D, g, mr + 1024, mr, H + (size_t)r * D, F.lane, hv); }
}

__device__ __forceinline__ void phase_prologue(Frame& F, const float* const* in) {
    { float* X = (float*)(F.ws + WS_X); const int gw = F.vcu * NWAVES + F.wave, NGW = GRID * NWAVES;
      for (int r = gw; r < M; r += NGW) { const int b = r / TPB, t = r - b * TPB;
          const float* src = t < CTX ? in[2] + ((size_t)b * CTX + t) * D : in[0] + ((size_t)b * SEQ + (t - CTX)) * D;
          const f32x4* s4 = (const f32x4*)src + F.lane; f32x4* d4 = (f32x4*)(X + (size_t)r * D) + F.lane;
#pragma unroll
          for (int j = 0; j < 4; ++j) d4[64 * j] = s4[64 * j]; } }
    { f32x2* TA = (f32x2*)(F.ws + WS_TABA); f32x2* TM = (f32x2*)(F.ws + WS_TABM);
      for (int i = blockIdx.x * NTHR + F.tid; i < SEQ * 32; i += GRID * NTHR) { const int pos = i >> 5, a = i & 31; const float p = (a < 16) ? (float)(pos >> 6) : (float)(pos & 63);
          const float inv = fast_exp2(-(float)(a & 15) * (13.287712379549449f / 16.0f)); const float rev = p * inv * 0.15915494309189535f; TA[i] = (f32x2){__builtin_amdgcn_cosf(rev), __builtin_amdgcn_sinf(rev)}; }
      for (int i = blockIdx.x * NTHR + F.tid; i < SEQ * 16; i += GRID * NTHR) { const int pos = i >> 4, a = i & 15; const float p = (a < 8) ? (float)(pos >> 6) : (float)(pos & 63);
          const float inv = fast_exp2(-(float)(a & 7) * (13.287712379549449f / 8.0f)); const float rev = p * inv * 0.15915494309189535f; TM[i] = (f32x2){__builtin_amdgcn_cosf(rev), __builtin_amdgcn_sinf(rev)}; } }
    { LAS float* sc = (LAS float*)F.lds;
      LAS float* part = (LAS float*)(F.lds + 40960);
      for (int i = F.tid; i < 9 * 1024; i += NTHR) { const int r = i >> 10, k = i & 1023; const float c = r < 8 ? in[1][r * 1024 + k] : in[3][k]; sc[i] = silu_f(c); }
      __syncthreads();
      float* MOD = (float*)(F.ws + WS_MOD);
      for (int u = F.vcu; u < 4 * 96; u += GRID) { const int l = u / 96, cb = u % 96, col = cb * 64 + (F.tid & 63), ks = F.tid >> 6;
          const float* w = in[6] + (size_t)l * 1024 * 6144 + col; float a[9];
#pragma unroll
          for (int r = 0; r < 9; ++r) a[r] = 0.f;
#pragma unroll 8
          for (int k = ks * 128; k < ks * 128 + 128; ++k) { const float wv = w[(size_t)k * 6144];
#pragma unroll
              for (int r = 0; r < 9; ++r) a[r] += sc[r * 1024 + k] * wv; }
#pragma unroll
          for (int r = 0; r < 9; ++r) part[(ks * 9 + r) * 64 + (F.tid & 63)] = a[r];
          __syncthreads();
          for (int i = F.tid; i < 9 * 64; i += NTHR) { const int r = i >> 6, c = i & 63; float s = 0.f;
#pragma unroll
              for (int q = 0; q < 8; ++q) s += part[(q * 9 + r) * 64 + c];
              MOD[((size_t)l * 9 + r) * 6144 + cb * 64 + c] = s + in[7][l * 6144 + cb * 64 + c]; }
          __syncthreads(); } }
}

__device__ __forceinline__ void phase_norm2_route(Frame& F, const float* const* in, int layer) {
    constexpr int RPW = M / GRID;
    LAS float* wl = (LAS float*)F.lds;
    LAS int* lcnt = (LAS int*)(F.lds + 81920);
    LAS int* lbase = (LAS int*)(F.lds + 81920 + 128);
    LAS int* rcls = (LAS int*)(F.lds + 81920 + 256);
    LAS int* rrank = (LAS int*)(F.lds + 81920 + 256 + 1024);
    LAS float* lgw = (LAS float*)(F.lds + 81920 + 4096);
    const float* wrg = in[8] + (size_t)layer * 1024 * 4; const float* wre = in[10] + (size_t)layer * 1024 * 16;
    for (int i = F.tid; i < 1024 * 4; i += NTHR) { const int k = i >> 2, o = i & 3; wl[o * 1024 + k] = wrg[i]; }
    for (int i = F.tid; i < 1024 * 16; i += NTHR) { const int k = i >> 4, o = i & 15; wl[(4 + o) * 1024 + k] = wre[i]; }
    if (F.tid < 24) lcnt[F.tid] = 0;
    __syncthreads();
    const float* X = (const float*)(F.ws + WS_X); bf16* H = (bf16*)(F.ws + WS_H);
    const float* g = in[5] + layer * D; const float* mod = (const float*)(F.ws + WS_MOD) + (size_t)layer * 9 * 6144;
    const float* brg = in[9] + layer * 4; const float* bre = in[11] + layer * 16;
    float* WT = (float*)(F.ws + MOE_WT); int* SL = (int*)(F.ws + MOE_SL);
    const int row0 = blockIdx.x * RPW;
    for (int i = F.wave; i < RPW; i += NWAVES) { const int r = row0 + i; const float* mr = mod + (size_t)modrow_of(r) * 6144; f32x4 hv[4];
        norm_mod_row(X + (size_t)r * D, g, mr + 4 * 1024, mr + 3 * 1024, H + (size_t)r * D, F.lane, hv);
        LAS float* lgs = lgw + F.wave * 32;
        for (int o = 0; o < 20; ++o) { float s = 0.f;
#pragma unroll
            for (int j = 0; j < 4; ++j) { const f32x4 w = *(const LAS f32x4*)(wl + o * 1024 + 4 * F.lane + 256 * j); s += (hv[j].x * w.x + hv[j].y * w.y) + (hv[j].z * w.z + hv[j].w * w.w); }
            s = wave_sum(s); if (F.lane == 0) lgs[o] = s; }
        LDS_WAIT(); asm volatile("" ::: "memory");
        float g0 = lgs[0] + brg[0], g1 = lgs[1] + brg[1], g2 = lgs[2] + brg[2], g3 = lgs[3] + brg[3];
        int gs = 0; float gm = g0; if (g1 > gm) { gm = g1; gs = 1; } if (g2 > gm) { gm = g2; gs = 2; } if (g3 > gm) { gm = g3; gs = 3; }
        const float pg = 1.0f / (fast_exp(g0 - gm) + fast_exp(g1 - gm) + fast_exp(g2 - gm) + fast_exp(g3 - gm));
        float e0 = lgs[4 + gs * 4 + 0] + bre[gs * 4 + 0], e1 = lgs[4 + gs * 4 + 1] + bre[gs * 4 + 1], e2 = lgs[4 + gs * 4 + 2] + bre[gs * 4 + 2], e3 = lgs[4 + gs * 4 + 3] + bre[gs * 4 + 3];
        LDS_WAIT(); asm volatile("" ::: "memory");
        int i1 = 0; float v1 = e0; if (e1 > v1) { v1 = e1; i1 = 1; } if (e2 > v1) { v1 = e2; i1 = 2; } if (e3 > v1) { v1 = e3; i1 = 3; }
        int i2 = -1; float v2 = -3.0e38f;
        if (i1 != 0 && e0 > v2) { v2 = e0; i2 = 0; } if (i1 != 1 && e1 > v2) { v2 = e1; i2 = 1; } if (i1 != 2 && e2 > v2) { v2 = e2; i2 = 2; } if (i1 != 3 && e3 > v2) { v2 = e3; i2 = 3; }
        const float ex = fast_exp(v2 - v1), w1 = pg / (1.0f + ex), w2 = pg * ex / (1.0f + ex);
        const int lo = i1 < i2 ? i1 : i2, hi = i1 < i2 ? i2 : i1; const float wlo = i1 < i2 ? w1 : w2, whi = i1 < i2 ? w2 : w1;
        const int pair = lo == 0 ? hi - 1 : (lo == 1 ? hi + 1 : 5);
        const int cls = gs * 6 + pair;
        if (F.lane == 0) { WT[2 * (size_t)r] = wlo; WT[2 * (size_t)r + 1] = whi; rcls[i] = cls; rrank[i] = atomicAdd((int*)&lcnt[cls], 1); }
    }
    __syncthreads();
    if (F.tid < 24) lbase[F.tid] = (int)atomicAdd(F.ctl + CW_MOECNT + layer * 64 + F.tid, (unsigned)lcnt[F.tid]);
    __syncthreads();
    for (int i = F.tid; i < RPW; i += NTHR) { const int c = rcls[i]; SL[(size_t)c * M + lbase[c] + rrank[i]] = row0 + i; }
}

__device__ __forceinline__ void phase_final(Frame& F, const float* const* in, bool poison) {
    const float* X = (const float*)(F.ws + WS_X); const float* g = in[36];
    const int gw = F.vcu * NWAVES + F.wave, NGW = GRID * NWAVES;
    for (int q = gw; q < NB * SEQ; q += NGW) { const int b = q / SEQ, p = q - b * SEQ; const int r = b * TPB + CTX + p;
        const f32x4* xr = (const f32x4*)(X + (size_t)r * D) + F.lane; f32x4 v[4]; float s = 0.f;
#pragma unroll
        for (int j = 0; j < 4; ++j) { v[j] = xr[64 * j]; s += (v[j].x * v[j].x + v[j].y * v[j].y) + (v[j].z * v[j].z + v[j].w * v[j].w); }
        float rstd = rsqrtf(wave_sum(s) * (1.f / D) + EPS); if (poison) rstd = __builtin_nanf("");
        f32x4* o = (f32x4*)(F.out + (size_t)q * D) + F.lane;
#pragma unroll
        for (int j = 0; j < 4; ++j) o[64 * j] = v[j] * rstd * ((const f32x4*)g)[F.lane + 64 * j]; }
}
typedef f32x4 AccT[2][2][4][2];
using pg8::Unit;

__device__ __forceinline__ v4u pack8(const f32x4 a, const f32x4 b) { v4u w; w.x = cvt_pk_bf16(a[0], a[1]); w.y = cvt_pk_bf16(a[2], a[3]); w.z = cvt_pk_bf16(b[0], b[1]); w.w = cvt_pk_bf16(b[2], b[3]); return w; }
__device__ __forceinline__ void rope8(f32x4& a, f32x4& b, const f32x2* cs) {
    const f32x4 c01 = *(const f32x4*)cs, c23 = *(const f32x4*)(cs + 2);
    float t;
    t = a[0] * c01[0] - a[1] * c01[1]; a[1] = a[1] * c01[0] + a[0] * c01[1]; a[0] = t;
    t = a[2] * c01[2] - a[3] * c01[3]; a[3] = a[3] * c01[2] + a[2] * c01[3]; a[2] = t;
    t = b[0] * c23[0] - b[1] * c23[1]; b[1] = b[1] * c23[0] + b[0] * c23[1]; b[0] = t;
    t = b[2] * c23[2] - b[3] * c23[3]; b[3] = b[3] * c23[2] + b[2] * c23[3]; b[2] = t;
}

struct EpiResid {
    static constexpr bool PERM = false;
    float* X; const float* gate;
    __device__ __forceinline__ void operator()(const AccT& acc, const Unit& u, int ui, int wr, int wc, int fr, int fq) const {
        const int tb = u.pm % 17, b = u.pm / 17; const float* gv = gate + (size_t)(tb == 0 ? 8 : b) * 6144;
        const int row0 = u.pm * 256 + wr * 64 + fr, col0 = u.pn * 256 + wc * 32 + 4 * fq;
        f32x4 g4[2][2];
#pragma unroll
        for (int bj = 0; bj < 2; ++bj)
#pragma unroll
            for (int n = 0; n < 2; ++n) g4[bj][n] = *(const f32x4*)(gv + col0 + bj * 128 + n * 16);
#pragma unroll
        for (int ai = 0; ai < 2; ++ai)
#pragma unroll
            for (int m = 0; m < 4; ++m) { float* rowp = X + (size_t)(row0 + ai * 128 + m * 16) * D + col0;
#pragma unroll
                for (int bj = 0; bj < 2; ++bj)
#pragma unroll
                    for (int n = 0; n < 2; ++n) { f32x4* p = (f32x4*)(rowp + bj * 128 + n * 16); *p = *p + g4[bj][n] * acc[ai][bj][m][n]; }
                asm volatile("" ::: "memory"); }
    }
};

struct EpiAttnIn {
    static constexpr bool PERM = true;
    bf16 *Q, *Kb, *Vb; const f32x2* tab; float qscale;
    __device__ __forceinline__ void operator()(const AccT& acc, const Unit& u, int ui, int wr, int wc, int fr, int fq) const {
        const int tb = u.pm % 17; const bool lat = tb != 0; const int pos0 = (tb - 1) * 256;
        bf16* base; int ld, colt; float sc = 1.f; bool rope = lat;
        if (u.pn < 4) { base = Q; ld = 1024; colt = u.pn * 256; sc = qscale; } else if (u.pn == 4) { base = Kb; ld = 256; colt = 0; } else { base = Vb; ld = 256; colt = 0; rope = false; }
#pragma unroll
        for (int ai = 0; ai < 2; ++ai)
#pragma unroll
            for (int m = 0; m < 4; ++m) { const int rl = ai * 128 + wr * 64 + m * 16 + fr; const size_t row = (size_t)u.pm * 256 + rl;
#pragma unroll
                for (int bj = 0; bj < 2; ++bj) { const int cl = bj * 128 + wc * 32 + 8 * fq;
                    f32x4 a = acc[ai][bj][m][0] * sc, b = acc[ai][bj][m][1] * sc;
                    if (rope) rope8(a, b, tab + (size_t)(pos0 + rl) * 32 + ((cl & 63) >> 1));
                    *(v4u*)(base + row * ld + colt + cl) = pack8(a, b); }
                asm volatile("" ::: "memory"); }
    }
};

struct EpiSsmIn {
    static constexpr bool PERM = true;
    bf16 *Z, *XBC; float* DT; const float* dtb;
    __device__ __forceinline__ void operator()(const AccT& acc, const Unit& u, int ui, int wr, int wc, int fr, int fq) const {
#pragma unroll
        for (int ai = 0; ai < 2; ++ai)
#pragma unroll
            for (int m = 0; m < 4; ++m) { const size_t row = (size_t)u.pm * 256 + ai * 128 + wr * 64 + m * 16 + fr;
#pragma unroll
                for (int bj = 0; bj < 2; ++bj) { const int c = u.pn * 256 + bj * 128 + wc * 32 + 8 * fq;
                    const f32x4 a = acc[ai][bj][m][0], b = acc[ai][bj][m][1];
                    if (c < 1024) *(v4u*)(Z + row * 1024 + c) = pack8(a, b);
                    else if (c < 2560) *(v4u*)(XBC + row * 1536 + (c - 1024)) = pack8(a, b);
                    else if (c < 2592) { const int cc = c - 2560; f32x4 o0, o1;
#pragma unroll
                        for (int j = 0; j < 4; ++j) { o0[j] = softplus_f(a[j] + dtb[(cc >> 4) * 32 + (cc & 15) + j]); o1[j] = softplus_f(b[j] + dtb[(cc >> 4) * 32 + (cc & 15) + 4 + j]); }
                        *(f32x4*)(DT + row * 32 + cc) = o0; *(f32x4*)(DT + row * 32 + cc + 4) = o1; } } }
    }
};

struct EpiMlIn {
    static constexpr bool PERM = true;
    bf16 *Qm, *Km, *Vm, *Om; float* G; const float* gb;
    __device__ __forceinline__ void operator()(const AccT& acc, const Unit& u, int ui, int wr, int wc, int fr, int fq) const {
#pragma unroll
        for (int ai = 0; ai < 2; ++ai)
#pragma unroll
            for (int m = 0; m < 4; ++m) { const size_t row = (size_t)u.pm * 256 + ai * 128 + wr * 64 + m * 16 + fr;
#pragma unroll
                for (int bj = 0; bj < 2; ++bj) { const int c = u.pn * 256 + bj * 128 + wc * 32 + 8 * fq;
                    const f32x4 a = acc[ai][bj][m][0], b = acc[ai][bj][m][1];
                    if (c < 512) *(v4u*)(Qm + row * 512 + c) = pack8(a, b);
                    else if (c < 1024) *(v4u*)(Km + row * 512 + (c - 512)) = pack8(a * 0.125f, b * 0.125f);
                    else if (c < 2048) *(v4u*)(Vm + row * 1024 + (c - 1024)) = pack8(a, b);
                    else if (c < 3072) *(v4u*)(Om + row * 1024 + (c - 2048)) = pack8(a, b);
                    else if (c < 3104) { const int cc = c - 3072; f32x4 o0, o1; const bool fg = ((cc >> 3) & 1) != 0;
#pragma unroll
                        for (int j = 0; j < 4; ++j) { float x0 = a[j] + gb[cc + j], x1 = b[j] + gb[cc + 4 + j];
                            o0[j] = fg ? -softplus_f(-x0) : x0; o1[j] = fg ? -softplus_f(-x1) : x1; }
                        *(f32x4*)(G + row * 32 + cc) = o0; *(f32x4*)(G + row * 32 + cc + 4) = o1; } } }
    }
};

struct EpiMlaIn {
    static constexpr bool PERM = true;
    bf16 *CQ, *CKV, *KF; float* SSQ; const f32x2* tab;
    __device__ __forceinline__ void operator()(const AccT& acc, const Unit& u, int ui, int wr, int wc, int fr, int fq) const {
        const int tb = u.pm % 17; const bool lat = tb != 0; const int pos0 = (tb - 1) * 256;
#pragma unroll
        for (int ai = 0; ai < 2; ++ai)
#pragma unroll
            for (int m = 0; m < 4; ++m) { const int rl = ai * 128 + wr * 64 + m * 16 + fr; const size_t row = (size_t)u.pm * 256 + rl;
                if (u.pn < 2) { bf16* dst = u.pn == 0 ? CQ : CKV; float ss = 0.f;
#pragma unroll
                    for (int bj = 0; bj < 2; ++bj) { const int c = bj * 128 + wc * 32 + 8 * fq; const f32x4 a = acc[ai][bj][m][0], b = acc[ai][bj][m][1];
                        ss += (a[0] * a[0] + a[1] * a[1]) + (a[2] * a[2] + a[3] * a[3]) + (b[0] * b[0] + b[1] * b[1]) + (b[2] * b[2] + b[3] * b[3]);
                        *(v4u*)(dst + row * 256 + c) = pack8(a, b); }
                    ss += __shfl_xor(ss, 16); ss += __shfl_xor(ss, 32);
                    if (fq == 0) SSQ[row * 8 + u.pn * 4 + wc] = ss;
                } else if (wc == 0) {
                    f32x4 a = acc[ai][0][m][0], b = acc[ai][0][m][1]; const int cl = 8 * fq;
                    if (lat) rope8(a, b, tab + (size_t)(pos0 + rl) * 16 + (cl >> 1));
                    const v4u w = pack8(a, b);
#pragma unroll
                    for (int h = 0; h < 16; ++h) *(v4u*)(KF + row * 1536 + h * 96 + 64 + cl) = w; }
                asm volatile("" ::: "memory"); }
    }
};
struct EpiMlaQ {
    static constexpr bool PERM = true;
    bf16* Q3; const float* SSQ; const f32x2* tab; float qscale;
    __device__ __forceinline__ void operator()(const AccT& acc, const Unit& u, int ui, int wr, int wc, int fr, int fq) const {
        const int tb = u.pm % 17; const bool lat = tb != 0; const int pos0 = (tb - 1) * 256;
#pragma unroll
        for (int ai = 0; ai < 2; ++ai)
#pragma unroll
            for (int m = 0; m < 4; ++m) { const int rl = ai * 128 + wr * 64 + m * 16 + fr; const size_t row = (size_t)u.pm * 256 + rl;
                const f32x4 s4 = *(const f32x4*)(SSQ + row * 8); const float rs = rsqrtf(((s4[0] + s4[1]) + (s4[2] + s4[3])) * (1.f / 256.f) + EPS) * qscale;
#pragma unroll
                for (int bj = 0; bj < 2; ++bj) { const int c = u.pn * 256 + bj * 128 + wc * 32 + 8 * fq; const int e = c % 96;
                    f32x4 a = acc[ai][bj][m][0] * rs, b = acc[ai][bj][m][1] * rs;
                    if (lat && e >= 64) rope8(a, b, tab + (size_t)(pos0 + rl) * 16 + ((e - 64) >> 1));
                    *(v4u*)(Q3 + row * 1536 + c) = pack8(a, b); }
                asm volatile("" ::: "memory"); }
    }
};
struct EpiMlaKV {
    static constexpr bool PERM = true;
    bf16 *KF, *V3; const float* SSQ;
    __device__ __forceinline__ void operator()(const AccT& acc, const Unit& u, int ui, int wr, int wc, int fr, int fq) const {
#pragma unroll
        for (int ai = 0; ai < 2; ++ai)
#pragma unroll
            for (int m = 0; m < 4; ++m) { const size_t row = (size_t)u.pm * 256 + ai * 128 + wr * 64 + m * 16 + fr;
                const f32x4 s4 = *(const f32x4*)(SSQ + row * 8 + 4); const float rs = rsqrtf(((s4[0] + s4[1]) + (s4[2] + s4[3])) * (1.f / 256.f) + EPS);
#pragma unroll
                for (int bj = 0; bj < 2; ++bj) { const int c = u.pn * 256 + bj * 128 + wc * 32 + 8 * fq; const int h = c >> 7, e = c & 127;
                    const v4u w = pack8(acc[ai][bj][m][0] * rs, acc[ai][bj][m][1] * rs);
                    if (e < 64) *(v4u*)(KF + row * 1536 + h * 96 + e) = w; else *(v4u*)(V3 + row * 1024 + h * 64 + (e - 64)) = w; }
                asm volatile("" ::: "memory"); }
    }
};

struct TblEnt { int tok; float w0, w1; int pad; };
__device__ __forceinline__ int cls_expert(int cls, int which) { const int g = cls / 6, p = cls - g * 6; const int lo = p < 3 ? 0 : (p < 5 ? 1 : 2), hi = p < 3 ? p + 1 : (p < 5 ? p - 1 : 3); return g * 4 + (which ? hi : lo); }
template <int MODE> struct MoeOrder {
    static constexpr bool GATHER = (MODE == 0);
    const LAS int* tb;
    const LAS TblEnt* tbl;
    const bf16* W; int G, c;
    __device__ __forceinline__ bool next(int i, Unit& u) const {
        const int L = i * G + c, tile = L >> 2; if (tile >= tb[24]) return false;
        int cls = 0;
#pragma unroll
        for (int k = 1; k < 24; ++k) cls += (tile >= tb[k]) ? 1 : 0;
        u.pm = tile; u.pn = L & 3; u.aux = cls | (i << 8); return true;
    }
    __device__ __forceinline__ int a_row(const Unit& u, int r) const {
        if (MODE == 1) return u.pm * 256 + r;
        const int t = tbl[(u.aux >> 8) * 256 + r].tok; return t < 0 ? 0 : t;
    }
    __device__ __forceinline__ const char* b_seg(const Unit& u, int seg) const {
        const int cls = u.aux & 255;
        if (MODE == 0) return (const char*)(W + ((size_t)cls_expert(cls, u.pn >> 1) * 512 + (u.pn & 1) * 256) * 1024);
        return (const char*)(W + ((size_t)cls_expert(cls, seg) * 1024 + u.pn * 256) * 256);
    }
};
template <int MODE> __device__ __forceinline__ void moe_setup(Frame& F, int layer, MoeOrder<MODE>& S) {
    LAS int* tb = (LAS int*)(F.lds + LDS_TB); LAS int* cn = tb + 32; LAS TblEnt* tbl = (LAS TblEnt*)(F.lds + LDS_TBL);
    if (F.tid == 0) { int t = 0; for (int k = 0; k < 24; ++k) { const int n = (int)__hip_atomic_load(F.ctl + CW_MOECNT + layer * 64 + k, RLX_AGENT); cn[k] = n; tb[k] = t; t += (n + 255) >> 8; } tb[24] = t; }
    __syncthreads();
    S.tb = tb; S.tbl = tbl;
    const int* SL = (const int*)(F.ws + MOE_SL); const float* WT = (const float*)(F.ws + MOE_WT);
    for (int i = 0; i < 4; ++i) { Unit u; if (!S.next(i, u)) break;
        if (F.tid < 256) { const int cls = u.aux & 255, idx = (u.pm - tb[cls]) * 256 + F.tid; TblEnt e; e.pad = 0;
            if (idx < cn[cls]) { e.tok = SL[(size_t)cls * M + idx]; e.w0 = WT[2 * (size_t)e.tok]; e.w1 = WT[2 * (size_t)e.tok + 1]; } else { e.tok = -1; e.w0 = 0.f; e.w1 = 0.f; }
            LAS TblEnt* te = tbl + i * 256 + F.tid; te->tok = e.tok; te->w0 = e.w0; te->w1 = e.w1; te->pad = 0; } }
    __syncthreads();
}
struct EpiMoeAct {
    static constexpr bool PERM = true;
    bf16* ACT; const LAS TblEnt* tbl;
    __device__ __forceinline__ void operator()(const AccT& acc, const Unit& u, int ui, int wr, int wc, int fr, int fq) const {
        const int slot = u.pn >> 1, colb = slot * 256 + (u.pn & 1) * 128 + wc * 32 + 8 * fq;
#pragma unroll
        for (int ai = 0; ai < 2; ++ai)
#pragma unroll
            for (int m = 0; m < 4; ++m) { const int rl = ai * 128 + wr * 64 + m * 16 + fr; const LAS TblEnt* te = tbl + (u.aux >> 8) * 256 + rl; const float w = slot ? te->w1 : te->w0;
                f32x4 a, b;
#pragma unroll
                for (int j = 0; j < 4; ++j) { a[j] = silu_f(acc[ai][0][m][0][j]) * acc[ai][1][m][0][j] * w; b[j] = silu_f(acc[ai][0][m][1][j]) * acc[ai][1][m][1][j] * w; }
                *(v4u*)(ACT + ((size_t)u.pm * 256 + rl) * 512 + colb) = pack8(a, b);
                asm volatile("" ::: "memory"); }
    }
};
struct EpiMoeDown {
    static constexpr bool PERM = false;
    float* X; const float* gate; const LAS TblEnt* tbl;
    __device__ __forceinline__ void operator()(const AccT& acc, const Unit& u, int ui, int wr, int wc, int fr, int fq) const {
        const int col0 = u.pn * 256 + wc * 32 + 4 * fq;
#pragma unroll
        for (int ai = 0; ai < 2; ++ai)
#pragma unroll
            for (int m = 0; m < 4; ++m) { const int rl = ai * 128 + wr * 64 + m * 16 + fr; const int tok = tbl[(u.aux >> 8) * 256 + rl].tok;
                if (tok >= 0) { float* rowp = X + (size_t)tok * D + col0; const float* gv = gate + (size_t)modrow_of(tok) * 6144 + col0;
#pragma unroll
                    for (int bj = 0; bj < 2; ++bj)
#pragma unroll
                        for (int n = 0; n < 2; ++n) { f32x4* p = (f32x4*)(rowp + bj * 128 + n * 16); *p = *p + *(const f32x4*)(gv + bj * 128 + n * 16) * acc[ai][bj][m][n]; } }
                asm volatile("" ::: "memory"); }
    }
};
template <int DQK, bool WIN>
__device__ __forceinline__ void flash_unit(LAS unsigned char* lds, const int tid, const int lane,
        const bf16* Kg, const int ldk, const bf16* Vg, const int ldv,
        const bf16* Qg, const int ldq, bf16* Og, const int ldo,
        const int ntiles, const int krow_ctx0, const int krow_lat0, const int kpos0, const int qpos_wave, const float sink2, const bool has_sink) {
    constexpr int KSTR = DQK * 2 + 16, VSTR = 160, KBUF = 64 * KSTR, VBUF = 64 * VSTR, CPR = DQK / 8, NKC = 64 * CPR, NKR = (NKC + 511) / 512, NKS = DQK / 32;
    LAS unsigned char* Kl = lds; LAS unsigned char* Vl = lds + 2 * KBUF;
    const int fr = lane & 15, fq = lane >> 4;
    bf16x8 qf[2][NKS];
#pragma unroll
    for (int qt = 0; qt < 2; ++qt)
#pragma unroll
        for (int ks = 0; ks < NKS; ++ks) qf[qt][ks] = *(const bf16x8*)(Qg + (size_t)(16 * qt + fr) * ldq + 32 * ks + 8 * fq);
    f32x4 oacc[4][2];
#pragma unroll
    for (int c = 0; c < 4; ++c) { oacc[c][0] = (f32x4){0.f, 0.f, 0.f, 0.f}; oacc[c][1] = (f32x4){0.f, 0.f, 0.f, 0.f}; }
    float mrun[2] = {-1.0e30f, -1.0e30f}, lsum[2] = {0.f, 0.f};
    v4u kreg[NKR], vreg;
#define FA_LOAD(j) do { const int _rb = (j) < 4 ? krow_ctx0 + 64 * (j) : krow_lat0 + 64 * ((j) - 4); \
        _Pragma("unroll") for (int _i = 0; _i < NKR; ++_i) { const int _c = tid + 512 * _i; if (_c < NKC) kreg[_i] = *(const v4u*)(Kg + (size_t)(_rb + _c / CPR) * ldk + (_c % CPR) * 8); } \
        vreg = *(const v4u*)(Vg + (size_t)(_rb + (tid >> 3)) * ldv + (tid & 7) * 8); } while (0)
#define FA_STORE(buf) do { _Pragma("unroll") for (int _i = 0; _i < NKR; ++_i) { const int _c = tid + 512 * _i; if (_c < NKC) *(LAS v4u*)(Kl + (buf) * KBUF + (_c / CPR) * KSTR + (_c % CPR) * 16) = kreg[_i]; } \
        *(LAS v4u*)(Vl + (buf) * VBUF + (tid >> 3) * VSTR + (tid & 7) * 16) = vreg; } while (0)
    FA_LOAD(0); FA_STORE(0); __syncthreads();
    for (int j = 0; j < ntiles; ++j) {
        const int buf = j & 1;
        if (j + 1 < ntiles) FA_LOAD(j + 1);
        bool skip = false; const int kp = kpos0 + 64 * (j - 4);
        if (WIN && j >= 4) skip = (kp + 63 < qpos_wave - 128) || (kp > qpos_wave + 31 + 128);
        if (!skip) {
            f32x4 sacc[4][2];
#pragma unroll
            for (int kt = 0; kt < 4; ++kt) { sacc[kt][0] = (f32x4){0.f, 0.f, 0.f, 0.f}; sacc[kt][1] = (f32x4){0.f, 0.f, 0.f, 0.f}; }
#pragma unroll
            for (int ks = 0; ks < NKS; ++ks) { bf16x8 kf[4];
#pragma unroll
                for (int kt = 0; kt < 4; ++kt) kf[kt] = *(const LAS bf16x8*)(Kl + buf * KBUF + (16 * kt + fr) * KSTR + (32 * ks + 8 * fq) * 2);
#pragma unroll
                for (int kt = 0; kt < 4; ++kt) { sacc[kt][0] = __builtin_amdgcn_mfma_f32_16x16x32_bf16(kf[kt], qf[0][ks], sacc[kt][0], 0, 0, 0);
                                                 sacc[kt][1] = __builtin_amdgcn_mfma_f32_16x16x32_bf16(kf[kt], qf[1][ks], sacc[kt][1], 0, 0, 0); } }
            if (WIN && j >= 4) {
#pragma unroll
                for (int kt = 0; kt < 4; ++kt)
#pragma unroll
                    for (int qt = 0; qt < 2; ++qt)
#pragma unroll
                        for (int jj = 0; jj < 4; ++jj) { const int d = (kp + 16 * kt + 4 * fq + jj) - (qpos_wave + 16 * qt + fr); if (d < -128 || d > 128) sacc[kt][qt][jj] = -1.0e30f; } }
            bf16x8 pf[2][2];
#pragma unroll
            for (int qt = 0; qt < 2; ++qt) {
                float mx = sacc[0][qt][0];
#pragma unroll
                for (int kt = 0; kt < 4; ++kt)
#pragma unroll
                    for (int jj = 0; jj < 4; ++jj) mx = fmaxf(mx, sacc[kt][qt][jj]);
                mx = fmaxf(mx, __shfl_xor(mx, 16)); mx = fmaxf(mx, __shfl_xor(mx, 32));
                const float mnew = fmaxf(mrun[qt], mx), alpha = fast_exp2(mrun[qt] - mnew); mrun[qt] = mnew;
                float ps = 0.f;
#pragma unroll
                for (int kt = 0; kt < 4; ++kt)
#pragma unroll
                    for (int jj = 0; jj < 4; ++jj) { const float p = fast_exp2(sacc[kt][qt][jj] - mnew); sacc[kt][qt][jj] = p; ps += p; }
                lsum[qt] = lsum[qt] * alpha + ps;
#pragma unroll
                for (int c = 0; c < 4; ++c) oacc[c][qt] = oacc[c][qt] * alpha;
#pragma unroll
                for (int ks2 = 0; ks2 < 2; ++ks2) { const v4u w = pack8(sacc[2 * ks2][qt], sacc[2 * ks2 + 1][qt]); pf[qt][ks2] = __builtin_bit_cast(bf16x8, w); }
            }
#pragma unroll
            for (int ks2 = 0; ks2 < 2; ++ks2)
#pragma unroll
                for (int c = 0; c < 4; ++c) {
                    const LAS unsigned char* vb = Vl + buf * VBUF + (32 * ks2 + 4 * fq + ((lane & 15) >> 2)) * VSTR + (16 * c + 4 * (lane & 3)) * 2;
                    const s16x4 v0 = __builtin_amdgcn_ds_read_tr16_b64_v4i16((LAS s16x4*)vb);
                    const s16x4 v1 = __builtin_amdgcn_ds_read_tr16_b64_v4i16((LAS s16x4*)(vb + 16 * VSTR));
                    bf16x8 vf; vf[0] = v0[0]; vf[1] = v0[1]; vf[2] = v0[2]; vf[3] = v0[3]; vf[4] = v1[0]; vf[5] = v1[1]; vf[6] = v1[2]; vf[7] = v1[3];
                    oacc[c][0] = __builtin_amdgcn_mfma_f32_16x16x32_bf16(vf, pf[0][ks2], oacc[c][0], 0, 0, 0);
                    oacc[c][1] = __builtin_amdgcn_mfma_f32_16x16x32_bf16(vf, pf[1][ks2], oacc[c][1], 0, 0, 0); }
        }
        if (j + 1 < ntiles) FA_STORE(buf ^ 1);
        __syncthreads();
    }
#pragma unroll
    for (int qt = 0; qt < 2; ++qt) { float l = lsum[qt]; l += __shfl_xor(l, 16); l += __shfl_xor(l, 32); if (has_sink) l += fast_exp2(sink2 - mrun[qt]);
        const float inv = 1.0f / l;
#pragma unroll
        for (int c = 0; c < 4; ++c) { const f32x4 o = oacc[c][qt] * inv; v2u w; w.x = cvt_pk_bf16(o[0], o[1]); w.y = cvt_pk_bf16(o[2], o[3]);
            *(v2u*)(Og + (size_t)(16 * qt + fr) * ldo + 16 * c + 4 * fq) = w; } }
#undef FA_LOAD
#undef FA_STORE
}

__device__ __forceinline__ void phase_attn_window(Frame& F, const float* const* in, bf16* Q, const bf16* Kb, const bf16* Vb) {
    constexpr int NLAT = NB * 4 * 64, NCTX = NB * 4 * 4;
    for (int un = F.vcu; un < NLAT + NCTX; un += GRID) {
        int b, kvh, q0, ntiles, kpos0, qrow0;
        if (un < NLAT) { b = un >> 8; kvh = (un >> 6) & 3; q0 = (un & 63) * 64; kpos0 = q0 >= 128 ? q0 - 128 : 0; const int kend = q0 + 192 <= SEQ ? q0 + 192 : SEQ; ntiles = 4 + (kend - kpos0) / 64; qrow0 = b * TPB + CTX + q0; }
        else { const int v = un - NLAT; b = v >> 4; kvh = (v >> 2) & 3; q0 = (v & 3) * 64; kpos0 = 0; ntiles = 4; qrow0 = b * TPB + q0; }
        const int g = F.wave >> 1, half = F.wave & 1, head = kvh * 4 + g;
        bf16* qp = Q + (size_t)(qrow0 + 32 * half) * 1024 + head * 64;
        flash_unit<64, true>(F.lds, F.tid, F.lane, Kb + kvh * 64, 256, Vb + kvh * 64, 256, qp, 1024, qp, 1024,
                             ntiles, b * TPB, b * TPB + CTX + kpos0, kpos0, q0 + 32 * half, in[16][head] * LOG2E, true);
    }
}
__device__ __forceinline__ void phase_attn_mla(Frame& F, const bf16* Q3, const bf16* KF, const bf16* V3, bf16* O) {
    for (int un = F.vcu; un < NB * 16 * 16; un += GRID) { const int b = un >> 8, head = (un >> 4) & 15, qb = un & 15; const int qrow = b * TPB + CTX + qb * 256 + 32 * F.wave;
        flash_unit<96, false>(F.lds, F.tid, F.lane, KF + head * 96, 1536, V3 + head * 64, 1024, Q3 + (size_t)qrow * 1536 + head * 96, 1536, O + (size_t)qrow * 1024 + head * 64, 1024,
                              68, b * TPB, b * TPB + CTX, 0, 0, 0.f, false);
    }
}
__device__ __forceinline__ int scan_row(int dir, int tau) { return dir == 0 ? tau : (tau < CTX ? CTX - 1 - tau : (TPB + CTX - 1) - tau); }

__device__ __forceinline__ void phase_ssm_conv(Frame& F, const float* const* in, int gp, const bf16* XP, bf16* XS, bf16* BC) {
    constexpr int RPW = M / GRID;
    if (F.tid < 384) {
    const int cg = F.tid % 192, rsub = F.tid / 192, c0 = cg * 8;
    const int oc = c0 < 1024 ? gp * 1024 + c0 : (c0 < 1280 ? 2048 + gp * 256 + (c0 - 1024) : 2560 + gp * 256 + (c0 - 1280));
    float w[5][8], bb[8];
#pragma unroll
    for (int k = 0; k < 5; ++k)
#pragma unroll
        for (int i = 0; i < 8; ++i) w[k][i] = in[19][k * 3072 + oc + i];
#pragma unroll
    for (int i = 0; i < 8; ++i) bb[i] = in[20][oc + i];
    const int row0 = blockIdx.x * RPW;
    for (int r = row0 + rsub; r < row0 + RPW; r += 2) { const int t = r % TPB; const int lo = t < CTX ? 0 : CTX, hi = t < CTX ? CTX : TPB;
        float a[8];
#pragma unroll
        for (int i = 0; i < 8; ++i) a[i] = bb[i];
#pragma unroll
        for (int k = 0; k < 5; ++k) { const int tt = t + k - 2; if (tt >= lo && tt < hi) { const v4u x = *(const v4u*)(XP + (size_t)(r + k - 2) * 1536 + c0);
                a[0] += w[k][0] * bflo(x.x); a[1] += w[k][1] * bfhi(x.x); a[2] += w[k][2] * bflo(x.y); a[3] += w[k][3] * bfhi(x.y);
                a[4] += w[k][4] * bflo(x.z); a[5] += w[k][5] * bfhi(x.z); a[6] += w[k][6] * bflo(x.w); a[7] += w[k][7] * bfhi(x.w); } }
        v4u o; o.x = cvt_pk_bf16(silu_f(a[0]), silu_f(a[1])); o.y = cvt_pk_bf16(silu_f(a[2]), silu_f(a[3])); o.z = cvt_pk_bf16(silu_f(a[4]), silu_f(a[5])); o.w = cvt_pk_bf16(silu_f(a[6]), silu_f(a[7]));
        if (c0 < 1024) *(v4u*)(XS + (size_t)r * 1024 + c0) = o; else *(v4u*)(BC + (size_t)r * 512 + (c0 - 1024)) = o; }
    }
}

__device__ __forceinline__ void phase_ssm_scan(Frame& F, const float* const* in, int gp, const bf16* XS, const bf16* BC, const float* DT, const bf16* Z, bf16* Y) {
    constexpr int T = 32;
    LAS float* Bf = (LAS float*)F.lds;
    LAS float* Cf = (LAS float*)(F.lds + 16384);
    LAS float* U = (LAS float*)(F.lds + 32768);
    LAS float* XT = (LAS float*)(F.lds + 40960);
    LAS float* DEC = (LAS float*)(F.lds + 49152);
    LAS float* PART = (LAS float*)(F.lds + 49152 + 256);
    const int it = blockIdx.x, b = it >> 5, hl = (it >> 1) & 15, ph = it & 1, head = gp * 16 + hl, gl = hl >> 3;
    const int col = hl * 64 + ph * 32;
    const int p = F.tid & 31, ns = F.tid >> 5;
    const float dskip = in[23][head] + in[23][32 + head];
    const int st = F.tid >> 4, sch = F.tid & 15;
    const int xt = F.tid >> 2, xch = F.tid & 3;
    for (int dir = 0; dir < 2; ++dir) {
        const float Ah = -fast_exp(in[22][dir * 32 + head]) * LOG2E;
        float S[8];
#pragma unroll
        for (int i = 0; i < 8; ++i) S[i] = 0.f;
        v4u rb, rc, rx; float rdt = 0.f;
#define SS_LOAD(tile) do { const int _rB = b * TPB + scan_row(dir, (tile) * T + st); rb = *(const v4u*)(BC + (size_t)_rB * 512 + gl * 128 + sch * 8); rc = *(const v4u*)(BC + (size_t)_rB * 512 + 256 + gl * 128 + sch * 8); \
            if (F.tid < 128) { const int _rX = b * TPB + scan_row(dir, (tile) * T + xt); rx = *(const v4u*)(XS + (size_t)_rX * 1024 + col + xch * 8); rdt = DT[(size_t)_rX * 32 + dir * 16 + hl]; } } while (0)
#define SS_STORE(nb) do { LAS float* _b = Bf + st * 128 + sch * 8; LAS float* _c = Cf + st * 128 + sch * 8; \
            *(LAS f32x4*)_b = (f32x4){bflo(rb.x), bfhi(rb.x), bflo(rb.y), bfhi(rb.y)}; *(LAS f32x4*)(_b + 4) = (f32x4){bflo(rb.z), bfhi(rb.z), bflo(rb.w), bfhi(rb.w)}; \
            *(LAS f32x4*)_c = (f32x4){bflo(rc.x), bfhi(rc.x), bflo(rc.y), bfhi(rc.y)}; *(LAS f32x4*)(_c + 4) = (f32x4){bflo(rc.z), bfhi(rc.z), bflo(rc.w), bfhi(rc.w)}; \
            if (F.tid < 128) { const f32x4 x0 = (f32x4){bflo(rx.x), bfhi(rx.x), bflo(rx.y), bfhi(rx.y)}, x1 = (f32x4){bflo(rx.z), bfhi(rx.z), bflo(rx.w), bfhi(rx.w)}; \
                LAS float* _x = XT + (nb) * 1024 + xt * 32 + xch * 8; LAS float* _u = U + (nb) * 1024 + xt * 32 + xch * 8; \
                *(LAS f32x4*)_x = x0; *(LAS f32x4*)(_x + 4) = x1; *(LAS f32x4*)_u = x0 * rdt; *(LAS f32x4*)(_u + 4) = x1 * rdt; \
                if (xch == 0) DEC[(nb) * 32 + xt] = fast_exp2(rdt * Ah); } } while (0)
        __syncthreads();
        SS_LOAD(0); SS_STORE(0); __syncthreads();
        constexpr int NT = TPB / T;
        for (int tile = 0; tile < NT; ++tile) { const int cb = tile & 1;
            if (tile + 1 < NT) SS_LOAD(tile + 1);
            const LAS float* u_ = U + cb * 1024 + p; const LAS float* d_ = DEC + cb * 32;
#pragma unroll 4
            for (int t = 0; t < T; ++t) {
                const float dec = d_[t], u = u_[t * 32];
                const f32x4 b0 = *(const LAS f32x4*)(Bf + t * 128 + ns * 8), b1 = *(const LAS f32x4*)(Bf + t * 128 + ns * 8 + 4);
                const f32x4 c0 = *(const LAS f32x4*)(Cf + t * 128 + ns * 8), c1 = *(const LAS f32x4*)(Cf + t * 128 + ns * 8 + 4);
                float pt = 0.f;
#pragma unroll
                for (int i = 0; i < 4; ++i) { S[i] = S[i] * dec + b0[i] * u; pt += c0[i] * S[i]; S[4 + i] = S[4 + i] * dec + b1[i] * u; pt += c1[i] * S[4 + i]; }
                pt += __shfl_xor(pt, 32);
                if (F.lane < 32) PART[(F.wave * 32 + t) * 32 + p] = pt;
            }
            __syncthreads();
#pragma unroll
            for (int k = 0; k < 2; ++k) { const int t = (F.tid >> 5) + 16 * k; float y = 0.f;
#pragma unroll
                for (int w = 0; w < 8; ++w) y += PART[(w * 32 + t) * 32 + p];
                const size_t ro = (size_t)(b * TPB + scan_row(dir, tile * T + t));
                if (dir == 0) Y[ro * 1024 + col + p] = (bf16)f2bf(y);
                else { const float yt = y + bf2f(Y[ro * 1024 + col + p]) + dskip * XT[cb * 1024 + t * 32 + p]; const float zz = bf2f(Z[ro * 1024 + col + p]);
                    Y[ro * 1024 + col + p] = (bf16)f2bf(yt * silu_f(zz)); } }
            if (tile + 1 < NT) SS_STORE(cb ^ 1);
            __syncthreads();
        }
#undef SS_LOAD
#undef SS_STORE
    }
}
__device__ __forceinline__ void phase_ssm_gnorm(Frame& F, const float* const* in, int gp, bf16* Y) {
    const int gw = F.vcu * NWAVES + F.wave, NGW = GRID * NWAVES; const float* ng = in[24] + gp * 1024 + 16 * F.lane;
    for (int r = gw; r < M; r += NGW) { v4u* p = (v4u*)(Y + (size_t)r * 1024 + 16 * F.lane); const v4u a = p[0], c = p[1];
        float v[16] = {bflo(a.x), bfhi(a.x), bflo(a.y), bfhi(a.y), bflo(a.z), bfhi(a.z), bflo(a.w), bfhi(a.w), bflo(c.x), bfhi(c.x), bflo(c.y), bfhi(c.y), bflo(c.z), bfhi(c.z), bflo(c.w), bfhi(c.w)};
        float ss = 0.f;
#pragma unroll
        for (int i = 0; i < 16; ++i) ss += v[i] * v[i];
#pragma unroll
        for (int o = 1; o < 32; o <<= 1) ss += __shfl_xor(ss, o);
        const float rs = rsqrtf(ss * (1.f / 512.f) + EPS);
        v4u o0, o1;
        o0.x = cvt_pk_bf16(v[0] * rs * ng[0], v[1] * rs * ng[1]); o0.y = cvt_pk_bf16(v[2] * rs * ng[2], v[3] * rs * ng[3]); o0.z = cvt_pk_bf16(v[4] * rs * ng[4], v[5] * rs * ng[5]); o0.w = cvt_pk_bf16(v[6] * rs * ng[6], v[7] * rs * ng[7]);
        o1.x = cvt_pk_bf16(v[8] * rs * ng[8], v[9] * rs * ng[9]); o1.y = cvt_pk_bf16(v[10] * rs * ng[10], v[11] * rs * ng[11]); o1.z = cvt_pk_bf16(v[12] * rs * ng[12], v[13] * rs * ng[13]); o1.w = cvt_pk_bf16(v[14] * rs * ng[14], v[15] * rs * ng[15]);
        p[0] = o0; p[1] = o1; }
}

__device__ __forceinline__ void phase_mlstm_scan(Frame& F, const bf16* Qm, const bf16* Km, const bf16* Vm, const float* G, bf16* Hf, bf16* Hb) {
    constexpr int T = 32;
    LAS float* Qf = (LAS float*)F.lds;
    LAS float* KW = (LAS float*)(F.lds + 8192);
    LAS float* Vf = (LAS float*)(F.lds + 16384);
    LAS float* FD = (LAS float*)(F.lds + 24576);
    LAS float* IW = (LAS float*)(F.lds + 24576 + 256);
    LAS float* EM = (LAS float*)(F.lds + 24576 + 512);
    LAS float* PN = (LAS float*)(F.lds + 32768);
    LAS float* PD = (LAS float*)(F.lds + 32768 + 65536);
    const int it = blockIdx.x, b = it >> 5, dir = (it >> 4) & 1, head = (it >> 1) & 7, jh = it & 1;
    bf16* Hout = dir == 0 ? Hf : Hb;
    const int w = F.wave, lane = F.lane, d7 = 8 * w + (lane & 7);
    float C[8], nst = 0.f, m_in = 0.f;
#pragma unroll
    for (int i = 0; i < 8; ++i) C[i] = 0.f;
    const int st = (F.tid & 255) >> 3, sch = F.tid & 7;
    v4u r0, r1; float gi = 0.f, gf = 0.f;
#define ML_LOAD(tile) do { const size_t _r = (size_t)(b * TPB + scan_row(dir, (tile) * T + st)); \
        if (F.tid < 256) { r0 = *(const v4u*)(Qm + _r * 512 + head * 64 + sch * 8); r1 = *(const v4u*)(Vm + _r * 1024 + head * 128 + jh * 64 + sch * 8); } \
        else { r0 = *(const v4u*)(Km + _r * 512 + head * 64 + sch * 8); } \
        if (F.tid < 32) { const size_t _g = (size_t)(b * TPB + scan_row(dir, (tile) * T + F.tid)); gi = G[_g * 32 + (2 * dir) * 8 + head]; gf = G[_g * 32 + (2 * dir + 1) * 8 + head]; } } while (0)
#define UNPK(dst, r) do { *(LAS f32x4*)(dst) = (f32x4){bflo(r.x), bfhi(r.x), bflo(r.y), bfhi(r.y)}; *(LAS f32x4*)((dst) + 4) = (f32x4){bflo(r.z), bfhi(r.z), bflo(r.w), bfhi(r.w)}; } while (0)
#define ML_GATES(nb) do { if (w == 0) { float Fc = lane < 32 ? gf : 0.f; \
            _Pragma("unroll") for (int o = 1; o < 32; o <<= 1) { const float t_ = __shfl_up(Fc, o); if (lane >= o) Fc += t_; } \
            float Gm = lane < 32 ? gi - Fc : -3.0e38f; \
            _Pragma("unroll") for (int o = 1; o < 32; o <<= 1) { const float t_ = __shfl_up(Gm, o); if (lane >= o) Gm = fmaxf(Gm, t_); } \
            const float mt = Fc + fmaxf(m_in, Gm); float mp = __shfl_up(mt, 1); if (lane == 0) mp = m_in; \
            if (lane < 32) { FD[(nb) * 32 + lane] = fast_exp2((gf + mp - mt) * LOG2E); IW[(nb) * 32 + lane] = fast_exp2((gi - mt) * LOG2E); EM[(nb) * 32 + lane] = fast_exp2(-mt * LOG2E); } \
            m_in = __shfl(mt, 31); } } while (0)
    __syncthreads();
    ML_LOAD(0); ML_GATES(0);
    if (F.tid < 256) { UNPK(Qf + st * 64 + sch * 8, r0); UNPK(Vf + st * 64 + sch * 8, r1); }
    __syncthreads();
    if (F.tid >= 256) { const float iw = IW[st]; LAS float* dk = KW + st * 64 + sch * 8;
        *(LAS f32x4*)dk = (f32x4){bflo(r0.x), bfhi(r0.x), bflo(r0.y), bfhi(r0.y)} * iw; *(LAS f32x4*)(dk + 4) = (f32x4){bflo(r0.z), bfhi(r0.z), bflo(r0.w), bfhi(r0.w)} * iw; }
    __syncthreads();
    constexpr int NT = TPB / T;
    for (int tile = 0; tile < NT; ++tile) { const int cb = tile & 1;
        if (tile + 1 < NT) ML_LOAD(tile + 1);
#pragma unroll 4
        for (int t = 0; t < T; ++t) {
            const float fd = FD[cb * 32 + t], v = Vf[t * 64 + lane];
            const f32x4 q0 = *(const LAS f32x4*)(Qf + t * 64 + 8 * w), q1 = *(const LAS f32x4*)(Qf + t * 64 + 8 * w + 4);
            const f32x4 k0 = *(const LAS f32x4*)(KW + t * 64 + 8 * w), k1 = *(const LAS f32x4*)(KW + t * 64 + 8 * w + 4);
            float pn = 0.f;
#pragma unroll
            for (int i = 0; i < 4; ++i) { C[i] = C[i] * fd + k0[i] * v; pn += q0[i] * C[i]; C[4 + i] = C[4 + i] * fd + k1[i] * v; pn += q1[i] * C[4 + i]; }
            PN[(w * 32 + t) * 64 + lane] = pn;
            nst = nst * fd + KW[t * 64 + d7];
            float pd = Qf[t * 64 + d7] * nst;
            pd += __shfl_xor(pd, 1); pd += __shfl_xor(pd, 2); pd += __shfl_xor(pd, 4);
            if (lane == 0) PD[w * 32 + t] = pd;
        }
        __syncthreads();
#pragma unroll
        for (int k = 0; k < 4; ++k) { const int t = (F.tid >> 6) + 8 * k; float num = 0.f, den = 0.f;
#pragma unroll
            for (int ww = 0; ww < 8; ++ww) { num += PN[(ww * 32 + t) * 64 + lane]; den += PD[ww * 32 + t]; }
            const float h = num / fmaxf(fabsf(den), EM[cb * 32 + t]);
            Hout[(size_t)(b * TPB + scan_row(dir, tile * T + t)) * 1024 + head * 128 + jh * 64 + lane] = (bf16)f2bf(h); }
        if (tile + 1 < NT) { ML_GATES(cb ^ 1); if (F.tid < 256) { UNPK(Qf + st * 64 + sch * 8, r0); UNPK(Vf + st * 64 + sch * 8, r1); } }
        __syncthreads();
        if (tile + 1 < NT && F.tid >= 256) { const float iw = IW[(cb ^ 1) * 32 + st]; LAS float* dk = KW + st * 64 + sch * 8;
            *(LAS f32x4*)dk = (f32x4){bflo(r0.x), bfhi(r0.x), bflo(r0.y), bfhi(r0.y)} * iw; *(LAS f32x4*)(dk + 4) = (f32x4){bflo(r0.z), bfhi(r0.z), bflo(r0.w), bfhi(r0.w)} * iw; }
        __syncthreads();
    }
#undef ML_LOAD
#undef ML_GATES
#undef UNPK
}
__device__ __forceinline__ void phase_mlstm_gnorm(Frame& F, const float* const* in, const bf16* Hf, const bf16* Hb, const bf16* Om, bf16* Hn) {
    const int gw = F.vcu * NWAVES + F.wave, NGW = GRID * NWAVES; const float* ng = in[28] + 16 * F.lane;
    for (int r = gw; r < M; r += NGW) { const size_t off = (size_t)r * 1024 + 16 * F.lane;
        const v4u a0 = *(const v4u*)(Hf + off), a1 = *(const v4u*)(Hf + off + 8), b0 = *(const v4u*)(Hb + off), b1 = *(const v4u*)(Hb + off + 8), o0 = *(const v4u*)(Om + off), o1 = *(const v4u*)(Om + off + 8);
        const unsigned aw[8] = {a0.x, a0.y, a0.z, a0.w, a1.x, a1.y, a1.z, a1.w}, bw[8] = {b0.x, b0.y, b0.z, b0.w, b1.x, b1.y, b1.z, b1.w}, ow[8] = {o0.x, o0.y, o0.z, o0.w, o1.x, o1.y, o1.z, o1.w};
        float v[16]; float ss = 0.f;
#pragma unroll
        for (int i = 0; i < 8; ++i) { v[2 * i] = bflo(aw[i]) + bflo(bw[i]); v[2 * i + 1] = bfhi(aw[i]) + bfhi(bw[i]); ss += v[2 * i] * v[2 * i] + v[2 * i + 1] * v[2 * i + 1]; }
        ss += __shfl_xor(ss, 1); ss += __shfl_xor(ss, 2); ss += __shfl_xor(ss, 4);
        const float rs = rsqrtf(ss * (1.f / 128.f) + EPS);
        unsigned res[8];
#pragma unroll
        for (int i = 0; i < 8; ++i) res[i] = cvt_pk_bf16(v[2 * i] * rs * ng[2 * i] * sigmoid_f(bflo(ow[i])), v[2 * i + 1] * rs * ng[2 * i + 1] * sigmoid_f(bfhi(ow[i])));
        *(v4u*)(Hn + off) = (v4u){res[0], res[1], res[2], res[3]}; *(v4u*)(Hn + off + 8) = (v4u){res[4], res[5], res[6], res[7]}; }
}
struct Args { const float* in[37]; float* out; unsigned char* ws; };

__device__ __forceinline__ void moe_phases(Frame& F, const float* const* in, int layer, const XcdBarrier& bar) {
    phase_norm2_route(F, in, layer);
    SYNC_GRID();
    bf16* Hb = (bf16*)(F.ws + WS_H); bf16* ACT = (bf16*)(F.ws + MOE_ACT); float* X = (float*)(F.ws + WS_X);
    const float* mod = (const float*)(F.ws + WS_MOD) + (size_t)layer * 9 * 6144;
    { MoeOrder<0> S; S.W = (const bf16*)(F.ws + WS_WGU); S.G = GRID; S.c = F.vcu; moe_setup(F, layer, S);
      pg8::Gemm g{Hb, 1024, 1024, 1 << 30}; EpiMoeAct E{ACT, S.tbl};
      pg8::gemm_phase(F.lds, g, S, E); }
    SYNC_GRID();
    { MoeOrder<1> S; S.W = (const bf16*)(F.ws + WS_WDN); S.G = GRID; S.c = F.vcu; moe_setup(F, layer, S);
      pg8::Gemm g{ACT, 512, 256, 4}; EpiMoeDown E{X, mod + 5 * 1024, S.tbl};
      pg8::gemm_phase(F.lds, g, S, E); }
    SYNC_GRID();
}
__device__ __forceinline__ void outproj_phase(Frame& F, const bf16* A, const bf16* Wt, int K, int ldb, int layer) {
    pg8::Gemm g{A, K, ldb, 1 << 30}; pg8::StaticOrder S; S.init(M, 1024, GRID, (int)blockIdx.x, Wt, ldb);
    EpiResid E{(float*)(F.ws + WS_X), (const float*)(F.ws + WS_MOD) + (size_t)layer * 9 * 6144 + 2 * 1024};
    pg8::gemm_phase(F.lds, g, S, E);
}

__device__ __forceinline__ void ssm_gp_phases(Frame& F, const float* const* in, const int gp, const XcdBarrier& bar) {
    unsigned char* scr = F.ws + WS_SCR; unsigned char* scr2 = (unsigned char*)F.out; bf16* H = (bf16*)(F.ws + WS_H); bf16* WM = (bf16*)(F.ws + WS_WMIX);
    bf16* Z = (bf16*)scr; bf16* XP = (bf16*)(scr + 68 * MiB); bf16* XS = (bf16*)(scr + 170 * MiB); float* DT = (float*)(scr + 238 * MiB); bf16* BC = (bf16*)scr2;
    { pg8::Gemm g{H, 1024, 1024, 1 << 30}; pg8::StaticOrder S; S.init(M, 2816, GRID, (int)blockIdx.x, WM + (size_t)gp * 2816 * 1024, 1024);
      EpiSsmIn E{Z, XP, DT, in[21] + gp * 16};
      pg8::gemm_phase(F.lds, g, S, E); }
    SYNC_GRID();
    phase_ssm_conv(F, in, gp, XP, XS, BC);
    SYNC_GRID();
    phase_ssm_scan(F, in, gp, XS, BC, DT, Z, XP);
    SYNC_GRID();
    phase_ssm_gnorm(F, in, gp, XP);
    SYNC_GRID();
    outproj_phase(F, XP, WM + 6 * MiB + (size_t)gp * 1024, 1024, 2048, 1);
    SYNC_GRID();
}

__global__ void __launch_bounds__(NTHR, 2) fwd_kernel(Args args) {
    extern __shared__ __attribute__((aligned(16))) unsigned char lds_raw[];
    Frame F;
    F.lds = (LAS unsigned char*)lds_raw; F.ws = args.ws; F.ctl = (unsigned*)(args.ws + WS_CTL); F.out = args.out;
    refresh(F);
    { const int bx = blockIdx.x; F.vcu = (bx % 8) * (GRID / 8) + bx / 8; }
    volatile LAS unsigned* MISC = (volatile LAS unsigned*)(F.lds + LDS_MISC);
    for (int u = F.tid; u < 256; u += NTHR) MISC[u] = 0u;
    __syncthreads();
    const XcdBarrier bar = xcd_barrier_post(F.ctl + CW_BAR, MISC + 8);
    const float* const* in = args.in;
    unsigned char* ws = F.ws; unsigned char* scr = ws + WS_SCR; unsigned char* scr2 = (unsigned char*)F.out;
    bf16* H = (bf16*)(ws + WS_H); bf16* WM = (bf16*)(ws + WS_WMIX);

    phase_prologue(F, in);
    __syncthreads(); refresh(F);
    convert_matrix<MAP_ATTN_IN>(F, in[15], 1024, 1536, WM, 0, nullptr);
    convert_matrix<MAP_ID>(F, in[17], 1024, 1024, WM + 2 * MiB, 0, nullptr);
    convert_moe(F, in, 0);
    SYNC_GRID();

#ifndef SKIP_L0
    phase_norm1(F, in, 0);
    SYNC_GRID();
    { bf16* Q = (bf16*)scr; bf16* Kb = (bf16*)(scr + 68 * MiB); bf16* Vb = (bf16*)(scr + 85 * MiB);
      { pg8::Gemm g{H, 1024, 1024, 1 << 30}; pg8::StaticOrder S; S.init(M, 1536, GRID, (int)blockIdx.x, WM, 1024);
        EpiAttnIn E{Q, Kb, Vb, (const f32x2*)(ws + WS_TABA), 0.125f * LOG2E};
        pg8::gemm_phase(F.lds, g, S, E); }
      SYNC_GRID();
      phase_attn_window(F, in, Q, Kb, Vb);
      SYNC_GRID();
      outproj_phase(F, Q, WM + 2 * MiB, 1024, 1024, 0);
      SYNC_GRID(); }
    moe_phases(F, in, 0, bar);

#endif
#ifndef SKIP_L1
    phase_norm1(F, in, 1);
    convert_matrix<MAP_SSM_IN>(F, in[18], 1024, 5184, WM, 0, nullptr);
    zero_rows(F, WM, 2592, 224, 1024); zero_rows(F, WM, 2816 + 2592, 224, 1024);
    convert_matrix<MAP_ID>(F, in[25], 2048, 1024, WM + 6 * MiB, 0, nullptr);
    convert_moe(F, in, 1);
    SYNC_GRID();
    ssm_gp_phases(F, in, 0, bar);
    ssm_gp_phases(F, in, 1, bar);
    moe_phases(F, in, 1, bar);

#endif
#ifndef SKIP_L2
    phase_norm1(F, in, 2);
    convert_matrix<MAP_ID>(F, in[26], 1024, 3104, WM, 0, nullptr);
    zero_rows(F, WM, 3104, 224, 1024);
    convert_matrix<MAP_ID>(F, in[29], 1024, 1024, WM + 4 * MiB, 0, nullptr);
    convert_moe(F, in, 2);
    SYNC_GRID();
    { bf16* Qm = (bf16*)scr; bf16* Km = (bf16*)(scr + 34 * MiB); bf16* Vm = (bf16*)(scr + 68 * MiB); bf16* Om = (bf16*)(scr + 136 * MiB); float* Gt = (float*)(scr + 204 * MiB);
      bf16* Hf = (bf16*)scr2; bf16* Hbw = H;
      { pg8::Gemm g{H, 1024, 1024, 1 << 30}; pg8::StaticOrder S; S.init(M, 3328, GRID, (int)blockIdx.x, WM, 1024);
        EpiMlIn E{Qm, Km, Vm, Om, Gt, in[27]};
        pg8::gemm_phase(F.lds, g, S, E); }
      SYNC_GRID();
      phase_mlstm_scan(F, Qm, Km, Vm, Gt, Hf, Hbw);
      SYNC_GRID();
      phase_mlstm_gnorm(F, in, Hf, Hbw, Om, Om);
      SYNC_GRID();
      outproj_phase(F, Om, WM + 4 * MiB, 1024, 1024, 2);
      SYNC_GRID(); }
    moe_phases(F, in, 2, bar);

#endif
#ifndef SKIP_L3
    phase_norm1(F, in, 3);
    convert_matrix<MAP_MLA_IN>(F, in[30], 1024, 544, WM, 0, nullptr);
    zero_rows(F, WM, 544, 224, 1024);
    convert_matrix<MAP_MLA_QUP>(F, in[32], 256, 1536, WM + 1 * MiB, 0, in[31]);
    convert_matrix<MAP_ID>(F, in[34], 256, 2048, WM + 2 * MiB, 0, in[33]);
    convert_matrix<MAP_ID>(F, in[35], 1024, 1024, WM + 3 * MiB, 0, nullptr);
    convert_moe(F, in, 3);
    SYNC_GRID();
    { bf16* CQ = (bf16*)scr; bf16* CKV = (bf16*)(scr + 17 * MiB); float* SSQ = (float*)(scr + 34 * MiB); bf16* KF = (bf16*)(scr + 36 * MiB); bf16* V3 = (bf16*)(scr + 138 * MiB);
      bf16* Q3 = (bf16*)scr2; bf16* O3 = H; const f32x2* tabm = (const f32x2*)(ws + WS_TABM);
      { pg8::Gemm g{H, 1024, 1024, 1 << 30}; pg8::StaticOrder S; S.init(M, 768, GRID, (int)blockIdx.x, WM, 1024);
        EpiMlaIn E{CQ, CKV, KF, SSQ, tabm};
        pg8::gemm_phase(F.lds, g, S, E); }
      SYNC_GRID();
      { pg8::Gemm g{CQ, 256, 256, 1 << 30}; pg8::StaticOrder S; S.init(M, 1536, GRID, (int)blockIdx.x, WM + 1 * MiB, 256);
        EpiMlaQ E{Q3, SSQ, tabm, 0.10206207261596577f * LOG2E};
        pg8::gemm_phase(F.lds, g, S, E); }
      { pg8::Gemm g{CKV, 256, 256, 1 << 30}; pg8::StaticOrder S; S.init(M, 2048, GRID, (int)blockIdx.x, WM + 2 * MiB, 256);
        EpiMlaKV E{KF, V3, SSQ};
        pg8::gemm_phase(F.lds, g, S, E); }
      SYNC_GRID();
      phase_attn_mla(F, Q3, KF, V3, O3);
      SYNC_GRID();
      outproj_phase(F, O3, WM + 3 * MiB, 1024, 1024, 3);
      SYNC_GRID(); }
    moe_phases(F, in, 3, bar);

#endif
    const bool poison = __hip_atomic_load(F.ctl + CW_BAR + XB_TMO, RLX_AGENT) != 0u || __hip_atomic_load(F.ctl + CW_POISON, RLX_AGENT) != 0u;
    phase_final(F, in, poison);
}

extern "C" void kernel_launch(void* const* d_in, const int* in_sizes, int n_in, void* d_out, int out_size, void* d_ws, size_t ws_size, hipStream_t stream) {
    static int ready = 0;
    if (ready == 0) {
        ready = -1;
        if (n_in != 37 || in_sizes[0] != NB * SEQ * D || out_size != NB * SEQ * D || ws_size < WS_END) { fprintf(stderr, "kernel_launch: unexpected problem shape (n_in %d, in0 %d, out %d, ws %zu)\n", n_in, n_in > 0 ? in_sizes[0] : -1, out_size, ws_size); return; }
        int dev = 0, cus = 0;
        if (hipGetDevice(&dev) != hipSuccess || hipDeviceGetAttribute(&cus, hipDeviceAttributeMultiprocessorCount, dev) != hipSuccess) { fprintf(stderr, "kernel_launch: device query failed\n"); return; }
        if (cus < GRID) { fprintf(stderr, "kernel_launch: needs %d CUs, device has %d\n", GRID, cus); return; }
        if (hipFuncSetAttribute((const void*)fwd_kernel, hipFuncAttributeMaxDynamicSharedMemorySize, LDS_BYTES) != hipSuccess) { fprintf(stderr, "kernel_launch: hipFuncSetAttribute failed\n"); return; }
        int per_cu = 0;
        if (hipOccupancyMaxActiveBlocksPerMultiprocessor(&per_cu, (const void*)fwd_kernel, NTHR, LDS_BYTES) != hipSuccess || per_cu < 1) { fprintf(stderr, "kernel_launch: occupancy query reports %d blocks per CU\n", per_cu); }
        (void)hipGetLastError();
        ready = 1;
    }
    if (ready < 0) return;
    if (hipMemsetAsync((char*)d_ws + WS_CTL, 0, CTL_ZERO_BYTES, stream) != hipSuccess) { fprintf(stderr, "kernel_launch: memset failed\n"); return; }
    Args a{};
    for (int i = 0; i < 37; ++i) a.in[i] = (const float*)d_in[i];
    a.out = (float*)d_out; a.ws = (unsigned char*)d_ws;
    hipLaunchKernelGGL(fwd_kernel, dim3(GRID), dim3(NTHR), LDS_BYTES, stream, a);
    const hipError_t le = hipPeekAtLastError();
    if (le != hipSuccess) fprintf(stderr, "kernel_launch: launch failed: %s\n", hipGetErrorName(le));
}
```

```cpp
#include <hip/hip_runtime.h>
#include <cstdio>
#include <cstdint>

#define GAS __attribute__((address_space(1)))
#define LAS __attribute__((address_space(3)))
typedef unsigned short bf16;
typedef unsigned v4u __attribute__((ext_vector_type(4)));
typedef unsigned v2u __attribute__((ext_vector_type(2)));
typedef float f32x4 __attribute__((ext_vector_type(4)));
typedef float f32x2 __attribute__((ext_vector_type(2)));
typedef short bf16x8 __attribute__((ext_vector_type(8)));
typedef short s16x4 __attribute__((ext_vector_type(4)));
#define RLX_AGENT __ATOMIC_RELAXED, __HIP_MEMORY_SCOPE_AGENT

constexpr int D = 1024, NB = 8, SEQ = 4096, CTX = 256, TPB = SEQ + CTX  , M = NB * TPB  ;
constexpr int NWAVES = 8, NTHR = 512, GRID = 256;
constexpr float EPS = 1e-6f;
constexpr float LOG2E = 1.4426950408889634f;

__device__ __forceinline__ unsigned f2bf(float f) { unsigned u = __builtin_bit_cast(unsigned, f); return (u + 0x7fffu + ((u >> 16) & 1u)) >> 16; }
__device__ __forceinline__ float bf2f(unsigned b) { return __builtin_bit_cast(float, b << 16); }
__device__ __forceinline__ float bflo(unsigned w) { return __builtin_bit_cast(float, w << 16); }
__device__ __forceinline__ float bfhi(unsigned w) { return __builtin_bit_cast(float, w & 0xffff0000u); }
__device__ __forceinline__ unsigned cvt_pk_bf16(float lo, float hi) { unsigned r; asm volatile("v_cvt_pk_bf16_f32 %0, %1, %2" : "=v"(r) : "v"(lo), "v"(hi)); return r; }
__device__ __forceinline__ float fast_exp2(float x) { return __builtin_amdgcn_exp2f(x); }
__device__ __forceinline__ float fast_rcp(float x) { return __builtin_amdgcn_rcpf(x); }
__device__ __forceinline__ float silu_f(float x) { return x * fast_rcp(1.0f + fast_exp2(-x * LOG2E)); }
__device__ __forceinline__ float sigmoid_f(float x) { return fast_rcp(1.0f + fast_exp2(-x * LOG2E)); }
__device__ __forceinline__ float fast_log(float x) { return __builtin_amdgcn_logf(x) * 0.6931471805599453f; }
__device__ __forceinline__ float fast_exp(float x) { return __builtin_amdgcn_exp2f(x * LOG2E); }
__device__ __forceinline__ float softplus_f(float x) { if (x > 20.f) return x; const float e = fast_exp(x); return e < 0.01f ? e * (1.0f - e * (0.5f - e * (1.0f / 3.0f))) : fast_log(1.0f + e); }
__device__ __forceinline__ float wave_sum(float v) {
#pragma unroll
    for (int o = 1; o < 64; o <<= 1) v += __shfl_xor(v, o);
    return v;
}
__device__ __forceinline__ int opaque_tid() { int t = threadIdx.x; asm volatile("" : "+v"(t)); return t; }
#define LDS_WAIT() asm volatile("s_waitcnt lgkmcnt(0)" ::: "memory")
#define VM_WAIT() asm volatile("s_waitcnt vmcnt(0)" ::: "memory")

namespace pg8 {
constexpr int BM = 256, BK = 64, HALF = 128, HTB = HALF * BK * 2, STAGE_BYTES = 8 * HTB, NXCD = 8, WGM = 8;
__host__ __device__ __forceinline__ int lds_byte(int r, int c) { const int st = (r >> 4) * 2 + (c >> 5), rr = r & 15, cc = c & 31, ob = rr * 64 + cc * 2; return st * 1024 + (ob ^ (((ob >> 9) & 1) << 5)); }
__host__ __device__ __forceinline__ void stage_rc(int b, int& R, int& C) { const int st = b / 1024, sb = b % 1024, swz = sb ^ (((sb >> 9) & 1) << 5); R = (st >> 1) * 16 + swz / 64; C = (st & 1) * 32 + (swz % 64) / 2; }
__host__ __device__ __forceinline__ int perm32(int rho) { const int n = rho >> 4, i = rho & 15; return 8 * (i >> 2) + 4 * n + (i & 3); }

struct Unit { int pm, pn, aux; };
struct Gemm { const bf16* A; int K; int ldb; int ksplit; };

struct StaticOrder {
    static constexpr bool GATHER = false;
    int nM, nN, nwg, G, c; const bf16* Bt; int ldb;
    __device__ void init(int M_, int N_, int G_, int c_, const bf16* Bt_, int ldb_) { nM = M_ / BM; nN = N_ / BM; nwg = nM * nN; G = G_; c = c_; Bt = Bt_; ldb = ldb_; }
    __device__ __forceinline__ bool next(int i, Unit& u) const {
        const long L = (long)i * G + c; if (L >= nwg) return false;
        int wgid = (int)L; { const int q = nwg / NXCD, r = nwg % NXCD, xcd = wgid % NXCD, off = wgid / NXCD; wgid = (xcd < r ? xcd * (q + 1) : r * (q + 1) + (xcd - r) * q) + off; }
        const int nig = WGM * nN, gid = wgid / nig, fm = gid * WGM, gsz = (nM - fm) < WGM ? (nM - fm) : WGM;
        u.pm = fm + ((wgid % nig) % gsz); u.pn = (wgid % nig) / gsz; u.aux = 0; return true;
    }
    __device__ __forceinline__ int a_row(const Unit& u, int r) const { return u.pm * BM + r; }
    __device__ __forceinline__ const char* b_seg(const Unit& u, int seg) const { return (const char*)(Bt + (size_t)u.pn * BM * ldb); }
};

template <class Epi, class Sched>
__device__ __forceinline__ void gemm_phase(LAS unsigned char* lds, const Gemm g, const Sched& S, const Epi& E) {
    const int tid = opaque_tid(), wid = __builtin_amdgcn_readfirstlane(tid >> 6), lane = tid & 63, wr = wid >> 2, wc = wid & 3, fr = lane & 15, fq = lane >> 4;
    const int K = g.K, nt = K / BK, ldb = g.ldb, ksplit = g.ksplit;
    int Rst[2], Cst[2]; unsigned voffB[2], voffA[2];
#pragma unroll
    for (int i = 0; i < 2; ++i) { int R, C; stage_rc(tid * 16 + i * 8192, R, C); const int Rb = Epi::PERM ? ((R & ~31) + perm32(R & 31)) : R; Rst[i] = R; Cst[i] = C;
        voffB[i] = (unsigned)(Rb * ldb + C) * 2u; voffA[i] = (unsigned)(R * K + C) * 2u; }
    const size_t hstepA = (size_t)HALF * K * 2;
    const size_t kstep = (size_t)(BK * 2);
    const size_t hstepB = (size_t)HALF * ldb * 2;
    const unsigned ldsw = (unsigned)wid * 1024u;
    const int aoff = lds_byte(wr * 64 + fr, fq * 8), boff = lds_byte(wc * 32 + fr, fq * 8);
#define PG8_SA(b, h) (((b) * 2 + (h)) * HTB)
#define PG8_SB(b, h) ((4 + (b) * 2 + (h)) * HTB)
#define PG8_STAGEB(bufoff, gbase) do { _Pragma("unroll") for (int _i = 0; _i < 2; ++_i) \
        __builtin_amdgcn_global_load_lds((const unsigned*)((const char*)(gbase) + voffB[_i]), (LAS unsigned*)(lds + (bufoff) + ldsw + _i * 8192), 16, 0, 0); } while (0)
#define PG8_STAGEA(bufoff, nextsel, h, kt) do { if constexpr (Sched::GATHER) { _Pragma("unroll") for (int _i = 0; _i < 2; ++_i) \
        __builtin_amdgcn_global_load_lds((const unsigned*)(gA + (size_t)(kt) * kstep + ((nextsel) ? vN[h][_i] : vA[h][_i])), (LAS unsigned*)(lds + (bufoff) + ldsw + _i * 8192), 16, 0, 0); } \
      else { const char* _ab = ((nextsel) ? nA : cA) + (size_t)(h) * hstepA + (size_t)(kt) * kstep; _Pragma("unroll") for (int _i = 0; _i < 2; ++_i) \
        __builtin_amdgcn_global_load_lds((const unsigned*)(_ab + voffA[_i]), (LAS unsigned*)(lds + (bufoff) + ldsw + _i * 8192), 16, 0, 0); } } while (0)
#define PG8_LDA(dst, b, h) do { _Pragma("unroll") for (int m = 0; m < 4; ++m) _Pragma("unroll") for (int k = 0; k < 2; ++k) dst[m][k] = *(const LAS bf16x8*)(lds + PG8_SA(b, h) + aoff + m * 2048 + k * 1024); } while (0)
#define PG8_LDB(dst, b, h) do { _Pragma("unroll") for (int n = 0; n < 2; ++n) _Pragma("unroll") for (int k = 0; k < 2; ++k) dst[n][k] = *(const LAS bf16x8*)(lds + PG8_SB(b, h) + boff + n * 2048 + k * 1024); } while (0)
#define PG8_MMA(ai, bj, At, Bt) do { __builtin_amdgcn_s_setprio(1); _Pragma("unroll") for (int m = 0; m < 4; ++m) _Pragma("unroll") for (int n = 0; n < 2; ++n) _Pragma("unroll") for (int k = 0; k < 2; ++k) \
        acc[ai][bj][m][n] = __builtin_amdgcn_mfma_f32_16x16x32_bf16(Bt[n][k], At[m][k], acc[ai][bj][m][n], 0, 0, 0); __builtin_amdgcn_s_setprio(0); } while (0)
#define PG8_WAIT_V(n) asm volatile("s_waitcnt vmcnt(" #n ")" ::: "memory")
#define PG8_WAIT_L(n) asm volatile("s_waitcnt lgkmcnt(" #n ")" ::: "memory")
#define PG8_BAR __builtin_amdgcn_s_barrier()
#define PG8_SCHED __builtin_amdgcn_sched_barrier(0)
#define PG8_AOFFS(dst, u) do { _Pragma("unroll") for (int _h = 0; _h < 2; ++_h) _Pragma("unroll") for (int _i = 0; _i < 2; ++_i) \
        dst[_h][_i] = (unsigned)S.a_row(u, _h * HALF + Rst[_i]) * (unsigned)(K * 2) + (unsigned)(Cst[_i] * 2); } while (0)
    Unit cur, nxt; int ui = 0;
    if (!S.next(0, cur)) return;
    const char* const gA = (const char*)g.A;
    f32x4 acc[2][2][4][2];
#pragma unroll
    for (int a = 0; a < 2; ++a)
#pragma unroll
        for (int b = 0; b < 2; ++b)
#pragma unroll
            for (int m = 0; m < 4; ++m)
#pragma unroll
                for (int n = 0; n < 2; ++n) acc[a][b][m][n] = (f32x4){0.f, 0.f, 0.f, 0.f};
    bf16x8 At[4][2], B0[2][2], B1[2][2];
    unsigned vA[2][2], vN[2][2];
    const char* cA = gA; const char* nA = gA;
    if constexpr (Sched::GATHER) { PG8_AOFFS(vA, cur); } else { cA = gA + (size_t)S.a_row(cur, 0) * K * 2; }
    const char* cB0 = S.b_seg(cur, 0); const char* cB1 = S.b_seg(cur, 1);
    PG8_STAGEB(PG8_SB(0, 0), cB0); PG8_STAGEB(PG8_SB(0, 1), cB0 + hstepB); PG8_STAGEA(PG8_SA(0, 0), false, 0, 0); PG8_STAGEA(PG8_SA(0, 1), false, 1, 0);
    if (wr == 1) PG8_BAR;
    PG8_WAIT_V(2); PG8_BAR;
    PG8_STAGEB(PG8_SB(1, 0), cB0 + kstep); PG8_STAGEA(PG8_SA(1, 0), false, 0, 1); PG8_STAGEB(PG8_SB(1, 1), cB0 + hstepB + kstep);
    PG8_WAIT_V(6); PG8_BAR;
    for (;;) {
        const bool has_next = S.next(ui + 1, nxt);
        const char* nB0 = cB0;
        nA = cA;
        if (has_next) { nB0 = S.b_seg(nxt, 0); if constexpr (Sched::GATHER) { PG8_AOFFS(vN, nxt); } else { nA = gA + (size_t)S.a_row(nxt, 0) * K * 2; } }
        else { if constexpr (Sched::GATHER) {
#pragma unroll
            for (int h = 0; h < 2; ++h)
#pragma unroll
                for (int i = 0; i < 2; ++i) vN[h][i] = vA[h][i]; } }
#pragma unroll 1
        for (int t = 0; t < nt; t += 2) {
            const bool last = (t == nt - 2);
            const char* b2 = last ? nB0 : ((t + 2 < ksplit) ? cB0 + (size_t)(t + 2) * kstep : cB1 + (size_t)(t + 2 - ksplit) * kstep);
            const char* b3 = b2 + kstep;
            const int kt2 = last ? 0 : t + 2;
            PG8_LDB(B0, 0, 0); PG8_LDB(B1, 0, 1); PG8_SCHED; PG8_LDA(At, 0, 0); PG8_STAGEA(PG8_SA(1, 1), false, 1, t + 1);
            PG8_WAIT_V(8); PG8_WAIT_L(0); PG8_BAR; PG8_MMA(0, 0, At, B0); PG8_MMA(0, 1, At, B1); PG8_BAR; PG8_SCHED;
            PG8_LDA(At, 0, 1); PG8_STAGEB(PG8_SB(0, 0), b2); PG8_STAGEB(PG8_SB(0, 1), b2 + hstepB); PG8_STAGEA(PG8_SA(0, 0), last, 0, kt2);
            PG8_WAIT_V(8); PG8_WAIT_L(0); PG8_BAR; PG8_MMA(1, 0, At, B0); PG8_MMA(1, 1, At, B1); PG8_BAR; PG8_SCHED;
            PG8_LDB(B0, 1, 0); PG8_LDB(B1, 1, 1); PG8_SCHED; PG8_LDA(At, 1, 0); PG8_STAGEA(PG8_SA(0, 1), last, 1, kt2);
            PG8_WAIT_V(8); PG8_WAIT_L(0); PG8_BAR; PG8_MMA(0, 0, At, B0); PG8_MMA(0, 1, At, B1); PG8_BAR; PG8_SCHED;
            PG8_LDA(At, 1, 1); PG8_STAGEB(PG8_SB(1, 0), b3); PG8_STAGEB(PG8_SB(1, 1), b3 + hstepB); PG8_STAGEA(PG8_SA(1, 0), last, 0, kt2 + 1);
            PG8_WAIT_V(8); PG8_WAIT_L(0); PG8_BAR; PG8_MMA(1, 0, At, B0); PG8_MMA(1, 1, At, B1); PG8_BAR; PG8_SCHED;
        }
        if (wr == 0) PG8_BAR;
        { int tz = tid; asm volatile("" : "+v"(tz));
          const int lz = tz & 63; E(acc, cur, ui, wr, wc, lz & 15, lz >> 4); }
        if (!has_next) break;
#pragma unroll
        for (int a = 0; a < 2; ++a)
#pragma unroll
            for (int b = 0; b < 2; ++b)
#pragma unroll
                for (int m = 0; m < 4; ++m)
#pragma unroll
                    for (int n = 0; n < 2; ++n) acc[a][b][m][n] = (f32x4){0.f, 0.f, 0.f, 0.f};
        cur = nxt; cB0 = nB0; cB1 = S.b_seg(cur, 1); cA = nA; ++ui;
        if constexpr (Sched::GATHER) {
#pragma unroll
        for (int h = 0; h < 2; ++h)
#pragma unroll
            for (int i = 0; i < 2; ++i) vA[h][i] = vN[h][i]; }
        if (wr == 1) PG8_BAR;
    }
    PG8_WAIT_V(0);
    PG8_BAR;
#undef PG8_SA
#undef PG8_SB
#undef PG8_STAGEA
#undef PG8_STAGEB
#undef PG8_LDA
#undef PG8_LDB
#undef PG8_MMA
#undef PG8_WAIT_V
#undef PG8_WAIT_L
#undef PG8_BAR
#undef PG8_SCHED
#undef PG8_AOFFS
}
}
#define XB_TMO      128
#define XB_XCNT(j)  (256  + 64 * (j))
#define XB_XSUB(j)  (1280 + 64 * (j))
#define XB_XGEN(j)  (2304 + 64 * (j))
#define XB_TOP      3328
#define XB_TOPGEN   3392
#define XCD_BAR_WORDS 3456
#define XB_SPIN_CAP (1u << 22)
__device__ __forceinline__ unsigned xb_ld(unsigned* p)              { return __hip_atomic_load(p, __ATOMIC_RELAXED, __HIP_MEMORY_SCOPE_AGENT); }
__device__ __forceinline__ unsigned xb_add(unsigned* p, unsigned v) { return __hip_atomic_fetch_add(p, v, __ATOMIC_RELAXED, __HIP_MEMORY_SCOPE_AGENT); }
__device__ __forceinline__ unsigned xb_xcc_id() { return (unsigned)__builtin_amdgcn_s_getreg((3 << 11) | 20) & 0xFu; }
#define XB_SPIN(cond, bar) do { unsigned _sp = 0; while (cond) { __builtin_amdgcn_s_sleep(1); \
    if ((++_sp & 255u) == 0u) { if (xb_ld(&(bar)[XB_TMO])) break; if (_sp > XB_SPIN_CAP) { atomicAdd(&(bar)[XB_TMO], 1u); break; } } } } while (0)
struct XcdBarrier { unsigned* bar; unsigned x; volatile LAS unsigned* st; };
__device__ __forceinline__ XcdBarrier xcd_barrier_post(unsigned* bar, volatile LAS unsigned* st) {
    XcdBarrier b; b.bar = bar; b.x = xb_xcc_id(); b.st = st;
    if (threadIdx.x == 0) (void)xb_add(&bar[XB_XCNT(b.x)], 1u);
    return b;
}
__device__ __forceinline__ void xcd_barrier_complete(unsigned* bar, unsigned x, unsigned& nloc, unsigned& nx) {
    const unsigned G = gridDim.x * gridDim.y * gridDim.z;
    unsigned sum, cnt, mine, sp = 0u;
    for (;;) {
        sum = 0u; cnt = 0u; mine = 0u;
#pragma unroll
        for (unsigned j = 0; j < 16; ++j) { const unsigned c = xb_ld(&bar[XB_XCNT(j)]); sum += c; cnt += (c > 0u) ? 1u : 0u; mine = (j == x) ? c : mine; }
        if (sum == G) break;
        __builtin_amdgcn_s_sleep(1);
        if ((++sp & 255u) == 0u) { if (xb_ld(&bar[XB_TMO])) break; if (sp > XB_SPIN_CAP) { atomicAdd(&bar[XB_TMO], 1u); break; } }
    }
    nloc = mine > 0u ? mine : 1u; nx = cnt > 0u ? cnt : 1u;
}
__device__ __forceinline__ void xcd_barrier(const XcdBarrier& b) {
    asm volatile("s_waitcnt vmcnt(0)" ::: "memory");
    __syncthreads();
    if (threadIdx.x == 0) {
        unsigned* bar = b.bar;
        __builtin_amdgcn_s_waitcnt(0);
        unsigned nloc = b.st[0], nx = b.st[1];
        if (nloc == 0u) { xcd_barrier_complete(bar, b.x, nloc, nx); b.st[0] = nloc; b.st[1] = nx; }
        const unsigned old = xb_add(&bar[XB_XSUB(b.x)], 1u);
        const unsigned gen = old / nloc;
        if (old + 1u == (gen + 1u) * nloc) {
            __builtin_amdgcn_fence(__ATOMIC_RELEASE, "agent");
            asm volatile("s_waitcnt vmcnt(0)" ::: "memory");
            const unsigned og = xb_add(&bar[XB_TOP], 1u);
            const unsigned tg = og / nx;
            if (og + 1u == (tg + 1u) * nx) xb_add(&bar[XB_TOPGEN], 1u);
            else XB_SPIN(xb_ld(&bar[XB_TOPGEN]) == tg, bar);
            __builtin_amdgcn_fence(__ATOMIC_ACQUIRE, "agent");
            xb_add(&bar[XB_XGEN(b.x)], 1u);
            asm volatile("s_waitcnt vmcnt(0)" ::: "memory");
        } else {
            XB_SPIN(xb_ld(&bar[XB_XGEN(b.x)]) == gen, bar);
            __builtin_amdgcn_fence(__ATOMIC_ACQUIRE, "agent");
            asm volatile("s_waitcnt vmcnt(0)" ::: "memory");
        }
    }
    __syncthreads();
}

constexpr size_t MiB = 1u << 20;
constexpr size_t WS_CTL = 0, CTL_ZERO_BYTES = 1 * MiB;
constexpr size_t WS_MOD = 1 * MiB;
constexpr size_t WS_TABA = 2 * MiB;
constexpr size_t WS_TABM = 3 * MiB;
constexpr size_t WS_WGU = 4 * MiB;
constexpr size_t WS_WDN = 20 * MiB;
constexpr size_t WS_WMIX = 28 * MiB;
constexpr size_t WS_X = 52 * MiB;
constexpr size_t WS_H = 188 * MiB;
constexpr size_t WS_SCR = 256 * MiB;
constexpr size_t WS_END = 512 * MiB;
constexpr size_t MOE_ACT = WS_SCR;
constexpr size_t MOE_SL = WS_SCR + 48 * MiB;
constexpr size_t MOE_WT = WS_SCR + 52 * MiB;
constexpr int CW_BAR = 4096;
constexpr int CW_MOECNT = 16384;
constexpr int CW_POISON = 20000;

constexpr int RING_BYTES = 131072;
constexpr int LDS_MISC = RING_BYTES;
constexpr int LDS_TB = RING_BYTES + 512;
constexpr int LDS_TBL = RING_BYTES + 1024;
constexpr int LDS_BYTES = RING_BYTES + 1024 + 16384;

struct Frame {
    LAS unsigned char* lds;
    unsigned* ctl;
    unsigned char* ws;
    float* out;
    int tid, lane, wave, vcu;
};

__device__ __forceinline__ void refresh(Frame& F) { F.tid = opaque_tid(); F.lane = F.tid & 63; F.wave = __builtin_amdgcn_readfirstlane(F.tid >> 6); }
#if defined(PROBE_BAR2)
#define SYNC_GRID() do { xcd_barrier(bar); xcd_barrier(bar); refresh(F); } while (0)
#else
#define SYNC_GRID() do { xcd_barrier(bar); refresh(F); } while (0)
#endif
__device__ __forceinline__ int modrow_of(int row) { const int b = row / TPB, t = row - b * TPB; return t < CTX ? 8 : b; }

enum { MAP_ID = 0, MAP_ATTN_IN, MAP_SSM_IN, MAP_MLA_IN, MAP_MLA_QUP, MAP_MOE_G, MAP_MOE_U };
template <int KIND> __device__ __forceinline__ int map_row(int n, int aux) {
    if (KIND == MAP_ID) return aux + n;
    if (KIND == MAP_ATTN_IN) { if (n >= 1280) return n; const int hb = n & ~63, d = n & 63; return hb + (d < 32 ? 2 * d : 2 * (d - 32) + 1); }
    if (KIND == MAP_SSM_IN) {
        if (n < 2048) { const int gp = n >> 10; return gp * 2816 + (n & 1023); }
        if (n < 4096) { const int c = n - 2048, gp = c >> 10; return gp * 2816 + 1024 + (c & 1023); }
        if (n < 4608) { const int c = n - 4096, gp = c >> 8; return gp * 2816 + 2048 + (c & 255); }
        if (n < 5120) { const int c = n - 4608, gp = c >> 8; return gp * 2816 + 2304 + (c & 255); }
        { const int c = n - 5120, dir = c >> 5, h = c & 31, gp = h >> 4; return gp * 2816 + 2560 + dir * 16 + (h & 15); }
    }
    if (KIND == MAP_MLA_IN) { if (n < 512) return n; const int d = n - 512; return 512 + (d < 16 ? 2 * d : 2 * (d - 16) + 1); }
    if (KIND == MAP_MLA_QUP) { const int h = n / 96, e = n - h * 96; if (e < 64) return n; const int d = e - 64; return h * 96 + 64 + (d < 16 ? 2 * d : 2 * (d - 16) + 1); }
    if (KIND == MAP_MOE_G) return aux + (n >> 7) * 256 + (n & 127);
    if (KIND == MAP_MOE_U) return aux + (n >> 7) * 256 + 128 + (n & 127);
    return n;
}
template <int KIND>
__device__ __forceinline__ void transpose_item(const float* W, int K, int N, bf16* WT, int aux, const float* kscale, LAS float* scr, int item, int lane) {
    const int nblk = N / 32, kb = item / nblk, nb = item % nblk, k0 = 64 * kb, n0 = 32 * nb;
#pragma unroll 8
    for (int i = 0; i < 32; ++i) { const int kk = 2 * i + (lane >> 5); float v = W[(size_t)(k0 + kk) * N + n0 + (lane & 31)]; if (kscale) v *= kscale[k0 + kk]; scr[kk * 33 + (lane & 31)] = v; }
    LDS_WAIT(); asm volatile("" ::: "memory");
    const int c = lane & 7;
#pragma unroll
    for (int j = 0; j < 4; ++j) { const int n = (lane >> 3) + 8 * j; const LAS float* s = scr + (8 * c) * 33 + n;
        v4u o; o.x = cvt_pk_bf16(s[0 * 33], s[1 * 33]); o.y = cvt_pk_bf16(s[2 * 33], s[3 * 33]); o.z = cvt_pk_bf16(s[4 * 33], s[5 * 33]); o.w = cvt_pk_bf16(s[6 * 33], s[7 * 33]);
        *(v4u*)(WT + (size_t)map_row<KIND>(n0 + n, aux) * K + k0 + 8 * c) = o; }
    LDS_WAIT(); asm volatile("" ::: "memory");
}
template <int KIND>
__device__ __forceinline__ void convert_matrix(Frame& F, const float* W, int K, int N, bf16* WT, int aux, const float* kscale) {
    LAS float* scr = (LAS float*)(F.lds + F.wave * 16384);
    const int gw = F.vcu * NWAVES + F.wave, NGW = GRID * NWAVES, nitems = (K / 64) * (N / 32);
    for (int it = gw; it < nitems; it += NGW) transpose_item<KIND>(W, K, N, WT, aux, kscale, scr, it, F.lane);
}
__device__ __forceinline__ void zero_rows(Frame& F, bf16* WT, int row0, int nrows, int K) {
    const size_t n16 = (size_t)nrows * K / 8; v4u* p = (v4u*)(WT + (size_t)row0 * K);
    for (size_t i = (size_t)blockIdx.x * NTHR + F.tid; i < n16; i += (size_t)GRID * NTHR) p[i] = (v4u){0u, 0u, 0u, 0u};
}
__device__ __forceinline__ void convert_moe(Frame& F, const float* const* in, int layer) {
    bf16* GU = (bf16*)(F.ws + WS_WGU); bf16* DN = (bf16*)(F.ws + WS_WDN);
    const float* wg = in[12] + (size_t)layer * 16 * 1024 * 256; const float* wu = in[13] + (size_t)layer * 16 * 1024 * 256; const float* wd = in[14] + (size_t)layer * 16 * 256 * 1024;
    LAS float* scr = (LAS float*)(F.lds + F.wave * 16384);
    const int gw = F.vcu * NWAVES + F.wave, NGW = GRID * NWAVES;
    for (int it = gw; it < 16 * 384; it += NGW) { const int e = it / 384, r = it - e * 384, kind = r >> 7, sub = r & 127;
        if (kind == 0) transpose_item<MAP_MOE_G>(wg + (size_t)e * 1024 * 256, 1024, 256, GU, e * 512, nullptr, scr, sub, F.lane);
        else if (kind == 1) transpose_item<MAP_MOE_U>(wu + (size_t)e * 1024 * 256, 1024, 256, GU, e * 512, nullptr, scr, sub, F.lane);
        else transpose_item<MAP_ID>(wd + (size_t)e * 256 * 1024, 256, 1024, DN, e * 1024, nullptr, scr, sub, F.lane); }
}

__device__ __forceinline__ void norm_mod_row(const float* xrow, const float* g, const float* sc, const float* sh, bf16* orow, int lane, f32x4 (&hv)[4]) {
    const f32x4* xr = (const f32x4*)xrow + lane;
    f32x4 v[4]; float s = 0.f;
#pragma unroll
    for (int j = 0; j < 4; ++j) { v[j] = xr[64 * j]; s += (v[j].x * v[j].x + v[j].y * v[j].y) + (v[j].z * v[j].z + v[j].w * v[j].w); }
    const float rstd = rsqrtf(wave_sum(s) * (1.f / D) + EPS);
    unsigned long long* o8 = (unsigned long long*)orow + lane;
#pragma unroll
    for (int j = 0; j < 4; ++j) {
        const f32x4 gg = ((const f32x4*)g)[lane + 64 * j], ss = ((const f32x4*)sc)[lane + 64 * j], hh = ((const f32x4*)sh)[lane + 64 * j];
        f32x4 h = v[j] * rstd * gg * (ss + 1.0f) + hh; hv[j] = h;
        o8[64 * j] = (unsigned long long)cvt_pk_bf16(h.x, h.y) | ((unsigned long long)cvt_pk_bf16(h.z, h.w) << 32);
    }
}
__device__ __forceinline__ void phase_norm1(Frame& F, const float* const* in, int layer) {
    const float* X = (const float*)(F.ws + WS_X); bf16* H = (bf16*)(F.ws + WS_H);
    const float* g = in[4] + layer * D; const float* mod = (const float*)(F.ws + WS_MOD) + (size_t)layer * 9 * 6144;
    const int gw = F.vcu * NWAVES + F.wave, NGW = GRID * NWAVES;
    for (int r = gw; r < M; r += NGW) { const float* mr = mod + (size_t)modrow_of(r) * 6144; f32x4 hv[4];
        norm_mod_row(X + (size_t)r * D, g, mr + 1024, mr, H + (size_t)r * D, F.lane, hv); }
}

__device__ __forceinline__ void phase_prologue(Frame& F, const float* const* in) {
    { float* X = (float*)(F.ws + WS_X); const int gw = F.vcu * NWAVES + F.wave, NGW = GRID * NWAVES;
      for (int r = gw; r < M; r += NGW) { const int b = r / TPB, t = r - b * TPB;
          const float* src = t < CTX ? in[2] + ((size_t)b * CTX + t) * D : in[0] + ((size_t)b * SEQ + (t - CTX)) * D;
          const f32x4* s4 = (const f32x4*)src + F.lane; f32x4* d4 = (f32x4*)(X + (size_t)r * D) + F.lane;
#pragma unroll
          for (int j = 0; j < 4; ++j) d4[64 * j] = s4[64 * j]; } }
    { f32x2* TA = (f32x2*)(F.ws + WS_TABA); f32x2* TM = (f32x2*)(F.ws + WS_TABM);
      for (int i = blockIdx.x * NTHR + F.tid; i < SEQ * 32; i += GRID * NTHR) { const int pos = i >> 5, a = i & 31; const float p = (a < 16) ? (float)(pos >> 6) : (float)(pos & 63);
          const float inv = fast_exp2(-(float)(a & 15) * (13.287712379549449f / 16.0f)); const float rev = p * inv * 0.15915494309189535f; TA[i] = (f32x2){__builtin_amdgcn_cosf(rev), __builtin_amdgcn_sinf(rev)}; }
      for (int i = blockIdx.x * NTHR + F.tid; i < SEQ * 16; i += GRID * NTHR) { const int pos = i >> 4, a = i & 15; const float p = (a < 8) ? (float)(pos >> 6) : (float)(pos & 63);
          const float inv = fast_exp2(-(float)(a & 7) * (13.287712379549449f / 8.0f)); const float rev = p * inv * 0.15915494309189535f; TM[i] = (f32x2){__builtin_amdgcn_cosf(rev), __builtin_amdgcn_sinf(rev)}; } }
    { LAS float* sc = (LAS float*)F.lds;
      LAS float* part = (LAS float*)(F.lds + 40960);
      for (int i = F.tid; i < 9 * 1024; i += NTHR) { const int r = i >> 10, k = i & 1023; const float c = r < 8 ? in[1][r * 1024 + k] : in[3][k]; sc[i] = silu_f(c); }
      __syncthreads();
      float* MOD = (float*)(F.ws + WS_MOD);
      for (int u = F.vcu; u < 4 * 96; u += GRID) { const int l = u / 96, cb = u % 96, col = cb * 64 + (F.tid & 63), ks = F.tid >> 6;
          const float* w = in[6] + (size_t)l * 1024 * 6144 + col; float a[9];
#pragma unroll
          for (int r = 0; r < 9; ++r) a[r] = 0.f;
#pragma unroll 8
          for (int k = ks * 128; k < ks * 128 + 128; ++k) { const float wv = w[(size_t)k * 6144];
#pragma unroll
              for (int r = 0; r < 9; ++r) a[r] += sc[r * 1024 + k] * wv; }
#pragma unroll
          for (int r = 0; r < 9; ++r) part[(ks * 9 + r) * 64 + (F.tid & 63)] = a[r];
          __syncthreads();
          for (int i = F.tid; i < 9 * 64; i += NTHR) { const int r = i >> 6, c = i & 63; float s = 0.f;
#pragma unroll
              for (int q = 0; q < 8; ++q) s += part[(q * 9 + r) * 64 + c];
              MOD[((size_t)l * 9 + r) * 6144 + cb * 64 + c] = s + in[7][l * 6144 + cb * 64 + c]; }
          __syncthreads(); } }
}

__device__ __forceinline__ void phase_norm2_route(Frame& F, const float* const* in, int layer) {
    constexpr int RPW = M / GRID;
    LAS float* wl = (LAS float*)F.lds;
    LAS int* lcnt = (LAS int*)(F.lds + 81920);
    LAS int* lbase = (LAS int*)(F.lds + 81920 + 128);
    LAS int* rcls = (LAS int*)(F.lds + 81920 + 256);
    LAS int* rrank = (LAS int*)(F.lds + 81920 + 256 + 1024);
    LAS float* lgw = (LAS float*)(F.lds + 81920 + 4096);
    const float* wrg = in[8] + (size_t)layer * 1024 * 4; const float* wre = in[10] + (size_t)layer * 1024 * 16;
    for (int i = F.tid; i < 1024 * 4; i += NTHR) { const int k = i >> 2, o = i & 3; wl[o * 1024 + k] = wrg[i]; }
    for (int i = F.tid; i < 1024 * 16; i += NTHR) { const int k = i >> 4, o = i & 15; wl[(4 + o) * 1024 + k] = wre[i]; }
    if (F.tid < 24) lcnt[F.tid] = 0;
    __syncthreads();
    const float* X = (const float*)(F.ws + WS_X); bf16* H = (bf16*)(F.ws + WS_H);
    const float* g = in[5] + layer * D; const float* mod = (const float*)(F.ws + WS_MOD) + (size_t)layer * 9 * 6144;
    const float* brg = in[9] + layer * 4; const float* bre = in[11] + layer * 16;
    float* WT = (float*)(F.ws + MOE_WT); int* SL = (int*)(F.ws + MOE_SL);
    const int row0 = blockIdx.x * RPW;
    for (int i = F.wave; i < RPW; i += NWAVES) { const int r = row0 + i; const float* mr = mod + (size_t)modrow_of(r) * 6144; f32x4 hv[4];
        norm_mod_row(X + (size_t)r * D, g, mr + 4 * 1024, mr + 3 * 1024, H + (size_t)r * D, F.lane, hv);
        LAS float* lgs = lgw + F.wave * 32;
        for (int o = 0; o < 20; ++o) { float s = 0.f;
#pragma unroll
            for (int j = 0; j < 4; ++j) { const f32x4 w = *(const LAS f32x4*)(wl + o * 1024 + 4 * F.lane + 256 * j); s += (hv[j].x * w.x + hv[j].y * w.y) + (hv[j].z * w.z + hv[j].w * w.w); }
            s = wave_sum(s); if (F.lane == 0) lgs[o] = s; }
        LDS_WAIT(); asm volatile("" ::: "memory");
        float g0 = lgs[0] + brg[0], g1 = lgs[1] + brg[1], g2 = lgs[2] + brg[2], g3 = lgs[3] + brg[3];
        int gs = 0; float gm = g0; if (g1 > gm) { gm = g1; gs = 1; } if (g2 > gm) { gm = g2; gs = 2; } if (g3 > gm) { gm = g3; gs = 3; }
        const float pg = 1.0f / (fast_exp(g0 - gm) + fast_exp(g1 - gm) + fast_exp(g2 - gm) + fast_exp(g3 - gm));
        float e0 = lgs[4 + gs * 4 + 0] + bre[gs * 4 + 0], e1 = lgs[4 + gs * 4 + 1] + bre[gs * 4 + 1], e2 = lgs[4 + gs * 4 + 2] + bre[gs * 4 + 2], e3 = lgs[4 + gs * 4 + 3] + bre[gs * 4 + 3];
        LDS_WAIT(); asm volatile("" ::: "memory");
        int i1 = 0; float v1 = e0; if (e1 > v1) { v1 = e1; i1 = 1; } if (e2 > v1) { v1 = e2; i1 = 2; } if (e3 > v1) { v1 = e3; i1 = 3; }
        int i2 = -1; float v2 = -3.0e38f;
        if (i1 != 0 && e0 > v2) { v2 = e0; i2 = 0; } if (i1 != 1 && e1 > v2) { v2 = e1; i2 = 1; } if (i1 != 2 && e2 > v2) { v2 = e2; i2 = 2; } if (i1 != 3 && e3 > v2) { v2 = e3; i2 = 3; }
        const float ex = fast_exp(v2 - v1), w1 = pg / (1.0f + ex), w2 = pg * ex / (1.0f + ex);
        const int lo = i1 < i2 ? i1 : i2, hi = i1 < i2 ? i2 : i1; const float wlo = i1 < i2 ? w1 : w2, whi = i1 < i2 ? w2 : w1;
        const int pair = lo == 0 ? hi - 1 : (lo == 1 ? hi + 1 : 5);
        const int cls = gs * 6 + pair;
        if (F.lane == 0) { WT[2 * (size_t)r] = wlo; WT[2 * (size_t)r + 1] = whi; rcls[i] = cls; rrank[i] = atomicAdd((int*)&lcnt[cls], 1); }
    }
    __syncthreads();
    if (F.tid < 24) lbase[F.tid] = (int)atomicAdd(F.ctl + CW_MOECNT + layer * 64 + F.tid, (unsigned)lcnt[F.tid]);
    __syncthreads();
    for (int i = F.tid; i < RPW; i += NTHR) { const int c = rcls[i]; SL[(size_t)c * M + lbase[c] + rrank[i]] = row0 + i; }
}

__device__ __forceinline__ void phase_final(Frame& F, const float* const* in, bool poison) {
    const float* X = (const float*)(F.ws + WS_X); const float* g = in[36];
    const int gw = F.vcu * NWAVES + F.wave, NGW = GRID * NWAVES;
    for (int q = gw; q < NB * SEQ; q += NGW) { const int b = q / SEQ, p = q - b * SEQ; const int r = b * TPB + CTX + p;
        const f32x4* xr = (const f32x4*)(X + (size_t)r * D) + F.lane; f32x4 v[4]; float s = 0.f;
#pragma unroll
        for (int j = 0; j < 4; ++j) { v[j] = xr[64 * j]; s += (v[j].x * v[j].x + v[j].y * v[j].y) + (v[j].z * v[j].z + v[j].w * v[j].w); }
        float rstd = rsqrtf(wave_sum(s) * (1.f / D) + EPS); if (poison) rstd = __builtin_nanf("");
        f32x4* o = (f32x4*)(F.out + (size_t)q * D) + F.lane;
#pragma unroll
        for (int j = 0; j < 4; ++j) o[64 * j] = v[j] * rstd * ((const f32x4*)g)[F.lane + 64 * j]; }
}
typedef f32x4 AccT[2][2][4][2];
using pg8::Unit;

__device__ __forceinline__ v4u pack8(const f32x4 a, const f32x4 b) { v4u w; w.x = cvt_pk_bf16(a[0], a[1]); w.y = cvt_pk_bf16(a[2], a[3]); w.z = cvt_pk_bf16(b[0], b[1]); w.w = cvt_pk_bf16(b[2], b[3]); return w; }
__device__ __forceinline__ void rope8(f32x4& a, f32x4& b, const f32x2* cs) {
    const f32x4 c01 = *(const f32x4*)cs, c23 = *(const f32x4*)(cs + 2);
    float t;
    t = a[0] * c01[0] - a[1] * c01[1]; a[1] = a[1] * c01[0] + a[0] * c01[1]; a[0] = t;
    t = a[2] * c01[2] - a[3] * c01[3]; a[3] = a[3] * c01[2] + a[2] * c01[3]; a[2] = t;
    t = b[0] * c23[0] - b[1] * c23[1]; b[1] = b[1] * c23[0] + b[0] * c23[1]; b[0] = t;
    t = b[2] * c23[2] - b[3] * c23[3]; b[3] = b[3] * c23[2] + b[2] * c23[3]; b[2] = t;
}

struct EpiResid {
    static constexpr bool PERM = false;
    float* X; const float* gate;
    __device__ __forceinline__ void operator()(const AccT& acc, const Unit& u, int ui, int wr, int wc, int fr, int fq) const {
        const int tb = u.pm % 17, b = u.pm / 17; const float* gv = gate + (size_t)(tb == 0 ? 8 : b) * 6144;
        const int row0 = u.pm * 256 + wr * 64 + fr, col0 = u.pn * 256 + wc * 32 + 4 * fq;
        f32x4 g4[2][2];
#pragma unroll
        for (int bj = 0; bj < 2; ++bj)
#pragma unroll
            for (int n = 0; n < 2; ++n) g4[bj][n] = *(const f32x4*)(gv + col0 + bj * 128 + n * 16);
#pragma unroll
        for (int ai = 0; ai < 2; ++ai)
#pragma unroll
            for (int m = 0; m < 4; ++m) { float* rowp = X + (size_t)(row0 + ai * 128 + m * 16) * D + col0;
#pragma unroll
                for (int bj = 0; bj < 2; ++bj)
#pragma unroll
                    for (int n = 0; n < 2; ++n) { f32x4* p = (f32x4*)(rowp + bj * 128 + n * 16); *p = *p + g4[bj][n] * acc[ai][bj][m][n]; }
                asm volatile("" ::: "memory"); }
    }
};

struct EpiAttnIn {
    static constexpr bool PERM = true;
    bf16 *Q, *Kb, *Vb; const f32x2* tab; float qscale;
    __device__ __forceinline__ void operator()(const AccT& acc, const Unit& u, int ui, int wr, int wc, int fr, int fq) const {
        const int tb = u.pm % 17; const bool lat = tb != 0; const int pos0 = (tb - 1) * 256;
        bf16* base; int ld, colt; float sc = 1.f; bool rope = lat;
        if (u.pn < 4) { base = Q; ld = 1024; colt = u.pn * 256; sc = qscale; } else if (u.pn == 4) { base = Kb; ld = 256; colt = 0; } else { base = Vb; ld = 256; colt = 0; rope = false; }
#pragma unroll
        for (int ai = 0; ai < 2; ++ai)
#pragma unroll
            for (int m = 0; m < 4; ++m) { const int rl = ai * 128 + wr * 64 + m * 16 + fr; const size_t row = (size_t)u.pm * 256 + rl;
#pragma unroll
                for (int bj = 0; bj < 2; ++bj) { const int cl = bj * 128 + wc * 32 + 8 * fq;
                    f32x4 a = acc[ai][bj][m][0] * sc, b = acc[ai][bj][m][1] * sc;
                    if (rope) rope8(a, b, tab + (size_t)(pos0 + rl) * 32 + ((cl & 63) >> 1));
                    *(v4u*)(base + row * ld + colt + cl) = pack8(a, b); }
                asm volatile("" ::: "memory"); }
    }
};

struct EpiSsmIn {
    static constexpr bool PERM = true;
    bf16 *Z, *XBC; float* DT; const float* dtb;
    __device__ __forceinline__ void operator()(const AccT& acc, const Unit& u, int ui, int wr, int wc, int fr, int fq) const {
#pragma unroll
        for (int ai = 0; ai < 2; ++ai)
#pragma unroll
            for (int m = 0; m < 4; ++m) { const size_t row = (size_t)u.pm * 256 + ai * 128 + wr * 64 + m * 16 + fr;
#pragma unroll
                for (int bj = 0; bj < 2; ++bj) { const int c = u.pn * 256 + bj * 128 + wc * 32 + 8 * fq;
                    const f32x4 a = acc[ai][bj][m][0], b = acc[ai][bj][m][1];
                    if (c < 1024) *(v4u*)(Z + row * 1024 + c) = pack8(a, b);
                    else if (c < 2560) *(v4u*)(XBC + row * 1536 + (c - 1024)) = pack8(a, b);
                    else if (c < 2592) { const int cc = c - 2560; f32x4 o0, o1;
#pragma unroll
                        for (int j = 0; j < 4; ++j) { o0[j] = softplus_f(a[j] + dtb[(cc >> 4) * 32 + (cc & 15) + j]); o1[j] = softplus_f(b[j] + dtb[(cc >> 4) * 32 + (cc & 15) + 4 + j]); }
                        *(f32x4*)(DT + row * 32 + cc) = o0; *(f32x4*)(DT + row * 32 + cc + 4) = o1; } } }
    }
};

struct EpiMlIn {
    static constexpr bool PERM = true;
    bf16 *Qm, *Km, *Vm, *Om; float* G; const float* gb;
    __device__ __forceinline__ void operator()(const AccT& acc, const Unit& u, int ui, int wr, int wc, int fr, int fq) const {
#pragma unroll
        for (int ai = 0; ai < 2; ++ai)
#pragma unroll
            for (int m = 0; m < 4; ++m) { const size_t row = (size_t)u.pm * 256 + ai * 128 + wr * 64 + m * 16 + fr;
#pragma unroll
                for (int bj = 0; bj < 2; ++bj) { const int c = u.pn * 256 + bj * 128 + wc * 32 + 8 * fq;
                    const f32x4 a = acc[ai][bj][m][0], b = acc[ai][bj][m][1];
                    if (c < 512) *(v4u*)(Qm + row * 512 + c) = pack8(a, b);
                    else if (c < 1024) *(v4u*)(Km + row * 512 + (c - 512)) = pack8(a * 0.125f, b * 0.125f);
                    else if (c < 2048) *(v4u*)(Vm + row * 1024 + (c - 1024)) = pack8(a, b);
                    else if (c < 3072) *(v4u*)(Om + row * 1024 + (c - 2048)) = pack8(a, b);
                    else if (c < 3104) { const int cc = c - 3072; f32x4 o0, o1; const bool fg = ((cc >> 3) & 1) != 0;
#pragma unroll
                        for (int j = 0; j < 4; ++j) { float x0 = a[j] + gb[cc + j], x1 = b[j] + gb[cc + 4 + j];
                            o0[j] = fg ? -softplus_f(-x0) : x0; o1[j] = fg ? -softplus_f(-x1) : x1; }
                        *(f32x4*)(G + row * 32 + cc) = o0; *(f32x4*)(G + row * 32 + cc + 4) = o1; } } }
    }
};

struct EpiMlaIn {
    static constexpr bool PERM = true;
    bf16 *CQ, *CKV, *KF; float* SSQ; const f32x2* tab;
    __device__ __forceinline__ void operator()(const AccT& acc, const Unit& u, int ui, int wr, int wc, int fr, int fq) const {
        const int tb = u.pm % 17; const bool lat = tb != 0; const int pos0 = (tb - 1) * 256;
#pragma unroll
        for (int ai = 0; ai < 2; ++ai)
#pragma unroll
            for (int m = 0; m < 4; ++m) { const int rl = ai * 128 + wr * 64 + m * 16 + fr; const size_t row = (size_t)u.pm * 256 + rl;
                if (u.pn < 2) { bf16* dst = u.pn == 0 ? CQ : CKV; float ss = 0.f;
#pragma unroll
                    for (int bj = 0; bj < 2; ++bj) { const int c = bj * 128 + wc * 32 + 8 * fq; const f32x4 a = acc[ai][bj][m][0], b = acc[ai][bj][m][1];
                        ss += (a[0] * a[0] + a[1] * a[1]) + (a[2] * a[2] + a[3] * a[3]) + (b[0] * b[0] + b[1] * b[1]) + (b[2] * b[2] + b[3] * b[3]);
                        *(v4u*)(dst + row * 256 + c) = pack8(a, b); }
                    ss += __shfl_xor(ss, 16); ss += __shfl_xor(ss, 32);
                    if (fq == 0) SSQ[row * 8 + u.pn * 4 + wc] = ss;
                } else if (wc == 0) {
                    f32x4 a = acc[ai][0][m][0], b = acc[ai][0][m][1]; const int cl = 8 * fq;
                    if (lat) rope8(a, b, tab + (size_t)(pos0 + rl) * 16 + (cl >> 1));
                    const v4u w = pack8(a, b);
#pragma unroll
                    for (int h = 0; h < 16; ++h) *(v4u*)(KF + row * 1536 + h * 96 + 64 + cl) = w; }
                asm volatile("" ::: "memory"); }
    }
};
struct EpiMlaQ {
    static constexpr bool PERM = true;
    bf16* Q3; const float* SSQ; const f32x2* tab; float qscale;
    __device__ __forceinline__ void operator()(const AccT& acc, const Unit& u, int ui, int wr, int wc, int fr, int fq) const {
        const int tb = u.pm % 17; const bool lat = tb != 0; const int pos0 = (tb - 1) * 256;
#pragma unroll
        for (int ai = 0; ai < 2; ++ai)
#pragma unroll
            for (int m = 0; m < 4; ++m) { const int rl = ai * 128 + wr * 64 + m * 16 + fr; const size_t row = (size_t)u.pm * 256 + rl;
                const f32x4 s4 = *(const f32x4*)(SSQ + row * 8); const float rs = rsqrtf(((s4[0] + s4[1]) + (s4[2] + s4[3])) * (1.f / 256.f) + EPS) * qscale;
#pragma unroll
                for (int bj = 0; bj < 2; ++bj) { const int c = u.pn * 256 + bj * 128 + wc * 32 + 8 * fq; const int e = c % 96;
                    f32x4 a = acc[ai][bj][m][0] * rs, b = acc[ai][bj][m][1] * rs;
                    if (lat && e >= 64) rope8(a, b, tab + (size_t)(pos0 + rl) * 16 + ((e - 64) >> 1));
                    *(v4u*)(Q3 + row * 1536 + c) = pack8(a, b); }
                asm volatile("" ::: "memory"); }
    }
};
struct EpiMlaKV {
    static constexpr bool PERM = true;
    bf16 *KF, *V3; const float* SSQ;
    __device__ __forceinline__ void operator()(const AccT& acc, const Unit& u, int ui, int wr, int wc, int fr, int fq) const {
#pragma unroll
        for (int ai = 0; ai < 2; ++ai)
#pragma unroll
            for (int m = 0; m < 4; ++m) { const size_t row = (size_t)u.pm * 256 + ai * 128 + wr * 64 + m * 16 + fr;
                const f32x4 s4 = *(const f32x4*)(SSQ + row * 8 + 4); const float rs = rsqrtf(((s4[0] + s4[1]) + (s4[2] + s4[3])) * (1.f / 256.f) + EPS);
#pragma unroll
                for (int bj = 0; bj < 2; ++bj) { const int c = u.pn * 256 + bj * 128 + wc * 32 + 8 * fq; const int h = c >> 7, e = c & 127;
                    const v4u w = pack8(acc[ai][bj][m][0] * rs, acc[ai][bj][m][1] * rs);
                    if (e < 64) *(v4u*)(KF + row * 1536 + h * 96 + e) = w; else *(v4u*)(V3 + row * 1024 + h * 64 + (e - 64)) = w; }
                asm volatile("" ::: "memory"); }
    }
};

struct TblEnt { int tok; float w0, w1; int pad; };
__device__ __forceinline__ int cls_expert(int cls, int which) { const int g = cls / 6, p = cls - g * 6; const int lo = p < 3 ? 0 : (p < 5 ? 1 : 2), hi = p < 3 ? p + 1 : (p < 5 ? p - 1 : 3); return g * 4 + (which ? hi : lo); }
template <int MODE> struct MoeOrder {
    static constexpr bool GATHER = (MODE == 0);
    const LAS int* tb;
    const LAS TblEnt* tbl;
    const bf16* W; int G, c;
    __device__ __forceinline__ bool next(int i, Unit& u) const {
        const int L = i * G + c, tile = L >> 2; if (tile >= tb[24]) return false;
        int cls = 0;
#pragma unroll
        for (int k = 1; k < 24; ++k) cls += (tile >= tb[k]) ? 1 : 0;
        u.pm = tile; u.pn = L & 3; u.aux = cls | (i << 8); return true;
    }
    __device__ __forceinline__ int a_row(const Unit& u, int r) const {
        if (MODE == 1) return u.pm * 256 + r;
        const int t = tbl[(u.aux >> 8) * 256 + r].tok; return t < 0 ? 0 : t;
    }
    __device__ __forceinline__ const char* b_seg(const Unit& u, int seg) const {
        const int cls = u.aux & 255;
        if (MODE == 0) return (const char*)(W + ((size_t)cls_expert(cls, u.pn >> 1) * 512 + (u.pn & 1) * 256) * 1024);
        return (const char*)(W + ((size_t)cls_expert(cls, seg) * 1024 + u.pn * 256) * 256);
    }
};
template <int MODE> __device__ __forceinline__ void moe_setup(Frame& F, int layer, MoeOrder<MODE>& S) {
    LAS int* tb = (LAS int*)(F.lds + LDS_TB); LAS int* cn = tb + 32; LAS TblEnt* tbl = (LAS TblEnt*)(F.lds + LDS_TBL);
    if (F.tid == 0) { int t = 0; for (int k = 0; k < 24; ++k) { const int n = (int)__hip_atomic_load(F.ctl + CW_MOECNT + layer * 64 + k, RLX_AGENT); cn[k] = n; tb[k] = t; t += (n + 255) >> 8; } tb[24] = t; }
    __syncthreads();
    S.tb = tb; S.tbl = tbl;
    const int* SL = (const int*)(F.ws + MOE_SL); const float* WT = (const float*)(F.ws + MOE_WT);
    for (int i = 0; i < 4; ++i) { Unit u; if (!S.next(i, u)) break;
        if (F.tid < 256) { const int cls = u.aux & 255, idx = (u.pm - tb[cls]) * 256 + F.tid; TblEnt e; e.pad = 0;
            if (idx < cn[cls]) { e.tok = SL[(size_t)cls * M + idx]; e.w0 = WT[2 * (size_t)e.tok]; e.w1 = WT[2 * (size_t)e.tok + 1]; } else { e.tok = -1; e.w0 = 0.f; e.w1 = 0.f; }
            LAS TblEnt* te = tbl + i * 256 + F.tid; te->tok = e.tok; te->w0 = e.w0; te->w1 = e.w1; te->pad = 0; } }
    __syncthreads();
}
struct EpiMoeAct {
    static constexpr bool PERM = true;
    bf16* ACT; const LAS TblEnt* tbl;
    __device__ __forceinline__ void operator()(const AccT& acc, const Unit& u, int ui, int wr, int wc, int fr, int fq) const {
        const int slot = u.pn >> 1, colb = slot * 256 + (u.pn & 1) * 128 + wc * 32 + 8 * fq;
#pragma unroll
        for (int ai = 0; ai < 2; ++ai)
#pragma unroll
            for (int m = 0; m < 4; ++m) { const int rl = ai * 128 + wr * 64 + m * 16 + fr; const LAS TblEnt* te = tbl + (u.aux >> 8) * 256 + rl; const float w = slot ? te->w1 : te->w0;
                f32x4 a, b;
#pragma unroll
                for (int j = 0; j < 4; ++j) { a[j] = silu_f(acc[ai][0][m][0][j]) * acc[ai][1][m][0][j] * w; b[j] = silu_f(acc[ai][0][m][1][j]) * acc[ai][1][m][1][j] * w; }
                *(v4u*)(ACT + ((size_t)u.pm * 256 + rl) * 512 + colb) = pack8(a, b);
                asm volatile("" ::: "memory"); }
    }
};
struct EpiMoeDown {
    static constexpr bool PERM = false;
    float* X; const float* gate; const LAS TblEnt* tbl;
    __device__ __forceinline__ void operator()(const AccT& acc, const Unit& u, int ui, int wr, int wc, int fr, int fq) const {
        const int col0 = u.pn * 256 + wc * 32 + 4 * fq;
#pragma unroll
        for (int ai = 0; ai < 2; ++ai)
#pragma unroll
            for (int m = 0; m < 4; ++m) { const int rl = ai * 128 + wr * 64 + m * 16 + fr; const int tok = tbl[(u.aux >> 8) * 256 + rl].tok;
                if (tok >= 0) { float* rowp = X + (size_t)tok * D + col0; const float* gv = gate + (size_t)modrow_of(tok) * 6144 + col0;
#pragma unroll
                    for (int bj = 0; bj < 2; ++bj)
#pragma unroll
                        for (int n = 0; n < 2; ++n) { f32x4* p = (f32x4*)(rowp + bj * 128 + n * 16); *p = *p + *(const f32x4*)(gv + bj * 128 + n * 16) * acc[ai][bj][m][n]; } }
                asm volatile("" ::: "memory"); }
    }
};
template <int DQK, bool WIN>
__device__ __forceinline__ void flash_unit(LAS unsigned char* lds, const int tid, const int lane,
        const bf16* Kg, const int ldk, const bf16* Vg, const int ldv,
        const bf16* Qg, const int ldq, bf16* Og, const int ldo,
        const int ntiles, const int krow_ctx0, const int krow_lat0, const int kpos0, const int qpos_wave, const float sink2, const bool has_sink) {
    constexpr int KSTR = DQK * 2 + 16, VSTR = 160, KBUF = 64 * KSTR, VBUF = 64 * VSTR, CPR = DQK / 8, NKC = 64 * CPR, NKR = (NKC + 511) / 512, NKS = DQK / 32;
    LAS unsigned char* Kl = lds; LAS unsigned char* Vl = lds + 2 * KBUF;
    const int fr = lane & 15, fq = lane >> 4;
    bf16x8 qf[2][NKS];
#pragma unroll
    for (int qt = 0; qt < 2; ++qt)
#pragma unroll
        for (int ks = 0; ks < NKS; ++ks) qf[qt][ks] = *(const bf16x8*)(Qg + (size_t)(16 * qt + fr) * ldq + 32 * ks + 8 * fq);
    f32x4 oacc[4][2];
#pragma unroll
    for (int c = 0; c < 4; ++c) { oacc[c][0] = (f32x4){0.f, 0.f, 0.f, 0.f}; oacc[c][1] = (f32x4){0.f, 0.f, 0.f, 0.f}; }
    float mrun[2] = {-1.0e30f, -1.0e30f}, lsum[2] = {0.f, 0.f};
    v4u kreg[NKR], vreg;
#define FA_LOAD(j) do { const int _rb = (j) < 4 ? krow_ctx0 + 64 * (j) : krow_lat0 + 64 * ((j) - 4); \
        _Pragma("unroll") for (int _i = 0; _i < NKR; ++_i) { const int _c = tid + 512 * _i; if (_c < NKC) kreg[_i] = *(const v4u*)(Kg + (size_t)(_rb + _c / CPR) * ldk + (_c % CPR) * 8); } \
        vreg = *(const v4u*)(Vg + (size_t)(_rb + (tid >> 3)) * ldv + (tid & 7) * 8); } while (0)
#define FA_STORE(buf) do { _Pragma("unroll") for (int _i = 0; _i < NKR; ++_i) { const int _c = tid + 512 * _i; if (_c < NKC) *(LAS v4u*)(Kl + (buf) * KBUF + (_c / CPR) * KSTR + (_c % CPR) * 16) = kreg[_i]; } \
        *(LAS v4u*)(Vl + (buf) * VBUF + (tid >> 3) * VSTR + (tid & 7) * 16) = vreg; } while (0)
    FA_LOAD(0); FA_STORE(0); __syncthreads();
    for (int j = 0; j < ntiles; ++j) {
        const int buf = j & 1;
        if (j + 1 < ntiles) FA_LOAD(j + 1);
        bool skip = false; const int kp = kpos0 + 64 * (j - 4);
        if (WIN && j >= 4) skip = (kp + 63 < qpos_wave - 128) || (kp > qpos_wave + 31 + 128);
        if (!skip) {
            f32x4 sacc[4][2];
#pragma unroll
            for (int kt = 0; kt < 4; ++kt) { sacc[kt][0] = (f32x4){0.f, 0.f, 0.f, 0.f}; sacc[kt][1] = (f32x4){0.f, 0.f, 0.f, 0.f}; }
#pragma unroll
            for (int ks = 0; ks < NKS; ++ks) { bf16x8 kf[4];
#pragma unroll
                for (int kt = 0; kt < 4; ++kt) kf[kt] = *(const LAS bf16x8*)(Kl + buf * KBUF + (16 * kt + fr) * KSTR + (32 * ks + 8 * fq) * 2);
#pragma unroll
                for (int kt = 0; kt < 4; ++kt) { sacc[kt][0] = __builtin_amdgcn_mfma_f32_16x16x32_bf16(kf[kt], qf[0][ks], sacc[kt][0], 0, 0, 0);
                                                 sacc[kt][1] = __builtin_amdgcn_mfma_f32_16x16x32_bf16(kf[kt], qf[1][ks], sacc[kt][1], 0, 0, 0); } }
            if (WIN && j >= 4) {
#pragma unroll
                for (int kt = 0; kt < 4; ++kt)
#pragma unroll
                    for (int qt = 0; qt < 2; ++qt)
#pragma unroll
                        for (int jj = 0; jj < 4; ++jj) { const int d = (kp + 16 * kt + 4 * fq + jj) - (qpos_wave + 16 * qt + fr); if (d < -128 || d > 128) sacc[kt][qt][jj] = -1.0e30f; } }
            bf16x8 pf[2][2];
#pragma unroll
            for (int qt = 0; qt < 2; ++qt) {
                float mx = sacc[0][qt][0];
#pragma unroll
                for (int kt = 0; kt < 4; ++kt)
#pragma unroll
                    for (int jj = 0; jj < 4; ++jj) mx = fmaxf(mx, sacc[kt][qt][jj]);
                mx = fmaxf(mx, __shfl_xor(mx, 16)); mx = fmaxf(mx, __shfl_xor(mx, 32));
                const float mnew = fmaxf(mrun[qt], mx), alpha = fast_exp2(mrun[qt] - mnew); mrun[qt] = mnew;
                float ps = 0.f;
#pragma unroll
                for (int kt = 0; kt < 4; ++kt)
#pragma unroll
                    for (int jj = 0; jj < 4; ++jj) { const float p = fast_exp2(sacc[kt][qt][jj] - mnew); sacc[kt][qt][jj] = p; ps += p; }
                lsum[qt] = lsum[qt] * alpha + ps;
#pragma unroll
                for (int c = 0; c < 4; ++c) oacc[c][qt] = oacc[c][qt] * alpha;
#pragma unroll
                for (int ks2 = 0; ks2 < 2; ++ks2) { const v4u w = pack8(sacc[2 * ks2][qt], sacc[2 * ks2 + 1][qt]); pf[qt][ks2] = __builtin_bit_cast(bf16x8, w); }
            }
#pragma unroll
            for (int ks2 = 0; ks2 < 2; ++ks2)
#pragma unroll
                for (int c = 0; c < 4; ++c) {
                    const LAS unsigned char* vb = Vl + buf * VBUF + (32 * ks2 + 4 * fq + ((lane & 15) >> 2)) * VSTR + (16 * c + 4 * (lane & 3)) * 2;
                    const s16x4 v0 = __builtin_amdgcn_ds_read_tr16_b64_v4i16((LAS s16x4*)vb);
                    const s16x4 v1 = __builtin_amdgcn_ds_read_tr16_b64_v4i16((LAS s16x4*)(vb + 16 * VSTR));
                    bf16x8 vf; vf[0] = v0[0]; vf[1] = v0[1]; vf[2] = v0[2]; vf[3] = v0[3]; vf[4] = v1[0]; vf[5] = v1[1]; vf[6] = v1[2]; vf[7] = v1[3];
                    oacc[c][0] = __builtin_amdgcn_mfma_f32_16x16x32_bf16(vf, pf[0][ks2], oacc[c][0], 0, 0, 0);
                    oacc[c][1] = __builtin_amdgcn_mfma_f32_16x16x32_bf16(vf, pf[1][ks2], oacc[c][1], 0, 0, 0); }
        }
        if (j + 1 < ntiles) FA_STORE(buf ^ 1);
        __syncthreads();
    }
#pragma unroll
    for (int qt = 0; qt < 2; ++qt) { float l = lsum[qt]; l += __shfl_xor(l, 16); l += __shfl_xor(l, 32); if (has_sink) l += fast_exp2(sink2 - mrun[qt]);
        const float inv = 1.0f / l;
#pragma unroll
        for (int c = 0; c < 4; ++c) { const f32x4 o = oacc[c][qt] * inv; v2u w; w.x = cvt_pk_bf16(o[0], o[1]); w.y = cvt_pk_bf16(o[2], o[3]);
            *(v2u*)(Og + (size_t)(16 * qt + fr) * ldo + 16 * c + 4 * fq) = w; } }
#undef FA_LOAD
#undef FA_STORE
}

__device__ __forceinline__ void phase_attn_window(Frame& F, const float* const* in, bf16* Q, const bf16* Kb, const bf16* Vb) {
    constexpr int NLAT = NB * 4 * 64, NCTX = NB * 4 * 4;
    for (int un = F.vcu; un < NLAT + NCTX; un += GRID) {
        int b, kvh, q0, ntiles, kpos0, qrow0;
        if (un < NLAT) { b = un >> 8; kvh = (un >> 6) & 3; q0 = (un & 63) * 64; kpos0 = q0 >= 128 ? q0 - 128 : 0; const int kend = q0 + 192 <= SEQ ? q0 + 192 : SEQ; ntiles = 4 + (kend - kpos0) / 64; qrow0 = b * TPB + CTX + q0; }
        else { const int v = un - NLAT; b = v >> 4; kvh = (v >> 2) & 3; q0 = (v & 3) * 64; kpos0 = 0; ntiles = 4; qrow0 = b * TPB + q0; }
        const int g = F.wave >> 1, half = F.wave & 1, head = kvh * 4 + g;
        bf16* qp = Q + (size_t)(qrow0 + 32 * half) * 1024 + head * 64;
        flash_unit<64, true>(F.lds, F.tid, F.lane, Kb + kvh * 64, 256, Vb + kvh * 64, 256, qp, 1024, qp, 1024,
                             ntiles, b * TPB, b * TPB + CTX + kpos0, kpos0, q0 + 32 * half, in[16][head] * LOG2E, true);
    }
}
__device__ __forceinline__ void phase_attn_mla(Frame& F, const bf16* Q3, const bf16* KF, const bf16* V3, bf16* O) {
    for (int un = F.vcu; un < NB * 16 * 16; un += GRID) { const int b = un >> 8, head = (un >> 4) & 15, qb = un & 15; const int qrow = b * TPB + CTX + qb * 256 + 32 * F.wave;
        flash_unit<96, false>(F.lds, F.tid, F.lane, KF + head * 96, 1536, V3 + head * 64, 1024, Q3 + (size_t)qrow * 1536 + head * 96, 1536, O + (size_t)qrow * 1024 + head * 64, 1024,
                              68, b * TPB, b * TPB + CTX, 0, 0, 0.f, false);
    }
}
__device__ __forceinline__ int scan_row(int dir, int tau) { return dir == 0 ? tau : (tau < CTX ? CTX - 1 - tau : (TPB + CTX - 1) - tau); }

__device__ __forceinline__ void phase_ssm_conv(Frame& F, const float* const* in, int gp, const bf16* XP, bf16* XS, bf16* BC) {
    constexpr int RPW = M / GRID;
    if (F.tid < 384) {
    const int cg = F.tid % 192, rsub = F.tid / 192, c0 = cg * 8;
    const int oc = c0 < 1024 ? gp * 1024 + c0 : (c0 < 1280 ? 2048 + gp * 256 + (c0 - 1024) : 2560 + gp * 256 + (c0 - 1280));
    float w[5][8], bb[8];
#pragma unroll
    for (int k = 0; k < 5; ++k)
#pragma unroll
        for (int i = 0; i < 8; ++i) w[k][i] = in[19][k * 3072 + oc + i];
#pragma unroll
    for (int i = 0; i < 8; ++i) bb[i] = in[20][oc + i];
    const int row0 = blockIdx.x * RPW;
    for (int r = row0 + rsub; r < row0 + RPW; r += 2) { const int t = r % TPB; const int lo = t < CTX ? 0 : CTX, hi = t < CTX ? CTX : TPB;
        float a[8];
#pragma unroll
        for (int i = 0; i < 8; ++i) a[i] = bb[i];
#pragma unroll
        for (int k = 0; k < 5; ++k) { const int tt = t + k - 2; if (tt >= lo && tt < hi) { const v4u x = *(const v4u*)(XP + (size_t)(r + k - 2) * 1536 + c0);
                a[0] += w[k][0] * bflo(x.x); a[1] += w[k][1] * bfhi(x.x); a[2] += w[k][2] * bflo(x.y); a[3] += w[k][3] * bfhi(x.y);
                a[4] += w[k][4] * bflo(x.z); a[5] += w[k][5] * bfhi(x.z); a[6] += w[k][6] * bflo(x.w); a[7] += w[k][7] * bfhi(x.w); } }
        v4u o; o.x = cvt_pk_bf16(silu_f(a[0]), silu_f(a[1])); o.y = cvt_pk_bf16(silu_f(a[2]), silu_f(a[3])); o.z = cvt_pk_bf16(silu_f(a[4]), silu_f(a[5])); o.w = cvt_pk_bf16(silu_f(a[6]), silu_f(a[7]));
        if (c0 < 1024) *(v4u*)(XS + (size_t)r * 1024 + c0) = o; else *(v4u*)(BC + (size_t)r * 512 + (c0 - 1024)) = o; }
    }
}

__device__ __forceinline__ void phase_ssm_scan(Frame& F, const float* const* in, int gp, const bf16* XS, const bf16* BC, const float* DT, const bf16* Z, bf16* Y) {
    constexpr int T = 32;
    LAS float* Bf = (LAS float*)F.lds;
    LAS float* Cf = (LAS float*)(F.lds + 16384);
    LAS float* U = (LAS float*)(F.lds + 32768);
    LAS float* XT = (LAS float*)(F.lds + 40960);
    LAS float* DEC = (LAS float*)(F.lds + 49152);
    LAS float* PART = (LAS float*)(F.lds + 49152 + 256);
    const int it = blockIdx.x, b = it >> 5, hl = (it >> 1) & 15, ph = it & 1, head = gp * 16 + hl, gl = hl >> 3;
    const int col = hl * 64 + ph * 32;
    const int p = F.tid & 31, ns = F.tid >> 5;
    const float dskip = in[23][head] + in[23][32 + head];
    const int st = F.tid >> 4, sch = F.tid & 15;
    const int xt = F.tid >> 2, xch = F.tid & 3;
    for (int dir = 0; dir < 2; ++dir) {
        const float Ah = -fast_exp(in[22][dir * 32 + head]) * LOG2E;
        float S[8];
#pragma unroll
        for (int i = 0; i < 8; ++i) S[i] = 0.f;
        v4u rb, rc, rx; float rdt = 0.f;
#define SS_LOAD(tile) do { const int _rB = b * TPB + scan_row(dir, (tile) * T + st); rb = *(const v4u*)(BC + (size_t)_rB * 512 + gl * 128 + sch * 8); rc = *(const v4u*)(BC + (size_t)_rB * 512 + 256 + gl * 128 + sch * 8); \
            if (F.tid < 128) { const int _rX = b * TPB + scan_row(dir, (tile) * T + xt); rx = *(const v4u*)(XS + (size_t)_rX * 1024 + col + xch * 8); rdt = DT[(size_t)_rX * 32 + dir * 16 + hl]; } } while (0)
#define SS_STORE(nb) do { LAS float* _b = Bf + st * 128 + sch * 8; LAS float* _c = Cf + st * 128 + sch * 8; \
            *(LAS f32x4*)_b = (f32x4){bflo(rb.x), bfhi(rb.x), bflo(rb.y), bfhi(rb.y)}; *(LAS f32x4*)(_b + 4) = (f32x4){bflo(rb.z), bfhi(rb.z), bflo(rb.w), bfhi(rb.w)}; \
            *(LAS f32x4*)_c = (f32x4){bflo(rc.x), bfhi(rc.x), bflo(rc.y), bfhi(rc.y)}; *(LAS f32x4*)(_c + 4) = (f32x4){bflo(rc.z), bfhi(rc.z), bflo(rc.w), bfhi(rc.w)}; \
            if (F.tid < 128) { const f32x4 x0 = (f32x4){bflo(rx.x), bfhi(rx.x), bflo(rx.y), bfhi(rx.y)}, x1 = (f32x4){bflo(rx.z), bfhi(rx.z), bflo(rx.w), bfhi(rx.w)}; \
                LAS float* _x = XT + (nb) * 1024 + xt * 32 + xch * 8; LAS float* _u = U + (nb) * 1024 + xt * 32 + xch * 8; \
                *(LAS f32x4*)_x = x0; *(LAS f32x4*)(_x + 4) = x1; *(LAS f32x4*)_u = x0 * rdt; *(LAS f32x4*)(_u + 4) = x1 * rdt; \
                if (xch == 0) DEC[(nb) * 32 + xt] = fast_exp2(rdt * Ah); } } while (0)
        __syncthreads();
        SS_LOAD(0); SS_STORE(0); __syncthreads();
        constexpr int NT = TPB / T;
        for (int tile = 0; tile < NT; ++tile) { const int cb = tile & 1;
            if (tile + 1 < NT) SS_LOAD(tile + 1);
            const LAS float* u_ = U + cb * 1024 + p; const LAS float* d_ = DEC + cb * 32;
#pragma unroll 4
            for (int t = 0; t < T; ++t) {
                const float dec = d_[t], u = u_[t * 32];
                const f32x4 b0 = *(const LAS f32x4*)(Bf + t * 128 + ns * 8), b1 = *(const LAS f32x4*)(Bf + t * 128 + ns * 8 + 4);
                const f32x4 c0 = *(const LAS f32x4*)(Cf + t * 128 + ns * 8), c1 = *(const LAS f32x4*)(Cf + t * 128 + ns * 8 + 4);
                float pt = 0.f;
#pragma unroll
                for (int i = 0; i < 4; ++i) { S[i] = S[i] * dec + b0[i] * u; pt += c0[i] * S[i]; S[4 + i] = S[4 + i] * dec + b1[i] * u; pt += c1[i] * S[4 + i]; }
                pt += __shfl_xor(pt, 32);
                if (F.lane < 32) PART[(F.wave * 32 + t) * 32 + p] = pt;
            }
            __syncthreads();
#pragma unroll
            for (int k = 0; k < 2; ++k) { const int t = (F.tid >> 5) + 16 * k; float y = 0.f;
#pragma unroll
                for (int w = 0; w < 8; ++w) y += PART[(w * 32 + t) * 32 + p];
                const size_t ro = (size_t)(b * TPB + scan_row(dir, tile * T + t));
                if (dir == 0) Y[ro * 1024 + col + p] = (bf16)f2bf(y);
                else { const float yt = y + bf2f(Y[ro * 1024 + col + p]) + dskip * XT[cb * 1024 + t * 32 + p]; const float zz = bf2f(Z[ro * 1024 + col + p]);
                    Y[ro * 1024 + col + p] = (bf16)f2bf(yt * silu_f(zz)); } }
            if (tile + 1 < NT) SS_STORE(cb ^ 1);
            __syncthreads();
        }
#undef SS_LOAD
#undef SS_STORE
    }
}
__device__ __forceinline__ void phase_ssm_gnorm(Frame& F, const float* const* in, int gp, bf16* Y) {
    const int gw = F.vcu * NWAVES + F.wave, NGW = GRID * NWAVES; const float* ng = in[24] + gp * 1024 + 16 * F.lane;
    for (int r = gw; r < M; r += NGW) { v4u* p = (v4u*)(Y + (size_t)r * 1024 + 16 * F.lane); const v4u a = p[0], c = p[1];
        float v[16] = {bflo(a.x), bfhi(a.x), bflo(a.y), bfhi(a.y), bflo(a.z), bfhi(a.z), bflo(a.w), bfhi(a.w), bflo(c.x), bfhi(c.x), bflo(c.y), bfhi(c.y), bflo(c.z), bfhi(c.z), bflo(c.w), bfhi(c.w)};
        float ss = 0.f;
#pragma unroll
        for (int i = 0; i < 16; ++i) ss += v[i] * v[i];
#pragma unroll
        for (int o = 1; o < 32; o <<= 1) ss += __shfl_xor(ss, o);
        const float rs = rsqrtf(ss * (1.f / 512.f) + EPS);
        v4u o0, o1;
        o0.x = cvt_pk_bf16(v[0] * rs * ng[0], v[1] * rs * ng[1]); o0.y = cvt_pk_bf16(v[2] * rs * ng[2], v[3] * rs * ng[3]); o0.z = cvt_pk_bf16(v[4] * rs * ng[4], v[5] * rs * ng[5]); o0.w = cvt_pk_bf16(v[6] * rs * ng[6], v[7] * rs * ng[7]);
        o1.x = cvt_pk_bf16(v[8] * rs * ng[8], v[9] * rs * ng[9]); o1.y = cvt_pk_bf16(v[10] * rs * ng[10], v[11] * rs * ng[11]); o1.z = cvt_pk_bf16(v[12] * rs * ng[12], v[13] * rs * ng[13]); o1.w = cvt_pk_bf16(v[14] * rs * ng[14], v[15] * rs * ng[15]);
        p[0] = o0; p[1] = o1; }
}

__device__ __forceinline__ void phase_mlstm_scan(Frame& F, const bf16* Qm, const bf16* Km, const bf16* Vm, const float* G, bf16* Hf, bf16* Hb) {
    constexpr int T = 32;
    LAS float* Qf = (LAS float*)F.lds;
    LAS float* KW = (LAS float*)(F.lds + 8192);
    LAS float* Vf = (LAS float*)(F.lds + 16384);
    LAS float* FD = (LAS float*)(F.lds + 24576);
    LAS float* IW = (LAS float*)(F.lds + 24576 + 256);
    LAS float* EM = (LAS float*)(F.lds + 24576 + 512);
    LAS float* PN = (LAS float*)(F.lds + 32768);
    LAS float* PD = (LAS float*)(F.lds + 32768 + 65536);
    const int it = blockIdx.x, b = it >> 5, dir = (it >> 4) & 1, head = (it >> 1) & 7, jh = it & 1;
    bf16* Hout = dir == 0 ? Hf : Hb;
    const int w = F.wave, lane = F.lane, d7 = 8 * w + (lane & 7);
    float C[8], nst = 0.f, m_in = 0.f;
#pragma unroll
    for (int i = 0; i < 8; ++i) C[i] = 0.f;
    const int st = (F.tid & 255) >> 3, sch = F.tid & 7;
    v4u r0, r1; float gi = 0.f, gf = 0.f;
#define ML_LOAD(tile) do { const size_t _r = (size_t)(b * TPB + scan_row(dir, (tile) * T + st)); \
        if (F.tid < 256) { r0 = *(const v4u*)(Qm + _r * 512 + head * 64 + sch * 8); r1 = *(const v4u*)(Vm + _r * 1024 + head * 128 + jh * 64 + sch * 8); } \
        else { r0 = *(const v4u*)(Km + _r * 512 + head * 64 + sch * 8); } \
        if (F.tid < 32) { const size_t _g = (size_t)(b * TPB + scan_row(dir, (tile) * T + F.tid)); gi = G[_g * 32 + (2 * dir) * 8 + head]; gf = G[_g * 32 + (2 * dir + 1) * 8 + head]; } } while (0)
#define UNPK(dst, r) do { *(LAS f32x4*)(dst) = (f32x4){bflo(r.x), bfhi(r.x), bflo(r.y), bfhi(r.y)}; *(LAS f32x4*)((dst) + 4) = (f32x4){bflo(r.z), bfhi(r.z), bflo(r.w), bfhi(r.w)}; } while (0)
#define ML_GATES(nb) do { if (w == 0) { float Fc = lane < 32 ? gf : 0.f; \
            _Pragma("unroll") for (int o = 1; o < 32; o <<= 1) { const float t_ = __shfl_up(Fc, o); if (lane >= o) Fc += t_; } \
            float Gm = lane < 32 ? gi - Fc : -3.0e38f; \
            _Pragma("unroll") for (int o = 1; o < 32; o <<= 1) { const float t_ = __shfl_up(Gm, o); if (lane >= o) Gm = fmaxf(Gm, t_); } \
            const float mt = Fc + fmaxf(m_in, Gm); float mp = __shfl_up(mt, 1); if (lane == 0) mp = m_in; \
            if (lane < 32) { FD[(nb) * 32 + lane] = fast_exp2((gf + mp - mt) * LOG2E); IW[(nb) * 32 + lane] = fast_exp2((gi - mt) * LOG2E); EM[(nb) * 32 + lane] = fast_exp2(-mt * LOG2E); } \
            m_in = __shfl(mt, 31); } } while (0)
    __syncthreads();
    ML_LOAD(0); ML_GATES(0);
    if (F.tid < 256) { UNPK(Qf + st * 64 + sch * 8, r0); UNPK(Vf + st * 64 + sch * 8, r1); }
    __syncthreads();
    if (F.tid >= 256) { const float iw = IW[st]; LAS float* dk = KW + st * 64 + sch * 8;
        *(LAS f32x4*)dk = (f32x4){bflo(r0.x), bfhi(r0.x), bflo(r0.y), bfhi(r0.y)} * iw; *(LAS f32x4*)(dk + 4) = (f32x4){bflo(r0.z), bfhi(r0.z), bflo(r0.w), bfhi(r0.w)} * iw; }
    __syncthreads();
    constexpr int NT = TPB / T;
    for (int tile = 0; tile < NT; ++tile) { const int cb = tile & 1;
        if (tile + 1 < NT) ML_LOAD(tile + 1);
#pragma unroll 4
        for (int t = 0; t < T; ++t) {
            const float fd = FD[cb * 32 + t], v = Vf[t * 64 + lane];
            const f32x4 q0 = *(const LAS f32x4*)(Qf + t * 64 + 8 * w), q1 = *(const LAS f32x4*)(Qf + t * 64 + 8 * w + 4);
            const f32x4 k0 = *(const LAS f32x4*)(KW + t * 64 + 8 * w), k1 = *(const LAS f32x4*)(KW + t * 64 + 8 * w + 4);
            float pn = 0.f;
#pragma unroll
            for (int i = 0; i < 4; ++i) { C[i] = C[i] * fd + k0[i] * v; pn += q0[i] * C[i]; C[4 + i] = C[4 + i] * fd + k1[i] * v; pn += q1[i] * C[4 + i]; }
            PN[(w * 32 + t) * 64 + lane] = pn;
            nst = nst * fd + KW[t * 64 + d7];
            float pd = Qf[t * 64 + d7] * nst;
            pd += __shfl_xor(pd, 1); pd += __shfl_xor(pd, 2); pd += __shfl_xor(pd, 4);
            if (lane == 0) PD[w * 32 + t] = pd;
        }
        __syncthreads();
#pragma unroll
        for (int k = 0; k < 4; ++k) { const int t = (F.tid >> 6) + 8 * k; float num = 0.f, den = 0.f;
#pragma unroll
            for (int ww = 0; ww < 8; ++ww) { num += PN[(ww * 32 + t) * 64 + lane]; den += PD[ww * 32 + t]; }
            const float h = num / fmaxf(fabsf(den), EM[cb * 32 + t]);
            Hout[(size_t)(b * TPB + scan_row(dir, tile * T + t)) * 1024 + head * 128 + jh * 64 + lane] = (bf16)f2bf(h); }
        if (tile + 1 < NT) { ML_GATES(cb ^ 1); if (F.tid < 256) { UNPK(Qf + st * 64 + sch * 8, r0); UNPK(Vf + st * 64 + sch * 8, r1); } }
        __syncthreads();
        if (tile + 1 < NT && F.tid >= 256) { const float iw = IW[(cb ^ 1) * 32 + st]; LAS float* dk = KW + st * 64 + sch * 8;
            *(LAS f32x4*)dk = (f32x4){bflo(r0.x), bfhi(r0.x), bflo(r0.y), bfhi(r0.y)} * iw; *(LAS f32x4*)(dk + 4) = (f32x4){bflo(r0.z), bfhi(r0.z), bflo(r0.w), bfhi(r0.w)} * iw; }
        __syncthreads();
    }
#undef ML_LOAD
#undef ML_GATES
#undef UNPK
}
__device__ __forceinline__ void phase_mlstm_gnorm(Frame& F, const float* const* in, const bf16* Hf, const bf16* Hb, const bf16* Om, bf16* Hn) {
    const int gw = F.vcu * NWAVES + F.wave, NGW = GRID * NWAVES; const float* ng = in[28] + 16 * F.lane;
    for (int r = gw; r < M; r += NGW) { const size_t off = (size_t)r * 1024 + 16 * F.lane;
        const v4u a0 = *(const v4u*)(Hf + off), a1 = *(const v4u*)(Hf + off + 8), b0 = *(const v4u*)(Hb + off), b1 = *(const v4u*)(Hb + off + 8), o0 = *(const v4u*)(Om + off), o1 = *(const v4u*)(Om + off + 8);
        const unsigned aw[8] = {a0.x, a0.y, a0.z, a0.w, a1.x, a1.y, a1.z, a1.w}, bw[8] = {b0.x, b0.y, b0.z, b0.w, b1.x, b1.y, b1.z, b1.w}, ow[8] = {o0.x, o0.y, o0.z, o0.w, o1.x, o1.y, o1.z, o1.w};
        float v[16]; float ss = 0.f;
#pragma unroll
        for (int i = 0; i < 8; ++i) { v[2 * i] = bflo(aw[i]) + bflo(bw[i]); v[2 * i + 1] = bfhi(aw[i]) + bfhi(bw[i]); ss += v[2 * i] * v[2 * i] + v[2 * i + 1] * v[2 * i + 1]; }
        ss += __shfl_xor(ss, 1); ss += __shfl_xor(ss, 2); ss += __shfl_xor(ss, 4);
        const float rs = rsqrtf(ss * (1.f / 128.f) + EPS);
        unsigned res[8];
#pragma unroll
        for (int i = 0; i < 8; ++i) res[i] = cvt_pk_bf16(v[2 * i] * rs * ng[2 * i] * sigmoid_f(bflo(ow[i])), v[2 * i + 1] * rs * ng[2 * i + 1] * sigmoid_f(bfhi(ow[i])));
        *(v4u*)(Hn + off) = (v4u){res[0], res[1], res[2], res[3]}; *(v4u*)(Hn + off + 8) = (v4u){res[4], res[5], res[6], res[7]}; }
}
struct Args { const float* in[37]; float* out; unsigned char* ws; };

__device__ __forceinline__ void moe_phases(Frame& F, const float* const* in, int layer, const XcdBarrier& bar) {
    phase_norm2_route(F, in, layer);
    SYNC_GRID();
    bf16* Hb = (bf16*)(F.ws + WS_H); bf16* ACT = (bf16*)(F.ws + MOE_ACT); float* X = (float*)(F.ws + WS_X);
    const float* mod = (const float*)(F.ws + WS_MOD) + (size_t)layer * 9 * 6144;
    { MoeOrder<0> S; S.W = (const bf16*)(F.ws + WS_WGU); S.G = GRID; S.c = F.vcu; moe_setup(F, layer, S);
      pg8::Gemm g{Hb, 1024, 1024, 1 << 30}; EpiMoeAct E{ACT, S.tbl};
      pg8::gemm_phase(F.lds, g, S, E); }
    SYNC_GRID();
    { MoeOrder<1> S; S.W = (const bf16*)(F.ws + WS_WDN); S.G = GRID; S.c = F.vcu; moe_setup(F, layer, S);
      pg8::Gemm g{ACT, 512, 256, 4}; EpiMoeDown E{X, mod + 5 * 1024, S.tbl};
      pg8::gemm_phase(F.lds, g, S, E); }
    SYNC_GRID();
}
__device__ __forceinline__ void outproj_phase(Frame& F, const bf16* A, const bf16* Wt, int K, int ldb, int layer) {
    pg8::Gemm g{A, K, ldb, 1 << 30}; pg8::StaticOrder S; S.init(M, 1024, GRID, (int)blockIdx.x, Wt, ldb);
    EpiResid E{(float*)(F.ws + WS_X), (const float*)(F.ws + WS_MOD) + (size_t)layer * 9 * 6144 + 2 * 1024};
    pg8::gemm_phase(F.lds, g, S, E);
}

__device__ __forceinline__ void ssm_gp_phases(Frame& F, const float* const* in, const int gp, const XcdBarrier& bar) {
    unsigned char* scr = F.ws + WS_SCR; unsigned char* scr2 = (unsigned char*)F.out; bf16* H = (bf16*)(F.ws + WS_H); bf16* WM = (bf16*)(F.ws + WS_WMIX);
    bf16* Z = (bf16*)scr; bf16* XP = (bf16*)(scr + 68 * MiB); bf16* XS = (bf16*)(scr + 170 * MiB); float* DT = (float*)(scr + 238 * MiB); bf16* BC = (bf16*)scr2;
    { pg8::Gemm g{H, 1024, 1024, 1 << 30}; pg8::StaticOrder S; S.init(M, 2816, GRID, (int)blockIdx.x, WM + (size_t)gp * 2816 * 1024, 1024);
      EpiSsmIn E{Z, XP, DT, in[21] + gp * 16};
      pg8::gemm_phase(F.lds, g, S, E);
#if defined(PROBE_GEMM2)
        __syncthreads(); pg8::gemm_phase(F.lds, g, S, E);
#endif
        }
    SYNC_GRID();
    phase_ssm_conv(F, in, gp, XP, XS, BC);
#if defined(PROBE_MEM2)
    phase_ssm_conv(F, in, gp, XP, XS, BC);
#endif
    SYNC_GRID();
    phase_ssm_scan(F, in, gp, XS, BC, DT, Z, XP);
#if defined(PROBE_SSD2)
    __syncthreads(); phase_ssm_scan(F, in, gp, XS, BC, DT, Z, XP);
#endif
    SYNC_GRID();
    phase_ssm_gnorm(F, in, gp, XP);
    SYNC_GRID();
    outproj_phase(F, XP, WM + 6 * MiB + (size_t)gp * 1024, 1024, 2048, 1);
    SYNC_GRID();
}

__global__ void __launch_bounds__(NTHR, 2) fwd_kernel(Args args) {
    extern __shared__ __attribute__((aligned(16))) unsigned char lds_raw[];
    Frame F;
    F.lds = (LAS unsigned char*)lds_raw; F.ws = args.ws; F.ctl = (unsigned*)(args.ws + WS_CTL); F.out = args.out;
    refresh(F);
    { const int bx = blockIdx.x; F.vcu = (bx % 8) * (GRID / 8) + bx / 8; }
    volatile LAS unsigned* MISC = (volatile LAS unsigned*)(F.lds + LDS_MISC);
    for (int u = F.tid; u < 256; u += NTHR) MISC[u] = 0u;
    __syncthreads();
    const XcdBarrier bar = xcd_barrier_post(F.ctl + CW_BAR, MISC + 8);
    const float* const* in = args.in;
    unsigned char* ws = F.ws; unsigned char* scr = ws + WS_SCR; unsigned char* scr2 = (unsigned char*)F.out;
    bf16* H = (bf16*)(ws + WS_H); bf16* WM = (bf16*)(ws + WS_WMIX);

#if defined(PROBE_MEM2)
    for (int rep = 0; rep < 2; ++rep) {
#endif
    phase_prologue(F, in);
    __syncthreads(); refresh(F);
    convert_matrix<MAP_ATTN_IN>(F, in[15], 1024, 1536, WM, 0, nullptr);
    convert_matrix<MAP_ID>(F, in[17], 1024, 1024, WM + 2 * MiB, 0, nullptr);
    convert_moe(F, in, 0);
#if defined(PROBE_MEM2)
    __syncthreads(); }
#endif
    SYNC_GRID();

#ifndef SKIP_L0
    phase_norm1(F, in, 0);
#if defined(PROBE_MEM2)
    phase_norm1(F, in, 0);
#endif
    SYNC_GRID();
    { bf16* Q = (bf16*)scr; bf16* Kb = (bf16*)(scr + 68 * MiB); bf16* Vb = (bf16*)(scr + 85 * MiB);
      { pg8::Gemm g{H, 1024, 1024, 1 << 30}; pg8::StaticOrder S; S.init(M, 1536, GRID, (int)blockIdx.x, WM, 1024);
        EpiAttnIn E{Q, Kb, Vb, (const f32x2*)(ws + WS_TABA), 0.125f * LOG2E};
        pg8::gemm_phase(F.lds, g, S, E);
#if defined(PROBE_GEMM2)
        __syncthreads(); pg8::gemm_phase(F.lds, g, S, E);
#endif
        }
      SYNC_GRID();
      phase_attn_window(F, in, Q, Kb, Vb);
      SYNC_GRID();
      outproj_phase(F, Q, WM + 2 * MiB, 1024, 1024, 0);
      SYNC_GRID(); }
    moe_phases(F, in, 0, bar);

#endif
#ifndef SKIP_L1
#if defined(PROBE_MEM2)
    for (int rep = 0; rep < 2; ++rep) {
#endif
    phase_norm1(F, in, 1);
    convert_matrix<MAP_SSM_IN>(F, in[18], 1024, 5184, WM, 0, nullptr);
    zero_rows(F, WM, 2592, 224, 1024); zero_rows(F, WM, 2816 + 2592, 224, 1024);
    convert_matrix<MAP_ID>(F, in[25], 2048, 1024, WM + 6 * MiB, 0, nullptr);
    convert_moe(F, in, 1);
#if defined(PROBE_MEM2)
    __syncthreads(); }
#endif
    SYNC_GRID();
    ssm_gp_phases(F, in, 0, bar);
    ssm_gp_phases(F, in, 1, bar);
    moe_phases(F, in, 1, bar);

#endif
#ifndef SKIP_L2
#if defined(PROBE_MEM2)
    for (int rep = 0; rep < 2; ++rep) {
#endif
    phase_norm1(F, in, 2);
    convert_matrix<MAP_ID>(F, in[26], 1024, 3104, WM, 0, nullptr);
    zero_rows(F, WM, 3104, 224, 1024);
    convert_matrix<MAP_ID>(F, in[29], 1024, 1024, WM + 4 * MiB, 0, nullptr);
    convert_moe(F, in, 2);
#if defined(PROBE_MEM2)
    __syncthreads(); }
#endif
    SYNC_GRID();
    { bf16* Qm = (bf16*)scr; bf16* Km = (bf16*)(scr + 34 * MiB); bf16* Vm = (bf16*)(scr + 68 * MiB); bf16* Om = (bf16*)(scr + 136 * MiB); float* Gt = (float*)(scr + 204 * MiB);
      bf16* Hf = (bf16*)scr2; bf16* Hbw = H;
      { pg8::Gemm g{H, 1024, 1024, 1 << 30}; pg8::StaticOrder S; S.init(M, 3328, GRID, (int)blockIdx.x, WM, 1024);
        EpiMlIn E{Qm, Km, Vm, Om, Gt, in[27]};
        pg8::gemm_phase(F.lds, g, S, E);
#if defined(PROBE_GEMM2)
        __syncthreads(); pg8::gemm_phase(F.lds, g, S, E);
#endif
        }
      SYNC_GRID();
      phase_mlstm_scan(F, Qm, Km, Vm, Gt, Hf, Hbw);
#if defined(PROBE_ML2)
      __syncthreads(); phase_mlstm_scan(F, Qm, Km, Vm, Gt, Hf, Hbw);
#endif
      SYNC_GRID();
      phase_mlstm_gnorm(F, in, Hf, Hbw, Om, Om);
      SYNC_GRID();
      outproj_phase(F, Om, WM + 4 * MiB, 1024, 1024, 2);
      SYNC_GRID(); }
    moe_phases(F, in, 2, bar);

#endif
#ifndef SKIP_L3
#if defined(PROBE_MEM2)
    for (int rep = 0; rep < 2; ++rep) {
#endif
    phase_norm1(F, in, 3);
    convert_matrix<MAP_MLA_IN>(F, in[30], 1024, 544, WM, 0, nullptr);
    zero_rows(F, WM, 544, 224, 1024);
    convert_matrix<MAP_MLA_QUP>(F, in[32], 256, 1536, WM + 1 * MiB, 0, in[31]);
    convert_matrix<MAP_ID>(F, in[34], 256, 2048, WM + 2 * MiB, 0, in[33]);
    convert_matrix<MAP_ID>(F, in[35], 1024, 1024, WM + 3 * MiB, 0, nullptr);
    convert_moe(F, in, 3);
#if defined(PROBE_MEM2)
    __syncthreads(); }
#endif
    SYNC_GRID();
    { bf16* CQ = (bf16*)scr; bf16* CKV = (bf16*)(scr + 17 * MiB); float* SSQ = (float*)(scr + 34 * MiB); bf16* KF = (bf16*)(scr + 36 * MiB); bf16* V3 = (bf16*)(scr + 138 * MiB);
      bf16* Q3 = (bf16*)scr2; bf16* O3 = H; const f32x2* tabm = (const f32x2*)(ws + WS_TABM);
      { pg8::Gemm g{H, 1024, 1024, 1 << 30}; pg8::StaticOrder S; S.init(M, 768, GRID, (int)blockIdx.x, WM, 1024);
        EpiMlaIn E{CQ, CKV, KF, SSQ, tabm};
        pg8::gemm_phase(F.lds, g, S, E);
#if defined(PROBE_GEMM2)
        __syncthreads(); pg8::gemm_phase(F.lds, g, S, E);
#endif
        }
      SYNC_GRID();
      { pg8::Gemm g{CQ, 256, 256, 1 << 30}; pg8::StaticOrder S; S.init(M, 1536, GRID, (int)blockIdx.x, WM + 1 * MiB, 256);
        EpiMlaQ E{Q3, SSQ, tabm, 0.10206207261596577f * LOG2E};
        pg8::gemm_phase(F.lds, g, S, E);
#if defined(PROBE_GEMM2)
        __syncthreads(); pg8::gemm_phase(F.lds, g, S, E);
#endif
        }
      { pg8::Gemm g{CKV, 256, 256, 1 << 30}; pg8::StaticOrder S; S.init(M, 2048, GRID, (int)blockIdx.x, WM + 2 * MiB, 256);
        EpiMlaKV E{KF, V3, SSQ};
        pg8::gemm_phase(F.lds, g, S, E);
#if defined(PROBE_GEMM2)
        __syncthreads(); pg8::gemm_phase(F.lds, g, S, E);
#endif
        }
      SYNC_GRID();
      phase_attn_mla(F, Q3, KF, V3, O3);
#if defined(PROBE_MLA2)
      __syncthreads(); phase_attn_mla(F, Q3, KF, V3, O3);
#endif
      SYNC_GRID();
      outproj_phase(F, O3, WM + 3 * MiB, 1024, 1024, 3);
      SYNC_GRID(); }
    moe_phases(F, in, 3, bar);

#endif
    const bool poison = __hip_atomic_load(F.ctl + CW_BAR + XB_TMO, RLX_AGENT) != 0u || __hip_atomic_load(F.ctl + CW_POISON, RLX_AGENT) != 0u;
    phase_final(F, in, poison);
#if defined(PROBE_MEM2)
    phase_final(F, in, poison);
#endif
}

extern "C" void kernel_launch(void* const* d_in, const int* in_sizes, int n_in, void* d_out, int out_size, void* d_ws, size_t ws_size, hipStream_t stream) {
    static int ready = 0;
    if (ready == 0) {
        ready = -1;
        if (n_in != 37 || in_sizes[0] != NB * SEQ * D || out_size != NB * SEQ * D || ws_size < WS_END) { fprintf(stderr, "kernel_launch: unexpected problem shape (n_in %d, in0 %d, out %d, ws %zu)\n", n_in, n_in > 0 ? in_sizes[0] : -1, out_size, ws_size); return; }
        int dev = 0, cus = 0;
        if (hipGetDevice(&dev) != hipSuccess || hipDeviceGetAttribute(&cus, hipDeviceAttributeMultiprocessorCount, dev) != hipSuccess) { fprintf(stderr, "kernel_launch: device query failed\n"); return; }
        if (cus < GRID) { fprintf(stderr, "kernel_launch: needs %d CUs, device has %d\n", GRID, cus); return; }
        if (hipFuncSetAttribute((const void*)fwd_kernel, hipFuncAttributeMaxDynamicSharedMemorySize, LDS_BYTES) != hipSuccess) { fprintf(stderr, "kernel_launch: hipFuncSetAttribute failed\n"); return; }
        int per_cu = 0;
        if (hipOccupancyMaxActiveBlocksPerMultiprocessor(&per_cu, (const void*)fwd_kernel, NTHR, LDS_BYTES) != hipSuccess || per_cu < 1) { fprintf(stderr, "kernel_launch: occupancy query reports %d blocks per CU\n", per_cu); }
        (void)hipGetLastError();
        ready = 1;
    }
    if (ready < 0) return;
    if (hipMemsetAsync((char*)d_ws + WS_CTL, 0, CTL_ZERO_BYTES, stream) != hipSuccess) { fprintf(stderr, "kernel_launch: memset failed\n"); return; }
    Args a{};
    for (int i = 0; i < 37; ++i) a.in[i] = (const float*)d_in[i];
    a.out = (float*)d_out; a.ws = (unsigned char*)d_ws;
    hipLaunchKernelGGL(fwd_kernel, dim3(GRID), dim3(NTHR), LDS_BYTES, stream, a);
    const hipError_t le = hipPeekAtLastError();
    if (le != hipSuccess) fprintf(stderr, "kernel_launch: launch failed: %s\n", hipGetErrorName(le));
}
```

```cpp
#include <hip/hip_runtime.h>
#include <cstdio>
#include <cstdint>

#define GAS __attribute__((address_space(1)))
#define LAS __attribute__((address_space(3)))
typedef unsigned short bf16;
typedef unsigned v4u __attribute__((ext_vector_type(4)));
typedef unsigned v2u __attribute__((ext_vector_type(2)));
typedef float f32x4 __attribute__((ext_vector_type(4)));
typedef float f32x2 __attribute__((ext_vector_type(2)));
typedef short bf16x8 __attribute__((ext_vector_type(8)));
typedef short s16x4 __attribute__((ext_vector_type(4)));
#define RLX_AGENT __ATOMIC_RELAXED, __HIP_MEMORY_SCOPE_AGENT

constexpr int D = 1024, NB = 8, SEQ = 4096, CTX = 256, TPB = SEQ + CTX  , M = NB * TPB  ;
constexpr int NWAVES = 8, NTHR = 512, GRID = 256;
constexpr float EPS = 1e-6f;
constexpr float LOG2E = 1.4426950408889634f;

__device__ __forceinline__ unsigned f2bf(float f) { unsigned u = __builtin_bit_cast(unsigned, f); return (u + 0x7fffu + ((u >> 16) & 1u)) >> 16; }
__device__ __forceinline__ float bf2f(unsigned b) { return __builtin_bit_cast(float, b << 16); }
__device__ __forceinline__ float bflo(unsigned w) { return __builtin_bit_cast(float, w << 16); }
__device__ __forceinline__ float bfhi(unsigned w) { return __builtin_bit_cast(float, w & 0xffff0000u); }
__device__ __forceinline__ unsigned cvt_pk_bf16(float lo, float hi) { unsigned r; asm volatile("v_cvt_pk_bf16_f32 %0, %1, %2" : "=v"(r) : "v"(lo), "v"(hi)); return r; }
__device__ __forceinline__ float fast_exp2(float x) { return __builtin_amdgcn_exp2f(x); }
__device__ __forceinline__ float fast_rcp(float x) { return __builtin_amdgcn_rcpf(x); }
__device__ __forceinline__ float silu_f(float x) { return x * fast_rcp(1.0f + fast_exp2(-x * LOG2E)); }
__device__ __forceinline__ float sigmoid_f(float x) { return fast_rcp(1.0f + fast_exp2(-x * LOG2E)); }
__device__ __forceinline__ float fast_log(float x) { return __builtin_amdgcn_logf(x) * 0.6931471805599453f; }
__device__ __forceinline__ float fast_exp(float x) { return __builtin_amdgcn_exp2f(x * LOG2E); }
__device__ __forceinline__ float softplus_f(float x) { if (x > 20.f) return x; const float e = fast_exp(x); return e < 0.01f ? e * (1.0f - e * (0.5f - e * (1.0f / 3.0f))) : fast_log(1.0f + e); }
__device__ __forceinline__ float wave_sum(float v) {
#pragma unroll
    for (int o = 1; o < 64; o <<= 1) v += __shfl_xor(v, o);
    return v;
}
__device__ __forceinline__ int opaque_tid() { int t = threadIdx.x; asm volatile("" : "+v"(t)); return t; }
#define LDS_WAIT() asm volatile("s_waitcnt lgkmcnt(0)" ::: "memory")
#define VM_WAIT() asm volatile("s_waitcnt vmcnt(0)" ::: "memory")

namespace pg8 {
constexpr int BM = 256, BK = 64, HALF = 128, HTB = HALF * BK * 2, STAGE_BYTES = 8 * HTB, NXCD = 8, WGM = 8;
__host__ __device__ __forceinline__ int lds_byte(int r, int c) { const int st = (r >> 4) * 2 + (c >> 5), rr = r & 15, cc = c & 31, ob = rr * 64 + cc * 2; return st * 1024 + (ob ^ (((ob >> 9) & 1) << 5)); }
__host__ __device__ __forceinline__ void stage_rc(int b, int& R, int& C) { const int st = b / 1024, sb = b % 1024, swz = sb ^ (((sb >> 9) & 1) << 5); R = (st >> 1) * 16 + swz / 64; C = (st & 1) * 32 + (swz % 64) / 2; }
__host__ __device__ __forceinline__ int perm32(int rho) { const int n = rho >> 4, i = rho & 15; return 8 * (i >> 2) + 4 * n + (i & 3); }

struct Unit { int pm, pn, aux; };
struct Gemm { const bf16* A; int K; int ldb; int ksplit; };

struct StaticOrder {
    static constexpr bool GATHER = false;
    int nM, nN, nwg, G, c; const bf16* Bt; int ldb;
    __device__ void init(int M_, int N_, int G_, int c_, const bf16* Bt_, int ldb_) { nM = M_ / BM; nN = N_ / BM; nwg = nM * nN; G = G_; c = c_; Bt = Bt_; ldb = ldb_; }
    __device__ __forceinline__ bool next(int i, Unit& u) const {
        const long L = (long)i * G + c; if (L >= nwg) return false;
        int wgid = (int)L; { const int q = nwg / NXCD, r = nwg % NXCD, xcd = wgid % NXCD, off = wgid / NXCD; wgid = (xcd < r ? xcd * (q + 1) : r * (q + 1) + (xcd - r) * q) + off; }
        const int nig = WGM * nN, gid = wgid / nig, fm = gid * WGM, gsz = (nM - fm) < WGM ? (nM - fm) : WGM;
        u.pm = fm + ((wgid % nig) % gsz); u.pn = (wgid % nig) / gsz; u.aux = 0; return true;
    }
    __device__ __forceinline__ int a_row(const Unit& u, int r) const { return u.pm * BM + r; }
    __device__ __forceinline__ const char* b_seg(const Unit& u, int seg) const { return (const char*)(Bt + (size_t)u.pn * BM * ldb); }
};

template <class Epi, class Sched>
__device__ __forceinline__ void gemm_phase(LAS unsigned char* lds, const Gemm g, const Sched& S, const Epi& E) {
    const int tid = opaque_tid(), wid = __builtin_amdgcn_readfirstlane(tid >> 6), lane = tid & 63, wr = wid >> 2, wc = wid & 3, fr = lane & 15, fq = lane >> 4;
    const int K = g.K, nt = K / BK, ldb = g.ldb, ksplit = g.ksplit;
    int Rst[2], Cst[2]; unsigned voffB[2], voffA[2];
#pragma unroll
    for (int i = 0; i < 2; ++i) { int R, C; stage_rc(tid * 16 + i * 8192, R, C); const int Rb = Epi::PERM ? ((R & ~31) + perm32(R & 31)) : R; Rst[i] = R; Cst[i] = C;
        voffB[i] = (unsigned)(Rb * ldb + C) * 2u; voffA[i] = (unsigned)(R * K + C) * 2u; }
    const size_t hstepA = (size_t)HALF * K * 2;
    const size_t kstep = (size_t)(BK * 2);
    const size_t hstepB = (size_t)HALF * ldb * 2;
    const unsigned ldsw = (unsigned)wid * 1024u;
    const int aoff = lds_byte(wr * 64 + fr, fq * 8), boff = lds_byte(wc * 32 + fr, fq * 8);
#define PG8_SA(b, h) (((b) * 2 + (h)) * HTB)
#define PG8_SB(b, h) ((4 + (b) * 2 + (h)) * HTB)
#define PG8_STAGEB(bufoff, gbase) do { _Pragma("unroll") for (int _i = 0; _i < 2; ++_i) \
        __builtin_amdgcn_global_load_lds((const unsigned*)((const char*)(gbase) + voffB[_i]), (LAS unsigned*)(lds + (bufoff) + ldsw + _i * 8192), 16, 0, 0); } while (0)
#define PG8_STAGEA(bufoff, nextsel, h, kt) do { if constexpr (Sched::GATHER) { _Pragma("unroll") for (int _i = 0; _i < 2; ++_i) \
        __builtin_amdgcn_global_load_lds((const unsigned*)(gA + (size_t)(kt) * kstep + ((nextsel) ? vN[h][_i] : vA[h][_i])), (LAS unsigned*)(lds + (bufoff) + ldsw + _i * 8192), 16, 0, 0); } \
      else { const char* _ab = ((nextsel) ? nA : cA) + (size_t)(h) * hstepA + (size_t)(kt) * kstep; _Pragma("unroll") for (int _i = 0; _i < 2; ++_i) \
        __builtin_amdgcn_global_load_lds((const unsigned*)(_ab + voffA[_i]), (LAS unsigned*)(lds + (bufoff) + ldsw + _i * 8192), 16, 0, 0); } } while (0)
#define PG8_LDA(dst, b, h) do { _Pragma("unroll") for (int m = 0; m < 4; ++m) _Pragma("unroll") for (int k = 0; k < 2; ++k) dst[m][k] = *(const LAS bf16x8*)(lds + PG8_SA(b, h) + aoff + m * 2048 + k * 1024); } while (0)
#define PG8_LDB(dst, b, h) do { _Pragma("unroll") for (int n = 0; n < 2; ++n) _Pragma("unroll") for (int k = 0; k < 2; ++k) dst[n][k] = *(const LAS bf16x8*)(lds + PG8_SB(b, h) + boff + n * 2048 + k * 1024); } while (0)
#define PG8_MMA(ai, bj, At, Bt) do { __builtin_amdgcn_s_setprio(1); _Pragma("unroll") for (int m = 0; m < 4; ++m) _Pragma("unroll") for (int n = 0; n < 2; ++n) _Pragma("unroll") for (int k = 0; k < 2; ++k) \
        acc[ai][bj][m][n] = __builtin_amdgcn_mfma_f32_16x16x32_bf16(Bt[n][k], At[m][k], acc[ai][bj][m][n], 0, 0, 0); __builtin_amdgcn_s_setprio(0); } while (0)
#define PG8_WAIT_V(n) asm volatile("s_waitcnt vmcnt(" #n ")" ::: "memory")
#define PG8_WAIT_L(n) asm volatile("s_waitcnt lgkmcnt(" #n ")" ::: "memory")
#define PG8_BAR __builtin_amdgcn_s_barrier()
#define PG8_SCHED __builtin_amdgcn_sched_barrier(0)
#define PG8_AOFFS(dst, u) do { _Pragma("unroll") for (int _h = 0; _h < 2; ++_h) _Pragma("unroll") for (int _i = 0; _i < 2; ++_i) \
        dst[_h][_i] = (unsigned)S.a_row(u, _h * HALF + Rst[_i]) * (unsigned)(K * 2) + (unsigned)(Cst[_i] * 2); } while (0)
    Unit cur, nxt; int ui = 0;
    if (!S.next(0, cur)) return;
    const char* const gA = (const char*)g.A;
    f32x4 acc[2][2][4][2];
#pragma unroll
    for (int a = 0; a < 2; ++a)
#pragma unroll
        for (int b = 0; b < 2; ++b)
#pragma unroll
            for (int m = 0; m < 4; ++m)
#pragma unroll
                for (int n = 0; n < 2; ++n) acc[a][b][m][n] = (f32x4){0.f, 0.f, 0.f, 0.f};
    bf16x8 At[4][2], B0[2][2], B1[2][2];
    unsigned vA[2][2], vN[2][2];
    const char* cA = gA; const char* nA = gA;
    if constexpr (Sched::GATHER) { PG8_AOFFS(vA, cur); } else { cA = gA + (size_t)S.a_row(cur, 0) * K * 2; }
    const char* cB0 = S.b_seg(cur, 0); const char* cB1 = S.b_seg(cur, 1);
    PG8_STAGEB(PG8_SB(0, 0), cB0); PG8_STAGEB(PG8_SB(0, 1), cB0 + hstepB); PG8_STAGEA(PG8_SA(0, 0), false, 0, 0); PG8_STAGEA(PG8_SA(0, 1), false, 1, 0);
    if (wr == 1) PG8_BAR;
    PG8_WAIT_V(2); PG8_BAR;
    PG8_STAGEB(PG8_SB(1, 0), cB0 + kstep); PG8_STAGEA(PG8_SA(1, 0), false, 0, 1); PG8_STAGEB(PG8_SB(1, 1), cB0 + hstepB + kstep);
    PG8_WAIT_V(6); PG8_BAR;
    for (;;) {
        const bool has_next = S.next(ui + 1, nxt);
        const char* nB0 = cB0;
        nA = cA;
        if (has_next) { nB0 = S.b_seg(nxt, 0); if constexpr (Sched::GATHER) { PG8_AOFFS(vN, nxt); } else { nA = gA + (size_t)S.a_row(nxt, 0) * K * 2; } }
        else { if constexpr (Sched::GATHER) {
#pragma unroll
            for (int h = 0; h < 2; ++h)
#pragma unroll
                for (int i = 0; i < 2; ++i) vN[h][i] = vA[h][i]; } }
#pragma unroll 1
        for (int t = 0; t < nt; t += 2) {
            const bool last = (t == nt - 2);
            const char* b2 = last ? nB0 : ((t + 2 < ksplit) ? cB0 + (size_t)(t + 2) * kstep : cB1 + (size_t)(t + 2 - ksplit) * kstep);
            const char* b3 = b2 + kstep;
            const int kt2 = last ? 0 : t + 2;
            PG8_LDB(B0, 0, 0); PG8_LDB(B1, 0, 1); PG8_SCHED; PG8_LDA(At, 0, 0); PG8_STAGEA(PG8_SA(1, 1), false, 1, t + 1);
            PG8_WAIT_V(8); PG8_WAIT_L(0); PG8_BAR; PG8_MMA(0, 0, At, B0); PG8_MMA(0, 1, At, B1); PG8_BAR; PG8_SCHED;
            PG8_LDA(At, 0, 1); PG8_STAGEB(PG8_SB(0, 0), b2); PG8_STAGEB(PG8_SB(0, 1), b2 + hstepB); PG8_STAGEA(PG8_SA(0, 0), last, 0, kt2);
            PG8_WAIT_V(8); PG8_WAIT_L(0); PG8_BAR; PG8_MMA(1, 0, At, B0); PG8_MMA(1, 1, At, B1); PG8_BAR; PG8_SCHED;
            PG8_LDB(B0, 1, 0); PG8_LDB(B1, 1, 1); PG8_SCHED; PG8_LDA(At, 1, 0); PG8_STAGEA(PG8_SA(0, 1), last, 1, kt2);
            PG8_WAIT_V(8); PG8_WAIT_L(0); PG8_BAR; PG8_MMA(0, 0, At, B0); PG8_MMA(0, 1, At, B1); PG8_BAR; PG8_SCHED;
            PG8_LDA(At, 1, 1); PG8_STAGEB(PG8_SB(1, 0), b3); PG8_STAGEB(PG8_SB(1, 1), b3 + hstepB); PG8_STAGEA(PG8_SA(1, 0), last, 0, kt2 + 1);
            PG8_WAIT_V(8); PG8_WAIT_L(0); PG8_BAR; PG8_MMA(1, 0, At, B0); PG8_MMA(1, 1, At, B1); PG8_BAR; PG8_SCHED;
        }
        if (wr == 0) PG8_BAR;
        { int tz = tid; asm volatile("" : "+v"(tz));
          const int lz = tz & 63; E(acc, cur, ui, wr, wc, lz & 15, lz >> 4); }
        if (!has_next) break;
#pragma unroll
        for (int a = 0; a < 2; ++a)
#pragma unroll
            for (int b = 0; b < 2; ++b)
#pragma unroll
                for (int m = 0; m < 4; ++m)
#pragma unroll
                    for (int n = 0; n < 2; ++n) acc[a][b][m][n] = (f32x4){0.f, 0.f, 0.f, 0.f};
        cur = nxt; cB0 = nB0; cB1 = S.b_seg(cur, 1); cA = nA; ++ui;
        if constexpr (Sched::GATHER) {
#pragma unroll
        for (int h = 0; h < 2; ++h)
#pragma unroll
            for (int i = 0; i < 2; ++i) vA[h][i] = vN[h][i]; }
        if (wr == 1) PG8_BAR;
    }
    PG8_WAIT_V(0);
    PG8_BAR;
#undef PG8_SA
#undef PG8_SB
#undef PG8_STAGEA
#undef PG8_STAGEB
#undef PG8_LDA
#undef PG8_LDB
#undef PG8_MMA
#undef PG8_WAIT_V
#undef PG8_WAIT_L
#undef PG8_BAR
#undef PG8_SCHED
#undef PG8_AOFFS
}
}
#define XB_TMO      128
#define XB_XCNT(j)  (256  + 64 * (j))
#define XB_XSUB(j)  (1280 + 64 * (j))
#define XB_XGEN(j)  (2304 + 64 * (j))
#define XB_TOP      3328
#define XB_TOPGEN   3392
#define XCD_BAR_WORDS 3456
#define XB_SPIN_CAP (1u << 22)
__device__ __forceinline__ unsigned xb_ld(unsigned* p)              { return __hip_atomic_load(p, __ATOMIC_RELAXED, __HIP_MEMORY_SCOPE_AGENT); }
__device__ __forceinline__ unsigned xb_add(unsigned* p, unsigned v) { return __hip_atomic_fetch_add(p, v, __ATOMIC_RELAXED, __HIP_MEMORY_SCOPE_AGENT); }
__device__ __forceinline__ unsigned xb_xcc_id() { return (unsigned)__builtin_amdgcn_s_getreg((3 << 11) | 20) & 0xFu; }
#define XB_SPIN(cond, bar) do { unsigned _sp = 0; while (cond) { __builtin_amdgcn_s_sleep(1); \
    if ((++_sp & 255u) == 0u) { if (xb_ld(&(bar)[XB_TMO])) break; if (_sp > XB_SPIN_CAP) { atomicAdd(&(bar)[XB_TMO], 1u); break; } } } } while (0)
struct XcdBarrier { unsigned* bar; unsigned x; volatile LAS unsigned* st; };
__device__ __forceinline__ XcdBarrier xcd_barrier_post(unsigned* bar, volatile LAS unsigned* st) {
    XcdBarrier b; b.bar = bar; b.x = xb_xcc_id(); b.st = st;
    if (threadIdx.x == 0) (void)xb_add(&bar[XB_XCNT(b.x)], 1u);
    return b;
}
__device__ __forceinline__ void xcd_barrier_complete(unsigned* bar, unsigned x, unsigned& nloc, unsigned& nx) {
    const unsigned G = gridDim.x * gridDim.y * gridDim.z;
    unsigned sum, cnt, mine, sp = 0u;
    for (;;) {
        sum = 0u; cnt = 0u; mine = 0u;
#pragma unroll
        for (unsigned j = 0; j < 16; ++j) { const unsigned c = xb_ld(&bar[XB_XCNT(j)]); sum += c; cnt += (c > 0u) ? 1u : 0u; mine = (j == x) ? c : mine; }
        if (sum == G) break;
        __builtin_amdgcn_s_sleep(1);
        if ((++sp & 255u) == 0u) { if (xb_ld(&bar[XB_TMO])) break; if (sp > XB_SPIN_CAP) { atomicAdd(&bar[XB_TMO], 1u); break; } }
    }
    nloc = mine > 0u ? mine : 1u; nx = cnt > 0u ? cnt : 1u;
}
__device__ __forceinline__ void xcd_barrier(const XcdBarrier& b) {
    asm volatile("s_waitcnt vmcnt(0)" ::: "memory");
    __syncthreads();
    if (threadIdx.x == 0) {
        unsigned* bar = b.bar;
        __builtin_amdgcn_s_waitcnt(0);
        unsigned nloc = b.st[0], nx = b.st[1];
        if (nloc == 0u) { xcd_barrier_complete(bar, b.x, nloc, nx); b.st[0] = nloc; b.st[1] = nx; }
        const unsigned old = xb_add(&bar[XB_XSUB(b.x)], 1u);
        const unsigned gen = old / nloc;
        if (old + 1u == (gen + 1u) * nloc) {
            __builtin_amdgcn_fence(__ATOMIC_RELEASE, "agent");
            asm volatile("s_waitcnt vmcnt(0)" ::: "memory");
            const unsigned og = xb_add(&bar[XB_TOP], 1u);
            const unsigned tg = og / nx;
            if (og + 1u == (tg + 1u) * nx) xb_add(&bar[XB_TOPGEN], 1u);
            else XB_SPIN(xb_ld(&bar[XB_TOPGEN]) == tg, bar);
            __builtin_amdgcn_fence(__ATOMIC_ACQUIRE, "agent");
            xb_add(&bar[XB_XGEN(b.x)], 1u);
            asm volatile("s_waitcnt vmcnt(0)" ::: "memory");
        } else {
            XB_SPIN(xb_ld(&bar[XB_XGEN(b.x)]) == gen, bar);
            __builtin_amdgcn_fence(__ATOMIC_ACQUIRE, "agent");
            asm volatile("s_waitcnt vmcnt(0)" ::: "memory");
        }
    }
    __syncthreads();
}

constexpr size_t MiB = 1u << 20;
constexpr size_t WS_CTL = 0, CTL_ZERO_BYTES = 1 * MiB;
constexpr size_t WS_MOD = 1 * MiB;
constexpr size_t WS_TABA = 2 * MiB;
constexpr size_t WS_TABM = 3 * MiB;
constexpr size_t WS_WGU = 4 * MiB;
constexpr size_t WS_WDN = 20 * MiB;
constexpr size_t WS_WMIX = 28 * MiB;
constexpr size_t WS_X = 52 * MiB;
constexpr size_t WS_H = 188 * MiB;
constexpr size_t WS_SCR = 256 * MiB;
constexpr size_t WS_END = 512 * MiB;
constexpr size_t MOE_ACT = WS_SCR;
constexpr size_t MOE_SL = WS_SCR + 48 * MiB;
constexpr size_t MOE_WT = WS_SCR + 52 * MiB;
constexpr int CW_BAR = 4096;
constexpr int CW_MOECNT = 16384;
constexpr int CW_POISON = 20000;

constexpr int RING_BYTES = 131072;
constexpr int LDS_MISC = RING_BYTES;
constexpr int LDS_TB = RING_BYTES + 512;
constexpr int LDS_TBL = RING_BYTES + 1024;
constexpr int LDS_BYTES = RING_BYTES + 1024 + 16384;

struct Frame {
    LAS unsigned char* lds;
    unsigned* ctl;
    unsigned char* ws;
    float* out;
    int tid, lane, wave, vcu;
};

__device__ __forceinline__ void refresh(Frame& F) { F.tid = opaque_tid(); F.lane = F.tid & 63; F.wave = __builtin_amdgcn_readfirstlane(F.tid >> 6); }
#if defined(PROBE_BAR2)
#define SYNC_GRID() do { xcd_barrier(bar); xcd_barrier(bar); refresh(F); } while (0)
#else
#define SYNC_GRID() do { xcd_barrier(bar); refresh(F); } while (0)
#endif
__device__ __forceinline__ int modrow_of(int row) { const int b = row / TPB, t = row - b * TPB; return t < CTX ? 8 : b; }

enum { MAP_ID = 0, MAP_ATTN_IN, MAP_SSM_IN, MAP_MLA_IN, MAP_MLA_QUP, MAP_MOE_G, MAP_MOE_U };
template <int KIND> __device__ __forceinline__ int map_row(int n, int aux) {
    if (KIND == MAP_ID) return aux + n;
    if (KIND == MAP_ATTN_IN) { if (n >= 1280) return n; const int hb = n & ~63, d = n & 63; return hb + (d < 32 ? 2 * d : 2 * (d - 32) + 1); }
    if (KIND == MAP_SSM_IN) {
        if (n < 2048) { const int gp = n >> 10; return gp * 2816 + (n & 1023); }
        if (n < 4096) { const int c = n - 2048, gp = c >> 10; return gp * 2816 + 1024 + (c & 1023); }
        if (n < 4608) { const int c = n - 4096, gp = c >> 8; return gp * 2816 + 2048 + (c & 255); }
        if (n < 5120) { const int c = n - 4608, gp = c >> 8; return gp * 2816 + 2304 + (c & 255); }
        { const int c = n - 5120, dir = c >> 5, h = c & 31, gp = h >> 4; return gp * 2816 + 2560 + dir * 16 + (h & 15); }
    }
    if (KIND == MAP_MLA_IN) { if (n < 512) return n; const int d = n - 512; return 512 + (d < 16 ? 2 * d : 2 * (d - 16) + 1); }
    if (KIND == MAP_MLA_QUP) { const int h = n / 96, e = n - h * 96; if (e < 64) return n; const int d = e - 64; return h * 96 + 64 + (d < 16 ? 2 * d : 2 * (d - 16) + 1); }
    if (KIND == MAP_MOE_G) return aux + (n >> 7) * 256 + (n & 127);
    if (KIND == MAP_MOE_U) return aux + (n >> 7) * 256 + 128 + (n & 127);
    return n;
}
template <int KIND>
__device__ __forceinline__ void transpose_item(const float* W, int K, int N, bf16* WT, int aux, const float* kscale, LAS float* scr, int item, int lane) {
    const int nblk = N / 32, kb = item / nblk, nb = item % nblk, k0 = 64 * kb, n0 = 32 * nb;
#pragma unroll 8
    for (int i = 0; i < 32; ++i) { const int kk = 2 * i + (lane >> 5); float v = W[(size_t)(k0 + kk) * N + n0 + (lane & 31)]; if (kscale) v *= kscale[k0 + kk]; scr[kk * 33 + (lane & 31)] = v; }
    LDS_WAIT(); asm volatile("" ::: "memory");
    const int c = lane & 7;
#pragma unroll
    for (int j = 0; j < 4; ++j) { const int n = (lane >> 3) + 8 * j; const LAS float* s = scr + (8 * c) * 33 + n;
        v4u o; o.x = cvt_pk_bf16(s[0 * 33], s[1 * 33]); o.y = cvt_pk_bf16(s[2 * 33], s[3 * 33]); o.z = cvt_pk_bf16(s[4 * 33], s[5 * 33]); o.w = cvt_pk_bf16(s[6 * 33], s[7 * 33]);
        *(v4u*)(WT + (size_t)map_row<KIND>(n0 + n, aux) * K + k0 + 8 * c) = o; }
    LDS_WAIT(); asm volatile("" ::: "memory");
}
template <int KIND>
__device__ __forceinline__ void convert_matrix(Frame& F, const float* W, int K, int N, bf16* WT, int aux, const float* kscale) {
    LAS float* scr = (LAS float*)(F.lds + F.wave * 16384);
    const int gw = F.vcu * NWAVES + F.wave, NGW = GRID * NWAVES, nitems = (K / 64) * (N / 32);
    for (int it = gw; it < nitems; it += NGW) transpose_item<KIND>(W, K, N, WT, aux, kscale, scr, it, F.lane);
}
__device__ __forceinline__ void zero_rows(Frame& F, bf16* WT, int row0, int nrows, int K) {
    const size_t n16 = (size_t)nrows * K / 8; v4u* p = (v4u*)(WT + (size_t)row0 * K);
    for (size_t i = (size_t)blockIdx.x * NTHR + F.tid; i < n16; i += (size_t)GRID * NTHR) p[i] = (v4u){0u, 0u, 0u, 0u};
}
__device__ __forceinline__ void convert_moe(Frame& F, const float* const* in, int layer) {
    bf16* GU = (bf16*)(F.ws + WS_WGU); bf16* DN = (bf16*)(F.ws + WS_WDN);
    const float* wg = in[12] + (size_t)layer * 16 * 1024 * 256; const float* wu = in[13] + (size_t)layer * 16 * 1024 * 256; const float* wd = in[14] + (size_t)layer * 16 * 256 * 1024;
    LAS float* scr = (LAS float*)(F.lds + F.wave * 16384);
    const int gw = F.vcu * NWAVES + F.wave, NGW = GRID * NWAVES;
    for (int it = gw; it < 16 * 384; it += NGW) { const int e = it / 384, r = it - e * 384, kind = r >> 7, sub = r & 127;
        if (kind == 0) transpose_item<MAP_MOE_G>(wg + (size_t)e * 1024 * 256, 1024, 256, GU, e * 512, nullptr, scr, sub, F.lane);
        else if (kind == 1) transpose_item<MAP_MOE_U>(wu + (size_t)e * 1024 * 256, 1024, 256, GU, e * 512, nullptr, scr, sub, F.lane);
        else transpose_item<MAP_ID>(wd + (size_t)e * 256 * 1024, 256, 1024, DN, e * 1024, nullptr, scr, sub, F.lane); }
}

__device__ __forceinline__ void norm_mod_row(const float* xrow, const float* g, const float* sc, const float* sh, bf16* orow, int lane, f32x4 (&hv)[4]) {
    const f32x4* xr = (const f32x4*)xrow + lane;
    f32x4 v[4]; float s = 0.f;
#pragma unroll
    for (int j = 0; j < 4; ++j) { v[j] = xr[64 * j]; s += (v[j].x * v[j].x + v[j].y * v[j].y) + (v[j].z * v[j].z + v[j].w * v[j].w); }
    const float rstd = rsqrtf(wave_sum(s) * (1.f / D) + EPS);
    unsigned long long* o8 = (unsigned long long*)orow + lane;
#pragma unroll
    for (int j = 0; j < 4; ++j) {
        const f32x4 gg = ((const f32x4*)g)[lane + 64 * j], ss = ((const f32x4*)sc)[lane + 64 * j], hh = ((const f32x4*)sh)[lane + 64 * j];
        f32x4 h = v[j] * rstd * gg * (ss + 1.0f) + hh; hv[j] = h;
        o8[64 * j] = (unsigned long long)cvt_pk_bf16(h.x, h.y) | ((unsigned long long)cvt_pk_bf16(h.z, h.w) << 32);
    }
}
__device__ __forceinline__ void phase_norm1(Frame& F, const float* const* in, int layer) {
    const float* X = (const float*)(F.ws + WS_X); bf16* H = (bf16*)(F.ws + WS_H);
    const float* g = in[4] + layer * D; const float* mod = (const float*)(F.ws + WS_MOD) + (size_t)layer * 9 * 6144;
    const int gw = F.vcu * NWAVES + F.wave, NGW = GRID * NWAVES;
    for (int r = gw; r < M; r += NGW) { const float* mr = mod + (size_t)modrow_of(r) * 6144; f32x4 hv[4];
        norm_mod_row(X + (size_t)r * D, g, mr + 1024, mr, H + (size_t)r * D, F.lane, hv); }
}

__device__ __forceinline__ void phase_prologue(Frame& F, const float* const* in) {
    { float* X = (float*)(F.ws + WS_X); const int gw = F.vcu * NWAVES + F.wave, NGW = GRID * NWAVES;
      for (int r = gw; r < M; r += NGW) { const int b = r / TPB, t = r - b * TPB;
          const float* src = t < CTX ? in[2] + ((size_t)b * CTX + t) * D : in[0] + ((size_t)b * SEQ + (t - CTX)) * D;
          const f32x4* s4 = (const f32x4*)src + F.lane; f32x4* d4 = (f32x4*)(X + (size_t)r * D) + F.lane;
#pragma unroll
          for (int j = 0; j < 4; ++j) d4[64 * j] = s4[64 * j]; } }
    { f32x2* TA = (f32x2*)(F.ws + WS_TABA); f32x2* TM = (f32x2*)(F.ws + WS_TABM);
      for (int i = blockIdx.x * NTHR + F.tid; i < SEQ * 32; i += GRID * NTHR) { const int pos = i >> 5, a = i & 31; const float p = (a < 16) ? (float)(pos >> 6) : (float)(pos & 63);
          const float inv = fast_exp2(-(float)(a & 15) * (13.287712379549449f / 16.0f)); const float rev = p * inv * 0.15915494309189535f; TA[i] = (f32x2){__builtin_amdgcn_cosf(rev), __builtin_amdgcn_sinf(rev)}; }
      for (int i = blockIdx.x * NTHR + F.tid; i < SEQ * 16; i += GRID * NTHR) { const int pos = i >> 4, a = i & 15; const float p = (a < 8) ? (float)(pos >> 6) : (float)(pos & 63);
          const float inv = fast_exp2(-(float)(a & 7) * (13.287712379549449f / 8.0f)); const float rev = p * inv * 0.15915494309189535f; TM[i] = (f32x2){__builtin_amdgcn_cosf(rev), __builtin_amdgcn_sinf(rev)}; } }
    { LAS float* sc = (LAS float*)F.lds;
      LAS float* part = (LAS float*)(F.lds + 40960);
      for (int i = F.tid; i < 9 * 1024; i += NTHR) { const int r = i >> 10, k = i & 1023; const float c = r < 8 ? in[1][r * 1024 + k] : in[3][k]; sc[i] = silu_f(c); }
      __syncthreads();
      float* MOD = (float*)(F.ws + WS_MOD);
      for (int u = F.vcu; u < 4 * 96; u += GRID) { const int l = u / 96, cb = u % 96, col = cb * 64 + (F.tid & 63), ks = F.tid >> 6;
          const float* w = in[6] + (size_t)l * 1024 * 6144 + col; float a[9];
#pragma unroll
          for (int r = 0; r < 9; ++r) a[r] = 0.f;
#pragma unroll 8
          for (int k = ks * 128; k < ks * 128 + 128; ++k) { const float wv = w[(size_t)k * 6144];
#pragma unroll
              for (int r = 0; r < 9; ++r) a[r] += sc[r * 1024 + k] * wv; }
#pragma unroll
          for (int r = 0; r < 9; ++r) part[(ks * 9 + r) * 64 + (F.tid & 63)] = a[r];
          __syncthreads();
          for (int i = F.tid; i < 9 * 64; i += NTHR) { const int r = i >> 6, c = i & 63; float s = 0.f;
#pragma unroll
              for (int q = 0; q < 8; ++q) s += part[(q * 9 + r) * 64 + c];
              MOD[((size_t)l * 9 + r) * 6144 + cb * 64 + c] = s + in[7][l * 6144 + cb * 64 + c]; }
          __syncthreads(); } }
}

__device__ __forceinline__ void phase_norm2_route(Frame& F, const float* const* in, int layer) {
    constexpr int RPW = M / GRID;
    LAS float* wl = (LAS float*)F.lds;
    LAS int* lcnt = (LAS int*)(F.lds + 81920);
    LAS int* lbase = (LAS int*)(F.lds + 81920 + 128);
    LAS int* rcls = (LAS int*)(F.lds + 81920 + 256);
    LAS int* rrank = (LAS int*)(F.lds + 81920 + 256 + 1024);
    LAS float* lgw = (LAS float*)(F.lds + 81920 + 4096);
    const float* wrg = in[8] + (size_t)layer * 1024 * 4; const float* wre = in[10] + (size_t)layer * 1024 * 16;
    for (int i = F.tid; i < 1024 * 4; i += NTHR) { const int k = i >> 2, o = i & 3; wl[o * 1024 + k] = wrg[i]; }
    for (int i = F.tid; i < 1024 * 16; i += NTHR) { const int k = i >> 4, o = i & 15; wl[(4 + o) * 1024 + k] = wre[i]; }
    if (F.tid < 24) lcnt[F.tid] = 0;
    __syncthreads();
    const float* X = (const float*)(F.ws + WS_X); bf16* H = (bf16*)(F.ws + WS_H);
    const float* g = in[5] + layer * D; const float* mod = (const float*)(F.ws + WS_MOD) + (size_t)layer * 9 * 6144;
    const float* brg = in[9] + layer * 4; const float* bre = in[11] + layer * 16;
    float* WT = (float*)(F.ws + MOE_WT); int* SL = (int*)(F.ws + MOE_SL);
    const int row0 = blockIdx.x * RPW;
    for (int i = F.wave; i < RPW; i += NWAVES) { const int r = row0 + i; const float* mr = mod + (size_t)modrow_of(r) * 6144; f32x4 hv[4];
        norm_mod_row(X + (size_t)r * D, g, mr + 4 * 1024, mr + 3 * 1024, H + (size_t)r * D, F.lane, hv);
        LAS float* lgs = lgw + F.wave * 32;
        for (int o = 0; o < 20; ++o) { float s = 0.f;
#pragma unroll
            for (int j = 0; j < 4; ++j) { const f32x4 w = *(const LAS f32x4*)(wl + o * 1024 + 4 * F.lane + 256 * j); s += (hv[j].x * w.x + hv[j].y * w.y) + (hv[j].z * w.z + hv[j].w * w.w); }
            s = wave_sum(s); if (F.lane == 0) lgs[o] = s; }
        LDS_WAIT(); asm volatile("" ::: "memory");
        float g0 = lgs[0] + brg[0], g1 = lgs[1] + brg[1], g2 = lgs[2] + brg[2], g3 = lgs[3] + brg[3];
        int gs = 0; float gm = g0; if (g1 > gm) { gm = g1; gs = 1; } if (g2 > gm) { gm = g2; gs = 2; } if (g3 > gm) { gm = g3; gs = 3; }
        const float pg = 1.0f / (fast_exp(g0 - gm) + fast_exp(g1 - gm) + fast_exp(g2 - gm) + fast_exp(g3 - gm));
        float e0 = lgs[4 + gs * 4 + 0] + bre[gs * 4 + 0], e1 = lgs[4 + gs * 4 + 1] + bre[gs * 4 + 1], e2 = lgs[4 + gs * 4 + 2] + bre[gs * 4 + 2], e3 = lgs[4 + gs * 4 + 3] + bre[gs * 4 + 3];
        LDS_WAIT(); asm volatile("" ::: "memory");
        int i1 = 0; float v1 = e0; if (e1 > v1) { v1 = e1; i1 = 1; } if (e2 > v1) { v1 = e2; i1 = 2; } if (e3 > v1) { v1 = e3; i1 = 3; }
        int i2 = -1; float v2 = -3.0e38f;
        if (i1 != 0 && e0 > v2) { v2 = e0; i2 = 0; } if (i1 != 1 && e1 > v2) { v2 = e1; i2 = 1; } if (i1 != 2 && e2 > v2) { v2 = e2; i2 = 2; } if (i1 != 3 && e3 > v2) { v2 = e3; i2 = 3; }
        const float ex = fast_exp(v2 - v1), w1 = pg / (1.0f + ex), w2 = pg * ex / (1.0f + ex);
        const int lo = i1 < i2 ? i1 : i2, hi = i1 < i2 ? i2 : i1; const float wlo = i1 < i2 ? w1 : w2, whi = i1 < i2 ? w2 : w1;
        const int pair = lo == 0 ? hi - 1 : (lo == 1 ? hi + 1 : 5);
        const int cls = gs * 6 + pair;
        if (F.lane == 0) { WT[2 * (size_t)r] = wlo; WT[2 * (size_t)r + 1] = whi; rcls[i] = cls; rrank[i] = atomicAdd((int*)&lcnt[cls], 1); }
    }
    __syncthreads();
    if (F.tid < 24) lbase[F.tid] = (int)atomicAdd(F.ctl + CW_MOECNT + layer * 64 + F.tid, (unsigned)lcnt[F.tid]);
    __syncthreads();
    for (int i = F.tid; i < RPW; i += NTHR) { const int c = rcls[i]; SL[(size_t)c * M + lbase[c] + rrank[i]] = row0 + i; }
}

__device__ __forceinline__ void phase_final(Frame& F, const float* const* in, bool poison) {
    const float* X = (const float*)(F.ws + WS_X); const float* g = in[36];
    const int gw = F.vcu * NWAVES + F.wave, NGW = GRID * NWAVES;
    for (int q = gw; q < NB * SEQ; q += NGW) { const int b = q / SEQ, p = q - b * SEQ; const int r = b * TPB + CTX + p;
        const f32x4* xr = (const f32x4*)(X + (size_t)r * D) + F.lane; f32x4 v[4]; float s = 0.f;
#pragma unroll
        for (int j = 0; j < 4; ++j) { v[j] = xr[64 * j]; s += (v[j].x * v[j].x + v[j].y * v[j].y) + (v[j].z * v[j].z + v[j].w * v[j].w); }
        float rstd = rsqrtf(wave_sum(s) * (1.f / D) + EPS); if (poison) rstd = __builtin_nanf("");
        f32x4* o = (f32x4*)(F.out + (size_t)q * D) + F.lane;
#pragma unroll
        for (int j = 0; j < 4; ++j) o[64 * j] = v[j] * rstd * ((const f32x4*)g)[F.lane + 64 * j]; }
}
typedef f32x4 AccT[2][2][4][2];
using pg8::Unit;

__device__ __forceinline__ v4u pack8(const f32x4 a, const f32x4 b) { v4u w; w.x = cvt_pk_bf16(a[0], a[1]); w.y = cvt_pk_bf16(a[2], a[3]); w.z = cvt_pk_bf16(b[0], b[1]); w.w = cvt_pk_bf16(b[2], b[3]); return w; }
__device__ __forceinline__ void rope8(f32x4& a, f32x4& b, const f32x2* cs) {
    const f32x4 c01 = *(const f32x4*)cs, c23 = *(const f32x4*)(cs + 2);
    float t;
    t = a[0] * c01[0] - a[1] * c01[1]; a[1] = a[1] * c01[0] + a[0] * c01[1]; a[0] = t;
    t = a[2] * c01[2] - a[3] * c01[3]; a[3] = a[3] * c01[2] + a[2] * c01[3]; a[2] = t;
    t = b[0] * c23[0] - b[1] * c23[1]; b[1] = b[1] * c23[0] + b[0] * c23[1]; b[0] = t;
    t = b[2] * c23[2] - b[3] * c23[3]; b[3] = b[3] * c23[2] + b[2] * c23[3]; b[2] = t;
}

struct EpiResid {
    static constexpr bool PERM = false;
    float* X; const float* gate;
    __device__ __forceinline__ void operator()(const AccT& acc, const Unit& u, int ui, int wr, int wc, int fr, int fq) const {
        const int tb = u.pm % 17, b = u.pm / 17; const float* gv = gate + (size_t)(tb == 0 ? 8 : b) * 6144;
        const int row0 = u.pm * 256 + wr * 64 + fr, col0 = u.pn * 256 + wc * 32 + 4 * fq;
        f32x4 g4[2][2];
#pragma unroll
        for (int bj = 0; bj < 2; ++bj)
#pragma unroll
            for (int n = 0; n < 2; ++n) g4[bj][n] = *(const f32x4*)(gv + col0 + bj * 128 + n * 16);
#pragma unroll
        for (int ai = 0; ai < 2; ++ai)
#pragma unroll
            for (int m = 0; m < 4; ++m) { float* rowp = X + (size_t)(row0 + ai * 128 + m * 16) * D + col0;
#pragma unroll
                for (int bj = 0; bj < 2; ++bj)
#pragma unroll
                    for (int n = 0; n < 2; ++n) { f32x4* p = (f32x4*)(rowp + bj * 128 + n * 16); *p = *p + g4[bj][n] * acc[ai][bj][m][n]; }
                asm volatile("" ::: "memory"); }
    }
};

struct EpiAttnIn {
    static constexpr bool PERM = true;
    bf16 *Q, *Kb, *Vb; const f32x2* tab; float qscale;
    __device__ __forceinline__ void operator()(const AccT& acc, const Unit& u, int ui, int wr, int wc, int fr, int fq) const {
        const int tb = u.pm % 17; const bool lat = tb != 0; const int pos0 = (tb - 1) * 256;
        bf16* base; int ld, colt; float sc = 1.f; bool rope = lat;
        if (u.pn < 4) { base = Q; ld = 1024; colt = u.pn * 256; sc = qscale; } else if (u.pn == 4) { base = Kb; ld = 256; colt = 0; } else { base = Vb; ld = 256; colt = 0; rope = false; }
#pragma unroll
        for (int ai = 0; ai < 2; ++ai)
#pragma unroll
            for (int m = 0; m < 4; ++m) { const int rl = ai * 128 + wr * 64 + m * 16 + fr; const size_t row = (size_t)u.pm * 256 + rl;
#pragma unroll
                for (int bj = 0; bj < 2; ++bj) { const int cl = bj * 128 + wc * 32 + 8 * fq;
                    f32x4 a = acc[ai][bj][m][0] * sc, b = acc[ai][bj][m][1] * sc;
                    if (rope) rope8(a, b, tab + (size_t)(pos0 + rl) * 32 + ((cl & 63) >> 1));
                    *(v4u*)(base + row * ld + colt + cl) = pack8(a, b); }
                asm volatile("" ::: "memory"); }
    }
};

struct EpiSsmIn {
    static constexpr bool PERM = true;
    bf16 *Z, *XBC; float* DT; const float* dtb;
    __device__ __forceinline__ void operator()(const AccT& acc, const Unit& u, int ui, int wr, int wc, int fr, int fq) const {
#pragma unroll
        for (int ai = 0; ai < 2; ++ai)
#pragma unroll
            for (int m = 0; m < 4; ++m) { const size_t row = (size_t)u.pm * 256 + ai * 128 + wr * 64 + m * 16 + fr;
#pragma unroll
                for (int bj = 0; bj < 2; ++bj) { const int c = u.pn * 256 + bj * 128 + wc * 32 + 8 * fq;
                    const f32x4 a = acc[ai][bj][m][0], b = acc[ai][bj][m][1];
                    if (c < 1024) *(v4u*)(Z + row * 1024 + c) = pack8(a, b);
                    else if (c < 2560) *(v4u*)(XBC + row * 1536 + (c - 1024)) = pack8(a, b);
                    else if (c < 2592) { const int cc = c - 2560; f32x4 o0, o1;
#pragma unroll
                        for (int j = 0; j < 4; ++j) { o0[j] = softplus_f(a[j] + dtb[(cc >> 4) * 32 + (cc & 15) + j]); o1[j] = softplus_f(b[j] + dtb[(cc >> 4) * 32 + (cc & 15) + 4 + j]); }
                        *(f32x4*)(DT + row * 32 + cc) = o0; *(f32x4*)(DT + row * 32 + cc + 4) = o1; } } }
    }
};

struct EpiMlIn {
    static constexpr bool PERM = true;
    bf16 *Qm, *Km, *Vm, *Om; float* G; const float* gb;
    __device__ __forceinline__ void operator()(const AccT& acc, const Unit& u, int ui, int wr, int wc, int fr, int fq) const {
#pragma unroll
        for (int ai = 0; ai < 2; ++ai)
#pragma unroll
            for (int m = 0; m < 4; ++m) { const size_t row = (size_t)u.pm * 256 + ai * 128 + wr * 64 + m * 16 + fr;
#pragma unroll
                for (int bj = 0; bj < 2; ++bj) { const int c = u.pn * 256 + bj * 128 + wc * 32 + 8 * fq;
                    const f32x4 a = acc[ai][bj][m][0], b = acc[ai][bj][m][1];
                    if (c < 512) *(v4u*)(Qm + row * 512 + c) = pack8(a, b);
                    else if (c < 1024) *(v4u*)(Km + row * 512 + (c - 512)) = pack8(a * 0.125f, b * 0.125f);
                    else if (c < 2048) *(v4u*)(Vm + row * 1024 + (c - 1024)) = pack8(a, b);
                    else if (c < 3072) *(v4u*)(Om + row * 1024 + (c - 2048)) = pack8(a, b);
                    else if (c < 3104) { const int cc = c - 3072; f32x4 o0, o1; const bool fg = ((cc >> 3) & 1) != 0;
#pragma unroll
                        for (int j = 0; j < 4; ++j) { float x0 = a[j] + gb[cc + j], x1 = b[j] + gb[cc + 4 + j];
                            o0[j] = fg ? -softplus_f(-x0) : x0; o1[j] = fg ? -softplus_f(-x1) : x1; }
                        *(f32x4*)(G + row * 32 + cc) = o0; *(f32x4*)(G + row * 32 + cc + 4) = o1; } } }
    }
};

struct EpiMlaIn {
    static constexpr bool PERM = true;
    bf16 *CQ, *CKV, *KF; float* SSQ; const f32x2* tab;
    __device__ __forceinline__ void operator()(const AccT& acc, const Unit& u, int ui, int wr, int wc, int fr, int fq) const {
        const int tb = u.pm % 17; const bool lat = tb != 0; const int pos0 = (tb - 1) * 256;
#pragma unroll
        for (int ai = 0; ai < 2; ++ai)
#pragma unroll
            for (int m = 0; m < 4; ++m) { const int rl = ai * 128 + wr * 64 + m * 16 + fr; const size_t row = (size_t)u.pm * 256 + rl;
                if (u.pn < 2) { bf16* dst = u.pn == 0 ? CQ : CKV; float ss = 0.f;
#pragma unroll
                    for (int bj = 0; bj < 2; ++bj) { const int c = bj * 128 + wc * 32 + 8 * fq; const f32x4 a = acc[ai][bj][m][0], b = acc[ai][bj][m][1];
                        ss += (a[0] * a[0] + a[1] * a[1]) + (a[2] * a[2] + a[3] * a[3]) + (b[0] * b[0] + b[1] * b[1]) + (b[2] * b[2] + b[3] * b[3]);
                        *(v4u*)(dst + row * 256 + c) = pack8(a, b); }
                    ss += __shfl_xor(ss, 16); ss += __shfl_xor(ss, 32);
                    if (fq == 0) SSQ[row * 8 + u.pn * 4 + wc] = ss;
                } else if (wc == 0) {
                    f32x4 a = acc[ai][0][m][0], b = acc[ai][0][m][1]; const int cl = 8 * fq;
                    if (lat) rope8(a, b, tab + (size_t)(pos0 + rl) * 16 + (cl >> 1));
                    const v4u w = pack8(a, b);
#pragma unroll
                    for (int h = 0; h < 16; ++h) *(v4u*)(KF + row * 1536 + h * 96 + 64 + cl) = w; }
                asm volatile("" ::: "memory"); }
    }
};
struct EpiMlaQ {
    static constexpr bool PERM = true;
    bf16* Q3; const float* SSQ; const f32x2* tab; float qscale;
    __device__ __forceinline__ void operator()(const AccT& acc, const Unit& u, int ui, int wr, int wc, int fr, int fq) const {
        const int tb = u.pm % 17; const bool lat = tb != 0; const int pos0 = (tb - 1) * 256;
#pragma unroll
        for (int ai = 0; ai < 2; ++ai)
#pragma unroll
            for (int m = 0; m < 4; ++m) { const int rl = ai * 128 + wr * 64 + m * 16 + fr; const size_t row = (size_t)u.pm * 256 + rl;
                const f32x4 s4 = *(const f32x4*)(SSQ + row * 8); const float rs = rsqrtf(((s4[0] + s4[1]) + (s4[2] + s4[3])) * (1.f / 256.f) + EPS) * qscale;
#pragma unroll
                for (int bj = 0; bj < 2; ++bj) { const int c = u.pn * 256 + bj * 128 + wc * 32 + 8 * fq; const int e = c % 96;
                    f32x4 a = acc[ai][bj][m][0] * rs, b = acc[ai][bj][m][1] * rs;
                    if (lat && e >= 64) rope8(a, b, tab + (size_t)(pos0 + rl) * 16 + ((e - 64) >> 1));
                    *(v4u*)(Q3 + row * 1536 + c) = pack8(a, b); }
                asm volatile("" ::: "memory"); }
    }
};
struct EpiMlaKV {
    static constexpr bool PERM = true;
    bf16 *KF, *V3; const float* SSQ;
    __device__ __forceinline__ void operator()(const AccT& acc, const Unit& u, int ui, int wr, int wc, int fr, int fq) const {
#pragma unroll
        for (int ai = 0; ai < 2; ++ai)
#pragma unroll
            for (int m = 0; m < 4; ++m) { const size_t row = (size_t)u.pm * 256 + ai * 128 + wr * 64 + m * 16 + fr;
                const f32x4 s4 = *(const f32x4*)(SSQ + row * 8 + 4); const float rs = rsqrtf(((s4[0] + s4[1]) + (s4[2] + s4[3])) * (1.f / 256.f) + EPS);
#pragma unroll
                for (int bj = 0; bj < 2; ++bj) { const int c = u.pn * 256 + bj * 128 + wc * 32 + 8 * fq; const int h = c >> 7, e = c & 127;
                    const v4u w = pack8(acc[ai][bj][m][0] * rs, acc[ai][bj][m][1] * rs);
                    if (e < 64) *(v4u*)(KF + row * 1536 + h * 96 + e) = w; else *(v4u*)(V3 + row * 1024 + h * 64 + (e - 64)) = w; }
                asm volatile("" ::: "memory"); }
    }
};

struct TblEnt { int tok; float w0, w1; int pad; };
__device__ __forceinline__ int cls_expert(int cls, int which) { const int g = cls / 6, p = cls - g * 6; const int lo = p < 3 ? 0 : (p < 5 ? 1 : 2), hi = p < 3 ? p + 1 : (p < 5 ? p - 1 : 3); return g * 4 + (which ? hi : lo); }
template <int MODE> struct MoeOrder {
    static constexpr bool GATHER = (MODE == 0);
    const LAS int* tb;
    const LAS TblEnt* tbl;
    const bf16* W; int G, c;
    __device__ __forceinline__ bool next(int i, Unit& u) const {
        const int L = i * G + c, tile = L >> 2; if (tile >= tb[24]) return false;
        int cls = 0;
#pragma unroll
        for (int k = 1; k < 24; ++k) cls += (tile >= tb[k]) ? 1 : 0;
        u.pm = tile; u.pn = L & 3; u.aux = cls | (i << 8); return true;
    }
    __device__ __forceinline__ int a_row(const Unit& u, int r) const {
        if (MODE == 1) return u.pm * 256 + r;
        const int t = tbl[(u.aux >> 8) * 256 + r].tok; return t < 0 ? 0 : t;
    }
    __device__ __forceinline__ const char* b_seg(const Unit& u, int seg) const {
        const int cls = u.aux & 255;
        if (MODE == 0) return (const char*)(W + ((size_t)cls_expert(cls, u.pn >> 1) * 512 + (u.pn & 1) * 256) * 1024);
        return (const char*)(W + ((size_t)cls_expert(cls, seg) * 1024 + u.pn * 256) * 256);
    }
};
template <int MODE> __device__ __forceinline__ void moe_setup(Frame& F, int layer, MoeOrder<MODE>& S) {
    LAS int* tb = (LAS int*)(F.lds + LDS_TB); LAS int* cn = tb + 32; LAS TblEnt* tbl = (LAS TblEnt*)(F.lds + LDS_TBL);
    if (F.tid == 0) { int t = 0; for (int k = 0; k < 24; ++k) { const int n = (int)__hip_atomic_load(F.ctl + CW_MOECNT + layer * 64 + k, RLX_AGENT); cn[k] = n; tb[k] = t; t += (n + 255) >> 8; } tb[24] = t; }
    __syncthreads();
    S.tb = tb; S.tbl = tbl;
    const int* SL = (const int*)(F.ws + MOE_SL); const float* WT = (const float*)(F.ws + MOE_WT);
    for (int i = 0; i < 4; ++i) { Unit u; if (!S.next(i, u)) break;
        if (F.tid < 256) { const int cls = u.aux & 255, idx = (u.pm - tb[cls]) * 256 + F.tid; TblEnt e; e.pad = 0;
            if (idx < cn[cls]) { e.tok = SL[(size_t)cls * M + idx]; e.w0 = WT[2 * (size_t)e.tok]; e.w1 = WT[2 * (size_t)e.tok + 1]; } else { e.tok = -1; e.w0 = 0.f; e.w1 = 0.f; }
            LAS TblEnt* te = tbl + i * 256 + F.tid; te->tok = e.tok; te->w0 = e.w0; te->w1 = e.w1; te->pad = 0; } }
    __syncthreads();
}
struct EpiMoeAct {
    static constexpr bool PERM = true;
    bf16* ACT; const LAS TblEnt* tbl;
    __device__ __forceinline__ void operator()(const AccT& acc, const Unit& u, int ui, int wr, int wc, int fr, int fq) const {
        const int slot = u.pn >> 1, colb = slot * 256 + (u.pn & 1) * 128 + wc * 32 + 8 * fq;
#pragma unroll
        for (int ai = 0; ai < 2; ++ai)
#pragma unroll
            for (int m = 0; m < 4; ++m) { const int rl = ai * 128 + wr * 64 + m * 16 + fr; const LAS TblEnt* te = tbl + (u.aux >> 8) * 256 + rl; const float w = slot ? te->w1 : te->w0;
                f32x4 a, b;
#pragma unroll
                for (int j = 0; j < 4; ++j) { a[j] = silu_f(acc[ai][0][m][0][j]) * acc[ai][1][m][0][j] * w; b[j] = silu_f(acc[ai][0][m][1][j]) * acc[ai][1][m][1][j] * w; }
                *(v4u*)(ACT + ((size_t)u.pm * 256 + rl) * 512 + colb) = pack8(a, b);
                asm volatile("" ::: "memory"); }
    }
};
struct EpiMoeDown {
    static constexpr bool PERM = false;
    float* X; const float* gate; const LAS TblEnt* tbl;
    __device__ __forceinline__ void operator()(const AccT& acc, const Unit& u, int ui, int wr, int wc, int fr, int fq) const {
        const int col0 = u.pn * 256 + wc * 32 + 4 * fq;
#pragma unroll
        for (int ai = 0; ai < 2; ++ai)
#pragma unroll
            for (int m = 0; m < 4; ++m) { const int rl = ai * 128 + wr * 64 + m * 16 + fr; const int tok = tbl[(u.aux >> 8) * 256 + rl].tok;
                if (tok >= 0) { float* rowp = X + (size_t)tok * D + col0; const float* gv = gate + (size_t)modrow_of(tok) * 6144 + col0;
#pragma unroll
                    for (int bj = 0; bj < 2; ++bj)
#pragma unroll
                        for (int n = 0; n < 2; ++n) { f32x4* p = (f32x4*)(rowp + bj * 128 + n * 16); *p = *p + *(const f32x4*)(gv + bj * 128 + n * 16) * acc[ai][bj][m][n]; } }
                asm volatile("" ::: "memory"); }
    }
};
template <int DQK, bool WIN>
__device__ __forceinline__ void flash_unit(LAS unsigned char* lds, const int tid, const int lane,
        const bf16* Kg, const int ldk, const bf16* Vg, const int ldv,
        const bf16* Qg, const int ldq, bf16* Og, const int ldo,
        const int ntiles, const int krow_ctx0, const int krow_lat0, const int kpos0, const int qpos_wave, const float sink2, const bool has_sink) {
    constexpr int KSTR = DQK * 2 + 16, VSTR = 160, KBUF = 64 * KSTR, VBUF = 64 * VSTR, CPR = DQK / 8, NKC = 64 * CPR, NKR = (NKC + 511) / 512, NKS = DQK / 32;
    LAS unsigned char* Kl = lds; LAS unsigned char* Vl = lds + 2 * KBUF;
    const int fr = lane & 15, fq = lane >> 4;
    bf16x8 qf[2][NKS];
#pragma unroll
    for (int qt = 0; qt < 2; ++qt)
#pragma unroll
        for (int ks = 0; ks < NKS; ++ks) qf[qt][ks] = *(const bf16x8*)(Qg + (size_t)(16 * qt + fr) * ldq + 32 * ks + 8 * fq);
    f32x4 oacc[4][2];
#pragma unroll
    for (int c = 0; c < 4; ++c) { oacc[c][0] = (f32x4){0.f, 0.f, 0.f, 0.f}; oacc[c][1] = (f32x4){0.f, 0.f, 0.f, 0.f}; }
    float mrun[2] = {-1.0e30f, -1.0e30f}, lsum[2] = {0.f, 0.f};
    v4u kreg[NKR], vreg;
#define FA_LOAD(j) do { const int _rb = (j) < 4 ? krow_ctx0 + 64 * (j) : krow_lat0 + 64 * ((j) - 4); \
        _Pragma("unroll") for (int _i = 0; _i < NKR; ++_i) { const int _c = tid + 512 * _i; if (_c < NKC) kreg[_i] = *(const v4u*)(Kg + (size_t)(_rb + _c / CPR) * ldk + (_c % CPR) * 8); } \
        vreg = *(const v4u*)(Vg + (size_t)(_rb + (tid >> 3)) * ldv + (tid & 7) * 8); } while (0)
#define FA_STORE(buf) do { _Pragma("unroll") for (int _i = 0; _i < NKR; ++_i) { const int _c = tid + 512 * _i; if (_c < NKC) *(LAS v4u*)(Kl + (buf) * KBUF + (_c / CPR) * KSTR + (_c % CPR) * 16) = kreg[_i]; } \
        *(LAS v4u*)(Vl + (buf) * VBUF + (tid >> 3) * VSTR + (tid & 7) * 16) = vreg; } while (0)
    FA_LOAD(0); FA_STORE(0); __syncthreads();
    for (int j = 0; j < ntiles; ++j) {
        const int buf = j & 1;
        if (j + 1 < ntiles) FA_LOAD(j + 1);
        bool skip = false; const int kp = kpos0 + 64 * (j - 4);
        if (WIN && j >= 4) skip = (kp + 63 < qpos_wave - 128) || (kp > qpos_wave + 31 + 128);
        if (!skip) {
            f32x4 sacc[4][2];
#pragma unroll
            for (int kt = 0; kt < 4; ++kt) { sacc[kt][0] = (f32x4){0.f, 0.f, 0.f, 0.f}; sacc[kt][1] = (f32x4){0.f, 0.f, 0.f, 0.f}; }
#pragma unroll
            for (int ks = 0; ks < NKS; ++ks) { bf16x8 kf[4];
#pragma unroll
                for (int kt = 0; kt < 4; ++kt) kf[kt] = *(const LAS bf16x8*)(Kl + buf * KBUF + (16 * kt + fr) * KSTR + (32 * ks + 8 * fq) * 2);
#pragma unroll
                for (int kt = 0; kt < 4; ++kt) { sacc[kt][0] = __builtin_amdgcn_mfma_f32_16x16x32_bf16(kf[kt], qf[0][ks], sacc[kt][0], 0, 0, 0);
                                                 sacc[kt][1] = __builtin_amdgcn_mfma_f32_16x16x32_bf16(kf[kt], qf[1][ks], sacc[kt][1], 0, 0, 0); } }
            if (WIN && j >= 4) {
#pragma unroll
                for (int kt = 0; kt < 4; ++kt)
#pragma unroll
                    for (int qt = 0; qt < 2; ++qt)
#pragma unroll
                        for (int jj = 0; jj < 4; ++jj) { const int d = (kp + 16 * kt + 4 * fq + jj) - (qpos_wave + 16 * qt + fr); if (d < -128 || d > 128) sacc[kt][qt][jj] = -1.0e30f; } }
            bf16x8 pf[2][2];
#pragma unroll
            for (int qt = 0; qt < 2; ++qt) {
                float mx = sacc[0][qt][0];
#pragma unroll
                for (int kt = 0; kt < 4; ++kt)
#pragma unroll
                    for (int jj = 0; jj < 4; ++jj) mx = fmaxf(mx, sacc[kt][qt][jj]);
                mx = fmaxf(mx, __shfl_xor(mx, 16)); mx = fmaxf(mx, __shfl_xor(mx, 32));
                const float mnew = fmaxf(mrun[qt], mx), alpha = fast_exp2(mrun[qt] - mnew); mrun[qt] = mnew;
                float ps = 0.f;
#pragma unroll
                for (int kt = 0; kt < 4; ++kt)
#pragma unroll
                    for (int jj = 0; jj < 4; ++jj) { const float p = fast_exp2(sacc[kt][qt][jj] - mnew); sacc[kt][qt][jj] = p; ps += p; }
                lsum[qt] = lsum[qt] * alpha + ps;
#pragma unroll
                for (int c = 0; c < 4; ++c) oacc[c][qt] = oacc[c][qt] * alpha;
#pragma unroll
                for (int ks2 = 0; ks2 < 2; ++ks2) { const v4u w = pack8(sacc[2 * ks2][qt], sacc[2 * ks2 + 1][qt]); pf[qt][ks2] = __builtin_bit_cast(bf16x8, w); }
            }
#pragma unroll
            for (int ks2 = 0; ks2 < 2; ++ks2)
#pragma unroll
                for (int c = 0; c < 4; ++c) {
                    const LAS unsigned char* vb = Vl + buf * VBUF + (32 * ks2 + 4 * fq + ((lane & 15) >> 2)) * VSTR + (16 * c + 4 * (lane & 3)) * 2;
                    const s16x4 v0 = __builtin_amdgcn_ds_read_tr16_b64_v4i16((LAS s16x4*)vb);
                    const s16x4 v1 = __builtin_amdgcn_ds_read_tr16_b64_v4i16((LAS s16x4*)(vb + 16 * VSTR));
                    bf16x8 vf; vf[0] = v0[0]; vf[1] = v0[1]; vf[2] = v0[2]; vf[3] = v0[3]; vf[4] = v1[0]; vf[5] = v1[1]; vf[6] = v1[2]; vf[7] = v1[3];
                    oacc[c][0] = __builtin_amdgcn_mfma_f32_16x16x32_bf16(vf, pf[0][ks2], oacc[c][0], 0, 0, 0);
                    oacc[c][1] = __builtin_amdgcn_mfma_f32_16x16x32_bf16(vf, pf[1][ks2], oacc[c][1], 0, 0, 0); }
        }
        if (j + 1 < ntiles) FA_STORE(buf ^ 1);
        __syncthreads();
    }
#pragma unroll
    for (int qt = 0; qt < 2; ++qt) { float l = lsum[qt]; l += __shfl_xor(l, 16); l += __shfl_xor(l, 32); if (has_sink) l += fast_exp2(sink2 - mrun[qt]);
        const float inv = 1.0f / l;
#pragma unroll
        for (int c = 0; c < 4; ++c) { const f32x4 o = oacc[c][qt] * inv; v2u w; w.x = cvt_pk_bf16(o[0], o[1]); w.y = cvt_pk_bf16(o[2], o[3]);
            *(v2u*)(Og + (size_t)(16 * qt + fr) * ldo + 16 * c + 4 * fq) = w; } }
#undef FA_LOAD
#undef FA_STORE
}

__device__ __forceinline__ void phase_attn_window(Frame& F, const float* const* in, bf16* Q, const bf16* Kb, const bf16* Vb) {
    constexpr int NLAT = NB * 4 * 64, NCTX = NB * 4 * 4;
    for (int un = F.vcu; un < NLAT + NCTX; un += GRID) {
        int b, kvh, q0, ntiles, kpos0, qrow0;
        if (un < NLAT) { b = un >> 8; kvh = (un >> 6) & 3; q0 = (un & 63) * 64; kpos0 = q0 >= 128 ? q0 - 128 : 0; const int kend = q0 + 192 <= SEQ ? q0 + 192 : SEQ; ntiles = 4 + (kend - kpos0) / 64; qrow0 = b * TPB + CTX + q0; }
        else { const int v = un - NLAT; b = v >> 4; kvh = (v >> 2) & 3; q0 = (v & 3) * 64; kpos0 = 0; ntiles = 4; qrow0 = b * TPB + q0; }
        const int g = F.wave >> 1, half = F.wave & 1, head = kvh * 4 + g;
        bf16* qp = Q + (size_t)(qrow0 + 32 * half) * 1024 + head * 64;
        flash_unit<64, true>(F.lds, F.tid, F.lane, Kb + kvh * 64, 256, Vb + kvh * 64, 256, qp, 1024, qp, 1024,
                             ntiles, b * TPB, b * TPB + CTX + kpos0, kpos0, q0 + 32 * half, in[16][head] * LOG2E, true);
    }
}
__device__ __forceinline__ void phase_attn_mla(Frame& F, const bf16* Q3, const bf16* KF, const bf16* V3, bf16* O) {
    for (int un = F.vcu; un < NB * 16 * 16; un += GRID) { const int b = un >> 8, head = (un >> 4) & 15, qb = un & 15; const int qrow = b * TPB + CTX + qb * 256 + 32 * F.wave;
        flash_unit<96, false>(F.lds, F.tid, F.lane, KF + head * 96, 1536, V3 + head * 64, 1024, Q3 + (size_t)qrow * 1536 + head * 96, 1536, O + (size_t)qrow * 1024 + head * 64, 1024,
                              68, b * TPB, b * TPB + CTX, 0, 0, 0.f, false);
    }
}
__device__ __forceinline__ int scan_row(int dir, int tau) { return dir == 0 ? tau : (tau < CTX ? CTX - 1 - tau : (TPB + CTX - 1) - tau); }

__device__ __forceinline__ void phase_ssm_conv(Frame& F, const float* const* in, int gp, const bf16* XP, bf16* XS, bf16* BC, const float* DT, float* ACUM) {
    constexpr int RPW = M / GRID;
    if (F.tid < 384) {
    const int cg = F.tid % 192, rsub = F.tid / 192, c0 = cg * 8;
    const int oc = c0 < 1024 ? gp * 1024 + c0 : (c0 < 1280 ? 2048 + gp * 256 + (c0 - 1024) : 2560 + gp * 256 + (c0 - 1280));
    float w[5][8], bb[8];
#pragma unroll
    for (int k = 0; k < 5; ++k)
#pragma unroll
        for (int i = 0; i < 8; ++i) w[k][i] = in[19][k * 3072 + oc + i];
#pragma unroll
    for (int i = 0; i < 8; ++i) bb[i] = in[20][oc + i];
    const int row0 = blockIdx.x * RPW;
    for (int r = row0 + rsub; r < row0 + RPW; r += 2) { const int t = r % TPB; const int lo = t < CTX ? 0 : CTX, hi = t < CTX ? CTX : TPB;
        float a[8];
#pragma unroll
        for (int i = 0; i < 8; ++i) a[i] = bb[i];
#pragma unroll
        for (int k = 0; k < 5; ++k) { const int tt = t + k - 2; if (tt >= lo && tt < hi) { const v4u x = *(const v4u*)(XP + (size_t)(r + k - 2) * 1536 + c0);
                a[0] += w[k][0] * bflo(x.x); a[1] += w[k][1] * bfhi(x.x); a[2] += w[k][2] * bflo(x.y); a[3] += w[k][3] * bfhi(x.y);
                a[4] += w[k][4] * bflo(x.z); a[5] += w[k][5] * bfhi(x.z); a[6] += w[k][6] * bflo(x.w); a[7] += w[k][7] * bfhi(x.w); } }
        v4u o; o.x = cvt_pk_bf16(silu_f(a[0]), silu_f(a[1])); o.y = cvt_pk_bf16(silu_f(a[2]), silu_f(a[3])); o.z = cvt_pk_bf16(silu_f(a[4]), silu_f(a[5])); o.w = cvt_pk_bf16(silu_f(a[6]), silu_f(a[7]));
        if (c0 < 1024) *(v4u*)(XS + (size_t)r * 1024 + c0) = o; else *(v4u*)(BC + (size_t)r * 512 + (c0 - 1024)) = o; }
    } else {
        const int chain = blockIdx.x * 128 + (F.tid - 384);
        if (chain < NB * 2 * 16 * 68) { const int ck = chain % 68, hl = (chain / 68) & 15, dir = (chain / (68 * 16)) & 1, b = chain / (68 * 32);
            const float Ah = -fast_exp(in[22][dir * 32 + gp * 16 + hl]) * LOG2E; float acc = 0.f;
#pragma unroll 1
            for (int h2 = 0; h2 < 2; ++h2) { float dv[32];
#pragma unroll
                for (int s = 0; s < 32; ++s) dv[s] = DT[(size_t)(b * TPB + scan_row(dir, ck * 64 + h2 * 32 + s)) * 32 + dir * 16 + hl];
#pragma unroll
                for (int s = 0; s < 32; ++s) { acc += dv[s] * Ah; ACUM[(size_t)(b * TPB + scan_row(dir, ck * 64 + h2 * 32 + s)) * 32 + dir * 16 + hl] = acc; } } }
    }
}

__device__ __forceinline__ void phase_ssm_scan(Frame& F, const float* const* in, int gp, const bf16* XS, const bf16* BC, const float* DT, const bf16* Z, bf16* Y) {
    constexpr int T = 32;
    LAS float* Bf = (LAS float*)F.lds;
    LAS float* Cf = (LAS float*)(F.lds + 16384);
    LAS float* U = (LAS float*)(F.lds + 32768);
    LAS float* XT = (LAS float*)(F.lds + 40960);
    LAS float* DEC = (LAS float*)(F.lds + 49152);
    LAS float* PART = (LAS float*)(F.lds + 49152 + 256);
    const int it = blockIdx.x, b = it >> 5, hl = (it >> 1) & 15, ph = it & 1, head = gp * 16 + hl, gl = hl >> 3;
    const int col = hl * 64 + ph * 32;
    const int p = F.tid & 31, ns = F.tid >> 5;
    const float dskip = in[23][head] + in[23][32 + head];
    const int st = F.tid >> 4, sch = F.tid & 15;
    const int xt = F.tid >> 2, xch = F.tid & 3;
    for (int dir = 0; dir < 2; ++dir) {
        const float Ah = -fast_exp(in[22][dir * 32 + head]) * LOG2E;
        float S[8];
#pragma unroll
        for (int i = 0; i < 8; ++i) S[i] = 0.f;
        v4u rb, rc, rx; float rdt = 0.f;
#define SS_LOAD(tile) do { const int _rB = b * TPB + scan_row(dir, (tile) * T + st); rb = *(const v4u*)(BC + (size_t)_rB * 512 + gl * 128 + sch * 8); rc = *(const v4u*)(BC + (size_t)_rB * 512 + 256 + gl * 128 + sch * 8); \
            if (F.tid < 128) { const int _rX = b * TPB + scan_row(dir, (tile) * T + xt); rx = *(const v4u*)(XS + (size_t)_rX * 1024 + col + xch * 8); rdt = DT[(size_t)_rX * 32 + dir * 16 + hl]; } } while (0)
#define SS_STORE(nb) do { LAS float* _b = Bf + st * 128 + sch * 8; LAS float* _c = Cf + st * 128 + sch * 8; \
            *(LAS f32x4*)_b = (f32x4){bflo(rb.x), bfhi(rb.x), bflo(rb.y), bfhi(rb.y)}; *(LAS f32x4*)(_b + 4) = (f32x4){bflo(rb.z), bfhi(rb.z), bflo(rb.w), bfhi(rb.w)}; \
            *(LAS f32x4*)_c = (f32x4){bflo(rc.x), bfhi(rc.x), bflo(rc.y), bfhi(rc.y)}; *(LAS f32x4*)(_c + 4) = (f32x4){bflo(rc.z), bfhi(rc.z), bflo(rc.w), bfhi(rc.w)}; \
            if (F.tid < 128) { const f32x4 x0 = (f32x4){bflo(rx.x), bfhi(rx.x), bflo(rx.y), bfhi(rx.y)}, x1 = (f32x4){bflo(rx.z), bfhi(rx.z), bflo(rx.w), bfhi(rx.w)}; \
                LAS float* _x = XT + (nb) * 1024 + xt * 32 + xch * 8; LAS float* _u = U + (nb) * 1024 + xt * 32 + xch * 8; \
                *(LAS f32x4*)_x = x0; *(LAS f32x4*)(_x + 4) = x1; *(LAS f32x4*)_u = x0 * rdt; *(LAS f32x4*)(_u + 4) = x1 * rdt; \
                if (xch == 0) DEC[(nb) * 32 + xt] = fast_exp2(rdt * Ah); } } while (0)
        __syncthreads();
        SS_LOAD(0); SS_STORE(0); __syncthreads();
        constexpr int NT = TPB / T;
        for (int tile = 0; tile < NT; ++tile) { const int cb = tile & 1;
            if (tile + 1 < NT) SS_LOAD(tile + 1);
            const LAS float* u_ = U + cb * 1024 + p; const LAS float* d_ = DEC + cb * 32;
#pragma unroll 4
            for (int t = 0; t < T; ++t) {
                const float dec = d_[t], u = u_[t * 32];
                const f32x4 b0 = *(const LAS f32x4*)(Bf + t * 128 + ns * 8), b1 = *(const LAS f32x4*)(Bf + t * 128 + ns * 8 + 4);
                const f32x4 c0 = *(const LAS f32x4*)(Cf + t * 128 + ns * 8), c1 = *(const LAS f32x4*)(Cf + t * 128 + ns * 8 + 4);
                float pt = 0.f;
#pragma unroll
                for (int i = 0; i < 4; ++i) { S[i] = S[i] * dec + b0[i] * u; pt += c0[i] * S[i]; S[4 + i] = S[4 + i] * dec + b1[i] * u; pt += c1[i] * S[4 + i]; }
                pt += __shfl_xor(pt, 32);
                if (F.lane < 32) PART[(F.wave * 32 + t) * 32 + p] = pt;
            }
            __syncthreads();
#pragma unroll
            for (int k = 0; k < 2; ++k) { const int t = (F.tid >> 5) + 16 * k; float y = 0.f;
#pragma unroll
                for (int w = 0; w < 8; ++w) y += PART[(w * 32 + t) * 32 + p];
                const size_t ro = (size_t)(b * TPB + scan_row(dir, tile * T + t));
                if (dir == 0) Y[ro * 1024 + col + p] = (bf16)f2bf(y);
                else { const float yt = y + bf2f(Y[ro * 1024 + col + p]) + dskip * XT[cb * 1024 + t * 32 + p]; const float zz = bf2f(Z[ro * 1024 + col + p]);
                    Y[ro * 1024 + col + p] = (bf16)f2bf(yt * silu_f(zz)); } }
            if (tile + 1 < NT) SS_STORE(cb ^ 1);
            __syncthreads();
        }
#undef SS_LOAD
#undef SS_STORE
    }
}
__device__ __forceinline__ void phase_ssm_gnorm(Frame& F, const float* const* in, int gp, bf16* Y) {
    const int gw = F.vcu * NWAVES + F.wave, NGW = GRID * NWAVES; const float* ng = in[24] + gp * 1024 + 16 * F.lane;
    for (int r = gw; r < M; r += NGW) { v4u* p = (v4u*)(Y + (size_t)r * 1024 + 16 * F.lane); const v4u a = p[0], c = p[1];
        float v[16] = {bflo(a.x), bfhi(a.x), bflo(a.y), bfhi(a.y), bflo(a.z), bfhi(a.z), bflo(a.w), bfhi(a.w), bflo(c.x), bfhi(c.x), bflo(c.y), bfhi(c.y), bflo(c.z), bfhi(c.z), bflo(c.w), bfhi(c.w)};
        float ss = 0.f;
#pragma unroll
        for (int i = 0; i < 16; ++i) ss += v[i] * v[i];
#pragma unroll
        for (int o = 1; o < 32; o <<= 1) ss += __shfl_xor(ss, o);
        const float rs = rsqrtf(ss * (1.f / 512.f) + EPS);
        v4u o0, o1;
        o0.x = cvt_pk_bf16(v[0] * rs * ng[0], v[1] * rs * ng[1]); o0.y = cvt_pk_bf16(v[2] * rs * ng[2], v[3] * rs * ng[3]); o0.z = cvt_pk_bf16(v[4] * rs * ng[4], v[5] * rs * ng[5]); o0.w = cvt_pk_bf16(v[6] * rs * ng[6], v[7] * rs * ng[7]);
        o1.x = cvt_pk_bf16(v[8] * rs * ng[8], v[9] * rs * ng[9]); o1.y = cvt_pk_bf16(v[10] * rs * ng[10], v[11] * rs * ng[11]); o1.z = cvt_pk_bf16(v[12] * rs * ng[12], v[13] * rs * ng[13]); o1.w = cvt_pk_bf16(v[14] * rs * ng[14], v[15] * rs * ng[15]);
        p[0] = o0; p[1] = o1; }
}


__device__ __forceinline__ void phase_ssm_scan_mfma(Frame& F, const float* const* in, int gp, const bf16* XS, const bf16* BC, const float* DT, const float* ACUM, bf16* Yf, bf16* Yb) {
    constexpr int BSTR = 272, XSTR = 160;
    LAS unsigned char* Bl = F.lds;
    LAS unsigned char* Cl = F.lds + 17408;
    LAS unsigned char* Xl = F.lds + 34816;
    LAS unsigned char* Xw = F.lds + 45056;
    LAS float* AC = (LAS float*)(F.lds + 55296);
    LAS float* DTs = (LAS float*)(F.lds + 55296 + 256);
    LAS unsigned char* Sb = F.lds + 55808;
    const int it = blockIdx.x, b = it >> 5, dir = (it >> 4) & 1, hl = it & 15, gl = hl >> 3;
    bf16* Y = dir == 0 ? Yf : Yb;
    const int tid = F.tid, lane = F.lane, w = F.wave, fr = lane & 15, fq = lane >> 4, lq = (lane & 15) >> 2, lp = lane & 3;
    const int lt = w & 3, ph = w >> 2;
    for (int i = tid; i < 64 * BSTR / 16; i += NTHR) *(LAS v4u*)(Sb + i * 16) = (v4u){0u, 0u, 0u, 0u};
    f32x4 sacc[4];
#pragma unroll
    for (int i = 0; i < 4; ++i) sacc[i] = (f32x4){0.f, 0.f, 0.f, 0.f};
    v4u rB[2], rC[2], rX; float rac = 0.f, rdt = 0.f, rxs = 0.f;
    const int xr = tid >> 3, xc = tid & 7;
#define SM_LOAD(ck) do { _Pragma("unroll") for (int _i = 0; _i < 2; ++_i) { const int _c = tid + 512 * _i; const size_t _r = (size_t)(b * TPB + scan_row(dir, (ck) * 64 + (_c >> 4))); \
            rB[_i] = *(const v4u*)(BC + _r * 512 + gl * 128 + (_c & 15) * 8); rC[_i] = *(const v4u*)(BC + _r * 512 + 256 + gl * 128 + (_c & 15) * 8); } \
        { const size_t _r = (size_t)(b * TPB + scan_row(dir, (ck) * 64 + xr)); const size_t _rl = (size_t)(b * TPB + scan_row(dir, (ck) * 64 + 63)); rX = *(const v4u*)(XS + _r * 1024 + hl * 64 + xc * 8); \
          const float _a = ACUM[_r * 32 + dir * 16 + hl], _al = ACUM[_rl * 32 + dir * 16 + hl], _d = DT[_r * 32 + dir * 16 + hl]; rac = _a; rdt = _d; rxs = _d * fast_exp2(_al - _a); } } while (0)
#define SM_STORE() do { _Pragma("unroll") for (int _i = 0; _i < 2; ++_i) { const int _c = tid + 512 * _i; *(LAS v4u*)(Bl + (_c >> 4) * BSTR + (_c & 15) * 16) = rB[_i]; *(LAS v4u*)(Cl + (_c >> 4) * BSTR + (_c & 15) * 16) = rC[_i]; } \
        *(LAS v4u*)(Xl + xr * XSTR + xc * 16) = rX; \
        { v4u _o; _o.x = cvt_pk_bf16(bflo(rX.x) * rxs, bfhi(rX.x) * rxs); _o.y = cvt_pk_bf16(bflo(rX.y) * rxs, bfhi(rX.y) * rxs); _o.z = cvt_pk_bf16(bflo(rX.z) * rxs, bfhi(rX.z) * rxs); _o.w = cvt_pk_bf16(bflo(rX.w) * rxs, bfhi(rX.w) * rxs); \
          *(LAS v4u*)(Xw + xr * XSTR + xc * 16) = _o; } \
        if (xc == 0) { AC[xr] = rac; DTs[xr] = rdt; } } while (0)
    SM_LOAD(0); SM_STORE(); __syncthreads();
    for (int ck = 0; ck < 68; ++ck) { const int cur = ck & 1;
        if (ck + 1 < 68) SM_LOAD(ck + 1);
        const LAS unsigned char* Sc = Sb + cur * (64 * BSTR); LAS unsigned char* Sn = Sb + (cur ^ 1) * (64 * BSTR);
        bf16x8 cf[4];
#pragma unroll
        for (int ks = 0; ks < 4; ++ks) cf[ks] = *(const LAS bf16x8*)(Cl + (16 * lt + fr) * BSTR + (32 * ks + 8 * fq) * 2);
        const float acl = AC[16 * lt + fr];
        f32x4 yacc[2];
#pragma unroll
        for (int pi = 0; pi < 2; ++pi) { f32x4 a = (f32x4){0.f, 0.f, 0.f, 0.f};
#pragma unroll
            for (int ks = 0; ks < 4; ++ks) { const bf16x8 sf = *(const LAS bf16x8*)(Sc + (16 * (2 * ph + pi) + fr) * BSTR + (32 * ks + 8 * fq) * 2); a = __builtin_amdgcn_mfma_f32_16x16x32_bf16(sf, cf[ks], a, 0, 0, 0); }
            yacc[pi] = a * fast_exp2(acl); }
        f32x4 pm[4];
#pragma unroll
        for (int st = 0; st < 4; ++st) { pm[st] = (f32x4){0.f, 0.f, 0.f, 0.f};
            if (st <= lt) { f32x4 g = (f32x4){0.f, 0.f, 0.f, 0.f};
#pragma unroll
                for (int ks = 0; ks < 4; ++ks) { const bf16x8 bfr = *(const LAS bf16x8*)(Bl + (16 * st + fr) * BSTR + (32 * ks + 8 * fq) * 2); g = __builtin_amdgcn_mfma_f32_16x16x32_bf16(bfr, cf[ks], g, 0, 0, 0); }
                const f32x4 acs = *(const LAS f32x4*)(AC + 16 * st + 4 * fq), dts = *(const LAS f32x4*)(DTs + 16 * st + 4 * fq);
#pragma unroll
                for (int j = 0; j < 4; ++j) { const bool ok = (16 * st + 4 * fq + j) <= (16 * lt + fr); pm[st][j] = ok ? g[j] * fast_exp2(acl - acs[j]) * dts[j] : 0.f; } } }
#pragma unroll
        for (int ks2 = 0; ks2 < 2; ++ks2) { if (2 * ks2 <= lt) { const v4u pw = pack8(pm[2 * ks2], pm[2 * ks2 + 1]); const bf16x8 pf = __builtin_bit_cast(bf16x8, pw);
#pragma unroll
                for (int pi = 0; pi < 2; ++pi) { const LAS unsigned char* xb = Xl + (32 * ks2 + 4 * fq + lq) * XSTR + (16 * (2 * ph + pi) + 4 * lp) * 2;
                    const s16x4 v0 = __builtin_amdgcn_ds_read_tr16_b64_v4i16((LAS s16x4*)xb), v1 = __builtin_amdgcn_ds_read_tr16_b64_v4i16((LAS s16x4*)(xb + 16 * XSTR));
                    bf16x8 xf; xf[0] = v0[0]; xf[1] = v0[1]; xf[2] = v0[2]; xf[3] = v0[3]; xf[4] = v1[0]; xf[5] = v1[1]; xf[6] = v1[2]; xf[7] = v1[3];
                    yacc[pi] = __builtin_amdgcn_mfma_f32_16x16x32_bf16(xf, pf, yacc[pi], 0, 0, 0); } } }
        { const size_t ro = (size_t)(b * TPB + scan_row(dir, ck * 64 + 16 * lt + fr));
#pragma unroll
          for (int pi = 0; pi < 2; ++pi) { v2u o; o.x = cvt_pk_bf16(yacc[pi][0], yacc[pi][1]); o.y = cvt_pk_bf16(yacc[pi][2], yacc[pi][3]);
              *(v2u*)(Y + ro * 1024 + hl * 64 + 16 * (2 * ph + pi) + 4 * fq) = o; } }
        { const float gdec = fast_exp2(AC[63]);
          bf16x8 xwf[2];
#pragma unroll
          for (int ks2 = 0; ks2 < 2; ++ks2) { const LAS unsigned char* xb = Xw + (32 * ks2 + 8 * fq + lq) * XSTR + (16 * lt + 4 * lp) * 2;
              const s16x4 v0 = __builtin_amdgcn_ds_read_tr16_b64_v4i16((LAS s16x4*)xb), v1 = __builtin_amdgcn_ds_read_tr16_b64_v4i16((LAS s16x4*)(xb + 4 * XSTR));
              xwf[ks2][0] = v0[0]; xwf[ks2][1] = v0[1]; xwf[ks2][2] = v0[2]; xwf[ks2][3] = v0[3]; xwf[ks2][4] = v1[0]; xwf[ks2][5] = v1[1]; xwf[ks2][6] = v1[2]; xwf[ks2][7] = v1[3]; }
#pragma unroll
          for (int i = 0; i < 4; ++i) { const int nt = 4 * ph + i; f32x4 a = sacc[i] * gdec;
#pragma unroll
              for (int ks2 = 0; ks2 < 2; ++ks2) { const LAS unsigned char* bb = Bl + (32 * ks2 + 8 * fq + lq) * BSTR + (16 * nt + 4 * lp) * 2;
                  const s16x4 v0 = __builtin_amdgcn_ds_read_tr16_b64_v4i16((LAS s16x4*)bb), v1 = __builtin_amdgcn_ds_read_tr16_b64_v4i16((LAS s16x4*)(bb + 4 * BSTR));
                  bf16x8 bt; bt[0] = v0[0]; bt[1] = v0[1]; bt[2] = v0[2]; bt[3] = v0[3]; bt[4] = v1[0]; bt[5] = v1[1]; bt[6] = v1[2]; bt[7] = v1[3];
                  a = __builtin_amdgcn_mfma_f32_16x16x32_bf16(xwf[ks2], bt, a, 0, 0, 0); }
              sacc[i] = a;
#pragma unroll
              for (int j = 0; j < 4; ++j) *(LAS bf16*)(Sn + (16 * lt + 4 * fq + j) * BSTR + (16 * nt + fr) * 2) = (bf16)f2bf(a[j]); } }
        __syncthreads();
        if (ck + 1 < 68) SM_STORE();
        __syncthreads();
    }
#undef SM_LOAD
#undef SM_STORE
}
__device__ __forceinline__ void phase_ssm_gnorm2(Frame& F, const float* const* in, int gp, bf16* Yf, const bf16* Yb, const bf16* XS, const bf16* Z) {
    const int gw = F.vcu * NWAVES + F.wave, NGW = GRID * NWAVES; const float* ng = in[24] + gp * 1024 + 16 * F.lane;
    const int head = gp * 16 + (F.lane >> 2); const float dskip = in[23][head] + in[23][32 + head];
    for (int r = gw; r < M; r += NGW) { const size_t off = (size_t)r * 1024 + 16 * F.lane;
        const v4u a0 = *(const v4u*)(Yf + off), a1 = *(const v4u*)(Yf + off + 8), b0 = *(const v4u*)(Yb + off), b1 = *(const v4u*)(Yb + off + 8);
        const v4u x0 = *(const v4u*)(XS + off), x1 = *(const v4u*)(XS + off + 8), z0 = *(const v4u*)(Z + off), z1 = *(const v4u*)(Z + off + 8);
        const unsigned aw[8] = {a0.x, a0.y, a0.z, a0.w, a1.x, a1.y, a1.z, a1.w}, bw[8] = {b0.x, b0.y, b0.z, b0.w, b1.x, b1.y, b1.z, b1.w};
        const unsigned xw[8] = {x0.x, x0.y, x0.z, x0.w, x1.x, x1.y, x1.z, x1.w}, zw[8] = {z0.x, z0.y, z0.z, z0.w, z1.x, z1.y, z1.z, z1.w};
        float v[16]; float ss = 0.f;
#pragma unroll
        for (int i = 0; i < 8; ++i) { v[2 * i] = (bflo(aw[i]) + bflo(bw[i]) + dskip * bflo(xw[i])) * silu_f(bflo(zw[i])); v[2 * i + 1] = (bfhi(aw[i]) + bfhi(bw[i]) + dskip * bfhi(xw[i])) * silu_f(bfhi(zw[i]));
            ss += v[2 * i] * v[2 * i] + v[2 * i + 1] * v[2 * i + 1]; }
#pragma unroll
        for (int o = 1; o < 32; o <<= 1) ss += __shfl_xor(ss, o);
        const float rs = rsqrtf(ss * (1.f / 512.f) + EPS);
        unsigned res[8];
#pragma unroll
        for (int i = 0; i < 8; ++i) res[i] = cvt_pk_bf16(v[2 * i] * rs * ng[2 * i], v[2 * i + 1] * rs * ng[2 * i + 1]);
        *(v4u*)(Yf + off) = (v4u){res[0], res[1], res[2], res[3]}; *(v4u*)(Yf + off + 8) = (v4u){res[4], res[5], res[6], res[7]}; }
}

__device__ __forceinline__ void phase_mlstm_scan(Frame& F, const bf16* Qm, const bf16* Km, const bf16* Vm, const float* G, bf16* Hf, bf16* Hb) {
    constexpr int T = 32;
    LAS float* Qf = (LAS float*)F.lds;
    LAS float* KW = (LAS float*)(F.lds + 8192);
    LAS float* Vf = (LAS float*)(F.lds + 16384);
    LAS float* FD = (LAS float*)(F.lds + 24576);
    LAS float* IW = (LAS float*)(F.lds + 24576 + 256);
    LAS float* EM = (LAS float*)(F.lds + 24576 + 512);
    LAS float* PN = (LAS float*)(F.lds + 32768);
    LAS float* PD = (LAS float*)(F.lds + 32768 + 65536);
    const int it = blockIdx.x, b = it >> 5, dir = (it >> 4) & 1, head = (it >> 1) & 7, jh = it & 1;
    bf16* Hout = dir == 0 ? Hf : Hb;
    const int w = F.wave, lane = F.lane, d7 = 8 * w + (lane & 7);
    float C[8], nst = 0.f, m_in = 0.f;
#pragma unroll
    for (int i = 0; i < 8; ++i) C[i] = 0.f;
    const int st = (F.tid & 255) >> 3, sch = F.tid & 7;
    v4u r0, r1; float gi = 0.f, gf = 0.f;
#define ML_LOAD(tile) do { const size_t _r = (size_t)(b * TPB + scan_row(dir, (tile) * T + st)); \
        if (F.tid < 256) { r0 = *(const v4u*)(Qm + _r * 512 + head * 64 + sch * 8); r1 = *(const v4u*)(Vm + _r * 1024 + head * 128 + jh * 64 + sch * 8); } \
        else { r0 = *(const v4u*)(Km + _r * 512 + head * 64 + sch * 8); } \
        if (F.tid < 32) { const size_t _g = (size_t)(b * TPB + scan_row(dir, (tile) * T + F.tid)); gi = G[_g * 32 + (2 * dir) * 8 + head]; gf = G[_g * 32 + (2 * dir + 1) * 8 + head]; } } while (0)
#define UNPK(dst, r) do { *(LAS f32x4*)(dst) = (f32x4){bflo(r.x), bfhi(r.x), bflo(r.y), bfhi(r.y)}; *(LAS f32x4*)((dst) + 4) = (f32x4){bflo(r.z), bfhi(r.z), bflo(r.w), bfhi(r.w)}; } while (0)
#define ML_GATES(nb) do { if (w == 0) { float Fc = lane < 32 ? gf : 0.f; \
            _Pragma("unroll") for (int o = 1; o < 32; o <<= 1) { const float t_ = __shfl_up(Fc, o); if (lane >= o) Fc += t_; } \
            float Gm = lane < 32 ? gi - Fc : -3.0e38f; \
            _Pragma("unroll") for (int o = 1; o < 32; o <<= 1) { const float t_ = __shfl_up(Gm, o); if (lane >= o) Gm = fmaxf(Gm, t_); } \
            const float mt = Fc + fmaxf(m_in, Gm); float mp = __shfl_up(mt, 1); if (lane == 0) mp = m_in; \
            if (lane < 32) { FD[(nb) * 32 + lane] = fast_exp2((gf + mp - mt) * LOG2E); IW[(nb) * 32 + lane] = fast_exp2((gi - mt) * LOG2E); EM[(nb) * 32 + lane] = fast_exp2(-mt * LOG2E); } \
            m_in = __shfl(mt, 31); } } while (0)
    __syncthreads();
    ML_LOAD(0); ML_GATES(0);
    if (F.tid < 256) { UNPK(Qf + st * 64 + sch * 8, r0); UNPK(Vf + st * 64 + sch * 8, r1); }
    __syncthreads();
    if (F.tid >= 256) { const float iw = IW[st]; LAS float* dk = KW + st * 64 + sch * 8;
        *(LAS f32x4*)dk = (f32x4){bflo(r0.x), bfhi(r0.x), bflo(r0.y), bfhi(r0.y)} * iw; *(LAS f32x4*)(dk + 4) = (f32x4){bflo(r0.z), bfhi(r0.z), bflo(r0.w), bfhi(r0.w)} * iw; }
    __syncthreads();
    constexpr int NT = TPB / T;
    for (int tile = 0; tile < NT; ++tile) { const int cb = tile & 1;
        if (tile + 1 < NT) ML_LOAD(tile + 1);
#pragma unroll 4
        for (int t = 0; t < T; ++t) {
            const float fd = FD[cb * 32 + t], v = Vf[t * 64 + lane];
            const f32x4 q0 = *(const LAS f32x4*)(Qf + t * 64 + 8 * w), q1 = *(const LAS f32x4*)(Qf + t * 64 + 8 * w + 4);
            const f32x4 k0 = *(const LAS f32x4*)(KW + t * 64 + 8 * w), k1 = *(const LAS f32x4*)(KW + t * 64 + 8 * w + 4);
            float pn = 0.f;
#pragma unroll
            for (int i = 0; i < 4; ++i) { C[i] = C[i] * fd + k0[i] * v; pn += q0[i] * C[i]; C[4 + i] = C[4 + i] * fd + k1[i] * v; pn += q1[i] * C[4 + i]; }
            PN[(w * 32 + t) * 64 + lane] = pn;
            nst = nst * fd + KW[t * 64 + d7];
            float pd = Qf[t * 64 + d7] * nst;
            pd += __shfl_xor(pd, 1); pd += __shfl_xor(pd, 2); pd += __shfl_xor(pd, 4);
            if (lane == 0) PD[w * 32 + t] = pd;
        }
        __syncthreads();
#pragma unroll
        for (int k = 0; k < 4; ++k) { const int t = (F.tid >> 6) + 8 * k; float num = 0.f, den = 0.f;
#pragma unroll
            for (int ww = 0; ww < 8; ++ww) { num += PN[(ww * 32 + t) * 64 + lane]; den += PD[ww * 32 + t]; }
            const float h = num / fmaxf(fabsf(den), EM[cb * 32 + t]);
            Hout[(size_t)(b * TPB + scan_row(dir, tile * T + t)) * 1024 + head * 128 + jh * 64 + lane] = (bf16)f2bf(h); }
        if (tile + 1 < NT) { ML_GATES(cb ^ 1); if (F.tid < 256) { UNPK(Qf + st * 64 + sch * 8, r0); UNPK(Vf + st * 64 + sch * 8, r1); } }
        __syncthreads();
        if (tile + 1 < NT && F.tid >= 256) { const float iw = IW[(cb ^ 1) * 32 + st]; LAS float* dk = KW + st * 64 + sch * 8;
            *(LAS f32x4*)dk = (f32x4){bflo(r0.x), bfhi(r0.x), bflo(r0.y), bfhi(r0.y)} * iw; *(LAS f32x4*)(dk + 4) = (f32x4){bflo(r0.z), bfhi(r0.z), bflo(r0.w), bfhi(r0.w)} * iw; }
        __syncthreads();
    }
#undef ML_LOAD
#undef ML_GATES
#undef UNPK
}
__device__ __forceinline__ void phase_mlstm_gnorm(Frame& F, const float* const* in, const bf16* Hf, const bf16* Hb, const bf16* Om, bf16* Hn) {
    const int gw = F.vcu * NWAVES + F.wave, NGW = GRID * NWAVES; const float* ng = in[28] + 16 * F.lane;
    for (int r = gw; r < M; r += NGW) { const size_t off = (size_t)r * 1024 + 16 * F.lane;
        const v4u a0 = *(const v4u*)(Hf + off), a1 = *(const v4u*)(Hf + off + 8), b0 = *(const v4u*)(Hb + off), b1 = *(const v4u*)(Hb + off + 8), o0 = *(const v4u*)(Om + off), o1 = *(const v4u*)(Om + off + 8);
        const unsigned aw[8] = {a0.x, a0.y, a0.z, a0.w, a1.x, a1.y, a1.z, a1.w}, bw[8] = {b0.x, b0.y, b0.z, b0.w, b1.x, b1.y, b1.z, b1.w}, ow[8] = {o0.x, o0.y, o0.z, o0.w, o1.x, o1.y, o1.z, o1.w};
        float v[16]; float ss = 0.f;
#pragma unroll
        for (int i = 0; i < 8; ++i) { v[2 * i] = bflo(aw[i]) + bflo(bw[i]); v[2 * i + 1] = bfhi(aw[i]) + bfhi(bw[i]); ss += v[2 * i] * v[2 * i] + v[2 * i + 1] * v[2 * i + 1]; }
        ss += __shfl_xor(ss, 1); ss += __shfl_xor(ss, 2); ss += __shfl_xor(ss, 4);
        const float rs = rsqrtf(ss * (1.f / 128.f) + EPS);
        unsigned res[8];
#pragma unroll
        for (int i = 0; i < 8; ++i) res[i] = cvt_pk_bf16(v[2 * i] * rs * ng[2 * i] * sigmoid_f(bflo(ow[i])), v[2 * i + 1] * rs * ng[2 * i + 1] * sigmoid_f(bfhi(ow[i])));
        *(v4u*)(Hn + off) = (v4u){res[0], res[1], res[2], res[3]}; *(v4u*)(Hn + off + 8) = (v4u){res[4], res[5], res[6], res[7]}; }
}
struct Args { const float* in[37]; float* out; unsigned char* ws; };

__device__ __forceinline__ void moe_phases(Frame& F, const float* const* in, int layer, const XcdBarrier& bar) {
    phase_norm2_route(F, in, layer);
    SYNC_GRID();
    bf16* Hb = (bf16*)(F.ws + WS_H); bf16* ACT = (bf16*)(F.ws + MOE_ACT); float* X = (float*)(F.ws + WS_X);
    const float* mod = (const float*)(F.ws + WS_MOD) + (size_t)layer * 9 * 6144;
    { MoeOrder<0> S; S.W = (const bf16*)(F.ws + WS_WGU); S.G = GRID; S.c = F.vcu; moe_setup(F, layer, S);
      pg8::Gemm g{Hb, 1024, 1024, 1 << 30}; EpiMoeAct E{ACT, S.tbl};
      pg8::gemm_phase(F.lds, g, S, E); }
    SYNC_GRID();
    { MoeOrder<1> S; S.W = (const bf16*)(F.ws + WS_WDN); S.G = GRID; S.c = F.vcu; moe_setup(F, layer, S);
      pg8::Gemm g{ACT, 512, 256, 4}; EpiMoeDown E{X, mod + 5 * 1024, S.tbl};
      pg8::gemm_phase(F.lds, g, S, E); }
    SYNC_GRID();
}
__device__ __forceinline__ void outproj_phase(Frame& F, const bf16* A, const bf16* Wt, int K, int ldb, int layer) {
    pg8::Gemm g{A, K, ldb, 1 << 30}; pg8::StaticOrder S; S.init(M, 1024, GRID, (int)blockIdx.x, Wt, ldb);
    EpiResid E{(float*)(F.ws + WS_X), (const float*)(F.ws + WS_MOD) + (size_t)layer * 9 * 6144 + 2 * 1024};
    pg8::gemm_phase(F.lds, g, S, E);
}

__device__ __forceinline__ void ssm_gp_phases(Frame& F, const float* const* in, const int gp, const XcdBarrier& bar) {
    unsigned char* scr = F.ws + WS_SCR; unsigned char* scr2 = (unsigned char*)F.out; bf16* H = (bf16*)(F.ws + WS_H); bf16* WM = (bf16*)(F.ws + WS_WMIX);
    bf16* Z = (bf16*)scr; bf16* XP = (bf16*)(scr + 68 * MiB); bf16* XS = (bf16*)(scr + 170 * MiB); float* DT = (float*)(scr + 238 * MiB); float* ACUM = (float*)(scr + 243 * MiB); bf16* BC = (bf16*)scr2; bf16* Yb = (bf16*)(scr2 + 34 * MiB);
    { pg8::Gemm g{H, 1024, 1024, 1 << 30}; pg8::StaticOrder S; S.init(M, 2816, GRID, (int)blockIdx.x, WM + (size_t)gp * 2816 * 1024, 1024);
      EpiSsmIn E{Z, XP, DT, in[21] + gp * 16};
      pg8::gemm_phase(F.lds, g, S, E);
#if defined(PROBE_GEMM2)
        __syncthreads(); pg8::gemm_phase(F.lds, g, S, E);
#endif
        }
    SYNC_GRID();
    phase_ssm_conv(F, in, gp, XP, XS, BC, DT, ACUM);
#if defined(PROBE_MEM2)
    phase_ssm_conv(F, in, gp, XP, XS, BC, DT, ACUM);
#endif
    SYNC_GRID();
#if defined(SSD_VALU)
    phase_ssm_scan(F, in, gp, XS, BC, DT, Z, XP);
    SYNC_GRID();
    phase_ssm_gnorm(F, in, gp, XP);
    SYNC_GRID();
#else
    phase_ssm_scan_mfma(F, in, gp, XS, BC, DT, ACUM, XP, Yb);
    SYNC_GRID();
    phase_ssm_gnorm2(F, in, gp, XP, Yb, XS, Z);
    SYNC_GRID();
#endif
    outproj_phase(F, XP, WM + 6 * MiB + (size_t)gp * 1024, 1024, 2048, 1);
    SYNC_GRID();
}

__global__ void __launch_bounds__(NTHR, 2) fwd_kernel(Args args) {
    extern __shared__ __attribute__((aligned(16))) unsigned char lds_raw[];
    Frame F;
    F.lds = (LAS unsigned char*)lds_raw; F.ws = args.ws; F.ctl = (unsigned*)(args.ws + WS_CTL); F.out = args.out;
    refresh(F);
    { const int bx = blockIdx.x; F.vcu = (bx % 8) * (GRID / 8) + bx / 8; }
    volatile LAS unsigned* MISC = (volatile LAS unsigned*)(F.lds + LDS_MISC);
    for (int u = F.tid; u < 256; u += NTHR) MISC[u] = 0u;
    __syncthreads();
    const XcdBarrier bar = xcd_barrier_post(F.ctl + CW_BAR, MISC + 8);
    const float* const* in = args.in;
    unsigned char* ws = F.ws; unsigned char* scr = ws + WS_SCR; unsigned char* scr2 = (unsigned char*)F.out;
    bf16* H = (bf16*)(ws + WS_H); bf16* WM = (bf16*)(ws + WS_WMIX);

#if defined(PROBE_MEM2)
    for (int rep = 0; rep < 2; ++rep) {
#endif
    phase_prologue(F, in);
    __syncthreads(); refresh(F);
    convert_matrix<MAP_ATTN_IN>(F, in[15], 1024, 1536, WM, 0, nullptr);
    convert_matrix<MAP_ID>(F, in[17], 1024, 1024, WM + 2 * MiB, 0, nullptr);
    convert_moe(F, in, 0);
#if defined(PROBE_MEM2)
    __syncthreads(); }
#endif
    SYNC_GRID();

#ifndef SKIP_L0
    phase_norm1(F, in, 0);
#if defined(PROBE_MEM2)
    phase_norm1(F, in, 0);
#endif
    SYNC_GRID();
    { bf16* Q = (bf16*)scr; bf16* Kb = (bf16*)(scr + 68 * MiB); bf16* Vb = (bf16*)(scr + 85 * MiB);
      { pg8::Gemm g{H, 1024, 1024, 1 << 30}; pg8::StaticOrder S; S.init(M, 1536, GRID, (int)blockIdx.x, WM, 1024);
        EpiAttnIn E{Q, Kb, Vb, (const f32x2*)(ws + WS_TABA), 0.125f * LOG2E};
        pg8::gemm_phase(F.lds, g, S, E);
#if defined(PROBE_GEMM2)
        __syncthreads(); pg8::gemm_phase(F.lds, g, S, E);
#endif
        }
      SYNC_GRID();
      phase_attn_window(F, in, Q, Kb, Vb);
      SYNC_GRID();
      outproj_phase(F, Q, WM + 2 * MiB, 1024, 1024, 0);
      SYNC_GRID(); }
    moe_phases(F, in, 0, bar);

#endif
#ifndef SKIP_L1
#if defined(PROBE_MEM2)
    for (int rep = 0; rep < 2; ++rep) {
#endif
    phase_norm1(F, in, 1);
    convert_matrix<MAP_SSM_IN>(F, in[18], 1024, 5184, WM, 0, nullptr);
    zero_rows(F, WM, 2592, 224, 1024); zero_rows(F, WM, 2816 + 2592, 224, 1024);
    convert_matrix<MAP_ID>(F, in[25], 2048, 1024, WM + 6 * MiB, 0, nullptr);
    convert_moe(F, in, 1);
#if defined(PROBE_MEM2)
    __syncthreads(); }
#endif
    SYNC_GRID();
    ssm_gp_phases(F, in, 0, bar);
    ssm_gp_phases(F, in, 1, bar);
    moe_phases(F, in, 1, bar);

#endif
#ifndef SKIP_L2
#if defined(PROBE_MEM2)
    for (int rep = 0; rep < 2; ++rep) {
#endif
    phase_norm1(F, in, 2);
    convert_matrix<MAP_ID>(F, in[26], 1024, 3104, WM, 0, nullptr);
    zero_rows(F, WM, 3104, 224, 1024);
    convert_matrix<MAP_ID>(F, in[29], 1024, 1024, WM + 4 * MiB, 0, nullptr);
    convert_moe(F, in, 2);
#if defined(PROBE_MEM2)
    __syncthreads(); }
#endif
    SYNC_GRID();
    { bf16* Qm = (bf16*)scr; bf16* Km = (bf16*)(scr + 34 * MiB); bf16* Vm = (bf16*)(scr + 68 * MiB); bf16* Om = (bf16*)(scr + 136 * MiB); float* Gt = (float*)(scr + 204 * MiB);
      bf16* Hf = (bf16*)scr2; bf16* Hbw = H;
      { pg8::Gemm g{H, 1024, 1024, 1 << 30}; pg8::StaticOrder S; S.init(M, 3328, GRID, (int)blockIdx.x, WM, 1024);
        EpiMlIn E{Qm, Km, Vm, Om, Gt, in[27]};
        pg8::gemm_phase(F.lds, g, S, E);
#if defined(PROBE_GEMM2)
        __syncthreads(); pg8::gemm_phase(F.lds, g, S, E);
#endif
        }
      SYNC_GRID();
      phase_mlstm_scan(F, Qm, Km, Vm, Gt, Hf, Hbw);
#if defined(PROBE_ML2)
      __syncthreads(); phase_mlstm_scan(F, Qm, Km, Vm, Gt, Hf, Hbw);
#endif
      SYNC_GRID();
      phase_mlstm_gnorm(F, in, Hf, Hbw, Om, Om);
      SYNC_GRID();
      outproj_phase(F, Om, WM + 4 * MiB, 1024, 1024, 2);
      SYNC_GRID(); }
    moe_phases(F, in, 2, bar);

#endif
#ifndef SKIP_L3
#if defined(PROBE_MEM2)
    for (int rep = 0; rep < 2; ++rep) {
#endif
    phase_norm1(F, in, 3);
    convert_matrix<MAP_MLA_IN>(F, in[30], 1024, 544, WM, 0, nullptr);
    zero_rows(F, WM, 544, 224, 1024);
    convert_matrix<MAP_MLA_QUP>(F, in[32], 256, 1536, WM + 1 * MiB, 0, in[31]);
    convert_matrix<MAP_ID>(F, in[34], 256, 2048, WM + 2 * MiB, 0, in[33]);
    convert_matrix<MAP_ID>(F, in[35], 1024, 1024, WM + 3 * MiB, 0, nullptr);
    convert_moe(F, in, 3);
#if defined(PROBE_MEM2)
    __syncthreads(); }
#endif
    SYNC_GRID();
    { bf16* CQ = (bf16*)scr; bf16* CKV = (bf16*)(scr + 17 * MiB); float* SSQ = (float*)(scr + 34 * MiB); bf16* KF = (bf16*)(scr + 36 * MiB); bf16* V3 = (bf16*)(scr + 138 * MiB);
      bf16* Q3 = (bf16*)scr2; bf16* O3 = H; const f32x2* tabm = (const f32x2*)(ws + WS_TABM);
      { pg8::Gemm g{H, 1024, 1024, 1 << 30}; pg8::StaticOrder S; S.init(M, 768, GRID, (int)blockIdx.x, WM, 1024);
        EpiMlaIn E{CQ, CKV, KF, SSQ, tabm};
        pg8::gemm_phase(F.lds, g, S, E);
#if defined(PROBE_GEMM2)
        __syncthreads(); pg8::gemm_phase(F.lds, g, S, E);
#endif
        }
      SYNC_GRID();
      { pg8::Gemm g{CQ, 256, 256, 1 << 30}; pg8::StaticOrder S; S.init(M, 1536, GRID, (int)blockIdx.x, WM + 1 * MiB, 256);
        EpiMlaQ E{Q3, SSQ, tabm, 0.10206207261596577f * LOG2E};
        pg8::gemm_phase(F.lds, g, S, E);
#if defined(PROBE_GEMM2)
        __syncthreads(); pg8::gemm_phase(F.lds, g, S, E);
#endif
        }
      { pg8::Gemm g{CKV, 256, 256, 1 << 30}; pg8::StaticOrder S; S.init(M, 2048, GRID, (int)blockIdx.x, WM + 2 * MiB, 256);
        EpiMlaKV E{KF, V3, SSQ};
        pg8::gemm_phase(F.lds, g, S, E);
#if defined(PROBE_GEMM2)
        __syncthreads(); pg8::gemm_phase(F.lds, g, S, E);
#endif
        }
      SYNC_GRID();
      phase_attn_mla(F, Q3, KF, V3, O3);
#if defined(PROBE_MLA2)
      __syncthreads(); phase_attn_mla(F, Q3, KF, V3, O3);
#endif
      SYNC_GRID();
      outproj_phase(F, O3, WM + 3 * MiB, 1024, 1024, 3);
      SYNC_GRID(); }
    moe_phases(F, in, 3, bar);

#endif
    const bool poison = __hip_atomic_load(F.ctl + CW_BAR + XB_TMO, RLX_AGENT) != 0u || __hip_atomic_load(F.ctl + CW_POISON, RLX_AGENT) != 0u;
    phase_final(F, in, poison);
#if defined(PROBE_MEM2)
    phase_final(F, in, poison);
#endif
}

extern "C" void kernel_launch(void* const* d_in, const int* in_sizes, int n_in, void* d_out, int out_size, void* d_ws, size_t ws_size, hipStream_t stream) {
    static int ready = 0;
    if (ready == 0) {
        ready = -1;
        if (n_in != 37 || in_sizes[0] != NB * SEQ * D || out_size != NB * SEQ * D || ws_size < WS_END) { fprintf(stderr, "kernel_launch: unexpected problem shape (n_in %d, in0 %d, out %d, ws %zu)\n", n_in, n_in > 0 ? in_sizes[0] : -1, out_size, ws_size); return; }
        int dev = 0, cus = 0;
        if (hipGetDevice(&dev) != hipSuccess || hipDeviceGetAttribute(&cus, hipDeviceAttributeMultiprocessorCount, dev) != hipSuccess) { fprintf(stderr, "kernel_launch: device query failed\n"); return; }
        if (cus < GRID) { fprintf(stderr, "kernel_launch: needs %d CUs, device has %d\n", GRID, cus); return; }
        if (hipFuncSetAttribute((const void*)fwd_kernel, hipFuncAttributeMaxDynamicSharedMemorySize, LDS_BYTES) != hipSuccess) { fprintf(stderr, "kernel_launch: hipFuncSetAttribute failed\n"); return; }
        int per_cu = 0;
        if (hipOccupancyMaxActiveBlocksPerMultiprocessor(&per_cu, (const void*)fwd_kernel, NTHR, LDS_BYTES) != hipSuccess || per_cu < 1) { fprintf(stderr, "kernel_launch: occupancy query reports %d blocks per CU\n", per_cu); }
        (void)hipGetLastError();
        ready = 1;
    }
    if (ready < 0) return;
    if (hipMemsetAsync((char*)d_ws + WS_CTL, 0, CTL_ZERO_BYTES, stream) != hipSuccess) { fprintf(stderr, "kernel_launch: memset failed\n"); return; }
    Args a{};
    for (int i = 0; i < 37; ++i) a.in[i] = (const float*)d_in[i];
    a.out = (float*)d_out; a.ws = (unsigned char*)d_ws;
    hipLaunchKernelGGL(fwd_kernel, dim3(GRID), dim3(NTHR), LDS_BYTES, stream, a);
    const hipError_t le = hipPeekAtLastError();
    if (le != hipSuccess) fprintf(stderr, "kernel_launch: launch failed: %s\n", hipGetErrorName(le));
}
```

```cpp
#include <hip/hip_runtime.h>
#include <cstdio>
#include <cstdint>

#define GAS __attribute__((address_space(1)))
#define LAS __attribute__((address_space(3)))
typedef unsigned short bf16;
typedef unsigned v4u __attribute__((ext_vector_type(4)));
typedef unsigned v2u __attribute__((ext_vector_type(2)));
typedef float f32x4 __attribute__((ext_vector_type(4)));
typedef float f32x2 __attribute__((ext_vector_type(2)));
typedef short bf16x8 __attribute__((ext_vector_type(8)));
typedef short s16x4 __attribute__((ext_vector_type(4)));
#define RLX_AGENT __ATOMIC_RELAXED, __HIP_MEMORY_SCOPE_AGENT

constexpr int D = 1024, NB = 8, SEQ = 4096, CTX = 256, TPB = SEQ + CTX  , M = NB * TPB  ;
constexpr int NWAVES = 8, NTHR = 512, GRID = 256;
constexpr float EPS = 1e-6f;
constexpr float LOG2E = 1.4426950408889634f;

__device__ __forceinline__ unsigned f2bf(float f) { unsigned u = __builtin_bit_cast(unsigned, f); return (u + 0x7fffu + ((u >> 16) & 1u)) >> 16; }
__device__ __forceinline__ float bf2f(unsigned b) { return __builtin_bit_cast(float, b << 16); }
__device__ __forceinline__ float bflo(unsigned w) { return __builtin_bit_cast(float, w << 16); }
__device__ __forceinline__ float bfhi(unsigned w) { return __builtin_bit_cast(float, w & 0xffff0000u); }
__device__ __forceinline__ unsigned cvt_pk_bf16(float lo, float hi) { unsigned r; asm volatile("v_cvt_pk_bf16_f32 %0, %1, %2" : "=v"(r) : "v"(lo), "v"(hi)); return r; }
__device__ __forceinline__ float fast_exp2(float x) { return __builtin_amdgcn_exp2f(x); }
__device__ __forceinline__ float fast_rcp(float x) { return __builtin_amdgcn_rcpf(x); }
__device__ __forceinline__ float silu_f(float x) { return x * fast_rcp(1.0f + fast_exp2(-x * LOG2E)); }
__device__ __forceinline__ float sigmoid_f(float x) { return fast_rcp(1.0f + fast_exp2(-x * LOG2E)); }
__device__ __forceinline__ float fast_log(float x) { return __builtin_amdgcn_logf(x) * 0.6931471805599453f; }
__device__ __forceinline__ float fast_exp(float x) { return __builtin_amdgcn_exp2f(x * LOG2E); }
__device__ __forceinline__ float softplus_f(float x) { if (x > 20.f) return x; const float e = fast_exp(x); return e < 0.01f ? e * (1.0f - e * (0.5f - e * (1.0f / 3.0f))) : fast_log(1.0f + e); }
__device__ __forceinline__ float wave_sum(float v) {
#pragma unroll
    for (int o = 1; o < 64; o <<= 1) v += __shfl_xor(v, o);
    return v;
}
__device__ __forceinline__ int opaque_tid() { int t = threadIdx.x; asm volatile("" : "+v"(t)); return t; }
#define LDS_WAIT() asm volatile("s_waitcnt lgkmcnt(0)" ::: "memory")
#define VM_WAIT() asm volatile("s_waitcnt vmcnt(0)" ::: "memory")

namespace pg8 {
constexpr int BM = 256, BK = 64, HALF = 128, HTB = HALF * BK * 2, STAGE_BYTES = 8 * HTB, NXCD = 8, WGM = 8;
__host__ __device__ __forceinline__ int lds_byte(int r, int c) { const int st = (r >> 4) * 2 + (c >> 5), rr = r & 15, cc = c & 31, ob = rr * 64 + cc * 2; return st * 1024 + (ob ^ (((ob >> 9) & 1) << 5)); }
__host__ __device__ __forceinline__ void stage_rc(int b, int& R, int& C) { const int st = b / 1024, sb = b % 1024, swz = sb ^ (((sb >> 9) & 1) << 5); R = (st >> 1) * 16 + swz / 64; C = (st & 1) * 32 + (swz % 64) / 2; }
__host__ __device__ __forceinline__ int perm32(int rho) { const int n = rho >> 4, i = rho & 15; return 8 * (i >> 2) + 4 * n + (i & 3); }

struct Unit { int pm, pn, aux; };
struct Gemm { const bf16* A; int K; int ldb; int ksplit; };

struct StaticOrder {
    static constexpr bool GATHER = false;
    int nM, nN, nwg, G, c; const bf16* Bt; int ldb;
    __device__ void init(int M_, int N_, int G_, int c_, const bf16* Bt_, int ldb_) { nM = M_ / BM; nN = N_ / BM; nwg = nM * nN; G = G_; c = c_; Bt = Bt_; ldb = ldb_; }
    __device__ __forceinline__ bool next(int i, Unit& u) const {
        const long L = (long)i * G + c; if (L >= nwg) return false;
        int wgid = (int)L; { const int q = nwg / NXCD, r = nwg % NXCD, xcd = wgid % NXCD, off = wgid / NXCD; wgid = (xcd < r ? xcd * (q + 1) : r * (q + 1) + (xcd - r) * q) + off; }
        const int nig = WGM * nN, gid = wgid / nig, fm = gid * WGM, gsz = (nM - fm) < WGM ? (nM - fm) : WGM;
        u.pm = fm + ((wgid % nig) % gsz); u.pn = (wgid % nig) / gsz; u.aux = 0; return true;
    }
    __device__ __forceinline__ int a_row(const Unit& u, int r) const { return u.pm * BM + r; }
    __device__ __forceinline__ const char* b_seg(const Unit& u, int seg) const { return (const char*)(Bt + (size_t)u.pn * BM * ldb); }
};

template <class Epi, class Sched>
__device__ __forceinline__ void gemm_phase(LAS unsigned char* lds, const Gemm g, const Sched& S, const Epi& E) {
    const int tid = opaque_tid(), wid = __builtin_amdgcn_readfirstlane(tid >> 6), lane = tid & 63, wr = wid >> 2, wc = wid & 3, fr = lane & 15, fq = lane >> 4;
    const int K = g.K, nt = K / BK, ldb = g.ldb, ksplit = g.ksplit;
    int Rst[2], Cst[2]; unsigned voffB[2], voffA[2];
#pragma unroll
    for (int i = 0; i < 2; ++i) { int R, C; stage_rc(tid * 16 + i * 8192, R, C); const int Rb = Epi::PERM ? ((R & ~31) + perm32(R & 31)) : R; Rst[i] = R; Cst[i] = C;
        voffB[i] = (unsigned)(Rb * ldb + C) * 2u; voffA[i] = (unsigned)(R * K + C) * 2u; }
    const size_t hstepA = (size_t)HALF * K * 2;
    const size_t kstep = (size_t)(BK * 2);
    const size_t hstepB = (size_t)HALF * ldb * 2;
    const unsigned ldsw = (unsigned)wid * 1024u;
    const int aoff = lds_byte(wr * 64 + fr, fq * 8), boff = lds_byte(wc * 32 + fr, fq * 8);
#define PG8_SA(b, h) (((b) * 2 + (h)) * HTB)
#define PG8_SB(b, h) ((4 + (b) * 2 + (h)) * HTB)
#define PG8_STAGEB(bufoff, gbase) do { _Pragma("unroll") for (int _i = 0; _i < 2; ++_i) \
        __builtin_amdgcn_global_load_lds((const unsigned*)((const char*)(gbase) + voffB[_i]), (LAS unsigned*)(lds + (bufoff) + ldsw + _i * 8192), 16, 0, 0); } while (0)
#define PG8_STAGEA(bufoff, nextsel, h, kt) do { if constexpr (Sched::GATHER) { _Pragma("unroll") for (int _i = 0; _i < 2; ++_i) \
        __builtin_amdgcn_global_load_lds((const unsigned*)(gA + (size_t)(kt) * kstep + ((nextsel) ? vN[h][_i] : vA[h][_i])), (LAS unsigned*)(lds + (bufoff) + ldsw + _i * 8192), 16, 0, 0); } \
      else { const char* _ab = ((nextsel) ? nA : cA) + (size_t)(h) * hstepA + (size_t)(kt) * kstep; _Pragma("unroll") for (int _i = 0; _i < 2; ++_i) \
        __builtin_amdgcn_global_load_lds((const unsigned*)(_ab + voffA[_i]), (LAS unsigned*)(lds + (bufoff) + ldsw + _i * 8192), 16, 0, 0); } } while (0)
#define PG8_LDA(dst, b, h) do { _Pragma("unroll") for (int m = 0; m < 4; ++m) _Pragma("unroll") for (int k = 0; k < 2; ++k) dst[m][k] = *(const LAS bf16x8*)(lds + PG8_SA(b, h) + aoff + m * 2048 + k * 1024); } while (0)
#define PG8_LDB(dst, b, h) do { _Pragma("unroll") for (int n = 0; n < 2; ++n) _Pragma("unroll") for (int k = 0; k < 2; ++k) dst[n][k] = *(const LAS bf16x8*)(lds + PG8_SB(b, h) + boff + n * 2048 + k * 1024); } while (0)
#define PG8_MMA(ai, bj, At, Bt) do { __builtin_amdgcn_s_setprio(1); _Pragma("unroll") for (int m = 0; m < 4; ++m) _Pragma("unroll") for (int n = 0; n < 2; ++n) _Pragma("unroll") for (int k = 0; k < 2; ++k) \
        acc[ai][bj][m][n] = __builtin_amdgcn_mfma_f32_16x16x32_bf16(Bt[n][k], At[m][k], acc[ai][bj][m][n], 0, 0, 0); __builtin_amdgcn_s_setprio(0); } while (0)
#define PG8_WAIT_V(n) asm volatile("s_waitcnt vmcnt(" #n ")" ::: "memory")
#define PG8_WAIT_L(n) asm volatile("s_waitcnt lgkmcnt(" #n ")" ::: "memory")
#define PG8_BAR __builtin_amdgcn_s_barrier()
#define PG8_SCHED __builtin_amdgcn_sched_barrier(0)
#define PG8_AOFFS(dst, u) do { _Pragma("unroll") for (int _h = 0; _h < 2; ++_h) _Pragma("unroll") for (int _i = 0; _i < 2; ++_i) \
        dst[_h][_i] = (unsigned)S.a_row(u, _h * HALF + Rst[_i]) * (unsigned)(K * 2) + (unsigned)(Cst[_i] * 2); } while (0)
    Unit cur, nxt; int ui = 0;
    if (!S.next(0, cur)) return;
    const char* const gA = (const char*)g.A;
    f32x4 acc[2][2][4][2];
#pragma unroll
    for (int a = 0; a < 2; ++a)
#pragma unroll
        for (int b = 0; b < 2; ++b)
#pragma unroll
            for (int m = 0; m < 4; ++m)
#pragma unroll
                for (int n = 0; n < 2; ++n) acc[a][b][m][n] = (f32x4){0.f, 0.f, 0.f, 0.f};
    bf16x8 At[4][2], B0[2][2], B1[2][2];
    unsigned vA[2][2], vN[2][2];
    const char* cA = gA; const char* nA = gA;
    if constexpr (Sched::GATHER) { PG8_AOFFS(vA, cur); } else { cA = gA + (size_t)S.a_row(cur, 0) * K * 2; }
    const char* cB0 = S.b_seg(cur, 0); const char* cB1 = S.b_seg(cur, 1);
    PG8_STAGEB(PG8_SB(0, 0), cB0); PG8_STAGEB(PG8_SB(0, 1), cB0 + hstepB); PG8_STAGEA(PG8_SA(0, 0), false, 0, 0); PG8_STAGEA(PG8_SA(0, 1), false, 1, 0);
    if (wr == 1) PG8_BAR;
    PG8_WAIT_V(2); PG8_BAR;
    PG8_STAGEB(PG8_SB(1, 0), cB0 + kstep); PG8_STAGEA(PG8_SA(1, 0), false, 0, 1); PG8_STAGEB(PG8_SB(1, 1), cB0 + hstepB + kstep);
    PG8_WAIT_V(6); PG8_BAR;
    for (;;) {
        const bool has_next = S.next(ui + 1, nxt);
        const char* nB0 = cB0;
        nA = cA;
        if (has_next) { nB0 = S.b_seg(nxt, 0); if constexpr (Sched::GATHER) { PG8_AOFFS(vN, nxt); } else { nA = gA + (size_t)S.a_row(nxt, 0) * K * 2; } }
        else { if constexpr (Sched::GATHER) {
#pragma unroll
            for (int h = 0; h < 2; ++h)
#pragma unroll
                for (int i = 0; i < 2; ++i) vN[h][i] = vA[h][i]; } }
#pragma unroll 1
        for (int t = 0; t < nt; t += 2) {
            const bool last = (t == nt - 2);
            const char* b2 = last ? nB0 : ((t + 2 < ksplit) ? cB0 + (size_t)(t + 2) * kstep : cB1 + (size_t)(t + 2 - ksplit) * kstep);
            const char* b3 = b2 + kstep;
            const int kt2 = last ? 0 : t + 2;
            PG8_LDB(B0, 0, 0); PG8_LDB(B1, 0, 1); PG8_SCHED; PG8_LDA(At, 0, 0); PG8_STAGEA(PG8_SA(1, 1), false, 1, t + 1);
            PG8_WAIT_V(8); PG8_WAIT_L(0); PG8_BAR; PG8_MMA(0, 0, At, B0); PG8_MMA(0, 1, At, B1); PG8_BAR; PG8_SCHED;
            PG8_LDA(At, 0, 1); PG8_STAGEB(PG8_SB(0, 0), b2); PG8_STAGEB(PG8_SB(0, 1), b2 + hstepB); PG8_STAGEA(PG8_SA(0, 0), last, 0, kt2);
            PG8_WAIT_V(8); PG8_WAIT_L(0); PG8_BAR; PG8_MMA(1, 0, At, B0); PG8_MMA(1, 1, At, B1); PG8_BAR; PG8_SCHED;
            PG8_LDB(B0, 1, 0); PG8_LDB(B1, 1, 1); PG8_SCHED; PG8_LDA(At, 1, 0); PG8_STAGEA(PG8_SA(0, 1), last, 1, kt2);
            PG8_WAIT_V(8); PG8_WAIT_L(0); PG8_BAR; PG8_MMA(0, 0, At, B0); PG8_MMA(0, 1, At, B1); PG8_BAR; PG8_SCHED;
            PG8_LDA(At, 1, 1); PG8_STAGEB(PG8_SB(1, 0), b3); PG8_STAGEB(PG8_SB(1, 1), b3 + hstepB); PG8_STAGEA(PG8_SA(1, 0), last, 0, kt2 + 1);
            PG8_WAIT_V(8); PG8_WAIT_L(0); PG8_BAR; PG8_MMA(1, 0, At, B0); PG8_MMA(1, 1, At, B1); PG8_BAR; PG8_SCHED;
        }
        if (wr == 0) PG8_BAR;
        { int tz = tid; asm volatile("" : "+v"(tz));
          const int lz = tz & 63; E(acc, cur, ui, wr, wc, lz & 15, lz >> 4); }
        if (!has_next) break;
#pragma unroll
        for (int a = 0; a < 2; ++a)
#pragma unroll
            for (int b = 0; b < 2; ++b)
#pragma unroll
                for (int m = 0; m < 4; ++m)
#pragma unroll
                    for (int n = 0; n < 2; ++n) acc[a][b][m][n] = (f32x4){0.f, 0.f, 0.f, 0.f};
        cur = nxt; cB0 = nB0; cB1 = S.b_seg(cur, 1); cA = nA; ++ui;
        if constexpr (Sched::GATHER) {
#pragma unroll
        for (int h = 0; h < 2; ++h)
#pragma unroll
            for (int i = 0; i < 2; ++i) vA[h][i] = vN[h][i]; }
        if (wr == 1) PG8_BAR;
    }
    PG8_WAIT_V(0);
    PG8_BAR;
#undef PG8_SA
#undef PG8_SB
#undef PG8_STAGEA
#undef PG8_STAGEB
#undef PG8_LDA
#undef PG8_LDB
#undef PG8_MMA
#undef PG8_WAIT_V
#undef PG8_WAIT_L
#undef PG8_BAR
#undef PG8_SCHED
#undef PG8_AOFFS
}
}
#define XB_TMO      128
#define XB_XCNT(j)  (256  + 64 * (j))
#define XB_XSUB(j)  (1280 + 64 * (j))
#define XB_XGEN(j)  (2304 + 64 * (j))
#define XB_TOP      3328
#define XB_TOPGEN   3392
#define XCD_BAR_WORDS 3456
#define XB_SPIN_CAP (1u << 22)
__device__ __forceinline__ unsigned xb_ld(unsigned* p)              { return __hip_atomic_load(p, __ATOMIC_RELAXED, __HIP_MEMORY_SCOPE_AGENT); }
__device__ __forceinline__ unsigned xb_add(unsigned* p, unsigned v) { return __hip_atomic_fetch_add(p, v, __ATOMIC_RELAXED, __HIP_MEMORY_SCOPE_AGENT); }
__device__ __forceinline__ unsigned xb_xcc_id() { return (unsigned)__builtin_amdgcn_s_getreg((3 << 11) | 20) & 0xFu; }
#define XB_SPIN(cond, bar) do { unsigned _sp = 0; while (cond) { __builtin_amdgcn_s_sleep(1); \
    if ((++_sp & 255u) == 0u) { if (xb_ld(&(bar)[XB_TMO])) break; if (_sp > XB_SPIN_CAP) { atomicAdd(&(bar)[XB_TMO], 1u); break; } } } } while (0)
struct XcdBarrier { unsigned* bar; unsigned x; volatile LAS unsigned* st; };
__device__ __forceinline__ XcdBarrier xcd_barrier_post(unsigned* bar, volatile LAS unsigned* st) {
    XcdBarrier b; b.bar = bar; b.x = xb_xcc_id(); b.st = st;
    if (threadIdx.x == 0) (void)xb_add(&bar[XB_XCNT(b.x)], 1u);
    return b;
}
__device__ __forceinline__ void xcd_barrier_complete(unsigned* bar, unsigned x, unsigned& nloc, unsigned& nx) {
    const unsigned G = gridDim.x * gridDim.y * gridDim.z;
    unsigned sum, cnt, mine, sp = 0u;
    for (;;) {
        sum = 0u; cnt = 0u; mine = 0u;
#pragma unroll
        for (unsigned j = 0; j < 16; ++j) { const unsigned c = xb_ld(&bar[XB_XCNT(j)]); sum += c; cnt += (c > 0u) ? 1u : 0u; mine = (j == x) ? c : mine; }
        if (sum == G) break;
        __builtin_amdgcn_s_sleep(1);
        if ((++sp & 255u) == 0u) { if (xb_ld(&bar[XB_TMO])) break; if (sp > XB_SPIN_CAP) { atomicAdd(&bar[XB_TMO], 1u); break; } }
    }
    nloc = mine > 0u ? mine : 1u; nx = cnt > 0u ? cnt : 1u;
}
__device__ __forceinline__ void xcd_barrier(const XcdBarrier& b) {
    asm volatile("s_waitcnt vmcnt(0)" ::: "memory");
    __syncthreads();
    if (threadIdx.x == 0) {
        unsigned* bar = b.bar;
        __builtin_amdgcn_s_waitcnt(0);
        unsigned nloc = b.st[0], nx = b.st[1];
        if (nloc == 0u) { xcd_barrier_complete(bar, b.x, nloc, nx); b.st[0] = nloc; b.st[1] = nx; }
        const unsigned old = xb_add(&bar[XB_XSUB(b.x)], 1u);
        const unsigned gen = old / nloc;
        if (old + 1u == (gen + 1u) * nloc) {
            __builtin_amdgcn_fence(__ATOMIC_RELEASE, "agent");
            asm volatile("s_waitcnt vmcnt(0)" ::: "memory");
            const unsigned og = xb_add(&bar[XB_TOP], 1u);
            const unsigned tg = og / nx;
            if (og + 1u == (tg + 1u) * nx) xb_add(&bar[XB_TOPGEN], 1u);
            else XB_SPIN(xb_ld(&bar[XB_TOPGEN]) == tg, bar);
            __builtin_amdgcn_fence(__ATOMIC_ACQUIRE, "agent");
            xb_add(&bar[XB_XGEN(b.x)], 1u);
            asm volatile("s_waitcnt vmcnt(0)" ::: "memory");
        } else {
            XB_SPIN(xb_ld(&bar[XB_XGEN(b.x)]) == gen, bar);
            __builtin_amdgcn_fence(__ATOMIC_ACQUIRE, "agent");
            asm volatile("s_waitcnt vmcnt(0)" ::: "memory");
        }
    }
    __syncthreads();
}

constexpr size_t MiB = 1u << 20;
constexpr size_t WS_CTL = 0, CTL_ZERO_BYTES = 1 * MiB;
constexpr size_t WS_MOD = 1 * MiB;
constexpr size_t WS_TABA = 2 * MiB;
constexpr size_t WS_TABM = 3 * MiB;
constexpr size_t WS_WGU = 4 * MiB;
constexpr size_t WS_WDN = 20 * MiB;
constexpr size_t WS_WMIX = 28 * MiB;
constexpr size_t WS_X = 52 * MiB;
constexpr size_t WS_H = 188 * MiB;
constexpr size_t WS_SCR = 256 * MiB;
constexpr size_t WS_END = 512 * MiB;
constexpr size_t MOE_ACT = WS_SCR;
constexpr size_t MOE_SL = WS_SCR + 48 * MiB;
constexpr size_t MOE_WT = WS_SCR + 52 * MiB;
constexpr int CW_BAR = 4096;
constexpr int CW_MOECNT = 16384;
constexpr int CW_POISON = 20000;

constexpr int RING_BYTES = 131072;
constexpr int LDS_MISC = RING_BYTES;
constexpr int LDS_TB = RING_BYTES + 512;
constexpr int LDS_TBL = RING_BYTES + 1024;
constexpr int LDS_BYTES = RING_BYTES + 1024 + 16384;

struct Frame {
    LAS unsigned char* lds;
    unsigned* ctl;
    unsigned char* ws;
    float* out;
    int tid, lane, wave, vcu;
};

__device__ __forceinline__ void refresh(Frame& F) { F.tid = opaque_tid(); F.lane = F.tid & 63; F.wave = __builtin_amdgcn_readfirstlane(F.tid >> 6); }
#if defined(PROBE_BAR2)
#define SYNC_GRID() do { xcd_barrier(bar); xcd_barrier(bar); refresh(F); } while (0)
#else
#define SYNC_GRID() do { xcd_barrier(bar); refresh(F); } while (0)
#endif
__device__ __forceinline__ int modrow_of(int row) { const int b = row / TPB, t = row - b * TPB; return t < CTX ? 8 : b; }

enum { MAP_ID = 0, MAP_ATTN_IN, MAP_SSM_IN, MAP_MLA_IN, MAP_MLA_QUP, MAP_MOE_G, MAP_MOE_U };
template <int KIND> __device__ __forceinline__ int map_row(int n, int aux) {
    if (KIND == MAP_ID) return aux + n;
    if (KIND == MAP_ATTN_IN) { if (n >= 1280) return n; const int hb = n & ~63, d = n & 63; return hb + (d < 32 ? 2 * d : 2 * (d - 32) + 1); }
    if (KIND == MAP_SSM_IN) {
        if (n < 2048) { const int gp = n >> 10; return gp * 2816 + (n & 1023); }
        if (n < 4096) { const int c = n - 2048, gp = c >> 10; return gp * 2816 + 1024 + (c & 1023); }
        if (n < 4608) { const int c = n - 4096, gp = c >> 8; return gp * 2816 + 2048 + (c & 255); }
        if (n < 5120) { const int c = n - 4608, gp = c >> 8; return gp * 2816 + 2304 + (c & 255); }
        { const int c = n - 5120, dir = c >> 5, h = c & 31, gp = h >> 4; return gp * 2816 + 2560 + dir * 16 + (h & 15); }
    }
    if (KIND == MAP_MLA_IN) { if (n < 512) return n; const int d = n - 512; return 512 + (d < 16 ? 2 * d : 2 * (d - 16) + 1); }
    if (KIND == MAP_MLA_QUP) { const int h = n / 96, e = n - h * 96; if (e < 64) return n; const int d = e - 64; return h * 96 + 64 + (d < 16 ? 2 * d : 2 * (d - 16) + 1); }
    if (KIND == MAP_MOE_G) return aux + (n >> 7) * 256 + (n & 127);
    if (KIND == MAP_MOE_U) return aux + (n >> 7) * 256 + 128 + (n & 127);
    return n;
}
template <int KIND>
__device__ __forceinline__ void transpose_item(const float* W, int K, int N, bf16* WT, int aux, const float* kscale, LAS float* scr, int item, int lane) {
    const int nblk = N / 32, kb = item / nblk, nb = item % nblk, k0 = 64 * kb, n0 = 32 * nb;
#pragma unroll 8
    for (int i = 0; i < 32; ++i) { const int kk = 2 * i + (lane >> 5); float v = W[(size_t)(k0 + kk) * N + n0 + (lane & 31)]; if (kscale) v *= kscale[k0 + kk]; scr[kk * 33 + (lane & 31)] = v; }
    LDS_WAIT(); asm volatile("" ::: "memory");
    const int c = lane & 7;
#pragma unroll
    for (int j = 0; j < 4; ++j) { const int n = (lane >> 3) + 8 * j; const LAS float* s = scr + (8 * c) * 33 + n;
        v4u o; o.x = cvt_pk_bf16(s[0 * 33], s[1 * 33]); o.y = cvt_pk_bf16(s[2 * 33], s[3 * 33]); o.z = cvt_pk_bf16(s[4 * 33], s[5 * 33]); o.w = cvt_pk_bf16(s[6 * 33], s[7 * 33]);
        *(v4u*)(WT + (size_t)map_row<KIND>(n0 + n, aux) * K + k0 + 8 * c) = o; }
    LDS_WAIT(); asm volatile("" ::: "memory");
}
template <int KIND>
__device__ __forceinline__ void convert_matrix(Frame& F, const float* W, int K, int N, bf16* WT, int aux, const float* kscale) {
    LAS float* scr = (LAS float*)(F.lds + F.wave * 16384);
    const int gw = F.vcu * NWAVES + F.wave, NGW = GRID * NWAVES, nitems = (K / 64) * (N / 32);
    for (int it = gw; it < nitems; it += NGW) transpose_item<KIND>(W, K, N, WT, aux, kscale, scr, it, F.lane);
}
__device__ __forceinline__ void zero_rows(Frame& F, bf16* WT, int row0, int nrows, int K) {
    const size_t n16 = (size_t)nrows * K / 8; v4u* p = (v4u*)(WT + (size_t)row0 * K);
    for (size_t i = (size_t)blockIdx.x * NTHR + F.tid; i < n16; i += (size_t)GRID * NTHR) p[i] = (v4u){0u, 0u, 0u, 0u};
}
__device__ __forceinline__ void convert_moe(Frame& F, const float* const* in, int layer) {
    bf16* GU = (bf16*)(F.ws + WS_WGU); bf16* DN = (bf16*)(F.ws + WS_WDN);
    const float* wg = in[12] + (size_t)layer * 16 * 1024 * 256; const float* wu = in[13] + (size_t)layer * 16 * 1024 * 256; const float* wd = in[14] + (size_t)layer * 16 * 256 * 1024;
    LAS float* scr = (LAS float*)(F.lds + F.wave * 16384);
    const int gw = F.vcu * NWAVES + F.wave, NGW = GRID * NWAVES;
    for (int it = gw; it < 16 * 384; it += NGW) { const int e = it / 384, r = it - e * 384, kind = r >> 7, sub = r & 127;
        if (kind == 0) transpose_item<MAP_MOE_G>(wg + (size_t)e * 1024 * 256, 1024, 256, GU, e * 512, nullptr, scr, sub, F.lane);
        else if (kind == 1) transpose_item<MAP_MOE_U>(wu + (size_t)e * 1024 * 256, 1024, 256, GU, e * 512, nullptr, scr, sub, F.lane);
        else transpose_item<MAP_ID>(wd + (size_t)e * 256 * 1024, 256, 1024, DN, e * 1024, nullptr, scr, sub, F.lane); }
}

__device__ __forceinline__ void norm_mod_row(const float* xrow, const float* g, const float* sc, const float* sh, bf16* orow, int lane, f32x4 (&hv)[4]) {
    const f32x4* xr = (const f32x4*)xrow + lane;
    f32x4 v[4]; float s = 0.f;
#pragma unroll
    for (int j = 0; j < 4; ++j) { v[j] = xr[64 * j]; s += (v[j].x * v[j].x + v[j].y * v[j].y) + (v[j].z * v[j].z + v[j].w * v[j].w); }
    const float rstd = rsqrtf(wave_sum(s) * (1.f / D) + EPS);
    unsigned long long* o8 = (unsigned long long*)orow + lane;
#pragma unroll
    for (int j = 0; j < 4; ++j) {
        const f32x4 gg = ((const f32x4*)g)[lane + 64 * j], ss = ((const f32x4*)sc)[lane + 64 * j], hh = ((const f32x4*)sh)[lane + 64 * j];
        f32x4 h = v[j] * rstd * gg * (ss + 1.0f) + hh; hv[j] = h;
        o8[64 * j] = (unsigned long long)cvt_pk_bf16(h.x, h.y) | ((unsigned long long)cvt_pk_bf16(h.z, h.w) << 32);
    }
}
__device__ __forceinline__ void phase_norm1(Frame& F, const float* const* in, int layer) {
    const float* X = (const float*)(F.ws + WS_X); bf16* H = (bf16*)(F.ws + WS_H);
    const float* g = in[4] + layer * D; const float* mod = (const float*)(F.ws + WS_MOD) + (size_t)layer * 9 * 6144;
    const int gw = F.vcu * NWAVES + F.wave, NGW = GRID * NWAVES;
    for (int r = gw; r < M; r += NGW) { const float* mr = mod + (size_t)modrow_of(r) * 6144; f32x4 hv[4];
        norm_mod_row(X + (size_t)r * D, g, mr + 1024, mr, H + (size_t)r * D, F.lane, hv); }
}

__device__ __forceinline__ void phase_prologue(Frame& F, const float* const* in) {
    { float* X = (float*)(F.ws + WS_X); const int gw = F.vcu * NWAVES + F.wave, NGW = GRID * NWAVES;
      for (int r = gw; r < M; r += NGW) { const int b = r / TPB, t = r - b * TPB;
          const float* src = t < CTX ? in[2] + ((size_t)b * CTX + t) * D : in[0] + ((size_t)b * SEQ + (t - CTX)) * D;
          const f32x4* s4 = (const f32x4*)src + F.lane; f32x4* d4 = (f32x4*)(X + (size_t)r * D) + F.lane;
#pragma unroll
          for (int j = 0; j < 4; ++j) d4[64 * j] = s4[64 * j]; } }
    { f32x2* TA = (f32x2*)(F.ws + WS_TABA); f32x2* TM = (f32x2*)(F.ws + WS_TABM);
      for (int i = blockIdx.x * NTHR + F.tid; i < SEQ * 32; i += GRID * NTHR) { const int pos = i >> 5, a = i & 31; const float p = (a < 16) ? (float)(pos >> 6) : (float)(pos & 63);
          const float inv = fast_exp2(-(float)(a & 15) * (13.287712379549449f / 16.0f)); const float rev = p * inv * 0.15915494309189535f; TA[i] = (f32x2){__builtin_amdgcn_cosf(rev), __builtin_amdgcn_sinf(rev)}; }
      for (int i = blockIdx.x * NTHR + F.tid; i < SEQ * 16; i += GRID * NTHR) { const int pos = i >> 4, a = i & 15; const float p = (a < 8) ? (float)(pos >> 6) : (float)(pos & 63);
          const float inv = fast_exp2(-(float)(a & 7) * (13.287712379549449f / 8.0f)); const float rev = p * inv * 0.15915494309189535f; TM[i] = (f32x2){__builtin_amdgcn_cosf(rev), __builtin_amdgcn_sinf(rev)}; } }
    { LAS float* sc = (LAS float*)F.lds;
      LAS float* part = (LAS float*)(F.lds + 40960);
      for (int i = F.tid; i < 9 * 1024; i += NTHR) { const int r = i >> 10, k = i & 1023; const float c = r < 8 ? in[1][r * 1024 + k] : in[3][k]; sc[i] = silu_f(c); }
      __syncthreads();
      float* MOD = (float*)(F.ws + WS_MOD);
      for (int u = F.vcu; u < 4 * 96; u += GRID) { const int l = u / 96, cb = u % 96, col = cb * 64 + (F.tid & 63), ks = F.tid >> 6;
          const float* w = in[6] + (size_t)l * 1024 * 6144 + col; float a[9];
#pragma unroll
          for (int r = 0; r < 9; ++r) a[r] = 0.f;
#pragma unroll 8
          for (int k = ks * 128; k < ks * 128 + 128; ++k) { const float wv = w[(size_t)k * 6144];
#pragma unroll
              for (int r = 0; r < 9; ++r) a[r] += sc[r * 1024 + k] * wv; }
#pragma unroll
          for (int r = 0; r < 9; ++r) part[(ks * 9 + r) * 64 + (F.tid & 63)] = a[r];
          __syncthreads();
          for (int i = F.tid; i < 9 * 64; i += NTHR) { const int r = i >> 6, c = i & 63; float s = 0.f;
#pragma unroll
              for (int q = 0; q < 8; ++q) s += part[(q * 9 + r) * 64 + c];
              MOD[((size_t)l * 9 + r) * 6144 + cb * 64 + c] = s + in[7][l * 6144 + cb * 64 + c]; }
          __syncthreads(); } }
}

__device__ __forceinline__ void phase_norm2_route(Frame& F, const float* const* in, int layer) {
    constexpr int RPW = M / GRID;
    LAS float* wl = (LAS float*)F.lds;
    LAS int* lcnt = (LAS int*)(F.lds + 81920);
    LAS int* lbase = (LAS int*)(F.lds + 81920 + 128);
    LAS int* rcls = (LAS int*)(F.lds + 81920 + 256);
    LAS int* rrank = (LAS int*)(F.lds + 81920 + 256 + 1024);
    LAS float* lgw = (LAS float*)(F.lds + 81920 + 4096);
    const float* wrg = in[8] + (size_t)layer * 1024 * 4; const float* wre = in[10] + (size_t)layer * 1024 * 16;
    for (int i = F.tid; i < 1024 * 4; i += NTHR) { const int k = i >> 2, o = i & 3; wl[o * 1024 + k] = wrg[i]; }
    for (int i = F.tid; i < 1024 * 16; i += NTHR) { const int k = i >> 4, o = i & 15; wl[(4 + o) * 1024 + k] = wre[i]; }
    if (F.tid < 24) lcnt[F.tid] = 0;
    __syncthreads();
    const float* X = (const float*)(F.ws + WS_X); bf16* H = (bf16*)(F.ws + WS_H);
    const float* g = in[5] + layer * D; const float* mod = (const float*)(F.ws + WS_MOD) + (size_t)layer * 9 * 6144;
    const float* brg = in[9] + layer * 4; const float* bre = in[11] + layer * 16;
    float* WT = (float*)(F.ws + MOE_WT); int* SL = (int*)(F.ws + MOE_SL);
    const int row0 = blockIdx.x * RPW;
    for (int i = F.wave; i < RPW; i += NWAVES) { const int r = row0 + i; const float* mr = mod + (size_t)modrow_of(r) * 6144; f32x4 hv[4];
        norm_mod_row(X + (size_t)r * D, g, mr + 4 * 1024, mr + 3 * 1024, H + (size_t)r * D, F.lane, hv);
        LAS float* lgs = lgw + F.wave * 32;
        for (int o = 0; o < 20; ++o) { float s = 0.f;
#pragma unroll
            for (int j = 0; j < 4; ++j) { const f32x4 w = *(const LAS f32x4*)(wl + o * 1024 + 4 * F.lane + 256 * j); s += (hv[j].x * w.x + hv[j].y * w.y) + (hv[j].z * w.z + hv[j].w * w.w); }
            s = wave_sum(s); if (F.lane == 0) lgs[o] = s; }
        LDS_WAIT(); asm volatile("" ::: "memory");
        float g0 = lgs[0] + brg[0], g1 = lgs[1] + brg[1], g2 = lgs[2] + brg[2], g3 = lgs[3] + brg[3];
        int gs = 0; float gm = g0; if (g1 > gm) { gm = g1; gs = 1; } if (g2 > gm) { gm = g2; gs = 2; } if (g3 > gm) { gm = g3; gs = 3; }
        const float pg = 1.0f / (fast_exp(g0 - gm) + fast_exp(g1 - gm) + fast_exp(g2 - gm) + fast_exp(g3 - gm));
        float e0 = lgs[4 + gs * 4 + 0] + bre[gs * 4 + 0], e1 = lgs[4 + gs * 4 + 1] + bre[gs * 4 + 1], e2 = lgs[4 + gs * 4 + 2] + bre[gs * 4 + 2], e3 = lgs[4 + gs * 4 + 3] + bre[gs * 4 + 3];
        LDS_WAIT(); asm volatile("" ::: "memory");
        int i1 = 0; float v1 = e0; if (e1 > v1) { v1 = e1; i1 = 1; } if (e2 > v1) { v1 = e2; i1 = 2; } if (e3 > v1) { v1 = e3; i1 = 3; }
        int i2 = -1; float v2 = -3.0e38f;
        if (i1 != 0 && e0 > v2) { v2 = e0; i2 = 0; } if (i1 != 1 && e1 > v2) { v2 = e1; i2 = 1; } if (i1 != 2 && e2 > v2) { v2 = e2; i2 = 2; } if (i1 != 3 && e3 > v2) { v2 = e3; i2 = 3; }
        const float ex = fast_exp(v2 - v1), w1 = pg / (1.0f + ex), w2 = pg * ex / (1.0f + ex);
        const int lo = i1 < i2 ? i1 : i2, hi = i1 < i2 ? i2 : i1; const float wlo = i1 < i2 ? w1 : w2, whi = i1 < i2 ? w2 : w1;
        const int pair = lo == 0 ? hi - 1 : (lo == 1 ? hi + 1 : 5);
        const int cls = gs * 6 + pair;
        if (F.lane == 0) { WT[2 * (size_t)r] = wlo; WT[2 * (size_t)r + 1] = whi; rcls[i] = cls; rrank[i] = atomicAdd((int*)&lcnt[cls], 1); }
    }
    __syncthreads();
    if (F.tid < 24) lbase[F.tid] = (int)atomicAdd(F.ctl + CW_MOECNT + layer * 64 + F.tid, (unsigned)lcnt[F.tid]);
    __syncthreads();
    for (int i = F.tid; i < RPW; i += NTHR) { const int c = rcls[i]; SL[(size_t)c * M + lbase[c] + rrank[i]] = row0 + i; }
}

__device__ __forceinline__ void phase_final(Frame& F, const float* const* in, bool poison) {
    const float* X = (const float*)(F.ws + WS_X); const float* g = in[36];
    const int gw = F.vcu * NWAVES + F.wave, NGW = GRID * NWAVES;
    for (int q = gw; q < NB * SEQ; q += NGW) { const int b = q / SEQ, p = q - b * SEQ; const int r = b * TPB + CTX + p;
        const f32x4* xr = (const f32x4*)(X + (size_t)r * D) + F.lane; f32x4 v[4]; float s = 0.f;
#pragma unroll
        for (int j = 0; j < 4; ++j) { v[j] = xr[64 * j]; s += (v[j].x * v[j].x + v[j].y * v[j].y) + (v[j].z * v[j].z + v[j].w * v[j].w); }
        float rstd = rsqrtf(wave_sum(s) * (1.f / D) + EPS); if (poison) rstd = __builtin_nanf("");
        f32x4* o = (f32x4*)(F.out + (size_t)q * D) + F.lane;
#pragma unroll
        for (int j = 0; j < 4; ++j) o[64 * j] = v[j] * rstd * ((const f32x4*)g)[F.lane + 64 * j]; }
}
typedef f32x4 AccT[2][2][4][2];
using pg8::Unit;

__device__ __forceinline__ v4u pack8(const f32x4 a, const f32x4 b) { v4u w; w.x = cvt_pk_bf16(a[0], a[1]); w.y = cvt_pk_bf16(a[2], a[3]); w.z = cvt_pk_bf16(b[0], b[1]); w.w = cvt_pk_bf16(b[2], b[3]); return w; }
__device__ __forceinline__ void rope8(f32x4& a, f32x4& b, const f32x2* cs) {
    const f32x4 c01 = *(const f32x4*)cs, c23 = *(const f32x4*)(cs + 2);
    float t;
    t = a[0] * c01[0] - a[1] * c01[1]; a[1] = a[1] * c01[0] + a[0] * c01[1]; a[0] = t;
    t = a[2] * c01[2] - a[3] * c01[3]; a[3] = a[3] * c01[2] + a[2] * c01[3]; a[2] = t;
    t = b[0] * c23[0] - b[1] * c23[1]; b[1] = b[1] * c23[0] + b[0] * c23[1]; b[0] = t;
    t = b[2] * c23[2] - b[3] * c23[3]; b[3] = b[3] * c23[2] + b[2] * c23[3]; b[2] = t;
}

struct EpiResid {
    static constexpr bool PERM = false;
    float* X; const float* gate;
    __device__ __forceinline__ void operator()(const AccT& acc, const Unit& u, int ui, int wr, int wc, int fr, int fq) const {
        const int tb = u.pm % 17, b = u.pm / 17; const float* gv = gate + (size_t)(tb == 0 ? 8 : b) * 6144;
        const int row0 = u.pm * 256 + wr * 64 + fr, col0 = u.pn * 256 + wc * 32 + 4 * fq;
        f32x4 g4[2][2];
#pragma unroll
        for (int bj = 0; bj < 2; ++bj)
#pragma unroll
            for (int n = 0; n < 2; ++n) g4[bj][n] = *(const f32x4*)(gv + col0 + bj * 128 + n * 16);
#pragma unroll
        for (int ai = 0; ai < 2; ++ai)
#pragma unroll
            for (int m = 0; m < 4; ++m) { float* rowp = X + (size_t)(row0 + ai * 128 + m * 16) * D + col0;
#pragma unroll
                for (int bj = 0; bj < 2; ++bj)
#pragma unroll
                    for (int n = 0; n < 2; ++n) { f32x4* p = (f32x4*)(rowp + bj * 128 + n * 16); *p = *p + g4[bj][n] * acc[ai][bj][m][n]; }
                asm volatile("" ::: "memory"); }
    }
};

struct EpiAttnIn {
    static constexpr bool PERM = true;
    bf16 *Q, *Kb, *Vb; const f32x2* tab; float qscale;
    __device__ __forceinline__ void operator()(const AccT& acc, const Unit& u, int ui, int wr, int wc, int fr, int fq) const {
        const int tb = u.pm % 17; const bool lat = tb != 0; const int pos0 = (tb - 1) * 256;
        bf16* base; int ld, colt; float sc = 1.f; bool rope = lat;
        if (u.pn < 4) { base = Q; ld = 1024; colt = u.pn * 256; sc = qscale; } else if (u.pn == 4) { base = Kb; ld = 256; colt = 0; } else { base = Vb; ld = 256; colt = 0; rope = false; }
#pragma unroll
        for (int ai = 0; ai < 2; ++ai)
#pragma unroll
            for (int m = 0; m < 4; ++m) { const int rl = ai * 128 + wr * 64 + m * 16 + fr; const size_t row = (size_t)u.pm * 256 + rl;
#pragma unroll
                for (int bj = 0; bj < 2; ++bj) { const int cl = bj * 128 + wc * 32 + 8 * fq;
                    f32x4 a = acc[ai][bj][m][0] * sc, b = acc[ai][bj][m][1] * sc;
                    if (rope) rope8(a, b, tab + (size_t)(pos0 + rl) * 32 + ((cl & 63) >> 1));
                    *(v4u*)(base + row * ld + colt + cl) = pack8(a, b); }
                asm volatile("" ::: "memory"); }
    }
};

struct EpiSsmIn {
    static constexpr bool PERM = true;
    bf16 *Z, *XBC; float* DT; const float* dtb;
    __device__ __forceinline__ void operator()(const AccT& acc, const Unit& u, int ui, int wr, int wc, int fr, int fq) const {
#pragma unroll
        for (int ai = 0; ai < 2; ++ai)
#pragma unroll
            for (int m = 0; m < 4; ++m) { const size_t row = (size_t)u.pm * 256 + ai * 128 + wr * 64 + m * 16 + fr;
#pragma unroll
                for (int bj = 0; bj < 2; ++bj) { const int c = u.pn * 256 + bj * 128 + wc * 32 + 8 * fq;
                    const f32x4 a = acc[ai][bj][m][0], b = acc[ai][bj][m][1];
                    if (c < 1024) *(v4u*)(Z + row * 1024 + c) = pack8(a, b);
                    else if (c < 2560) *(v4u*)(XBC + row * 1536 + (c - 1024)) = pack8(a, b);
                    else if (c < 2592) { const int cc = c - 2560; f32x4 o0, o1;
#pragma unroll
                        for (int j = 0; j < 4; ++j) { o0[j] = softplus_f(a[j] + dtb[(cc >> 4) * 32 + (cc & 15) + j]); o1[j] = softplus_f(b[j] + dtb[(cc >> 4) * 32 + (cc & 15) + 4 + j]); }
                        *(f32x4*)(DT + row * 32 + cc) = o0; *(f32x4*)(DT + row * 32 + cc + 4) = o1; } } }
    }
};

struct EpiMlIn {
    static constexpr bool PERM = true;
    bf16 *Qm, *Km, *Vm, *Om; float* G; const float* gb;
    __device__ __forceinline__ void operator()(const AccT& acc, const Unit& u, int ui, int wr, int wc, int fr, int fq) const {
#pragma unroll
        for (int ai = 0; ai < 2; ++ai)
#pragma unroll
            for (int m = 0; m < 4; ++m) { const size_t row = (size_t)u.pm * 256 + ai * 128 + wr * 64 + m * 16 + fr;
#pragma unroll
                for (int bj = 0; bj < 2; ++bj) { const int c = u.pn * 256 + bj * 128 + wc * 32 + 8 * fq;
                    const f32x4 a = acc[ai][bj][m][0], b = acc[ai][bj][m][1];
                    if (c < 512) *(v4u*)(Qm + row * 512 + c) = pack8(a, b);
                    else if (c < 1024) *(v4u*)(Km + row * 512 + (c - 512)) = pack8(a * 0.125f, b * 0.125f);
                    else if (c < 2048) *(v4u*)(Vm + row * 1024 + (c - 1024)) = pack8(a, b);
                    else if (c < 3072) *(v4u*)(Om + row * 1024 + (c - 2048)) = pack8(a, b);
                    else if (c < 3104) { const int cc = c - 3072; f32x4 o0, o1; const bool fg = ((cc >> 3) & 1) != 0;
#pragma unroll
                        for (int j = 0; j < 4; ++j) { float x0 = a[j] + gb[cc + j], x1 = b[j] + gb[cc + 4 + j];
                            o0[j] = fg ? -softplus_f(-x0) : x0; o1[j] = fg ? -softplus_f(-x1) : x1; }
                        *(f32x4*)(G + row * 32 + cc) = o0; *(f32x4*)(G + row * 32 + cc + 4) = o1; } } }
    }
};

struct EpiMlaIn {
    static constexpr bool PERM = true;
    bf16 *CQ, *CKV, *KF; float* SSQ; const f32x2* tab;
    __device__ __forceinline__ void operator()(const AccT& acc, const Unit& u, int ui, int wr, int wc, int fr, int fq) const {
        const int tb = u.pm % 17; const bool lat = tb != 0; const int pos0 = (tb - 1) * 256;
#pragma unroll
        for (int ai = 0; ai < 2; ++ai)
#pragma unroll
            for (int m = 0; m < 4; ++m) { const int rl = ai * 128 + wr * 64 + m * 16 + fr; const size_t row = (size_t)u.pm * 256 + rl;
                if (u.pn < 2) { bf16* dst = u.pn == 0 ? CQ : CKV; float ss = 0.f;
#pragma unroll
                    for (int bj = 0; bj < 2; ++bj) { const int c = bj * 128 + wc * 32 + 8 * fq; const f32x4 a = acc[ai][bj][m][0], b = acc[ai][bj][m][1];
                        ss += (a[0] * a[0] + a[1] * a[1]) + (a[2] * a[2] + a[3] * a[3]) + (b[0] * b[0] + b[1] * b[1]) + (b[2] * b[2] + b[3] * b[3]);
                        *(v4u*)(dst + row * 256 + c) = pack8(a, b); }
                    ss += __shfl_xor(ss, 16); ss += __shfl_xor(ss, 32);
                    if (fq == 0) SSQ[row * 8 + u.pn * 4 + wc] = ss;
                } else if (wc == 0) {
                    f32x4 a = acc[ai][0][m][0], b = acc[ai][0][m][1]; const int cl = 8 * fq;
                    if (lat) rope8(a, b, tab + (size_t)(pos0 + rl) * 16 + (cl >> 1));
                    const v4u w = pack8(a, b);
#pragma unroll
                    for (int h = 0; h < 16; ++h) *(v4u*)(KF + row * 1536 + h * 96 + 64 + cl) = w; }
                asm volatile("" ::: "memory"); }
    }
};
struct EpiMlaQ {
    static constexpr bool PERM = true;
    bf16* Q3; const float* SSQ; const f32x2* tab; float qscale;
    __device__ __forceinline__ void operator()(const AccT& acc, const Unit& u, int ui, int wr, int wc, int fr, int fq) const {
        const int tb = u.pm % 17; const bool lat = tb != 0; const int pos0 = (tb - 1) * 256;
#pragma unroll
        for (int ai = 0; ai < 2; ++ai)
#pragma unroll
            for (int m = 0; m < 4; ++m) { const int rl = ai * 128 + wr * 64 + m * 16 + fr; const size_t row = (size_t)u.pm * 256 + rl;
                const f32x4 s4 = *(const f32x4*)(SSQ + row * 8); const float rs = rsqrtf(((s4[0] + s4[1]) + (s4[2] + s4[3])) * (1.f / 256.f) + EPS) * qscale;
#pragma unroll
                for (int bj = 0; bj < 2; ++bj) { const int c = u.pn * 256 + bj * 128 + wc * 32 + 8 * fq; const int e = c % 96;
                    f32x4 a = acc[ai][bj][m][0] * rs, b = acc[ai][bj][m][1] * rs;
                    if (lat && e >= 64) rope8(a, b, tab + (size_t)(pos0 + rl) * 16 + ((e - 64) >> 1));
                    *(v4u*)(Q3 + row * 1536 + c) = pack8(a, b); }
                asm volatile("" ::: "memory"); }
    }
};
struct EpiMlaKV {
    static constexpr bool PERM = true;
    bf16 *KF, *V3; const float* SSQ;
    __device__ __forceinline__ void operator()(const AccT& acc, const Unit& u, int ui, int wr, int wc, int fr, int fq) const {
#pragma unroll
        for (int ai = 0; ai < 2; ++ai)
#pragma unroll
            for (int m = 0; m < 4; ++m) { const size_t row = (size_t)u.pm * 256 + ai * 128 + wr * 64 + m * 16 + fr;
                const f32x4 s4 = *(const f32x4*)(SSQ + row * 8 + 4); const float rs = rsqrtf(((s4[0] + s4[1]) + (s4[2] + s4[3])) * (1.f / 256.f) + EPS);
#pragma unroll
                for (int bj = 0; bj < 2; ++bj) { const int c = u.pn * 256 + bj * 128 + wc * 32 + 8 * fq; const int h = c >> 7, e = c & 127;
                    const v4u w = pack8(acc[ai][bj][m][0] * rs, acc[ai][bj][m][1] * rs);
                    if (e < 64) *(v4u*)(KF + row * 1536 + h * 96 + e) = w; else *(v4u*)(V3 + row * 1024 + h * 64 + (e - 64)) = w; }
                asm volatile("" ::: "memory"); }
    }
};

struct TblEnt { int tok; float w0, w1; int pad; };
__device__ __forceinline__ int cls_expert(int cls, int which) { const int g = cls / 6, p = cls - g * 6; const int lo = p < 3 ? 0 : (p < 5 ? 1 : 2), hi = p < 3 ? p + 1 : (p < 5 ? p - 1 : 3); return g * 4 + (which ? hi : lo); }
template <int MODE> struct MoeOrder {
    static constexpr bool GATHER = (MODE == 0);
    const LAS int* tb;
    const LAS TblEnt* tbl;
    const bf16* W; int G, c;
    __device__ __forceinline__ bool next(int i, Unit& u) const {
        const int L = i * G + c, tile = L >> 2; if (tile >= tb[24]) return false;
        int cls = 0;
#pragma unroll
        for (int k = 1; k < 24; ++k) cls += (tile >= tb[k]) ? 1 : 0;
        u.pm = tile; u.pn = L & 3; u.aux = cls | (i << 8); return true;
    }
    __device__ __forceinline__ int a_row(const Unit& u, int r) const {
        if (MODE == 1) return u.pm * 256 + r;
        const int t = tbl[(u.aux >> 8) * 256 + r].tok; return t < 0 ? 0 : t;
    }
    __device__ __forceinline__ const char* b_seg(const Unit& u, int seg) const {
        const int cls = u.aux & 255;
        if (MODE == 0) return (const char*)(W + ((size_t)cls_expert(cls, u.pn >> 1) * 512 + (u.pn & 1) * 256) * 1024);
        return (const char*)(W + ((size_t)cls_expert(cls, seg) * 1024 + u.pn * 256) * 256);
    }
};
template <int MODE> __device__ __forceinline__ void moe_setup(Frame& F, int layer, MoeOrder<MODE>& S) {
    LAS int* tb = (LAS int*)(F.lds + LDS_TB); LAS int* cn = tb + 32; LAS TblEnt* tbl = (LAS TblEnt*)(F.lds + LDS_TBL);
    if (F.tid == 0) { int t = 0; for (int k = 0; k < 24; ++k) { const int n = (int)__hip_atomic_load(F.ctl + CW_MOECNT + layer * 64 + k, RLX_AGENT); cn[k] = n; tb[k] = t; t += (n + 255) >> 8; } tb[24] = t; }
    __syncthreads();
    S.tb = tb; S.tbl = tbl;
    const int* SL = (const int*)(F.ws + MOE_SL); const float* WT = (const float*)(F.ws + MOE_WT);
    for (int i = 0; i < 4; ++i) { Unit u; if (!S.next(i, u)) break;
        if (F.tid < 256) { const int cls = u.aux & 255, idx = (u.pm - tb[cls]) * 256 + F.tid; TblEnt e; e.pad = 0;
            if (idx < cn[cls]) { e.tok = SL[(size_t)cls * M + idx]; e.w0 = WT[2 * (size_t)e.tok]; e.w1 = WT[2 * (size_t)e.tok + 1]; } else { e.tok = -1; e.w0 = 0.f; e.w1 = 0.f; }
            LAS TblEnt* te = tbl + i * 256 + F.tid; te->tok = e.tok; te->w0 = e.w0; te->w1 = e.w1; te->pad = 0; } }
    __syncthreads();
}
struct EpiMoeAct {
    static constexpr bool PERM = true;
    bf16* ACT; const LAS TblEnt* tbl;
    __device__ __forceinline__ void operator()(const AccT& acc, const Unit& u, int ui, int wr, int wc, int fr, int fq) const {
        const int slot = u.pn >> 1, colb = slot * 256 + (u.pn & 1) * 128 + wc * 32 + 8 * fq;
#pragma unroll
        for (int ai = 0; ai < 2; ++ai)
#pragma unroll
            for (int m = 0; m < 4; ++m) { const int rl = ai * 128 + wr * 64 + m * 16 + fr; const LAS TblEnt* te = tbl + (u.aux >> 8) * 256 + rl; const float w = slot ? te->w1 : te->w0;
                f32x4 a, b;
#pragma unroll
                for (int j = 0; j < 4; ++j) { a[j] = silu_f(acc[ai][0][m][0][j]) * acc[ai][1][m][0][j] * w; b[j] = silu_f(acc[ai][0][m][1][j]) * acc[ai][1][m][1][j] * w; }
                *(v4u*)(ACT + ((size_t)u.pm * 256 + rl) * 512 + colb) = pack8(a, b);
                asm volatile("" ::: "memory"); }
    }
};
struct EpiMoeDown {
    static constexpr bool PERM = false;
    float* X; const float* gate; const LAS TblEnt* tbl;
    __device__ __forceinline__ void operator()(const AccT& acc, const Unit& u, int ui, int wr, int wc, int fr, int fq) const {
        const int col0 = u.pn * 256 + wc * 32 + 4 * fq;
#pragma unroll
        for (int ai = 0; ai < 2; ++ai)
#pragma unroll
            for (int m = 0; m < 4; ++m) { const int rl = ai * 128 + wr * 64 + m * 16 + fr; const int tok = tbl[(u.aux >> 8) * 256 + rl].tok;
                if (tok >= 0) { float* rowp = X + (size_t)tok * D + col0; const float* gv = gate + (size_t)modrow_of(tok) * 6144 + col0;
#pragma unroll
                    for (int bj = 0; bj < 2; ++bj)
#pragma unroll
                        for (int n = 0; n < 2; ++n) { f32x4* p = (f32x4*)(rowp + bj * 128 + n * 16); *p = *p + *(const f32x4*)(gv + bj * 128 + n * 16) * acc[ai][bj][m][n]; } }
                asm volatile("" ::: "memory"); }
    }
};
template <int DQK, bool WIN>
__device__ __forceinline__ void flash_unit(LAS unsigned char* lds, const int tid, const int lane,
        const bf16* Kg, const int ldk, const bf16* Vg, const int ldv,
        const bf16* Qg, const int ldq, bf16* Og, const int ldo,
        const int ntiles, const int krow_ctx0, const int krow_lat0, const int kpos0, const int qpos_wave, const float sink2, const bool has_sink) {
    constexpr int KSTR = DQK * 2 + 16, VSTR = 160, KBUF = 64 * KSTR, VBUF = 64 * VSTR, CPR = DQK / 8, NKC = 64 * CPR, NKR = (NKC + 511) / 512, NKS = DQK / 32;
    LAS unsigned char* Kl = lds; LAS unsigned char* Vl = lds + 2 * KBUF;
    const int fr = lane & 15, fq = lane >> 4;
    bf16x8 qf[2][NKS];
#pragma unroll
    for (int qt = 0; qt < 2; ++qt)
#pragma unroll
        for (int ks = 0; ks < NKS; ++ks) qf[qt][ks] = *(const bf16x8*)(Qg + (size_t)(16 * qt + fr) * ldq + 32 * ks + 8 * fq);
    f32x4 oacc[4][2];
#pragma unroll
    for (int c = 0; c < 4; ++c) { oacc[c][0] = (f32x4){0.f, 0.f, 0.f, 0.f}; oacc[c][1] = (f32x4){0.f, 0.f, 0.f, 0.f}; }
    float mrun[2] = {-1.0e30f, -1.0e30f}, lsum[2] = {0.f, 0.f};
    v4u kreg[NKR], vreg;
#define FA_LOAD(j) do { const int _rb = (j) < 4 ? krow_ctx0 + 64 * (j) : krow_lat0 + 64 * ((j) - 4); \
        _Pragma("unroll") for (int _i = 0; _i < NKR; ++_i) { const int _c = tid + 512 * _i; if (_c < NKC) kreg[_i] = *(const v4u*)(Kg + (size_t)(_rb + _c / CPR) * ldk + (_c % CPR) * 8); } \
        vreg = *(const v4u*)(Vg + (size_t)(_rb + (tid >> 3)) * ldv + (tid & 7) * 8); } while (0)
#define FA_STORE(buf) do { _Pragma("unroll") for (int _i = 0; _i < NKR; ++_i) { const int _c = tid + 512 * _i; if (_c < NKC) *(LAS v4u*)(Kl + (buf) * KBUF + (_c / CPR) * KSTR + (_c % CPR) * 16) = kreg[_i]; } \
        *(LAS v4u*)(Vl + (buf) * VBUF + (tid >> 3) * VSTR + (tid & 7) * 16) = vreg; } while (0)
    FA_LOAD(0); FA_STORE(0); __syncthreads();
    for (int j = 0; j < ntiles; ++j) {
        const int buf = j & 1;
        if (j + 1 < ntiles) FA_LOAD(j + 1);
        bool skip = false; const int kp = kpos0 + 64 * (j - 4);
        if (WIN && j >= 4) skip = (kp + 63 < qpos_wave - 128) || (kp > qpos_wave + 31 + 128);
        if (!skip) {
            f32x4 sacc[4][2];
#pragma unroll
            for (int kt = 0; kt < 4; ++kt) { sacc[kt][0] = (f32x4){0.f, 0.f, 0.f, 0.f}; sacc[kt][1] = (f32x4){0.f, 0.f, 0.f, 0.f}; }
#pragma unroll
            for (int ks = 0; ks < NKS; ++ks) { bf16x8 kf[4];
#pragma unroll
                for (int kt = 0; kt < 4; ++kt) kf[kt] = *(const LAS bf16x8*)(Kl + buf * KBUF + (16 * kt + fr) * KSTR + (32 * ks + 8 * fq) * 2);
#pragma unroll
                for (int kt = 0; kt < 4; ++kt) { sacc[kt][0] = __builtin_amdgcn_mfma_f32_16x16x32_bf16(kf[kt], qf[0][ks], sacc[kt][0], 0, 0, 0);
                                                 sacc[kt][1] = __builtin_amdgcn_mfma_f32_16x16x32_bf16(kf[kt], qf[1][ks], sacc[kt][1], 0, 0, 0); } }
            if (WIN && j >= 4) {
#pragma unroll
                for (int kt = 0; kt < 4; ++kt)
#pragma unroll
                    for (int qt = 0; qt < 2; ++qt)
#pragma unroll
                        for (int jj = 0; jj < 4; ++jj) { const int d = (kp + 16 * kt + 4 * fq + jj) - (qpos_wave + 16 * qt + fr); if (d < -128 || d > 128) sacc[kt][qt][jj] = -1.0e30f; } }
            bf16x8 pf[2][2];
#pragma unroll
            for (int qt = 0; qt < 2; ++qt) {
                float mx = sacc[0][qt][0];
#pragma unroll
                for (int kt = 0; kt < 4; ++kt)
#pragma unroll
                    for (int jj = 0; jj < 4; ++jj) mx = fmaxf(mx, sacc[kt][qt][jj]);
                mx = fmaxf(mx, __shfl_xor(mx, 16)); mx = fmaxf(mx, __shfl_xor(mx, 32));
                const float mnew = fmaxf(mrun[qt], mx), alpha = fast_exp2(mrun[qt] - mnew); mrun[qt] = mnew;
                float ps = 0.f;
#pragma unroll
                for (int kt = 0; kt < 4; ++kt)
#pragma unroll
                    for (int jj = 0; jj < 4; ++jj) { const float p = fast_exp2(sacc[kt][qt][jj] - mnew); sacc[kt][qt][jj] = p; ps += p; }
                lsum[qt] = lsum[qt] * alpha + ps;
#pragma unroll
                for (int c = 0; c < 4; ++c) oacc[c][qt] = oacc[c][qt] * alpha;
#pragma unroll
                for (int ks2 = 0; ks2 < 2; ++ks2) { const v4u w = pack8(sacc[2 * ks2][qt], sacc[2 * ks2 + 1][qt]); pf[qt][ks2] = __builtin_bit_cast(bf16x8, w); }
            }
#pragma unroll
            for (int ks2 = 0; ks2 < 2; ++ks2)
#pragma unroll
                for (int c = 0; c < 4; ++c) {
                    const LAS unsigned char* vb = Vl + buf * VBUF + (32 * ks2 + 4 * fq + ((lane & 15) >> 2)) * VSTR + (16 * c + 4 * (lane & 3)) * 2;
                    const s16x4 v0 = __builtin_amdgcn_ds_read_tr16_b64_v4i16((LAS s16x4*)vb);
                    const s16x4 v1 = __builtin_amdgcn_ds_read_tr16_b64_v4i16((LAS s16x4*)(vb + 16 * VSTR));
                    bf16x8 vf; vf[0] = v0[0]; vf[1] = v0[1]; vf[2] = v0[2]; vf[3] = v0[3]; vf[4] = v1[0]; vf[5] = v1[1]; vf[6] = v1[2]; vf[7] = v1[3];
                    oacc[c][0] = __builtin_amdgcn_mfma_f32_16x16x32_bf16(vf, pf[0][ks2], oacc[c][0], 0, 0, 0);
                    oacc[c][1] = __builtin_amdgcn_mfma_f32_16x16x32_bf16(vf, pf[1][ks2], oacc[c][1], 0, 0, 0); }
        }
        if (j + 1 < ntiles) FA_STORE(buf ^ 1);
        __syncthreads();
    }
#pragma unroll
    for (int qt = 0; qt < 2; ++qt) { float l = lsum[qt]; l += __shfl_xor(l, 16); l += __shfl_xor(l, 32); if (has_sink) l += fast_exp2(sink2 - mrun[qt]);
        const float inv = 1.0f / l;
#pragma unroll
        for (int c = 0; c < 4; ++c) { const f32x4 o = oacc[c][qt] * inv; v2u w; w.x = cvt_pk_bf16(o[0], o[1]); w.y = cvt_pk_bf16(o[2], o[3]);
            *(v2u*)(Og + (size_t)(16 * qt + fr) * ldo + 16 * c + 4 * fq) = w; } }
#undef FA_LOAD
#undef FA_STORE
}

__device__ __forceinline__ void phase_attn_window(Frame& F, const float* const* in, bf16* Q, const bf16* Kb, const bf16* Vb) {
    constexpr int NLAT = NB * 4 * 64, NCTX = NB * 4 * 4;
    for (int un = F.vcu; un < NLAT + NCTX; un += GRID) {
        int b, kvh, q0, ntiles, kpos0, qrow0;
        if (un < NLAT) { b = un >> 8; kvh = (un >> 6) & 3; q0 = (un & 63) * 64; kpos0 = q0 >= 128 ? q0 - 128 : 0; const int kend = q0 + 192 <= SEQ ? q0 + 192 : SEQ; ntiles = 4 + (kend - kpos0) / 64; qrow0 = b * TPB + CTX + q0; }
        else { const int v = un - NLAT; b = v >> 4; kvh = (v >> 2) & 3; q0 = (v & 3) * 64; kpos0 = 0; ntiles = 4; qrow0 = b * TPB + q0; }
        const int g = F.wave >> 1, half = F.wave & 1, head = kvh * 4 + g;
        bf16* qp = Q + (size_t)(qrow0 + 32 * half) * 1024 + head * 64;
        flash_unit<64, true>(F.lds, F.tid, F.lane, Kb + kvh * 64, 256, Vb + kvh * 64, 256, qp, 1024, qp, 1024,
                             ntiles, b * TPB, b * TPB + CTX + kpos0, kpos0, q0 + 32 * half, in[16][head] * LOG2E, true);
    }
}
__device__ __forceinline__ void phase_attn_mla(Frame& F, const bf16* Q3, const bf16* KF, const bf16* V3, bf16* O) {
    for (int un = F.vcu; un < NB * 16 * 16; un += GRID) { const int b = un >> 8, head = (un >> 4) & 15, qb = un & 15; const int qrow = b * TPB + CTX + qb * 256 + 32 * F.wave;
        flash_unit<96, false>(F.lds, F.tid, F.lane, KF + head * 96, 1536, V3 + head * 64, 1024, Q3 + (size_t)qrow * 1536 + head * 96, 1536, O + (size_t)qrow * 1024 + head * 64, 1024,
                              68, b * TPB, b * TPB + CTX, 0, 0, 0.f, false);
    }
}
__device__ __forceinline__ int scan_row(int dir, int tau) { return dir == 0 ? tau : (tau < CTX ? CTX - 1 - tau : (TPB + CTX - 1) - tau); }

__device__ __forceinline__ void phase_ssm_conv(Frame& F, const float* const* in, int gp, const bf16* XP, bf16* XS, bf16* BC, const float* DT, float* ACUM) {
    constexpr int RPW = M / GRID;
    if (F.tid < 384) {
    const int cg = F.tid % 192, rsub = F.tid / 192, c0 = cg * 8;
    const int oc = c0 < 1024 ? gp * 1024 + c0 : (c0 < 1280 ? 2048 + gp * 256 + (c0 - 1024) : 2560 + gp * 256 + (c0 - 1280));
    float w[5][8], bb[8];
#pragma unroll
    for (int k = 0; k < 5; ++k)
#pragma unroll
        for (int i = 0; i < 8; ++i) w[k][i] = in[19][k * 3072 + oc + i];
#pragma unroll
    for (int i = 0; i < 8; ++i) bb[i] = in[20][oc + i];
    const int row0 = blockIdx.x * RPW;
    for (int r = row0 + rsub; r < row0 + RPW; r += 2) { const int t = r % TPB; const int lo = t < CTX ? 0 : CTX, hi = t < CTX ? CTX : TPB;
        float a[8];
#pragma unroll
        for (int i = 0; i < 8; ++i) a[i] = bb[i];
#pragma unroll
        for (int k = 0; k < 5; ++k) { const int tt = t + k - 2; if (tt >= lo && tt < hi) { const v4u x = *(const v4u*)(XP + (size_t)(r + k - 2) * 1536 + c0);
                a[0] += w[k][0] * bflo(x.x); a[1] += w[k][1] * bfhi(x.x); a[2] += w[k][2] * bflo(x.y); a[3] += w[k][3] * bfhi(x.y);
                a[4] += w[k][4] * bflo(x.z); a[5] += w[k][5] * bfhi(x.z); a[6] += w[k][6] * bflo(x.w); a[7] += w[k][7] * bfhi(x.w); } }
        v4u o; o.x = cvt_pk_bf16(silu_f(a[0]), silu_f(a[1])); o.y = cvt_pk_bf16(silu_f(a[2]), silu_f(a[3])); o.z = cvt_pk_bf16(silu_f(a[4]), silu_f(a[5])); o.w = cvt_pk_bf16(silu_f(a[6]), silu_f(a[7]));
        if (c0 < 1024) *(v4u*)(XS + (size_t)r * 1024 + c0) = o; else *(v4u*)(BC + (size_t)r * 512 + (c0 - 1024)) = o; }
    } else {
        const int chain = blockIdx.x * 128 + (F.tid - 384);
        if (chain < NB * 2 * 16 * 68) { const int ck = chain % 68, hl = (chain / 68) & 15, dir = (chain / (68 * 16)) & 1, b = chain / (68 * 32);
            const float Ah = -fast_exp(in[22][dir * 32 + gp * 16 + hl]) * LOG2E; float acc = 0.f;
#pragma unroll 1
            for (int h2 = 0; h2 < 2; ++h2) { float dv[32];
#pragma unroll
                for (int s = 0; s < 32; ++s) dv[s] = DT[(size_t)(b * TPB + scan_row(dir, ck * 64 + h2 * 32 + s)) * 32 + dir * 16 + hl];
#pragma unroll
                for (int s = 0; s < 32; ++s) { acc += dv[s] * Ah; ACUM[(size_t)(b * TPB + scan_row(dir, ck * 64 + h2 * 32 + s)) * 32 + dir * 16 + hl] = acc; } } }
    }
}

__device__ __forceinline__ void phase_ssm_scan(Frame& F, const float* const* in, int gp, const bf16* XS, const bf16* BC, const float* DT, const bf16* Z, bf16* Y) {
    constexpr int T = 32;
    LAS float* Bf = (LAS float*)F.lds;
    LAS float* Cf = (LAS float*)(F.lds + 16384);
    LAS float* U = (LAS float*)(F.lds + 32768);
    LAS float* XT = (LAS float*)(F.lds + 40960);
    LAS float* DEC = (LAS float*)(F.lds + 49152);
    LAS float* PART = (LAS float*)(F.lds + 49152 + 256);
    const int it = blockIdx.x, b = it >> 5, hl = (it >> 1) & 15, ph = it & 1, head = gp * 16 + hl, gl = hl >> 3;
    const int col = hl * 64 + ph * 32;
    const int p = F.tid & 31, ns = F.tid >> 5;
    const float dskip = in[23][head] + in[23][32 + head];
    const int st = F.tid >> 4, sch = F.tid & 15;
    const int xt = F.tid >> 2, xch = F.tid & 3;
    for (int dir = 0; dir < 2; ++dir) {
        const float Ah = -fast_exp(in[22][dir * 32 + head]) * LOG2E;
        float S[8];
#pragma unroll
        for (int i = 0; i < 8; ++i) S[i] = 0.f;
        v4u rb, rc, rx; float rdt = 0.f;
#define SS_LOAD(tile) do { const int _rB = b * TPB + scan_row(dir, (tile) * T + st); rb = *(const v4u*)(BC + (size_t)_rB * 512 + gl * 128 + sch * 8); rc = *(const v4u*)(BC + (size_t)_rB * 512 + 256 + gl * 128 + sch * 8); \
            if (F.tid < 128) { const int _rX = b * TPB + scan_row(dir, (tile) * T + xt); rx = *(const v4u*)(XS + (size_t)_rX * 1024 + col + xch * 8); rdt = DT[(size_t)_rX * 32 + dir * 16 + hl]; } } while (0)
#define SS_STORE(nb) do { LAS float* _b = Bf + st * 128 + sch * 8; LAS float* _c = Cf + st * 128 + sch * 8; \
            *(LAS f32x4*)_b = (f32x4){bflo(rb.x), bfhi(rb.x), bflo(rb.y), bfhi(rb.y)}; *(LAS f32x4*)(_b + 4) = (f32x4){bflo(rb.z), bfhi(rb.z), bflo(rb.w), bfhi(rb.w)}; \
            *(LAS f32x4*)_c = (f32x4){bflo(rc.x), bfhi(rc.x), bflo(rc.y), bfhi(rc.y)}; *(LAS f32x4*)(_c + 4) = (f32x4){bflo(rc.z), bfhi(rc.z), bflo(rc.w), bfhi(rc.w)}; \
            if (F.tid < 128) { const f32x4 x0 = (f32x4){bflo(rx.x), bfhi(rx.x), bflo(rx.y), bfhi(rx.y)}, x1 = (f32x4){bflo(rx.z), bfhi(rx.z), bflo(rx.w), bfhi(rx.w)}; \
                LAS float* _x = XT + (nb) * 1024 + xt * 32 + xch * 8; LAS float* _u = U + (nb) * 1024 + xt * 32 + xch * 8; \
                *(LAS f32x4*)_x = x0; *(LAS f32x4*)(_x + 4) = x1; *(LAS f32x4*)_u = x0 * rdt; *(LAS f32x4*)(_u + 4) = x1 * rdt; \
                if (xch == 0) DEC[(nb) * 32 + xt] = fast_exp2(rdt * Ah); } } while (0)
        __syncthreads();
        SS_LOAD(0); SS_STORE(0); __syncthreads();
        constexpr int NT = TPB / T;
        for (int tile = 0; tile < NT; ++tile) { const int cb = tile & 1;
            if (tile + 1 < NT) SS_LOAD(tile + 1);
            const LAS float* u_ = U + cb * 1024 + p; const LAS float* d_ = DEC + cb * 32;
#pragma unroll 4
            for (int t = 0; t < T; ++t) {
                const float dec = d_[t], u = u_[t * 32];
                const f32x4 b0 = *(const LAS f32x4*)(Bf + t * 128 + ns * 8), b1 = *(const LAS f32x4*)(Bf + t * 128 + ns * 8 + 4);
                const f32x4 c0 = *(const LAS f32x4*)(Cf + t * 128 + ns * 8), c1 = *(const LAS f32x4*)(Cf + t * 128 + ns * 8 + 4);
                float pt = 0.f;
#pragma unroll
                for (int i = 0; i < 4; ++i) { S[i] = S[i] * dec + b0[i] * u; pt += c0[i] * S[i]; S[4 + i] = S[4 + i] * dec + b1[i] * u; pt += c1[i] * S[4 + i]; }
                pt += __shfl_xor(pt, 32);
                if (F.lane < 32) PART[(F.wave * 32 + t) * 32 + p] = pt;
            }
            __syncthreads();
#pragma unroll
            for (int k = 0; k < 2; ++k) { const int t = (F.tid >> 5) + 16 * k; float y = 0.f;
#pragma unroll
                for (int w = 0; w < 8; ++w) y += PART[(w * 32 + t) * 32 + p];
                const size_t ro = (size_t)(b * TPB + scan_row(dir, tile * T + t));
                if (dir == 0) Y[ro * 1024 + col + p] = (bf16)f2bf(y);
                else { const float yt = y + bf2f(Y[ro * 1024 + col + p]) + dskip * XT[cb * 1024 + t * 32 + p]; const float zz = bf2f(Z[ro * 1024 + col + p]);
                    Y[ro * 1024 + col + p] = (bf16)f2bf(yt * silu_f(zz)); } }
            if (tile + 1 < NT) SS_STORE(cb ^ 1);
            __syncthreads();
        }
#undef SS_LOAD
#undef SS_STORE
    }
}
__device__ __forceinline__ void phase_ssm_gnorm(Frame& F, const float* const* in, int gp, bf16* Y) {
    const int gw = F.vcu * NWAVES + F.wave, NGW = GRID * NWAVES; const float* ng = in[24] + gp * 1024 + 16 * F.lane;
    for (int r = gw; r < M; r += NGW) { v4u* p = (v4u*)(Y + (size_t)r * 1024 + 16 * F.lane); const v4u a = p[0], c = p[1];
        float v[16] = {bflo(a.x), bfhi(a.x), bflo(a.y), bfhi(a.y), bflo(a.z), bfhi(a.z), bflo(a.w), bfhi(a.w), bflo(c.x), bfhi(c.x), bflo(c.y), bfhi(c.y), bflo(c.z), bfhi(c.z), bflo(c.w), bfhi(c.w)};
        float ss = 0.f;
#pragma unroll
        for (int i = 0; i < 16; ++i) ss += v[i] * v[i];
#pragma unroll
        for (int o = 1; o < 32; o <<= 1) ss += __shfl_xor(ss, o);
        const float rs = rsqrtf(ss * (1.f / 512.f) + EPS);
        v4u o0, o1;
        o0.x = cvt_pk_bf16(v[0] * rs * ng[0], v[1] * rs * ng[1]); o0.y = cvt_pk_bf16(v[2] * rs * ng[2], v[3] * rs * ng[3]); o0.z = cvt_pk_bf16(v[4] * rs * ng[4], v[5] * rs * ng[5]); o0.w = cvt_pk_bf16(v[6] * rs * ng[6], v[7] * rs * ng[7]);
        o1.x = cvt_pk_bf16(v[8] * rs * ng[8], v[9] * rs * ng[9]); o1.y = cvt_pk_bf16(v[10] * rs * ng[10], v[11] * rs * ng[11]); o1.z = cvt_pk_bf16(v[12] * rs * ng[12], v[13] * rs * ng[13]); o1.w = cvt_pk_bf16(v[14] * rs * ng[14], v[15] * rs * ng[15]);
        p[0] = o0; p[1] = o1; }
}


__device__ __forceinline__ void phase_ssm_scan_mfma(Frame& F, const float* const* in, int gp, const bf16* XS, const bf16* BC, const float* DT, const float* ACUM, bf16* Yf, bf16* Yb) {
    constexpr int BSTR = 272, XSTR = 160;
    LAS unsigned char* Bl = F.lds;
    LAS unsigned char* Cl = F.lds + 17408;
    LAS unsigned char* Xl = F.lds + 34816;
    LAS unsigned char* Xw = F.lds + 45056;
    LAS float* AC = (LAS float*)(F.lds + 55296);
    LAS float* DTs = (LAS float*)(F.lds + 55296 + 256);
    LAS unsigned char* Sb = F.lds + 55808;
    const int it = blockIdx.x, b = it >> 5, dir = (it >> 4) & 1, hl = it & 15, gl = hl >> 3;
    bf16* Y = dir == 0 ? Yf : Yb;
    const int tid = F.tid, lane = F.lane, w = F.wave, fr = lane & 15, fq = lane >> 4, lq = (lane & 15) >> 2, lp = lane & 3;
    const int lt = w & 3, ph = w >> 2;
    for (int i = tid; i < 64 * BSTR / 16; i += NTHR) *(LAS v4u*)(Sb + i * 16) = (v4u){0u, 0u, 0u, 0u};
    f32x4 sacc[4];
#pragma unroll
    for (int i = 0; i < 4; ++i) sacc[i] = (f32x4){0.f, 0.f, 0.f, 0.f};
    v4u rB[2], rC[2], rX; float rac = 0.f, rdt = 0.f, rxs = 0.f;
    const int xr = tid >> 3, xc = tid & 7;
#define SM_LOAD(ck) do { _Pragma("unroll") for (int _i = 0; _i < 2; ++_i) { const int _c = tid + 512 * _i; const size_t _r = (size_t)(b * TPB + scan_row(dir, (ck) * 64 + (_c >> 4))); \
            rB[_i] = *(const v4u*)(BC + _r * 512 + gl * 128 + (_c & 15) * 8); rC[_i] = *(const v4u*)(BC + _r * 512 + 256 + gl * 128 + (_c & 15) * 8); } \
        { const size_t _r = (size_t)(b * TPB + scan_row(dir, (ck) * 64 + xr)); const size_t _rl = (size_t)(b * TPB + scan_row(dir, (ck) * 64 + 63)); rX = *(const v4u*)(XS + _r * 1024 + hl * 64 + xc * 8); \
          const float _a = ACUM[_r * 32 + dir * 16 + hl], _al = ACUM[_rl * 32 + dir * 16 + hl], _d = DT[_r * 32 + dir * 16 + hl]; rac = _a; rdt = _d; rxs = _d * fast_exp2(_al - _a); } } while (0)
#define SM_STORE() do { _Pragma("unroll") for (int _i = 0; _i < 2; ++_i) { const int _c = tid + 512 * _i; *(LAS v4u*)(Bl + (_c >> 4) * BSTR + (_c & 15) * 16) = rB[_i]; *(LAS v4u*)(Cl + (_c >> 4) * BSTR + (_c & 15) * 16) = rC[_i]; } \
        *(LAS v4u*)(Xl + xr * XSTR + xc * 16) = rX; \
        { v4u _o; _o.x = cvt_pk_bf16(bflo(rX.x) * rxs, bfhi(rX.x) * rxs); _o.y = cvt_pk_bf16(bflo(rX.y) * rxs, bfhi(rX.y) * rxs); _o.z = cvt_pk_bf16(bflo(rX.z) * rxs, bfhi(rX.z) * rxs); _o.w = cvt_pk_bf16(bflo(rX.w) * rxs, bfhi(rX.w) * rxs); \
          *(LAS v4u*)(Xw + xr * XSTR + xc * 16) = _o; } \
        if (xc == 0) { AC[xr] = rac; DTs[xr] = rdt; } } while (0)
    SM_LOAD(0); SM_STORE(); __syncthreads();
    for (int ck = 0; ck < 68; ++ck) { const int cur = ck & 1;
        if (ck + 1 < 68) SM_LOAD(ck + 1);
        const LAS unsigned char* Sc = Sb + cur * (64 * BSTR); LAS unsigned char* Sn = Sb + (cur ^ 1) * (64 * BSTR);
        bf16x8 cf[4];
#pragma unroll
        for (int ks = 0; ks < 4; ++ks) cf[ks] = *(const LAS bf16x8*)(Cl + (16 * lt + fr) * BSTR + (32 * ks + 8 * fq) * 2);
        const float acl = AC[16 * lt + fr];
        f32x4 yacc[2];
#pragma unroll
        for (int pi = 0; pi < 2; ++pi) { f32x4 a = (f32x4){0.f, 0.f, 0.f, 0.f};
#pragma unroll
            for (int ks = 0; ks < 4; ++ks) { const bf16x8 sf = *(const LAS bf16x8*)(Sc + (16 * (2 * ph + pi) + fr) * BSTR + (32 * ks + 8 * fq) * 2); a = __builtin_amdgcn_mfma_f32_16x16x32_bf16(sf, cf[ks], a, 0, 0, 0); }
            yacc[pi] = a * fast_exp2(acl); }
        f32x4 pm[4];
#pragma unroll
        for (int st = 0; st < 4; ++st) { pm[st] = (f32x4){0.f, 0.f, 0.f, 0.f};
            if (st <= lt) { f32x4 g = (f32x4){0.f, 0.f, 0.f, 0.f};
#pragma unroll
                for (int ks = 0; ks < 4; ++ks) { const bf16x8 bfr = *(const LAS bf16x8*)(Bl + (16 * st + fr) * BSTR + (32 * ks + 8 * fq) * 2); g = __builtin_amdgcn_mfma_f32_16x16x32_bf16(bfr, cf[ks], g, 0, 0, 0); }
                const f32x4 acs = *(const LAS f32x4*)(AC + 16 * st + 4 * fq), dts = *(const LAS f32x4*)(DTs + 16 * st + 4 * fq);
#pragma unroll
                for (int j = 0; j < 4; ++j) { const bool ok = (16 * st + 4 * fq + j) <= (16 * lt + fr); pm[st][j] = ok ? g[j] * fast_exp2(acl - acs[j]) * dts[j] : 0.f; } } }
#pragma unroll
        for (int ks2 = 0; ks2 < 2; ++ks2) { if (2 * ks2 <= lt) { const v4u pw = pack8(pm[2 * ks2], pm[2 * ks2 + 1]); const bf16x8 pf = __builtin_bit_cast(bf16x8, pw);
#pragma unroll
                for (int pi = 0; pi < 2; ++pi) { const LAS unsigned char* xb = Xl + (32 * ks2 + 4 * fq + lq) * XSTR + (16 * (2 * ph + pi) + 4 * lp) * 2;
                    const s16x4 v0 = __builtin_amdgcn_ds_read_tr16_b64_v4i16((LAS s16x4*)xb), v1 = __builtin_amdgcn_ds_read_tr16_b64_v4i16((LAS s16x4*)(xb + 16 * XSTR));
                    bf16x8 xf; xf[0] = v0[0]; xf[1] = v0[1]; xf[2] = v0[2]; xf[3] = v0[3]; xf[4] = v1[0]; xf[5] = v1[1]; xf[6] = v1[2]; xf[7] = v1[3];
                    yacc[pi] = __builtin_amdgcn_mfma_f32_16x16x32_bf16(xf, pf, yacc[pi], 0, 0, 0); } } }
        { const size_t ro = (size_t)(b * TPB + scan_row(dir, ck * 64 + 16 * lt + fr));
#pragma unroll
          for (int pi = 0; pi < 2; ++pi) { v2u o; o.x = cvt_pk_bf16(yacc[pi][0], yacc[pi][1]); o.y = cvt_pk_bf16(yacc[pi][2], yacc[pi][3]);
              *(v2u*)(Y + ro * 1024 + hl * 64 + 16 * (2 * ph + pi) + 4 * fq) = o; } }
        { const float gdec = fast_exp2(AC[63]);
          bf16x8 xwf[2];
#pragma unroll
          for (int ks2 = 0; ks2 < 2; ++ks2) { const LAS unsigned char* xb = Xw + (32 * ks2 + 8 * fq + lq) * XSTR + (16 * lt + 4 * lp) * 2;
              const s16x4 v0 = __builtin_amdgcn_ds_read_tr16_b64_v4i16((LAS s16x4*)xb), v1 = __builtin_amdgcn_ds_read_tr16_b64_v4i16((LAS s16x4*)(xb + 4 * XSTR));
              xwf[ks2][0] = v0[0]; xwf[ks2][1] = v0[1]; xwf[ks2][2] = v0[2]; xwf[ks2][3] = v0[3]; xwf[ks2][4] = v1[0]; xwf[ks2][5] = v1[1]; xwf[ks2][6] = v1[2]; xwf[ks2][7] = v1[3]; }
#pragma unroll
          for (int i = 0; i < 4; ++i) { const int nt = 4 * ph + i; f32x4 a = sacc[i] * gdec;
#pragma unroll
              for (int ks2 = 0; ks2 < 2; ++ks2) { const LAS unsigned char* bb = Bl + (32 * ks2 + 8 * fq + lq) * BSTR + (16 * nt + 4 * lp) * 2;
                  const s16x4 v0 = __builtin_amdgcn_ds_read_tr16_b64_v4i16((LAS s16x4*)bb), v1 = __builtin_amdgcn_ds_read_tr16_b64_v4i16((LAS s16x4*)(bb + 4 * BSTR));
                  bf16x8 bt; bt[0] = v0[0]; bt[1] = v0[1]; bt[2] = v0[2]; bt[3] = v0[3]; bt[4] = v1[0]; bt[5] = v1[1]; bt[6] = v1[2]; bt[7] = v1[3];
                  a = __builtin_amdgcn_mfma_f32_16x16x32_bf16(xwf[ks2], bt, a, 0, 0, 0); }
              sacc[i] = a;
#pragma unroll
              for (int j = 0; j < 4; ++j) *(LAS bf16*)(Sn + (16 * lt + 4 * fq + j) * BSTR + (16 * nt + fr) * 2) = (bf16)f2bf(a[j]); } }
        __syncthreads();
        if (ck + 1 < 68) SM_STORE();
        __syncthreads();
    }
#undef SM_LOAD
#undef SM_STORE
}
__device__ __forceinline__ void phase_ssm_gnorm2(Frame& F, const float* const* in, int gp, bf16* Yf, const bf16* Yb, const bf16* XS, const bf16* Z) {
    const int gw = F.vcu * NWAVES + F.wave, NGW = GRID * NWAVES; const float* ng = in[24] + gp * 1024 + 16 * F.lane;
    const int head = gp * 16 + (F.lane >> 2); const float dskip = in[23][head] + in[23][32 + head];
    for (int r = gw; r < M; r += NGW) { const size_t off = (size_t)r * 1024 + 16 * F.lane;
        const v4u a0 = *(const v4u*)(Yf + off), a1 = *(const v4u*)(Yf + off + 8), b0 = *(const v4u*)(Yb + off), b1 = *(const v4u*)(Yb + off + 8);
        const v4u x0 = *(const v4u*)(XS + off), x1 = *(const v4u*)(XS + off + 8), z0 = *(const v4u*)(Z + off), z1 = *(const v4u*)(Z + off + 8);
        const unsigned aw[8] = {a0.x, a0.y, a0.z, a0.w, a1.x, a1.y, a1.z, a1.w}, bw[8] = {b0.x, b0.y, b0.z, b0.w, b1.x, b1.y, b1.z, b1.w};
        const unsigned xw[8] = {x0.x, x0.y, x0.z, x0.w, x1.x, x1.y, x1.z, x1.w}, zw[8] = {z0.x, z0.y, z0.z, z0.w, z1.x, z1.y, z1.z, z1.w};
        float v[16]; float ss = 0.f;
#pragma unroll
        for (int i = 0; i < 8; ++i) { v[2 * i] = (bflo(aw[i]) + bflo(bw[i]) + dskip * bflo(xw[i])) * silu_f(bflo(zw[i])); v[2 * i + 1] = (bfhi(aw[i]) + bfhi(bw[i]) + dskip * bfhi(xw[i])) * silu_f(bfhi(zw[i]));
            ss += v[2 * i] * v[2 * i] + v[2 * i + 1] * v[2 * i + 1]; }
#pragma unroll
        for (int o = 1; o < 32; o <<= 1) ss += __shfl_xor(ss, o);
        const float rs = rsqrtf(ss * (1.f / 512.f) + EPS);
        unsigned res[8];
#pragma unroll
        for (int i = 0; i < 8; ++i) res[i] = cvt_pk_bf16(v[2 * i] * rs * ng[2 * i], v[2 * i + 1] * rs * ng[2 * i + 1]);
        *(v4u*)(Yf + off) = (v4u){res[0], res[1], res[2], res[3]}; *(v4u*)(Yf + off + 8) = (v4u){res[4], res[5], res[6], res[7]}; }
}

__device__ __forceinline__ void phase_mlstm_scan(Frame& F, const bf16* Qm, const bf16* Km, const bf16* Vm, const float* G, bf16* Hf, bf16* Hb) {
    constexpr int T = 32;
    LAS float* Qf = (LAS float*)F.lds;
    LAS float* KW = (LAS float*)(F.lds + 8192);
    LAS float* Vf = (LAS float*)(F.lds + 16384);
    LAS float* FD = (LAS float*)(F.lds + 24576);
    LAS float* IW = (LAS float*)(F.lds + 24576 + 256);
    LAS float* EM = (LAS float*)(F.lds + 24576 + 512);
    LAS float* PN = (LAS float*)(F.lds + 32768);
    LAS float* PD = (LAS float*)(F.lds + 32768 + 65536);
    const int it = blockIdx.x, b = it >> 5, dir = (it >> 4) & 1, head = (it >> 1) & 7, jh = it & 1;
    bf16* Hout = dir == 0 ? Hf : Hb;
    const int w = F.wave, lane = F.lane, d7 = 8 * w + (lane & 7);
    float C[8], nst = 0.f, m_in = 0.f;
#pragma unroll
    for (int i = 0; i < 8; ++i) C[i] = 0.f;
    const int st = (F.tid & 255) >> 3, sch = F.tid & 7;
    v4u r0, r1; float gi = 0.f, gf = 0.f;
#define ML_LOAD(tile) do { const size_t _r = (size_t)(b * TPB + scan_row(dir, (tile) * T + st)); \
        if (F.tid < 256) { r0 = *(const v4u*)(Qm + _r * 512 + head * 64 + sch * 8); r1 = *(const v4u*)(Vm + _r * 1024 + head * 128 + jh * 64 + sch * 8); } \
        else { r0 = *(const v4u*)(Km + _r * 512 + head * 64 + sch * 8); } \
        if (F.tid < 32) { const size_t _g = (size_t)(b * TPB + scan_row(dir, (tile) * T + F.tid)); gi = G[_g * 32 + (2 * dir) * 8 + head]; gf = G[_g * 32 + (2 * dir + 1) * 8 + head]; } } while (0)
#define UNPK(dst, r) do { *(LAS f32x4*)(dst) = (f32x4){bflo(r.x), bfhi(r.x), bflo(r.y), bfhi(r.y)}; *(LAS f32x4*)((dst) + 4) = (f32x4){bflo(r.z), bfhi(r.z), bflo(r.w), bfhi(r.w)}; } while (0)
#define ML_GATES(nb) do { if (w == 0) { float Fc = lane < 32 ? gf : 0.f; \
            _Pragma("unroll") for (int o = 1; o < 32; o <<= 1) { const float t_ = __shfl_up(Fc, o); if (lane >= o) Fc += t_; } \
            float Gm = lane < 32 ? gi - Fc : -3.0e38f; \
            _Pragma("unroll") for (int o = 1; o < 32; o <<= 1) { const float t_ = __shfl_up(Gm, o); if (lane >= o) Gm = fmaxf(Gm, t_); } \
            const float mt = Fc + fmaxf(m_in, Gm); float mp = __shfl_up(mt, 1); if (lane == 0) mp = m_in; \
            if (lane < 32) { FD[(nb) * 32 + lane] = fast_exp2((gf + mp - mt) * LOG2E); IW[(nb) * 32 + lane] = fast_exp2((gi - mt) * LOG2E); EM[(nb) * 32 + lane] = fast_exp2(-mt * LOG2E); } \
            m_in = __shfl(mt, 31); } } while (0)
    __syncthreads();
    ML_LOAD(0); ML_GATES(0);
    if (F.tid < 256) { UNPK(Qf + st * 64 + sch * 8, r0); UNPK(Vf + st * 64 + sch * 8, r1); }
    __syncthreads();
    if (F.tid >= 256) { const float iw = IW[st]; LAS float* dk = KW + st * 64 + sch * 8;
        *(LAS f32x4*)dk = (f32x4){bflo(r0.x), bfhi(r0.x), bflo(r0.y), bfhi(r0.y)} * iw; *(LAS f32x4*)(dk + 4) = (f32x4){bflo(r0.z), bfhi(r0.z), bflo(r0.w), bfhi(r0.w)} * iw; }
    __syncthreads();
    constexpr int NT = TPB / T;
    for (int tile = 0; tile < NT; ++tile) { const int cb = tile & 1;
        if (tile + 1 < NT) ML_LOAD(tile + 1);
#pragma unroll 4
        for (int t = 0; t < T; ++t) {
            const float fd = FD[cb * 32 + t], v = Vf[t * 64 + lane];
            const f32x4 q0 = *(const LAS f32x4*)(Qf + t * 64 + 8 * w), q1 = *(const LAS f32x4*)(Qf + t * 64 + 8 * w + 4);
            const f32x4 k0 = *(const LAS f32x4*)(KW + t * 64 + 8 * w), k1 = *(const LAS f32x4*)(KW + t * 64 + 8 * w + 4);
            float pn = 0.f;
#pragma unroll
            for (int i = 0; i < 4; ++i) { C[i] = C[i] * fd + k0[i] * v; pn += q0[i] * C[i]; C[4 + i] = C[4 + i] * fd + k1[i] * v; pn += q1[i] * C[4 + i]; }
            PN[(w * 32 + t) * 64 + lane] = pn;
            nst = nst * fd + KW[t * 64 + d7];
            float pd = Qf[t * 64 + d7] * nst;
            pd += __shfl_xor(pd, 1); pd += __shfl_xor(pd, 2); pd += __shfl_xor(pd, 4);
            if (lane == 0) PD[w * 32 + t] = pd;
        }
        __syncthreads();
#pragma unroll
        for (int k = 0; k < 4; ++k) { const int t = (F.tid >> 6) + 8 * k; float num = 0.f, den = 0.f;
#pragma unroll
            for (int ww = 0; ww < 8; ++ww) { num += PN[(ww * 32 + t) * 64 + lane]; den += PD[ww * 32 + t]; }
            const float h = num / fmaxf(fabsf(den), EM[cb * 32 + t]);
            Hout[(size_t)(b * TPB + scan_row(dir, tile * T + t)) * 1024 + head * 128 + jh * 64 + lane] = (bf16)f2bf(h); }
        if (tile + 1 < NT) { ML_GATES(cb ^ 1); if (F.tid < 256) { UNPK(Qf + st * 64 + sch * 8, r0); UNPK(Vf + st * 64 + sch * 8, r1); } }
        __syncthreads();
        if (tile + 1 < NT && F.tid >= 256) { const float iw = IW[(cb ^ 1) * 32 + st]; LAS float* dk = KW + st * 64 + sch * 8;
            *(LAS f32x4*)dk = (f32x4){bflo(r0.x), bfhi(r0.x), bflo(r0.y), bfhi(r0.y)} * iw; *(LAS f32x4*)(dk + 4) = (f32x4){bflo(r0.z), bfhi(r0.z), bflo(r0.w), bfhi(r0.w)} * iw; }
        __syncthreads();
    }
#undef ML_LOAD
#undef ML_GATES
#undef UNPK
}

__device__ __forceinline__ void phase_mlstm_scan_mfma(Frame& F, const bf16* Qm, const bf16* Km, const bf16* Vm, const float* G, bf16* Hf, bf16* Hb) {
    constexpr int QSTR = 144, WSTR = 160, VSTR = 176, CSTR = 144;
    LAS unsigned char* Ql = F.lds;
    LAS unsigned char* Kl = F.lds + 9216;
    LAS unsigned char* Kw = F.lds + 18432;
    LAS unsigned char* Vl = F.lds + 28672;
    LAS unsigned char* Cb = F.lds + 39936;
    LAS float* BCU = (LAS float*)(F.lds + 62976);
    LAS float* IGA = BCU + 64;
    LAS float* MTA = BCU + 128;
    LAS float* SCA = BCU + 192;
    const int it = blockIdx.x, b = it >> 5, dir = (it >> 4) & 1, head = (it >> 1) & 7, jh = it & 1;
    bf16* Hout = dir == 0 ? Hf : Hb;
    const int tid = F.tid, lane = F.lane, w = F.wave, fr = lane & 15, fq = lane >> 4, lq = (lane & 15) >> 2, lp = lane & 3;
    const int lt = w & 3, jg = w >> 2;
    for (int i = tid; i < 80 * CSTR / 16; i += NTHR) *(LAS v4u*)(Cb + i * 16) = (v4u){0u, 0u, 0u, 0u};
    for (int i = tid; i < 64 * 2; i += NTHR) { const int s = i >> 1, hh = i & 1; *(LAS v4u*)(Vl + s * VSTR + 128 + hh * 16) = hh == 0 ? (v4u){0x3F80u, 0u, 0u, 0u} : (v4u){0u, 0u, 0u, 0u}; }
    f32x4 sacc[3];
#pragma unroll
    for (int i = 0; i < 3; ++i) sacc[i] = (f32x4){0.f, 0.f, 0.f, 0.f};
    v4u rQ, rK, rV; float gi = 0.f, gf = 0.f, m_in = 0.f;
    const int sr = tid >> 3, sc = tid & 7;
#define MM_LOAD(ck) do { const size_t _r = (size_t)(b * TPB + scan_row(dir, (ck) * 64 + sr)); \
        rQ = *(const v4u*)(Qm + _r * 512 + head * 64 + sc * 8); rK = *(const v4u*)(Km + _r * 512 + head * 64 + sc * 8); rV = *(const v4u*)(Vm + _r * 1024 + head * 128 + jh * 64 + sc * 8); \
        if (tid < 64) { const size_t _g = (size_t)(b * TPB + scan_row(dir, (ck) * 64 + tid)); gi = G[_g * 32 + (2 * dir) * 8 + head] * LOG2E; gf = G[_g * 32 + (2 * dir + 1) * 8 + head] * LOG2E; } } while (0)
#define MM_STAGE1() do { if (w == 0) { float Fc = gf; \
            _Pragma("unroll") for (int o = 1; o < 64; o <<= 1) { const float t_ = __shfl_up(Fc, o); if (lane >= o) Fc += t_; } \
            float Gm = gi - Fc; \
            _Pragma("unroll") for (int o = 1; o < 64; o <<= 1) { const float t_ = __shfl_up(Gm, o); if (lane >= o) Gm = fmaxf(Gm, t_); } \
            const float mt = Fc + fmaxf(m_in, Gm); BCU[lane] = Fc; IGA[lane] = gi; MTA[lane] = mt; \
            if (lane == 63) { SCA[0] = Fc; SCA[1] = m_in; SCA[2] = mt; } \
            m_in = __shfl(mt, 63); } \
        *(LAS v4u*)(Ql + sr * QSTR + sc * 16) = rQ; *(LAS v4u*)(Kl + sr * QSTR + sc * 16) = rK; *(LAS v4u*)(Vl + sr * VSTR + sc * 16) = rV; } while (0)
#define MM_STAGE2() do { const float ws_ = fast_exp2(SCA[0] - BCU[sr] + IGA[sr] - SCA[2]); v4u _o; \
        _o.x = cvt_pk_bf16(bflo(rK.x) * ws_, bfhi(rK.x) * ws_); _o.y = cvt_pk_bf16(bflo(rK.y) * ws_, bfhi(rK.y) * ws_); _o.z = cvt_pk_bf16(bflo(rK.z) * ws_, bfhi(rK.z) * ws_); _o.w = cvt_pk_bf16(bflo(rK.w) * ws_, bfhi(rK.w) * ws_); \
        *(LAS v4u*)(Kw + sr * WSTR + sc * 16) = _o; } while (0)
    __syncthreads();
    MM_LOAD(0); MM_STAGE1(); __syncthreads(); MM_STAGE2(); __syncthreads();
    for (int ck = 0; ck < 68; ++ck) { const int cur = ck & 1;
        if (ck + 1 < 68) MM_LOAD(ck + 1);
        const LAS unsigned char* Cc = Cb + cur * (80 * CSTR); LAS unsigned char* Cn = Cb + (cur ^ 1) * (80 * CSTR);
        bf16x8 qf[2];
#pragma unroll
        for (int ks = 0; ks < 2; ++ks) qf[ks] = *(const LAS bf16x8*)(Ql + (16 * lt + fr) * QSTR + (32 * ks + 8 * fq) * 2);
        const float bl = BCU[16 * lt + fr], ml = MTA[16 * lt + fr], m0 = SCA[1];
        const float dl = fast_exp2(bl + m0 - ml);
        f32x4 nacc[2]; float den;
#pragma unroll
        for (int ji = 0; ji < 2; ++ji) { f32x4 a = (f32x4){0.f, 0.f, 0.f, 0.f};
#pragma unroll
            for (int ks = 0; ks < 2; ++ks) { const bf16x8 cfr = *(const LAS bf16x8*)(Cc + (16 * (2 * jg + ji) + fr) * CSTR + (32 * ks + 8 * fq) * 2); a = __builtin_amdgcn_mfma_f32_16x16x32_bf16(cfr, qf[ks], a, 0, 0, 0); }
            nacc[ji] = a * dl; }
        { f32x4 a = (f32x4){0.f, 0.f, 0.f, 0.f};
#pragma unroll
          for (int ks = 0; ks < 2; ++ks) { const bf16x8 cfr = *(const LAS bf16x8*)(Cc + (64 + fr) * CSTR + (32 * ks + 8 * fq) * 2); a = __builtin_amdgcn_mfma_f32_16x16x32_bf16(cfr, qf[ks], a, 0, 0, 0); }
          den = __shfl(a[0], fr) * dl; }
        f32x4 pm[4]; float dsum = 0.f;
#pragma unroll
        for (int st = 0; st < 4; ++st) { pm[st] = (f32x4){0.f, 0.f, 0.f, 0.f};
            if (st <= lt) { f32x4 g = (f32x4){0.f, 0.f, 0.f, 0.f};
#pragma unroll
                for (int ks = 0; ks < 2; ++ks) { const bf16x8 kfr = *(const LAS bf16x8*)(Kl + (16 * st + fr) * QSTR + (32 * ks + 8 * fq) * 2); g = __builtin_amdgcn_mfma_f32_16x16x32_bf16(kfr, qf[ks], g, 0, 0, 0); }
                const f32x4 bs = *(const LAS f32x4*)(BCU + 16 * st + 4 * fq), is = *(const LAS f32x4*)(IGA + 16 * st + 4 * fq);
#pragma unroll
                for (int j = 0; j < 4; ++j) { const bool ok = (16 * st + 4 * fq + j) <= (16 * lt + fr); const float v = ok ? g[j] * fast_exp2(bl - bs[j] + is[j] - ml) : 0.f; pm[st][j] = v; dsum += v; } } }
        dsum += __shfl_xor(dsum, 16); dsum += __shfl_xor(dsum, 32);
        den += dsum;
#pragma unroll
        for (int ks2 = 0; ks2 < 2; ++ks2) { if (2 * ks2 <= lt) { const v4u pw = pack8(pm[2 * ks2], pm[2 * ks2 + 1]); const bf16x8 pf = __builtin_bit_cast(bf16x8, pw);
#pragma unroll
                for (int ji = 0; ji < 2; ++ji) { const LAS unsigned char* vb = Vl + (32 * ks2 + 4 * fq + lq) * VSTR + (16 * (2 * jg + ji) + 4 * lp) * 2;
                    const s16x4 v0 = __builtin_amdgcn_ds_read_tr16_b64_v4i16((LAS s16x4*)vb), v1 = __builtin_amdgcn_ds_read_tr16_b64_v4i16((LAS s16x4*)(vb + 16 * VSTR));
                    bf16x8 vf; vf[0] = v0[0]; vf[1] = v0[1]; vf[2] = v0[2]; vf[3] = v0[3]; vf[4] = v1[0]; vf[5] = v1[1]; vf[6] = v1[2]; vf[7] = v1[3];
                    nacc[ji] = __builtin_amdgcn_mfma_f32_16x16x32_bf16(vf, pf, nacc[ji], 0, 0, 0); } } }
        { const float inv = 1.0f / fmaxf(fabsf(den), fast_exp2(-ml)); const size_t ro = (size_t)(b * TPB + scan_row(dir, ck * 64 + 16 * lt + fr));
#pragma unroll
          for (int ji = 0; ji < 2; ++ji) { v2u o; o.x = cvt_pk_bf16(nacc[ji][0] * inv, nacc[ji][1] * inv); o.y = cvt_pk_bf16(nacc[ji][2] * inv, nacc[ji][3] * inv);
              *(v2u*)(Hout + ro * 1024 + head * 128 + jh * 64 + 16 * (2 * jg + ji) + 4 * fq) = o; } }
        { const float gdec = fast_exp2(SCA[0] + m0 - SCA[2]);
          bf16x8 kwf[2];
#pragma unroll
          for (int ks2 = 0; ks2 < 2; ++ks2) { const LAS unsigned char* kb = Kw + (32 * ks2 + 8 * fq + lq) * WSTR + (16 * lt + 4 * lp) * 2;
              const s16x4 v0 = __builtin_amdgcn_ds_read_tr16_b64_v4i16((LAS s16x4*)kb), v1 = __builtin_amdgcn_ds_read_tr16_b64_v4i16((LAS s16x4*)(kb + 4 * WSTR));
              kwf[ks2][0] = v0[0]; kwf[ks2][1] = v0[1]; kwf[ks2][2] = v0[2]; kwf[ks2][3] = v0[3]; kwf[ks2][4] = v1[0]; kwf[ks2][5] = v1[1]; kwf[ks2][6] = v1[2]; kwf[ks2][7] = v1[3]; }
#pragma unroll
          for (int i = 0; i < 3; ++i) { if (jg == 0 || i < 2) { const int jt = jg == 0 ? i : 3 + i; f32x4 a = sacc[i] * gdec;
#pragma unroll
              for (int ks2 = 0; ks2 < 2; ++ks2) { const LAS unsigned char* vb = Vl + (32 * ks2 + 8 * fq + lq) * VSTR + (16 * jt + 4 * lp) * 2;
                  const s16x4 v0 = __builtin_amdgcn_ds_read_tr16_b64_v4i16((LAS s16x4*)vb), v1 = __builtin_amdgcn_ds_read_tr16_b64_v4i16((LAS s16x4*)(vb + 4 * VSTR));
                  bf16x8 vt; vt[0] = v0[0]; vt[1] = v0[1]; vt[2] = v0[2]; vt[3] = v0[3]; vt[4] = v1[0]; vt[5] = v1[1]; vt[6] = v1[2]; vt[7] = v1[3];
                  a = __builtin_amdgcn_mfma_f32_16x16x32_bf16(vt, kwf[ks2], a, 0, 0, 0); }
              sacc[i] = a;
#pragma unroll
              for (int j = 0; j < 4; ++j) *(LAS bf16*)(Cn + (16 * jt + 4 * fq + j) * CSTR + (16 * lt + fr) * 2) = (bf16)f2bf(a[j]); } } }
        __syncthreads();
        if (ck + 1 < 68) MM_STAGE1();
        __syncthreads();
        if (ck + 1 < 68) MM_STAGE2();
        __syncthreads();
    }
#undef MM_LOAD
#undef MM_STAGE1
#undef MM_STAGE2
}

__device__ __forceinline__ void phase_mlstm_gnorm(Frame& F, const float* const* in, const bf16* Hf, const bf16* Hb, const bf16* Om, bf16* Hn) {
    const int gw = F.vcu * NWAVES + F.wave, NGW = GRID * NWAVES; const float* ng = in[28] + 16 * F.lane;
    for (int r = gw; r < M; r += NGW) { const size_t off = (size_t)r * 1024 + 16 * F.lane;
        const v4u a0 = *(const v4u*)(Hf + off), a1 = *(const v4u*)(Hf + off + 8), b0 = *(const v4u*)(Hb + off), b1 = *(const v4u*)(Hb + off + 8), o0 = *(const v4u*)(Om + off), o1 = *(const v4u*)(Om + off + 8);
        const unsigned aw[8] = {a0.x, a0.y, a0.z, a0.w, a1.x, a1.y, a1.z, a1.w}, bw[8] = {b0.x, b0.y, b0.z, b0.w, b1.x, b1.y, b1.z, b1.w}, ow[8] = {o0.x, o0.y, o0.z, o0.w, o1.x, o1.y, o1.z, o1.w};
        float v[16]; float ss = 0.f;
#pragma unroll
        for (int i = 0; i < 8; ++i) { v[2 * i] = bflo(aw[i]) + bflo(bw[i]); v[2 * i + 1] = bfhi(aw[i]) + bfhi(bw[i]); ss += v[2 * i] * v[2 * i] + v[2 * i + 1] * v[2 * i + 1]; }
        ss += __shfl_xor(ss, 1); ss += __shfl_xor(ss, 2); ss += __shfl_xor(ss, 4);
        const float rs = rsqrtf(ss * (1.f / 128.f) + EPS);
        unsigned res[8];
#pragma unroll
        for (int i = 0; i < 8; ++i) res[i] = cvt_pk_bf16(v[2 * i] * rs * ng[2 * i] * sigmoid_f(bflo(ow[i])), v[2 * i + 1] * rs * ng[2 * i + 1] * sigmoid_f(bfhi(ow[i])));
        *(v4u*)(Hn + off) = (v4u){res[0], res[1], res[2], res[3]}; *(v4u*)(Hn + off + 8) = (v4u){res[4], res[5], res[6], res[7]}; }
}
struct Args { const float* in[37]; float* out; unsigned char* ws; };

__device__ __forceinline__ void moe_phases(Frame& F, const float* const* in, int layer, const XcdBarrier& bar) {
    phase_norm2_route(F, in, layer);
    SYNC_GRID();
    bf16* Hb = (bf16*)(F.ws + WS_H); bf16* ACT = (bf16*)(F.ws + MOE_ACT); float* X = (float*)(F.ws + WS_X);
    const float* mod = (const float*)(F.ws + WS_MOD) + (size_t)layer * 9 * 6144;
    { MoeOrder<0> S; S.W = (const bf16*)(F.ws + WS_WGU); S.G = GRID; S.c = F.vcu; moe_setup(F, layer, S);
      pg8::Gemm g{Hb, 1024, 1024, 1 << 30}; EpiMoeAct E{ACT, S.tbl};
      pg8::gemm_phase(F.lds, g, S, E); }
    SYNC_GRID();
    { MoeOrder<1> S; S.W = (const bf16*)(F.ws + WS_WDN); S.G = GRID; S.c = F.vcu; moe_setup(F, layer, S);
      pg8::Gemm g{ACT, 512, 256, 4}; EpiMoeDown E{X, mod + 5 * 1024, S.tbl};
      pg8::gemm_phase(F.lds, g, S, E); }
    SYNC_GRID();
}
__device__ __forceinline__ void outproj_phase(Frame& F, const bf16* A, const bf16* Wt, int K, int ldb, int layer) {
    pg8::Gemm g{A, K, ldb, 1 << 30}; pg8::StaticOrder S; S.init(M, 1024, GRID, (int)blockIdx.x, Wt, ldb);
    EpiResid E{(float*)(F.ws + WS_X), (const float*)(F.ws + WS_MOD) + (size_t)layer * 9 * 6144 + 2 * 1024};
    pg8::gemm_phase(F.lds, g, S, E);
}

__device__ __forceinline__ void ssm_gp_phases(Frame& F, const float* const* in, const int gp, const XcdBarrier& bar) {
    unsigned char* scr = F.ws + WS_SCR; unsigned char* scr2 = (unsigned char*)F.out; bf16* H = (bf16*)(F.ws + WS_H); bf16* WM = (bf16*)(F.ws + WS_WMIX);
    bf16* Z = (bf16*)scr; bf16* XP = (bf16*)(scr + 68 * MiB); bf16* XS = (bf16*)(scr + 170 * MiB); float* DT = (float*)(scr + 238 * MiB); float* ACUM = (float*)(scr + 243 * MiB); bf16* BC = (bf16*)scr2; bf16* Yb = (bf16*)(scr2 + 34 * MiB);
    { pg8::Gemm g{H, 1024, 1024, 1 << 30}; pg8::StaticOrder S; S.init(M, 2816, GRID, (int)blockIdx.x, WM + (size_t)gp * 2816 * 1024, 1024);
      EpiSsmIn E{Z, XP, DT, in[21] + gp * 16};
      pg8::gemm_phase(F.lds, g, S, E);
#if defined(PROBE_GEMM2)
        __syncthreads(); pg8::gemm_phase(F.lds, g, S, E);
#endif
        }
    SYNC_GRID();
    phase_ssm_conv(F, in, gp, XP, XS, BC, DT, ACUM);
#if defined(PROBE_MEM2)
    phase_ssm_conv(F, in, gp, XP, XS, BC, DT, ACUM);
#endif
    SYNC_GRID();
#if defined(SSD_VALU)
    phase_ssm_scan(F, in, gp, XS, BC, DT, Z, XP);
    SYNC_GRID();
    phase_ssm_gnorm(F, in, gp, XP);
    SYNC_GRID();
#else
    phase_ssm_scan_mfma(F, in, gp, XS, BC, DT, ACUM, XP, Yb);
    SYNC_GRID();
    phase_ssm_gnorm2(F, in, gp, XP, Yb, XS, Z);
    SYNC_GRID();
#endif
    outproj_phase(F, XP, WM + 6 * MiB + (size_t)gp * 1024, 1024, 2048, 1);
    SYNC_GRID();
}

__global__ void __launch_bounds__(NTHR, 2) fwd_kernel(Args args) {
    extern __shared__ __attribute__((aligned(16))) unsigned char lds_raw[];
    Frame F;
    F.lds = (LAS unsigned char*)lds_raw; F.ws = args.ws; F.ctl = (unsigned*)(args.ws + WS_CTL); F.out = args.out;
    refresh(F);
    { const int bx = blockIdx.x; F.vcu = (bx % 8) * (GRID / 8) + bx / 8; }
    volatile LAS unsigned* MISC = (volatile LAS unsigned*)(F.lds + LDS_MISC);
    for (int u = F.tid; u < 256; u += NTHR) MISC[u] = 0u;
    __syncthreads();
    const XcdBarrier bar = xcd_barrier_post(F.ctl + CW_BAR, MISC + 8);
    const float* const* in = args.in;
    unsigned char* ws = F.ws; unsigned char* scr = ws + WS_SCR; unsigned char* scr2 = (unsigned char*)F.out;
    bf16* H = (bf16*)(ws + WS_H); bf16* WM = (bf16*)(ws + WS_WMIX);

#if defined(PROBE_MEM2)
    for (int rep = 0; rep < 2; ++rep) {
#endif
    phase_prologue(F, in);
    __syncthreads(); refresh(F);
    convert_matrix<MAP_ATTN_IN>(F, in[15], 1024, 1536, WM, 0, nullptr);
    convert_matrix<MAP_ID>(F, in[17], 1024, 1024, WM + 2 * MiB, 0, nullptr);
    convert_moe(F, in, 0);
#if defined(PROBE_MEM2)
    __syncthreads(); }
#endif
    SYNC_GRID();

#ifndef SKIP_L0
    phase_norm1(F, in, 0);
#if defined(PROBE_MEM2)
    phase_norm1(F, in, 0);
#endif
    SYNC_GRID();
    { bf16* Q = (bf16*)scr; bf16* Kb = (bf16*)(scr + 68 * MiB); bf16* Vb = (bf16*)(scr + 85 * MiB);
      { pg8::Gemm g{H, 1024, 1024, 1 << 30}; pg8::StaticOrder S; S.init(M, 1536, GRID, (int)blockIdx.x, WM, 1024);
        EpiAttnIn E{Q, Kb, Vb, (const f32x2*)(ws + WS_TABA), 0.125f * LOG2E};
        pg8::gemm_phase(F.lds, g, S, E);
#if defined(PROBE_GEMM2)
        __syncthreads(); pg8::gemm_phase(F.lds, g, S, E);
#endif
        }
      SYNC_GRID();
      phase_attn_window(F, in, Q, Kb, Vb);
      SYNC_GRID();
      outproj_phase(F, Q, WM + 2 * MiB, 1024, 1024, 0);
      SYNC_GRID(); }
    moe_phases(F, in, 0, bar);

#endif
#ifndef SKIP_L1
#if defined(PROBE_MEM2)
    for (int rep = 0; rep < 2; ++rep) {
#endif
    phase_norm1(F, in, 1);
    convert_matrix<MAP_SSM_IN>(F, in[18], 1024, 5184, WM, 0, nullptr);
    zero_rows(F, WM, 2592, 224, 1024); zero_rows(F, WM, 2816 + 2592, 224, 1024);
    convert_matrix<MAP_ID>(F, in[25], 2048, 1024, WM + 6 * MiB, 0, nullptr);
    convert_moe(F, in, 1);
#if defined(PROBE_MEM2)
    __syncthreads(); }
#endif
    SYNC_GRID();
    ssm_gp_phases(F, in, 0, bar);
    ssm_gp_phases(F, in, 1, bar);
    moe_phases(F, in, 1, bar);

#endif
#ifndef SKIP_L2
#if defined(PROBE_MEM2)
    for (int rep = 0; rep < 2; ++rep) {
#endif
    phase_norm1(F, in, 2);
    convert_matrix<MAP_ID>(F, in[26], 1024, 3104, WM, 0, nullptr);
    zero_rows(F, WM, 3104, 224, 1024);
    convert_matrix<MAP_ID>(F, in[29], 1024, 1024, WM + 4 * MiB, 0, nullptr);
    convert_moe(F, in, 2);
#if defined(PROBE_MEM2)
    __syncthreads(); }
#endif
    SYNC_GRID();
    { bf16* Qm = (bf16*)scr; bf16* Km = (bf16*)(scr + 34 * MiB); bf16* Vm = (bf16*)(scr + 68 * MiB); bf16* Om = (bf16*)(scr + 136 * MiB); float* Gt = (float*)(scr + 204 * MiB);
      bf16* Hf = (bf16*)scr2; bf16* Hbw = H;
      { pg8::Gemm g{H, 1024, 1024, 1 << 30}; pg8::StaticOrder S; S.init(M, 3328, GRID, (int)blockIdx.x, WM, 1024);
        EpiMlIn E{Qm, Km, Vm, Om, Gt, in[27]};
        pg8::gemm_phase(F.lds, g, S, E);
#if defined(PROBE_GEMM2)
        __syncthreads(); pg8::gemm_phase(F.lds, g, S, E);
#endif
        }
      SYNC_GRID();
#if defined(ML_VALU)
      phase_mlstm_scan(F, Qm, Km, Vm, Gt, Hf, Hbw);
#else
      phase_mlstm_scan_mfma(F, Qm, Km, Vm, Gt, Hf, Hbw);
#endif
      SYNC_GRID();
      phase_mlstm_gnorm(F, in, Hf, Hbw, Om, Om);
      SYNC_GRID();
      outproj_phase(F, Om, WM + 4 * MiB, 1024, 1024, 2);
      SYNC_GRID(); }
    moe_phases(F, in, 2, bar);

#endif
#ifndef SKIP_L3
#if defined(PROBE_MEM2)
    for (int rep = 0; rep < 2; ++rep) {
#endif
    phase_norm1(F, in, 3);
    convert_matrix<MAP_MLA_IN>(F, in[30], 1024, 544, WM, 0, nullptr);
    zero_rows(F, WM, 544, 224, 1024);
    convert_matrix<MAP_MLA_QUP>(F, in[32], 256, 1536, WM + 1 * MiB, 0, in[31]);
    convert_matrix<MAP_ID>(F, in[34], 256, 2048, WM + 2 * MiB, 0, in[33]);
    convert_matrix<MAP_ID>(F, in[35], 1024, 1024, WM + 3 * MiB, 0, nullptr);
    convert_moe(F, in, 3);
#if defined(PROBE_MEM2)
    __syncthreads(); }
#endif
    SYNC_GRID();
    { bf16* CQ = (bf16*)scr; bf16* CKV = (bf16*)(scr + 17 * MiB); float* SSQ = (float*)(scr + 34 * MiB); bf16* KF = (bf16*)(scr + 36 * MiB); bf16* V3 = (bf16*)(scr + 138 * MiB);
      bf16* Q3 = (bf16*)scr2; bf16* O3 = H; const f32x2* tabm = (const f32x2*)(ws + WS_TABM);
      { pg8::Gemm g{H, 1024, 1024, 1 << 30}; pg8::StaticOrder S; S.init(M, 768, GRID, (int)blockIdx.x, WM, 1024);
        EpiMlaIn E{CQ, CKV, KF, SSQ, tabm};
        pg8::gemm_phase(F.lds, g, S, E);
#if defined(PROBE_GEMM2)
        __syncthreads(); pg8::gemm_phase(F.lds, g, S, E);
#endif
        }
      SYNC_GRID();
      { pg8::Gemm g{CQ, 256, 256, 1 << 30}; pg8::StaticOrder S; S.init(M, 1536, GRID, (int)blockIdx.x, WM + 1 * MiB, 256);
        EpiMlaQ E{Q3, SSQ, tabm, 0.10206207261596577f * LOG2E};
        pg8::gemm_phase(F.lds, g, S, E);
#if defined(PROBE_GEMM2)
        __syncthreads(); pg8::gemm_phase(F.lds, g, S, E);
#endif
        }
      { pg8::Gemm g{CKV, 256, 256, 1 << 30}; pg8::StaticOrder S; S.init(M, 2048, GRID, (int)blockIdx.x, WM + 2 * MiB, 256);
        EpiMlaKV E{KF, V3, SSQ};
        pg8::gemm_phase(F.lds, g, S, E);
#if defined(PROBE_GEMM2)
        __syncthreads(); pg8::gemm_phase(F.lds, g, S, E);
#endif
        }
      SYNC_GRID();
      phase_attn_mla(F, Q3, KF, V3, O3);
#if defined(PROBE_MLA2)
      __syncthreads(); phase_attn_mla(F, Q3, KF, V3, O3);
#endif
      SYNC_GRID();
      outproj_phase(F, O3, WM + 3 * MiB, 1024, 1024, 3);
      SYNC_GRID(); }
    moe_phases(F, in, 3, bar);

#endif
    const bool poison = __hip_atomic_load(F.ctl + CW_BAR + XB_TMO, RLX_AGENT) != 0u || __hip_atomic_load(F.ctl + CW_POISON, RLX_AGENT) != 0u;
    phase_final(F, in, poison);
#if defined(PROBE_MEM2)
    phase_final(F, in, poison);
#endif
}

extern "C" void kernel_launch(void* const* d_in, const int* in_sizes, int n_in, void* d_out, int out_size, void* d_ws, size_t ws_size, hipStream_t stream) {
    static int ready = 0;
    if (ready == 0) {
        ready = -1;
        if (n_in != 37 || in_sizes[0] != NB * SEQ * D || out_size != NB * SEQ * D || ws_size < WS_END) { fprintf(stderr, "kernel_launch: unexpected problem shape (n_in %d, in0 %d, out %d, ws %zu)\n", n_in, n_in > 0 ? in_sizes[0] : -1, out_size, ws_size); return; }
        int dev = 0, cus = 0;
        if (hipGetDevice(&dev) != hipSuccess || hipDeviceGetAttribute(&cus, hipDeviceAttributeMultiprocessorCount, dev) != hipSuccess) { fprintf(stderr, "kernel_launch: device query failed\n"); return; }
        if (cus < GRID) { fprintf(stderr, "kernel_launch: needs %d CUs, device has %d\n", GRID, cus); return; }
        if (hipFuncSetAttribute((const void*)fwd_kernel, hipFuncAttributeMaxDynamicSharedMemorySize, LDS_BYTES) != hipSuccess) { fprintf(stderr, "kernel_launch: hipFuncSetAttribute failed\n"); return; }
        int per_cu = 0;
        if (hipOccupancyMaxActiveBlocksPerMultiprocessor(&per_cu, (const void*)fwd_kernel, NTHR, LDS_BYTES) != hipSuccess || per_cu < 1) { fprintf(stderr, "kernel_launch: occupancy query reports %d blocks per CU\n", per_cu); }
        (void)hipGetLastError();
        ready = 1;
    }
    if (ready < 0) return;
    if (hipMemsetAsync((char*)d_ws + WS_CTL, 0, CTL_ZERO_BYTES, stream) != hipSuccess) { fprintf(stderr, "kernel_launch: memset failed\n"); return; }
    Args a{};
    for (int i = 0; i < 37; ++i) a.in[i] = (const float*)d_in[i];
    a.out = (float*)d_out; a.ws = (unsigned char*)d_ws;
    hipLaunchKernelGGL(fwd_kernel, dim3(GRID), dim3(NTHR), LDS_BYTES, stream, a);
    const hipError_t le = hipPeekAtLastError();
    if (le != hipSuccess) fprintf(stderr, "kernel_launch: launch failed: %s\n", hipGetErrorName(le));
}
```

```cpp
#include <hip/hip_runtime.h>
#include <cstdio>
#include <cstdint>

#define GAS __attribute__((address_space(1)))
#define LAS __attribute__((address_space(3)))
typedef unsigned short bf16;
typedef unsigned v4u __attribute__((ext_vector_type(4)));
typedef unsigned v2u __attribute__((ext_vector_type(2)));
typedef float f32x4 __attribute__((ext_vector_type(4)));
typedef float f32x2 __attribute__((ext_vector_type(2)));
typedef short bf16x8 __attribute__((ext_vector_type(8)));
typedef short s16x4 __attribute__((ext_vector_type(4)));
#define RLX_AGENT __ATOMIC_RELAXED, __HIP_MEMORY_SCOPE_AGENT

constexpr int D = 1024, NB = 8, SEQ = 4096, CTX = 256, TPB = SEQ + CTX  , M = NB * TPB  ;
constexpr int NWAVES = 8, NTHR = 512, GRID = 256;
constexpr float EPS = 1e-6f;
constexpr float LOG2E = 1.4426950408889634f;

__device__ __forceinline__ unsigned f2bf(float f) { unsigned u = __builtin_bit_cast(unsigned, f); return (u + 0x7fffu + ((u >> 16) & 1u)) >> 16; }
__device__ __forceinline__ float bf2f(unsigned b) { return __builtin_bit_cast(float, b << 16); }
__device__ __forceinline__ float bflo(unsigned w) { return __builtin_bit_cast(float, w << 16); }
__device__ __forceinline__ float bfhi(unsigned w) { return __builtin_bit_cast(float, w & 0xffff0000u); }
__device__ __forceinline__ unsigned cvt_pk_bf16(float lo, float hi) { unsigned r; asm volatile("v_cvt_pk_bf16_f32 %0, %1, %2" : "=v"(r) : "v"(lo), "v"(hi)); return r; }
__device__ __forceinline__ float fast_exp2(float x) { return __builtin_amdgcn_exp2f(x); }
__device__ __forceinline__ float fast_rcp(float x) { return __builtin_amdgcn_rcpf(x); }
__device__ __forceinline__ float silu_f(float x) { return x * fast_rcp(1.0f + fast_exp2(-x * LOG2E)); }
__device__ __forceinline__ float sigmoid_f(float x) { return fast_rcp(1.0f + fast_exp2(-x * LOG2E)); }
__device__ __forceinline__ float fast_log(float x) { return __builtin_amdgcn_logf(x) * 0.6931471805599453f; }
__device__ __forceinline__ float fast_exp(float x) { return __builtin_amdgcn_exp2f(x * LOG2E); }
__device__ __forceinline__ float softplus_f(float x) { if (x > 20.f) return x; const float e = fast_exp(x); return e < 0.01f ? e * (1.0f - e * (0.5f - e * (1.0f / 3.0f))) : fast_log(1.0f + e); }
#define DPPF(old, src, ctrl, rm, bc) __builtin_bit_cast(float, __builtin_amdgcn_update_dpp(__builtin_bit_cast(int, (float)(old)), __builtin_bit_cast(int, (float)(src)), ctrl, rm, 0xF, bc))
__device__ __forceinline__ float wave_sum(float v) {
    v += DPPF(0.f, v, 0xB1, 0xF, true); v += DPPF(0.f, v, 0x4E, 0xF, true); v += DPPF(0.f, v, 0x141, 0xF, true); v += DPPF(0.f, v, 0x140, 0xF, true);
    v += DPPF(0.f, v, 0x142, 0xA, false); v += DPPF(0.f, v, 0x143, 0xC, false);
    return __builtin_bit_cast(float, __builtin_amdgcn_readlane(__builtin_bit_cast(int, v), 63));
}
__device__ __forceinline__ int opaque_tid() { int t = threadIdx.x; asm volatile("" : "+v"(t)); return t; }
__device__ __forceinline__ float xrow_max(float v) {
    { auto r = __builtin_amdgcn_permlane16_swap(__builtin_bit_cast(unsigned, v), __builtin_bit_cast(unsigned, v), false, false); v = fmaxf(__builtin_bit_cast(float, r[0]), __builtin_bit_cast(float, r[1])); }
    { auto r = __builtin_amdgcn_permlane32_swap(__builtin_bit_cast(unsigned, v), __builtin_bit_cast(unsigned, v), false, false); v = fmaxf(__builtin_bit_cast(float, r[0]), __builtin_bit_cast(float, r[1])); }
    return v; }
__device__ __forceinline__ float xrow_sum(float v) {
    { auto r = __builtin_amdgcn_permlane16_swap(__builtin_bit_cast(unsigned, v), __builtin_bit_cast(unsigned, v), false, false); v = __builtin_bit_cast(float, r[0]) + __builtin_bit_cast(float, r[1]); }
    { auto r = __builtin_amdgcn_permlane32_swap(__builtin_bit_cast(unsigned, v), __builtin_bit_cast(unsigned, v), false, false); v = __builtin_bit_cast(float, r[0]) + __builtin_bit_cast(float, r[1]); }
    return v; }
#define LDS_WAIT() asm volatile("s_waitcnt lgkmcnt(0)" ::: "memory")
#define VM_WAIT() asm volatile("s_waitcnt vmcnt(0)" ::: "memory")

namespace pg8 {
constexpr int BM = 256, BK = 64, HALF = 128, HTB = HALF * BK * 2, STAGE_BYTES = 8 * HTB, NXCD = 8, WGM = 8;
__host__ __device__ __forceinline__ int lds_byte(int r, int c) { const int st = (r >> 4) * 2 + (c >> 5), rr = r & 15, cc = c & 31, ob = rr * 64 + cc * 2; return st * 1024 + (ob ^ (((ob >> 9) & 1) << 5)); }
__host__ __device__ __forceinline__ void stage_rc(int b, int& R, int& C) { const int st = b / 1024, sb = b % 1024, swz = sb ^ (((sb >> 9) & 1) << 5); R = (st >> 1) * 16 + swz / 64; C = (st & 1) * 32 + (swz % 64) / 2; }
__host__ __device__ __forceinline__ int perm32(int rho) { const int n = rho >> 4, i = rho & 15; return 8 * (i >> 2) + 4 * n + (i & 3); }

struct Unit { int pm, pn, aux; };
struct Gemm { const bf16* A; int K; int ldb; int ksplit; };

struct StaticOrder {
    static constexpr bool GATHER = false;
    int nM, nN, nwg, G, c; const bf16* Bt; int ldb;
    __device__ void init(int M_, int N_, int G_, int c_, const bf16* Bt_, int ldb_) { nM = M_ / BM; nN = N_ / BM; nwg = nM * nN; G = G_; c = c_; Bt = Bt_; ldb = ldb_; }
    __device__ __forceinline__ bool next(int i, Unit& u) const {
        const long L = (long)i * G + c; if (L >= nwg) return false;
        int wgid = (int)L; { const int q = nwg / NXCD, r = nwg % NXCD, xcd = wgid % NXCD, off = wgid / NXCD; wgid = (xcd < r ? xcd * (q + 1) : r * (q + 1) + (xcd - r) * q) + off; }
        const int nig = WGM * nN, gid = wgid / nig, fm = gid * WGM, gsz = (nM - fm) < WGM ? (nM - fm) : WGM;
        u.pm = fm + ((wgid % nig) % gsz); u.pn = (wgid % nig) / gsz; u.aux = 0; return true;
    }
    __device__ __forceinline__ int a_row(const Unit& u, int r) const { return u.pm * BM + r; }
    __device__ __forceinline__ const char* b_seg(const Unit& u, int seg) const { return (const char*)(Bt + (size_t)u.pn * BM * ldb); }
};

template <class Epi, class Sched>
__device__ __forceinline__ void gemm_phase(LAS unsigned char* lds, const Gemm g, const Sched& S, const Epi& E) {
    const int tid = opaque_tid(), wid = __builtin_amdgcn_readfirstlane(tid >> 6), lane = tid & 63, wr = wid >> 2, wc = wid & 3, fr = lane & 15, fq = lane >> 4;
    const int K = g.K, nt = K / BK, ldb = g.ldb, ksplit = g.ksplit;
    int Rst[2], Cst[2]; unsigned voffB[2], voffA[2];
#pragma unroll
    for (int i = 0; i < 2; ++i) { int R, C; stage_rc(tid * 16 + i * 8192, R, C); const int Rb = Epi::PERM ? ((R & ~31) + perm32(R & 31)) : R; Rst[i] = R; Cst[i] = C;
        voffB[i] = (unsigned)(Rb * ldb + C) * 2u; voffA[i] = (unsigned)(R * K + C) * 2u; }
    const size_t hstepA = (size_t)HALF * K * 2;
    const size_t kstep = (size_t)(BK * 2);
    const size_t hstepB = (size_t)HALF * ldb * 2;
    const unsigned ldsw = (unsigned)wid * 1024u;
    const int aoff = lds_byte(wr * 64 + fr, fq * 8), boff = lds_byte(wc * 32 + fr, fq * 8);
#define PG8_SA(b, h) (((b) * 2 + (h)) * HTB)
#define PG8_SB(b, h) ((4 + (b) * 2 + (h)) * HTB)
#define PG8_STAGEB(bufoff, gbase) do { _Pragma("unroll") for (int _i = 0; _i < 2; ++_i) \
        __builtin_amdgcn_global_load_lds((const unsigned*)((const char*)(gbase) + voffB[_i]), (LAS unsigned*)(lds + (bufoff) + ldsw + _i * 8192), 16, 0, 0); } while (0)
#define PG8_STAGEA(bufoff, nextsel, h, kt) do { if constexpr (Sched::GATHER) { _Pragma("unroll") for (int _i = 0; _i < 2; ++_i) \
        __builtin_amdgcn_global_load_lds((const unsigned*)(gA + (size_t)(kt) * kstep + ((nextsel) ? vN[h][_i] : vA[h][_i])), (LAS unsigned*)(lds + (bufoff) + ldsw + _i * 8192), 16, 0, 0); } \
      else { const char* _ab = ((nextsel) ? nA : cA) + (size_t)(h) * hstepA + (size_t)(kt) * kstep; _Pragma("unroll") for (int _i = 0; _i < 2; ++_i) \
        __builtin_amdgcn_global_load_lds((const unsigned*)(_ab + voffA[_i]), (LAS unsigned*)(lds + (bufoff) + ldsw + _i * 8192), 16, 0, 0); } } while (0)
#define PG8_LDA(dst, b, h) do { _Pragma("unroll") for (int m = 0; m < 4; ++m) _Pragma("unroll") for (int k = 0; k < 2; ++k) dst[m][k] = *(const LAS bf16x8*)(lds + PG8_SA(b, h) + aoff + m * 2048 + k * 1024); } while (0)
#define PG8_LDB(dst, b, h) do { _Pragma("unroll") for (int n = 0; n < 2; ++n) _Pragma("unroll") for (int k = 0; k < 2; ++k) dst[n][k] = *(const LAS bf16x8*)(lds + PG8_SB(b, h) + boff + n * 2048 + k * 1024); } while (0)
#define PG8_MMA(ai, bj, At, Bt) do { __builtin_amdgcn_s_setprio(1); _Pragma("unroll") for (int m = 0; m < 4; ++m) _Pragma("unroll") for (int n = 0; n < 2; ++n) _Pragma("unroll") for (int k = 0; k < 2; ++k) \
        acc[ai][bj][m][n] = __builtin_amdgcn_mfma_f32_16x16x32_bf16(Bt[n][k], At[m][k], acc[ai][bj][m][n], 0, 0, 0); __builtin_amdgcn_s_setprio(0); } while (0)
#define PG8_WAIT_V(n) asm volatile("s_waitcnt vmcnt(" #n ")" ::: "memory")
#define PG8_WAIT_L(n) asm volatile("s_waitcnt lgkmcnt(" #n ")" ::: "memory")
#define PG8_BAR __builtin_amdgcn_s_barrier()
#define PG8_SCHED __builtin_amdgcn_sched_barrier(0)
#define PG8_AOFFS(dst, u) do { _Pragma("unroll") for (int _h = 0; _h < 2; ++_h) _Pragma("unroll") for (int _i = 0; _i < 2; ++_i) \
        dst[_h][_i] = (unsigned)S.a_row(u, _h * HALF + Rst[_i]) * (unsigned)(K * 2) + (unsigned)(Cst[_i] * 2); } while (0)
    Unit cur, nxt; int ui = 0;
    if (!S.next(0, cur)) return;
    const char* const gA = (const char*)g.A;
    f32x4 acc[2][2][4][2];
#pragma unroll
    for (int a = 0; a < 2; ++a)
#pragma unroll
        for (int b = 0; b < 2; ++b)
#pragma unroll
            for (int m = 0; m < 4; ++m)
#pragma unroll
                for (int n = 0; n < 2; ++n) acc[a][b][m][n] = (f32x4){0.f, 0.f, 0.f, 0.f};
    bf16x8 At[4][2], B0[2][2], B1[2][2];
    unsigned vA[2][2], vN[2][2];
    const char* cA = gA; const char* nA = gA;
    if constexpr (Sched::GATHER) { PG8_AOFFS(vA, cur); } else { cA = gA + (size_t)S.a_row(cur, 0) * K * 2; }
    const char* cB0 = S.b_seg(cur, 0); const char* cB1 = S.b_seg(cur, 1);
    PG8_STAGEB(PG8_SB(0, 0), cB0); PG8_STAGEB(PG8_SB(0, 1), cB0 + hstepB); PG8_STAGEA(PG8_SA(0, 0), false, 0, 0); PG8_STAGEA(PG8_SA(0, 1), false, 1, 0);
    if (wr == 1) PG8_BAR;
    PG8_WAIT_V(2); PG8_BAR;
    PG8_STAGEB(PG8_SB(1, 0), cB0 + kstep); PG8_STAGEA(PG8_SA(1, 0), false, 0, 1); PG8_STAGEB(PG8_SB(1, 1), cB0 + hstepB + kstep);
    PG8_WAIT_V(6); PG8_BAR;
    for (;;) {
        const bool has_next = S.next(ui + 1, nxt);
        const char* nB0 = cB0;
        nA = cA;
        if (has_next) { nB0 = S.b_seg(nxt, 0); if constexpr (Sched::GATHER) { PG8_AOFFS(vN, nxt); } else { nA = gA + (size_t)S.a_row(nxt, 0) * K * 2; } }
        else { if constexpr (Sched::GATHER) {
#pragma unroll
            for (int h = 0; h < 2; ++h)
#pragma unroll
                for (int i = 0; i < 2; ++i) vN[h][i] = vA[h][i]; } }
#pragma unroll 1
        for (int t = 0; t < nt; t += 2) {
            const bool last = (t == nt - 2);
            const char* b2 = last ? nB0 : ((t + 2 < ksplit) ? cB0 + (size_t)(t + 2) * kstep : cB1 + (size_t)(t + 2 - ksplit) * kstep);
            const char* b3 = b2 + kstep;
            const int kt2 = last ? 0 : t + 2;
            PG8_LDB(B0, 0, 0); PG8_LDB(B1, 0, 1); PG8_SCHED; PG8_LDA(At, 0, 0); PG8_STAGEA(PG8_SA(1, 1), false, 1, t + 1);
            PG8_WAIT_V(8); PG8_WAIT_L(0); PG8_BAR; PG8_MMA(0, 0, At, B0); PG8_MMA(0, 1, At, B1); PG8_BAR; PG8_SCHED;
            PG8_LDA(At, 0, 1); PG8_STAGEB(PG8_SB(0, 0), b2); PG8_STAGEB(PG8_SB(0, 1), b2 + hstepB); PG8_STAGEA(PG8_SA(0, 0), last, 0, kt2);
            PG8_WAIT_V(8); PG8_WAIT_L(0); PG8_BAR; PG8_MMA(1, 0, At, B0); PG8_MMA(1, 1, At, B1); PG8_BAR; PG8_SCHED;
            PG8_LDB(B0, 1, 0); PG8_LDB(B1, 1, 1); PG8_SCHED; PG8_LDA(At, 1, 0); PG8_STAGEA(PG8_SA(0, 1), last, 1, kt2);
            PG8_WAIT_V(8); PG8_WAIT_L(0); PG8_BAR; PG8_MMA(0, 0, At, B0); PG8_MMA(0, 1, At, B1); PG8_BAR; PG8_SCHED;
            PG8_LDA(At, 1, 1); PG8_STAGEB(PG8_SB(1, 0), b3); PG8_STAGEB(PG8_SB(1, 1), b3 + hstepB); PG8_STAGEA(PG8_SA(1, 0), last, 0, kt2 + 1);
            PG8_WAIT_V(8); PG8_WAIT_L(0); PG8_BAR; PG8_MMA(1, 0, At, B0); PG8_MMA(1, 1, At, B1); PG8_BAR; PG8_SCHED;
        }
        if (wr == 0) PG8_BAR;
        { int tz = tid; asm volatile("" : "+v"(tz));
          const int lz = tz & 63; E(acc, cur, ui, wr, wc, lz & 15, lz >> 4); }
        if (!has_next) break;
#pragma unroll
        for (int a = 0; a < 2; ++a)
#pragma unroll
            for (int b = 0; b < 2; ++b)
#pragma unroll
                for (int m = 0; m < 4; ++m)
#pragma unroll
                    for (int n = 0; n < 2; ++n) acc[a][b][m][n] = (f32x4){0.f, 0.f, 0.f, 0.f};
        cur = nxt; cB0 = nB0; cB1 = S.b_seg(cur, 1); cA = nA; ++ui;
        if constexpr (Sched::GATHER) {
#pragma unroll
        for (int h = 0; h < 2; ++h)
#pragma unroll
            for (int i = 0; i < 2; ++i) vA[h][i] = vN[h][i]; }
        if (wr == 1) PG8_BAR;
    }
    PG8_WAIT_V(0);
    PG8_BAR;
#undef PG8_SA
#undef PG8_SB
#undef PG8_STAGEA
#undef PG8_STAGEB
#undef PG8_LDA
#undef PG8_LDB
#undef PG8_MMA
#undef PG8_WAIT_V
#undef PG8_WAIT_L
#undef PG8_BAR
#undef PG8_SCHED
#undef PG8_AOFFS
}
}
#define XB_TMO      128
#define XB_XCNT(j)  (256  + 64 * (j))
#define XB_XSUB(j)  (1280 + 64 * (j))
#define XB_XGEN(j)  (2304 + 64 * (j))
#define XB_TOP      3328
#define XB_TOPGEN   3392
#define XCD_BAR_WORDS 3456
#define XB_SPIN_CAP (1u << 22)
__device__ __forceinline__ unsigned xb_ld(unsigned* p)              { return __hip_atomic_load(p, __ATOMIC_RELAXED, __HIP_MEMORY_SCOPE_AGENT); }
__device__ __forceinline__ unsigned xb_add(unsigned* p, unsigned v) { return __hip_atomic_fetch_add(p, v, __ATOMIC_RELAXED, __HIP_MEMORY_SCOPE_AGENT); }
__device__ __forceinline__ unsigned xb_xcc_id() { return (unsigned)__builtin_amdgcn_s_getreg((3 << 11) | 20) & 0xFu; }
#define XB_SPIN(cond, bar) do { unsigned _sp = 0; while (cond) { __builtin_amdgcn_s_sleep(1); \
    if ((++_sp & 255u) == 0u) { if (xb_ld(&(bar)[XB_TMO])) break; if (_sp > XB_SPIN_CAP) { atomicAdd(&(bar)[XB_TMO], 1u); break; } } } } while (0)
struct XcdBarrier { unsigned* bar; unsigned x; volatile LAS unsigned* st; };
__device__ __forceinline__ XcdBarrier xcd_barrier_post(unsigned* bar, volatile LAS unsigned* st) {
    XcdBarrier b; b.bar = bar; b.x = xb_xcc_id(); b.st = st;
    if (threadIdx.x == 0) (void)xb_add(&bar[XB_XCNT(b.x)], 1u);
    return b;
}
__device__ __forceinline__ void xcd_barrier_complete(unsigned* bar, unsigned x, unsigned& nloc, unsigned& nx) {
    const unsigned G = gridDim.x * gridDim.y * gridDim.z;
    unsigned sum, cnt, mine, sp = 0u;
    for (;;) {
        sum = 0u; cnt = 0u; mine = 0u;
#pragma unroll
        for (unsigned j = 0; j < 16; ++j) { const unsigned c = xb_ld(&bar[XB_XCNT(j)]); sum += c; cnt += (c > 0u) ? 1u : 0u; mine = (j == x) ? c : mine; }
        if (sum == G) break;
        __builtin_amdgcn_s_sleep(1);
        if ((++sp & 255u) == 0u) { if (xb_ld(&bar[XB_TMO])) break; if (sp > XB_SPIN_CAP) { atomicAdd(&bar[XB_TMO], 1u); break; } }
    }
    nloc = mine > 0u ? mine : 1u; nx = cnt > 0u ? cnt : 1u;
}
__device__ __forceinline__ void xcd_barrier(const XcdBarrier& b) {
    asm volatile("s_waitcnt vmcnt(0)" ::: "memory");
    __syncthreads();
    if (threadIdx.x == 0) {
        unsigned* bar = b.bar;
        __builtin_amdgcn_s_waitcnt(0);
        unsigned nloc = b.st[0], nx = b.st[1];
        if (nloc == 0u) { xcd_barrier_complete(bar, b.x, nloc, nx); b.st[0] = nloc; b.st[1] = nx; }
        const unsigned old = xb_add(&bar[XB_XSUB(b.x)], 1u);
        const unsigned gen = old / nloc;
        if (old + 1u == (gen + 1u) * nloc) {
            __builtin_amdgcn_fence(__ATOMIC_RELEASE, "agent");
            asm volatile("s_waitcnt vmcnt(0)" ::: "memory");
            const unsigned og = xb_add(&bar[XB_TOP], 1u);
            const unsigned tg = og / nx;
            if (og + 1u == (tg + 1u) * nx) xb_add(&bar[XB_TOPGEN], 1u);
            else XB_SPIN(xb_ld(&bar[XB_TOPGEN]) == tg, bar);
            __builtin_amdgcn_fence(__ATOMIC_ACQUIRE, "agent");
            xb_add(&bar[XB_XGEN(b.x)], 1u);
            asm volatile("s_waitcnt vmcnt(0)" ::: "memory");
        } else {
            XB_SPIN(xb_ld(&bar[XB_XGEN(b.x)]) == gen, bar);
            __builtin_amdgcn_fence(__ATOMIC_ACQUIRE, "agent");
            asm volatile("s_waitcnt vmcnt(0)" ::: "memory");
        }
    }
    __syncthreads();
}

constexpr size_t MiB = 1u << 20;
constexpr size_t WS_CTL = 0, CTL_ZERO_BYTES = 1 * MiB;
constexpr size_t WS_MOD = 1 * MiB;
constexpr size_t WS_TABA = 2 * MiB;
constexpr size_t WS_TABM = 3 * MiB;
constexpr size_t WS_WGU = 4 * MiB;
constexpr size_t WS_WDN = 20 * MiB;
constexpr size_t WS_WMIX = 28 * MiB;
constexpr size_t WS_X = 52 * MiB;
constexpr size_t WS_H = 188 * MiB;
constexpr size_t WS_SCR = 256 * MiB;
constexpr size_t WS_END = 512 * MiB;
constexpr size_t MOE_ACT = WS_SCR;
constexpr size_t MOE_SL = WS_SCR + 48 * MiB;
constexpr size_t MOE_WT = WS_SCR + 52 * MiB;
constexpr int CW_BAR = 4096;
constexpr int CW_MOECNT = 16384;
constexpr int CW_POISON = 20000;

constexpr int RING_BYTES = 131072;
constexpr int LDS_MISC = RING_BYTES;
constexpr int LDS_TB = RING_BYTES + 512;
constexpr int LDS_TBL = RING_BYTES + 1024;
constexpr int LDS_BYTES = RING_BYTES + 1024 + 16384;

struct Frame {
    LAS unsigned char* lds;
    unsigned* ctl;
    unsigned char* ws;
    float* out;
    int tid, lane, wave, vcu;
};

__device__ __forceinline__ void refresh(Frame& F) { F.tid = opaque_tid(); F.lane = F.tid & 63; F.wave = __builtin_amdgcn_readfirstlane(F.tid >> 6); }
#if defined(PROBE_BAR2)
#define SYNC_GRID() do { xcd_barrier(bar); xcd_barrier(bar); refresh(F); } while (0)
#else
#define SYNC_GRID() do { xcd_barrier(bar); refresh(F); } while (0)
#endif
__device__ __forceinline__ int modrow_of(int row) { const int b = row / TPB, t = row - b * TPB; return t < CTX ? 8 : b; }

enum { MAP_ID = 0, MAP_ATTN_IN, MAP_SSM_IN, MAP_MLA_IN, MAP_MLA_QUP, MAP_MOE_G, MAP_MOE_U };
template <int KIND> __device__ __forceinline__ int map_row(int n, int aux) {
    if (KIND == MAP_ID) return aux + n;
    if (KIND == MAP_ATTN_IN) { if (n >= 1280) return n; const int hb = n & ~63, d = n & 63; return hb + (d < 32 ? 2 * d : 2 * (d - 32) + 1); }
    if (KIND == MAP_SSM_IN) {
        if (n < 2048) { const int gp = n >> 10; return gp * 2816 + (n & 1023); }
        if (n < 4096) { const int c = n - 2048, gp = c >> 10; return gp * 2816 + 1024 + (c & 1023); }
        if (n < 4608) { const int c = n - 4096, gp = c >> 8; return gp * 2816 + 2048 + (c & 255); }
        if (n < 5120) { const int c = n - 4608, gp = c >> 8; return gp * 2816 + 2304 + (c & 255); }
        { const int c = n - 5120, dir = c >> 5, h = c & 31, gp = h >> 4; return gp * 2816 + 2560 + dir * 16 + (h & 15); }
    }
    if (KIND == MAP_MLA_IN) { if (n < 512) return n; const int d = n - 512; return 512 + (d < 16 ? 2 * d : 2 * (d - 16) + 1); }
    if (KIND == MAP_MLA_QUP) { const int h = n / 96, e = n - h * 96; if (e < 64) return n; const int d = e - 64; return h * 96 + 64 + (d < 16 ? 2 * d : 2 * (d - 16) + 1); }
    if (KIND == MAP_MOE_G) return aux + (n >> 7) * 256 + (n & 127);
    if (KIND == MAP_MOE_U) return aux + (n >> 7) * 256 + 128 + (n & 127);
    return n;
}
template <int KIND>
__device__ __forceinline__ void transpose_item(const float* W, int K, int N, bf16* WT, int aux, const float* kscale, LAS float* scr, int item, int lane) {
    const int nblk = N / 32, kb = item / nblk, nb = item % nblk, k0 = 64 * kb, n0 = 32 * nb;
#pragma unroll 8
    for (int i = 0; i < 32; ++i) { const int kk = 2 * i + (lane >> 5); float v = W[(size_t)(k0 + kk) * N + n0 + (lane & 31)]; if (kscale) v *= kscale[k0 + kk]; scr[kk * 33 + (lane & 31)] = v; }
    LDS_WAIT(); asm volatile("" ::: "memory");
    const int c = lane & 7;
#pragma unroll
    for (int j = 0; j < 4; ++j) { const int n = (lane >> 3) + 8 * j; const LAS float* s = scr + (8 * c) * 33 + n;
        v4u o; o.x = cvt_pk_bf16(s[0 * 33], s[1 * 33]); o.y = cvt_pk_bf16(s[2 * 33], s[3 * 33]); o.z = cvt_pk_bf16(s[4 * 33], s[5 * 33]); o.w = cvt_pk_bf16(s[6 * 33], s[7 * 33]);
        *(v4u*)(WT + (size_t)map_row<KIND>(n0 + n, aux) * K + k0 + 8 * c) = o; }
    LDS_WAIT(); asm volatile("" ::: "memory");
}
template <int KIND>
__device__ __forceinline__ void convert_matrix(Frame& F, const float* W, int K, int N, bf16* WT, int aux, const float* kscale) {
    LAS float* scr = (LAS float*)(F.lds + F.wave * 16384);
    const int gw = F.vcu * NWAVES + F.wave, NGW = GRID * NWAVES, nitems = (K / 64) * (N / 32);
    for (int it = gw; it < nitems; it += NGW) transpose_item<KIND>(W, K, N, WT, aux, kscale, scr, it, F.lane);
}
__device__ __forceinline__ void zero_rows(Frame& F, bf16* WT, int row0, int nrows, int K) {
    const size_t n16 = (size_t)nrows * K / 8; v4u* p = (v4u*)(WT + (size_t)row0 * K);
    for (size_t i = (size_t)blockIdx.x * NTHR + F.tid; i < n16; i += (size_t)GRID * NTHR) p[i] = (v4u){0u, 0u, 0u, 0u};
}
__device__ __forceinline__ void convert_moe(Frame& F, const float* const* in, int layer) {
    bf16* GU = (bf16*)(F.ws + WS_WGU); bf16* DN = (bf16*)(F.ws + WS_WDN);
    const float* wg = in[12] + (size_t)layer * 16 * 1024 * 256; const float* wu = in[13] + (size_t)layer * 16 * 1024 * 256; const float* wd = in[14] + (size_t)layer * 16 * 256 * 1024;
    LAS float* scr = (LAS float*)(F.lds + F.wave * 16384);
    const int gw = F.vcu * NWAVES + F.wave, NGW = GRID * NWAVES;
    for (int it = gw; it < 16 * 384; it += NGW) { const int e = it / 384, r = it - e * 384, kind = r >> 7, sub = r & 127;
        if (kind == 0) transpose_item<MAP_MOE_G>(wg + (size_t)e * 1024 * 256, 1024, 256, GU, e * 512, nullptr, scr, sub, F.lane);
        else if (kind == 1) transpose_item<MAP_MOE_U>(wu + (size_t)e * 1024 * 256, 1024, 256, GU, e * 512, nullptr, scr, sub, F.lane);
        else transpose_item<MAP_ID>(wd + (size_t)e * 256 * 1024, 256, 1024, DN, e * 1024, nullptr, scr, sub, F.lane); }
}

__device__ __forceinline__ const float* src_row(const float* const* in, int r) { const int b = r / TPB, t = r - b * TPB; return t < CTX ? in[2] + ((size_t)b * CTX + t) * D : in[0] + ((size_t)b * SEQ + (t - CTX)) * D; }
__device__ __forceinline__ float row_load_ss(const float* xrow, int lane, f32x4 (&v)[4]) {
    const f32x4* xr = (const f32x4*)xrow + lane; float s = 0.f;
#pragma unroll
    for (int j = 0; j < 4; ++j) { v[j] = xr[64 * j]; s += (v[j].x * v[j].x + v[j].y * v[j].y) + (v[j].z * v[j].z + v[j].w * v[j].w); }
    return s;
}
__device__ __forceinline__ void row_finish(const f32x4 (&v)[4], float ss, const float* g, const float* sc, const float* sh, bf16* orow, int lane, f32x4 (&hv)[4]) {
    const float rstd = rsqrtf(ss * (1.f / D) + EPS);
    unsigned long long* o8 = (unsigned long long*)orow + lane;
#pragma unroll
    for (int j = 0; j < 4; ++j) {
        const f32x4 gg = ((const f32x4*)g)[lane + 64 * j], ss4 = ((const f32x4*)sc)[lane + 64 * j], hh = ((const f32x4*)sh)[lane + 64 * j];
        f32x4 h = v[j] * rstd * gg * (ss4 + 1.0f) + hh; hv[j] = h;
        o8[64 * j] = (unsigned long long)cvt_pk_bf16(h.x, h.y) | ((unsigned long long)cvt_pk_bf16(h.z, h.w) << 32);
    }
}
__device__ __forceinline__ void phase_norm1(Frame& F, const float* const* in, int layer) {
    const float* X = (const float*)(F.ws + WS_X); bf16* H = (bf16*)(F.ws + WS_H);
    const float* g = in[4] + layer * D; const float* mod = (const float*)(F.ws + WS_MOD) + (size_t)layer * 9 * 6144;
    const int gw = F.vcu * NWAVES + F.wave, NGW = GRID * NWAVES;
    for (int r = gw; r < M; r += 2 * NGW) { const int r2 = r + NGW; const bool two = r2 < M; f32x4 va[4], vb[4], hv[4];
        float sa = row_load_ss(layer == 0 ? src_row(in, r) : X + (size_t)r * D, F.lane, va), sb = 0.f;
        if (two) sb = row_load_ss(layer == 0 ? src_row(in, r2) : X + (size_t)r2 * D, F.lane, vb);
        sa = wave_sum(sa); sb = wave_sum(sb);
        { const float* mr = mod + (size_t)modrow_of(r) * 6144; row_finish(va, sa, g, mr + 1024, mr, H + (size_t)r * D, F.lane, hv); }
        if (two) { const float* mr = mod + (size_t)modrow_of(r2) * 6144; row_finish(vb, sb, g, mr + 1024, mr, H + (size_t)r2 * D, F.lane, hv); } }
}

__device__ __forceinline__ void phase_prologue(Frame& F, const float* const* in) {
    { f32x2* TA = (f32x2*)(F.ws + WS_TABA); f32x2* TM = (f32x2*)(F.ws + WS_TABM);
      for (int i = blockIdx.x * NTHR + F.tid; i < SEQ * 32; i += GRID * NTHR) { const int pos = i >> 5, a = i & 31; const float p = (a < 16) ? (float)(pos >> 6) : (float)(pos & 63);
          const float inv = fast_exp2(-(float)(a & 15) * (13.287712379549449f / 16.0f)); const float rev = p * inv * 0.15915494309189535f; TA[i] = (f32x2){__builtin_amdgcn_cosf(rev), __builtin_amdgcn_sinf(rev)}; }
      for (int i = blockIdx.x * NTHR + F.tid; i < SEQ * 16; i += GRID * NTHR) { const int pos = i >> 4, a = i & 15; const float p = (a < 8) ? (float)(pos >> 6) : (float)(pos & 63);
          const float inv = fast_exp2(-(float)(a & 7) * (13.287712379549449f / 8.0f)); const float rev = p * inv * 0.15915494309189535f; TM[i] = (f32x2){__builtin_amdgcn_cosf(rev), __builtin_amdgcn_sinf(rev)}; } }
    { LAS float* sc = (LAS float*)F.lds;
      LAS float* part = (LAS float*)(F.lds + 40960);
      for (int i = F.tid; i < 9 * 1024; i += NTHR) { const int r = i >> 10, k = i & 1023; const float c = r < 8 ? in[1][r * 1024 + k] : in[3][k]; sc[i] = silu_f(c); }
      __syncthreads();
      float* MOD = (float*)(F.ws + WS_MOD);
      const int cq = F.tid & 15, ks = F.tid >> 4;
      for (int u = F.vcu; u < 4 * 96; u += GRID) { const int l = u / 96, cb = u % 96;
          const float* w = in[6] + (size_t)l * 1024 * 6144 + cb * 64 + cq * 4; f32x4 a[9];
#pragma unroll
          for (int r = 0; r < 9; ++r) a[r] = (f32x4){0.f, 0.f, 0.f, 0.f};
#pragma unroll 8
          for (int k = ks * 32; k < ks * 32 + 32; ++k) { const f32x4 wv = *(const f32x4*)(w + (size_t)k * 6144);
#pragma unroll
              for (int r = 0; r < 9; ++r) a[r] = a[r] + wv * sc[r * 1024 + k]; }
#pragma unroll
          for (int r = 0; r < 9; ++r) *(LAS f32x4*)(part + (ks * 9 + r) * 64 + cq * 4) = a[r];
          __syncthreads();
          for (int i = F.tid; i < 9 * 64; i += NTHR) { const int r = i >> 6, c = i & 63; float s = 0.f;
#pragma unroll
              for (int q = 0; q < 32; ++q) s += part[(q * 9 + r) * 64 + c];
              MOD[((size_t)l * 9 + r) * 6144 + cb * 64 + c] = s + in[7][l * 6144 + cb * 64 + c]; }
          __syncthreads(); } }
}

__device__ __forceinline__ void phase_norm2_route(Frame& F, const float* const* in, int layer) {
    constexpr int RPW = M / GRID;
    LAS float* wl = (LAS float*)F.lds;
    LAS int* lcnt = (LAS int*)(F.lds + 81920);
    LAS int* lbase = (LAS int*)(F.lds + 81920 + 128);
    LAS int* rcls = (LAS int*)(F.lds + 81920 + 256);
    LAS int* rrank = (LAS int*)(F.lds + 81920 + 256 + 1024);
    LAS float* lgw = (LAS float*)(F.lds + 81920 + 4096);
    const float* wrg = in[8] + (size_t)layer * 1024 * 4; const float* wre = in[10] + (size_t)layer * 1024 * 16;
    for (int i = F.tid; i < 1024 * 4; i += NTHR) { const int k = i >> 2, o = i & 3; wl[o * 1024 + k] = wrg[i]; }
    for (int i = F.tid; i < 1024 * 16; i += NTHR) { const int k = i >> 4, o = i & 15; wl[(4 + o) * 1024 + k] = wre[i]; }
    if (F.tid < 24) lcnt[F.tid] = 0;
    __syncthreads();
    const float* X = (const float*)(F.ws + WS_X); bf16* H = (bf16*)(F.ws + WS_H);
    const float* g = in[5] + layer * D; const float* mod = (const float*)(F.ws + WS_MOD) + (size_t)layer * 9 * 6144;
    const float* brg = in[9] + layer * 4; const float* bre = in[11] + layer * 16;
    float* WT = (float*)(F.ws + MOE_WT); int* SL = (int*)(F.ws + MOE_SL);
    const int row0 = blockIdx.x * RPW;
    for (int i0 = F.wave; i0 < RPW; i0 += 2 * NWAVES) { const int i1 = i0 + NWAVES; const bool two = i1 < RPW; const int ra = row0 + i0, rb = two ? row0 + i1 : ra;
        f32x4 va[4], vb[4], ha[4], hb[4];
        float sa = row_load_ss(X + (size_t)ra * D, F.lane, va), sb = row_load_ss(X + (size_t)rb * D, F.lane, vb);
        sa = wave_sum(sa); sb = wave_sum(sb);
        { const float* mr = mod + (size_t)modrow_of(ra) * 6144; row_finish(va, sa, g, mr + 4 * 1024, mr + 3 * 1024, H + (size_t)ra * D, F.lane, ha); }
        { const float* mr = mod + (size_t)modrow_of(rb) * 6144; row_finish(vb, sb, g, mr + 4 * 1024, mr + 3 * 1024, H + (size_t)rb * D, F.lane, hb); }
        LAS float* lgs = lgw + F.wave * 64;
        for (int o = 0; o < 20; ++o) { float s = 0.f, t = 0.f;
#pragma unroll
            for (int j = 0; j < 4; ++j) { const f32x4 w = *(const LAS f32x4*)(wl + o * 1024 + 4 * F.lane + 256 * j);
                s += (ha[j].x * w.x + ha[j].y * w.y) + (ha[j].z * w.z + ha[j].w * w.w); t += (hb[j].x * w.x + hb[j].y * w.y) + (hb[j].z * w.z + hb[j].w * w.w); }
            s = wave_sum(s); t = wave_sum(t); if (F.lane == 0) { lgs[o] = s; lgs[32 + o] = t; } }
        LDS_WAIT(); asm volatile("" ::: "memory");
        for (int q = 0; q < (two ? 2 : 1); ++q) { const LAS float* lq_ = lgs + 32 * q; const int r = q ? rb : ra, i = q ? i1 : i0;
        float g0 = lq_[0] + brg[0], g1 = lq_[1] + brg[1], g2 = lq_[2] + brg[2], g3 = lq_[3] + brg[3];
        int gs = 0; float gm = g0; if (g1 > gm) { gm = g1; gs = 1; } if (g2 > gm) { gm = g2; gs = 2; } if (g3 > gm) { gm = g3; gs = 3; }
        const float pg = 1.0f / (fast_exp(g0 - gm) + fast_exp(g1 - gm) + fast_exp(g2 - gm) + fast_exp(g3 - gm));
        float e0 = lq_[4 + gs * 4 + 0] + bre[gs * 4 + 0], e1 = lq_[4 + gs * 4 + 1] + bre[gs * 4 + 1], e2 = lq_[4 + gs * 4 + 2] + bre[gs * 4 + 2], e3 = lq_[4 + gs * 4 + 3] + bre[gs * 4 + 3];
        int i1x = 0; float v1 = e0; if (e1 > v1) { v1 = e1; i1x = 1; } if (e2 > v1) { v1 = e2; i1x = 2; } if (e3 > v1) { v1 = e3; i1x = 3; }
        int i2x = -1; float v2 = -3.0e38f;
        if (i1x != 0 && e0 > v2) { v2 = e0; i2x = 0; } if (i1x != 1 && e1 > v2) { v2 = e1; i2x = 1; } if (i1x != 2 && e2 > v2) { v2 = e2; i2x = 2; } if (i1x != 3 && e3 > v2) { v2 = e3; i2x = 3; }
        const float ex = fast_exp(v2 - v1), w1 = pg / (1.0f + ex), w2 = pg * ex / (1.0f + ex);
        const int lo = i1x < i2x ? i1x : i2x, hi = i1x < i2x ? i2x : i1x; const float wlo = i1x < i2x ? w1 : w2, whi = i1x < i2x ? w2 : w1;
        const int pair = lo == 0 ? hi - 1 : (lo == 1 ? hi + 1 : 5);
        const int cls = gs * 6 + pair;
        if (F.lane == 0) { WT[2 * (size_t)r] = wlo; WT[2 * (size_t)r + 1] = whi; rcls[i] = cls; rrank[i] = atomicAdd((int*)&lcnt[cls], 1); }
        }
        LDS_WAIT(); asm volatile("" ::: "memory");
    }
    __syncthreads();
    if (F.tid < 24) lbase[F.tid] = (int)atomicAdd(F.ctl + CW_MOECNT + layer * 64 + F.tid, (unsigned)lcnt[F.tid]);
    __syncthreads();
    for (int i = F.tid; i < RPW; i += NTHR) { const int c = rcls[i]; SL[(size_t)c * M + lbase[c] + rrank[i]] = row0 + i; }
}

__device__ __forceinline__ void phase_final(Frame& F, const float* const* in, bool poison) {
    const float* X = (const float*)(F.ws + WS_X); const float* g = in[36];
    const int gw = F.vcu * NWAVES + F.wave, NGW = GRID * NWAVES;
    for (int q = gw; q < NB * SEQ; q += 2 * NGW) { const int q2 = q + NGW;
        const int ra = (q / SEQ) * TPB + CTX + (q % SEQ), rb = (q2 / SEQ) * TPB + CTX + (q2 % SEQ); f32x4 va[4], vb[4];
        float sa = row_load_ss(X + (size_t)ra * D, F.lane, va), sb = row_load_ss(X + (size_t)rb * D, F.lane, vb);
        sa = wave_sum(sa); sb = wave_sum(sb);
        float rsa = rsqrtf(sa * (1.f / D) + EPS), rsb = rsqrtf(sb * (1.f / D) + EPS); if (poison) { rsa = __builtin_nanf(""); rsb = rsa; }
        f32x4* oa = (f32x4*)(F.out + (size_t)q * D) + F.lane; f32x4* ob = (f32x4*)(F.out + (size_t)q2 * D) + F.lane;
#pragma unroll
        for (int j = 0; j < 4; ++j) { const f32x4 gg = ((const f32x4*)g)[F.lane + 64 * j]; oa[64 * j] = va[j] * rsa * gg; ob[64 * j] = vb[j] * rsb * gg; } }
}
typedef f32x4 AccT[2][2][4][2];
using pg8::Unit;

__device__ __forceinline__ v4u pack8(const f32x4 a, const f32x4 b) { v4u w; w.x = cvt_pk_bf16(a[0], a[1]); w.y = cvt_pk_bf16(a[2], a[3]); w.z = cvt_pk_bf16(b[0], b[1]); w.w = cvt_pk_bf16(b[2], b[3]); return w; }
__device__ __forceinline__ void rope8(f32x4& a, f32x4& b, const f32x2* cs) {
    const f32x4 c01 = *(const f32x4*)cs, c23 = *(const f32x4*)(cs + 2);
    float t;
    t = a[0] * c01[0] - a[1] * c01[1]; a[1] = a[1] * c01[0] + a[0] * c01[1]; a[0] = t;
    t = a[2] * c01[2] - a[3] * c01[3]; a[3] = a[3] * c01[2] + a[2] * c01[3]; a[2] = t;
    t = b[0] * c23[0] - b[1] * c23[1]; b[1] = b[1] * c23[0] + b[0] * c23[1]; b[0] = t;
    t = b[2] * c23[2] - b[3] * c23[3]; b[3] = b[3] * c23[2] + b[2] * c23[3]; b[2] = t;
}

struct EpiResid {
    static constexpr bool PERM = false;
    float* X; const float* gate; const float* x_in; const float* ctx_in;
    __device__ __forceinline__ void operator()(const AccT& acc, const Unit& u, int ui, int wr, int wc, int fr, int fq) const {
        const int tb = u.pm % 17, b = u.pm / 17; const float* gv = gate + (size_t)(tb == 0 ? 8 : b) * 6144;
        const float* src = x_in ? (tb == 0 ? ctx_in + (size_t)b * CTX * D : x_in + ((size_t)b * SEQ + (tb - 1) * 256) * D) - (size_t)u.pm * 256 * D : X;
        const int row0 = u.pm * 256 + wr * 64 + fr, col0 = u.pn * 256 + wc * 32 + 4 * fq;
        f32x4 g4[2][2];
#pragma unroll
        for (int bj = 0; bj < 2; ++bj)
#pragma unroll
            for (int n = 0; n < 2; ++n) g4[bj][n] = *(const f32x4*)(gv + col0 + bj * 128 + n * 16);
#pragma unroll
        for (int ai = 0; ai < 2; ++ai)
#pragma unroll
            for (int m = 0; m < 4; ++m) { float* rowp = X + (size_t)(row0 + ai * 128 + m * 16) * D + col0;
#pragma unroll
                for (int bj = 0; bj < 2; ++bj)
#pragma unroll
                    for (int n = 0; n < 2; ++n) { f32x4* p = (f32x4*)(rowp + bj * 128 + n * 16); const f32x4* s = (const f32x4*)(src + (p - (f32x4*)X) * 4); *p = *s + g4[bj][n] * acc[ai][bj][m][n]; }
                asm volatile("" ::: "memory"); }
    }
};

struct EpiAttnIn {
    static constexpr bool PERM = true;
    bf16 *Q, *Kb, *Vb; const f32x2* tab; float qscale;
    __device__ __forceinline__ void operator()(const AccT& acc, const Unit& u, int ui, int wr, int wc, int fr, int fq) const {
        const int tb = u.pm % 17; const bool lat = tb != 0; const int pos0 = (tb - 1) * 256;
        bf16* base; int ld, colt; float sc = 1.f; bool rope = lat;
        if (u.pn < 4) { base = Q; ld = 1024; colt = u.pn * 256; sc = qscale; } else if (u.pn == 4) { base = Kb; ld = 256; colt = 0; } else { base = Vb; ld = 256; colt = 0; rope = false; }
#pragma unroll
        for (int ai = 0; ai < 2; ++ai)
#pragma unroll
            for (int m = 0; m < 4; ++m) { const int rl = ai * 128 + wr * 64 + m * 16 + fr; const size_t row = (size_t)u.pm * 256 + rl;
#pragma unroll
                for (int bj = 0; bj < 2; ++bj) { const int cl = bj * 128 + wc * 32 + 8 * fq;
                    f32x4 a = acc[ai][bj][m][0] * sc, b = acc[ai][bj][m][1] * sc;
                    if (rope) rope8(a, b, tab + (size_t)(pos0 + rl) * 32 + ((cl & 63) >> 1));
                    *(v4u*)(base + row * ld + colt + cl) = pack8(a, b); }
                asm volatile("" ::: "memory"); }
    }
};

struct EpiSsmIn {
    static constexpr bool PERM = true;
    bf16 *Z, *XBC; float* DT; const float* dtb;
    __device__ __forceinline__ void operator()(const AccT& acc, const Unit& u, int ui, int wr, int wc, int fr, int fq) const {
#pragma unroll
        for (int ai = 0; ai < 2; ++ai)
#pragma unroll
            for (int m = 0; m < 4; ++m) { const size_t row = (size_t)u.pm * 256 + ai * 128 + wr * 64 + m * 16 + fr;
#pragma unroll
                for (int bj = 0; bj < 2; ++bj) { const int c = u.pn * 256 + bj * 128 + wc * 32 + 8 * fq;
                    const f32x4 a = acc[ai][bj][m][0], b = acc[ai][bj][m][1];
                    if (c < 1024) *(v4u*)(Z + row * 1024 + c) = pack8(a, b);
                    else if (c < 2560) *(v4u*)(XBC + row * 1536 + (c - 1024)) = pack8(a, b);
                    else if (c < 2592) { const int cc = c - 2560; f32x4 o0, o1;
#pragma unroll
                        for (int j = 0; j < 4; ++j) { o0[j] = softplus_f(a[j] + dtb[(cc >> 4) * 32 + (cc & 15) + j]); o1[j] = softplus_f(b[j] + dtb[(cc >> 4) * 32 + (cc & 15) + 4 + j]); }
                        *(f32x4*)(DT + row * 32 + cc) = o0; *(f32x4*)(DT + row * 32 + cc + 4) = o1; } } }
    }
};

struct EpiMlIn {
    static constexpr bool PERM = true;
    bf16 *Qm, *Km, *Vm, *Om; float* G; const float* gb;
    __device__ __forceinline__ void operator()(const AccT& acc, const Unit& u, int ui, int wr, int wc, int fr, int fq) const {
#pragma unroll
        for (int ai = 0; ai < 2; ++ai)
#pragma unroll
            for (int m = 0; m < 4; ++m) { const size_t row = (size_t)u.pm * 256 + ai * 128 + wr * 64 + m * 16 + fr;
#pragma unroll
                for (int bj = 0; bj < 2; ++bj) { const int c = u.pn * 256 + bj * 128 + wc * 32 + 8 * fq;
                    const f32x4 a = acc[ai][bj][m][0], b = acc[ai][bj][m][1];
                    if (c < 512) *(v4u*)(Qm + row * 512 + c) = pack8(a, b);
                    else if (c < 1024) *(v4u*)(Km + row * 512 + (c - 512)) = pack8(a * 0.125f, b * 0.125f);
                    else if (c < 2048) *(v4u*)(Vm + row * 1024 + (c - 1024)) = pack8(a, b);
                    else if (c < 3072) *(v4u*)(Om + row * 1024 + (c - 2048)) = pack8(a, b);
                    else if (c < 3104) { const int cc = c - 3072; f32x4 o0, o1; const bool fg = ((cc >> 3) & 1) != 0;
#pragma unroll
                        for (int j = 0; j < 4; ++j) { float x0 = a[j] + gb[cc + j], x1 = b[j] + gb[cc + 4 + j];
                            o0[j] = fg ? -softplus_f(-x0) : x0; o1[j] = fg ? -softplus_f(-x1) : x1; }
                        *(f32x4*)(G + row * 32 + cc) = o0; *(f32x4*)(G + row * 32 + cc + 4) = o1; } } }
    }
};

struct EpiMlaIn {
    static constexpr bool PERM = true;
    bf16 *CQ, *CKV, *KF; float* SSQ; const f32x2* tab;
    __device__ __forceinline__ void operator()(const AccT& acc, const Unit& u, int ui, int wr, int wc, int fr, int fq) const {
        const int tb = u.pm % 17; const bool lat = tb != 0; const int pos0 = (tb - 1) * 256;
#pragma unroll
        for (int ai = 0; ai < 2; ++ai)
#pragma unroll
            for (int m = 0; m < 4; ++m) { const int rl = ai * 128 + wr * 64 + m * 16 + fr; const size_t row = (size_t)u.pm * 256 + rl;
                if (u.pn < 2) { bf16* dst = u.pn == 0 ? CQ : CKV; float ss = 0.f;
#pragma unroll
                    for (int bj = 0; bj < 2; ++bj) { const int c = bj * 128 + wc * 32 + 8 * fq; const f32x4 a = acc[ai][bj][m][0], b = acc[ai][bj][m][1];
                        ss += (a[0] * a[0] + a[1] * a[1]) + (a[2] * a[2] + a[3] * a[3]) + (b[0] * b[0] + b[1] * b[1]) + (b[2] * b[2] + b[3] * b[3]);
                        *(v4u*)(dst + row * 256 + c) = pack8(a, b); }
                    ss += __shfl_xor(ss, 16); ss += __shfl_xor(ss, 32);
                    if (fq == 0) SSQ[row * 8 + u.pn * 4 + wc] = ss;
                } else if (wc == 0) {
                    f32x4 a = acc[ai][0][m][0], b = acc[ai][0][m][1]; const int cl = 8 * fq;
                    if (lat) rope8(a, b, tab + (size_t)(pos0 + rl) * 16 + (cl >> 1));
                    const v4u w = pack8(a, b);
#pragma unroll
                    for (int h = 0; h < 16; ++h) *(v4u*)(KF + row * 1536 + h * 96 + 64 + cl) = w; }
                asm volatile("" ::: "memory"); }
    }
};
struct EpiMlaQ {
    static constexpr bool PERM = true;
    bf16* Q3; const float* SSQ; const f32x2* tab; float qscale;
    __device__ __forceinline__ void operator()(const AccT& acc, const Unit& u, int ui, int wr, int wc, int fr, int fq) const {
        const int tb = u.pm % 17; const bool lat = tb != 0; const int pos0 = (tb - 1) * 256;
#pragma unroll
        for (int ai = 0; ai < 2; ++ai)
#pragma unroll
            for (int m = 0; m < 4; ++m) { const int rl = ai * 128 + wr * 64 + m * 16 + fr; const size_t row = (size_t)u.pm * 256 + rl;
                const f32x4 s4 = *(const f32x4*)(SSQ + row * 8); const float rs = rsqrtf(((s4[0] + s4[1]) + (s4[2] + s4[3])) * (1.f / 256.f) + EPS) * qscale;
#pragma unroll
                for (int bj = 0; bj < 2; ++bj) { const int c = u.pn * 256 + bj * 128 + wc * 32 + 8 * fq; const int e = c % 96;
                    f32x4 a = acc[ai][bj][m][0] * rs, b = acc[ai][bj][m][1] * rs;
                    if (lat && e >= 64) rope8(a, b, tab + (size_t)(pos0 + rl) * 16 + ((e - 64) >> 1));
                    *(v4u*)(Q3 + row * 1536 + c) = pack8(a, b); }
                asm volatile("" ::: "memory"); }
    }
};
struct EpiMlaKV {
    static constexpr bool PERM = true;
    bf16 *KF, *V3; const float* SSQ;
    __device__ __forceinline__ void operator()(const AccT& acc, const Unit& u, int ui, int wr, int wc, int fr, int fq) const {
#pragma unroll
        for (int ai = 0; ai < 2; ++ai)
#pragma unroll
            for (int m = 0; m < 4; ++m) { const size_t row = (size_t)u.pm * 256 + ai * 128 + wr * 64 + m * 16 + fr;
                const f32x4 s4 = *(const f32x4*)(SSQ + row * 8 + 4); const float rs = rsqrtf(((s4[0] + s4[1]) + (s4[2] + s4[3])) * (1.f / 256.f) + EPS);
#pragma unroll
                for (int bj = 0; bj < 2; ++bj) { const int c = u.pn * 256 + bj * 128 + wc * 32 + 8 * fq; const int h = c >> 7, e = c & 127;
                    const v4u w = pack8(acc[ai][bj][m][0] * rs, acc[ai][bj][m][1] * rs);
                    if (e < 64) *(v4u*)(KF + row * 1536 + h * 96 + e) = w; else *(v4u*)(V3 + row * 1024 + h * 64 + (e - 64)) = w; }
                asm volatile("" ::: "memory"); }
    }
};

struct TblEnt { int tok; float w0, w1; int pad; };
__device__ __forceinline__ int cls_expert(int cls, int which) { const int g = cls / 6, p = cls - g * 6; const int lo = p < 3 ? 0 : (p < 5 ? 1 : 2), hi = p < 3 ? p + 1 : (p < 5 ? p - 1 : 3); return g * 4 + (which ? hi : lo); }
template <int MODE> struct MoeOrder {
    static constexpr bool GATHER = (MODE == 0);
    const LAS int* tb;
    const LAS TblEnt* tbl;
    const bf16* W; int G, c;
    __device__ __forceinline__ bool next(int i, Unit& u) const {
        const int L = i * G + c, tile = L >> 2; if (tile >= tb[24]) return false;
        int cls = 0;
#pragma unroll
        for (int k = 1; k < 24; ++k) cls += (tile >= tb[k]) ? 1 : 0;
        u.pm = tile; u.pn = L & 3; u.aux = cls | (i << 8); return true;
    }
    __device__ __forceinline__ int a_row(const Unit& u, int r) const {
        if (MODE == 1) return u.pm * 256 + r;
        const int t = tbl[(u.aux >> 8) * 256 + r].tok; return t < 0 ? 0 : t;
    }
    __device__ __forceinline__ const char* b_seg(const Unit& u, int seg) const {
        const int cls = u.aux & 255;
        if (MODE == 0) return (const char*)(W + ((size_t)cls_expert(cls, u.pn >> 1) * 512 + (u.pn & 1) * 256) * 1024);
        return (const char*)(W + ((size_t)cls_expert(cls, seg) * 1024 + u.pn * 256) * 256);
    }
};
template <int MODE> __device__ __forceinline__ void moe_setup(Frame& F, int layer, MoeOrder<MODE>& S) {
    LAS int* tb = (LAS int*)(F.lds + LDS_TB); LAS int* cn = tb + 32; LAS TblEnt* tbl = (LAS TblEnt*)(F.lds + LDS_TBL);
    if (F.tid == 0) { int t = 0; for (int k = 0; k < 24; ++k) { const int n = (int)__hip_atomic_load(F.ctl + CW_MOECNT + layer * 64 + k, RLX_AGENT); cn[k] = n; tb[k] = t; t += (n + 255) >> 8; } tb[24] = t; }
    __syncthreads();
    S.tb = tb; S.tbl = tbl;
    const int* SL = (const int*)(F.ws + MOE_SL); const float* WT = (const float*)(F.ws + MOE_WT);
    for (int i = 0; i < 4; ++i) { Unit u; if (!S.next(i, u)) break;
        if (F.tid < 256) { const int cls = u.aux & 255, idx = (u.pm - tb[cls]) * 256 + F.tid; TblEnt e; e.pad = 0;
            if (idx < cn[cls]) { e.tok = SL[(size_t)cls * M + idx]; e.w0 = WT[2 * (size_t)e.tok]; e.w1 = WT[2 * (size_t)e.tok + 1]; } else { e.tok = -1; e.w0 = 0.f; e.w1 = 0.f; }
            LAS TblEnt* te = tbl + i * 256 + F.tid; te->tok = e.tok; te->w0 = e.w0; te->w1 = e.w1; te->pad = 0; } }
    __syncthreads();
}
struct EpiMoeAct {
    static constexpr bool PERM = true;
    bf16* ACT; const LAS TblEnt* tbl;
    __device__ __forceinline__ void operator()(const AccT& acc, const Unit& u, int ui, int wr, int wc, int fr, int fq) const {
        const int slot = u.pn >> 1, colb = slot * 256 + (u.pn & 1) * 128 + wc * 32 + 8 * fq;
#pragma unroll
        for (int ai = 0; ai < 2; ++ai)
#pragma unroll
            for (int m = 0; m < 4; ++m) { const int rl = ai * 128 + wr * 64 + m * 16 + fr; const LAS TblEnt* te = tbl + (u.aux >> 8) * 256 + rl; const float w = slot ? te->w1 : te->w0;
                f32x4 a, b;
#pragma unroll
                for (int j = 0; j < 4; ++j) { a[j] = silu_f(acc[ai][0][m][0][j]) * acc[ai][1][m][0][j] * w; b[j] = silu_f(acc[ai][0][m][1][j]) * acc[ai][1][m][1][j] * w; }
                *(v4u*)(ACT + ((size_t)u.pm * 256 + rl) * 512 + colb) = pack8(a, b);
                asm volatile("" ::: "memory"); }
    }
};
struct EpiMoeDown {
    static constexpr bool PERM = false;
    float* X; const float* gate; const LAS TblEnt* tbl;
    __device__ __forceinline__ void operator()(const AccT& acc, const Unit& u, int ui, int wr, int wc, int fr, int fq) const {
        const int col0 = u.pn * 256 + wc * 32 + 4 * fq;
#pragma unroll
        for (int ai = 0; ai < 2; ++ai)
#pragma unroll
            for (int m = 0; m < 4; ++m) { const int rl = ai * 128 + wr * 64 + m * 16 + fr; const int tok = tbl[(u.aux >> 8) * 256 + rl].tok;
                if (tok >= 0) { float* rowp = X + (size_t)tok * D + col0; const float* gv = gate + (size_t)modrow_of(tok) * 6144 + col0;
#pragma unroll
                    for (int bj = 0; bj < 2; ++bj)
#pragma unroll
                        for (int n = 0; n < 2; ++n) { f32x4* p = (f32x4*)(rowp + bj * 128 + n * 16); *p = *p + *(const f32x4*)(gv + bj * 128 + n * 16) * acc[ai][bj][m][n]; } }
                asm volatile("" ::: "memory"); }
    }
};
template <int DQK, bool WIN>
__device__ __forceinline__ void flash_unit(LAS unsigned char* lds, const int tid, const int lane, const int grpB,
        const bf16* Kg, const int ldk, const bf16* Vg, const int ldv,
        const bf16* Qg, const int ldq, bf16* Og, const int ldo,
        const int ntiles, const int krow_ctx0, const int krow_lat0, const int kpos0, const int qpos_wave, const float sink2, const bool has_sink) {
    constexpr int KSTR = DQK * 2 + 16, VSTR = 160, KBUF = 64 * KSTR, VBUF = 64 * VSTR, CPR = DQK / 8, NKC = 64 * CPR, NKR = (NKC + 511) / 512, NKS = DQK / 32;
    LAS unsigned char* Kl = lds; LAS unsigned char* Vl = lds + 2 * KBUF;
    const int fr = lane & 15, fq = lane >> 4;
    bf16x8 qf[2][NKS];
#pragma unroll
    for (int qt = 0; qt < 2; ++qt)
#pragma unroll
        for (int ks = 0; ks < NKS; ++ks) qf[qt][ks] = *(const bf16x8*)(Qg + (size_t)(16 * qt + fr) * ldq + 32 * ks + 8 * fq);
    f32x4 oacc[4][2];
#pragma unroll
    for (int c = 0; c < 4; ++c) { oacc[c][0] = (f32x4){0.f, 0.f, 0.f, 0.f}; oacc[c][1] = (f32x4){0.f, 0.f, 0.f, 0.f}; }
    float mrun[2] = {-1.0e30f, -1.0e30f}, lsum[2] = {0.f, 0.f};
    v4u kreg[NKR], vreg;
    bf16x8 pf[2][2]; bool pvalid = false; int pvb = 0;
#pragma unroll
    for (int a = 0; a < 2; ++a)
#pragma unroll
        for (int b2 = 0; b2 < 2; ++b2)
#pragma unroll
            for (int e = 0; e < 8; ++e) pf[a][b2][e] = 0;
#define FA_LOAD(j) do { const int _rb = (j) < 4 ? krow_ctx0 + 64 * (j) : krow_lat0 + 64 * ((j) - 4); \
        _Pragma("unroll") for (int _i = 0; _i < NKR; ++_i) { const int _c = tid + 512 * _i; if (_c < NKC) kreg[_i] = *(const v4u*)(Kg + (size_t)(_rb + _c / CPR) * ldk + (_c % CPR) * 8); } \
        vreg = *(const v4u*)(Vg + (size_t)(_rb + (tid >> 3)) * ldv + (tid & 7) * 8); } while (0)
#define FA_STORE(kb, vb) do { _Pragma("unroll") for (int _i = 0; _i < NKR; ++_i) { const int _c = tid + 512 * _i; if (_c < NKC) *(LAS v4u*)(Kl + (kb) * KBUF + (_c / CPR) * KSTR + (_c % CPR) * 16) = kreg[_i]; } \
        *(LAS v4u*)(Vl + (vb) * VBUF + (tid >> 3) * VSTR + (tid & 7) * 16) = vreg; } while (0)
#define FA_PV(vbuf) do { _Pragma("unroll") for (int ks2 = 0; ks2 < 2; ++ks2) _Pragma("unroll") for (int c = 0; c < 4; ++c) { \
            const LAS unsigned char* vb_ = Vl + (vbuf) * VBUF + (32 * ks2 + 4 * fq + ((lane & 15) >> 2)) * VSTR + (16 * c + 4 * (lane & 3)) * 2; \
            const s16x4 v0 = __builtin_amdgcn_ds_read_tr16_b64_v4i16((LAS s16x4*)vb_); const s16x4 v1 = __builtin_amdgcn_ds_read_tr16_b64_v4i16((LAS s16x4*)(vb_ + 16 * VSTR)); \
            bf16x8 vf; vf[0] = v0[0]; vf[1] = v0[1]; vf[2] = v0[2]; vf[3] = v0[3]; vf[4] = v1[0]; vf[5] = v1[1]; vf[6] = v1[2]; vf[7] = v1[3]; \
            oacc[c][0] = __builtin_amdgcn_mfma_f32_16x16x32_bf16(vf, pf[0][ks2], oacc[c][0], 0, 0, 0); \
            oacc[c][1] = __builtin_amdgcn_mfma_f32_16x16x32_bf16(vf, pf[1][ks2], oacc[c][1], 0, 0, 0); } } while (0)
    FA_LOAD(0); FA_STORE(0, 0); __syncthreads();
    int vcur = 0;
    for (int j = 0; j < ntiles; ++j) {
        const int kb = j & 1;
        if (j + 1 < ntiles) FA_LOAD(j + 1);
        if (grpB && pvalid) FA_PV(pvb);
        bool skip = false; const int kp = kpos0 + 64 * (j - 4);
        if (WIN && j >= 4) skip = (kp + 63 < qpos_wave - 128) || (kp > qpos_wave + 31 + 128);
        pvalid = !skip; pvb = vcur;
        if (!skip) {
            f32x4 sacc[4][2];
#pragma unroll
            for (int kt = 0; kt < 4; ++kt) { sacc[kt][0] = (f32x4){0.f, 0.f, 0.f, 0.f}; sacc[kt][1] = (f32x4){0.f, 0.f, 0.f, 0.f}; }
#pragma unroll
            for (int ks = 0; ks < NKS; ++ks) { bf16x8 kf[4];
#pragma unroll
                for (int kt = 0; kt < 4; ++kt) kf[kt] = *(const LAS bf16x8*)(Kl + kb * KBUF + (16 * kt + fr) * KSTR + (32 * ks + 8 * fq) * 2);
#pragma unroll
                for (int kt = 0; kt < 4; ++kt) { sacc[kt][0] = __builtin_amdgcn_mfma_f32_16x16x32_bf16(kf[kt], qf[0][ks], sacc[kt][0], 0, 0, 0);
                                                 sacc[kt][1] = __builtin_amdgcn_mfma_f32_16x16x32_bf16(kf[kt], qf[1][ks], sacc[kt][1], 0, 0, 0); } }
            if (WIN && j >= 4) {
#pragma unroll
                for (int kt = 0; kt < 4; ++kt)
#pragma unroll
                    for (int qt = 0; qt < 2; ++qt)
#pragma unroll
                        for (int jj = 0; jj < 4; ++jj) { const int d = (kp + 16 * kt + 4 * fq + jj) - (qpos_wave + 16 * qt + fr); if (d < -128 || d > 128) sacc[kt][qt][jj] = -1.0e30f; } }
#pragma unroll
            for (int qt = 0; qt < 2; ++qt) {
                float mx = sacc[0][qt][0];
#pragma unroll
                for (int kt = 0; kt < 4; ++kt)
#pragma unroll
                    for (int jj = 0; jj < 4; ++jj) mx = fmaxf(mx, sacc[kt][qt][jj]);
                mx = fmaxf(mx, __shfl_xor(mx, 16)); mx = fmaxf(mx, __shfl_xor(mx, 32));
                const float mnew = fmaxf(mrun[qt], mx);
                if (__builtin_amdgcn_ballot_w64(mnew != mrun[qt]) != 0ull) {
                    const float alpha = fast_exp2(mrun[qt] - mnew); lsum[qt] *= alpha;
#pragma unroll
                    for (int c = 0; c < 4; ++c) oacc[c][qt] = oacc[c][qt] * alpha; }
                mrun[qt] = mnew;
                float ps = 0.f;
#pragma unroll
                for (int kt = 0; kt < 4; ++kt)
#pragma unroll
                    for (int jj = 0; jj < 4; ++jj) { const float p = fast_exp2(sacc[kt][qt][jj] - mnew); sacc[kt][qt][jj] = p; ps += p; }
                lsum[qt] += ps;
#pragma unroll
                for (int ks2 = 0; ks2 < 2; ++ks2) { const v4u w = pack8(sacc[2 * ks2][qt], sacc[2 * ks2 + 1][qt]); pf[qt][ks2] = __builtin_bit_cast(bf16x8, w); }
            }
            if (!grpB) FA_PV(vcur);
        }
        const int vnext = vcur == 2 ? 0 : vcur + 1;
        if (j + 1 < ntiles) FA_STORE(kb ^ 1, vnext);
        vcur = vnext;
        __syncthreads();
    }
    if (grpB && pvalid) FA_PV(pvb);
    __syncthreads();
#pragma unroll
    for (int qt = 0; qt < 2; ++qt) { float l = lsum[qt]; l += __shfl_xor(l, 16); l += __shfl_xor(l, 32); if (has_sink) l += fast_exp2(sink2 - mrun[qt]);
        const float inv = 1.0f / l;
#pragma unroll
        for (int c = 0; c < 4; ++c) { const f32x4 o = oacc[c][qt] * inv; v2u w; w.x = cvt_pk_bf16(o[0], o[1]); w.y = cvt_pk_bf16(o[2], o[3]);
            *(v2u*)(Og + (size_t)(16 * qt + fr) * ldo + 16 * c + 4 * fq) = w; } }
#undef FA_LOAD
#undef FA_STORE
#undef FA_PV
}

__device__ __forceinline__ void phase_attn_window(Frame& F, const float* const* in, bf16* Q, const bf16* Kb, const bf16* Vb, bf16* Oalt = nullptr) {
    constexpr int NLAT = NB * 4 * 64, NCTX = NB * 4 * 4;
    for (int un = F.vcu; un < NLAT + NCTX; un += GRID) {
        int b, kvh, q0, ntiles, kpos0, qrow0;
        if (un < NLAT) { b = un >> 8; kvh = (un >> 6) & 3; q0 = (un & 63) * 64; kpos0 = q0 >= 128 ? q0 - 128 : 0; const int kend = q0 + 192 <= SEQ ? q0 + 192 : SEQ; ntiles = 4 + (kend - kpos0) / 64; qrow0 = b * TPB + CTX + q0; }
        else { const int v = un - NLAT; b = v >> 4; kvh = (v >> 2) & 3; q0 = (v & 3) * 64; kpos0 = 0; ntiles = 4; qrow0 = b * TPB + q0; }
        const int g = F.wave >> 1, half = F.wave & 1, head = kvh * 4 + g;
        bf16* qp = Q + (size_t)(qrow0 + 32 * half) * 1024 + head * 64;
        bf16* op = Oalt ? Oalt + (size_t)(qrow0 + 32 * half) * 1024 + head * 64 : qp;
        flash_unit<64, true>(F.lds, F.tid, F.lane, F.wave >> 2, Kb + kvh * 64, 256, Vb + kvh * 64, 256, qp, 1024, op, 1024,
                             ntiles, b * TPB, b * TPB + CTX + kpos0, kpos0, q0 + 32 * half, in[16][head] * LOG2E, true);
    }
}
__device__ __forceinline__ void phase_attn_mla(Frame& F, const bf16* Q3, const bf16* KF, const bf16* V3, bf16* O) {
    for (int un = F.vcu; un < NB * 16 * 16; un += GRID) { const int b = un >> 8, head = (un >> 4) & 15, qb = un & 15; const int qrow = b * TPB + CTX + qb * 256 + 32 * F.wave;
        flash_unit<96, false>(F.lds, F.tid, F.lane, F.wave >> 2, KF + head * 96, 1536, V3 + head * 64, 1024, Q3 + (size_t)qrow * 1536 + head * 96, 1536, O + (size_t)qrow * 1024 + head * 64, 1024,
                              68, b * TPB, b * TPB + CTX, 0, 0, 0.f, false);
    }
}
__device__ __forceinline__ int scan_row(int dir, int tau) { return dir == 0 ? tau : (tau < CTX ? CTX - 1 - tau : (TPB + CTX - 1) - tau); }

__device__ __forceinline__ void phase_ssm_conv(Frame& F, const float* const* in, int gp, const bf16* XP, bf16* XS, bf16* BC, const float* DT, float* ACUM) {
    constexpr int RPW = M / GRID;
    if (F.tid < 384) {
    const int cg = F.tid % 192, rsub = F.tid / 192, c0 = cg * 8;
    const int oc = c0 < 1024 ? gp * 1024 + c0 : (c0 < 1280 ? 2048 + gp * 256 + (c0 - 1024) : 2560 + gp * 256 + (c0 - 1280));
    float w[5][8], bb[8];
#pragma unroll
    for (int k = 0; k < 5; ++k)
#pragma unroll
        for (int i = 0; i < 8; ++i) w[k][i] = in[19][k * 3072 + oc + i];
#pragma unroll
    for (int i = 0; i < 8; ++i) bb[i] = in[20][oc + i];
    const int rbeg = blockIdx.x * RPW + rsub * (RPW / 2), rend = rbeg + RPW / 2;
    for (int g0 = rbeg; g0 < rend; g0 += 8) {
        v4u xin[12];
#pragma unroll
        for (int j = 0; j < 12; ++j) { const int rr = g0 - 2 + j; xin[j] = (rr >= 0 && rr < M) ? *(const v4u*)(XP + (size_t)rr * 1536 + c0) : (v4u){0u, 0u, 0u, 0u}; }
#pragma unroll
        for (int i = 0; i < 8; ++i) { const int r = g0 + i; if (r < rend) { const int t = r % TPB; const int lo = t < CTX ? 0 : CTX, hi = t < CTX ? CTX : TPB;
            float a[8];
#pragma unroll
            for (int q = 0; q < 8; ++q) a[q] = bb[q];
#pragma unroll
            for (int k = 0; k < 5; ++k) { const int tt = t + k - 2; if (tt >= lo && tt < hi) { const v4u x = xin[i + k];
                    a[0] += w[k][0] * bflo(x.x); a[1] += w[k][1] * bfhi(x.x); a[2] += w[k][2] * bflo(x.y); a[3] += w[k][3] * bfhi(x.y);
                    a[4] += w[k][4] * bflo(x.z); a[5] += w[k][5] * bfhi(x.z); a[6] += w[k][6] * bflo(x.w); a[7] += w[k][7] * bfhi(x.w); } }
            v4u o; o.x = cvt_pk_bf16(silu_f(a[0]), silu_f(a[1])); o.y = cvt_pk_bf16(silu_f(a[2]), silu_f(a[3])); o.z = cvt_pk_bf16(silu_f(a[4]), silu_f(a[5])); o.w = cvt_pk_bf16(silu_f(a[6]), silu_f(a[7]));
            if (c0 < 1024) *(v4u*)(XS + (size_t)r * 1024 + c0) = o; else *(v4u*)(BC + (size_t)r * 512 + (c0 - 1024)) = o; } } }
    } else {
        const int chain = blockIdx.x * 128 + (F.tid - 384);
        if (chain < NB * 2 * 16 * 68) { const int ck = chain % 68, hl = (chain / 68) & 15, dir = (chain / (68 * 16)) & 1, b = chain / (68 * 32);
            const float Ah = -fast_exp(in[22][dir * 32 + gp * 16 + hl]) * LOG2E; float acc = 0.f;
#pragma unroll 1
            for (int h2 = 0; h2 < 2; ++h2) { float dv[32];
#pragma unroll
                for (int s = 0; s < 32; ++s) dv[s] = DT[(size_t)(b * TPB + scan_row(dir, ck * 64 + h2 * 32 + s)) * 32 + dir * 16 + hl];
#pragma unroll
                for (int s = 0; s < 32; ++s) { acc += dv[s] * Ah; ACUM[(size_t)(b * TPB + scan_row(dir, ck * 64 + h2 * 32 + s)) * 32 + dir * 16 + hl] = acc; } } }
    }
}

__device__ __forceinline__ void phase_ssm_scan(Frame& F, const float* const* in, int gp, const bf16* XS, const bf16* BC, const float* DT, const bf16* Z, bf16* Y) {
    constexpr int T = 32;
    LAS float* Bf = (LAS float*)F.lds;
    LAS float* Cf = (LAS float*)(F.lds + 16384);
    LAS float* U = (LAS float*)(F.lds + 32768);
    LAS float* XT = (LAS float*)(F.lds + 40960);
    LAS float* DEC = (LAS float*)(F.lds + 49152);
    LAS float* PART = (LAS float*)(F.lds + 49152 + 256);
    const int it = blockIdx.x, b = it >> 5, hl = (it >> 1) & 15, ph = it & 1, head = gp * 16 + hl, gl = hl >> 3;
    const int col = hl * 64 + ph * 32;
    const int p = F.tid & 31, ns = F.tid >> 5;
    const float dskip = in[23][head] + in[23][32 + head];
    const int st = F.tid >> 4, sch = F.tid & 15;
    const int xt = F.tid >> 2, xch = F.tid & 3;
    for (int dir = 0; dir < 2; ++dir) {
        const float Ah = -fast_exp(in[22][dir * 32 + head]) * LOG2E;
        float S[8];
#pragma unroll
        for (int i = 0; i < 8; ++i) S[i] = 0.f;
        v4u rb, rc, rx; float rdt = 0.f;
#define SS_LOAD(tile) do { const int _rB = b * TPB + scan_row(dir, (tile) * T + st); rb = *(const v4u*)(BC + (size_t)_rB * 512 + gl * 128 + sch * 8); rc = *(const v4u*)(BC + (size_t)_rB * 512 + 256 + gl * 128 + sch * 8); \
            if (F.tid < 128) { const int _rX = b * TPB + scan_row(dir, (tile) * T + xt); rx = *(const v4u*)(XS + (size_t)_rX * 1024 + col + xch * 8); rdt = DT[(size_t)_rX * 32 + dir * 16 + hl]; } } while (0)
#define SS_STORE(nb) do { LAS float* _b = Bf + st * 128 + sch * 8; LAS float* _c = Cf + st * 128 + sch * 8; \
            *(LAS f32x4*)_b = (f32x4){bflo(rb.x), bfhi(rb.x), bflo(rb.y), bfhi(rb.y)}; *(LAS f32x4*)(_b + 4) = (f32x4){bflo(rb.z), bfhi(rb.z), bflo(rb.w), bfhi(rb.w)}; \
            *(LAS f32x4*)_c = (f32x4){bflo(rc.x), bfhi(rc.x), bflo(rc.y), bfhi(rc.y)}; *(LAS f32x4*)(_c + 4) = (f32x4){bflo(rc.z), bfhi(rc.z), bflo(rc.w), bfhi(rc.w)}; \
            if (F.tid < 128) { const f32x4 x0 = (f32x4){bflo(rx.x), bfhi(rx.x), bflo(rx.y), bfhi(rx.y)}, x1 = (f32x4){bflo(rx.z), bfhi(rx.z), bflo(rx.w), bfhi(rx.w)}; \
                LAS float* _x = XT + (nb) * 1024 + xt * 32 + xch * 8; LAS float* _u = U + (nb) * 1024 + xt * 32 + xch * 8; \
                *(LAS f32x4*)_x = x0; *(LAS f32x4*)(_x + 4) = x1; *(LAS f32x4*)_u = x0 * rdt; *(LAS f32x4*)(_u + 4) = x1 * rdt; \
                if (xch == 0) DEC[(nb) * 32 + xt] = fast_exp2(rdt * Ah); } } while (0)
        __syncthreads();
        SS_LOAD(0); SS_STORE(0); __syncthreads();
        constexpr int NT = TPB / T;
        for (int tile = 0; tile < NT; ++tile) { const int cb = tile & 1;
            if (tile + 1 < NT) SS_LOAD(tile + 1);
            const LAS float* u_ = U + cb * 1024 + p; const LAS float* d_ = DEC + cb * 32;
#pragma unroll 4
            for (int t = 0; t < T; ++t) {
                const float dec = d_[t], u = u_[t * 32];
                const f32x4 b0 = *(const LAS f32x4*)(Bf + t * 128 + ns * 8), b1 = *(const LAS f32x4*)(Bf + t * 128 + ns * 8 + 4);
                const f32x4 c0 = *(const LAS f32x4*)(Cf + t * 128 + ns * 8), c1 = *(const LAS f32x4*)(Cf + t * 128 + ns * 8 + 4);
                float pt = 0.f;
#pragma unroll
                for (int i = 0; i < 4; ++i) { S[i] = S[i] * dec + b0[i] * u; pt += c0[i] * S[i]; S[4 + i] = S[4 + i] * dec + b1[i] * u; pt += c1[i] * S[4 + i]; }
                pt += __shfl_xor(pt, 32);
                if (F.lane < 32) PART[(F.wave * 32 + t) * 32 + p] = pt;
            }
            __syncthreads();
#pragma unroll
            for (int k = 0; k < 2; ++k) { const int t = (F.tid >> 5) + 16 * k; float y = 0.f;
#pragma unroll
                for (int w = 0; w < 8; ++w) y += PART[(w * 32 + t) * 32 + p];
                const size_t ro = (size_t)(b * TPB + scan_row(dir, tile * T + t));
                if (dir == 0) Y[ro * 1024 + col + p] = (bf16)f2bf(y);
                else { const float yt = y + bf2f(Y[ro * 1024 + col + p]) + dskip * XT[cb * 1024 + t * 32 + p]; const float zz = bf2f(Z[ro * 1024 + col + p]);
                    Y[ro * 1024 + col + p] = (bf16)f2bf(yt * silu_f(zz)); } }
            if (tile + 1 < NT) SS_STORE(cb ^ 1);
            __syncthreads();
        }
#undef SS_LOAD
#undef SS_STORE
    }
}
__device__ __forceinline__ void phase_ssm_gnorm(Frame& F, const float* const* in, int gp, bf16* Y) {
    const int gw = F.vcu * NWAVES + F.wave, NGW = GRID * NWAVES; const float* ng = in[24] + gp * 1024 + 16 * F.lane;
    for (int r = gw; r < M; r += NGW) { v4u* p = (v4u*)(Y + (size_t)r * 1024 + 16 * F.lane); const v4u a = p[0], c = p[1];
        float v[16] = {bflo(a.x), bfhi(a.x), bflo(a.y), bfhi(a.y), bflo(a.z), bfhi(a.z), bflo(a.w), bfhi(a.w), bflo(c.x), bfhi(c.x), bflo(c.y), bfhi(c.y), bflo(c.z), bfhi(c.z), bflo(c.w), bfhi(c.w)};
        float ss = 0.f;
#pragma unroll
        for (int i = 0; i < 16; ++i) ss += v[i] * v[i];
#pragma unroll
        for (int o = 1; o < 32; o <<= 1) ss += __shfl_xor(ss, o);
        const float rs = rsqrtf(ss * (1.f / 512.f) + EPS);
        v4u o0, o1;
        o0.x = cvt_pk_bf16(v[0] * rs * ng[0], v[1] * rs * ng[1]); o0.y = cvt_pk_bf16(v[2] * rs * ng[2], v[3] * rs * ng[3]); o0.z = cvt_pk_bf16(v[4] * rs * ng[4], v[5] * rs * ng[5]); o0.w = cvt_pk_bf16(v[6] * rs * ng[6], v[7] * rs * ng[7]);
        o1.x = cvt_pk_bf16(v[8] * rs * ng[8], v[9] * rs * ng[9]); o1.y = cvt_pk_bf16(v[10] * rs * ng[10], v[11] * rs * ng[11]); o1.z = cvt_pk_bf16(v[12] * rs * ng[12], v[13] * rs * ng[13]); o1.w = cvt_pk_bf16(v[14] * rs * ng[14], v[15] * rs * ng[15]);
        p[0] = o0; p[1] = o1; }
}


__device__ __forceinline__ void phase_ssm_scan_mfma(Frame& F, const float* const* in, int gp, const bf16* XS, const bf16* BC, const float* DT, const float* ACUM, bf16* Yf, bf16* Yb) {
    constexpr int BSTR = 272, XSTR = 160;
    LAS unsigned char* Bl = F.lds;
    LAS unsigned char* Cl = F.lds + 17408;
    LAS unsigned char* Xl = F.lds + 34816;
    LAS unsigned char* Xw = F.lds + 45056;
    LAS float* AC = (LAS float*)(F.lds + 55296);
    LAS float* DTs = (LAS float*)(F.lds + 55296 + 256);
    LAS unsigned char* Sb = F.lds + 55808;
    const int it = blockIdx.x, b = it >> 5, dir = (it >> 4) & 1, hl = it & 15, gl = hl >> 3;
    bf16* Y = dir == 0 ? Yf : Yb;
    const int tid = F.tid, lane = F.lane, w = F.wave, fr = lane & 15, fq = lane >> 4, lq = (lane & 15) >> 2, lp = lane & 3;
    const int lt = w & 3, ph = w >> 2;
    for (int i = tid; i < 64 * BSTR / 16; i += NTHR) *(LAS v4u*)(Sb + i * 16) = (v4u){0u, 0u, 0u, 0u};
    f32x4 sacc[4];
#pragma unroll
    for (int i = 0; i < 4; ++i) sacc[i] = (f32x4){0.f, 0.f, 0.f, 0.f};
    v4u rB[2], rC[2], rX; float rac = 0.f, rdt = 0.f, rxs = 0.f;
    const int xr = tid >> 3, xc = tid & 7;
#define SM_LOAD(ck) do { _Pragma("unroll") for (int _i = 0; _i < 2; ++_i) { const int _c = tid + 512 * _i; const size_t _r = (size_t)(b * TPB + scan_row(dir, (ck) * 64 + (_c >> 4))); \
            rB[_i] = *(const v4u*)(BC + _r * 512 + gl * 128 + (_c & 15) * 8); rC[_i] = *(const v4u*)(BC + _r * 512 + 256 + gl * 128 + (_c & 15) * 8); } \
        { const size_t _r = (size_t)(b * TPB + scan_row(dir, (ck) * 64 + xr)); const size_t _rl = (size_t)(b * TPB + scan_row(dir, (ck) * 64 + 63)); rX = *(const v4u*)(XS + _r * 1024 + hl * 64 + xc * 8); \
          const float _a = ACUM[_r * 32 + dir * 16 + hl], _al = ACUM[_rl * 32 + dir * 16 + hl], _d = DT[_r * 32 + dir * 16 + hl]; rac = _a; rdt = _d; rxs = _d * fast_exp2(_al - _a); } } while (0)
#define SM_STORE() do { _Pragma("unroll") for (int _i = 0; _i < 2; ++_i) { const int _c = tid + 512 * _i; *(LAS v4u*)(Bl + (_c >> 4) * BSTR + (_c & 15) * 16) = rB[_i]; *(LAS v4u*)(Cl + (_c >> 4) * BSTR + (_c & 15) * 16) = rC[_i]; } \
        *(LAS v4u*)(Xl + xr * XSTR + xc * 16) = rX; \
        { v4u _o; _o.x = cvt_pk_bf16(bflo(rX.x) * rxs, bfhi(rX.x) * rxs); _o.y = cvt_pk_bf16(bflo(rX.y) * rxs, bfhi(rX.y) * rxs); _o.z = cvt_pk_bf16(bflo(rX.z) * rxs, bfhi(rX.z) * rxs); _o.w = cvt_pk_bf16(bflo(rX.w) * rxs, bfhi(rX.w) * rxs); \
          *(LAS v4u*)(Xw + xr * XSTR + xc * 16) = _o; } \
        if (xc == 0) { AC[xr] = rac; DTs[xr] = rdt; } } while (0)
    SM_LOAD(0); SM_STORE(); __syncthreads();
    for (int ck = 0; ck < 68; ++ck) { const int cur = ck & 1;
        if (ck + 1 < 68) SM_LOAD(ck + 1);
        const LAS unsigned char* Sc = Sb + cur * (64 * BSTR); LAS unsigned char* Sn = Sb + (cur ^ 1) * (64 * BSTR);
        bf16x8 cf[4];
#pragma unroll
        for (int ks = 0; ks < 4; ++ks) cf[ks] = *(const LAS bf16x8*)(Cl + (16 * lt + fr) * BSTR + (32 * ks + 8 * fq) * 2);
        const float acl = AC[16 * lt + fr];
        f32x4 yacc[2];
#pragma unroll
        for (int pi = 0; pi < 2; ++pi) { f32x4 a = (f32x4){0.f, 0.f, 0.f, 0.f};
#pragma unroll
            for (int ks = 0; ks < 4; ++ks) { const bf16x8 sf = *(const LAS bf16x8*)(Sc + (16 * (2 * ph + pi) + fr) * BSTR + (32 * ks + 8 * fq) * 2); a = __builtin_amdgcn_mfma_f32_16x16x32_bf16(sf, cf[ks], a, 0, 0, 0); }
            yacc[pi] = a * fast_exp2(acl); }
        f32x4 pm[4];
#pragma unroll
        for (int st = 0; st < 4; ++st) { pm[st] = (f32x4){0.f, 0.f, 0.f, 0.f};
            if (st <= lt) { f32x4 g = (f32x4){0.f, 0.f, 0.f, 0.f};
#pragma unroll
                for (int ks = 0; ks < 4; ++ks) { const bf16x8 bfr = *(const LAS bf16x8*)(Bl + (16 * st + fr) * BSTR + (32 * ks + 8 * fq) * 2); g = __builtin_amdgcn_mfma_f32_16x16x32_bf16(bfr, cf[ks], g, 0, 0, 0); }
                const f32x4 acs = *(const LAS f32x4*)(AC + 16 * st + 4 * fq), dts = *(const LAS f32x4*)(DTs + 16 * st + 4 * fq);
#pragma unroll
                for (int j = 0; j < 4; ++j) { const bool ok = (16 * st + 4 * fq + j) <= (16 * lt + fr); pm[st][j] = ok ? g[j] * fast_exp2(acl - acs[j]) * dts[j] : 0.f; } } }
#pragma unroll
        for (int ks2 = 0; ks2 < 2; ++ks2) { if (2 * ks2 <= lt) { const v4u pw = pack8(pm[2 * ks2], pm[2 * ks2 + 1]); const bf16x8 pf = __builtin_bit_cast(bf16x8, pw);
#pragma unroll
                for (int pi = 0; pi < 2; ++pi) { const LAS unsigned char* xb = Xl + (32 * ks2 + 4 * fq + lq) * XSTR + (16 * (2 * ph + pi) + 4 * lp) * 2;
                    const s16x4 v0 = __builtin_amdgcn_ds_read_tr16_b64_v4i16((LAS s16x4*)xb), v1 = __builtin_amdgcn_ds_read_tr16_b64_v4i16((LAS s16x4*)(xb + 16 * XSTR));
                    bf16x8 xf; xf[0] = v0[0]; xf[1] = v0[1]; xf[2] = v0[2]; xf[3] = v0[3]; xf[4] = v1[0]; xf[5] = v1[1]; xf[6] = v1[2]; xf[7] = v1[3];
                    yacc[pi] = __builtin_amdgcn_mfma_f32_16x16x32_bf16(xf, pf, yacc[pi], 0, 0, 0); } } }
        { const size_t ro = (size_t)(b * TPB + scan_row(dir, ck * 64 + 16 * lt + fr));
#pragma unroll
          for (int pi = 0; pi < 2; ++pi) { v2u o; o.x = cvt_pk_bf16(yacc[pi][0], yacc[pi][1]); o.y = cvt_pk_bf16(yacc[pi][2], yacc[pi][3]);
              *(v2u*)(Y + ro * 1024 + hl * 64 + 16 * (2 * ph + pi) + 4 * fq) = o; } }
        { const float gdec = fast_exp2(AC[63]);
          bf16x8 xwf[2];
#pragma unroll
          for (int ks2 = 0; ks2 < 2; ++ks2) { const LAS unsigned char* xb = Xw + (32 * ks2 + 8 * fq + lq) * XSTR + (16 * lt + 4 * lp) * 2;
              const s16x4 v0 = __builtin_amdgcn_ds_read_tr16_b64_v4i16((LAS s16x4*)xb), v1 = __builtin_amdgcn_ds_read_tr16_b64_v4i16((LAS s16x4*)(xb + 4 * XSTR));
              xwf[ks2][0] = v0[0]; xwf[ks2][1] = v0[1]; xwf[ks2][2] = v0[2]; xwf[ks2][3] = v0[3]; xwf[ks2][4] = v1[0]; xwf[ks2][5] = v1[1]; xwf[ks2][6] = v1[2]; xwf[ks2][7] = v1[3]; }
#pragma unroll
          for (int i = 0; i < 4; ++i) { const int nt = 4 * ph + i; f32x4 a = sacc[i] * gdec;
#pragma unroll
              for (int ks2 = 0; ks2 < 2; ++ks2) { const LAS unsigned char* bb = Bl + (32 * ks2 + 8 * fq + lq) * BSTR + (16 * nt + 4 * lp) * 2;
                  const s16x4 v0 = __builtin_amdgcn_ds_read_tr16_b64_v4i16((LAS s16x4*)bb), v1 = __builtin_amdgcn_ds_read_tr16_b64_v4i16((LAS s16x4*)(bb + 4 * BSTR));
                  bf16x8 bt; bt[0] = v0[0]; bt[1] = v0[1]; bt[2] = v0[2]; bt[3] = v0[3]; bt[4] = v1[0]; bt[5] = v1[1]; bt[6] = v1[2]; bt[7] = v1[3];
                  a = __builtin_amdgcn_mfma_f32_16x16x32_bf16(xwf[ks2], bt, a, 0, 0, 0); }
              sacc[i] = a;
#pragma unroll
              for (int j = 0; j < 4; ++j) *(LAS bf16*)(Sn + (16 * lt + 4 * fq + j) * BSTR + (16 * nt + fr) * 2) = (bf16)f2bf(a[j]); } }
        __syncthreads();
        if (ck + 1 < 68) SM_STORE();
        __syncthreads();
    }
#undef SM_LOAD
#undef SM_STORE
}
__device__ __forceinline__ void phase_ssm_gnorm2(Frame& F, const float* const* in, int gp, bf16* Yf, const bf16* Yb, const bf16* XS, const bf16* Z) {
    const int gw = F.vcu * NWAVES + F.wave, NGW = GRID * NWAVES; const float* ng = in[24] + gp * 1024 + 16 * F.lane;
    const int head = gp * 16 + (F.lane >> 2); const float dskip = in[23][head] + in[23][32 + head];
    for (int r = gw; r < M; r += NGW) { const size_t off = (size_t)r * 1024 + 16 * F.lane;
        const v4u a0 = *(const v4u*)(Yf + off), a1 = *(const v4u*)(Yf + off + 8), b0 = *(const v4u*)(Yb + off), b1 = *(const v4u*)(Yb + off + 8);
        const v4u x0 = *(const v4u*)(XS + off), x1 = *(const v4u*)(XS + off + 8), z0 = *(const v4u*)(Z + off), z1 = *(const v4u*)(Z + off + 8);
        const unsigned aw[8] = {a0.x, a0.y, a0.z, a0.w, a1.x, a1.y, a1.z, a1.w}, bw[8] = {b0.x, b0.y, b0.z, b0.w, b1.x, b1.y, b1.z, b1.w};
        const unsigned xw[8] = {x0.x, x0.y, x0.z, x0.w, x1.x, x1.y, x1.z, x1.w}, zw[8] = {z0.x, z0.y, z0.z, z0.w, z1.x, z1.y, z1.z, z1.w};
        float v[16]; float ss = 0.f;
#pragma unroll
        for (int i = 0; i < 8; ++i) { v[2 * i] = (bflo(aw[i]) + bflo(bw[i]) + dskip * bflo(xw[i])) * silu_f(bflo(zw[i])); v[2 * i + 1] = (bfhi(aw[i]) + bfhi(bw[i]) + dskip * bfhi(xw[i])) * silu_f(bfhi(zw[i]));
            ss += v[2 * i] * v[2 * i] + v[2 * i + 1] * v[2 * i + 1]; }
#pragma unroll
        for (int o = 1; o < 32; o <<= 1) ss += __shfl_xor(ss, o);
        const float rs = rsqrtf(ss * (1.f / 512.f) + EPS);
        unsigned res[8];
#pragma unroll
        for (int i = 0; i < 8; ++i) res[i] = cvt_pk_bf16(v[2 * i] * rs * ng[2 * i], v[2 * i + 1] * rs * ng[2 * i + 1]);
        *(v4u*)(Yf + off) = (v4u){res[0], res[1], res[2], res[3]}; *(v4u*)(Yf + off + 8) = (v4u){res[4], res[5], res[6], res[7]}; }
}

__device__ __forceinline__ void phase_mlstm_scan(Frame& F, const bf16* Qm, const bf16* Km, const bf16* Vm, const float* G, bf16* Hf, bf16* Hb) {
    constexpr int T = 32;
    LAS float* Qf = (LAS float*)F.lds;
    LAS float* KW = (LAS float*)(F.lds + 8192);
    LAS float* Vf = (LAS float*)(F.lds + 16384);
    LAS float* FD = (LAS float*)(F.lds + 24576);
    LAS float* IW = (LAS float*)(F.lds + 24576 + 256);
    LAS float* EM = (LAS float*)(F.lds + 24576 + 512);
    LAS float* PN = (LAS float*)(F.lds + 32768);
    LAS float* PD = (LAS float*)(F.lds + 32768 + 65536);
    const int it = blockIdx.x, b = it >> 5, dir = (it >> 4) & 1, head = (it >> 1) & 7, jh = it & 1;
    bf16* Hout = dir == 0 ? Hf : Hb;
    const int w = F.wave, lane = F.lane, d7 = 8 * w + (lane & 7);
    float C[8], nst = 0.f, m_in = 0.f;
#pragma unroll
    for (int i = 0; i < 8; ++i) C[i] = 0.f;
    const int st = (F.tid & 255) >> 3, sch = F.tid & 7;
    v4u r0, r1; float gi = 0.f, gf = 0.f;
#define ML_LOAD(tile) do { const size_t _r = (size_t)(b * TPB + scan_row(dir, (tile) * T + st)); \
        if (F.tid < 256) { r0 = *(const v4u*)(Qm + _r * 512 + head * 64 + sch * 8); r1 = *(const v4u*)(Vm + _r * 1024 + head * 128 + jh * 64 + sch * 8); } \
        else { r0 = *(const v4u*)(Km + _r * 512 + head * 64 + sch * 8); } \
        if (F.tid < 32) { const size_t _g = (size_t)(b * TPB + scan_row(dir, (tile) * T + F.tid)); gi = G[_g * 32 + (2 * dir) * 8 + head]; gf = G[_g * 32 + (2 * dir + 1) * 8 + head]; } } while (0)
#define UNPK(dst, r) do { *(LAS f32x4*)(dst) = (f32x4){bflo(r.x), bfhi(r.x), bflo(r.y), bfhi(r.y)}; *(LAS f32x4*)((dst) + 4) = (f32x4){bflo(r.z), bfhi(r.z), bflo(r.w), bfhi(r.w)}; } while (0)
#define ML_GATES(nb) do { if (w == 0) { float Fc = lane < 32 ? gf : 0.f; \
            _Pragma("unroll") for (int o = 1; o < 32; o <<= 1) { const float t_ = __shfl_up(Fc, o); if (lane >= o) Fc += t_; } \
            float Gm = lane < 32 ? gi - Fc : -3.0e38f; \
            _Pragma("unroll") for (int o = 1; o < 32; o <<= 1) { const float t_ = __shfl_up(Gm, o); if (lane >= o) Gm = fmaxf(Gm, t_); } \
            const float mt = Fc + fmaxf(m_in, Gm); float mp = __shfl_up(mt, 1); if (lane == 0) mp = m_in; \
            if (lane < 32) { FD[(nb) * 32 + lane] = fast_exp2((gf + mp - mt) * LOG2E); IW[(nb) * 32 + lane] = fast_exp2((gi - mt) * LOG2E); EM[(nb) * 32 + lane] = fast_exp2(-mt * LOG2E); } \
            m_in = __shfl(mt, 31); } } while (0)
    __syncthreads();
    ML_LOAD(0); ML_GATES(0);
    if (F.tid < 256) { UNPK(Qf + st * 64 + sch * 8, r0); UNPK(Vf + st * 64 + sch * 8, r1); }
    __syncthreads();
    if (F.tid >= 256) { const float iw = IW[st]; LAS float* dk = KW + st * 64 + sch * 8;
        *(LAS f32x4*)dk = (f32x4){bflo(r0.x), bfhi(r0.x), bflo(r0.y), bfhi(r0.y)} * iw; *(LAS f32x4*)(dk + 4) = (f32x4){bflo(r0.z), bfhi(r0.z), bflo(r0.w), bfhi(r0.w)} * iw; }
    __syncthreads();
    constexpr int NT = TPB / T;
    for (int tile = 0; tile < NT; ++tile) { const int cb = tile & 1;
        if (tile + 1 < NT) ML_LOAD(tile + 1);
#pragma unroll 4
        for (int t = 0; t < T; ++t) {
            const float fd = FD[cb * 32 + t], v = Vf[t * 64 + lane];
            const f32x4 q0 = *(const LAS f32x4*)(Qf + t * 64 + 8 * w), q1 = *(const LAS f32x4*)(Qf + t * 64 + 8 * w + 4);
            const f32x4 k0 = *(const LAS f32x4*)(KW + t * 64 + 8 * w), k1 = *(const LAS f32x4*)(KW + t * 64 + 8 * w + 4);
            float pn = 0.f;
#pragma unroll
            for (int i = 0; i < 4; ++i) { C[i] = C[i] * fd + k0[i] * v; pn += q0[i] * C[i]; C[4 + i] = C[4 + i] * fd + k1[i] * v; pn += q1[i] * C[4 + i]; }
            PN[(w * 32 + t) * 64 + lane] = pn;
            nst = nst * fd + KW[t * 64 + d7];
            float pd = Qf[t * 64 + d7] * nst;
            pd += __shfl_xor(pd, 1); pd += __shfl_xor(pd, 2); pd += __shfl_xor(pd, 4);
            if (lane == 0) PD[w * 32 + t] = pd;
        }
        __syncthreads();
#pragma unroll
        for (int k = 0; k < 4; ++k) { const int t = (F.tid >> 6) + 8 * k; float num = 0.f, den = 0.f;
#pragma unroll
            for (int ww = 0; ww < 8; ++ww) { num += PN[(ww * 32 + t) * 64 + lane]; den += PD[ww * 32 + t]; }
            const float h = num / fmaxf(fabsf(den), EM[cb * 32 + t]);
            Hout[(size_t)(b * TPB + scan_row(dir, tile * T + t)) * 1024 + head * 128 + jh * 64 + lane] = (bf16)f2bf(h); }
        if (tile + 1 < NT) { ML_GATES(cb ^ 1); if (F.tid < 256) { UNPK(Qf + st * 64 + sch * 8, r0); UNPK(Vf + st * 64 + sch * 8, r1); } }
        __syncthreads();
        if (tile + 1 < NT && F.tid >= 256) { const float iw = IW[(cb ^ 1) * 32 + st]; LAS float* dk = KW + st * 64 + sch * 8;
            *(LAS f32x4*)dk = (f32x4){bflo(r0.x), bfhi(r0.x), bflo(r0.y), bfhi(r0.y)} * iw; *(LAS f32x4*)(dk + 4) = (f32x4){bflo(r0.z), bfhi(r0.z), bflo(r0.w), bfhi(r0.w)} * iw; }
        __syncthreads();
    }
#undef ML_LOAD
#undef ML_GATES
#undef UNPK
}

__device__ __forceinline__ void phase_mlstm_scan_mfma(Frame& F, const bf16* Qm, const bf16* Km, const bf16* Vm, const float* G, bf16* Hf, bf16* Hb) {
    constexpr int QSTR = 144, WSTR = 160, VSTR = 176, CSTR = 144;
    LAS unsigned char* Ql = F.lds;
    LAS unsigned char* Kl = F.lds + 9216;
    LAS unsigned char* Kw = F.lds + 18432;
    LAS unsigned char* Vl = F.lds + 28672;
    LAS unsigned char* Cb = F.lds + 39936;
    LAS float* BCU = (LAS float*)(F.lds + 62976);
    LAS float* IGA = BCU + 64;
    LAS float* MTA = BCU + 128;
    LAS float* SCA = BCU + 192;
    const int it = blockIdx.x, b = it >> 5, dir = (it >> 4) & 1, head = (it >> 1) & 7, jh = it & 1;
    bf16* Hout = dir == 0 ? Hf : Hb;
    const int tid = F.tid, lane = F.lane, w = F.wave, fr = lane & 15, fq = lane >> 4, lq = (lane & 15) >> 2, lp = lane & 3;
    const int lt = w & 3, jg = w >> 2;
    for (int i = tid; i < 80 * CSTR / 16; i += NTHR) *(LAS v4u*)(Cb + i * 16) = (v4u){0u, 0u, 0u, 0u};
    for (int i = tid; i < 64 * 2; i += NTHR) { const int s = i >> 1, hh = i & 1; *(LAS v4u*)(Vl + s * VSTR + 128 + hh * 16) = hh == 0 ? (v4u){0x3F80u, 0u, 0u, 0u} : (v4u){0u, 0u, 0u, 0u}; }
    f32x4 sacc[3];
#pragma unroll
    for (int i = 0; i < 3; ++i) sacc[i] = (f32x4){0.f, 0.f, 0.f, 0.f};
    v4u rQ, rK, rV; float gi = 0.f, gf = 0.f, m_in = 0.f;
    const int sr = tid >> 3, sc = tid & 7;
#define MM_LOAD(ck) do { const size_t _r = (size_t)(b * TPB + scan_row(dir, (ck) * 64 + sr)); \
        rQ = *(const v4u*)(Qm + _r * 512 + head * 64 + sc * 8); rK = *(const v4u*)(Km + _r * 512 + head * 64 + sc * 8); rV = *(const v4u*)(Vm + _r * 1024 + head * 128 + jh * 64 + sc * 8); \
        if (tid < 64) { const size_t _g = (size_t)(b * TPB + scan_row(dir, (ck) * 64 + tid)); gi = G[_g * 32 + (2 * dir) * 8 + head] * LOG2E; gf = G[_g * 32 + (2 * dir + 1) * 8 + head] * LOG2E; } } while (0)
#define MM_STAGE1() do { if (w == 0) { float Fc = gf; \
            _Pragma("unroll") for (int o = 1; o < 64; o <<= 1) { const float t_ = __shfl_up(Fc, o); if (lane >= o) Fc += t_; } \
            float Gm = gi - Fc; \
            _Pragma("unroll") for (int o = 1; o < 64; o <<= 1) { const float t_ = __shfl_up(Gm, o); if (lane >= o) Gm = fmaxf(Gm, t_); } \
            const float mt = Fc + fmaxf(m_in, Gm); BCU[lane] = Fc; IGA[lane] = gi; MTA[lane] = mt; \
            if (lane == 63) { SCA[0] = Fc; SCA[1] = m_in; SCA[2] = mt; } \
            m_in = __shfl(mt, 63); } \
        *(LAS v4u*)(Ql + sr * QSTR + sc * 16) = rQ; *(LAS v4u*)(Kl + sr * QSTR + sc * 16) = rK; *(LAS v4u*)(Vl + sr * VSTR + sc * 16) = rV; } while (0)
#define MM_STAGE2() do { const float ws_ = fast_exp2(SCA[0] - BCU[sr] + IGA[sr] - SCA[2]); v4u _o; \
        _o.x = cvt_pk_bf16(bflo(rK.x) * ws_, bfhi(rK.x) * ws_); _o.y = cvt_pk_bf16(bflo(rK.y) * ws_, bfhi(rK.y) * ws_); _o.z = cvt_pk_bf16(bflo(rK.z) * ws_, bfhi(rK.z) * ws_); _o.w = cvt_pk_bf16(bflo(rK.w) * ws_, bfhi(rK.w) * ws_); \
        *(LAS v4u*)(Kw + sr * WSTR + sc * 16) = _o; } while (0)
    __syncthreads();
    MM_LOAD(0); MM_STAGE1(); __syncthreads(); MM_STAGE2(); __syncthreads();
    for (int ck = 0; ck < 68; ++ck) { const int cur = ck & 1;
        if (ck + 1 < 68) MM_LOAD(ck + 1);
        const LAS unsigned char* Cc = Cb + cur * (80 * CSTR); LAS unsigned char* Cn = Cb + (cur ^ 1) * (80 * CSTR);
        bf16x8 qf[2];
#pragma unroll
        for (int ks = 0; ks < 2; ++ks) qf[ks] = *(const LAS bf16x8*)(Ql + (16 * lt + fr) * QSTR + (32 * ks + 8 * fq) * 2);
        const float bl = BCU[16 * lt + fr], ml = MTA[16 * lt + fr], m0 = SCA[1];
        const float dl = fast_exp2(bl + m0 - ml);
        f32x4 nacc[2]; float den;
#pragma unroll
        for (int ji = 0; ji < 2; ++ji) { f32x4 a = (f32x4){0.f, 0.f, 0.f, 0.f};
#pragma unroll
            for (int ks = 0; ks < 2; ++ks) { const bf16x8 cfr = *(const LAS bf16x8*)(Cc + (16 * (2 * jg + ji) + fr) * CSTR + (32 * ks + 8 * fq) * 2); a = __builtin_amdgcn_mfma_f32_16x16x32_bf16(cfr, qf[ks], a, 0, 0, 0); }
            nacc[ji] = a * dl; }
        { f32x4 a = (f32x4){0.f, 0.f, 0.f, 0.f};
#pragma unroll
          for (int ks = 0; ks < 2; ++ks) { const bf16x8 cfr = *(const LAS bf16x8*)(Cc + (64 + fr) * CSTR + (32 * ks + 8 * fq) * 2); a = __builtin_amdgcn_mfma_f32_16x16x32_bf16(cfr, qf[ks], a, 0, 0, 0); }
          den = __shfl(a[0], fr) * dl; }
        f32x4 pm[4]; float dsum = 0.f;
#pragma unroll
        for (int st = 0; st < 4; ++st) { pm[st] = (f32x4){0.f, 0.f, 0.f, 0.f};
            if (st <= lt) { f32x4 g = (f32x4){0.f, 0.f, 0.f, 0.f};
#pragma unroll
                for (int ks = 0; ks < 2; ++ks) { const bf16x8 kfr = *(const LAS bf16x8*)(Kl + (16 * st + fr) * QSTR + (32 * ks + 8 * fq) * 2); g = __builtin_amdgcn_mfma_f32_16x16x32_bf16(kfr, qf[ks], g, 0, 0, 0); }
                const f32x4 bs = *(const LAS f32x4*)(BCU + 16 * st + 4 * fq), is = *(const LAS f32x4*)(IGA + 16 * st + 4 * fq);
#pragma unroll
                for (int j = 0; j < 4; ++j) { const bool ok = (16 * st + 4 * fq + j) <= (16 * lt + fr); const float v = ok ? g[j] * fast_exp2(bl - bs[j] + is[j] - ml) : 0.f; pm[st][j] = v; dsum += v; } } }
        dsum += __shfl_xor(dsum, 16); dsum += __shfl_xor(dsum, 32);
        den += dsum;
#pragma unroll
        for (int ks2 = 0; ks2 < 2; ++ks2) { if (2 * ks2 <= lt) { const v4u pw = pack8(pm[2 * ks2], pm[2 * ks2 + 1]); const bf16x8 pf = __builtin_bit_cast(bf16x8, pw);
#pragma unroll
                for (int ji = 0; ji < 2; ++ji) { const LAS unsigned char* vb = Vl + (32 * ks2 + 4 * fq + lq) * VSTR + (16 * (2 * jg + ji) + 4 * lp) * 2;
                    const s16x4 v0 = __builtin_amdgcn_ds_read_tr16_b64_v4i16((LAS s16x4*)vb), v1 = __builtin_amdgcn_ds_read_tr16_b64_v4i16((LAS s16x4*)(vb + 16 * VSTR));
                    bf16x8 vf; vf[0] = v0[0]; vf[1] = v0[1]; vf[2] = v0[2]; vf[3] = v0[3]; vf[4] = v1[0]; vf[5] = v1[1]; vf[6] = v1[2]; vf[7] = v1[3];
                    nacc[ji] = __builtin_amdgcn_mfma_f32_16x16x32_bf16(vf, pf, nacc[ji], 0, 0, 0); } } }
        { const float inv = 1.0f / fmaxf(fabsf(den), fast_exp2(-ml)); const size_t ro = (size_t)(b * TPB + scan_row(dir, ck * 64 + 16 * lt + fr));
#pragma unroll
          for (int ji = 0; ji < 2; ++ji) { v2u o; o.x = cvt_pk_bf16(nacc[ji][0] * inv, nacc[ji][1] * inv); o.y = cvt_pk_bf16(nacc[ji][2] * inv, nacc[ji][3] * inv);
              *(v2u*)(Hout + ro * 1024 + head * 128 + jh * 64 + 16 * (2 * jg + ji) + 4 * fq) = o; } }
        { const float gdec = fast_exp2(SCA[0] + m0 - SCA[2]);
          bf16x8 kwf[2];
#pragma unroll
          for (int ks2 = 0; ks2 < 2; ++ks2) { const LAS unsigned char* kb = Kw + (32 * ks2 + 8 * fq + lq) * WSTR + (16 * lt + 4 * lp) * 2;
              const s16x4 v0 = __builtin_amdgcn_ds_read_tr16_b64_v4i16((LAS s16x4*)kb), v1 = __builtin_amdgcn_ds_read_tr16_b64_v4i16((LAS s16x4*)(kb + 4 * WSTR));
              kwf[ks2][0] = v0[0]; kwf[ks2][1] = v0[1]; kwf[ks2][2] = v0[2]; kwf[ks2][3] = v0[3]; kwf[ks2][4] = v1[0]; kwf[ks2][5] = v1[1]; kwf[ks2][6] = v1[2]; kwf[ks2][7] = v1[3]; }
#pragma unroll
          for (int i = 0; i < 3; ++i) { if (jg == 0 || i < 2) { const int jt = jg == 0 ? i : 3 + i; f32x4 a = sacc[i] * gdec;
#pragma unroll
              for (int ks2 = 0; ks2 < 2; ++ks2) { const LAS unsigned char* vb = Vl + (32 * ks2 + 8 * fq + lq) * VSTR + (16 * jt + 4 * lp) * 2;
                  const s16x4 v0 = __builtin_amdgcn_ds_read_tr16_b64_v4i16((LAS s16x4*)vb), v1 = __builtin_amdgcn_ds_read_tr16_b64_v4i16((LAS s16x4*)(vb + 4 * VSTR));
                  bf16x8 vt; vt[0] = v0[0]; vt[1] = v0[1]; vt[2] = v0[2]; vt[3] = v0[3]; vt[4] = v1[0]; vt[5] = v1[1]; vt[6] = v1[2]; vt[7] = v1[3];
                  a = __builtin_amdgcn_mfma_f32_16x16x32_bf16(vt, kwf[ks2], a, 0, 0, 0); }
              sacc[i] = a;
#pragma unroll
              for (int j = 0; j < 4; ++j) *(LAS bf16*)(Cn + (16 * jt + 4 * fq + j) * CSTR + (16 * lt + fr) * 2) = (bf16)f2bf(a[j]); } } }
        __syncthreads();
        if (ck + 1 < 68) MM_STAGE1();
        __syncthreads();
        if (ck + 1 < 68) MM_STAGE2();
        __syncthreads();
    }
#undef MM_LOAD
#undef MM_STAGE1
#undef MM_STAGE2
}

__device__ __forceinline__ void phase_mlstm_gnorm(Frame& F, const float* const* in, const bf16* Hf, const bf16* Hb, const bf16* Om, bf16* Hn) {
    const int gw = F.vcu * NWAVES + F.wave, NGW = GRID * NWAVES; const float* ng = in[28] + 16 * F.lane;
    for (int r = gw; r < M; r += NGW) { const size_t off = (size_t)r * 1024 + 16 * F.lane;
        const v4u a0 = *(const v4u*)(Hf + off), a1 = *(const v4u*)(Hf + off + 8), b0 = *(const v4u*)(Hb + off), b1 = *(const v4u*)(Hb + off + 8), o0 = *(const v4u*)(Om + off), o1 = *(const v4u*)(Om + off + 8);
        const unsigned aw[8] = {a0.x, a0.y, a0.z, a0.w, a1.x, a1.y, a1.z, a1.w}, bw[8] = {b0.x, b0.y, b0.z, b0.w, b1.x, b1.y, b1.z, b1.w}, ow[8] = {o0.x, o0.y, o0.z, o0.w, o1.x, o1.y, o1.z, o1.w};
        float v[16]; float ss = 0.f;
#pragma unroll
        for (int i = 0; i < 8; ++i) { v[2 * i] = bflo(aw[i]) + bflo(bw[i]); v[2 * i + 1] = bfhi(aw[i]) + bfhi(bw[i]); ss += v[2 * i] * v[2 * i] + v[2 * i + 1] * v[2 * i + 1]; }
        ss += __shfl_xor(ss, 1); ss += __shfl_xor(ss, 2); ss += __shfl_xor(ss, 4);
        const float rs = rsqrtf(ss * (1.f / 128.f) + EPS);
        unsigned res[8];
#pragma unroll
        for (int i = 0; i < 8; ++i) res[i] = cvt_pk_bf16(v[2 * i] * rs * ng[2 * i] * sigmoid_f(bflo(ow[i])), v[2 * i + 1] * rs * ng[2 * i + 1] * sigmoid_f(bfhi(ow[i])));
        *(v4u*)(Hn + off) = (v4u){res[0], res[1], res[2], res[3]}; *(v4u*)(Hn + off + 8) = (v4u){res[4], res[5], res[6], res[7]}; }
}
struct Args { const float* in[37]; float* out; unsigned char* ws; };

__device__ __forceinline__ void moe_phases(Frame& F, const float* const* in, int layer, const XcdBarrier& bar) {
    phase_norm2_route(F, in, layer);
    SYNC_GRID();
    bf16* Hb = (bf16*)(F.ws + WS_H); bf16* ACT = (bf16*)(F.ws + MOE_ACT); float* X = (float*)(F.ws + WS_X);
    const float* mod = (const float*)(F.ws + WS_MOD) + (size_t)layer * 9 * 6144;
    { MoeOrder<0> S; S.W = (const bf16*)(F.ws + WS_WGU); S.G = GRID; S.c = F.vcu; moe_setup(F, layer, S);
      pg8::Gemm g{Hb, 1024, 1024, 1 << 30}; EpiMoeAct E{ACT, S.tbl};
      pg8::gemm_phase(F.lds, g, S, E); }
    SYNC_GRID();
    { MoeOrder<1> S; S.W = (const bf16*)(F.ws + WS_WDN); S.G = GRID; S.c = F.vcu; moe_setup(F, layer, S);
      pg8::Gemm g{ACT, 512, 256, 4}; EpiMoeDown E{X, mod + 5 * 1024, S.tbl};
      pg8::gemm_phase(F.lds, g, S, E); }
    SYNC_GRID();
}
__device__ __forceinline__ void outproj_phase(Frame& F, const bf16* A, const bf16* Wt, int K, int ldb, int layer, const float* xin = nullptr, const float* cin = nullptr) {
    pg8::Gemm g{A, K, ldb, 1 << 30}; pg8::StaticOrder S; S.init(M, 1024, GRID, (int)blockIdx.x, Wt, ldb);
    EpiResid E{(float*)(F.ws + WS_X), (const float*)(F.ws + WS_MOD) + (size_t)layer * 9 * 6144 + 2 * 1024, xin, cin};
    pg8::gemm_phase(F.lds, g, S, E);
}

__device__ __forceinline__ void ssm_gp_phases(Frame& F, const float* const* in, const int gp, const XcdBarrier& bar) {
    unsigned char* scr = F.ws + WS_SCR; unsigned char* scr2 = (unsigned char*)F.out; bf16* H = (bf16*)(F.ws + WS_H); bf16* WM = (bf16*)(F.ws + WS_WMIX);
    bf16* Z = (bf16*)scr; bf16* XP = (bf16*)(scr + 68 * MiB); bf16* XS = (bf16*)(scr + 170 * MiB); float* DT = (float*)(scr + 238 * MiB); float* ACUM = (float*)(scr + 243 * MiB); bf16* BC = (bf16*)scr2; bf16* Yb = (bf16*)(scr2 + 34 * MiB);
    { pg8::Gemm g{H, 1024, 1024, 1 << 30}; pg8::StaticOrder S; S.init(M, 2816, GRID, (int)blockIdx.x, WM + (size_t)gp * 2816 * 1024, 1024);
      EpiSsmIn E{Z, XP, DT, in[21] + gp * 16};
      pg8::gemm_phase(F.lds, g, S, E);
#if defined(PROBE_GEMM2)
        __syncthreads(); pg8::gemm_phase(F.lds, g, S, E);
#endif
        }
    SYNC_GRID();
    phase_ssm_conv(F, in, gp, XP, XS, BC, DT, ACUM);
#if defined(PROBE_MEM2)
    phase_ssm_conv(F, in, gp, XP, XS, BC, DT, ACUM);
#endif
    SYNC_GRID();
#if defined(SSD_VALU)
    phase_ssm_scan(F, in, gp, XS, BC, DT, Z, XP);
    SYNC_GRID();
    phase_ssm_gnorm(F, in, gp, XP);
    SYNC_GRID();
#else
    phase_ssm_scan_mfma(F, in, gp, XS, BC, DT, ACUM, XP, Yb);
#if defined(PROBE_SSDM2)
    VM_WAIT(); __syncthreads(); __builtin_amdgcn_fence(__ATOMIC_ACQUIRE, "agent"); VM_WAIT(); __syncthreads(); refresh(F); phase_ssm_scan_mfma(F, in, gp, XS, BC, DT, ACUM, XP, Yb);
#endif
    SYNC_GRID();
    phase_ssm_gnorm2(F, in, gp, XP, Yb, XS, Z);
    SYNC_GRID();
#endif
    outproj_phase(F, XP, WM + 6 * MiB + (size_t)gp * 1024, 1024, 2048, 1);
    SYNC_GRID();
}

__global__ void __launch_bounds__(NTHR, 2) fwd_kernel(Args args) {
    extern __shared__ __attribute__((aligned(16))) unsigned char lds_raw[];
    Frame F;
    F.lds = (LAS unsigned char*)lds_raw; F.ws = args.ws; F.ctl = (unsigned*)(args.ws + WS_CTL); F.out = args.out;
    refresh(F);
    { const int bx = blockIdx.x; F.vcu = (bx % 8) * (GRID / 8) + bx / 8; }
    volatile LAS unsigned* MISC = (volatile LAS unsigned*)(F.lds + LDS_MISC);
    for (int u = F.tid; u < 256; u += NTHR) MISC[u] = 0u;
    __syncthreads();
    const XcdBarrier bar = xcd_barrier_post(F.ctl + CW_BAR, MISC + 8);
    const float* const* in = args.in;
    unsigned char* ws = F.ws; unsigned char* scr = ws + WS_SCR; unsigned char* scr2 = (unsigned char*)F.out;
    bf16* H = (bf16*)(ws + WS_H); bf16* WM = (bf16*)(ws + WS_WMIX);

#if defined(PROBE_MEM2)
    for (int rep = 0; rep < 2; ++rep) {
#endif
    phase_prologue(F, in);
    __syncthreads(); refresh(F);
    convert_matrix<MAP_ATTN_IN>(F, in[15], 1024, 1536, WM, 0, nullptr);
    convert_matrix<MAP_ID>(F, in[17], 1024, 1024, WM + 2 * MiB, 0, nullptr);
    convert_moe(F, in, 0);
#if defined(PROBE_MEM2)
    __syncthreads(); }
#endif
    SYNC_GRID();

#ifndef SKIP_L0
    phase_norm1(F, in, 0);
#if defined(PROBE_MEM2)
    phase_norm1(F, in, 0);
#endif
    SYNC_GRID();
    { bf16* Q = (bf16*)scr; bf16* Kb = (bf16*)(scr + 68 * MiB); bf16* Vb = (bf16*)(scr + 85 * MiB);
      { pg8::Gemm g{H, 1024, 1024, 1 << 30}; pg8::StaticOrder S; S.init(M, 1536, GRID, (int)blockIdx.x, WM, 1024);
        EpiAttnIn E{Q, Kb, Vb, (const f32x2*)(ws + WS_TABA), 0.125f * LOG2E};
        pg8::gemm_phase(F.lds, g, S, E);
#if defined(PROBE_GEMM2)
        __syncthreads(); pg8::gemm_phase(F.lds, g, S, E);
#endif
        }
      SYNC_GRID();
#if defined(PROBE_WIN2)
      phase_attn_window(F, in, Q, Kb, Vb, (bf16*)scr2); __syncthreads();
#endif
      phase_attn_window(F, in, Q, Kb, Vb);
      SYNC_GRID();
      outproj_phase(F, Q, WM + 2 * MiB, 1024, 1024, 0, in[0], in[2]);
      SYNC_GRID(); }
    moe_phases(F, in, 0, bar);

#endif
#ifndef SKIP_L1
#if defined(PROBE_MEM2)
    for (int rep = 0; rep < 2; ++rep) {
#endif
    phase_norm1(F, in, 1);
    convert_matrix<MAP_SSM_IN>(F, in[18], 1024, 5184, WM, 0, nullptr);
    zero_rows(F, WM, 2592, 224, 1024); zero_rows(F, WM, 2816 + 2592, 224, 1024);
    convert_matrix<MAP_ID>(F, in[25], 2048, 1024, WM + 6 * MiB, 0, nullptr);
    convert_moe(F, in, 1);
#if defined(PROBE_MEM2)
    __syncthreads(); }
#endif
    SYNC_GRID();
    ssm_gp_phases(F, in, 0, bar);
    ssm_gp_phases(F, in, 1, bar);
    moe_phases(F, in, 1, bar);

#endif
#ifndef SKIP_L2
#if defined(PROBE_MEM2)
    for (int rep = 0; rep < 2; ++rep) {
#endif
    phase_norm1(F, in, 2);
    convert_matrix<MAP_ID>(F, in[26], 1024, 3104, WM, 0, nullptr);
    zero_rows(F, WM, 3104, 224, 1024);
    convert_matrix<MAP_ID>(F, in[29], 1024, 1024, WM + 4 * MiB, 0, nullptr);
    convert_moe(F, in, 2);
#if defined(PROBE_MEM2)
    __syncthreads(); }
#endif
    SYNC_GRID();
    { bf16* Qm = (bf16*)scr; bf16* Km = (bf16*)(scr + 34 * MiB); bf16* Vm = (bf16*)(scr + 68 * MiB); bf16* Om = (bf16*)(scr + 136 * MiB); float* Gt = (float*)(scr + 204 * MiB);
      bf16* Hf = (bf16*)scr2; bf16* Hbw = H;
      { pg8::Gemm g{H, 1024, 1024, 1 << 30}; pg8::StaticOrder S; S.init(M, 3328, GRID, (int)blockIdx.x, WM, 1024);
        EpiMlIn E{Qm, Km, Vm, Om, Gt, in[27]};
        pg8::gemm_phase(F.lds, g, S, E);
#if defined(PROBE_GEMM2)
        __syncthreads(); pg8::gemm_phase(F.lds, g, S, E);
#endif
        }
      SYNC_GRID();
#if defined(ML_VALU)
      phase_mlstm_scan(F, Qm, Km, Vm, Gt, Hf, Hbw);
#else
      phase_mlstm_scan_mfma(F, Qm, Km, Vm, Gt, Hf, Hbw);
#if defined(PROBE_MLM2)
      __syncthreads(); phase_mlstm_scan_mfma(F, Qm, Km, Vm, Gt, Hf, Hbw);
#endif
#endif
      SYNC_GRID();
      phase_mlstm_gnorm(F, in, Hf, Hbw, Om, Om);
      SYNC_GRID();
      outproj_phase(F, Om, WM + 4 * MiB, 1024, 1024, 2);
      SYNC_GRID(); }
    moe_phases(F, in, 2, bar);

#endif
#ifndef SKIP_L3
#if defined(PROBE_MEM2)
    for (int rep = 0; rep < 2; ++rep) {
#endif
    phase_norm1(F, in, 3);
    convert_matrix<MAP_MLA_IN>(F, in[30], 1024, 544, WM, 0, nullptr);
    zero_rows(F, WM, 544, 224, 1024);
    convert_matrix<MAP_MLA_QUP>(F, in[32], 256, 1536, WM + 1 * MiB, 0, in[31]);
    convert_matrix<MAP_ID>(F, in[34], 256, 2048, WM + 2 * MiB, 0, in[33]);
    convert_matrix<MAP_ID>(F, in[35], 1024, 1024, WM + 3 * MiB, 0, nullptr);
    convert_moe(F, in, 3);
#if defined(PROBE_MEM2)
    __syncthreads(); }
#endif
    SYNC_GRID();
    { bf16* CQ = (bf16*)scr; bf16* CKV = (bf16*)(scr + 17 * MiB); float* SSQ = (float*)(scr + 34 * MiB); bf16* KF = (bf16*)(scr + 36 * MiB); bf16* V3 = (bf16*)(scr + 138 * MiB);
      bf16* Q3 = (bf16*)scr2; bf16* O3 = H; const f32x2* tabm = (const f32x2*)(ws + WS_TABM);
      { pg8::Gemm g{H, 1024, 1024, 1 << 30}; pg8::StaticOrder S; S.init(M, 768, GRID, (int)blockIdx.x, WM, 1024);
        EpiMlaIn E{CQ, CKV, KF, SSQ, tabm};
        pg8::gemm_phase(F.lds, g, S, E);
#if defined(PROBE_GEMM2)
        __syncthreads(); pg8::gemm_phase(F.lds, g, S, E);
#endif
        }
      SYNC_GRID();
      { pg8::Gemm g{CQ, 256, 256, 1 << 30}; pg8::StaticOrder S; S.init(M, 1536, GRID, (int)blockIdx.x, WM + 1 * MiB, 256);
        EpiMlaQ E{Q3, SSQ, tabm, 0.10206207261596577f * LOG2E};
        pg8::gemm_phase(F.lds, g, S, E);
#if defined(PROBE_GEMM2)
        __syncthreads(); pg8::gemm_phase(F.lds, g, S, E);
#endif
        }
      { pg8::Gemm g{CKV, 256, 256, 1 << 30}; pg8::StaticOrder S; S.init(M, 2048, GRID, (int)blockIdx.x, WM + 2 * MiB, 256);
        EpiMlaKV E{KF, V3, SSQ};
        pg8::gemm_phase(F.lds, g, S, E);
#if defined(PROBE_GEMM2)
        __syncthreads(); pg8::gemm_phase(F.lds, g, S, E);
#endif
        }
      SYNC_GRID();
      phase_attn_mla(F, Q3, KF, V3, O3);
#if defined(PROBE_MLA2)
      __syncthreads(); phase_attn_mla(F, Q3, KF, V3, O3);
#endif
      SYNC_GRID();
      outproj_phase(F, O3, WM + 3 * MiB, 1024, 1024, 3);
      SYNC_GRID(); }
    moe_phases(F, in, 3, bar);

#endif
    const bool poison = __hip_atomic_load(F.ctl + CW_BAR + XB_TMO, RLX_AGENT) != 0u || __hip_atomic_load(F.ctl + CW_POISON, RLX_AGENT) != 0u;
    phase_final(F, in, poison);
#if defined(PROBE_MEM2)
    phase_final(F, in, poison);
#endif
}

extern "C" void kernel_launch(void* const* d_in, const int* in_sizes, int n_in, void* d_out, int out_size, void* d_ws, size_t ws_size, hipStream_t stream) {
    static int ready = 0;
    if (ready == 0) {
        ready = -1;
        if (n_in != 37 || in_sizes[0] != NB * SEQ * D || out_size != NB * SEQ * D || ws_size < WS_END) { fprintf(stderr, "kernel_launch: unexpected problem shape (n_in %d, in0 %d, out %d, ws %zu)\n", n_in, n_in > 0 ? in_sizes[0] : -1, out_size, ws_size); return; }
        int dev = 0, cus = 0;
        if (hipGetDevice(&dev) != hipSuccess || hipDeviceGetAttribute(&cus, hipDeviceAttributeMultiprocessorCount, dev) != hipSuccess) { fprintf(stderr, "kernel_launch: device query failed\n"); return; }
        if (cus < GRID) { fprintf(stderr, "kernel_launch: needs %d CUs, device has %d\n", GRID, cus); return; }
        if (hipFuncSetAttribute((const void*)fwd_kernel, hipFuncAttributeMaxDynamicSharedMemorySize, LDS_BYTES) != hipSuccess) { fprintf(stderr, "kernel_launch: hipFuncSetAttribute failed\n"); return; }
        int per_cu = 0;
        if (hipOccupancyMaxActiveBlocksPerMultiprocessor(&per_cu, (const void*)fwd_kernel, NTHR, LDS_BYTES) != hipSuccess || per_cu < 1) { fprintf(stderr, "kernel_launch: occupancy query reports %d blocks per CU\n", per_cu); }
        (void)hipGetLastError();
        ready = 1;
    }
    if (ready < 0) return;
    if (hipMemsetAsync((char*)d_ws + WS_CTL, 0, CTL_ZERO_BYTES, stream) != hipSuccess) { fprintf(stderr, "kernel_launch: memset failed\n"); return; }
    Args a{};
    for (int i = 0; i < 37; ++i) a.in[i] = (const float*)d_in[i];
    a.out = (float*)d_out; a.ws = (unsigned char*)d_ws;
    hipLaunchKernelGGL(fwd_kernel, dim3(GRID), dim3(NTHR), LDS_BYTES, stream, a);
    const hipError_t le = hipPeekAtLastError();
    if (le != hipSuccess) fprintf(stderr, "kernel_launch: launch failed: %s\n", hipGetErrorName(le));
}
```

```cpp
#include <hip/hip_runtime.h>
#include <cstdio>
#include <cstdint>

#define GAS __attribute__((address_space(1)))
#define LAS __attribute__((address_space(3)))
typedef unsigned short bf16;
typedef unsigned v4u __attribute__((ext_vector_type(4)));
typedef unsigned v2u __attribute__((ext_vector_type(2)));
typedef float f32x4 __attribute__((ext_vector_type(4)));
typedef float f32x2 __attribute__((ext_vector_type(2)));
typedef short bf16x8 __attribute__((ext_vector_type(8)));
typedef short s16x4 __attribute__((ext_vector_type(4)));
#define RLX_AGENT __ATOMIC_RELAXED, __HIP_MEMORY_SCOPE_AGENT

constexpr int D = 1024, NB = 8, SEQ = 4096, CTX = 256, TPB = SEQ + CTX  , M = NB * TPB  ;
constexpr int NWAVES = 8, NTHR = 512, GRID = 256;
constexpr float EPS = 1e-6f;
constexpr float LOG2E = 1.4426950408889634f;

__device__ __forceinline__ unsigned f2bf(float f) { unsigned u = __builtin_bit_cast(unsigned, f); return (u + 0x7fffu + ((u >> 16) & 1u)) >> 16; }
__device__ __forceinline__ float bf2f(unsigned b) { return __builtin_bit_cast(float, b << 16); }
__device__ __forceinline__ float bflo(unsigned w) { return __builtin_bit_cast(float, w << 16); }
__device__ __forceinline__ float bfhi(unsigned w) { return __builtin_bit_cast(float, w & 0xffff0000u); }
__device__ __forceinline__ unsigned cvt_pk_bf16(float lo, float hi) { unsigned r; asm volatile("v_cvt_pk_bf16_f32 %0, %1, %2" : "=v"(r) : "v"(lo), "v"(hi)); return r; }
__device__ __forceinline__ float fast_exp2(float x) { return __builtin_amdgcn_exp2f(x); }
__device__ __forceinline__ float fast_rcp(float x) { return __builtin_amdgcn_rcpf(x); }
__device__ __forceinline__ float silu_f(float x) { return x * fast_rcp(1.0f + fast_exp2(-x * LOG2E)); }
__device__ __forceinline__ float sigmoid_f(float x) { return fast_rcp(1.0f + fast_exp2(-x * LOG2E)); }
__device__ __forceinline__ float fast_log(float x) { return __builtin_amdgcn_logf(x) * 0.6931471805599453f; }
__device__ __forceinline__ float fast_exp(float x) { return __builtin_amdgcn_exp2f(x * LOG2E); }
__device__ __forceinline__ float softplus_f(float x) { if (x > 20.f) return x; const float e = fast_exp(x); return e < 0.01f ? e * (1.0f - e * (0.5f - e * (1.0f / 3.0f))) : fast_log(1.0f + e); }
#define DPPF(old, src, ctrl, rm, bc) __builtin_bit_cast(float, __builtin_amdgcn_update_dpp(__builtin_bit_cast(int, (float)(old)), __builtin_bit_cast(int, (float)(src)), ctrl, rm, 0xF, bc))
__device__ __forceinline__ float wave_sum(float v) {
    v += DPPF(0.f, v, 0xB1, 0xF, true); v += DPPF(0.f, v, 0x4E, 0xF, true); v += DPPF(0.f, v, 0x141, 0xF, true); v += DPPF(0.f, v, 0x140, 0xF, true);
    v += DPPF(0.f, v, 0x142, 0xA, false); v += DPPF(0.f, v, 0x143, 0xC, false);
    return __builtin_bit_cast(float, __builtin_amdgcn_readlane(__builtin_bit_cast(int, v), 63));
}
__device__ __forceinline__ int opaque_tid() { int t = threadIdx.x; asm volatile("" : "+v"(t)); return t; }
__device__ __forceinline__ float xrow_max(float v) {
    { auto r = __builtin_amdgcn_permlane16_swap(__builtin_bit_cast(unsigned, v), __builtin_bit_cast(unsigned, v), false, false); v = fmaxf(__builtin_bit_cast(float, r[0]), __builtin_bit_cast(float, r[1])); }
    { auto r = __builtin_amdgcn_permlane32_swap(__builtin_bit_cast(unsigned, v), __builtin_bit_cast(unsigned, v), false, false); v = fmaxf(__builtin_bit_cast(float, r[0]), __builtin_bit_cast(float, r[1])); }
    return v; }
__device__ __forceinline__ float xrow_sum(float v) {
    { auto r = __builtin_amdgcn_permlane16_swap(__builtin_bit_cast(unsigned, v), __builtin_bit_cast(unsigned, v), false, false); v = __builtin_bit_cast(float, r[0]) + __builtin_bit_cast(float, r[1]); }
    { auto r = __builtin_amdgcn_permlane32_swap(__builtin_bit_cast(unsigned, v), __builtin_bit_cast(unsigned, v), false, false); v = __builtin_bit_cast(float, r[0]) + __builtin_bit_cast(float, r[1]); }
    return v; }
#define LDS_WAIT() asm volatile("s_waitcnt lgkmcnt(0)" ::: "memory")
#define VM_WAIT() asm volatile("s_waitcnt vmcnt(0)" ::: "memory")

namespace pg8 {
constexpr int BM = 256, BK = 64, HALF = 128, HTB = HALF * BK * 2, STAGE_BYTES = 8 * HTB, NXCD = 8, WGM = 8;
__host__ __device__ __forceinline__ int lds_byte(int r, int c) { const int st = (r >> 4) * 2 + (c >> 5), rr = r & 15, cc = c & 31, ob = rr * 64 + cc * 2; return st * 1024 + (ob ^ (((ob >> 9) & 1) << 5)); }
__host__ __device__ __forceinline__ void stage_rc(int b, int& R, int& C) { const int st = b / 1024, sb = b % 1024, swz = sb ^ (((sb >> 9) & 1) << 5); R = (st >> 1) * 16 + swz / 64; C = (st & 1) * 32 + (swz % 64) / 2; }
__host__ __device__ __forceinline__ int perm32(int rho) { const int n = rho >> 4, i = rho & 15; return 8 * (i >> 2) + 4 * n + (i & 3); }

struct Unit { int pm, pn, aux; };
struct Gemm { const bf16* A; int K; int ldb; int ksplit; };

struct StaticOrder {
    static constexpr bool GATHER = false;
    int nM, nN, nwg, G, c; const bf16* Bt; int ldb;
    __device__ void init(int M_, int N_, int G_, int c_, const bf16* Bt_, int ldb_) { nM = M_ / BM; nN = N_ / BM; nwg = nM * nN; G = G_; c = c_; Bt = Bt_; ldb = ldb_; }
    __device__ __forceinline__ bool next(int i, Unit& u) const {
        const long L = (long)i * G + c; if (L >= nwg) return false;
        int wgid = (int)L; { const int q = nwg / NXCD, r = nwg % NXCD, xcd = wgid % NXCD, off = wgid / NXCD; wgid = (xcd < r ? xcd * (q + 1) : r * (q + 1) + (xcd - r) * q) + off; }
        const int nig = WGM * nN, gid = wgid / nig, fm = gid * WGM, gsz = (nM - fm) < WGM ? (nM - fm) : WGM;
        u.pm = fm + ((wgid % nig) % gsz); u.pn = (wgid % nig) / gsz; u.aux = 0; return true;
    }
    __device__ __forceinline__ int a_row(const Unit& u, int r) const { return u.pm * BM + r; }
    __device__ __forceinline__ const char* b_seg(const Unit& u, int seg) const { return (const char*)(Bt + (size_t)u.pn * BM * ldb); }
};

template <class Epi, class Sched>
__device__ __forceinline__ void gemm_phase(LAS unsigned char* lds, const Gemm g, const Sched& S, const Epi& E) {
    const int tid = opaque_tid(), wid = __builtin_amdgcn_readfirstlane(tid >> 6), lane = tid & 63, wr = wid >> 2, wc = wid & 3, fr = lane & 15, fq = lane >> 4;
    const int K = g.K, nt = K / BK, ldb = g.ldb, ksplit = g.ksplit;
    int Rst[2], Cst[2]; unsigned voffB[2], voffA[2];
#pragma unroll
    for (int i = 0; i < 2; ++i) { int R, C; stage_rc(tid * 16 + i * 8192, R, C); const int Rb = Epi::PERM ? ((R & ~31) + perm32(R & 31)) : R; Rst[i] = R; Cst[i] = C;
        voffB[i] = (unsigned)(Rb * ldb + C) * 2u; voffA[i] = (unsigned)(R * K + C) * 2u; }
    const size_t hstepA = (size_t)HALF * K * 2;
    const size_t kstep = (size_t)(BK * 2);
    const size_t hstepB = (size_t)HALF * ldb * 2;
    const unsigned ldsw = (unsigned)wid * 1024u;
    const int aoff = lds_byte(wr * 64 + fr, fq * 8), boff = lds_byte(wc * 32 + fr, fq * 8);
#define PG8_SA(b, h) (((b) * 2 + (h)) * HTB)
#define PG8_SB(b, h) ((4 + (b) * 2 + (h)) * HTB)
#define PG8_STAGEB(bufoff, gbase) do { _Pragma("unroll") for (int _i = 0; _i < 2; ++_i) \
        __builtin_amdgcn_global_load_lds((const unsigned*)((const char*)(gbase) + voffB[_i]), (LAS unsigned*)(lds + (bufoff) + ldsw + _i * 8192), 16, 0, 0); } while (0)
#define PG8_STAGEA(bufoff, nextsel, h, kt) do { if constexpr (Sched::GATHER) { _Pragma("unroll") for (int _i = 0; _i < 2; ++_i) \
        __builtin_amdgcn_global_load_lds((const unsigned*)(gA + (size_t)(kt) * kstep + ((nextsel) ? vN[h][_i] : vA[h][_i])), (LAS unsigned*)(lds + (bufoff) + ldsw + _i * 8192), 16, 0, 0); } \
      else { const char* _ab = ((nextsel) ? nA : cA) + (size_t)(h) * hstepA + (size_t)(kt) * kstep; _Pragma("unroll") for (int _i = 0; _i < 2; ++_i) \
        __builtin_amdgcn_global_load_lds((const unsigned*)(_ab + voffA[_i]), (LAS unsigned*)(lds + (bufoff) + ldsw + _i * 8192), 16, 0, 0); } } while (0)
#define PG8_LDA(dst, b, h) do { _Pragma("unroll") for (int m = 0; m < 4; ++m) _Pragma("unroll") for (int k = 0; k < 2; ++k) dst[m][k] = *(const LAS bf16x8*)(lds + PG8_SA(b, h) + aoff + m * 2048 + k * 1024); } while (0)
#define PG8_LDB(dst, b, h) do { _Pragma("unroll") for (int n = 0; n < 2; ++n) _Pragma("unroll") for (int k = 0; k < 2; ++k) dst[n][k] = *(const LAS bf16x8*)(lds + PG8_SB(b, h) + boff + n * 2048 + k * 1024); } while (0)
#define PG8_MMA(ai, bj, At, Bt) do { __builtin_amdgcn_s_setprio(1); _Pragma("unroll") for (int m = 0; m < 4; ++m) _Pragma("unroll") for (int n = 0; n < 2; ++n) _Pragma("unroll") for (int k = 0; k < 2; ++k) \
        acc[ai][bj][m][n] = __builtin_amdgcn_mfma_f32_16x16x32_bf16(Bt[n][k], At[m][k], acc[ai][bj][m][n], 0, 0, 0); __builtin_amdgcn_s_setprio(0); } while (0)
#define PG8_WAIT_V(n) asm volatile("s_waitcnt vmcnt(" #n ")" ::: "memory")
#define PG8_WAIT_L(n) asm volatile("s_waitcnt lgkmcnt(" #n ")" ::: "memory")
#define PG8_BAR __builtin_amdgcn_s_barrier()
#define PG8_SCHED __builtin_amdgcn_sched_barrier(0)
#define PG8_AOFFS(dst, u) do { _Pragma("unroll") for (int _h = 0; _h < 2; ++_h) _Pragma("unroll") for (int _i = 0; _i < 2; ++_i) \
        dst[_h][_i] = (unsigned)S.a_row(u, _h * HALF + Rst[_i]) * (unsigned)(K * 2) + (unsigned)(Cst[_i] * 2); } while (0)
    Unit cur, nxt; int ui = 0;
    if (!S.next(0, cur)) return;
    const char* const gA = (const char*)g.A;
    f32x4 acc[2][2][4][2];
#pragma unroll
    for (int a = 0; a < 2; ++a)
#pragma unroll
        for (int b = 0; b < 2; ++b)
#pragma unroll
            for (int m = 0; m < 4; ++m)
#pragma unroll
                for (int n = 0; n < 2; ++n) acc[a][b][m][n] = (f32x4){0.f, 0.f, 0.f, 0.f};
    bf16x8 At[4][2], B0[2][2], B1[2][2];
    unsigned vA[2][2], vN[2][2];
    const char* cA = gA; const char* nA = gA;
    if constexpr (Sched::GATHER) { PG8_AOFFS(vA, cur); } else { cA = gA + (size_t)S.a_row(cur, 0) * K * 2; }
    const char* cB0 = S.b_seg(cur, 0); const char* cB1 = S.b_seg(cur, 1);
    PG8_STAGEB(PG8_SB(0, 0), cB0); PG8_STAGEB(PG8_SB(0, 1), cB0 + hstepB); PG8_STAGEA(PG8_SA(0, 0), false, 0, 0); PG8_STAGEA(PG8_SA(0, 1), false, 1, 0);
    if (wr == 1) PG8_BAR;
    PG8_WAIT_V(2); PG8_BAR;
    PG8_STAGEB(PG8_SB(1, 0), cB0 + kstep); PG8_STAGEA(PG8_SA(1, 0), false, 0, 1); PG8_STAGEB(PG8_SB(1, 1), cB0 + hstepB + kstep);
    PG8_WAIT_V(6); PG8_BAR;
    for (;;) {
        const bool has_next = S.next(ui + 1, nxt);
        const char* nB0 = cB0;
        nA = cA;
        if (has_next) { nB0 = S.b_seg(nxt, 0); if constexpr (Sched::GATHER) { PG8_AOFFS(vN, nxt); } else { nA = gA + (size_t)S.a_row(nxt, 0) * K * 2; } }
        else { if constexpr (Sched::GATHER) {
#pragma unroll
            for (int h = 0; h < 2; ++h)
#pragma unroll
                for (int i = 0; i < 2; ++i) vN[h][i] = vA[h][i]; } }
#pragma unroll 1
        for (int t = 0; t < nt; t += 2) {
            const bool last = (t == nt - 2);
            const char* b2 = last ? nB0 : ((t + 2 < ksplit) ? cB0 + (size_t)(t + 2) * kstep : cB1 + (size_t)(t + 2 - ksplit) * kstep);
            const char* b3 = b2 + kstep;
            const int kt2 = last ? 0 : t + 2;
            PG8_LDB(B0, 0, 0); PG8_LDB(B1, 0, 1); PG8_SCHED; PG8_LDA(At, 0, 0); PG8_STAGEA(PG8_SA(1, 1), false, 1, t + 1);
            PG8_WAIT_V(8); PG8_WAIT_L(0); PG8_BAR; PG8_MMA(0, 0, At, B0); PG8_MMA(0, 1, At, B1); PG8_BAR; PG8_SCHED;
            PG8_LDA(At, 0, 1); PG8_STAGEB(PG8_SB(0, 0), b2); PG8_STAGEB(PG8_SB(0, 1), b2 + hstepB); PG8_STAGEA(PG8_SA(0, 0), last, 0, kt2);
            PG8_WAIT_V(8); PG8_WAIT_L(0); PG8_BAR; PG8_MMA(1, 0, At, B0); PG8_MMA(1, 1, At, B1); PG8_BAR; PG8_SCHED;
            PG8_LDB(B0, 1, 0); PG8_LDB(B1, 1, 1); PG8_SCHED; PG8_LDA(At, 1, 0); PG8_STAGEA(PG8_SA(0, 1), last, 1, kt2);
            PG8_WAIT_V(8); PG8_WAIT_L(0); PG8_BAR; PG8_MMA(0, 0, At, B0); PG8_MMA(0, 1, At, B1); PG8_BAR; PG8_SCHED;
            PG8_LDA(At, 1, 1); PG8_STAGEB(PG8_SB(1, 0), b3); PG8_STAGEB(PG8_SB(1, 1), b3 + hstepB); PG8_STAGEA(PG8_SA(1, 0), last, 0, kt2 + 1);
            PG8_WAIT_V(8); PG8_WAIT_L(0); PG8_BAR; PG8_MMA(1, 0, At, B0); PG8_MMA(1, 1, At, B1); PG8_BAR; PG8_SCHED;
        }
        if (wr == 0) PG8_BAR;
        { int tz = tid; asm volatile("" : "+v"(tz));
          const int lz = tz & 63; E(acc, cur, ui, wr, wc, lz & 15, lz >> 4); }
        if (!has_next) break;
#pragma unroll
        for (int a = 0; a < 2; ++a)
#pragma unroll
            for (int b = 0; b < 2; ++b)
#pragma unroll
                for (int m = 0; m < 4; ++m)
#pragma unroll
                    for (int n = 0; n < 2; ++n) acc[a][b][m][n] = (f32x4){0.f, 0.f, 0.f, 0.f};
        cur = nxt; cB0 = nB0; cB1 = S.b_seg(cur, 1); cA = nA; ++ui;
        if constexpr (Sched::GATHER) {
#pragma unroll
        for (int h = 0; h < 2; ++h)
#pragma unroll
            for (int i = 0; i < 2; ++i) vA[h][i] = vN[h][i]; }
        if (wr == 1) PG8_BAR;
    }
    PG8_WAIT_V(0);
    PG8_BAR;
#undef PG8_SA
#undef PG8_SB
#undef PG8_STAGEA
#undef PG8_STAGEB
#undef PG8_LDA
#undef PG8_LDB
#undef PG8_MMA
#undef PG8_WAIT_V
#undef PG8_WAIT_L
#undef PG8_BAR
#undef PG8_SCHED
#undef PG8_AOFFS
}
}
#define XB_TMO      128
#define XB_XCNT(j)  (256  + 64 * (j))
#define XB_XSUB(j)  (1280 + 64 * (j))
#define XB_XGEN(j)  (2304 + 64 * (j))
#define XB_TOP      3328
#define XB_TOPGEN   3392
#define XCD_BAR_WORDS 3456
#define XB_SPIN_CAP (1u << 22)
__device__ __forceinline__ unsigned xb_ld(unsigned* p)              { return __hip_atomic_load(p, __ATOMIC_RELAXED, __HIP_MEMORY_SCOPE_AGENT); }
__device__ __forceinline__ unsigned xb_add(unsigned* p, unsigned v) { return __hip_atomic_fetch_add(p, v, __ATOMIC_RELAXED, __HIP_MEMORY_SCOPE_AGENT); }
__device__ __forceinline__ unsigned xb_xcc_id() { return (unsigned)__builtin_amdgcn_s_getreg((3 << 11) | 20) & 0xFu; }
#define XB_SPIN(cond, bar) do { unsigned _sp = 0; while (cond) { __builtin_amdgcn_s_sleep(1); \
    if ((++_sp & 255u) == 0u) { if (xb_ld(&(bar)[XB_TMO])) break; if (_sp > XB_SPIN_CAP) { atomicAdd(&(bar)[XB_TMO], 1u); break; } } } } while (0)
struct XcdBarrier { unsigned* bar; unsigned x; volatile LAS unsigned* st; };
__device__ __forceinline__ XcdBarrier xcd_barrier_post(unsigned* bar, volatile LAS unsigned* st) {
    XcdBarrier b; b.bar = bar; b.x = xb_xcc_id(); b.st = st;
    if (threadIdx.x == 0) (void)xb_add(&bar[XB_XCNT(b.x)], 1u);
    return b;
}
__device__ __forceinline__ void xcd_barrier_complete(unsigned* bar, unsigned x, unsigned& nloc, unsigned& nx) {
    const unsigned G = gridDim.x * gridDim.y * gridDim.z;
    unsigned sum, cnt, mine, sp = 0u;
    for (;;) {
        sum = 0u; cnt = 0u; mine = 0u;
#pragma unroll
        for (unsigned j = 0; j < 16; ++j) { const unsigned c = xb_ld(&bar[XB_XCNT(j)]); sum += c; cnt += (c > 0u) ? 1u : 0u; mine = (j == x) ? c : mine; }
        if (sum == G) break;
        __builtin_amdgcn_s_sleep(1);
        if ((++sp & 255u) == 0u) { if (xb_ld(&bar[XB_TMO])) break; if (sp > XB_SPIN_CAP) { atomicAdd(&bar[XB_TMO], 1u); break; } }
    }
    nloc = mine > 0u ? mine : 1u; nx = cnt > 0u ? cnt : 1u;
}
__device__ __forceinline__ void xcd_barrier(const XcdBarrier& b) {
    asm volatile("s_waitcnt vmcnt(0)" ::: "memory");
    __syncthreads();
    if (threadIdx.x == 0) {
        unsigned* bar = b.bar;
        __builtin_amdgcn_s_waitcnt(0);
        unsigned nloc = b.st[0], nx = b.st[1];
        if (nloc == 0u) { xcd_barrier_complete(bar, b.x, nloc, nx); b.st[0] = nloc; b.st[1] = nx; }
        const unsigned old = xb_add(&bar[XB_XSUB(b.x)], 1u);
        const unsigned gen = old / nloc;
        if (old + 1u == (gen + 1u) * nloc) {
            __builtin_amdgcn_fence(__ATOMIC_RELEASE, "agent");
            asm volatile("s_waitcnt vmcnt(0)" ::: "memory");
            const unsigned og = xb_add(&bar[XB_TOP], 1u);
            const unsigned tg = og / nx;
            if (og + 1u == (tg + 1u) * nx) xb_add(&bar[XB_TOPGEN], 1u);
            else XB_SPIN(xb_ld(&bar[XB_TOPGEN]) == tg, bar);
            __builtin_amdgcn_fence(__ATOMIC_ACQUIRE, "agent");
            xb_add(&bar[XB_XGEN(b.x)], 1u);
            asm volatile("s_waitcnt vmcnt(0)" ::: "memory");
        } else {
            XB_SPIN(xb_ld(&bar[XB_XGEN(b.x)]) == gen, bar);
            __builtin_amdgcn_fence(__ATOMIC_ACQUIRE, "agent");
            asm volatile("s_waitcnt vmcnt(0)" ::: "memory");
        }
    }
    __syncthreads();
}

constexpr size_t MiB = 1u << 20;
constexpr size_t WS_CTL = 0, CTL_ZERO_BYTES = 1 * MiB;
constexpr size_t WS_MOD = 1 * MiB;
constexpr size_t WS_TABA = 2 * MiB;
constexpr size_t WS_TABM = 3 * MiB;
constexpr size_t WS_WGU = 4 * MiB;
constexpr size_t WS_WDN = 20 * MiB;
constexpr size_t WS_WMIX = 28 * MiB;
constexpr size_t WS_X = 52 * MiB;
constexpr size_t WS_H = 188 * MiB;
constexpr size_t WS_SCR = 256 * MiB;
constexpr size_t WS_END = 512 * MiB;
constexpr size_t MOE_ACT = WS_SCR;
constexpr size_t MOE_SL = WS_SCR + 48 * MiB;
constexpr size_t MOE_WT = WS_SCR + 52 * MiB;
constexpr int CW_BAR = 4096;
constexpr int CW_MOECNT = 16384;
constexpr int CW_POISON = 20000;

constexpr int RING_BYTES = 131072;
constexpr int LDS_MISC = RING_BYTES;
constexpr int LDS_TB = RING_BYTES + 512;
constexpr int LDS_TBL = RING_BYTES + 1024;
constexpr int LDS_BYTES = RING_BYTES + 1024 + 16384;

struct Frame {
    LAS unsigned char* lds;
    unsigned* ctl;
    unsigned char* ws;
    float* out;
    int tid, lane, wave, vcu;
};

__device__ __forceinline__ void refresh(Frame& F) { F.tid = opaque_tid(); F.lane = F.tid & 63; F.wave = __builtin_amdgcn_readfirstlane(F.tid >> 6); }
#if defined(PROBE_BAR2)
#define SYNC_GRID() do { xcd_barrier(bar); xcd_barrier(bar); refresh(F); } while (0)
#else
#define SYNC_GRID() do { xcd_barrier(bar); refresh(F); } while (0)
#endif
__device__ __forceinline__ int modrow_of(int row) { const int b = row / TPB, t = row - b * TPB; return t < CTX ? 8 : b; }

enum { MAP_ID = 0, MAP_ATTN_IN, MAP_SSM_IN, MAP_MLA_IN, MAP_MLA_QUP, MAP_MOE_G, MAP_MOE_U };
template <int KIND> __device__ __forceinline__ int map_row(int n, int aux) {
    if (KIND == MAP_ID) return aux + n;
    if (KIND == MAP_ATTN_IN) { if (n >= 1280) return n; const int hb = n & ~63, d = n & 63; return hb + (d < 32 ? 2 * d : 2 * (d - 32) + 1); }
    if (KIND == MAP_SSM_IN) {
        if (n < 2048) { const int gp = n >> 10; return gp * 2816 + (n & 1023); }
        if (n < 4096) { const int c = n - 2048, gp = c >> 10; return gp * 2816 + 1024 + (c & 1023); }
        if (n < 4608) { const int c = n - 4096, gp = c >> 8; return gp * 2816 + 2048 + (c & 255); }
        if (n < 5120) { const int c = n - 4608, gp = c >> 8; return gp * 2816 + 2304 + (c & 255); }
        { const int c = n - 5120, dir = c >> 5, h = c & 31, gp = h >> 4; return gp * 2816 + 2560 + dir * 16 + (h & 15); }
    }
    if (KIND == MAP_MLA_IN) { if (n < 512) return n; const int d = n - 512; return 512 + (d < 16 ? 2 * d : 2 * (d - 16) + 1); }
    if (KIND == MAP_MLA_QUP) { const int h = n / 96, e = n - h * 96; if (e < 64) return n; const int d = e - 64; return h * 96 + 64 + (d < 16 ? 2 * d : 2 * (d - 16) + 1); }
    if (KIND == MAP_MOE_G) return aux + (n >> 7) * 256 + (n & 127);
    if (KIND == MAP_MOE_U) return aux + (n >> 7) * 256 + 128 + (n & 127);
    return n;
}
template <int KIND>
__device__ __forceinline__ void transpose_item(const float* W, int K, int N, bf16* WT, int aux, const float* kscale, LAS float* scr, int item, int lane) {
    const int nblk = N / 32, kb = item / nblk, nb = item % nblk, k0 = 64 * kb, n0 = 32 * nb;
#pragma unroll 8
    for (int i = 0; i < 32; ++i) { const int kk = 2 * i + (lane >> 5); float v = W[(size_t)(k0 + kk) * N + n0 + (lane & 31)]; if (kscale) v *= kscale[k0 + kk]; scr[kk * 33 + (lane & 31)] = v; }
    LDS_WAIT(); asm volatile("" ::: "memory");
    const int c = lane & 7;
#pragma unroll
    for (int j = 0; j < 4; ++j) { const int n = (lane >> 3) + 8 * j; const LAS float* s = scr + (8 * c) * 33 + n;
        v4u o; o.x = cvt_pk_bf16(s[0 * 33], s[1 * 33]); o.y = cvt_pk_bf16(s[2 * 33], s[3 * 33]); o.z = cvt_pk_bf16(s[4 * 33], s[5 * 33]); o.w = cvt_pk_bf16(s[6 * 33], s[7 * 33]);
        *(v4u*)(WT + (size_t)map_row<KIND>(n0 + n, aux) * K + k0 + 8 * c) = o; }
    LDS_WAIT(); asm volatile("" ::: "memory");
}
template <int KIND>
__device__ __forceinline__ void convert_matrix(Frame& F, const float* W, int K, int N, bf16* WT, int aux, const float* kscale) {
    LAS float* scr = (LAS float*)(F.lds + F.wave * 16384);
    const int gw = F.vcu * NWAVES + F.wave, NGW = GRID * NWAVES, nitems = (K / 64) * (N / 32);
    for (int it = gw; it < nitems; it += NGW) transpose_item<KIND>(W, K, N, WT, aux, kscale, scr, it, F.lane);
}
__device__ __forceinline__ void zero_rows(Frame& F, bf16* WT, int row0, int nrows, int K) {
    const size_t n16 = (size_t)nrows * K / 8; v4u* p = (v4u*)(WT + (size_t)row0 * K);
    for (size_t i = (size_t)blockIdx.x * NTHR + F.tid; i < n16; i += (size_t)GRID * NTHR) p[i] = (v4u){0u, 0u, 0u, 0u};
}
__device__ __forceinline__ void convert_moe(Frame& F, const float* const* in, int layer) {
    bf16* GU = (bf16*)(F.ws + WS_WGU); bf16* DN = (bf16*)(F.ws + WS_WDN);
    const float* wg = in[12] + (size_t)layer * 16 * 1024 * 256; const float* wu = in[13] + (size_t)layer * 16 * 1024 * 256; const float* wd = in[14] + (size_t)layer * 16 * 256 * 1024;
    LAS float* scr = (LAS float*)(F.lds + F.wave * 16384);
    const int gw = F.vcu * NWAVES + F.wave, NGW = GRID * NWAVES;
    for (int it = gw; it < 16 * 384; it += NGW) { const int e = it / 384, r = it - e * 384, kind = r >> 7, sub = r & 127;
        if (kind == 0) transpose_item<MAP_MOE_G>(wg + (size_t)e * 1024 * 256, 1024, 256, GU, e * 512, nullptr, scr, sub, F.lane);
        else if (kind == 1) transpose_item<MAP_MOE_U>(wu + (size_t)e * 1024 * 256, 1024, 256, GU, e * 512, nullptr, scr, sub, F.lane);
        else transpose_item<MAP_ID>(wd + (size_t)e * 256 * 1024, 256, 1024, DN, e * 1024, nullptr, scr, sub, F.lane); }
}

__device__ __forceinline__ const float* src_row(const float* const* in, int r) { const int b = r / TPB, t = r - b * TPB; return t < CTX ? in[2] + ((size_t)b * CTX + t) * D : in[0] + ((size_t)b * SEQ + (t - CTX)) * D; }
__device__ __forceinline__ float row_load_ss(const float* xrow, int lane, f32x4 (&v)[4]) {
    const f32x4* xr = (const f32x4*)xrow + lane; float s = 0.f;
#pragma unroll
    for (int j = 0; j < 4; ++j) { v[j] = xr[64 * j]; s += (v[j].x * v[j].x + v[j].y * v[j].y) + (v[j].z * v[j].z + v[j].w * v[j].w); }
    return s;
}
__device__ __forceinline__ void row_finish(const f32x4 (&v)[4], float ss, const float* g, const float* sc, const float* sh, bf16* orow, int lane, f32x4 (&hv)[4]) {
    const float rstd = rsqrtf(ss * (1.f / D) + EPS);
    unsigned long long* o8 = (unsigned long long*)orow + lane;
#pragma unroll
    for (int j = 0; j < 4; ++j) {
        const f32x4 gg = ((const f32x4*)g)[lane + 64 * j], ss4 = ((const f32x4*)sc)[lane + 64 * j], hh = ((const f32x4*)sh)[lane + 64 * j];
        f32x4 h = v[j] * rstd * gg * (ss4 + 1.0f) + hh; hv[j] = h;
        o8[64 * j] = (unsigned long long)cvt_pk_bf16(h.x, h.y) | ((unsigned long long)cvt_pk_bf16(h.z, h.w) << 32);
    }
}
__device__ __forceinline__ void phase_norm1(Frame& F, const float* const* in, int layer) {
    const float* X = (const float*)(F.ws + WS_X); bf16* H = (bf16*)(F.ws + WS_H);
    const float* g = in[4] + layer * D; const float* mod = (const float*)(F.ws + WS_MOD) + (size_t)layer * 9 * 6144;
    const int gw = F.vcu * NWAVES + F.wave, NGW = GRID * NWAVES;
    for (int r = gw; r < M; r += 2 * NGW) { const int r2 = r + NGW; const bool two = r2 < M; f32x4 va[4], vb[4], hv[4];
        float sa = row_load_ss(layer == 0 ? src_row(in, r) : X + (size_t)r * D, F.lane, va), sb = 0.f;
        if (two) sb = row_load_ss(layer == 0 ? src_row(in, r2) : X + (size_t)r2 * D, F.lane, vb);
        sa = wave_sum(sa); sb = wave_sum(sb);
        { const float* mr = mod + (size_t)modrow_of(r) * 6144; row_finish(va, sa, g, mr + 1024, mr, H + (size_t)r * D, F.lane, hv); }
        if (two) { const float* mr = mod + (size_t)modrow_of(r2) * 6144; row_finish(vb, sb, g, mr + 1024, mr, H + (size_t)r2 * D, F.lane, hv); } }
}

__device__ __forceinline__ void phase_prologue(Frame& F, const float* const* in) {
    { f32x2* TA = (f32x2*)(F.ws + WS_TABA); f32x2* TM = (f32x2*)(F.ws + WS_TABM);
      for (int i = blockIdx.x * NTHR + F.tid; i < SEQ * 32; i += GRID * NTHR) { const int pos = i >> 5, a = i & 31; const float p = (a < 16) ? (float)(pos >> 6) : (float)(pos & 63);
          const float inv = fast_exp2(-(float)(a & 15) * (13.287712379549449f / 16.0f)); const float rev = p * inv * 0.15915494309189535f; TA[i] = (f32x2){__builtin_amdgcn_cosf(rev), __builtin_amdgcn_sinf(rev)}; }
      for (int i = blockIdx.x * NTHR + F.tid; i < SEQ * 16; i += GRID * NTHR) { const int pos = i >> 4, a = i & 15; const float p = (a < 8) ? (float)(pos >> 6) : (float)(pos & 63);
          const float inv = fast_exp2(-(float)(a & 7) * (13.287712379549449f / 8.0f)); const float rev = p * inv * 0.15915494309189535f; TM[i] = (f32x2){__builtin_amdgcn_cosf(rev), __builtin_amdgcn_sinf(rev)}; } }
    { LAS float* sc = (LAS float*)F.lds;
      LAS float* part = (LAS float*)(F.lds + 40960);
      for (int i = F.tid; i < 9 * 1024; i += NTHR) { const int r = i >> 10, k = i & 1023; const float c = r < 8 ? in[1][r * 1024 + k] : in[3][k]; sc[i] = silu_f(c); }
      __syncthreads();
      float* MOD = (float*)(F.ws + WS_MOD);
      const int cq = F.tid & 15, ks = F.tid >> 4;
      for (int u = F.vcu; u < 4 * 96; u += GRID) { const int l = u / 96, cb = u % 96;
          const float* w = in[6] + (size_t)l * 1024 * 6144 + cb * 64 + cq * 4; f32x4 a[9];
#pragma unroll
          for (int r = 0; r < 9; ++r) a[r] = (f32x4){0.f, 0.f, 0.f, 0.f};
#pragma unroll 8
          for (int k = ks * 32; k < ks * 32 + 32; ++k) { const f32x4 wv = *(const f32x4*)(w + (size_t)k * 6144);
#pragma unroll
              for (int r = 0; r < 9; ++r) a[r] = a[r] + wv * sc[r * 1024 + k]; }
#pragma unroll
          for (int r = 0; r < 9; ++r) *(LAS f32x4*)(part + (ks * 9 + r) * 64 + cq * 4) = a[r];
          __syncthreads();
          for (int i = F.tid; i < 9 * 64; i += NTHR) { const int r = i >> 6, c = i & 63; float s = 0.f;
#pragma unroll
              for (int q = 0; q < 32; ++q) s += part[(q * 9 + r) * 64 + c];
              MOD[((size_t)l * 9 + r) * 6144 + cb * 64 + c] = s + in[7][l * 6144 + cb * 64 + c]; }
          __syncthreads(); } }
}

__device__ __forceinline__ void phase_norm2_route(Frame& F, const float* const* in, int layer, bool dry = false) {
    constexpr int RPW = M / GRID;
    LAS float* wl = (LAS float*)F.lds;
    LAS int* lcnt = (LAS int*)(F.lds + 81920);
    LAS int* lbase = (LAS int*)(F.lds + 81920 + 128);
    LAS int* rcls = (LAS int*)(F.lds + 81920 + 256);
    LAS int* rrank = (LAS int*)(F.lds + 81920 + 256 + 1024);
    LAS float* lgw = (LAS float*)(F.lds + 81920 + 4096);
    const float* wrg = in[8] + (size_t)layer * 1024 * 4; const float* wre = in[10] + (size_t)layer * 1024 * 16;
    for (int i = F.tid; i < 1024 * 4; i += NTHR) { const int k = i >> 2, o = i & 3; wl[o * 1024 + k] = wrg[i]; }
    for (int i = F.tid; i < 1024 * 16; i += NTHR) { const int k = i >> 4, o = i & 15; wl[(4 + o) * 1024 + k] = wre[i]; }
    if (F.tid < 24) lcnt[F.tid] = 0;
    __syncthreads();
    const float* X = (const float*)(F.ws + WS_X); bf16* H = (bf16*)(F.ws + WS_H);
    const float* g = in[5] + layer * D; const float* mod = (const float*)(F.ws + WS_MOD) + (size_t)layer * 9 * 6144;
    const float* brg = in[9] + layer * 4; const float* bre = in[11] + layer * 16;
    float* WT = (float*)(F.ws + MOE_WT); int* SL = (int*)(F.ws + MOE_SL);
    const int row0 = blockIdx.x * RPW;
    for (int i0 = F.wave; i0 < RPW; i0 += 2 * NWAVES) { const int i1 = i0 + NWAVES; const bool two = i1 < RPW; const int ra = row0 + i0, rb = two ? row0 + i1 : ra;
        f32x4 va[4], vb[4], ha[4], hb[4];
        float sa = row_load_ss(X + (size_t)ra * D, F.lane, va), sb = row_load_ss(X + (size_t)rb * D, F.lane, vb);
        sa = wave_sum(sa); sb = wave_sum(sb);
        { const float* mr = mod + (size_t)modrow_of(ra) * 6144; row_finish(va, sa, g, mr + 4 * 1024, mr + 3 * 1024, H + (size_t)ra * D, F.lane, ha); }
        { const float* mr = mod + (size_t)modrow_of(rb) * 6144; row_finish(vb, sb, g, mr + 4 * 1024, mr + 3 * 1024, H + (size_t)rb * D, F.lane, hb); }
        LAS float* lgs = lgw + F.wave * 64;
        for (int o = 0; o < 20; ++o) { float s = 0.f, t = 0.f;
#pragma unroll
            for (int j = 0; j < 4; ++j) { const f32x4 w = *(const LAS f32x4*)(wl + o * 1024 + 4 * F.lane + 256 * j);
                s += (ha[j].x * w.x + ha[j].y * w.y) + (ha[j].z * w.z + ha[j].w * w.w); t += (hb[j].x * w.x + hb[j].y * w.y) + (hb[j].z * w.z + hb[j].w * w.w); }
            s = wave_sum(s); t = wave_sum(t); if (F.lane == 0) { lgs[o] = s; lgs[32 + o] = t; } }
        LDS_WAIT(); asm volatile("" ::: "memory");
        for (int q = 0; q < (two ? 2 : 1); ++q) { const LAS float* lq_ = lgs + 32 * q; const int r = q ? rb : ra, i = q ? i1 : i0;
        float g0 = lq_[0] + brg[0], g1 = lq_[1] + brg[1], g2 = lq_[2] + brg[2], g3 = lq_[3] + brg[3];
        int gs = 0; float gm = g0; if (g1 > gm) { gm = g1; gs = 1; } if (g2 > gm) { gm = g2; gs = 2; } if (g3 > gm) { gm = g3; gs = 3; }
        const float pg = 1.0f / (fast_exp(g0 - gm) + fast_exp(g1 - gm) + fast_exp(g2 - gm) + fast_exp(g3 - gm));
        float e0 = lq_[4 + gs * 4 + 0] + bre[gs * 4 + 0], e1 = lq_[4 + gs * 4 + 1] + bre[gs * 4 + 1], e2 = lq_[4 + gs * 4 + 2] + bre[gs * 4 + 2], e3 = lq_[4 + gs * 4 + 3] + bre[gs * 4 + 3];
        int i1x = 0; float v1 = e0; if (e1 > v1) { v1 = e1; i1x = 1; } if (e2 > v1) { v1 = e2; i1x = 2; } if (e3 > v1) { v1 = e3; i1x = 3; }
        int i2x = -1; float v2 = -3.0e38f;
        if (i1x != 0 && e0 > v2) { v2 = e0; i2x = 0; } if (i1x != 1 && e1 > v2) { v2 = e1; i2x = 1; } if (i1x != 2 && e2 > v2) { v2 = e2; i2x = 2; } if (i1x != 3 && e3 > v2) { v2 = e3; i2x = 3; }
        const float ex = fast_exp(v2 - v1), w1 = pg / (1.0f + ex), w2 = pg * ex / (1.0f + ex);
        const int lo = i1x < i2x ? i1x : i2x, hi = i1x < i2x ? i2x : i1x; const float wlo = i1x < i2x ? w1 : w2, whi = i1x < i2x ? w2 : w1;
        const int pair = lo == 0 ? hi - 1 : (lo == 1 ? hi + 1 : 5);
        const int cls = gs * 6 + pair;
        if (F.lane == 0 && !dry) { WT[2 * (size_t)r] = wlo; WT[2 * (size_t)r + 1] = whi; rcls[i] = cls; rrank[i] = atomicAdd((int*)&lcnt[cls], 1); }
        }
        LDS_WAIT(); asm volatile("" ::: "memory");
    }
    __syncthreads();
    if (dry) return;
    if (F.tid < 24) lbase[F.tid] = (int)atomicAdd(F.ctl + CW_MOECNT + layer * 64 + F.tid, (unsigned)lcnt[F.tid]);
    __syncthreads();
    for (int i = F.tid; i < RPW; i += NTHR) { const int c = rcls[i]; SL[(size_t)c * M + lbase[c] + rrank[i]] = row0 + i; }
}

__device__ __forceinline__ void phase_final(Frame& F, const float* const* in, bool poison) {
    const float* X = (const float*)(F.ws + WS_X); const float* g = in[36];
    const int gw = F.vcu * NWAVES + F.wave, NGW = GRID * NWAVES;
    for (int q = gw; q < NB * SEQ; q += 2 * NGW) { const int q2 = q + NGW;
        const int ra = (q / SEQ) * TPB + CTX + (q % SEQ), rb = (q2 / SEQ) * TPB + CTX + (q2 % SEQ); f32x4 va[4], vb[4];
        float sa = row_load_ss(X + (size_t)ra * D, F.lane, va), sb = row_load_ss(X + (size_t)rb * D, F.lane, vb);
        sa = wave_sum(sa); sb = wave_sum(sb);
        float rsa = rsqrtf(sa * (1.f / D) + EPS), rsb = rsqrtf(sb * (1.f / D) + EPS); if (poison) { rsa = __builtin_nanf(""); rsb = rsa; }
        f32x4* oa = (f32x4*)(F.out + (size_t)q * D) + F.lane; f32x4* ob = (f32x4*)(F.out + (size_t)q2 * D) + F.lane;
#pragma unroll
        for (int j = 0; j < 4; ++j) { const f32x4 gg = ((const f32x4*)g)[F.lane + 64 * j]; oa[64 * j] = va[j] * rsa * gg; ob[64 * j] = vb[j] * rsb * gg; } }
}
typedef f32x4 AccT[2][2][4][2];
using pg8::Unit;

__device__ __forceinline__ v4u pack8(const f32x4 a, const f32x4 b) { v4u w; w.x = cvt_pk_bf16(a[0], a[1]); w.y = cvt_pk_bf16(a[2], a[3]); w.z = cvt_pk_bf16(b[0], b[1]); w.w = cvt_pk_bf16(b[2], b[3]); return w; }
__device__ __forceinline__ void rope8(f32x4& a, f32x4& b, const f32x2* cs) {
    const f32x4 c01 = *(const f32x4*)cs, c23 = *(const f32x4*)(cs + 2);
    float t;
    t = a[0] * c01[0] - a[1] * c01[1]; a[1] = a[1] * c01[0] + a[0] * c01[1]; a[0] = t;
    t = a[2] * c01[2] - a[3] * c01[3]; a[3] = a[3] * c01[2] + a[2] * c01[3]; a[2] = t;
    t = b[0] * c23[0] - b[1] * c23[1]; b[1] = b[1] * c23[0] + b[0] * c23[1]; b[0] = t;
    t = b[2] * c23[2] - b[3] * c23[3]; b[3] = b[3] * c23[2] + b[2] * c23[3]; b[2] = t;
}

struct EpiResid {
    static constexpr bool PERM = false;
    float* X; const float* gate; const float* x_in; const float* ctx_in;
    __device__ __forceinline__ void operator()(const AccT& acc, const Unit& u, int ui, int wr, int wc, int fr, int fq) const {
        const int tb = u.pm % 17, b = u.pm / 17; const float* gv = gate + (size_t)(tb == 0 ? 8 : b) * 6144;
        const float* src = x_in ? (tb == 0 ? ctx_in + (size_t)b * CTX * D : x_in + ((size_t)b * SEQ + (tb - 1) * 256) * D) - (size_t)u.pm * 256 * D : X;
        const int row0 = u.pm * 256 + wr * 64 + fr, col0 = u.pn * 256 + wc * 32 + 4 * fq;
        f32x4 g4[2][2];
#pragma unroll
        for (int bj = 0; bj < 2; ++bj)
#pragma unroll
            for (int n = 0; n < 2; ++n) g4[bj][n] = *(const f32x4*)(gv + col0 + bj * 128 + n * 16);
#pragma unroll
        for (int ai = 0; ai < 2; ++ai)
#pragma unroll
            for (int m = 0; m < 4; ++m) { float* rowp = X + (size_t)(row0 + ai * 128 + m * 16) * D + col0;
#pragma unroll
                for (int bj = 0; bj < 2; ++bj)
#pragma unroll
                    for (int n = 0; n < 2; ++n) { f32x4* p = (f32x4*)(rowp + bj * 128 + n * 16); const f32x4* s = (const f32x4*)(src + (p - (f32x4*)X) * 4); *p = *s + g4[bj][n] * acc[ai][bj][m][n]; }
                asm volatile("" ::: "memory"); }
    }
};

struct EpiAttnIn {
    static constexpr bool PERM = true;
    bf16 *Q, *Kb, *Vb; const f32x2* tab; float qscale;
    __device__ __forceinline__ void operator()(const AccT& acc, const Unit& u, int ui, int wr, int wc, int fr, int fq) const {
        const int tb = u.pm % 17; const bool lat = tb != 0; const int pos0 = (tb - 1) * 256;
        bf16* base; int ld, colt; float sc = 1.f; bool rope = lat;
        if (u.pn < 4) { base = Q; ld = 1024; colt = u.pn * 256; sc = qscale; } else if (u.pn == 4) { base = Kb; ld = 256; colt = 0; } else { base = Vb; ld = 256; colt = 0; rope = false; }
#pragma unroll
        for (int ai = 0; ai < 2; ++ai)
#pragma unroll
            for (int m = 0; m < 4; ++m) { const int rl = ai * 128 + wr * 64 + m * 16 + fr; const size_t row = (size_t)u.pm * 256 + rl;
#pragma unroll
                for (int bj = 0; bj < 2; ++bj) { const int cl = bj * 128 + wc * 32 + 8 * fq;
                    f32x4 a = acc[ai][bj][m][0] * sc, b = acc[ai][bj][m][1] * sc;
                    if (rope) rope8(a, b, tab + (size_t)(pos0 + rl) * 32 + ((cl & 63) >> 1));
                    *(v4u*)(base + row * ld + colt + cl) = pack8(a, b); }
                asm volatile("" ::: "memory"); }
    }
};

struct EpiSsmIn {
    static constexpr bool PERM = true;
    bf16 *Z, *XBC; float* DT; const float* dtb;
    __device__ __forceinline__ void operator()(const AccT& acc, const Unit& u, int ui, int wr, int wc, int fr, int fq) const {
#pragma unroll
        for (int ai = 0; ai < 2; ++ai)
#pragma unroll
            for (int m = 0; m < 4; ++m) { const size_t row = (size_t)u.pm * 256 + ai * 128 + wr * 64 + m * 16 + fr;
#pragma unroll
                for (int bj = 0; bj < 2; ++bj) { const int c = u.pn * 256 + bj * 128 + wc * 32 + 8 * fq;
                    const f32x4 a = acc[ai][bj][m][0], b = acc[ai][bj][m][1];
                    if (c < 1024) *(v4u*)(Z + row * 1024 + c) = pack8(a, b);
                    else if (c < 2560) *(v4u*)(XBC + row * 1536 + (c - 1024)) = pack8(a, b);
                    else if (c < 2592) { const int cc = c - 2560; f32x4 o0, o1;
#pragma unroll
                        for (int j = 0; j < 4; ++j) { o0[j] = softplus_f(a[j] + dtb[(cc >> 4) * 32 + (cc & 15) + j]); o1[j] = softplus_f(b[j] + dtb[(cc >> 4) * 32 + (cc & 15) + 4 + j]); }
                        *(f32x4*)(DT + row * 32 + cc) = o0; *(f32x4*)(DT + row * 32 + cc + 4) = o1; } } }
    }
};

struct EpiMlIn {
    static constexpr bool PERM = true;
    bf16 *Qm, *Km, *Vm, *Om; float* G; const float* gb;
    __device__ __forceinline__ void operator()(const AccT& acc, const Unit& u, int ui, int wr, int wc, int fr, int fq) const {
#pragma unroll
        for (int ai = 0; ai < 2; ++ai)
#pragma unroll
            for (int m = 0; m < 4; ++m) { const size_t row = (size_t)u.pm * 256 + ai * 128 + wr * 64 + m * 16 + fr;
#pragma unroll
                for (int bj = 0; bj < 2; ++bj) { const int c = u.pn * 256 + bj * 128 + wc * 32 + 8 * fq;
                    const f32x4 a = acc[ai][bj][m][0], b = acc[ai][bj][m][1];
                    if (c < 512) *(v4u*)(Qm + row * 512 + c) = pack8(a, b);
                    else if (c < 1024) *(v4u*)(Km + row * 512 + (c - 512)) = pack8(a * 0.125f, b * 0.125f);
                    else if (c < 2048) *(v4u*)(Vm + row * 1024 + (c - 1024)) = pack8(a, b);
                    else if (c < 3072) *(v4u*)(Om + row * 1024 + (c - 2048)) = pack8(a, b);
                    else if (c < 3104) { const int cc = c - 3072; f32x4 o0, o1; const bool fg = ((cc >> 3) & 1) != 0;
#pragma unroll
                        for (int j = 0; j < 4; ++j) { float x0 = a[j] + gb[cc + j], x1 = b[j] + gb[cc + 4 + j];
                            o0[j] = fg ? -softplus_f(-x0) : x0; o1[j] = fg ? -softplus_f(-x1) : x1; }
                        *(f32x4*)(G + row * 32 + cc) = o0; *(f32x4*)(G + row * 32 + cc + 4) = o1; } } }
    }
};

struct EpiMlaIn {
    static constexpr bool PERM = true;
    bf16 *CQ, *CKV, *KF; float* SSQ; const f32x2* tab;
    __device__ __forceinline__ void operator()(const AccT& acc, const Unit& u, int ui, int wr, int wc, int fr, int fq) const {
        const int tb = u.pm % 17; const bool lat = tb != 0; const int pos0 = (tb - 1) * 256;
#pragma unroll
        for (int ai = 0; ai < 2; ++ai)
#pragma unroll
            for (int m = 0; m < 4; ++m) { const int rl = ai * 128 + wr * 64 + m * 16 + fr; const size_t row = (size_t)u.pm * 256 + rl;
                if (u.pn < 2) { bf16* dst = u.pn == 0 ? CQ : CKV; float ss = 0.f;
#pragma unroll
                    for (int bj = 0; bj < 2; ++bj) { const int c = bj * 128 + wc * 32 + 8 * fq; const f32x4 a = acc[ai][bj][m][0], b = acc[ai][bj][m][1];
                        ss += (a[0] * a[0] + a[1] * a[1]) + (a[2] * a[2] + a[3] * a[3]) + (b[0] * b[0] + b[1] * b[1]) + (b[2] * b[2] + b[3] * b[3]);
                        *(v4u*)(dst + row * 256 + c) = pack8(a, b); }
                    ss += __shfl_xor(ss, 16); ss += __shfl_xor(ss, 32);
                    if (fq == 0) SSQ[row * 8 + u.pn * 4 + wc] = ss;
                } else if (wc == 0) {
                    f32x4 a = acc[ai][0][m][0], b = acc[ai][0][m][1]; const int cl = 8 * fq;
                    if (lat) rope8(a, b, tab + (size_t)(pos0 + rl) * 16 + (cl >> 1));
                    const v4u w = pack8(a, b);
#pragma unroll
                    for (int h = 0; h < 16; ++h) *(v4u*)(KF + row * 1536 + h * 96 + 64 + cl) = w; }
                asm volatile("" ::: "memory"); }
    }
};
struct EpiMlaQ {
    static constexpr bool PERM = true;
    bf16* Q3; const float* SSQ; const f32x2* tab; float qscale;
    __device__ __forceinline__ void operator()(const AccT& acc, const Unit& u, int ui, int wr, int wc, int fr, int fq) const {
        const int tb = u.pm % 17; const bool lat = tb != 0; const int pos0 = (tb - 1) * 256;
#pragma unroll
        for (int ai = 0; ai < 2; ++ai)
#pragma unroll
            for (int m = 0; m < 4; ++m) { const int rl = ai * 128 + wr * 64 + m * 16 + fr; const size_t row = (size_t)u.pm * 256 + rl;
                const f32x4 s4 = *(const f32x4*)(SSQ + row * 8); const float rs = rsqrtf(((s4[0] + s4[1]) + (s4[2] + s4[3])) * (1.f / 256.f) + EPS) * qscale;
#pragma unroll
                for (int bj = 0; bj < 2; ++bj) { const int c = u.pn * 256 + bj * 128 + wc * 32 + 8 * fq; const int e = c % 96;
                    f32x4 a = acc[ai][bj][m][0] * rs, b = acc[ai][bj][m][1] * rs;
                    if (lat && e >= 64) rope8(a, b, tab + (size_t)(pos0 + rl) * 16 + ((e - 64) >> 1));
                    *(v4u*)(Q3 + row * 1536 + c) = pack8(a, b); }
                asm volatile("" ::: "memory"); }
    }
};
struct EpiMlaKV {
    static constexpr bool PERM = true;
    bf16 *KF, *V3; const float* SSQ;
    __device__ __forceinline__ void operator()(const AccT& acc, const Unit& u, int ui, int wr, int wc, int fr, int fq) const {
#pragma unroll
        for (int ai = 0; ai < 2; ++ai)
#pragma unroll
            for (int m = 0; m < 4; ++m) { const size_t row = (size_t)u.pm * 256 + ai * 128 + wr * 64 + m * 16 + fr;
                const f32x4 s4 = *(const f32x4*)(SSQ + row * 8 + 4); const float rs = rsqrtf(((s4[0] + s4[1]) + (s4[2] + s4[3])) * (1.f / 256.f) + EPS);
#pragma unroll
                for (int bj = 0; bj < 2; ++bj) { const int c = u.pn * 256 + bj * 128 + wc * 32 + 8 * fq; const int h = c >> 7, e = c & 127;
                    const v4u w = pack8(acc[ai][bj][m][0] * rs, acc[ai][bj][m][1] * rs);
                    if (e < 64) *(v4u*)(KF + row * 1536 + h * 96 + e) = w; else *(v4u*)(V3 + row * 1024 + h * 64 + (e - 64)) = w; }
                asm volatile("" ::: "memory"); }
    }
};

struct TblEnt { int tok; float w0, w1; int pad; };
__device__ __forceinline__ int cls_expert(int cls, int which) { const int g = cls / 6, p = cls - g * 6; const int lo = p < 3 ? 0 : (p < 5 ? 1 : 2), hi = p < 3 ? p + 1 : (p < 5 ? p - 1 : 3); return g * 4 + (which ? hi : lo); }
template <int MODE> struct MoeOrder {
    static constexpr bool GATHER = (MODE == 0);
    const LAS int* tb;
    const LAS TblEnt* tbl;
    const bf16* W; int G, c;
    __device__ __forceinline__ bool next(int i, Unit& u) const {
        const int L = i * G + c, tile = L >> 2; if (tile >= tb[24]) return false;
        int cls = 0;
#pragma unroll
        for (int k = 1; k < 24; ++k) cls += (tile >= tb[k]) ? 1 : 0;
        u.pm = tile; u.pn = L & 3; u.aux = cls | (i << 8); return true;
    }
    __device__ __forceinline__ int a_row(const Unit& u, int r) const {
        if (MODE == 1) return u.pm * 256 + r;
        const int t = tbl[(u.aux >> 8) * 256 + r].tok; return t < 0 ? 0 : t;
    }
    __device__ __forceinline__ const char* b_seg(const Unit& u, int seg) const {
        const int cls = u.aux & 255;
        if (MODE == 0) return (const char*)(W + ((size_t)cls_expert(cls, u.pn >> 1) * 512 + (u.pn & 1) * 256) * 1024);
        return (const char*)(W + ((size_t)cls_expert(cls, seg) * 1024 + u.pn * 256) * 256);
    }
};
template <int MODE> __device__ __forceinline__ void moe_setup(Frame& F, int layer, MoeOrder<MODE>& S) {
    LAS int* tb = (LAS int*)(F.lds + LDS_TB); LAS int* cn = tb + 32; LAS TblEnt* tbl = (LAS TblEnt*)(F.lds + LDS_TBL);
    if (F.tid == 0) { int t = 0; for (int k = 0; k < 24; ++k) { const int n = (int)__hip_atomic_load(F.ctl + CW_MOECNT + layer * 64 + k, RLX_AGENT); cn[k] = n; tb[k] = t; t += (n + 255) >> 8; } tb[24] = t; }
    __syncthreads();
    S.tb = tb; S.tbl = tbl;
    const int* SL = (const int*)(F.ws + MOE_SL); const float* WT = (const float*)(F.ws + MOE_WT);
    for (int i = 0; i < 4; ++i) { Unit u; if (!S.next(i, u)) break;
        if (F.tid < 256) { const int cls = u.aux & 255, idx = (u.pm - tb[cls]) * 256 + F.tid; TblEnt e; e.pad = 0;
            if (idx < cn[cls]) { e.tok = SL[(size_t)cls * M + idx]; e.w0 = WT[2 * (size_t)e.tok]; e.w1 = WT[2 * (size_t)e.tok + 1]; } else { e.tok = -1; e.w0 = 0.f; e.w1 = 0.f; }
            LAS TblEnt* te = tbl + i * 256 + F.tid; te->tok = e.tok; te->w0 = e.w0; te->w1 = e.w1; te->pad = 0; } }
    __syncthreads();
}
struct EpiMoeAct {
    static constexpr bool PERM = true;
    bf16* ACT; const LAS TblEnt* tbl;
    __device__ __forceinline__ void operator()(const AccT& acc, const Unit& u, int ui, int wr, int wc, int fr, int fq) const {
        const int slot = u.pn >> 1, colb = slot * 256 + (u.pn & 1) * 128 + wc * 32 + 8 * fq;
#pragma unroll
        for (int ai = 0; ai < 2; ++ai)
#pragma unroll
            for (int m = 0; m < 4; ++m) { const int rl = ai * 128 + wr * 64 + m * 16 + fr; const LAS TblEnt* te = tbl + (u.aux >> 8) * 256 + rl; const float w = slot ? te->w1 : te->w0;
                f32x4 a, b;
#pragma unroll
                for (int j = 0; j < 4; ++j) { a[j] = silu_f(acc[ai][0][m][0][j]) * acc[ai][1][m][0][j] * w; b[j] = silu_f(acc[ai][0][m][1][j]) * acc[ai][1][m][1][j] * w; }
                *(v4u*)(ACT + ((size_t)u.pm * 256 + rl) * 512 + colb) = pack8(a, b);
                asm volatile("" ::: "memory"); }
    }
};
struct EpiMoeDown {
    static constexpr bool PERM = false;
    float* X; const float* gate; const LAS TblEnt* tbl;
    __device__ __forceinline__ void operator()(const AccT& acc, const Unit& u, int ui, int wr, int wc, int fr, int fq) const {
        const int col0 = u.pn * 256 + wc * 32 + 4 * fq;
#pragma unroll
        for (int ai = 0; ai < 2; ++ai)
#pragma unroll
            for (int m = 0; m < 4; ++m) { const int rl = ai * 128 + wr * 64 + m * 16 + fr; const int tok = tbl[(u.aux >> 8) * 256 + rl].tok;
                if (tok >= 0) { float* rowp = X + (size_t)tok * D + col0; const float* gv = gate + (size_t)modrow_of(tok) * 6144 + col0;
#pragma unroll
                    for (int bj = 0; bj < 2; ++bj)
#pragma unroll
                        for (int n = 0; n < 2; ++n) { f32x4* p = (f32x4*)(rowp + bj * 128 + n * 16); *p = *p + *(const f32x4*)(gv + bj * 128 + n * 16) * acc[ai][bj][m][n]; } }
                asm volatile("" ::: "memory"); }
    }
};
template <int DQK, bool WIN>
__device__ __forceinline__ void flash_unit(LAS unsigned char* lds, const int tid, const int lane, const int grpB,
        const bf16* Kg, const int ldk, const bf16* Vg, const int ldv,
        const bf16* Qg, const int ldq, bf16* Og, const int ldo,
        const int ntiles, const int krow_ctx0, const int krow_lat0, const int kpos0, const int qpos_wave, const float sink2, const bool has_sink) {
    constexpr int KSTR = DQK * 2 + 16, VSTR = 160, KBUF = 64 * KSTR, VBUF = 64 * VSTR, CPR = DQK / 8, NKC = 64 * CPR, NKR = (NKC + 511) / 512, NKS = DQK / 32;
    LAS unsigned char* Kl = lds; LAS unsigned char* Vl = lds + 2 * KBUF;
    const int fr = lane & 15, fq = lane >> 4;
    bf16x8 qf[2][NKS];
#pragma unroll
    for (int qt = 0; qt < 2; ++qt)
#pragma unroll
        for (int ks = 0; ks < NKS; ++ks) qf[qt][ks] = *(const bf16x8*)(Qg + (size_t)(16 * qt + fr) * ldq + 32 * ks + 8 * fq);
    f32x4 oacc[4][2];
#pragma unroll
    for (int c = 0; c < 4; ++c) { oacc[c][0] = (f32x4){0.f, 0.f, 0.f, 0.f}; oacc[c][1] = (f32x4){0.f, 0.f, 0.f, 0.f}; }
    float mrun[2] = {-1.0e30f, -1.0e30f}, lsum[2] = {0.f, 0.f};
    v4u kreg[NKR], vreg;
    bf16x8 pf[2][2]; bool pvalid = false; int pvb = 0;
#pragma unroll
    for (int a = 0; a < 2; ++a)
#pragma unroll
        for (int b2 = 0; b2 < 2; ++b2)
#pragma unroll
            for (int e = 0; e < 8; ++e) pf[a][b2][e] = 0;
#define FA_LOAD(j) do { const int _rb = (j) < 4 ? krow_ctx0 + 64 * (j) : krow_lat0 + 64 * ((j) - 4); \
        _Pragma("unroll") for (int _i = 0; _i < NKR; ++_i) { const int _c = tid + 512 * _i; if (_c < NKC) kreg[_i] = *(const v4u*)(Kg + (size_t)(_rb + _c / CPR) * ldk + (_c % CPR) * 8); } \
        vreg = *(const v4u*)(Vg + (size_t)(_rb + (tid >> 3)) * ldv + (tid & 7) * 8); } while (0)
#define FA_STORE(kb, vb) do { _Pragma("unroll") for (int _i = 0; _i < NKR; ++_i) { const int _c = tid + 512 * _i; if (_c < NKC) *(LAS v4u*)(Kl + (kb) * KBUF + (_c / CPR) * KSTR + (_c % CPR) * 16) = kreg[_i]; } \
        *(LAS v4u*)(Vl + (vb) * VBUF + (tid >> 3) * VSTR + (tid & 7) * 16) = vreg; } while (0)
#define FA_PV(vbuf) do { _Pragma("unroll") for (int ks2 = 0; ks2 < 2; ++ks2) _Pragma("unroll") for (int c = 0; c < 4; ++c) { \
            const LAS unsigned char* vb_ = Vl + (vbuf) * VBUF + (32 * ks2 + 4 * fq + ((lane & 15) >> 2)) * VSTR + (16 * c + 4 * (lane & 3)) * 2; \
            const s16x4 v0 = __builtin_amdgcn_ds_read_tr16_b64_v4i16((LAS s16x4*)vb_); const s16x4 v1 = __builtin_amdgcn_ds_read_tr16_b64_v4i16((LAS s16x4*)(vb_ + 16 * VSTR)); \
            bf16x8 vf; vf[0] = v0[0]; vf[1] = v0[1]; vf[2] = v0[2]; vf[3] = v0[3]; vf[4] = v1[0]; vf[5] = v1[1]; vf[6] = v1[2]; vf[7] = v1[3]; \
            oacc[c][0] = __builtin_amdgcn_mfma_f32_16x16x32_bf16(vf, pf[0][ks2], oacc[c][0], 0, 0, 0); \
            oacc[c][1] = __builtin_amdgcn_mfma_f32_16x16x32_bf16(vf, pf[1][ks2], oacc[c][1], 0, 0, 0); } } while (0)
    FA_LOAD(0); FA_STORE(0, 0); __syncthreads();
    int vcur = 0;
    for (int j = 0; j < ntiles; ++j) {
        const int kb = j & 1;
        if (j + 1 < ntiles) FA_LOAD(j + 1);
        if (grpB && pvalid) { __builtin_amdgcn_s_setprio(1); FA_PV(pvb); __builtin_amdgcn_s_setprio(0); }
        bool skip = false; const int kp = kpos0 + 64 * (j - 4);
        if (WIN && j >= 4) skip = (kp + 63 < qpos_wave - 128) || (kp > qpos_wave + 31 + 128);
        pvalid = !skip; pvb = vcur;
        if (!skip) {
            f32x4 sacc[4][2];
#pragma unroll
            for (int kt = 0; kt < 4; ++kt) { sacc[kt][0] = (f32x4){0.f, 0.f, 0.f, 0.f}; sacc[kt][1] = (f32x4){0.f, 0.f, 0.f, 0.f}; }
            __builtin_amdgcn_s_setprio(1);
#pragma unroll
            for (int ks = 0; ks < NKS; ++ks) { bf16x8 kf[4];
#pragma unroll
                for (int kt = 0; kt < 4; ++kt) kf[kt] = *(const LAS bf16x8*)(Kl + kb * KBUF + (16 * kt + fr) * KSTR + (32 * ks + 8 * fq) * 2);
#pragma unroll
                for (int kt = 0; kt < 4; ++kt) { sacc[kt][0] = __builtin_amdgcn_mfma_f32_16x16x32_bf16(kf[kt], qf[0][ks], sacc[kt][0], 0, 0, 0);
                                                 sacc[kt][1] = __builtin_amdgcn_mfma_f32_16x16x32_bf16(kf[kt], qf[1][ks], sacc[kt][1], 0, 0, 0); } }
            __builtin_amdgcn_s_setprio(0);
            if (WIN && j >= 4) {
#pragma unroll
                for (int kt = 0; kt < 4; ++kt)
#pragma unroll
                    for (int qt = 0; qt < 2; ++qt)
#pragma unroll
                        for (int jj = 0; jj < 4; ++jj) { const int d = (kp + 16 * kt + 4 * fq + jj) - (qpos_wave + 16 * qt + fr); if (d < -128 || d > 128) sacc[kt][qt][jj] = -1.0e30f; } }
#pragma unroll
            for (int qt = 0; qt < 2; ++qt) {
                float mx = sacc[0][qt][0];
#pragma unroll
                for (int kt = 0; kt < 4; ++kt)
#pragma unroll
                    for (int jj = 0; jj < 4; ++jj) mx = fmaxf(mx, sacc[kt][qt][jj]);
                mx = fmaxf(mx, __shfl_xor(mx, 16)); mx = fmaxf(mx, __shfl_xor(mx, 32));
                const float mnew = fmaxf(mrun[qt], mx);
                if (__builtin_amdgcn_ballot_w64(mnew != mrun[qt]) != 0ull) {
                    const float alpha = fast_exp2(mrun[qt] - mnew); lsum[qt] *= alpha;
#pragma unroll
                    for (int c = 0; c < 4; ++c) oacc[c][qt] = oacc[c][qt] * alpha; }
                mrun[qt] = mnew;
                float ps = 0.f;
#pragma unroll
                for (int kt = 0; kt < 4; ++kt)
#pragma unroll
                    for (int jj = 0; jj < 4; ++jj) { const float p = fast_exp2(sacc[kt][qt][jj] - mnew); sacc[kt][qt][jj] = p; ps += p; }
                lsum[qt] += ps;
#pragma unroll
                for (int ks2 = 0; ks2 < 2; ++ks2) { const v4u w = pack8(sacc[2 * ks2][qt], sacc[2 * ks2 + 1][qt]); pf[qt][ks2] = __builtin_bit_cast(bf16x8, w); }
            }
            if (!grpB) { __builtin_amdgcn_s_setprio(1); FA_PV(vcur); __builtin_amdgcn_s_setprio(0); }
        }
        const int vnext = vcur == 2 ? 0 : vcur + 1;
        if (j + 1 < ntiles) FA_STORE(kb ^ 1, vnext);
        vcur = vnext;
        __syncthreads();
    }
    if (grpB && pvalid) FA_PV(pvb);
    __syncthreads();
#pragma unroll
    for (int qt = 0; qt < 2; ++qt) { float l = lsum[qt]; l += __shfl_xor(l, 16); l += __shfl_xor(l, 32); if (has_sink) l += fast_exp2(sink2 - mrun[qt]);
        const float inv = 1.0f / l;
#pragma unroll
        for (int c = 0; c < 4; ++c) { const f32x4 o = oacc[c][qt] * inv; v2u w; w.x = cvt_pk_bf16(o[0], o[1]); w.y = cvt_pk_bf16(o[2], o[3]);
            *(v2u*)(Og + (size_t)(16 * qt + fr) * ldo + 16 * c + 4 * fq) = w; } }
#undef FA_LOAD
#undef FA_STORE
#undef FA_PV
}

__device__ __forceinline__ void phase_attn_window(Frame& F, const float* const* in, bf16* Q, const bf16* Kb, const bf16* Vb, bf16* Oalt = nullptr) {
    constexpr int NLAT = NB * 4 * 64, NCTX = NB * 4 * 4;
    for (int un = F.vcu; un < NLAT + NCTX; un += GRID) {
        int b, kvh, q0, ntiles, kpos0, qrow0;
        if (un < NLAT) { b = un >> 8; kvh = (un >> 6) & 3; q0 = (un & 63) * 64; kpos0 = q0 >= 128 ? q0 - 128 : 0; const int kend = q0 + 192 <= SEQ ? q0 + 192 : SEQ; ntiles = 4 + (kend - kpos0) / 64; qrow0 = b * TPB + CTX + q0; }
        else { const int v = un - NLAT; b = v >> 4; kvh = (v >> 2) & 3; q0 = (v & 3) * 64; kpos0 = 0; ntiles = 4; qrow0 = b * TPB + q0; }
        const int g = F.wave >> 1, half = F.wave & 1, head = kvh * 4 + g;
        bf16* qp = Q + (size_t)(qrow0 + 32 * half) * 1024 + head * 64;
        bf16* op = Oalt ? Oalt + (size_t)(qrow0 + 32 * half) * 1024 + head * 64 : qp;
        flash_unit<64, true>(F.lds, F.tid, F.lane, F.wave >> 2, Kb + kvh * 64, 256, Vb + kvh * 64, 256, qp, 1024, op, 1024,
                             ntiles, b * TPB, b * TPB + CTX + kpos0, kpos0, q0 + 32 * half, in[16][head] * LOG2E, true);
    }
}
__device__ __forceinline__ void phase_attn_mla(Frame& F, const bf16* Q3, const bf16* KF, const bf16* V3, bf16* O) {
    for (int un = F.vcu; un < NB * 16 * 16; un += GRID) { const int b = un >> 8, head = (un >> 4) & 15, qb = un & 15; const int qrow = b * TPB + CTX + qb * 256 + 32 * F.wave;
        flash_unit<96, false>(F.lds, F.tid, F.lane, F.wave >> 2, KF + head * 96, 1536, V3 + head * 64, 1024, Q3 + (size_t)qrow * 1536 + head * 96, 1536, O + (size_t)qrow * 1024 + head * 64, 1024,
                              68, b * TPB, b * TPB + CTX, 0, 0, 0.f, false);
    }
}
__device__ __forceinline__ int scan_row(int dir, int tau) { return dir == 0 ? tau : (tau < CTX ? CTX - 1 - tau : (TPB + CTX - 1) - tau); }

__device__ __forceinline__ void phase_ssm_conv(Frame& F, const float* const* in, int gp, const bf16* XP, bf16* XS, bf16* BC, const float* DT, float* ACUM) {
    constexpr int RPW = M / GRID;
    if (F.tid < 384) {
    const int cg = F.tid % 192, rsub = F.tid / 192, c0 = cg * 8;
    const int oc = c0 < 1024 ? gp * 1024 + c0 : (c0 < 1280 ? 2048 + gp * 256 + (c0 - 1024) : 2560 + gp * 256 + (c0 - 1280));
    float w[5][8], bb[8];
#pragma unroll
    for (int k = 0; k < 5; ++k)
#pragma unroll
        for (int i = 0; i < 8; ++i) w[k][i] = in[19][k * 3072 + oc + i];
#pragma unroll
    for (int i = 0; i < 8; ++i) bb[i] = in[20][oc + i];
    const int rbeg = blockIdx.x * RPW + rsub * (RPW / 2), rend = rbeg + RPW / 2;
    for (int g0 = rbeg; g0 < rend; g0 += 8) {
        v4u xin[12];
#pragma unroll
        for (int j = 0; j < 12; ++j) { const int rr = g0 - 2 + j; xin[j] = (rr >= 0 && rr < M) ? *(const v4u*)(XP + (size_t)rr * 1536 + c0) : (v4u){0u, 0u, 0u, 0u}; }
#pragma unroll
        for (int i = 0; i < 8; ++i) { const int r = g0 + i; if (r < rend) { const int t = r % TPB; const int lo = t < CTX ? 0 : CTX, hi = t < CTX ? CTX : TPB;
            float a[8];
#pragma unroll
            for (int q = 0; q < 8; ++q) a[q] = bb[q];
#pragma unroll
            for (int k = 0; k < 5; ++k) { const int tt = t + k - 2; if (tt >= lo && tt < hi) { const v4u x = xin[i + k];
                    a[0] += w[k][0] * bflo(x.x); a[1] += w[k][1] * bfhi(x.x); a[2] += w[k][2] * bflo(x.y); a[3] += w[k][3] * bfhi(x.y);
                    a[4] += w[k][4] * bflo(x.z); a[5] += w[k][5] * bfhi(x.z); a[6] += w[k][6] * bflo(x.w); a[7] += w[k][7] * bfhi(x.w); } }
            v4u o; o.x = cvt_pk_bf16(silu_f(a[0]), silu_f(a[1])); o.y = cvt_pk_bf16(silu_f(a[2]), silu_f(a[3])); o.z = cvt_pk_bf16(silu_f(a[4]), silu_f(a[5])); o.w = cvt_pk_bf16(silu_f(a[6]), silu_f(a[7]));
            if (c0 < 1024) *(v4u*)(XS + (size_t)r * 1024 + c0) = o; else *(v4u*)(BC + (size_t)r * 512 + (c0 - 1024)) = o; } } }
    } else {
        const int chain = blockIdx.x * 128 + (F.tid - 384);
        if (chain < NB * 2 * 16 * 68) { const int ck = chain % 68, hl = (chain / 68) & 15, dir = (chain / (68 * 16)) & 1, b = chain / (68 * 32);
            const float Ah = -fast_exp(in[22][dir * 32 + gp * 16 + hl]) * LOG2E; float acc = 0.f;
#pragma unroll 1
            for (int h2 = 0; h2 < 2; ++h2) { float dv[32];
#pragma unroll
                for (int s = 0; s < 32; ++s) dv[s] = DT[(size_t)(b * TPB + scan_row(dir, ck * 64 + h2 * 32 + s)) * 32 + dir * 16 + hl];
#pragma unroll
                for (int s = 0; s < 32; ++s) { acc += dv[s] * Ah; ACUM[(size_t)(b * TPB + scan_row(dir, ck * 64 + h2 * 32 + s)) * 32 + dir * 16 + hl] = acc; } } }
    }
}

__device__ __forceinline__ void phase_ssm_scan(Frame& F, const float* const* in, int gp, const bf16* XS, const bf16* BC, const float* DT, const bf16* Z, bf16* Y) {
    constexpr int T = 32;
    LAS float* Bf = (LAS float*)F.lds;
    LAS float* Cf = (LAS float*)(F.lds + 16384);
    LAS float* U = (LAS float*)(F.lds + 32768);
    LAS float* XT = (LAS float*)(F.lds + 40960);
    LAS float* DEC = (LAS float*)(F.lds + 49152);
    LAS float* PART = (LAS float*)(F.lds + 49152 + 256);
    const int it = blockIdx.x, b = it >> 5, hl = (it >> 1) & 15, ph = it & 1, head = gp * 16 + hl, gl = hl >> 3;
    const int col = hl * 64 + ph * 32;
    const int p = F.tid & 31, ns = F.tid >> 5;
    const float dskip = in[23][head] + in[23][32 + head];
    const int st = F.tid >> 4, sch = F.tid & 15;
    const int xt = F.tid >> 2, xch = F.tid & 3;
    for (int dir = 0; dir < 2; ++dir) {
        const float Ah = -fast_exp(in[22][dir * 32 + head]) * LOG2E;
        float S[8];
#pragma unroll
        for (int i = 0; i < 8; ++i) S[i] = 0.f;
        v4u rb, rc, rx; float rdt = 0.f;
#define SS_LOAD(tile) do { const int _rB = b * TPB + scan_row(dir, (tile) * T + st); rb = *(const v4u*)(BC + (size_t)_rB * 512 + gl * 128 + sch * 8); rc = *(const v4u*)(BC + (size_t)_rB * 512 + 256 + gl * 128 + sch * 8); \
            if (F.tid < 128) { const int _rX = b * TPB + scan_row(dir, (tile) * T + xt); rx = *(const v4u*)(XS + (size_t)_rX * 1024 + col + xch * 8); rdt = DT[(size_t)_rX * 32 + dir * 16 + hl]; } } while (0)
#define SS_STORE(nb) do { LAS float* _b = Bf + st * 128 + sch * 8; LAS float* _c = Cf + st * 128 + sch * 8; \
            *(LAS f32x4*)_b = (f32x4){bflo(rb.x), bfhi(rb.x), bflo(rb.y), bfhi(rb.y)}; *(LAS f32x4*)(_b + 4) = (f32x4){bflo(rb.z), bfhi(rb.z), bflo(rb.w), bfhi(rb.w)}; \
            *(LAS f32x4*)_c = (f32x4){bflo(rc.x), bfhi(rc.x), bflo(rc.y), bfhi(rc.y)}; *(LAS f32x4*)(_c + 4) = (f32x4){bflo(rc.z), bfhi(rc.z), bflo(rc.w), bfhi(rc.w)}; \
            if (F.tid < 128) { const f32x4 x0 = (f32x4){bflo(rx.x), bfhi(rx.x), bflo(rx.y), bfhi(rx.y)}, x1 = (f32x4){bflo(rx.z), bfhi(rx.z), bflo(rx.w), bfhi(rx.w)}; \
                LAS float* _x = XT + (nb) * 1024 + xt * 32 + xch * 8; LAS float* _u = U + (nb) * 1024 + xt * 32 + xch * 8; \
                *(LAS f32x4*)_x = x0; *(LAS f32x4*)(_x + 4) = x1; *(LAS f32x4*)_u = x0 * rdt; *(LAS f32x4*)(_u + 4) = x1 * rdt; \
                if (xch == 0) DEC[(nb) * 32 + xt] = fast_exp2(rdt * Ah); } } while (0)
        __syncthreads();
        SS_LOAD(0); SS_STORE(0); __syncthreads();
        constexpr int NT = TPB / T;
        for (int tile = 0; tile < NT; ++tile) { const int cb = tile & 1;
            if (tile + 1 < NT) SS_LOAD(tile + 1);
            const LAS float* u_ = U + cb * 1024 + p; const LAS float* d_ = DEC + cb * 32;
#pragma unroll 4
            for (int t = 0; t < T; ++t) {
                const float dec = d_[t], u = u_[t * 32];
                const f32x4 b0 = *(const LAS f32x4*)(Bf + t * 128 + ns * 8), b1 = *(const LAS f32x4*)(Bf + t * 128 + ns * 8 + 4);
                const f32x4 c0 = *(const LAS f32x4*)(Cf + t * 128 + ns * 8), c1 = *(const LAS f32x4*)(Cf + t * 128 + ns * 8 + 4);
                float pt = 0.f;
#pragma unroll
                for (int i = 0; i < 4; ++i) { S[i] = S[i] * dec + b0[i] * u; pt += c0[i] * S[i]; S[4 + i] = S[4 + i] * dec + b1[i] * u; pt += c1[i] * S[4 + i]; }
                pt += __shfl_xor(pt, 32);
                if (F.lane < 32) PART[(F.wave * 32 + t) * 32 + p] = pt;
            }
            __syncthreads();
#pragma unroll
            for (int k = 0; k < 2; ++k) { const int t = (F.tid >> 5) + 16 * k; float y = 0.f;
#pragma unroll
                for (int w = 0; w < 8; ++w) y += PART[(w * 32 + t) * 32 + p];
                const size_t ro = (size_t)(b * TPB + scan_row(dir, tile * T + t));
                if (dir == 0) Y[ro * 1024 + col + p] = (bf16)f2bf(y);
                else { const float yt = y + bf2f(Y[ro * 1024 + col + p]) + dskip * XT[cb * 1024 + t * 32 + p]; const float zz = bf2f(Z[ro * 1024 + col + p]);
                    Y[ro * 1024 + col + p] = (bf16)f2bf(yt * silu_f(zz)); } }
            if (tile + 1 < NT) SS_STORE(cb ^ 1);
            __syncthreads();
        }
#undef SS_LOAD
#undef SS_STORE
    }
}
__device__ __forceinline__ void phase_ssm_gnorm(Frame& F, const float* const* in, int gp, bf16* Y) {
    const int gw = F.vcu * NWAVES + F.wave, NGW = GRID * NWAVES; const float* ng = in[24] + gp * 1024 + 16 * F.lane;
    for (int r = gw; r < M; r += NGW) { v4u* p = (v4u*)(Y + (size_t)r * 1024 + 16 * F.lane); const v4u a = p[0], c = p[1];
        float v[16] = {bflo(a.x), bfhi(a.x), bflo(a.y), bfhi(a.y), bflo(a.z), bfhi(a.z), bflo(a.w), bfhi(a.w), bflo(c.x), bfhi(c.x), bflo(c.y), bfhi(c.y), bflo(c.z), bfhi(c.z), bflo(c.w), bfhi(c.w)};
        float ss = 0.f;
#pragma unroll
        for (int i = 0; i < 16; ++i) ss += v[i] * v[i];
#pragma unroll
        for (int o = 1; o < 32; o <<= 1) ss += __shfl_xor(ss, o);
        const float rs = rsqrtf(ss * (1.f / 512.f) + EPS);
        v4u o0, o1;
        o0.x = cvt_pk_bf16(v[0] * rs * ng[0], v[1] * rs * ng[1]); o0.y = cvt_pk_bf16(v[2] * rs * ng[2], v[3] * rs * ng[3]); o0.z = cvt_pk_bf16(v[4] * rs * ng[4], v[5] * rs * ng[5]); o0.w = cvt_pk_bf16(v[6] * rs * ng[6], v[7] * rs * ng[7]);
        o1.x = cvt_pk_bf16(v[8] * rs * ng[8], v[9] * rs * ng[9]); o1.y = cvt_pk_bf16(v[10] * rs * ng[10], v[11] * rs * ng[11]); o1.z = cvt_pk_bf16(v[12] * rs * ng[12], v[13] * rs * ng[13]); o1.w = cvt_pk_bf16(v[14] * rs * ng[14], v[15] * rs * ng[15]);
        p[0] = o0; p[1] = o1; }
}


__device__ __forceinline__ void phase_ssm_scan_mfma(Frame& F, const float* const* in, int gp, const bf16* XS, const bf16* BC, const float* DT, const float* ACUM, bf16* Yf, bf16* Yb) {
    constexpr int BSTR = 272, XSTR = 160;
    LAS unsigned char* Bl = F.lds;
    LAS unsigned char* Cl = F.lds + 17408;
    LAS unsigned char* Xl = F.lds + 34816;
    LAS unsigned char* Xw = F.lds + 45056;
    LAS float* AC = (LAS float*)(F.lds + 55296);
    LAS float* DTs = (LAS float*)(F.lds + 55296 + 256);
    LAS unsigned char* Sb = F.lds + 55808;
    const int it = blockIdx.x, b = it >> 5, dir = (it >> 4) & 1, hl = it & 15, gl = hl >> 3;
    bf16* Y = dir == 0 ? Yf : Yb;
    const int tid = F.tid, lane = F.lane, w = F.wave, fr = lane & 15, fq = lane >> 4, lq = (lane & 15) >> 2, lp = lane & 3;
    const int lt = w & 3, ph = w >> 2;
    for (int i = tid; i < 64 * BSTR / 16; i += NTHR) *(LAS v4u*)(Sb + i * 16) = (v4u){0u, 0u, 0u, 0u};
    f32x4 sacc[4];
#pragma unroll
    for (int i = 0; i < 4; ++i) sacc[i] = (f32x4){0.f, 0.f, 0.f, 0.f};
    v4u rB[2], rC[2], rX; float rac = 0.f, rdt = 0.f, rxs = 0.f;
    const int xr = tid >> 3, xc = tid & 7;
#define SM_LOAD(ck) do { _Pragma("unroll") for (int _i = 0; _i < 2; ++_i) { const int _c = tid + 512 * _i; const size_t _r = (size_t)(b * TPB + scan_row(dir, (ck) * 64 + (_c >> 4))); \
            rB[_i] = *(const v4u*)(BC + _r * 512 + gl * 128 + (_c & 15) * 8); rC[_i] = *(const v4u*)(BC + _r * 512 + 256 + gl * 128 + (_c & 15) * 8); } \
        { const size_t _r = (size_t)(b * TPB + scan_row(dir, (ck) * 64 + xr)); const size_t _rl = (size_t)(b * TPB + scan_row(dir, (ck) * 64 + 63)); rX = *(const v4u*)(XS + _r * 1024 + hl * 64 + xc * 8); \
          const float _a = ACUM[_r * 32 + dir * 16 + hl], _al = ACUM[_rl * 32 + dir * 16 + hl], _d = DT[_r * 32 + dir * 16 + hl]; rac = _a; rdt = _d; rxs = _d * fast_exp2(_al - _a); } } while (0)
#define SM_STORE() do { _Pragma("unroll") for (int _i = 0; _i < 2; ++_i) { const int _c = tid + 512 * _i; *(LAS v4u*)(Bl + (_c >> 4) * BSTR + (_c & 15) * 16) = rB[_i]; *(LAS v4u*)(Cl + (_c >> 4) * BSTR + (_c & 15) * 16) = rC[_i]; } \
        *(LAS v4u*)(Xl + xr * XSTR + xc * 16) = rX; \
        { v4u _o; _o.x = cvt_pk_bf16(bflo(rX.x) * rxs, bfhi(rX.x) * rxs); _o.y = cvt_pk_bf16(bflo(rX.y) * rxs, bfhi(rX.y) * rxs); _o.z = cvt_pk_bf16(bflo(rX.z) * rxs, bfhi(rX.z) * rxs); _o.w = cvt_pk_bf16(bflo(rX.w) * rxs, bfhi(rX.w) * rxs); \
          *(LAS v4u*)(Xw + xr * XSTR + xc * 16) = _o; } \
        if (xc == 0) { AC[xr] = rac; DTs[xr] = rdt; } } while (0)
    SM_LOAD(0); SM_STORE(); __syncthreads();
    for (int ck = 0; ck < 68; ++ck) { const int cur = ck & 1;
        if (ck + 1 < 68) SM_LOAD(ck + 1);
        const LAS unsigned char* Sc = Sb + cur * (64 * BSTR); LAS unsigned char* Sn = Sb + (cur ^ 1) * (64 * BSTR);
        bf16x8 cf[4];
#pragma unroll
        for (int ks = 0; ks < 4; ++ks) cf[ks] = *(const LAS bf16x8*)(Cl + (16 * lt + fr) * BSTR + (32 * ks + 8 * fq) * 2);
        const float acl = AC[16 * lt + fr];
        f32x4 yacc[2];
#pragma unroll
        for (int pi = 0; pi < 2; ++pi) { f32x4 a = (f32x4){0.f, 0.f, 0.f, 0.f};
#pragma unroll
            for (int ks = 0; ks < 4; ++ks) { const bf16x8 sf = *(const LAS bf16x8*)(Sc + (16 * (2 * ph + pi) + fr) * BSTR + (32 * ks + 8 * fq) * 2); a = __builtin_amdgcn_mfma_f32_16x16x32_bf16(sf, cf[ks], a, 0, 0, 0); }
            yacc[pi] = a * fast_exp2(acl); }
        f32x4 pm[4];
#pragma unroll
        for (int st = 0; st < 4; ++st) { pm[st] = (f32x4){0.f, 0.f, 0.f, 0.f};
            if (st <= lt) { f32x4 g = (f32x4){0.f, 0.f, 0.f, 0.f};
#pragma unroll
                for (int ks = 0; ks < 4; ++ks) { const bf16x8 bfr = *(const LAS bf16x8*)(Bl + (16 * st + fr) * BSTR + (32 * ks + 8 * fq) * 2); g = __builtin_amdgcn_mfma_f32_16x16x32_bf16(bfr, cf[ks], g, 0, 0, 0); }
                const f32x4 acs = *(const LAS f32x4*)(AC + 16 * st + 4 * fq), dts = *(const LAS f32x4*)(DTs + 16 * st + 4 * fq);
#pragma unroll
                for (int j = 0; j < 4; ++j) { const bool ok = (16 * st + 4 * fq + j) <= (16 * lt + fr); pm[st][j] = ok ? g[j] * fast_exp2(acl - acs[j]) * dts[j] : 0.f; } } }
#pragma unroll
        for (int ks2 = 0; ks2 < 2; ++ks2) { if (2 * ks2 <= lt) { const v4u pw = pack8(pm[2 * ks2], pm[2 * ks2 + 1]); const bf16x8 pf = __builtin_bit_cast(bf16x8, pw);
#pragma unroll
                for (int pi = 0; pi < 2; ++pi) { const LAS unsigned char* xb = Xl + (32 * ks2 + 4 * fq + lq) * XSTR + (16 * (2 * ph + pi) + 4 * lp) * 2;
                    const s16x4 v0 = __builtin_amdgcn_ds_read_tr16_b64_v4i16((LAS s16x4*)xb), v1 = __builtin_amdgcn_ds_read_tr16_b64_v4i16((LAS s16x4*)(xb + 16 * XSTR));
                    bf16x8 xf; xf[0] = v0[0]; xf[1] = v0[1]; xf[2] = v0[2]; xf[3] = v0[3]; xf[4] = v1[0]; xf[5] = v1[1]; xf[6] = v1[2]; xf[7] = v1[3];
                    yacc[pi] = __builtin_amdgcn_mfma_f32_16x16x32_bf16(xf, pf, yacc[pi], 0, 0, 0); } } }
        { const size_t ro = (size_t)(b * TPB + scan_row(dir, ck * 64 + 16 * lt + fr));
#pragma unroll
          for (int pi = 0; pi < 2; ++pi) { v2u o; o.x = cvt_pk_bf16(yacc[pi][0], yacc[pi][1]); o.y = cvt_pk_bf16(yacc[pi][2], yacc[pi][3]);
              *(v2u*)(Y + ro * 1024 + hl * 64 + 16 * (2 * ph + pi) + 4 * fq) = o; } }
        { const float gdec = fast_exp2(AC[63]);
          bf16x8 xwf[2];
#pragma unroll
          for (int ks2 = 0; ks2 < 2; ++ks2) { const LAS unsigned char* xb = Xw + (32 * ks2 + 8 * fq + lq) * XSTR + (16 * lt + 4 * lp) * 2;
              const s16x4 v0 = __builtin_amdgcn_ds_read_tr16_b64_v4i16((LAS s16x4*)xb), v1 = __builtin_amdgcn_ds_read_tr16_b64_v4i16((LAS s16x4*)(xb + 4 * XSTR));
              xwf[ks2][0] = v0[0]; xwf[ks2][1] = v0[1]; xwf[ks2][2] = v0[2]; xwf[ks2][3] = v0[3]; xwf[ks2][4] = v1[0]; xwf[ks2][5] = v1[1]; xwf[ks2][6] = v1[2]; xwf[ks2][7] = v1[3]; }
#pragma unroll
          for (int i = 0; i < 4; ++i) { const int nt = 4 * ph + i; f32x4 a = sacc[i] * gdec;
#pragma unroll
              for (int ks2 = 0; ks2 < 2; ++ks2) { const LAS unsigned char* bb = Bl + (32 * ks2 + 8 * fq + lq) * BSTR + (16 * nt + 4 * lp) * 2;
                  const s16x4 v0 = __builtin_amdgcn_ds_read_tr16_b64_v4i16((LAS s16x4*)bb), v1 = __builtin_amdgcn_ds_read_tr16_b64_v4i16((LAS s16x4*)(bb + 4 * BSTR));
                  bf16x8 bt; bt[0] = v0[0]; bt[1] = v0[1]; bt[2] = v0[2]; bt[3] = v0[3]; bt[4] = v1[0]; bt[5] = v1[1]; bt[6] = v1[2]; bt[7] = v1[3];
                  a = __builtin_amdgcn_mfma_f32_16x16x32_bf16(xwf[ks2], bt, a, 0, 0, 0); }
              sacc[i] = a;
#pragma unroll
              for (int j = 0; j < 4; ++j) *(LAS bf16*)(Sn + (16 * lt + 4 * fq + j) * BSTR + (16 * nt + fr) * 2) = (bf16)f2bf(a[j]); } }
        __syncthreads();
        if (ck + 1 < 68) SM_STORE();
        __syncthreads();
    }
#undef SM_LOAD
#undef SM_STORE
}
struct GnRow { float v[16]; float ss; };
__device__ __forceinline__ void gn2_load(GnRow& R, const bf16* Yf, const bf16* Yb, const bf16* XS, const bf16* Z, size_t off, float dskip) {
    const v4u a0 = *(const v4u*)(Yf + off), a1 = *(const v4u*)(Yf + off + 8), b0 = *(const v4u*)(Yb + off), b1 = *(const v4u*)(Yb + off + 8);
    const v4u x0 = *(const v4u*)(XS + off), x1 = *(const v4u*)(XS + off + 8), z0 = *(const v4u*)(Z + off), z1 = *(const v4u*)(Z + off + 8);
    const unsigned aw[8] = {a0.x, a0.y, a0.z, a0.w, a1.x, a1.y, a1.z, a1.w}, bw[8] = {b0.x, b0.y, b0.z, b0.w, b1.x, b1.y, b1.z, b1.w};
    const unsigned xw[8] = {x0.x, x0.y, x0.z, x0.w, x1.x, x1.y, x1.z, x1.w}, zw[8] = {z0.x, z0.y, z0.z, z0.w, z1.x, z1.y, z1.z, z1.w};
    float ss = 0.f;
#pragma unroll
    for (int i = 0; i < 8; ++i) { R.v[2 * i] = (bflo(aw[i]) + bflo(bw[i]) + dskip * bflo(xw[i])) * silu_f(bflo(zw[i])); R.v[2 * i + 1] = (bfhi(aw[i]) + bfhi(bw[i]) + dskip * bfhi(xw[i])) * silu_f(bfhi(zw[i]));
        ss += R.v[2 * i] * R.v[2 * i] + R.v[2 * i + 1] * R.v[2 * i + 1]; }
    R.ss = ss;
}
__device__ __forceinline__ void gn_store(const GnRow& R, float rs, const float* ng, bf16* dst) {
    unsigned res[8];
#pragma unroll
    for (int i = 0; i < 8; ++i) res[i] = cvt_pk_bf16(R.v[2 * i] * rs * ng[2 * i], R.v[2 * i + 1] * rs * ng[2 * i + 1]);
    *(v4u*)(dst) = (v4u){res[0], res[1], res[2], res[3]}; *(v4u*)(dst + 8) = (v4u){res[4], res[5], res[6], res[7]};
}
__device__ __forceinline__ void phase_ssm_gnorm2(Frame& F, const float* const* in, int gp, bf16* Yf, const bf16* Yb, const bf16* XS, const bf16* Z) {
    const int gw = F.vcu * NWAVES + F.wave, NGW = GRID * NWAVES; const float* ng = in[24] + gp * 1024 + 16 * F.lane;
    const int head = gp * 16 + (F.lane >> 2); const float dskip = in[23][head] + in[23][32 + head];
    for (int r = gw; r < M; r += 2 * NGW) { const int r2 = r + NGW < M ? r + NGW : r; const size_t o1 = (size_t)r * 1024 + 16 * F.lane, o2 = (size_t)r2 * 1024 + 16 * F.lane;
        GnRow A, B; gn2_load(A, Yf, Yb, XS, Z, o1, dskip); gn2_load(B, Yf, Yb, XS, Z, o2, dskip);
        float sa = A.ss, sb = B.ss;
#pragma unroll
        for (int o = 1; o < 32; o <<= 1) { sa += __shfl_xor(sa, o); sb += __shfl_xor(sb, o); }
        gn_store(A, rsqrtf(sa * (1.f / 512.f) + EPS), ng, Yf + o1);
        if (r2 != r) gn_store(B, rsqrtf(sb * (1.f / 512.f) + EPS), ng, Yf + o2); }
}

__device__ __forceinline__ void phase_mlstm_scan(Frame& F, const bf16* Qm, const bf16* Km, const bf16* Vm, const float* G, bf16* Hf, bf16* Hb) {
    constexpr int T = 32;
    LAS float* Qf = (LAS float*)F.lds;
    LAS float* KW = (LAS float*)(F.lds + 8192);
    LAS float* Vf = (LAS float*)(F.lds + 16384);
    LAS float* FD = (LAS float*)(F.lds + 24576);
    LAS float* IW = (LAS float*)(F.lds + 24576 + 256);
    LAS float* EM = (LAS float*)(F.lds + 24576 + 512);
    LAS float* PN = (LAS float*)(F.lds + 32768);
    LAS float* PD = (LAS float*)(F.lds + 32768 + 65536);
    const int it = blockIdx.x, b = it >> 5, dir = (it >> 4) & 1, head = (it >> 1) & 7, jh = it & 1;
    bf16* Hout = dir == 0 ? Hf : Hb;
    const int w = F.wave, lane = F.lane, d7 = 8 * w + (lane & 7);
    float C[8], nst = 0.f, m_in = 0.f;
#pragma unroll
    for (int i = 0; i < 8; ++i) C[i] = 0.f;
    const int st = (F.tid & 255) >> 3, sch = F.tid & 7;
    v4u r0, r1; float gi = 0.f, gf = 0.f;
#define ML_LOAD(tile) do { const size_t _r = (size_t)(b * TPB + scan_row(dir, (tile) * T + st)); \
        if (F.tid < 256) { r0 = *(const v4u*)(Qm + _r * 512 + head * 64 + sch * 8); r1 = *(const v4u*)(Vm + _r * 1024 + head * 128 + jh * 64 + sch * 8); } \
        else { r0 = *(const v4u*)(Km + _r * 512 + head * 64 + sch * 8); } \
        if (F.tid < 32) { const size_t _g = (size_t)(b * TPB + scan_row(dir, (tile) * T + F.tid)); gi = G[_g * 32 + (2 * dir) * 8 + head]; gf = G[_g * 32 + (2 * dir + 1) * 8 + head]; } } while (0)
#define UNPK(dst, r) do { *(LAS f32x4*)(dst) = (f32x4){bflo(r.x), bfhi(r.x), bflo(r.y), bfhi(r.y)}; *(LAS f32x4*)((dst) + 4) = (f32x4){bflo(r.z), bfhi(r.z), bflo(r.w), bfhi(r.w)}; } while (0)
#define ML_GATES(nb) do { if (w == 0) { float Fc = lane < 32 ? gf : 0.f; \
            _Pragma("unroll") for (int o = 1; o < 32; o <<= 1) { const float t_ = __shfl_up(Fc, o); if (lane >= o) Fc += t_; } \
            float Gm = lane < 32 ? gi - Fc : -3.0e38f; \
            _Pragma("unroll") for (int o = 1; o < 32; o <<= 1) { const float t_ = __shfl_up(Gm, o); if (lane >= o) Gm = fmaxf(Gm, t_); } \
            const float mt = Fc + fmaxf(m_in, Gm); float mp = __shfl_up(mt, 1); if (lane == 0) mp = m_in; \
            if (lane < 32) { FD[(nb) * 32 + lane] = fast_exp2((gf + mp - mt) * LOG2E); IW[(nb) * 32 + lane] = fast_exp2((gi - mt) * LOG2E); EM[(nb) * 32 + lane] = fast_exp2(-mt * LOG2E); } \
            m_in = __shfl(mt, 31); } } while (0)
    __syncthreads();
    ML_LOAD(0); ML_GATES(0);
    if (F.tid < 256) { UNPK(Qf + st * 64 + sch * 8, r0); UNPK(Vf + st * 64 + sch * 8, r1); }
    __syncthreads();
    if (F.tid >= 256) { const float iw = IW[st]; LAS float* dk = KW + st * 64 + sch * 8;
        *(LAS f32x4*)dk = (f32x4){bflo(r0.x), bfhi(r0.x), bflo(r0.y), bfhi(r0.y)} * iw; *(LAS f32x4*)(dk + 4) = (f32x4){bflo(r0.z), bfhi(r0.z), bflo(r0.w), bfhi(r0.w)} * iw; }
    __syncthreads();
    constexpr int NT = TPB / T;
    for (int tile = 0; tile < NT; ++tile) { const int cb = tile & 1;
        if (tile + 1 < NT) ML_LOAD(tile + 1);
#pragma unroll 4
        for (int t = 0; t < T; ++t) {
            const float fd = FD[cb * 32 + t], v = Vf[t * 64 + lane];
            const f32x4 q0 = *(const LAS f32x4*)(Qf + t * 64 + 8 * w), q1 = *(const LAS f32x4*)(Qf + t * 64 + 8 * w + 4);
            const f32x4 k0 = *(const LAS f32x4*)(KW + t * 64 + 8 * w), k1 = *(const LAS f32x4*)(KW + t * 64 + 8 * w + 4);
            float pn = 0.f;
#pragma unroll
            for (int i = 0; i < 4; ++i) { C[i] = C[i] * fd + k0[i] * v; pn += q0[i] * C[i]; C[4 + i] = C[4 + i] * fd + k1[i] * v; pn += q1[i] * C[4 + i]; }
            PN[(w * 32 + t) * 64 + lane] = pn;
            nst = nst * fd + KW[t * 64 + d7];
            float pd = Qf[t * 64 + d7] * nst;
            pd += __shfl_xor(pd, 1); pd += __shfl_xor(pd, 2); pd += __shfl_xor(pd, 4);
            if (lane == 0) PD[w * 32 + t] = pd;
        }
        __syncthreads();
#pragma unroll
        for (int k = 0; k < 4; ++k) { const int t = (F.tid >> 6) + 8 * k; float num = 0.f, den = 0.f;
#pragma unroll
            for (int ww = 0; ww < 8; ++ww) { num += PN[(ww * 32 + t) * 64 + lane]; den += PD[ww * 32 + t]; }
            const float h = num / fmaxf(fabsf(den), EM[cb * 32 + t]);
            Hout[(size_t)(b * TPB + scan_row(dir, tile * T + t)) * 1024 + head * 128 + jh * 64 + lane] = (bf16)f2bf(h); }
        if (tile + 1 < NT) { ML_GATES(cb ^ 1); if (F.tid < 256) { UNPK(Qf + st * 64 + sch * 8, r0); UNPK(Vf + st * 64 + sch * 8, r1); } }
        __syncthreads();
        if (tile + 1 < NT && F.tid >= 256) { const float iw = IW[(cb ^ 1) * 32 + st]; LAS float* dk = KW + st * 64 + sch * 8;
            *(LAS f32x4*)dk = (f32x4){bflo(r0.x), bfhi(r0.x), bflo(r0.y), bfhi(r0.y)} * iw; *(LAS f32x4*)(dk + 4) = (f32x4){bflo(r0.z), bfhi(r0.z), bflo(r0.w), bfhi(r0.w)} * iw; }
        __syncthreads();
    }
#undef ML_LOAD
#undef ML_GATES
#undef UNPK
}

__device__ __forceinline__ void phase_mlstm_scan_mfma(Frame& F, const bf16* Qm, const bf16* Km, const bf16* Vm, const float* G, bf16* Hf, bf16* Hb) {
    constexpr int QSTR = 144, WSTR = 160, VSTR = 176, CSTR = 144;
    LAS unsigned char* Ql = F.lds;
    LAS unsigned char* Kl = F.lds + 9216;
    LAS unsigned char* Kw = F.lds + 18432;
    LAS unsigned char* Vl = F.lds + 28672;
    LAS unsigned char* Cb = F.lds + 39936;
    LAS float* BCU = (LAS float*)(F.lds + 62976);
    LAS float* IGA = BCU + 64;
    LAS float* MTA = BCU + 128;
    LAS float* SCA = BCU + 192;
    const int it = blockIdx.x, b = it >> 5, dir = (it >> 4) & 1, head = (it >> 1) & 7, jh = it & 1;
    bf16* Hout = dir == 0 ? Hf : Hb;
    const int tid = F.tid, lane = F.lane, w = F.wave, fr = lane & 15, fq = lane >> 4, lq = (lane & 15) >> 2, lp = lane & 3;
    const int lt = w & 3, jg = w >> 2;
    for (int i = tid; i < 80 * CSTR / 16; i += NTHR) *(LAS v4u*)(Cb + i * 16) = (v4u){0u, 0u, 0u, 0u};
    for (int i = tid; i < 64 * 2; i += NTHR) { const int s = i >> 1, hh = i & 1; *(LAS v4u*)(Vl + s * VSTR + 128 + hh * 16) = hh == 0 ? (v4u){0x3F80u, 0u, 0u, 0u} : (v4u){0u, 0u, 0u, 0u}; }
    f32x4 sacc[3];
#pragma unroll
    for (int i = 0; i < 3; ++i) sacc[i] = (f32x4){0.f, 0.f, 0.f, 0.f};
    v4u rQ, rK, rV; float gi = 0.f, gf = 0.f, m_in = 0.f;
    const int sr = tid >> 3, sc = tid & 7;
#define MM_LOAD(ck) do { const size_t _r = (size_t)(b * TPB + scan_row(dir, (ck) * 64 + sr)); \
        rQ = *(const v4u*)(Qm + _r * 512 + head * 64 + sc * 8); rK = *(const v4u*)(Km + _r * 512 + head * 64 + sc * 8); rV = *(const v4u*)(Vm + _r * 1024 + head * 128 + jh * 64 + sc * 8); \
        if (tid < 64) { const size_t _g = (size_t)(b * TPB + scan_row(dir, (ck) * 64 + tid)); gi = G[_g * 32 + (2 * dir) * 8 + head] * LOG2E; gf = G[_g * 32 + (2 * dir + 1) * 8 + head] * LOG2E; } } while (0)
#define MM_STAGE1() do { if (w == 0) { float Fc = gf; \
            _Pragma("unroll") for (int o = 1; o < 64; o <<= 1) { const float t_ = __shfl_up(Fc, o); if (lane >= o) Fc += t_; } \
            float Gm = gi - Fc; \
            _Pragma("unroll") for (int o = 1; o < 64; o <<= 1) { const float t_ = __shfl_up(Gm, o); if (lane >= o) Gm = fmaxf(Gm, t_); } \
            const float mt = Fc + fmaxf(m_in, Gm); BCU[lane] = Fc; IGA[lane] = gi; MTA[lane] = mt; \
            if (lane == 63) { SCA[0] = Fc; SCA[1] = m_in; SCA[2] = mt; } \
            m_in = __shfl(mt, 63); } \
        *(LAS v4u*)(Ql + sr * QSTR + sc * 16) = rQ; *(LAS v4u*)(Kl + sr * QSTR + sc * 16) = rK; *(LAS v4u*)(Vl + sr * VSTR + sc * 16) = rV; } while (0)
#define MM_STAGE2() do { const float ws_ = fast_exp2(SCA[0] - BCU[sr] + IGA[sr] - SCA[2]); v4u _o; \
        _o.x = cvt_pk_bf16(bflo(rK.x) * ws_, bfhi(rK.x) * ws_); _o.y = cvt_pk_bf16(bflo(rK.y) * ws_, bfhi(rK.y) * ws_); _o.z = cvt_pk_bf16(bflo(rK.z) * ws_, bfhi(rK.z) * ws_); _o.w = cvt_pk_bf16(bflo(rK.w) * ws_, bfhi(rK.w) * ws_); \
        *(LAS v4u*)(Kw + sr * WSTR + sc * 16) = _o; } while (0)
    __syncthreads();
    MM_LOAD(0); MM_STAGE1(); __syncthreads(); MM_STAGE2(); __syncthreads();
    for (int ck = 0; ck < 68; ++ck) { const int cur = ck & 1;
        if (ck + 1 < 68) MM_LOAD(ck + 1);
        const LAS unsigned char* Cc = Cb + cur * (80 * CSTR); LAS unsigned char* Cn = Cb + (cur ^ 1) * (80 * CSTR);
        bf16x8 qf[2];
#pragma unroll
        for (int ks = 0; ks < 2; ++ks) qf[ks] = *(const LAS bf16x8*)(Ql + (16 * lt + fr) * QSTR + (32 * ks + 8 * fq) * 2);
        const float bl = BCU[16 * lt + fr], ml = MTA[16 * lt + fr], m0 = SCA[1];
        const float dl = fast_exp2(bl + m0 - ml);
        f32x4 nacc[2]; float den;
#pragma unroll
        for (int ji = 0; ji < 2; ++ji) { f32x4 a = (f32x4){0.f, 0.f, 0.f, 0.f};
#pragma unroll
            for (int ks = 0; ks < 2; ++ks) { const bf16x8 cfr = *(const LAS bf16x8*)(Cc + (16 * (2 * jg + ji) + fr) * CSTR + (32 * ks + 8 * fq) * 2); a = __builtin_amdgcn_mfma_f32_16x16x32_bf16(cfr, qf[ks], a, 0, 0, 0); }
            nacc[ji] = a * dl; }
        { f32x4 a = (f32x4){0.f, 0.f, 0.f, 0.f};
#pragma unroll
          for (int ks = 0; ks < 2; ++ks) { const bf16x8 cfr = *(const LAS bf16x8*)(Cc + (64 + fr) * CSTR + (32 * ks + 8 * fq) * 2); a = __builtin_amdgcn_mfma_f32_16x16x32_bf16(cfr, qf[ks], a, 0, 0, 0); }
          den = __shfl(a[0], fr) * dl; }
        f32x4 pm[4]; float dsum = 0.f;
#pragma unroll
        for (int st = 0; st < 4; ++st) { pm[st] = (f32x4){0.f, 0.f, 0.f, 0.f};
            if (st <= lt) { f32x4 g = (f32x4){0.f, 0.f, 0.f, 0.f};
#pragma unroll
                for (int ks = 0; ks < 2; ++ks) { const bf16x8 kfr = *(const LAS bf16x8*)(Kl + (16 * st + fr) * QSTR + (32 * ks + 8 * fq) * 2); g = __builtin_amdgcn_mfma_f32_16x16x32_bf16(kfr, qf[ks], g, 0, 0, 0); }
                const f32x4 bs = *(const LAS f32x4*)(BCU + 16 * st + 4 * fq), is = *(const LAS f32x4*)(IGA + 16 * st + 4 * fq);
#pragma unroll
                for (int j = 0; j < 4; ++j) { const bool ok = (16 * st + 4 * fq + j) <= (16 * lt + fr); const float v = ok ? g[j] * fast_exp2(bl - bs[j] + is[j] - ml) : 0.f; pm[st][j] = v; dsum += v; } } }
        dsum += __shfl_xor(dsum, 16); dsum += __shfl_xor(dsum, 32);
        den += dsum;
#pragma unroll
        for (int ks2 = 0; ks2 < 2; ++ks2) { if (2 * ks2 <= lt) { const v4u pw = pack8(pm[2 * ks2], pm[2 * ks2 + 1]); const bf16x8 pf = __builtin_bit_cast(bf16x8, pw);
#pragma unroll
                for (int ji = 0; ji < 2; ++ji) { const LAS unsigned char* vb = Vl + (32 * ks2 + 4 * fq + lq) * VSTR + (16 * (2 * jg + ji) + 4 * lp) * 2;
                    const s16x4 v0 = __builtin_amdgcn_ds_read_tr16_b64_v4i16((LAS s16x4*)vb), v1 = __builtin_amdgcn_ds_read_tr16_b64_v4i16((LAS s16x4*)(vb + 16 * VSTR));
                    bf16x8 vf; vf[0] = v0[0]; vf[1] = v0[1]; vf[2] = v0[2]; vf[3] = v0[3]; vf[4] = v1[0]; vf[5] = v1[1]; vf[6] = v1[2]; vf[7] = v1[3];
                    nacc[ji] = __builtin_amdgcn_mfma_f32_16x16x32_bf16(vf, pf, nacc[ji], 0, 0, 0); } } }
        { const float inv = 1.0f / fmaxf(fabsf(den), fast_exp2(-ml)); const size_t ro = (size_t)(b * TPB + scan_row(dir, ck * 64 + 16 * lt + fr));
#pragma unroll
          for (int ji = 0; ji < 2; ++ji) { v2u o; o.x = cvt_pk_bf16(nacc[ji][0] * inv, nacc[ji][1] * inv); o.y = cvt_pk_bf16(nacc[ji][2] * inv, nacc[ji][3] * inv);
              *(v2u*)(Hout + ro * 1024 + head * 128 + jh * 64 + 16 * (2 * jg + ji) + 4 * fq) = o; } }
        { const float gdec = fast_exp2(SCA[0] + m0 - SCA[2]);
          bf16x8 kwf[2];
#pragma unroll
          for (int ks2 = 0; ks2 < 2; ++ks2) { const LAS unsigned char* kb = Kw + (32 * ks2 + 8 * fq + lq) * WSTR + (16 * lt + 4 * lp) * 2;
              const s16x4 v0 = __builtin_amdgcn_ds_read_tr16_b64_v4i16((LAS s16x4*)kb), v1 = __builtin_amdgcn_ds_read_tr16_b64_v4i16((LAS s16x4*)(kb + 4 * WSTR));
              kwf[ks2][0] = v0[0]; kwf[ks2][1] = v0[1]; kwf[ks2][2] = v0[2]; kwf[ks2][3] = v0[3]; kwf[ks2][4] = v1[0]; kwf[ks2][5] = v1[1]; kwf[ks2][6] = v1[2]; kwf[ks2][7] = v1[3]; }
#pragma unroll
          for (int i = 0; i < 3; ++i) { if (jg == 0 || i < 2) { const int jt = jg == 0 ? i : 3 + i; f32x4 a = sacc[i] * gdec;
#pragma unroll
              for (int ks2 = 0; ks2 < 2; ++ks2) { const LAS unsigned char* vb = Vl + (32 * ks2 + 8 * fq + lq) * VSTR + (16 * jt + 4 * lp) * 2;
                  const s16x4 v0 = __builtin_amdgcn_ds_read_tr16_b64_v4i16((LAS s16x4*)vb), v1 = __builtin_amdgcn_ds_read_tr16_b64_v4i16((LAS s16x4*)(vb + 4 * VSTR));
                  bf16x8 vt; vt[0] = v0[0]; vt[1] = v0[1]; vt[2] = v0[2]; vt[3] = v0[3]; vt[4] = v1[0]; vt[5] = v1[1]; vt[6] = v1[2]; vt[7] = v1[3];
                  a = __builtin_amdgcn_mfma_f32_16x16x32_bf16(vt, kwf[ks2], a, 0, 0, 0); }
              sacc[i] = a;
#pragma unroll
              for (int j = 0; j < 4; ++j) *(LAS bf16*)(Cn + (16 * jt + 4 * fq + j) * CSTR + (16 * lt + fr) * 2) = (bf16)f2bf(a[j]); } } }
        __syncthreads();
        if (ck + 1 < 68) MM_STAGE1();
        __syncthreads();
        if (ck + 1 < 68) MM_STAGE2();
        __syncthreads();
    }
#undef MM_LOAD
#undef MM_STAGE1
#undef MM_STAGE2
}

__device__ __forceinline__ void mg_load(GnRow& R, unsigned (&ow)[8], const bf16* Hf, const bf16* Hb, const bf16* Om, size_t off) {
    const v4u a0 = *(const v4u*)(Hf + off), a1 = *(const v4u*)(Hf + off + 8), b0 = *(const v4u*)(Hb + off), b1 = *(const v4u*)(Hb + off + 8), o0 = *(const v4u*)(Om + off), o1 = *(const v4u*)(Om + off + 8);
    const unsigned aw[8] = {a0.x, a0.y, a0.z, a0.w, a1.x, a1.y, a1.z, a1.w}, bw[8] = {b0.x, b0.y, b0.z, b0.w, b1.x, b1.y, b1.z, b1.w};
    ow[0] = o0.x; ow[1] = o0.y; ow[2] = o0.z; ow[3] = o0.w; ow[4] = o1.x; ow[5] = o1.y; ow[6] = o1.z; ow[7] = o1.w;
    float ss = 0.f;
#pragma unroll
    for (int i = 0; i < 8; ++i) { R.v[2 * i] = bflo(aw[i]) + bflo(bw[i]); R.v[2 * i + 1] = bfhi(aw[i]) + bfhi(bw[i]); ss += R.v[2 * i] * R.v[2 * i] + R.v[2 * i + 1] * R.v[2 * i + 1]; }
    R.ss = ss;
}
__device__ __forceinline__ void mg_store(const GnRow& R, const unsigned (&ow)[8], float rs, const float* ng, bf16* dst) {
    unsigned res[8];
#pragma unroll
    for (int i = 0; i < 8; ++i) res[i] = cvt_pk_bf16(R.v[2 * i] * rs * ng[2 * i] * sigmoid_f(bflo(ow[i])), R.v[2 * i + 1] * rs * ng[2 * i + 1] * sigmoid_f(bfhi(ow[i])));
    *(v4u*)(dst) = (v4u){res[0], res[1], res[2], res[3]}; *(v4u*)(dst + 8) = (v4u){res[4], res[5], res[6], res[7]};
}
__device__ __forceinline__ void phase_mlstm_gnorm(Frame& F, const float* const* in, const bf16* Hf, const bf16* Hb, const bf16* Om, bf16* Hn) {
    const int gw = F.vcu * NWAVES + F.wave, NGW = GRID * NWAVES; const float* ng = in[28] + 16 * F.lane;
    for (int r = gw; r < M; r += 2 * NGW) { const int r2 = r + NGW < M ? r + NGW : r; const size_t o1 = (size_t)r * 1024 + 16 * F.lane, o2 = (size_t)r2 * 1024 + 16 * F.lane;
        GnRow A, B; unsigned wa[8], wb[8]; mg_load(A, wa, Hf, Hb, Om, o1); mg_load(B, wb, Hf, Hb, Om, o2);
        float sa = A.ss, sb = B.ss;
        sa += __shfl_xor(sa, 1); sb += __shfl_xor(sb, 1); sa += __shfl_xor(sa, 2); sb += __shfl_xor(sb, 2); sa += __shfl_xor(sa, 4); sb += __shfl_xor(sb, 4);
        mg_store(A, wa, rsqrtf(sa * (1.f / 128.f) + EPS), ng, Hn + o1);
        if (r2 != r) mg_store(B, wb, rsqrtf(sb * (1.f / 128.f) + EPS), ng, Hn + o2); }
}
struct Args { const float* in[37]; float* out; unsigned char* ws; };

__device__ __forceinline__ void moe_phases(Frame& F, const float* const* in, int layer, const XcdBarrier& bar) {
#if defined(PROBE_ROUTE2)
    phase_norm2_route(F, in, layer, true); __syncthreads();
#endif
    phase_norm2_route(F, in, layer);
    SYNC_GRID();
    bf16* Hb = (bf16*)(F.ws + WS_H); bf16* ACT = (bf16*)(F.ws + MOE_ACT); float* X = (float*)(F.ws + WS_X);
    const float* mod = (const float*)(F.ws + WS_MOD) + (size_t)layer * 9 * 6144;
    { MoeOrder<0> S; S.W = (const bf16*)(F.ws + WS_WGU); S.G = GRID; S.c = F.vcu; moe_setup(F, layer, S);
      pg8::Gemm g{Hb, 1024, 1024, 1 << 30}; EpiMoeAct E{ACT, S.tbl};
      pg8::gemm_phase(F.lds, g, S, E);
#if defined(PROBE_GM1)
      __syncthreads(); pg8::gemm_phase(F.lds, g, S, E);
#endif
      }
    SYNC_GRID();
    { MoeOrder<1> S; S.W = (const bf16*)(F.ws + WS_WDN); S.G = GRID; S.c = F.vcu; moe_setup(F, layer, S);
      pg8::Gemm g{ACT, 512, 256, 4}; EpiMoeDown E{X, mod + 5 * 1024, S.tbl};
      pg8::gemm_phase(F.lds, g, S, E); }
    SYNC_GRID();
}
__device__ __forceinline__ void outproj_phase(Frame& F, const bf16* A, const bf16* Wt, int K, int ldb, int layer, const float* xin = nullptr, const float* cin = nullptr) {
    pg8::Gemm g{A, K, ldb, 1 << 30}; pg8::StaticOrder S; S.init(M, 1024, GRID, (int)blockIdx.x, Wt, ldb);
    EpiResid E{(float*)(F.ws + WS_X), (const float*)(F.ws + WS_MOD) + (size_t)layer * 9 * 6144 + 2 * 1024, xin, cin};
    pg8::gemm_phase(F.lds, g, S, E);
}

__device__ __forceinline__ void ssm_gp_phases(Frame& F, const float* const* in, const int gp, const XcdBarrier& bar) {
    unsigned char* scr = F.ws + WS_SCR; unsigned char* scr2 = (unsigned char*)F.out; bf16* H = (bf16*)(F.ws + WS_H); bf16* WM = (bf16*)(F.ws + WS_WMIX);
    bf16* Z = (bf16*)scr; bf16* XP = (bf16*)(scr + 68 * MiB); bf16* XS = (bf16*)(scr + 170 * MiB); float* DT = (float*)(scr + 238 * MiB); float* ACUM = (float*)(scr + 243 * MiB); bf16* BC = (bf16*)scr2; bf16* Yb = (bf16*)(scr2 + 34 * MiB);
    { pg8::Gemm g{H, 1024, 1024, 1 << 30}; pg8::StaticOrder S; S.init(M, 2816, GRID, (int)blockIdx.x, WM + (size_t)gp * 2816 * 1024, 1024);
      EpiSsmIn E{Z, XP, DT, in[21] + gp * 16};
      pg8::gemm_phase(F.lds, g, S, E);
#if defined(PROBE_GEMM2)
        __syncthreads(); pg8::gemm_phase(F.lds, g, S, E);
#endif
        }
    SYNC_GRID();
    phase_ssm_conv(F, in, gp, XP, XS, BC, DT, ACUM);
#if defined(PROBE_MEM2)
    phase_ssm_conv(F, in, gp, XP, XS, BC, DT, ACUM);
#endif
    SYNC_GRID();
#if defined(SSD_VALU)
    phase_ssm_scan(F, in, gp, XS, BC, DT, Z, XP);
    SYNC_GRID();
    phase_ssm_gnorm(F, in, gp, XP);
    SYNC_GRID();
#else
    phase_ssm_scan_mfma(F, in, gp, XS, BC, DT, ACUM, XP, Yb);
#if defined(PROBE_SSDM2)
    VM_WAIT(); __syncthreads(); __builtin_amdgcn_fence(__ATOMIC_ACQUIRE, "agent"); VM_WAIT(); __syncthreads(); refresh(F); phase_ssm_scan_mfma(F, in, gp, XS, BC, DT, ACUM, XP, Yb);
#endif
    SYNC_GRID();
    phase_ssm_gnorm2(F, in, gp, XP, Yb, XS, Z);
    SYNC_GRID();
#endif
    outproj_phase(F, XP, WM + 6 * MiB + (size_t)gp * 1024, 1024, 2048, 1);
    SYNC_GRID();
}

__global__ void __launch_bounds__(NTHR, 2) fwd_kernel(Args args) {
    extern __shared__ __attribute__((aligned(16))) unsigned char lds_raw[];
    Frame F;
    F.lds = (LAS unsigned char*)lds_raw; F.ws = args.ws; F.ctl = (unsigned*)(args.ws + WS_CTL); F.out = args.out;
    refresh(F);
    { const int bx = blockIdx.x; F.vcu = (bx % 8) * (GRID / 8) + bx / 8; }
    volatile LAS unsigned* MISC = (volatile LAS unsigned*)(F.lds + LDS_MISC);
    for (int u = F.tid; u < 256; u += NTHR) MISC[u] = 0u;
    __syncthreads();
    const XcdBarrier bar = xcd_barrier_post(F.ctl + CW_BAR, MISC + 8);
    const float* const* in = args.in;
    unsigned char* ws = F.ws; unsigned char* scr = ws + WS_SCR; unsigned char* scr2 = (unsigned char*)F.out;
    bf16* H = (bf16*)(ws + WS_H); bf16* WM = (bf16*)(ws + WS_WMIX);

#if defined(PROBE_MEM2)
    for (int rep = 0; rep < 2; ++rep) {
#endif
    phase_prologue(F, in);
    __syncthreads(); refresh(F);
    convert_matrix<MAP_ATTN_IN>(F, in[15], 1024, 1536, WM, 0, nullptr);
    convert_matrix<MAP_ID>(F, in[17], 1024, 1024, WM + 2 * MiB, 0, nullptr);
    convert_moe(F, in, 0);
#if defined(PROBE_MEM2)
    __syncthreads(); }
#endif
    SYNC_GRID();

#ifndef SKIP_L0
    phase_norm1(F, in, 0);
#if defined(PROBE_MEM2)
    phase_norm1(F, in, 0);
#endif
    SYNC_GRID();
    { bf16* Q = (bf16*)scr; bf16* Kb = (bf16*)(scr + 68 * MiB); bf16* Vb = (bf16*)(scr + 85 * MiB);
      { pg8::Gemm g{H, 1024, 1024, 1 << 30}; pg8::StaticOrder S; S.init(M, 1536, GRID, (int)blockIdx.x, WM, 1024);
        EpiAttnIn E{Q, Kb, Vb, (const f32x2*)(ws + WS_TABA), 0.125f * LOG2E};
        pg8::gemm_phase(F.lds, g, S, E);
#if defined(PROBE_GEMM2)
        __syncthreads(); pg8::gemm_phase(F.lds, g, S, E);
#endif
        }
      SYNC_GRID();
#if defined(PROBE_WIN2)
      phase_attn_window(F, in, Q, Kb, Vb, (bf16*)scr2); __syncthreads();
#endif
      phase_attn_window(F, in, Q, Kb, Vb);
      SYNC_GRID();
      outproj_phase(F, Q, WM + 2 * MiB, 1024, 1024, 0, in[0], in[2]);
      SYNC_GRID(); }
    moe_phases(F, in, 0, bar);

#endif
#ifndef SKIP_L1
#if defined(PROBE_MEM2)
    for (int rep = 0; rep < 2; ++rep) {
#endif
    phase_norm1(F, in, 1);
    convert_matrix<MAP_SSM_IN>(F, in[18], 1024, 5184, WM, 0, nullptr);
    zero_rows(F, WM, 2592, 224, 1024); zero_rows(F, WM, 2816 + 2592, 224, 1024);
    convert_matrix<MAP_ID>(F, in[25], 2048, 1024, WM + 6 * MiB, 0, nullptr);
    convert_moe(F, in, 1);
#if defined(PROBE_MEM2)
    __syncthreads(); }
#endif
    SYNC_GRID();
    ssm_gp_phases(F, in, 0, bar);
    ssm_gp_phases(F, in, 1, bar);
    moe_phases(F, in, 1, bar);

#endif
#ifndef SKIP_L2
#if defined(PROBE_MEM2)
    for (int rep = 0; rep < 2; ++rep) {
#endif
    phase_norm1(F, in, 2);
    convert_matrix<MAP_ID>(F, in[26], 1024, 3104, WM, 0, nullptr);
    zero_rows(F, WM, 3104, 224, 1024);
    convert_matrix<MAP_ID>(F, in[29], 1024, 1024, WM + 4 * MiB, 0, nullptr);
    convert_moe(F, in, 2);
#if defined(PROBE_MEM2)
    __syncthreads(); }
#endif
    SYNC_GRID();
    { bf16* Qm = (bf16*)scr; bf16* Km = (bf16*)(scr + 34 * MiB); bf16* Vm = (bf16*)(scr + 68 * MiB); bf16* Om = (bf16*)(scr + 136 * MiB); float* Gt = (float*)(scr + 204 * MiB);
      bf16* Hf = (bf16*)scr2; bf16* Hbw = H;
      { pg8::Gemm g{H, 1024, 1024, 1 << 30}; pg8::StaticOrder S; S.init(M, 3328, GRID, (int)blockIdx.x, WM, 1024);
        EpiMlIn E{Qm, Km, Vm, Om, Gt, in[27]};
        pg8::gemm_phase(F.lds, g, S, E);
#if defined(PROBE_GEMM2)
        __syncthreads(); pg8::gemm_phase(F.lds, g, S, E);
#endif
        }
      SYNC_GRID();
#if defined(ML_VALU)
      phase_mlstm_scan(F, Qm, Km, Vm, Gt, Hf, Hbw);
#else
      phase_mlstm_scan_mfma(F, Qm, Km, Vm, Gt, Hf, Hbw);
#if defined(PROBE_MLM2)
      __syncthreads(); phase_mlstm_scan_mfma(F, Qm, Km, Vm, Gt, Hf, Hbw);
#endif
#endif
      SYNC_GRID();
      phase_mlstm_gnorm(F, in, Hf, Hbw, Om, Om);
      SYNC_GRID();
      outproj_phase(F, Om, WM + 4 * MiB, 1024, 1024, 2);
      SYNC_GRID(); }
    moe_phases(F, in, 2, bar);

#endif
#ifndef SKIP_L3
#if defined(PROBE_MEM2)
    for (int rep = 0; rep < 2; ++rep) {
#endif
    phase_norm1(F, in, 3);
    convert_matrix<MAP_MLA_IN>(F, in[30], 1024, 544, WM, 0, nullptr);
    zero_rows(F, WM, 544, 224, 1024);
    convert_matrix<MAP_MLA_QUP>(F, in[32], 256, 1536, WM + 1 * MiB, 0, in[31]);
    convert_matrix<MAP_ID>(F, in[34], 256, 2048, WM + 2 * MiB, 0, in[33]);
    convert_matrix<MAP_ID>(F, in[35], 1024, 1024, WM + 3 * MiB, 0, nullptr);
    convert_moe(F, in, 3);
#if defined(PROBE_MEM2)
    __syncthreads(); }
#endif
    SYNC_GRID();
    { bf16* CQ = (bf16*)scr; bf16* CKV = (bf16*)(scr + 17 * MiB); float* SSQ = (float*)(scr + 34 * MiB); bf16* KF = (bf16*)(scr + 36 * MiB); bf16* V3 = (bf16*)(scr + 138 * MiB);
      bf16* Q3 = (bf16*)scr2; bf16* O3 = H; const f32x2* tabm = (const f32x2*)(ws + WS_TABM);
      { pg8::Gemm g{H, 1024, 1024, 1 << 30}; pg8::StaticOrder S; S.init(M, 768, GRID, (int)blockIdx.x, WM, 1024);
        EpiMlaIn E{CQ, CKV, KF, SSQ, tabm};
        pg8::gemm_phase(F.lds, g, S, E);
#if defined(PROBE_GEMM2)
        __syncthreads(); pg8::gemm_phase(F.lds, g, S, E);
#endif
        }
      SYNC_GRID();
      { pg8::Gemm g{CQ, 256, 256, 1 << 30}; pg8::StaticOrder S; S.init(M, 1536, GRID, (int)blockIdx.x, WM + 1 * MiB, 256);
        EpiMlaQ E{Q3, SSQ, tabm, 0.10206207261596577f * LOG2E};
        pg8::gemm_phase(F.lds, g, S, E);
#if defined(PROBE_GEMM2)
        __syncthreads(); pg8::gemm_phase(F.lds, g, S, E);
#endif
        }
      { pg8::Gemm g{CKV, 256, 256, 1 << 30}; pg8::StaticOrder S; S.init(M, 2048, GRID, (int)blockIdx.x, WM + 2 * MiB, 256);
        EpiMlaKV E{KF, V3, SSQ};
        pg8::gemm_phase(F.lds, g, S, E);
#if defined(PROBE_GEMM2)
        __syncthreads(); pg8::gemm_phase(F.lds, g, S, E);
#endif
        }
      SYNC_GRID();
      phase_attn_mla(F, Q3, KF, V3, O3);
#if defined(PROBE_MLA2)
      __syncthreads(); phase_attn_mla(F, Q3, KF, V3, O3);
#endif
      SYNC_GRID();
      outproj_phase(F, O3, WM + 3 * MiB, 1024, 1024, 3);
      SYNC_GRID(); }
    moe_phases(F, in, 3, bar);

#endif
    const bool poison = __hip_atomic_load(F.ctl + CW_BAR + XB_TMO, RLX_AGENT) != 0u || __hip_atomic_load(F.ctl + CW_POISON, RLX_AGENT) != 0u;
    phase_final(F, in, poison);
#if defined(PROBE_MEM2)
    phase_final(F, in, poison);
#endif
}

extern "C" void kernel_launch(void* const* d_in, const int* in_sizes, int n_in, void* d_out, int out_size, void* d_ws, size_t ws_size, hipStream_t stream) {
    static int ready = 0;
    if (ready == 0) {
        ready = -1;
        if (n_in != 37 || in_sizes[0] != NB * SEQ * D || out_size != NB * SEQ * D || ws_size < WS_END) { fprintf(stderr, "kernel_launch: unexpected problem shape (n_in %d, in0 %d, out %d, ws %zu)\n", n_in, n_in > 0 ? in_sizes[0] : -1, out_size, ws_size); return; }
        int dev = 0, cus = 0;
        if (hipGetDevice(&dev) != hipSuccess || hipDeviceGetAttribute(&cus, hipDeviceAttributeMultiprocessorCount, dev) != hipSuccess) { fprintf(stderr, "kernel_launch: device query failed\n"); return; }
        if (cus < GRID) { fprintf(stderr, "kernel_launch: needs %d CUs, device has %d\n", GRID, cus); return; }
        if (hipFuncSetAttribute((const void*)fwd_kernel, hipFuncAttributeMaxDynamicSharedMemorySize, LDS_BYTES) != hipSuccess) { fprintf(stderr, "kernel_launch: hipFuncSetAttribute failed\n"); return; }
        int per_cu = 0;
        if (hipOccupancyMaxActiveBlocksPerMultiprocessor(&per_cu, (const void*)fwd_kernel, NTHR, LDS_BYTES) != hipSuccess || per_cu < 1) { fprintf(stderr, "kernel_launch: occupancy query reports %d blocks per CU\n", per_cu); }
        (void)hipGetLastError();
        ready = 1;
    }
    if (ready < 0) return;
    if (hipMemsetAsync((char*)d_ws + WS_CTL, 0, CTL_ZERO_BYTES, stream) != hipSuccess) { fprintf(stderr, "kernel_launch: memset failed\n"); return; }
    Args a{};
    for (int i = 0; i < 37; ++i) a.in[i] = (const float*)d_in[i];
    a.out = (float*)d_out; a.ws = (unsigned char*)d_ws;
    hipLaunchKernelGGL(fwd_kernel, dim3(GRID), dim3(NTHR), LDS_BYTES, stream, a);
    const hipError_t le = hipPeekAtLastError();
    if (le != hipSuccess) fprintf(stderr, "kernel_launch: launch failed: %s\n", hipGetErrorName(le));
}
```

```cpp
#include <hip/hip_runtime.h>
#include <cstdio>
#include <cstdint>

#define GAS __attribute__((address_space(1)))
#define LAS __attribute__((address_space(3)))
typedef unsigned short bf16;
typedef unsigned v4u __attribute__((ext_vector_type(4)));
typedef unsigned v2u __attribute__((ext_vector_type(2)));
typedef float f32x4 __attribute__((ext_vector_type(4)));
typedef float f32x2 __attribute__((ext_vector_type(2)));
typedef short bf16x8 __attribute__((ext_vector_type(8)));
typedef short s16x4 __attribute__((ext_vector_type(4)));
#define RLX_AGENT __ATOMIC_RELAXED, __HIP_MEMORY_SCOPE_AGENT

constexpr int D = 1024, NB = 8, SEQ = 4096, CTX = 256, TPB = SEQ + CTX  , M = NB * TPB  ;
constexpr int NWAVES = 8, NTHR = 512, GRID = 256;
constexpr float EPS = 1e-6f;
constexpr float LOG2E = 1.4426950408889634f;

__device__ __forceinline__ unsigned f2bf(float f) { unsigned u = __builtin_bit_cast(unsigned, f); return (u + 0x7fffu + ((u >> 16) & 1u)) >> 16; }
__device__ __forceinline__ float bf2f(unsigned b) { return __builtin_bit_cast(float, b << 16); }
__device__ __forceinline__ float bflo(unsigned w) { return __builtin_bit_cast(float, w << 16); }
__device__ __forceinline__ float bfhi(unsigned w) { return __builtin_bit_cast(float, w & 0xffff0000u); }
__device__ __forceinline__ unsigned cvt_pk_bf16(float lo, float hi) { unsigned r; asm volatile("v_cvt_pk_bf16_f32 %0, %1, %2" : "=v"(r) : "v"(lo), "v"(hi)); return r; }
__device__ __forceinline__ float fast_exp2(float x) { return __builtin_amdgcn_exp2f(x); }
__device__ __forceinline__ float fast_rcp(float x) { return __builtin_amdgcn_rcpf(x); }
__device__ __forceinline__ float silu_f(float x) { return x * fast_rcp(1.0f + fast_exp2(-x * LOG2E)); }
__device__ __forceinline__ float sigmoid_f(float x) { return fast_rcp(1.0f + fast_exp2(-x * LOG2E)); }
__device__ __forceinline__ float fast_log(float x) { return __builtin_amdgcn_logf(x) * 0.6931471805599453f; }
__device__ __forceinline__ float fast_exp(float x) { return __builtin_amdgcn_exp2f(x * LOG2E); }
__device__ __forceinline__ float softplus_f(float x) { if (x > 20.f) return x; const float e = fast_exp(x); return e < 0.01f ? e * (1.0f - e * (0.5f - e * (1.0f / 3.0f))) : fast_log(1.0f + e); }
__device__ __forceinline__ v4u pack8(const f32x4 a, const f32x4 b) { v4u w; w.x = cvt_pk_bf16(a[0], a[1]); w.y = cvt_pk_bf16(a[2], a[3]); w.z = cvt_pk_bf16(b[0], b[1]); w.w = cvt_pk_bf16(b[2], b[3]); return w; }
#define DPPF(old, src, ctrl, rm, bc) __builtin_bit_cast(float, __builtin_amdgcn_update_dpp(__builtin_bit_cast(int, (float)(old)), __builtin_bit_cast(int, (float)(src)), ctrl, rm, 0xF, bc))
__device__ __forceinline__ float wave_sum(float v) {
    v += DPPF(0.f, v, 0xB1, 0xF, true); v += DPPF(0.f, v, 0x4E, 0xF, true); v += DPPF(0.f, v, 0x141, 0xF, true); v += DPPF(0.f, v, 0x140, 0xF, true);
    v += DPPF(0.f, v, 0x142, 0xA, false); v += DPPF(0.f, v, 0x143, 0xC, false);
    return __builtin_bit_cast(float, __builtin_amdgcn_readlane(__builtin_bit_cast(int, v), 63));
}
__device__ __forceinline__ int opaque_tid() { int t = threadIdx.x; asm volatile("" : "+v"(t)); return t; }
__device__ __forceinline__ float xrow_max(float v) {
    { auto r = __builtin_amdgcn_permlane16_swap(__builtin_bit_cast(unsigned, v), __builtin_bit_cast(unsigned, v), false, false); v = fmaxf(__builtin_bit_cast(float, r[0]), __builtin_bit_cast(float, r[1])); }
    { auto r = __builtin_amdgcn_permlane32_swap(__builtin_bit_cast(unsigned, v), __builtin_bit_cast(unsigned, v), false, false); v = fmaxf(__builtin_bit_cast(float, r[0]), __builtin_bit_cast(float, r[1])); }
    return v; }
__device__ __forceinline__ float xrow_sum(float v) {
    { auto r = __builtin_amdgcn_permlane16_swap(__builtin_bit_cast(unsigned, v), __builtin_bit_cast(unsigned, v), false, false); v = __builtin_bit_cast(float, r[0]) + __builtin_bit_cast(float, r[1]); }
    { auto r = __builtin_amdgcn_permlane32_swap(__builtin_bit_cast(unsigned, v), __builtin_bit_cast(unsigned, v), false, false); v = __builtin_bit_cast(float, r[0]) + __builtin_bit_cast(float, r[1]); }
    return v; }
#define LDS_WAIT() asm volatile("s_waitcnt lgkmcnt(0)" ::: "memory")
#define VM_WAIT() asm volatile("s_waitcnt vmcnt(0)" ::: "memory")

namespace pg8 {
constexpr int BM = 256, BK = 64, HALF = 128, HTB = HALF * BK * 2, STAGE_BYTES = 8 * HTB, NXCD = 8, WGM = 8;
__host__ __device__ __forceinline__ int lds_byte(int r, int c) { const int st = (r >> 4) * 2 + (c >> 5), rr = r & 15, cc = c & 31, ob = rr * 64 + cc * 2; return st * 1024 + (ob ^ (((ob >> 9) & 1) << 5)); }
__host__ __device__ __forceinline__ void stage_rc(int b, int& R, int& C) { const int st = b / 1024, sb = b % 1024, swz = sb ^ (((sb >> 9) & 1) << 5); R = (st >> 1) * 16 + swz / 64; C = (st & 1) * 32 + (swz % 64) / 2; }
__host__ __device__ __forceinline__ int perm32(int rho) { const int n = rho >> 4, i = rho & 15; return 8 * (i >> 2) + 4 * n + (i & 3); }

struct Unit { int pm, pn, aux; };
struct Gemm { const bf16* A; int K; int ldb; int ksplit; };

struct StaticOrder {
    static constexpr bool GATHER = false;
    int nM, nN, nwg, G, c; const bf16* Bt; int ldb;
    __device__ void init(int M_, int N_, int G_, int c_, const bf16* Bt_, int ldb_) { nM = M_ / BM; nN = N_ / BM; nwg = nM * nN; G = G_; c = c_; Bt = Bt_; ldb = ldb_; }
    __device__ __forceinline__ bool next(int i, Unit& u) const {
        const long L = (long)i * G + c; if (L >= nwg) return false;
        int wgid = (int)L; { const int q = nwg / NXCD, r = nwg % NXCD, xcd = wgid % NXCD, off = wgid / NXCD; wgid = (xcd < r ? xcd * (q + 1) : r * (q + 1) + (xcd - r) * q) + off; }
        const int nig = WGM * nN, gid = wgid / nig, fm = gid * WGM, gsz = (nM - fm) < WGM ? (nM - fm) : WGM;
        u.pm = fm + ((wgid % nig) % gsz); u.pn = (wgid % nig) / gsz; u.aux = 0; return true;
    }
    __device__ __forceinline__ int a_row(const Unit& u, int r) const { return u.pm * BM + r; }
    __device__ __forceinline__ const char* b_seg(const Unit& u, int seg) const { return (const char*)(Bt + (size_t)u.pn * BM * ldb); }
};

template <class Epi, class Sched>
__device__ __forceinline__ void gemm_phase(LAS unsigned char* lds, const Gemm g, const Sched& S, const Epi& E) {
    const int tid = opaque_tid(), wid = __builtin_amdgcn_readfirstlane(tid >> 6), lane = tid & 63, wr = wid >> 2, wc = wid & 3, fr = lane & 15, fq = lane >> 4;
    const int K = g.K, nt = K / BK, ldb = g.ldb, ksplit = g.ksplit;
    int Rst[2], Cst[2]; unsigned voffB[2], voffA[2];
#pragma unroll
    for (int i = 0; i < 2; ++i) { int R, C; stage_rc(tid * 16 + i * 8192, R, C); const int Rb = Epi::PERM ? ((R & ~31) + perm32(R & 31)) : R; Rst[i] = R; Cst[i] = C;
        voffB[i] = (unsigned)(Rb * ldb + C) * 2u; voffA[i] = (unsigned)(R * K + C) * 2u; }
    const size_t hstepA = (size_t)HALF * K * 2;
    const size_t kstep = (size_t)(BK * 2);
    const size_t hstepB = (size_t)HALF * ldb * 2;
    const unsigned ldsw = (unsigned)wid * 1024u;
    const int aoff = lds_byte(wr * 64 + fr, fq * 8), boff = lds_byte(wc * 32 + fr, fq * 8);
#define PG8_SA(b, h) (((b) * 2 + (h)) * HTB)
#define PG8_SB(b, h) ((4 + (b) * 2 + (h)) * HTB)
#define PG8_STAGEB(bufoff, gbase) do { _Pragma("unroll") for (int _i = 0; _i < 2; ++_i) \
        __builtin_amdgcn_global_load_lds((const unsigned*)((const char*)(gbase) + voffB[_i]), (LAS unsigned*)(lds + (bufoff) + ldsw + _i * 8192), 16, 0, 0); } while (0)
#define PG8_STAGEA(bufoff, nextsel, h, kt) do { if constexpr (Sched::GATHER) { _Pragma("unroll") for (int _i = 0; _i < 2; ++_i) \
        __builtin_amdgcn_global_load_lds((const unsigned*)(gA + (size_t)(kt) * kstep + ((nextsel) ? vN[h][_i] : vA[h][_i])), (LAS unsigned*)(lds + (bufoff) + ldsw + _i * 8192), 16, 0, 0); } \
      else { const char* _ab = ((nextsel) ? nA : cA) + (size_t)(h) * hstepA + (size_t)(kt) * kstep; _Pragma("unroll") for (int _i = 0; _i < 2; ++_i) \
        __builtin_amdgcn_global_load_lds((const unsigned*)(_ab + voffA[_i]), (LAS unsigned*)(lds + (bufoff) + ldsw + _i * 8192), 16, 0, 0); } } while (0)
#define PG8_LDA(dst, b, h) do { _Pragma("unroll") for (int m = 0; m < 4; ++m) _Pragma("unroll") for (int k = 0; k < 2; ++k) dst[m][k] = *(const LAS bf16x8*)(lds + PG8_SA(b, h) + aoff + m * 2048 + k * 1024); } while (0)
#define PG8_LDB(dst, b, h) do { _Pragma("unroll") for (int n = 0; n < 2; ++n) _Pragma("unroll") for (int k = 0; k < 2; ++k) dst[n][k] = *(const LAS bf16x8*)(lds + PG8_SB(b, h) + boff + n * 2048 + k * 1024); } while (0)
#define PG8_MMA(ai, bj, At, Bt) do { __builtin_amdgcn_s_setprio(1); _Pragma("unroll") for (int m = 0; m < 4; ++m) _Pragma("unroll") for (int n = 0; n < 2; ++n) _Pragma("unroll") for (int k = 0; k < 2; ++k) \
        acc[ai][bj][m][n] = __builtin_amdgcn_mfma_f32_16x16x32_bf16(Bt[n][k], At[m][k], acc[ai][bj][m][n], 0, 0, 0); __builtin_amdgcn_s_setprio(0); } while (0)
#define PG8_WAIT_V(n) asm volatile("s_waitcnt vmcnt(" #n ")" ::: "memory")
#define PG8_WAIT_L(n) asm volatile("s_waitcnt lgkmcnt(" #n ")" ::: "memory")
#define PG8_BAR __builtin_amdgcn_s_barrier()
#define PG8_SCHED __builtin_amdgcn_sched_barrier(0)
#define PG8_AOFFS(dst, u) do { _Pragma("unroll") for (int _h = 0; _h < 2; ++_h) _Pragma("unroll") for (int _i = 0; _i < 2; ++_i) \
        dst[_h][_i] = (unsigned)S.a_row(u, _h * HALF + Rst[_i]) * (unsigned)(K * 2) + (unsigned)(Cst[_i] * 2); } while (0)
    Unit cur, nxt; int ui = 0;
    if (!S.next(0, cur)) return;
    const char* const gA = (const char*)g.A;
    f32x4 acc[2][2][4][2];
#pragma unroll
    for (int a = 0; a < 2; ++a)
#pragma unroll
        for (int b = 0; b < 2; ++b)
#pragma unroll
            for (int m = 0; m < 4; ++m)
#pragma unroll
                for (int n = 0; n < 2; ++n) acc[a][b][m][n] = (f32x4){0.f, 0.f, 0.f, 0.f};
    bf16x8 At[4][2], B0[2][2], B1[2][2];
    unsigned vA[2][2], vN[2][2];
    const char* cA = gA; const char* nA = gA;
    if constexpr (Sched::GATHER) { PG8_AOFFS(vA, cur); } else { cA = gA + (size_t)S.a_row(cur, 0) * K * 2; }
    const char* cB0 = S.b_seg(cur, 0); const char* cB1 = S.b_seg(cur, 1);
    PG8_STAGEB(PG8_SB(0, 0), cB0); PG8_STAGEB(PG8_SB(0, 1), cB0 + hstepB); PG8_STAGEA(PG8_SA(0, 0), false, 0, 0); PG8_STAGEA(PG8_SA(0, 1), false, 1, 0);
    if (wr == 1) PG8_BAR;
    PG8_WAIT_V(2); PG8_BAR;
    PG8_STAGEB(PG8_SB(1, 0), cB0 + kstep); PG8_STAGEA(PG8_SA(1, 0), false, 0, 1); PG8_STAGEB(PG8_SB(1, 1), cB0 + hstepB + kstep);
    PG8_WAIT_V(6); PG8_BAR;
    for (;;) {
        const bool has_next = S.next(ui + 1, nxt);
        const char* nB0 = cB0;
        nA = cA;
        if (has_next) { nB0 = S.b_seg(nxt, 0); if constexpr (Sched::GATHER) { PG8_AOFFS(vN, nxt); } else { nA = gA + (size_t)S.a_row(nxt, 0) * K * 2; } }
        else { if constexpr (Sched::GATHER) {
#pragma unroll
            for (int h = 0; h < 2; ++h)
#pragma unroll
                for (int i = 0; i < 2; ++i) vN[h][i] = vA[h][i]; } }
#pragma unroll 1
        for (int t = 0; t < nt; t += 2) {
            const bool last = (t == nt - 2);
            const char* b2 = last ? nB0 : ((t + 2 < ksplit) ? cB0 + (size_t)(t + 2) * kstep : cB1 + (size_t)(t + 2 - ksplit) * kstep);
            const char* b3 = b2 + kstep;
            const int kt2 = last ? 0 : t + 2;
            PG8_LDB(B0, 0, 0); PG8_LDB(B1, 0, 1); PG8_SCHED; PG8_LDA(At, 0, 0); PG8_STAGEA(PG8_SA(1, 1), false, 1, t + 1);
            PG8_WAIT_V(8); PG8_WAIT_L(0); PG8_BAR; PG8_MMA(0, 0, At, B0); PG8_MMA(0, 1, At, B1); PG8_BAR; PG8_SCHED;
            PG8_LDA(At, 0, 1); PG8_STAGEB(PG8_SB(0, 0), b2); PG8_STAGEB(PG8_SB(0, 1), b2 + hstepB); PG8_STAGEA(PG8_SA(0, 0), last, 0, kt2);
            PG8_WAIT_V(8); PG8_WAIT_L(0); PG8_BAR; PG8_MMA(1, 0, At, B0); PG8_MMA(1, 1, At, B1); PG8_BAR; PG8_SCHED;
            PG8_LDB(B0, 1, 0); PG8_LDB(B1, 1, 1); PG8_SCHED; PG8_LDA(At, 1, 0); PG8_STAGEA(PG8_SA(0, 1), last, 1, kt2);
            PG8_WAIT_V(8); PG8_WAIT_L(0); PG8_BAR; PG8_MMA(0, 0, At, B0); PG8_MMA(0, 1, At, B1); PG8_BAR; PG8_SCHED;
            PG8_LDA(At, 1, 1); PG8_STAGEB(PG8_SB(1, 0), b3); PG8_STAGEB(PG8_SB(1, 1), b3 + hstepB); PG8_STAGEA(PG8_SA(1, 0), last, 0, kt2 + 1);
            PG8_WAIT_V(8); PG8_WAIT_L(0); PG8_BAR; PG8_MMA(1, 0, At, B0); PG8_MMA(1, 1, At, B1); PG8_BAR; PG8_SCHED;
        }
        if (wr == 0) PG8_BAR;
        { int tz = tid; asm volatile("" : "+v"(tz));
          const int lz = tz & 63; E(acc, cur, ui, wr, wc, lz & 15, lz >> 4); }
        if (!has_next) break;
#pragma unroll
        for (int a = 0; a < 2; ++a)
#pragma unroll
            for (int b = 0; b < 2; ++b)
#pragma unroll
                for (int m = 0; m < 4; ++m)
#pragma unroll
                    for (int n = 0; n < 2; ++n) acc[a][b][m][n] = (f32x4){0.f, 0.f, 0.f, 0.f};
        cur = nxt; cB0 = nB0; cB1 = S.b_seg(cur, 1); cA = nA; ++ui;
        if constexpr (Sched::GATHER) {
#pragma unroll
        for (int h = 0; h < 2; ++h)
#pragma unroll
            for (int i = 0; i < 2; ++i) vA[h][i] = vN[h][i]; }
        if (wr == 1) PG8_BAR;
    }
    PG8_WAIT_V(0);
    PG8_BAR;
#undef PG8_SA
#undef PG8_SB
#undef PG8_STAGEA
#undef PG8_STAGEB
#undef PG8_LDA
#undef PG8_LDB
#undef PG8_MMA
#undef PG8_WAIT_V
#undef PG8_WAIT_L
#undef PG8_BAR
#undef PG8_SCHED
#undef PG8_AOFFS
}
}
#define XB_TMO      128
#define XB_XCNT(j)  (256  + 64 * (j))
#define XB_XSUB(j)  (1280 + 64 * (j))
#define XB_XGEN(j)  (2304 + 64 * (j))
#define XB_TOP      3328
#define XB_TOPGEN   3392
#define XCD_BAR_WORDS 3456
#define XB_SPIN_CAP (1u << 22)
__device__ __forceinline__ unsigned xb_ld(unsigned* p)              { return __hip_atomic_load(p, __ATOMIC_RELAXED, __HIP_MEMORY_SCOPE_AGENT); }
__device__ __forceinline__ unsigned xb_add(unsigned* p, unsigned v) { return __hip_atomic_fetch_add(p, v, __ATOMIC_RELAXED, __HIP_MEMORY_SCOPE_AGENT); }
__device__ __forceinline__ unsigned xb_xcc_id() { return (unsigned)__builtin_amdgcn_s_getreg((3 << 11) | 20) & 0xFu; }
#define XB_SPIN(cond, bar) do { unsigned _sp = 0; while (cond) { __builtin_amdgcn_s_sleep(1); \
    if ((++_sp & 255u) == 0u) { if (xb_ld(&(bar)[XB_TMO])) break; if (_sp > XB_SPIN_CAP) { atomicAdd(&(bar)[XB_TMO], 1u); break; } } } } while (0)
struct XcdBarrier { unsigned* bar; unsigned x; volatile LAS unsigned* st; };
__device__ __forceinline__ XcdBarrier xcd_barrier_post(unsigned* bar, volatile LAS unsigned* st) {
    XcdBarrier b; b.bar = bar; b.x = xb_xcc_id(); b.st = st;
    if (threadIdx.x == 0) (void)xb_add(&bar[XB_XCNT(b.x)], 1u);
    return b;
}
__device__ __forceinline__ void xcd_barrier_complete(unsigned* bar, unsigned x, unsigned& nloc, unsigned& nx) {
    const unsigned G = gridDim.x * gridDim.y * gridDim.z;
    unsigned sum, cnt, mine, sp = 0u;
    for (;;) {
        sum = 0u; cnt = 0u; mine = 0u;
#pragma unroll
        for (unsigned j = 0; j < 16; ++j) { const unsigned c = xb_ld(&bar[XB_XCNT(j)]); sum += c; cnt += (c > 0u) ? 1u : 0u; mine = (j == x) ? c : mine; }
        if (sum == G) break;
        __builtin_amdgcn_s_sleep(1);
        if ((++sp & 255u) == 0u) { if (xb_ld(&bar[XB_TMO])) break; if (sp > XB_SPIN_CAP) { atomicAdd(&bar[XB_TMO], 1u); break; } }
    }
    nloc = mine > 0u ? mine : 1u; nx = cnt > 0u ? cnt : 1u;
}
__device__ __forceinline__ void xcd_barrier(const XcdBarrier& b) {
    asm volatile("s_waitcnt vmcnt(0)" ::: "memory");
    __syncthreads();
    if (threadIdx.x == 0) {
        unsigned* bar = b.bar;
        __builtin_amdgcn_s_waitcnt(0);
        unsigned nloc = b.st[0], nx = b.st[1];
        if (nloc == 0u) { xcd_barrier_complete(bar, b.x, nloc, nx); b.st[0] = nloc; b.st[1] = nx; }
        const unsigned old = xb_add(&bar[XB_XSUB(b.x)], 1u);
        const unsigned gen = old / nloc;
        if (old + 1u == (gen + 1u) * nloc) {
            __builtin_amdgcn_fence(__ATOMIC_RELEASE, "agent");
            asm volatile("s_waitcnt vmcnt(0)" ::: "memory");
            const unsigned og = xb_add(&bar[XB_TOP], 1u);
            const unsigned tg = og / nx;
            if (og + 1u == (tg + 1u) * nx) xb_add(&bar[XB_TOPGEN], 1u);
            else XB_SPIN(xb_ld(&bar[XB_TOPGEN]) == tg, bar);
            __builtin_amdgcn_fence(__ATOMIC_ACQUIRE, "agent");
            xb_add(&bar[XB_XGEN(b.x)], 1u);
            asm volatile("s_waitcnt vmcnt(0)" ::: "memory");
        } else {
            XB_SPIN(xb_ld(&bar[XB_XGEN(b.x)]) == gen, bar);
            __builtin_amdgcn_fence(__ATOMIC_ACQUIRE, "agent");
            asm volatile("s_waitcnt vmcnt(0)" ::: "memory");
        }
    }
    __syncthreads();
}

constexpr size_t MiB = 1u << 20;
constexpr size_t WS_CTL = 0, CTL_ZERO_BYTES = 1 * MiB;
constexpr size_t WS_MOD = 1 * MiB;
constexpr size_t WS_TABA = 2 * MiB;
constexpr size_t WS_TABM = 3 * MiB;
constexpr size_t WS_WGU = 4 * MiB;
constexpr size_t WS_WDN = 20 * MiB;
constexpr size_t WS_WMIX = 28 * MiB;
constexpr size_t WS_X = 52 * MiB;
constexpr size_t WS_H = 188 * MiB;
constexpr size_t WS_SCR = 256 * MiB;
constexpr size_t WS_END = 512 * MiB;
constexpr size_t MOE_ACT = WS_SCR;
constexpr size_t MOE_SL = WS_SCR + 48 * MiB;
constexpr size_t MOE_WT = WS_SCR + 52 * MiB;
constexpr int CW_BAR = 4096;
constexpr int CW_MOECNT = 16384;
constexpr int CW_POISON = 20000;

constexpr int RING_BYTES = 131072;
constexpr int LDS_MISC = RING_BYTES;
constexpr int LDS_TB = RING_BYTES + 512;
constexpr int LDS_TBL = RING_BYTES + 1024;
constexpr int LDS_BYTES = RING_BYTES + 1024 + 16384;

struct Frame {
    LAS unsigned char* lds;
    unsigned* ctl;
    unsigned char* ws;
    float* out;
    int tid, lane, wave, vcu;
};

__device__ __forceinline__ void refresh(Frame& F) { F.tid = opaque_tid(); F.lane = F.tid & 63; F.wave = __builtin_amdgcn_readfirstlane(F.tid >> 6); }
#if defined(PROBE_BAR2)
#define SYNC_GRID() do { xcd_barrier(bar); xcd_barrier(bar); refresh(F); } while (0)
#else
#define SYNC_GRID() do { xcd_barrier(bar); refresh(F); } while (0)
#endif
__device__ __forceinline__ int modrow_of(int row) { const int b = row / TPB, t = row - b * TPB; return t < CTX ? 8 : b; }

enum { MAP_ID = 0, MAP_ATTN_IN, MAP_SSM_IN, MAP_MLA_IN, MAP_MLA_QUP, MAP_MOE_G, MAP_MOE_U };
template <int KIND> __device__ __forceinline__ int map_row(int n, int aux) {
    if (KIND == MAP_ID) return aux + n;
    if (KIND == MAP_ATTN_IN) { if (n >= 1280) return n; const int hb = n & ~63, d = n & 63; return hb + (d < 32 ? 2 * d : 2 * (d - 32) + 1); }
    if (KIND == MAP_SSM_IN) {
        if (n < 2048) { const int gp = n >> 10; return gp * 2816 + (n & 1023); }
        if (n < 4096) { const int c = n - 2048, gp = c >> 10; return gp * 2816 + 1024 + (c & 1023); }
        if (n < 4608) { const int c = n - 4096, gp = c >> 8; return gp * 2816 + 2048 + (c & 255); }
        if (n < 5120) { const int c = n - 4608, gp = c >> 8; return gp * 2816 + 2304 + (c & 255); }
        { const int c = n - 5120, dir = c >> 5, h = c & 31, gp = h >> 4; return gp * 2816 + 2560 + dir * 16 + (h & 15); }
    }
    if (KIND == MAP_MLA_IN) { if (n < 512) return n; const int d = n - 512; return 512 + (d < 16 ? 2 * d : 2 * (d - 16) + 1); }
    if (KIND == MAP_MLA_QUP) { const int h = n / 96, e = n - h * 96; if (e < 64) return n; const int d = e - 64; return h * 96 + 64 + (d < 16 ? 2 * d : 2 * (d - 16) + 1); }
    if (KIND == MAP_MOE_G) return aux + (n >> 7) * 256 + (n & 127);
    if (KIND == MAP_MOE_U) return aux + (n >> 7) * 256 + 128 + (n & 127);
    return n;
}
template <int KIND>
__device__ __forceinline__ void transpose_item(const float* W, int K, int N, bf16* WT, int aux, const float* kscale, LAS float* scr, int item, int lane) {
    const int nblk = N / 32, kb = item / nblk, nb = item % nblk, k0 = 64 * kb, n0 = 32 * nb;
#pragma unroll 8
    for (int i = 0; i < 32; ++i) { const int kk = 2 * i + (lane >> 5); float v = W[(size_t)(k0 + kk) * N + n0 + (lane & 31)]; if (kscale) v *= kscale[k0 + kk]; scr[kk * 33 + (lane & 31)] = v; }
    LDS_WAIT(); asm volatile("" ::: "memory");
    const int c = lane & 7;
#pragma unroll
    for (int j = 0; j < 4; ++j) { const int n = (lane >> 3) + 8 * j; const LAS float* s = scr + (8 * c) * 33 + n;
        v4u o; o.x = cvt_pk_bf16(s[0 * 33], s[1 * 33]); o.y = cvt_pk_bf16(s[2 * 33], s[3 * 33]); o.z = cvt_pk_bf16(s[4 * 33], s[5 * 33]); o.w = cvt_pk_bf16(s[6 * 33], s[7 * 33]);
        *(v4u*)(WT + (size_t)map_row<KIND>(n0 + n, aux) * K + k0 + 8 * c) = o; }
    LDS_WAIT(); asm volatile("" ::: "memory");
}
template <int KIND>
__device__ __forceinline__ void convert_matrix(Frame& F, const float* W, int K, int N, bf16* WT, int aux, const float* kscale) {
    LAS float* scr = (LAS float*)(F.lds + F.wave * 16384);
    const int gw = F.vcu * NWAVES + F.wave, NGW = GRID * NWAVES, nitems = (K / 64) * (N / 32);
    for (int it = gw; it < nitems; it += NGW) transpose_item<KIND>(W, K, N, WT, aux, kscale, scr, it, F.lane);
}
__device__ __forceinline__ void zero_rows(Frame& F, bf16* WT, int row0, int nrows, int K) {
    const size_t n16 = (size_t)nrows * K / 8; v4u* p = (v4u*)(WT + (size_t)row0 * K);
    for (size_t i = (size_t)blockIdx.x * NTHR + F.tid; i < n16; i += (size_t)GRID * NTHR) p[i] = (v4u){0u, 0u, 0u, 0u};
}
__device__ __forceinline__ void convert_moe(Frame& F, const float* const* in, int layer) {
    bf16* GU = (bf16*)(F.ws + WS_WGU); bf16* DN = (bf16*)(F.ws + WS_WDN);
    const float* wg = in[12] + (size_t)layer * 16 * 1024 * 256; const float* wu = in[13] + (size_t)layer * 16 * 1024 * 256; const float* wd = in[14] + (size_t)layer * 16 * 256 * 1024;
    LAS float* scr = (LAS float*)(F.lds + F.wave * 16384);
    const int gw = F.vcu * NWAVES + F.wave, NGW = GRID * NWAVES;
    for (int it = gw; it < 16 * 384; it += NGW) { const int e = it / 384, r = it - e * 384, kind = r >> 7, sub = r & 127;
        if (kind == 0) transpose_item<MAP_MOE_G>(wg + (size_t)e * 1024 * 256, 1024, 256, GU, e * 512, nullptr, scr, sub, F.lane);
        else if (kind == 1) transpose_item<MAP_MOE_U>(wu + (size_t)e * 1024 * 256, 1024, 256, GU, e * 512, nullptr, scr, sub, F.lane);
        else transpose_item<MAP_ID>(wd + (size_t)e * 256 * 1024, 256, 1024, DN, e * 1024, nullptr, scr, sub, F.lane); }
}

__device__ __forceinline__ const float* src_row(const float* const* in, int r) { const int b = r / TPB, t = r - b * TPB; return t < CTX ? in[2] + ((size_t)b * CTX + t) * D : in[0] + ((size_t)b * SEQ + (t - CTX)) * D; }
__device__ __forceinline__ float row_load_ss(const bf16* xrow, int lane, f32x4 (&v)[4]) {
    const v4u a = *((const v4u*)xrow + lane), b = *((const v4u*)xrow + 64 + lane);
    v[0] = (f32x4){bflo(a.x), bfhi(a.x), bflo(a.y), bfhi(a.y)}; v[1] = (f32x4){bflo(a.z), bfhi(a.z), bflo(a.w), bfhi(a.w)};
    v[2] = (f32x4){bflo(b.x), bfhi(b.x), bflo(b.y), bfhi(b.y)}; v[3] = (f32x4){bflo(b.z), bfhi(b.z), bflo(b.w), bfhi(b.w)};
    float s = 0.f;
#pragma unroll
    for (int j = 0; j < 4; ++j) s += (v[j].x * v[j].x + v[j].y * v[j].y) + (v[j].z * v[j].z + v[j].w * v[j].w);
    return s;
}
__device__ __forceinline__ float row_load_ss_f32(const float* xrow, int lane, f32x4 (&v)[4]) {
    float s = 0.f;
#pragma unroll
    for (int j = 0; j < 2; ++j) { v[2 * j] = *(const f32x4*)(xrow + 512 * j + 8 * lane); v[2 * j + 1] = *(const f32x4*)(xrow + 512 * j + 8 * lane + 4); }
#pragma unroll
    for (int j = 0; j < 4; ++j) s += (v[j].x * v[j].x + v[j].y * v[j].y) + (v[j].z * v[j].z + v[j].w * v[j].w);
    return s;
}
__device__ __forceinline__ void row_finish(const f32x4 (&v)[4], float ss, const float* g, const float* sc, const float* sh, bf16* orow, int lane, f32x4 (&hv)[4]) {
    const float rstd = rsqrtf(ss * (1.f / D) + EPS);
#pragma unroll
    for (int j = 0; j < 2; ++j) {
#pragma unroll
        for (int q = 0; q < 2; ++q) { const int o = 512 * j + 8 * lane + 4 * q;
            hv[2 * j + q] = v[2 * j + q] * rstd * *(const f32x4*)(g + o) * (*(const f32x4*)(sc + o) + 1.0f) + *(const f32x4*)(sh + o); }
        *((v4u*)orow + 64 * j + lane) = pack8(hv[2 * j], hv[2 * j + 1]);
    }
}
__device__ __forceinline__ void phase_norm1(Frame& F, const float* const* in, int layer) {
    const bf16* X = (const bf16*)(F.ws + WS_X); bf16* H = (bf16*)(F.ws + WS_H);
    const float* g = in[4] + layer * D; const float* mod = (const float*)(F.ws + WS_MOD) + (size_t)layer * 9 * 6144;
    const int gw = F.vcu * NWAVES + F.wave, NGW = GRID * NWAVES;
    for (int r = gw; r < M; r += 2 * NGW) { const int r2 = r + NGW; const bool two = r2 < M; f32x4 va[4], vb[4], hv[4];
        float sa = layer == 0 ? row_load_ss_f32(src_row(in, r), F.lane, va) : row_load_ss(X + (size_t)r * D, F.lane, va), sb = 0.f;
        if (two) sb = layer == 0 ? row_load_ss_f32(src_row(in, r2), F.lane, vb) : row_load_ss(X + (size_t)r2 * D, F.lane, vb);
        sa = wave_sum(sa); sb = wave_sum(sb);
        { const float* mr = mod + (size_t)modrow_of(r) * 6144; row_finish(va, sa, g, mr + 1024, mr, H + (size_t)r * D, F.lane, hv); }
        if (two) { const float* mr = mod + (size_t)modrow_of(r2) * 6144; row_finish(vb, sb, g, mr + 1024, mr, H + (size_t)r2 * D, F.lane, hv); } }
}

__device__ __forceinline__ void phase_prologue(Frame& F, const float* const* in) {
    { f32x2* TA = (f32x2*)(F.ws + WS_TABA); f32x2* TM = (f32x2*)(F.ws + WS_TABM);
      for (int i = blockIdx.x * NTHR + F.tid; i < SEQ * 32; i += GRID * NTHR) { const int pos = i >> 5, a = i & 31; const float p = (a < 16) ? (float)(pos >> 6) : (float)(pos & 63);
          const float inv = fast_exp2(-(float)(a & 15) * (13.287712379549449f / 16.0f)); const float rev = p * inv * 0.15915494309189535f; TA[i] = (f32x2){__builtin_amdgcn_cosf(rev), __builtin_amdgcn_sinf(rev)}; }
      for (int i = blockIdx.x * NTHR + F.tid; i < SEQ * 16; i += GRID * NTHR) { const int pos = i >> 4, a = i & 15; const float p = (a < 8) ? (float)(pos >> 6) : (float)(pos & 63);
          const float inv = fast_exp2(-(float)(a & 7) * (13.287712379549449f / 8.0f)); const float rev = p * inv * 0.15915494309189535f; TM[i] = (f32x2){__builtin_amdgcn_cosf(rev), __builtin_amdgcn_sinf(rev)}; } }
    { LAS float* sc = (LAS float*)F.lds;
      LAS float* part = (LAS float*)(F.lds + 40960);
      for (int i = F.tid; i < 9 * 1024; i += NTHR) { const int r = i >> 10, k = i & 1023; const float c = r < 8 ? in[1][r * 1024 + k] : in[3][k]; sc[i] = silu_f(c); }
      __syncthreads();
      float* MOD = (float*)(F.ws + WS_MOD);
      const int cq = F.tid & 15, ks = F.tid >> 4;
      for (int u = F.vcu; u < 4 * 96; u += GRID) { const int l = u / 96, cb = u % 96;
          const float* w = in[6] + (size_t)l * 1024 * 6144 + cb * 64 + cq * 4; f32x4 a[9];
#pragma unroll
          for (int r = 0; r < 9; ++r) a[r] = (f32x4){0.f, 0.f, 0.f, 0.f};
#pragma unroll 8
          for (int k = ks * 32; k < ks * 32 + 32; ++k) { const f32x4 wv = *(const f32x4*)(w + (size_t)k * 6144);
#pragma unroll
              for (int r = 0; r < 9; ++r) a[r] = a[r] + wv * sc[r * 1024 + k]; }
#pragma unroll
          for (int r = 0; r < 9; ++r) *(LAS f32x4*)(part + (ks * 9 + r) * 64 + cq * 4) = a[r];
          __syncthreads();
          for (int i = F.tid; i < 9 * 64; i += NTHR) { const int r = i >> 6, c = i & 63; float s = 0.f;
#pragma unroll
              for (int q = 0; q < 32; ++q) s += part[(q * 9 + r) * 64 + c];
              MOD[((size_t)l * 9 + r) * 6144 + cb * 64 + c] = s + in[7][l * 6144 + cb * 64 + c]; }
          __syncthreads(); } }
}

__device__ __forceinline__ void phase_norm2_route(Frame& F, const float* const* in, int layer, bool dry = false) {
    constexpr int RPW = M / GRID;
    LAS float* wl = (LAS float*)F.lds;
    LAS int* lcnt = (LAS int*)(F.lds + 81920);
    LAS int* lbase = (LAS int*)(F.lds + 81920 + 128);
    LAS int* rcls = (LAS int*)(F.lds + 81920 + 256);
    LAS int* rrank = (LAS int*)(F.lds + 81920 + 256 + 1024);
    LAS float* lgw = (LAS float*)(F.lds + 81920 + 4096);
    const float* wrg = in[8] + (size_t)layer * 1024 * 4; const float* wre = in[10] + (size_t)layer * 1024 * 16;
    for (int i = F.tid; i < 1024 * 4; i += NTHR) { const int k = i >> 2, o = i & 3; wl[o * 1024 + k] = wrg[i]; }
    for (int i = F.tid; i < 1024 * 16; i += NTHR) { const int k = i >> 4, o = i & 15; wl[(4 + o) * 1024 + k] = wre[i]; }
    if (F.tid < 24) lcnt[F.tid] = 0;
    __syncthreads();
    const bf16* X = (const bf16*)(F.ws + WS_X); bf16* H = (bf16*)(F.ws + WS_H);
    const float* g = in[5] + layer * D; const float* mod = (const float*)(F.ws + WS_MOD) + (size_t)layer * 9 * 6144;
    const float* brg = in[9] + layer * 4; const float* bre = in[11] + layer * 16;
    float* WT = (float*)(F.ws + MOE_WT); int* SL = (int*)(F.ws + MOE_SL);
    const int row0 = blockIdx.x * RPW;
    for (int i0 = F.wave; i0 < RPW; i0 += 2 * NWAVES) { const int i1 = i0 + NWAVES; const bool two = i1 < RPW; const int ra = row0 + i0, rb = two ? row0 + i1 : ra;
        f32x4 va[4], vb[4], ha[4], hb[4];
        float sa = row_load_ss(X + (size_t)ra * D, F.lane, va), sb = row_load_ss(X + (size_t)rb * D, F.lane, vb);
        sa = wave_sum(sa); sb = wave_sum(sb);
        { const float* mr = mod + (size_t)modrow_of(ra) * 6144; row_finish(va, sa, g, mr + 4 * 1024, mr + 3 * 1024, H + (size_t)ra * D, F.lane, ha); }
        { const float* mr = mod + (size_t)modrow_of(rb) * 6144; row_finish(vb, sb, g, mr + 4 * 1024, mr + 3 * 1024, H + (size_t)rb * D, F.lane, hb); }
        LAS float* lgs = lgw + F.wave * 64;
        for (int o = 0; o < 20; ++o) { float s = 0.f, t = 0.f;
#pragma unroll
            for (int j = 0; j < 4; ++j) { const f32x4 w = *(const LAS f32x4*)(wl + o * 1024 + 512 * (j >> 1) + 8 * F.lane + 4 * (j & 1));
                s += (ha[j].x * w.x + ha[j].y * w.y) + (ha[j].z * w.z + ha[j].w * w.w); t += (hb[j].x * w.x + hb[j].y * w.y) + (hb[j].z * w.z + hb[j].w * w.w); }
            s = wave_sum(s); t = wave_sum(t); if (F.lane == 0) { lgs[o] = s; lgs[32 + o] = t; } }
        LDS_WAIT(); asm volatile("" ::: "memory");
        for (int q = 0; q < (two ? 2 : 1); ++q) { const LAS float* lq_ = lgs + 32 * q; const int r = q ? rb : ra, i = q ? i1 : i0;
        float g0 = lq_[0] + brg[0], g1 = lq_[1] + brg[1], g2 = lq_[2] + brg[2], g3 = lq_[3] + brg[3];
        int gs = 0; float gm = g0; if (g1 > gm) { gm = g1; gs = 1; } if (g2 > gm) { gm = g2; gs = 2; } if (g3 > gm) { gm = g3; gs = 3; }
        const float pg = 1.0f / (fast_exp(g0 - gm) + fast_exp(g1 - gm) + fast_exp(g2 - gm) + fast_exp(g3 - gm));
        float e0 = lq_[4 + gs * 4 + 0] + bre[gs * 4 + 0], e1 = lq_[4 + gs * 4 + 1] + bre[gs * 4 + 1], e2 = lq_[4 + gs * 4 + 2] + bre[gs * 4 + 2], e3 = lq_[4 + gs * 4 + 3] + bre[gs * 4 + 3];
        int i1x = 0; float v1 = e0; if (e1 > v1) { v1 = e1; i1x = 1; } if (e2 > v1) { v1 = e2; i1x = 2; } if (e3 > v1) { v1 = e3; i1x = 3; }
        int i2x = -1; float v2 = -3.0e38f;
        if (i1x != 0 && e0 > v2) { v2 = e0; i2x = 0; } if (i1x != 1 && e1 > v2) { v2 = e1; i2x = 1; } if (i1x != 2 && e2 > v2) { v2 = e2; i2x = 2; } if (i1x != 3 && e3 > v2) { v2 = e3; i2x = 3; }
        const float ex = fast_exp(v2 - v1), w1 = pg / (1.0f + ex), w2 = pg * ex / (1.0f + ex);
        const int lo = i1x < i2x ? i1x : i2x, hi = i1x < i2x ? i2x : i1x; const float wlo = i1x < i2x ? w1 : w2, whi = i1x < i2x ? w2 : w1;
        const int pair = lo == 0 ? hi - 1 : (lo == 1 ? hi + 1 : 5);
        const int cls = gs * 6 + pair;
        if (F.lane == 0 && !dry) { WT[2 * (size_t)r] = wlo; WT[2 * (size_t)r + 1] = whi; rcls[i] = cls; rrank[i] = atomicAdd((int*)&lcnt[cls], 1); }
        }
        LDS_WAIT(); asm volatile("" ::: "memory");
    }
    __syncthreads();
    if (dry) return;
    if (F.tid < 24) lbase[F.tid] = (int)atomicAdd(F.ctl + CW_MOECNT + layer * 64 + F.tid, (unsigned)lcnt[F.tid]);
    __syncthreads();
    for (int i = F.tid; i < RPW; i += NTHR) { const int c = rcls[i]; SL[(size_t)c * M + lbase[c] + rrank[i]] = row0 + i; }
}

__device__ __forceinline__ void phase_final(Frame& F, const float* const* in, bool poison) {
    const bf16* X = (const bf16*)(F.ws + WS_X); const float* g = in[36];
    const int gw = F.vcu * NWAVES + F.wave, NGW = GRID * NWAVES;
    for (int q = gw; q < NB * SEQ; q += 2 * NGW) { const int q2 = q + NGW;
        const int ra = (q / SEQ) * TPB + CTX + (q % SEQ), rb = (q2 / SEQ) * TPB + CTX + (q2 % SEQ); f32x4 va[4], vb[4];
        float sa = row_load_ss(X + (size_t)ra * D, F.lane, va), sb = row_load_ss(X + (size_t)rb * D, F.lane, vb);
        sa = wave_sum(sa); sb = wave_sum(sb);
        float rsa = rsqrtf(sa * (1.f / D) + EPS), rsb = rsqrtf(sb * (1.f / D) + EPS); if (poison) { rsa = __builtin_nanf(""); rsb = rsa; }
        float* oa = F.out + (size_t)q * D; float* ob = F.out + (size_t)q2 * D;
#pragma unroll
        for (int j = 0; j < 4; ++j) { const int o = 512 * (j >> 1) + 8 * F.lane + 4 * (j & 1); const f32x4 gg = *(const f32x4*)(g + o); *(f32x4*)(oa + o) = va[j] * rsa * gg; *(f32x4*)(ob + o) = vb[j] * rsb * gg; } }
}
typedef f32x4 AccT[2][2][4][2];
using pg8::Unit;

__device__ __forceinline__ void rope8(f32x4& a, f32x4& b, const f32x2* cs) {
    const f32x4 c01 = *(const f32x4*)cs, c23 = *(const f32x4*)(cs + 2);
    float t;
    t = a[0] * c01[0] - a[1] * c01[1]; a[1] = a[1] * c01[0] + a[0] * c01[1]; a[0] = t;
    t = a[2] * c01[2] - a[3] * c01[3]; a[3] = a[3] * c01[2] + a[2] * c01[3]; a[2] = t;
    t = b[0] * c23[0] - b[1] * c23[1]; b[1] = b[1] * c23[0] + b[0] * c23[1]; b[0] = t;
    t = b[2] * c23[2] - b[3] * c23[3]; b[3] = b[3] * c23[2] + b[2] * c23[3]; b[2] = t;
}

__device__ __forceinline__ void unpack8(const v4u w, f32x4& a, f32x4& b) { a = (f32x4){bflo(w.x), bfhi(w.x), bflo(w.y), bfhi(w.y)}; b = (f32x4){bflo(w.z), bfhi(w.z), bflo(w.w), bfhi(w.w)}; }
struct EpiResid {
    static constexpr bool PERM = true;
    bf16* X; const float* gate; const float* x_in; const float* ctx_in;
    __device__ __forceinline__ void operator()(const AccT& acc, const Unit& u, int ui, int wr, int wc, int fr, int fq) const {
        const int tb = u.pm % 17, b = u.pm / 17; const float* gv = gate + (size_t)(tb == 0 ? 8 : b) * 6144;
        const float* src = x_in ? (tb == 0 ? ctx_in + (size_t)b * CTX * D : x_in + ((size_t)b * SEQ + (tb - 1) * 256) * D) : nullptr;
        const int rl0 = wr * 64 + fr, col0 = u.pn * 256 + wc * 32 + 8 * fq;
        f32x4 g4[2][2];
#pragma unroll
        for (int bj = 0; bj < 2; ++bj)
#pragma unroll
            for (int n = 0; n < 2; ++n) g4[bj][n] = *(const f32x4*)(gv + col0 + bj * 128 + n * 4);
#pragma unroll
        for (int ai = 0; ai < 2; ++ai)
#pragma unroll
            for (int mp = 0; mp < 2; ++mp) { f32x4 xin[2][2][2];
#pragma unroll
                for (int mm = 0; mm < 2; ++mm) { const int rl = rl0 + ai * 128 + (2 * mp + mm) * 16;
#pragma unroll
                    for (int bj = 0; bj < 2; ++bj) {
                        if (src) { const float* sp = src + (size_t)rl * D + col0 + bj * 128; xin[mm][bj][0] = *(const f32x4*)sp; xin[mm][bj][1] = *(const f32x4*)(sp + 4); }
                        else unpack8(*(const v4u*)(X + ((size_t)u.pm * 256 + rl) * D + col0 + bj * 128), xin[mm][bj][0], xin[mm][bj][1]); } }
#pragma unroll
                for (int mm = 0; mm < 2; ++mm) { const int rl = rl0 + ai * 128 + (2 * mp + mm) * 16;
#pragma unroll
                    for (int bj = 0; bj < 2; ++bj) *(v4u*)(X + ((size_t)u.pm * 256 + rl) * D + col0 + bj * 128) =
                        pack8(xin[mm][bj][0] + g4[bj][0] * acc[ai][bj][2 * mp + mm][0], xin[mm][bj][1] + g4[bj][1] * acc[ai][bj][2 * mp + mm][1]); }
                asm volatile("" ::: "memory"); }
    }
};

struct EpiAttnIn {
    static constexpr bool PERM = true;
    bf16 *Q, *Kb, *Vb; const f32x2* tab; float qscale;
    __device__ __forceinline__ void operator()(const AccT& acc, const Unit& u, int ui, int wr, int wc, int fr, int fq) const {
        const int tb = u.pm % 17; const bool lat = tb != 0; const int pos0 = (tb - 1) * 256;
        bf16* base; int ld, colt; float sc = 1.f; bool rope = lat;
        if (u.pn < 4) { base = Q; ld = 1024; colt = u.pn * 256; sc = qscale; } else if (u.pn == 4) { base = Kb; ld = 256; colt = 0; } else { base = Vb; ld = 256; colt = 0; rope = false; }
#pragma unroll
        for (int ai = 0; ai < 2; ++ai)
#pragma unroll
            for (int m = 0; m < 4; ++m) { const int rl = ai * 128 + wr * 64 + m * 16 + fr; const size_t row = (size_t)u.pm * 256 + rl;
#pragma unroll
                for (int bj = 0; bj < 2; ++bj) { const int cl = bj * 128 + wc * 32 + 8 * fq;
                    f32x4 a = acc[ai][bj][m][0] * sc, b = acc[ai][bj][m][1] * sc;
                    if (rope) rope8(a, b, tab + (size_t)(pos0 + rl) * 32 + ((cl & 63) >> 1));
                    *(v4u*)(base + row * ld + colt + cl) = pack8(a, b); }
                asm volatile("" ::: "memory"); }
    }
};

struct EpiSsmIn {
    static constexpr bool PERM = true;
    bf16 *Z, *XBC; float* DT; const float* dtb;
    __device__ __forceinline__ void operator()(const AccT& acc, const Unit& u, int ui, int wr, int wc, int fr, int fq) const {
#pragma unroll
        for (int ai = 0; ai < 2; ++ai)
#pragma unroll
            for (int m = 0; m < 4; ++m) { const size_t row = (size_t)u.pm * 256 + ai * 128 + wr * 64 + m * 16 + fr;
#pragma unroll
                for (int bj = 0; bj < 2; ++bj) { const int c = u.pn * 256 + bj * 128 + wc * 32 + 8 * fq;
                    const f32x4 a = acc[ai][bj][m][0], b = acc[ai][bj][m][1];
                    if (c < 1024) *(v4u*)(Z + row * 1024 + c) = pack8(a, b);
                    else if (c < 2560) *(v4u*)(XBC + row * 1536 + (c - 1024)) = pack8(a, b);
                    else if (c < 2592) { const int cc = c - 2560; f32x4 o0, o1;
#pragma unroll
                        for (int j = 0; j < 4; ++j) { o0[j] = softplus_f(a[j] + dtb[(cc >> 4) * 32 + (cc & 15) + j]); o1[j] = softplus_f(b[j] + dtb[(cc >> 4) * 32 + (cc & 15) + 4 + j]); }
                        *(f32x4*)(DT + row * 32 + cc) = o0; *(f32x4*)(DT + row * 32 + cc + 4) = o1; } } }
    }
};

struct EpiMlIn {
    static constexpr bool PERM = true;
    bf16 *Qm, *Km, *Vm, *Om; float* G; const float* gb;
    __device__ __forceinline__ void operator()(const AccT& acc, const Unit& u, int ui, int wr, int wc, int fr, int fq) const {
#pragma unroll
        for (int ai = 0; ai < 2; ++ai)
#pragma unroll
            for (int m = 0; m < 4; ++m) { const size_t row = (size_t)u.pm * 256 + ai * 128 + wr * 64 + m * 16 + fr;
#pragma unroll
                for (int bj = 0; bj < 2; ++bj) { const int c = u.pn * 256 + bj * 128 + wc * 32 + 8 * fq;
                    const f32x4 a = acc[ai][bj][m][0], b = acc[ai][bj][m][1];
                    if (c < 512) *(v4u*)(Qm + row * 512 + c) = pack8(a, b);
                    else if (c < 1024) *(v4u*)(Km + row * 512 + (c - 512)) = pack8(a * 0.125f, b * 0.125f);
                    else if (c < 2048) *(v4u*)(Vm + row * 1024 + (c - 1024)) = pack8(a, b);
                    else if (c < 3072) *(v4u*)(Om + row * 1024 + (c - 2048)) = pack8(a, b);
                    else if (c < 3104) { const int cc = c - 3072; f32x4 o0, o1; const bool fg = ((cc >> 3) & 1) != 0;
#pragma unroll
                        for (int j = 0; j < 4; ++j) { float x0 = a[j] + gb[cc + j], x1 = b[j] + gb[cc + 4 + j];
                            o0[j] = fg ? -softplus_f(-x0) : x0; o1[j] = fg ? -softplus_f(-x1) : x1; }
                        *(f32x4*)(G + row * 32 + cc) = o0; *(f32x4*)(G + row * 32 + cc + 4) = o1; } } }
    }
};

struct EpiMlaIn {
    static constexpr bool PERM = true;
    bf16 *CQ, *CKV, *KF; float* SSQ; const f32x2* tab;
    __device__ __forceinline__ void operator()(const AccT& acc, const Unit& u, int ui, int wr, int wc, int fr, int fq) const {
        const int tb = u.pm % 17; const bool lat = tb != 0; const int pos0 = (tb - 1) * 256;
#pragma unroll
        for (int ai = 0; ai < 2; ++ai)
#pragma unroll
            for (int m = 0; m < 4; ++m) { const int rl = ai * 128 + wr * 64 + m * 16 + fr; const size_t row = (size_t)u.pm * 256 + rl;
                if (u.pn < 2) { bf16* dst = u.pn == 0 ? CQ : CKV; float ss = 0.f;
#pragma unroll
                    for (int bj = 0; bj < 2; ++bj) { const int c = bj * 128 + wc * 32 + 8 * fq; const f32x4 a = acc[ai][bj][m][0], b = acc[ai][bj][m][1];
                        ss += (a[0] * a[0] + a[1] * a[1]) + (a[2] * a[2] + a[3] * a[3]) + (b[0] * b[0] + b[1] * b[1]) + (b[2] * b[2] + b[3] * b[3]);
                        *(v4u*)(dst + row * 256 + c) = pack8(a, b); }
                    ss += __shfl_xor(ss, 16); ss += __shfl_xor(ss, 32);
                    if (fq == 0) SSQ[row * 8 + u.pn * 4 + wc] = ss;
                } else if (wc == 0) {
                    f32x4 a = acc[ai][0][m][0], b = acc[ai][0][m][1]; const int cl = 8 * fq;
                    if (lat) rope8(a, b, tab + (size_t)(pos0 + rl) * 16 + (cl >> 1));
                    const v4u w = pack8(a, b);
#pragma unroll
                    for (int h = 0; h < 16; ++h) *(v4u*)(KF + row * 1536 + h * 96 + 64 + cl) = w; }
                asm volatile("" ::: "memory"); }
    }
};
struct EpiMlaQ {
    static constexpr bool PERM = true;
    bf16* Q3; const float* SSQ; const f32x2* tab; float qscale;
    __device__ __forceinline__ void operator()(const AccT& acc, const Unit& u, int ui, int wr, int wc, int fr, int fq) const {
        const int tb = u.pm % 17; const bool lat = tb != 0; const int pos0 = (tb - 1) * 256;
#pragma unroll
        for (int ai = 0; ai < 2; ++ai)
#pragma unroll
            for (int m = 0; m < 4; ++m) { const int rl = ai * 128 + wr * 64 + m * 16 + fr; const size_t row = (size_t)u.pm * 256 + rl;
                const f32x4 s4 = *(const f32x4*)(SSQ + row * 8); const float rs = rsqrtf(((s4[0] + s4[1]) + (s4[2] + s4[3])) * (1.f / 256.f) + EPS) * qscale;
#pragma unroll
                for (int bj = 0; bj < 2; ++bj) { const int c = u.pn * 256 + bj * 128 + wc * 32 + 8 * fq; const int e = c % 96;
                    f32x4 a = acc[ai][bj][m][0] * rs, b = acc[ai][bj][m][1] * rs;
                    if (lat && e >= 64) rope8(a, b, tab + (size_t)(pos0 + rl) * 16 + ((e - 64) >> 1));
                    *(v4u*)(Q3 + row * 1536 + c) = pack8(a, b); }
                asm volatile("" ::: "memory"); }
    }
};
struct EpiMlaKV {
    static constexpr bool PERM = true;
    bf16 *KF, *V3; const float* SSQ;
    __device__ __forceinline__ void operator()(const AccT& acc, const Unit& u, int ui, int wr, int wc, int fr, int fq) const {
#pragma unroll
        for (int ai = 0; ai < 2; ++ai)
#pragma unroll
            for (int m = 0; m < 4; ++m) { const size_t row = (size_t)u.pm * 256 + ai * 128 + wr * 64 + m * 16 + fr;
                const f32x4 s4 = *(const f32x4*)(SSQ + row * 8 + 4); const float rs = rsqrtf(((s4[0] + s4[1]) + (s4[2] + s4[3])) * (1.f / 256.f) + EPS);
#pragma unroll
                for (int bj = 0; bj < 2; ++bj) { const int c = u.pn * 256 + bj * 128 + wc * 32 + 8 * fq; const int h = c >> 7, e = c & 127;
                    const v4u w = pack8(acc[ai][bj][m][0] * rs, acc[ai][bj][m][1] * rs);
                    if (e < 64) *(v4u*)(KF + row * 1536 + h * 96 + e) = w; else *(v4u*)(V3 + row * 1024 + h * 64 + (e - 64)) = w; }
                asm volatile("" ::: "memory"); }
    }
};

struct TblEnt { int tok; float w0, w1; int pad; };
__device__ __forceinline__ int cls_expert(int cls, int which) { const int g = cls / 6, p = cls - g * 6; const int lo = p < 3 ? 0 : (p < 5 ? 1 : 2), hi = p < 3 ? p + 1 : (p < 5 ? p - 1 : 3); return g * 4 + (which ? hi : lo); }
template <int MODE> struct MoeOrder {
    static constexpr bool GATHER = (MODE == 0);
    const LAS int* tb;
    const LAS TblEnt* tbl;
    const bf16* W; int G, c;
    __device__ __forceinline__ bool next(int i, Unit& u) const {
        const int L = i * G + c, tile = L >> 2; if (tile >= tb[24]) return false;
        int cls = 0;
#pragma unroll
        for (int k = 1; k < 24; ++k) cls += (tile >= tb[k]) ? 1 : 0;
        u.pm = tile; u.pn = L & 3; u.aux = cls | (i << 8); return true;
    }
    __device__ __forceinline__ int a_row(const Unit& u, int r) const {
        if (MODE == 1) return u.pm * 256 + r;
        const int t = tbl[(u.aux >> 8) * 256 + r].tok; return t < 0 ? 0 : t;
    }
    __device__ __forceinline__ const char* b_seg(const Unit& u, int seg) const {
        const int cls = u.aux & 255;
        if (MODE == 0) return (const char*)(W + ((size_t)cls_expert(cls, u.pn >> 1) * 512 + (u.pn & 1) * 256) * 1024);
        return (const char*)(W + ((size_t)cls_expert(cls, seg) * 1024 + u.pn * 256) * 256);
    }
};
template <int MODE> __device__ __forceinline__ void moe_setup(Frame& F, int layer, MoeOrder<MODE>& S) {
    LAS int* tb = (LAS int*)(F.lds + LDS_TB); LAS int* cn = tb + 32; LAS TblEnt* tbl = (LAS TblEnt*)(F.lds + LDS_TBL);
    if (F.tid == 0) { int t = 0; for (int k = 0; k < 24; ++k) { const int n = (int)__hip_atomic_load(F.ctl + CW_MOECNT + layer * 64 + k, RLX_AGENT); cn[k] = n; tb[k] = t; t += (n + 255) >> 8; } tb[24] = t; }
    __syncthreads();
    S.tb = tb; S.tbl = tbl;
    const int* SL = (const int*)(F.ws + MOE_SL); const float* WT = (const float*)(F.ws + MOE_WT);
    for (int i = 0; i < 4; ++i) { Unit u; if (!S.next(i, u)) break;
        if (F.tid < 256) { const int cls = u.aux & 255, idx = (u.pm - tb[cls]) * 256 + F.tid; TblEnt e; e.pad = 0;
            if (idx < cn[cls]) { e.tok = SL[(size_t)cls * M + idx]; e.w0 = WT[2 * (size_t)e.tok]; e.w1 = WT[2 * (size_t)e.tok + 1]; } else { e.tok = -1; e.w0 = 0.f; e.w1 = 0.f; }
            LAS TblEnt* te = tbl + i * 256 + F.tid; te->tok = e.tok; te->w0 = e.w0; te->w1 = e.w1; te->pad = 0; } }
    __syncthreads();
}
struct EpiMoeAct {
    static constexpr bool PERM = true;
    bf16* ACT; const LAS TblEnt* tbl;
    __device__ __forceinline__ void operator()(const AccT& acc, const Unit& u, int ui, int wr, int wc, int fr, int fq) const {
        const int slot = u.pn >> 1, colb = slot * 256 + (u.pn & 1) * 128 + wc * 32 + 8 * fq;
#pragma unroll
        for (int ai = 0; ai < 2; ++ai)
#pragma unroll
            for (int m = 0; m < 4; ++m) { const int rl = ai * 128 + wr * 64 + m * 16 + fr; const LAS TblEnt* te = tbl + (u.aux >> 8) * 256 + rl; const float w = slot ? te->w1 : te->w0;
                f32x4 a, b;
#pragma unroll
                for (int j = 0; j < 4; ++j) { a[j] = silu_f(acc[ai][0][m][0][j]) * acc[ai][1][m][0][j] * w; b[j] = silu_f(acc[ai][0][m][1][j]) * acc[ai][1][m][1][j] * w; }
                *(v4u*)(ACT + ((size_t)u.pm * 256 + rl) * 512 + colb) = pack8(a, b);
                asm volatile("" ::: "memory"); }
    }
};
struct EpiMoeDown {
    static constexpr bool PERM = true;
    bf16* X; const float* gate; const LAS TblEnt* tbl;
    __device__ __forceinline__ void operator()(const AccT& acc, const Unit& u, int ui, int wr, int wc, int fr, int fq) const {
        const int col0 = u.pn * 256 + wc * 32 + 8 * fq;
#pragma unroll
        for (int ai = 0; ai < 2; ++ai)
#pragma unroll
            for (int mp = 0; mp < 2; ++mp) { f32x4 xin[2][2][2], gin[2][2][2]; int tk[2];
#pragma unroll
                for (int mm = 0; mm < 2; ++mm) { const int rl = ai * 128 + wr * 64 + (2 * mp + mm) * 16 + fr; const int tok = tbl[(u.aux >> 8) * 256 + rl].tok; tk[mm] = tok; const int t0 = tok < 0 ? 0 : tok;
                    const bf16* rowp = X + (size_t)t0 * D + col0; const float* gv = gate + (size_t)modrow_of(t0) * 6144 + col0;
#pragma unroll
                    for (int bj = 0; bj < 2; ++bj) { unpack8(*(const v4u*)(rowp + bj * 128), xin[mm][bj][0], xin[mm][bj][1]); gin[mm][bj][0] = *(const f32x4*)(gv + bj * 128); gin[mm][bj][1] = *(const f32x4*)(gv + bj * 128 + 4); } }
#pragma unroll
                for (int mm = 0; mm < 2; ++mm) { if (tk[mm] >= 0) { bf16* rowp = X + (size_t)tk[mm] * D + col0;
#pragma unroll
                    for (int bj = 0; bj < 2; ++bj) *(v4u*)(rowp + bj * 128) = pack8(xin[mm][bj][0] + gin[mm][bj][0] * acc[ai][bj][2 * mp + mm][0], xin[mm][bj][1] + gin[mm][bj][1] * acc[ai][bj][2 * mp + mm][1]); } }
                asm volatile("" ::: "memory"); }
    }
};
template <int DQK, bool WIN>
__device__ __forceinline__ void flash_unit(LAS unsigned char* lds, const int tid, const int lane, const int grpB,
        const bf16* Kg, const int ldk, const bf16* Vg, const int ldv,
        const bf16* Qg, const int ldq, bf16* Og, const int ldo,
        const int ntiles, const int krow_ctx0, const int krow_lat0, const int kpos0, const int qpos_wave, const float sink2, const bool has_sink) {
    constexpr int KSTR = DQK * 2 + 16, VSTR = 160, KBUF = 64 * KSTR, VBUF = 64 * VSTR, CPR = DQK / 8, NKC = 64 * CPR, NKR = (NKC + 511) / 512, NKS = DQK / 32;
    LAS unsigned char* Kl = lds; LAS unsigned char* Vl = lds + 2 * KBUF;
    const int fr = lane & 15, fq = lane >> 4;
    bf16x8 qf[2][NKS];
#pragma unroll
    for (int qt = 0; qt < 2; ++qt)
#pragma unroll
        for (int ks = 0; ks < NKS; ++ks) qf[qt][ks] = *(const bf16x8*)(Qg + (size_t)(16 * qt + fr) * ldq + 32 * ks + 8 * fq);
    f32x4 oacc[4][2];
#pragma unroll
    for (int c = 0; c < 4; ++c) { oacc[c][0] = (f32x4){0.f, 0.f, 0.f, 0.f}; oacc[c][1] = (f32x4){0.f, 0.f, 0.f, 0.f}; }
    float mrun[2] = {-1.0e30f, -1.0e30f}, lsum[2] = {0.f, 0.f};
    v4u kreg[NKR], vreg;
    bf16x8 pf[2][2]; bool pvalid = false; int pvb = 0;
#pragma unroll
    for (int a = 0; a < 2; ++a)
#pragma unroll
        for (int b2 = 0; b2 < 2; ++b2)
#pragma unroll
            for (int e = 0; e < 8; ++e) pf[a][b2][e] = 0;
#define FA_LOAD(j) do { const int _rb = (j) < 4 ? krow_ctx0 + 64 * (j) : krow_lat0 + 64 * ((j) - 4); \
        _Pragma("unroll") for (int _i = 0; _i < NKR; ++_i) { const int _c = tid + 512 * _i; if (_c < NKC) kreg[_i] = *(const v4u*)(Kg + (size_t)(_rb + _c / CPR) * ldk + (_c % CPR) * 8); } \
        vreg = *(const v4u*)(Vg + (size_t)(_rb + (tid >> 3)) * ldv + (tid & 7) * 8); } while (0)
#define FA_STORE(kb, vb) do { _Pragma("unroll") for (int _i = 0; _i < NKR; ++_i) { const int _c = tid + 512 * _i; if (_c < NKC) *(LAS v4u*)(Kl + (kb) * KBUF + (_c / CPR) * KSTR + (_c % CPR) * 16) = kreg[_i]; } \
        *(LAS v4u*)(Vl + (vb) * VBUF + (tid >> 3) * VSTR + (tid & 7) * 16) = vreg; } while (0)
#define FA_PV(vbuf) do { _Pragma("unroll") for (int ks2 = 0; ks2 < 2; ++ks2) _Pragma("unroll") for (int c = 0; c < 4; ++c) { \
            const LAS unsigned char* vb_ = Vl + (vbuf) * VBUF + (32 * ks2 + 4 * fq + ((lane & 15) >> 2)) * VSTR + (16 * c + 4 * (lane & 3)) * 2; \
            const s16x4 v0 = __builtin_amdgcn_ds_read_tr16_b64_v4i16((LAS s16x4*)vb_); const s16x4 v1 = __builtin_amdgcn_ds_read_tr16_b64_v4i16((LAS s16x4*)(vb_ + 16 * VSTR)); \
            bf16x8 vf; vf[0] = v0[0]; vf[1] = v0[1]; vf[2] = v0[2]; vf[3] = v0[3]; vf[4] = v1[0]; vf[5] = v1[1]; vf[6] = v1[2]; vf[7] = v1[3]; \
            oacc[c][0] = __builtin_amdgcn_mfma_f32_16x16x32_bf16(vf, pf[0][ks2], oacc[c][0], 0, 0, 0); \
            oacc[c][1] = __builtin_amdgcn_mfma_f32_16x16x32_bf16(vf, pf[1][ks2], oacc[c][1], 0, 0, 0); } } while (0)
    FA_LOAD(0); FA_STORE(0, 0); __syncthreads();
    int vcur = 0;
    for (int j = 0; j < ntiles; ++j) {
        const int kb = j & 1;
        if (j + 1 < ntiles) FA_LOAD(j + 1);
        if (grpB && pvalid) { __builtin_amdgcn_s_setprio(1); FA_PV(pvb); __builtin_amdgcn_s_setprio(0); }
        bool skip = false; const int kp = kpos0 + 64 * (j - 4);
        if (WIN && j >= 4) skip = (kp + 63 < qpos_wave - 128) || (kp > qpos_wave + 31 + 128);
        pvalid = !skip; pvb = vcur;
        if (!skip) {
            f32x4 sacc[4][2];
#pragma unroll
            for (int kt = 0; kt < 4; ++kt) { sacc[kt][0] = (f32x4){0.f, 0.f, 0.f, 0.f}; sacc[kt][1] = (f32x4){0.f, 0.f, 0.f, 0.f}; }
            __builtin_amdgcn_s_setprio(1);
#pragma unroll
            for (int ks = 0; ks < NKS; ++ks) { bf16x8 kf[4];
#pragma unroll
                for (int kt = 0; kt < 4; ++kt) kf[kt] = *(const LAS bf16x8*)(Kl + kb * KBUF + (16 * kt + fr) * KSTR + (32 * ks + 8 * fq) * 2);
#pragma unroll
                for (int kt = 0; kt < 4; ++kt) { sacc[kt][0] = __builtin_amdgcn_mfma_f32_16x16x32_bf16(kf[kt], qf[0][ks], sacc[kt][0], 0, 0, 0);
                                                 sacc[kt][1] = __builtin_amdgcn_mfma_f32_16x16x32_bf16(kf[kt], qf[1][ks], sacc[kt][1], 0, 0, 0); } }
            __builtin_amdgcn_s_setprio(0);
            if (WIN && j >= 4) {
#pragma unroll
                for (int kt = 0; kt < 4; ++kt)
#pragma unroll
                    for (int qt = 0; qt < 2; ++qt)
#pragma unroll
                        for (int jj = 0; jj < 4; ++jj) { const int d = (kp + 16 * kt + 4 * fq + jj) - (qpos_wave + 16 * qt + fr); if (d < -128 || d > 128) sacc[kt][qt][jj] = -1.0e30f; } }
#pragma unroll
            for (int qt = 0; qt < 2; ++qt) {
                float mx = sacc[0][qt][0];
#pragma unroll
                for (int kt = 0; kt < 4; ++kt)
#pragma unroll
                    for (int jj = 0; jj < 4; ++jj) mx = fmaxf(mx, sacc[kt][qt][jj]);
                mx = fmaxf(mx, __shfl_xor(mx, 16)); mx = fmaxf(mx, __shfl_xor(mx, 32));
                const float mnew = fmaxf(mrun[qt], mx);
                if (__builtin_amdgcn_ballot_w64(mnew != mrun[qt]) != 0ull) {
                    const float alpha = fast_exp2(mrun[qt] - mnew); lsum[qt] *= alpha;
#pragma unroll
                    for (int c = 0; c < 4; ++c) oacc[c][qt] = oacc[c][qt] * alpha; }
                mrun[qt] = mnew;
                float ps = 0.f;
#pragma unroll
                for (int kt = 0; kt < 4; ++kt)
#pragma unroll
                    for (int jj = 0; jj < 4; ++jj) { const float p = fast_exp2(sacc[kt][qt][jj] - mnew); sacc[kt][qt][jj] = p; ps += p; }
                lsum[qt] += ps;
#pragma unroll
                for (int ks2 = 0; ks2 < 2; ++ks2) { const v4u w = pack8(sacc[2 * ks2][qt], sacc[2 * ks2 + 1][qt]); pf[qt][ks2] = __builtin_bit_cast(bf16x8, w); }
            }
            if (!grpB) { __builtin_amdgcn_s_setprio(1); FA_PV(vcur); __builtin_amdgcn_s_setprio(0); }
        }
        const int vnext = vcur == 2 ? 0 : vcur + 1;
        if (j + 1 < ntiles) FA_STORE(kb ^ 1, vnext);
        vcur = vnext;
        __syncthreads();
    }
    if (grpB && pvalid) FA_PV(pvb);
    __syncthreads();
#pragma unroll
    for (int qt = 0; qt < 2; ++qt) { float l = lsum[qt]; l += __shfl_xor(l, 16); l += __shfl_xor(l, 32); if (has_sink) l += fast_exp2(sink2 - mrun[qt]);
        const float inv = 1.0f / l;
#pragma unroll
        for (int c = 0; c < 4; ++c) { const f32x4 o = oacc[c][qt] * inv; v2u w; w.x = cvt_pk_bf16(o[0], o[1]); w.y = cvt_pk_bf16(o[2], o[3]);
            *(v2u*)(Og + (size_t)(16 * qt + fr) * ldo + 16 * c + 4 * fq) = w; } }
#undef FA_LOAD
#undef FA_STORE
#undef FA_PV
}

__device__ __forceinline__ void phase_attn_window(Frame& F, const float* const* in, bf16* Q, const bf16* Kb, const bf16* Vb, bf16* Oalt = nullptr) {
    constexpr int NLAT = NB * 4 * 64, NCTX = NB * 4 * 4;
    for (int un = F.vcu; un < NLAT + NCTX; un += GRID) {
        int b, kvh, q0, ntiles, kpos0, qrow0;
        if (un < NLAT) { b = un >> 8; kvh = (un >> 6) & 3; q0 = (un & 63) * 64; kpos0 = q0 >= 128 ? q0 - 128 : 0; const int kend = q0 + 192 <= SEQ ? q0 + 192 : SEQ; ntiles = 4 + (kend - kpos0) / 64; qrow0 = b * TPB + CTX + q0; }
        else { const int v = un - NLAT; b = v >> 4; kvh = (v >> 2) & 3; q0 = (v & 3) * 64; kpos0 = 0; ntiles = 4; qrow0 = b * TPB + q0; }
        const int g = F.wave >> 1, half = F.wave & 1, head = kvh * 4 + g;
        bf16* qp = Q + (size_t)(qrow0 + 32 * half) * 1024 + head * 64;
        bf16* op = Oalt ? Oalt + (size_t)(qrow0 + 32 * half) * 1024 + head * 64 : qp;
        flash_unit<64, true>(F.lds, F.tid, F.lane, F.wave >> 2, Kb + kvh * 64, 256, Vb + kvh * 64, 256, qp, 1024, op, 1024,
                             ntiles, b * TPB, b * TPB + CTX + kpos0, kpos0, q0 + 32 * half, in[16][head] * LOG2E, true);
    }
}
__device__ __forceinline__ void phase_attn_mla(Frame& F, const bf16* Q3, const bf16* KF, const bf16* V3, bf16* O) {
    for (int un = F.vcu; un < NB * 16 * 16; un += GRID) { const int b = un >> 8, head = (un >> 4) & 15, qb = un & 15; const int qrow = b * TPB + CTX + qb * 256 + 32 * F.wave;
        flash_unit<96, false>(F.lds, F.tid, F.lane, F.wave >> 2, KF + head * 96, 1536, V3 + head * 64, 1024, Q3 + (size_t)qrow * 1536 + head * 96, 1536, O + (size_t)qrow * 1024 + head * 64, 1024,
                              68, b * TPB, b * TPB + CTX, 0, 0, 0.f, false);
    }
}
__device__ __forceinline__ int scan_row(int dir, int tau) { return dir == 0 ? tau : (tau < CTX ? CTX - 1 - tau : (TPB + CTX - 1) - tau); }

__device__ __forceinline__ void phase_ssm_conv(Frame& F, const float* const* in, int gp, const bf16* XP, bf16* XS, bf16* BC, const float* DT, float* ACUM) {
    constexpr int RPW = M / GRID;
    if (F.tid < 384) {
    const int cg = F.tid % 192, rsub = F.tid / 192, c0 = cg * 8;
    const int oc = c0 < 1024 ? gp * 1024 + c0 : (c0 < 1280 ? 2048 + gp * 256 + (c0 - 1024) : 2560 + gp * 256 + (c0 - 1280));
    float w[5][8], bb[8];
#pragma unroll
    for (int k = 0; k < 5; ++k)
#pragma unroll
        for (int i = 0; i < 8; ++i) w[k][i] = in[19][k * 3072 + oc + i];
#pragma unroll
    for (int i = 0; i < 8; ++i) bb[i] = in[20][oc + i];
    const int rbeg = blockIdx.x * RPW + rsub * (RPW / 2), rend = rbeg + RPW / 2;
    for (int g0 = rbeg; g0 < rend; g0 += 8) {
        v4u xin[12];
#pragma unroll
        for (int j = 0; j < 12; ++j) { const int rr = g0 - 2 + j; xin[j] = (rr >= 0 && rr < M) ? *(const v4u*)(XP + (size_t)rr * 1536 + c0) : (v4u){0u, 0u, 0u, 0u}; }
#pragma unroll
        for (int i = 0; i < 8; ++i) { const int r = g0 + i; if (r < rend) { const int t = r % TPB; const int lo = t < CTX ? 0 : CTX, hi = t < CTX ? CTX : TPB;
            float a[8];
#pragma unroll
            for (int q = 0; q < 8; ++q) a[q] = bb[q];
#pragma unroll
            for (int k = 0; k < 5; ++k) { const int tt = t + k - 2; if (tt >= lo && tt < hi) { const v4u x = xin[i + k];
                    a[0] += w[k][0] * bflo(x.x); a[1] += w[k][1] * bfhi(x.x); a[2] += w[k][2] * bflo(x.y); a[3] += w[k][3] * bfhi(x.y);
                    a[4] += w[k][4] * bflo(x.z); a[5] += w[k][5] * bfhi(x.z); a[6] += w[k][6] * bflo(x.w); a[7] += w[k][7] * bfhi(x.w); } }
            v4u o; o.x = cvt_pk_bf16(silu_f(a[0]), silu_f(a[1])); o.y = cvt_pk_bf16(silu_f(a[2]), silu_f(a[3])); o.z = cvt_pk_bf16(silu_f(a[4]), silu_f(a[5])); o.w = cvt_pk_bf16(silu_f(a[6]), silu_f(a[7]));
            if (c0 < 1024) *(v4u*)(XS + (size_t)r * 1024 + c0) = o; else *(v4u*)(BC + (size_t)r * 512 + (c0 - 1024)) = o; } } }
    } else {
        const int chain = blockIdx.x * 128 + (F.tid - 384);
        if (chain < NB * 2 * 16 * 68) { const int ck = chain % 68, hl = (chain / 68) & 15, dir = (chain / (68 * 16)) & 1, b = chain / (68 * 32);
            const float Ah = -fast_exp(in[22][dir * 32 + gp * 16 + hl]) * LOG2E; float acc = 0.f;
#pragma unroll 1
            for (int h2 = 0; h2 < 2; ++h2) { float dv[32];
#pragma unroll
                for (int s = 0; s < 32; ++s) dv[s] = DT[(size_t)(b * TPB + scan_row(dir, ck * 64 + h2 * 32 + s)) * 32 + dir * 16 + hl];
#pragma unroll
                for (int s = 0; s < 32; ++s) { acc += dv[s] * Ah; ACUM[(size_t)(b * TPB + scan_row(dir, ck * 64 + h2 * 32 + s)) * 32 + dir * 16 + hl] = acc; } } }
    }
}

__device__ __forceinline__ void phase_ssm_scan(Frame& F, const float* const* in, int gp, const bf16* XS, const bf16* BC, const float* DT, const bf16* Z, bf16* Y) {
    constexpr int T = 32;
    LAS float* Bf = (LAS float*)F.lds;
    LAS float* Cf = (LAS float*)(F.lds + 16384);
    LAS float* U = (LAS float*)(F.lds + 32768);
    LAS float* XT = (LAS float*)(F.lds + 40960);
    LAS float* DEC = (LAS float*)(F.lds + 49152);
    LAS float* PART = (LAS float*)(F.lds + 49152 + 256);
    const int it = blockIdx.x, b = it >> 5, hl = (it >> 1) & 15, ph = it & 1, head = gp * 16 + hl, gl = hl >> 3;
    const int col = hl * 64 + ph * 32;
    const int p = F.tid & 31, ns = F.tid >> 5;
    const float dskip = in[23][head] + in[23][32 + head];
    const int st = F.tid >> 4, sch = F.tid & 15;
    const int xt = F.tid >> 2, xch = F.tid & 3;
    for (int dir = 0; dir < 2; ++dir) {
        const float Ah = -fast_exp(in[22][dir * 32 + head]) * LOG2E;
        float S[8];
#pragma unroll
        for (int i = 0; i < 8; ++i) S[i] = 0.f;
        v4u rb, rc, rx; float rdt = 0.f;
#define SS_LOAD(tile) do { const int _rB = b * TPB + scan_row(dir, (tile) * T + st); rb = *(const v4u*)(BC + (size_t)_rB * 512 + gl * 128 + sch * 8); rc = *(const v4u*)(BC + (size_t)_rB * 512 + 256 + gl * 128 + sch * 8); \
            if (F.tid < 128) { const int _rX = b * TPB + scan_row(dir, (tile) * T + xt); rx = *(const v4u*)(XS + (size_t)_rX * 1024 + col + xch * 8); rdt = DT[(size_t)_rX * 32 + dir * 16 + hl]; } } while (0)
#define SS_STORE(nb) do { LAS float* _b = Bf + st * 128 + sch * 8; LAS float* _c = Cf + st * 128 + sch * 8; \
            *(LAS f32x4*)_b = (f32x4){bflo(rb.x), bfhi(rb.x), bflo(rb.y), bfhi(rb.y)}; *(LAS f32x4*)(_b + 4) = (f32x4){bflo(rb.z), bfhi(rb.z), bflo(rb.w), bfhi(rb.w)}; \
            *(LAS f32x4*)_c = (f32x4){bflo(rc.x), bfhi(rc.x), bflo(rc.y), bfhi(rc.y)}; *(LAS f32x4*)(_c + 4) = (f32x4){bflo(rc.z), bfhi(rc.z), bflo(rc.w), bfhi(rc.w)}; \
            if (F.tid < 128) { const f32x4 x0 = (f32x4){bflo(rx.x), bfhi(rx.x), bflo(rx.y), bfhi(rx.y)}, x1 = (f32x4){bflo(rx.z), bfhi(rx.z), bflo(rx.w), bfhi(rx.w)}; \
                LAS float* _x = XT + (nb) * 1024 + xt * 32 + xch * 8; LAS float* _u = U + (nb) * 1024 + xt * 32 + xch * 8; \
                *(LAS f32x4*)_x = x0; *(LAS f32x4*)(_x + 4) = x1; *(LAS f32x4*)_u = x0 * rdt; *(LAS f32x4*)(_u + 4) = x1 * rdt; \
                if (xch == 0) DEC[(nb) * 32 + xt] = fast_exp2(rdt * Ah); } } while (0)
        __syncthreads();
        SS_LOAD(0); SS_STORE(0); __syncthreads();
        constexpr int NT = TPB / T;
        for (int tile = 0; tile < NT; ++tile) { const int cb = tile & 1;
            if (tile + 1 < NT) SS_LOAD(tile + 1);
            const LAS float* u_ = U + cb * 1024 + p; const LAS float* d_ = DEC + cb * 32;
#pragma unroll 4
            for (int t = 0; t < T; ++t) {
                const float dec = d_[t], u = u_[t * 32];
                const f32x4 b0 = *(const LAS f32x4*)(Bf + t * 128 + ns * 8), b1 = *(const LAS f32x4*)(Bf + t * 128 + ns * 8 + 4);
                const f32x4 c0 = *(const LAS f32x4*)(Cf + t * 128 + ns * 8), c1 = *(const LAS f32x4*)(Cf + t * 128 + ns * 8 + 4);
                float pt = 0.f;
#pragma unroll
                for (int i = 0; i < 4; ++i) { S[i] = S[i] * dec + b0[i] * u; pt += c0[i] * S[i]; S[4 + i] = S[4 + i] * dec + b1[i] * u; pt += c1[i] * S[4 + i]; }
                pt += __shfl_xor(pt, 32);
                if (F.lane < 32) PART[(F.wave * 32 + t) * 32 + p] = pt;
            }
            __syncthreads();
#pragma unroll
            for (int k = 0; k < 2; ++k) { const int t = (F.tid >> 5) + 16 * k; float y = 0.f;
#pragma unroll
                for (int w = 0; w < 8; ++w) y += PART[(w * 32 + t) * 32 + p];
                const size_t ro = (size_t)(b * TPB + scan_row(dir, tile * T + t));
                if (dir == 0) Y[ro * 1024 + col + p] = (bf16)f2bf(y);
                else { const float yt = y + bf2f(Y[ro * 1024 + col + p]) + dskip * XT[cb * 1024 + t * 32 + p]; const float zz = bf2f(Z[ro * 1024 + col + p]);
                    Y[ro * 1024 + col + p] = (bf16)f2bf(yt * silu_f(zz)); } }
            if (tile + 1 < NT) SS_STORE(cb ^ 1);
            __syncthreads();
        }
#undef SS_LOAD
#undef SS_STORE
    }
}
__device__ __forceinline__ void phase_ssm_gnorm(Frame& F, const float* const* in, int gp, bf16* Y) {
    const int gw = F.vcu * NWAVES + F.wave, NGW = GRID * NWAVES; const float* ng = in[24] + gp * 1024 + 16 * F.lane;
    for (int r = gw; r < M; r += NGW) { v4u* p = (v4u*)(Y + (size_t)r * 1024 + 16 * F.lane); const v4u a = p[0], c = p[1];
        float v[16] = {bflo(a.x), bfhi(a.x), bflo(a.y), bfhi(a.y), bflo(a.z), bfhi(a.z), bflo(a.w), bfhi(a.w), bflo(c.x), bfhi(c.x), bflo(c.y), bfhi(c.y), bflo(c.z), bfhi(c.z), bflo(c.w), bfhi(c.w)};
        float ss = 0.f;
#pragma unroll
        for (int i = 0; i < 16; ++i) ss += v[i] * v[i];
#pragma unroll
        for (int o = 1; o < 32; o <<= 1) ss += __shfl_xor(ss, o);
        const float rs = rsqrtf(ss * (1.f / 512.f) + EPS);
        v4u o0, o1;
        o0.x = cvt_pk_bf16(v[0] * rs * ng[0], v[1] * rs * ng[1]); o0.y = cvt_pk_bf16(v[2] * rs * ng[2], v[3] * rs * ng[3]); o0.z = cvt_pk_bf16(v[4] * rs * ng[4], v[5] * rs * ng[5]); o0.w = cvt_pk_bf16(v[6] * rs * ng[6], v[7] * rs * ng[7]);
        o1.x = cvt_pk_bf16(v[8] * rs * ng[8], v[9] * rs * ng[9]); o1.y = cvt_pk_bf16(v[10] * rs * ng[10], v[11] * rs * ng[11]); o1.z = cvt_pk_bf16(v[12] * rs * ng[12], v[13] * rs * ng[13]); o1.w = cvt_pk_bf16(v[14] * rs * ng[14], v[15] * rs * ng[15]);
        p[0] = o0; p[1] = o1; }
}


__device__ __forceinline__ void phase_ssm_scan_mfma(Frame& F, const float* const* in, int gp, const bf16* XS, const bf16* BC, const float* DT, const float* ACUM, bf16* Yf, bf16* Yb) {
    constexpr int BSTR = 272, XSTR = 160;
    LAS unsigned char* Bl = F.lds;
    LAS unsigned char* Cl = F.lds + 17408;
    LAS unsigned char* Xl = F.lds + 34816;
    LAS unsigned char* Xw = F.lds + 45056;
    LAS float* AC = (LAS float*)(F.lds + 55296);
    LAS float* DTs = (LAS float*)(F.lds + 55296 + 256);
    LAS unsigned char* Sb = F.lds + 55808;
    const int it = blockIdx.x, b = it >> 5, dir = (it >> 4) & 1, hl = it & 15, gl = hl >> 3;
    bf16* Y = dir == 0 ? Yf : Yb;
    const int tid = F.tid, lane = F.lane, w = F.wave, fr = lane & 15, fq = lane >> 4, lq = (lane & 15) >> 2, lp = lane & 3;
    const int lt = w & 3, ph = w >> 2;
    for (int i = tid; i < 64 * BSTR / 16; i += NTHR) *(LAS v4u*)(Sb + i * 16) = (v4u){0u, 0u, 0u, 0u};
    f32x4 sacc[4];
#pragma unroll
    for (int i = 0; i < 4; ++i) sacc[i] = (f32x4){0.f, 0.f, 0.f, 0.f};
    v4u rB[2], rC[2], rX; float rac = 0.f, rdt = 0.f, rxs = 0.f;
    const int xr = tid >> 3, xc = tid & 7;
#define SM_LOAD(ck) do { _Pragma("unroll") for (int _i = 0; _i < 2; ++_i) { const int _c = tid + 512 * _i; const size_t _r = (size_t)(b * TPB + scan_row(dir, (ck) * 64 + (_c >> 4))); \
            rB[_i] = *(const v4u*)(BC + _r * 512 + gl * 128 + (_c & 15) * 8); rC[_i] = *(const v4u*)(BC + _r * 512 + 256 + gl * 128 + (_c & 15) * 8); } \
        { const size_t _r = (size_t)(b * TPB + scan_row(dir, (ck) * 64 + xr)); const size_t _rl = (size_t)(b * TPB + scan_row(dir, (ck) * 64 + 63)); rX = *(const v4u*)(XS + _r * 1024 + hl * 64 + xc * 8); \
          const float _a = ACUM[_r * 32 + dir * 16 + hl], _al = ACUM[_rl * 32 + dir * 16 + hl], _d = DT[_r * 32 + dir * 16 + hl]; rac = _a; rdt = _d; rxs = _d * fast_exp2(_al - _a); } } while (0)
#define SM_STORE() do { _Pragma("unroll") for (int _i = 0; _i < 2; ++_i) { const int _c = tid + 512 * _i; *(LAS v4u*)(Bl + (_c >> 4) * BSTR + (_c & 15) * 16) = rB[_i]; *(LAS v4u*)(Cl + (_c >> 4) * BSTR + (_c & 15) * 16) = rC[_i]; } \
        *(LAS v4u*)(Xl + xr * XSTR + xc * 16) = rX; \
        { v4u _o; _o.x = cvt_pk_bf16(bflo(rX.x) * rxs, bfhi(rX.x) * rxs); _o.y = cvt_pk_bf16(bflo(rX.y) * rxs, bfhi(rX.y) * rxs); _o.z = cvt_pk_bf16(bflo(rX.z) * rxs, bfhi(rX.z) * rxs); _o.w = cvt_pk_bf16(bflo(rX.w) * rxs, bfhi(rX.w) * rxs); \
          *(LAS v4u*)(Xw + xr * XSTR + xc * 16) = _o; } \
        if (xc == 0) { AC[xr] = rac; DTs[xr] = rdt; } } while (0)
    SM_LOAD(0); SM_STORE(); __syncthreads();
    for (int ck = 0; ck < 68; ++ck) { const int cur = ck & 1;
        if (ck + 1 < 68) SM_LOAD(ck + 1);
        const LAS unsigned char* Sc = Sb + cur * (64 * BSTR); LAS unsigned char* Sn = Sb + (cur ^ 1) * (64 * BSTR);
        bf16x8 cf[4];
#pragma unroll
        for (int ks = 0; ks < 4; ++ks) cf[ks] = *(const LAS bf16x8*)(Cl + (16 * lt + fr) * BSTR + (32 * ks + 8 * fq) * 2);
        const float acl = AC[16 * lt + fr];
        f32x4 yacc[2];
#pragma unroll
        for (int pi = 0; pi < 2; ++pi) { f32x4 a = (f32x4){0.f, 0.f, 0.f, 0.f};
#pragma unroll
            for (int ks = 0; ks < 4; ++ks) { const bf16x8 sf = *(const LAS bf16x8*)(Sc + (16 * (2 * ph + pi) + fr) * BSTR + (32 * ks + 8 * fq) * 2); a = __builtin_amdgcn_mfma_f32_16x16x32_bf16(sf, cf[ks], a, 0, 0, 0); }
            yacc[pi] = a * fast_exp2(acl); }
        f32x4 pm[4];
#pragma unroll
        for (int st = 0; st < 4; ++st) { pm[st] = (f32x4){0.f, 0.f, 0.f, 0.f};
            if (st <= lt) { f32x4 g = (f32x4){0.f, 0.f, 0.f, 0.f};
#pragma unroll
                for (int ks = 0; ks < 4; ++ks) { const bf16x8 bfr = *(const LAS bf16x8*)(Bl + (16 * st + fr) * BSTR + (32 * ks + 8 * fq) * 2); g = __builtin_amdgcn_mfma_f32_16x16x32_bf16(bfr, cf[ks], g, 0, 0, 0); }
                const f32x4 acs = *(const LAS f32x4*)(AC + 16 * st + 4 * fq), dts = *(const LAS f32x4*)(DTs + 16 * st + 4 * fq);
#pragma unroll
                for (int j = 0; j < 4; ++j) { const bool ok = (16 * st + 4 * fq + j) <= (16 * lt + fr); pm[st][j] = ok ? g[j] * fast_exp2(acl - acs[j]) * dts[j] : 0.f; } } }
#pragma unroll
        for (int ks2 = 0; ks2 < 2; ++ks2) { if (2 * ks2 <= lt) { const v4u pw = pack8(pm[2 * ks2], pm[2 * ks2 + 1]); const bf16x8 pf = __builtin_bit_cast(bf16x8, pw);
#pragma unroll
                for (int pi = 0; pi < 2; ++pi) { const LAS unsigned char* xb = Xl + (32 * ks2 + 4 * fq + lq) * XSTR + (16 * (2 * ph + pi) + 4 * lp) * 2;
                    const s16x4 v0 = __builtin_amdgcn_ds_read_tr16_b64_v4i16((LAS s16x4*)xb), v1 = __builtin_amdgcn_ds_read_tr16_b64_v4i16((LAS s16x4*)(xb + 16 * XSTR));
                    bf16x8 xf; xf[0] = v0[0]; xf[1] = v0[1]; xf[2] = v0[2]; xf[3] = v0[3]; xf[4] = v1[0]; xf[5] = v1[1]; xf[6] = v1[2]; xf[7] = v1[3];
                    yacc[pi] = __builtin_amdgcn_mfma_f32_16x16x32_bf16(xf, pf, yacc[pi], 0, 0, 0); } } }
        { const size_t ro = (size_t)(b * TPB + scan_row(dir, ck * 64 + 16 * lt + fr));
#pragma unroll
          for (int pi = 0; pi < 2; ++pi) { v2u o; o.x = cvt_pk_bf16(yacc[pi][0], yacc[pi][1]); o.y = cvt_pk_bf16(yacc[pi][2], yacc[pi][3]);
              *(v2u*)(Y + ro * 1024 + hl * 64 + 16 * (2 * ph + pi) + 4 * fq) = o; } }
        { const float gdec = fast_exp2(AC[63]);
          bf16x8 xwf[2];
#pragma unroll
          for (int ks2 = 0; ks2 < 2; ++ks2) { const LAS unsigned char* xb = Xw + (32 * ks2 + 8 * fq + lq) * XSTR + (16 * lt + 4 * lp) * 2;
              const s16x4 v0 = __builtin_amdgcn_ds_read_tr16_b64_v4i16((LAS s16x4*)xb), v1 = __builtin_amdgcn_ds_read_tr16_b64_v4i16((LAS s16x4*)(xb + 4 * XSTR));
              xwf[ks2][0] = v0[0]; xwf[ks2][1] = v0[1]; xwf[ks2][2] = v0[2]; xwf[ks2][3] = v0[3]; xwf[ks2][4] = v1[0]; xwf[ks2][5] = v1[1]; xwf[ks2][6] = v1[2]; xwf[ks2][7] = v1[3]; }
#pragma unroll
          for (int i = 0; i < 4; ++i) { const int nt = 4 * ph + i; f32x4 a = sacc[i] * gdec;
#pragma unroll
              for (int ks2 = 0; ks2 < 2; ++ks2) { const LAS unsigned char* bb = Bl + (32 * ks2 + 8 * fq + lq) * BSTR + (16 * nt + 4 * lp) * 2;
                  const s16x4 v0 = __builtin_amdgcn_ds_read_tr16_b64_v4i16((LAS s16x4*)bb), v1 = __builtin_amdgcn_ds_read_tr16_b64_v4i16((LAS s16x4*)(bb + 4 * BSTR));
                  bf16x8 bt; bt[0] = v0[0]; bt[1] = v0[1]; bt[2] = v0[2]; bt[3] = v0[3]; bt[4] = v1[0]; bt[5] = v1[1]; bt[6] = v1[2]; bt[7] = v1[3];
                  a = __builtin_amdgcn_mfma_f32_16x16x32_bf16(xwf[ks2], bt, a, 0, 0, 0); }
              sacc[i] = a;
#pragma unroll
              for (int j = 0; j < 4; ++j) *(LAS bf16*)(Sn + (16 * lt + 4 * fq + j) * BSTR + (16 * nt + fr) * 2) = (bf16)f2bf(a[j]); } }
        __syncthreads();
        if (ck + 1 < 68) SM_STORE();
        __syncthreads();
    }
#undef SM_LOAD
#undef SM_STORE
}
struct GnRow { float v[16]; float ss; };
__device__ __forceinline__ void gn2_load(GnRow& R, const bf16* Yf, const bf16* Yb, const bf16* XS, const bf16* Z, size_t off, float dskip) {
    const v4u a0 = *(const v4u*)(Yf + off), a1 = *(const v4u*)(Yf + off + 8), b0 = *(const v4u*)(Yb + off), b1 = *(const v4u*)(Yb + off + 8);
    const v4u x0 = *(const v4u*)(XS + off), x1 = *(const v4u*)(XS + off + 8), z0 = *(const v4u*)(Z + off), z1 = *(const v4u*)(Z + off + 8);
    const unsigned aw[8] = {a0.x, a0.y, a0.z, a0.w, a1.x, a1.y, a1.z, a1.w}, bw[8] = {b0.x, b0.y, b0.z, b0.w, b1.x, b1.y, b1.z, b1.w};
    const unsigned xw[8] = {x0.x, x0.y, x0.z, x0.w, x1.x, x1.y, x1.z, x1.w}, zw[8] = {z0.x, z0.y, z0.z, z0.w, z1.x, z1.y, z1.z, z1.w};
    float ss = 0.f;
#pragma unroll
    for (int i = 0; i < 8; ++i) { R.v[2 * i] = (bflo(aw[i]) + bflo(bw[i]) + dskip * bflo(xw[i])) * silu_f(bflo(zw[i])); R.v[2 * i + 1] = (bfhi(aw[i]) + bfhi(bw[i]) + dskip * bfhi(xw[i])) * silu_f(bfhi(zw[i]));
        ss += R.v[2 * i] * R.v[2 * i] + R.v[2 * i + 1] * R.v[2 * i + 1]; }
    R.ss = ss;
}
__device__ __forceinline__ void gn_store(const GnRow& R, float rs, const float* ng, bf16* dst) {
    unsigned res[8];
#pragma unroll
    for (int i = 0; i < 8; ++i) res[i] = cvt_pk_bf16(R.v[2 * i] * rs * ng[2 * i], R.v[2 * i + 1] * rs * ng[2 * i + 1]);
    *(v4u*)(dst) = (v4u){res[0], res[1], res[2], res[3]}; *(v4u*)(dst + 8) = (v4u){res[4], res[5], res[6], res[7]};
}
__device__ __forceinline__ void phase_ssm_gnorm2(Frame& F, const float* const* in, int gp, bf16* Yf, const bf16* Yb, const bf16* XS, const bf16* Z) {
    const int gw = F.vcu * NWAVES + F.wave, NGW = GRID * NWAVES; const float* ng = in[24] + gp * 1024 + 16 * F.lane;
    const int head = gp * 16 + (F.lane >> 2); const float dskip = in[23][head] + in[23][32 + head];
    for (int r = gw; r < M; r += 2 * NGW) { const int r2 = r + NGW < M ? r + NGW : r; const size_t o1 = (size_t)r * 1024 + 16 * F.lane, o2 = (size_t)r2 * 1024 + 16 * F.lane;
        GnRow A, B; gn2_load(A, Yf, Yb, XS, Z, o1, dskip); gn2_load(B, Yf, Yb, XS, Z, o2, dskip);
        float sa = A.ss, sb = B.ss;
#pragma unroll
        for (int o = 1; o < 32; o <<= 1) { sa += __shfl_xor(sa, o); sb += __shfl_xor(sb, o); }
        gn_store(A, rsqrtf(sa * (1.f / 512.f) + EPS), ng, Yf + o1);
        if (r2 != r) gn_store(B, rsqrtf(sb * (1.f / 512.f) + EPS), ng, Yf + o2); }
}

__device__ __forceinline__ void phase_mlstm_scan(Frame& F, const bf16* Qm, const bf16* Km, const bf16* Vm, const float* G, bf16* Hf, bf16* Hb) {
    constexpr int T = 32;
    LAS float* Qf = (LAS float*)F.lds;
    LAS float* KW = (LAS float*)(F.lds + 8192);
    LAS float* Vf = (LAS float*)(F.lds + 16384);
    LAS float* FD = (LAS float*)(F.lds + 24576);
    LAS float* IW = (LAS float*)(F.lds + 24576 + 256);
    LAS float* EM = (LAS float*)(F.lds + 24576 + 512);
    LAS float* PN = (LAS float*)(F.lds + 32768);
    LAS float* PD = (LAS float*)(F.lds + 32768 + 65536);
    const int it = blockIdx.x, b = it >> 5, dir = (it >> 4) & 1, head = (it >> 1) & 7, jh = it & 1;
    bf16* Hout = dir == 0 ? Hf : Hb;
    const int w = F.wave, lane = F.lane, d7 = 8 * w + (lane & 7);
    float C[8], nst = 0.f, m_in = 0.f;
#pragma unroll
    for (int i = 0; i < 8; ++i) C[i] = 0.f;
    const int st = (F.tid & 255) >> 3, sch = F.tid & 7;
    v4u r0, r1; float gi = 0.f, gf = 0.f;
#define ML_LOAD(tile) do { const size_t _r = (size_t)(b * TPB + scan_row(dir, (tile) * T + st)); \
        if (F.tid < 256) { r0 = *(const v4u*)(Qm + _r * 512 + head * 64 + sch * 8); r1 = *(const v4u*)(Vm + _r * 1024 + head * 128 + jh * 64 + sch * 8); } \
        else { r0 = *(const v4u*)(Km + _r * 512 + head * 64 + sch * 8); } \
        if (F.tid < 32) { const size_t _g = (size_t)(b * TPB + scan_row(dir, (tile) * T + F.tid)); gi = G[_g * 32 + (2 * dir) * 8 + head]; gf = G[_g * 32 + (2 * dir + 1) * 8 + head]; } } while (0)
#define UNPK(dst, r) do { *(LAS f32x4*)(dst) = (f32x4){bflo(r.x), bfhi(r.x), bflo(r.y), bfhi(r.y)}; *(LAS f32x4*)((dst) + 4) = (f32x4){bflo(r.z), bfhi(r.z), bflo(r.w), bfhi(r.w)}; } while (0)
#define ML_GATES(nb) do { if (w == 0) { float Fc = lane < 32 ? gf : 0.f; \
            _Pragma("unroll") for (int o = 1; o < 32; o <<= 1) { const float t_ = __shfl_up(Fc, o); if (lane >= o) Fc += t_; } \
            float Gm = lane < 32 ? gi - Fc : -3.0e38f; \
            _Pragma("unroll") for (int o = 1; o < 32; o <<= 1) { const float t_ = __shfl_up(Gm, o); if (lane >= o) Gm = fmaxf(Gm, t_); } \
            const float mt = Fc + fmaxf(m_in, Gm); float mp = __shfl_up(mt, 1); if (lane == 0) mp = m_in; \
            if (lane < 32) { FD[(nb) * 32 + lane] = fast_exp2((gf + mp - mt) * LOG2E); IW[(nb) * 32 + lane] = fast_exp2((gi - mt) * LOG2E); EM[(nb) * 32 + lane] = fast_exp2(-mt * LOG2E); } \
            m_in = __shfl(mt, 31); } } while (0)
    __syncthreads();
    ML_LOAD(0); ML_GATES(0);
    if (F.tid < 256) { UNPK(Qf + st * 64 + sch * 8, r0); UNPK(Vf + st * 64 + sch * 8, r1); }
    __syncthreads();
    if (F.tid >= 256) { const float iw = IW[st]; LAS float* dk = KW + st * 64 + sch * 8;
        *(LAS f32x4*)dk = (f32x4){bflo(r0.x), bfhi(r0.x), bflo(r0.y), bfhi(r0.y)} * iw; *(LAS f32x4*)(dk + 4) = (f32x4){bflo(r0.z), bfhi(r0.z), bflo(r0.w), bfhi(r0.w)} * iw; }
    __syncthreads();
    constexpr int NT = TPB / T;
    for (int tile = 0; tile < NT; ++tile) { const int cb = tile & 1;
        if (tile + 1 < NT) ML_LOAD(tile + 1);
#pragma unroll 4
        for (int t = 0; t < T; ++t) {
            const float fd = FD[cb * 32 + t], v = Vf[t * 64 + lane];
            const f32x4 q0 = *(const LAS f32x4*)(Qf + t * 64 + 8 * w), q1 = *(const LAS f32x4*)(Qf + t * 64 + 8 * w + 4);
            const f32x4 k0 = *(const LAS f32x4*)(KW + t * 64 + 8 * w), k1 = *(const LAS f32x4*)(KW + t * 64 + 8 * w + 4);
            float pn = 0.f;
#pragma unroll
            for (int i = 0; i < 4; ++i) { C[i] = C[i] * fd + k0[i] * v; pn += q0[i] * C[i]; C[4 + i] = C[4 + i] * fd + k1[i] * v; pn += q1[i] * C[4 + i]; }
            PN[(w * 32 + t) * 64 + lane] = pn;
            nst = nst * fd + KW[t * 64 + d7];
            float pd = Qf[t * 64 + d7] * nst;
            pd += __shfl_xor(pd, 1); pd += __shfl_xor(pd, 2); pd += __shfl_xor(pd, 4);
            if (lane == 0) PD[w * 32 + t] = pd;
        }
        __syncthreads();
#pragma unroll
        for (int k = 0; k < 4; ++k) { const int t = (F.tid >> 6) + 8 * k; float num = 0.f, den = 0.f;
#pragma unroll
            for (int ww = 0; ww < 8; ++ww) { num += PN[(ww * 32 + t) * 64 + lane]; den += PD[ww * 32 + t]; }
            const float h = num / fmaxf(fabsf(den), EM[cb * 32 + t]);
            Hout[(size_t)(b * TPB + scan_row(dir, tile * T + t)) * 1024 + head * 128 + jh * 64 + lane] = (bf16)f2bf(h); }
        if (tile + 1 < NT) { ML_GATES(cb ^ 1); if (F.tid < 256) { UNPK(Qf + st * 64 + sch * 8, r0); UNPK(Vf + st * 64 + sch * 8, r1); } }
        __syncthreads();
        if (tile + 1 < NT && F.tid >= 256) { const float iw = IW[(cb ^ 1) * 32 + st]; LAS float* dk = KW + st * 64 + sch * 8;
            *(LAS f32x4*)dk = (f32x4){bflo(r0.x), bfhi(r0.x), bflo(r0.y), bfhi(r0.y)} * iw; *(LAS f32x4*)(dk + 4) = (f32x4){bflo(r0.z), bfhi(r0.z), bflo(r0.w), bfhi(r0.w)} * iw; }
        __syncthreads();
    }
#undef ML_LOAD
#undef ML_GATES
#undef UNPK
}

__device__ __forceinline__ void phase_mlstm_scan_mfma(Frame& F, const bf16* Qm, const bf16* Km, const bf16* Vm, const float* G, bf16* Hf, bf16* Hb) {
    constexpr int QSTR = 144, WSTR = 160, VSTR = 176, CSTR = 144;
    LAS unsigned char* Ql = F.lds;
    LAS unsigned char* Kl = F.lds + 9216;
    LAS unsigned char* Kw = F.lds + 18432;
    LAS unsigned char* Vl = F.lds + 28672;
    LAS unsigned char* Cb = F.lds + 39936;
    LAS float* BCU = (LAS float*)(F.lds + 62976);
    LAS float* IGA = BCU + 64;
    LAS float* MTA = BCU + 128;
    LAS float* SCA = BCU + 192;
    const int it = blockIdx.x, b = it >> 5, dir = (it >> 4) & 1, head = (it >> 1) & 7, jh = it & 1;
    bf16* Hout = dir == 0 ? Hf : Hb;
    const int tid = F.tid, lane = F.lane, w = F.wave, fr = lane & 15, fq = lane >> 4, lq = (lane & 15) >> 2, lp = lane & 3;
    const int lt = w & 3, jg = w >> 2;
    for (int i = tid; i < 80 * CSTR / 16; i += NTHR) *(LAS v4u*)(Cb + i * 16) = (v4u){0u, 0u, 0u, 0u};
    for (int i = tid; i < 64 * 2; i += NTHR) { const int s = i >> 1, hh = i & 1; *(LAS v4u*)(Vl + s * VSTR + 128 + hh * 16) = hh == 0 ? (v4u){0x3F80u, 0u, 0u, 0u} : (v4u){0u, 0u, 0u, 0u}; }
    f32x4 sacc[3];
#pragma unroll
    for (int i = 0; i < 3; ++i) sacc[i] = (f32x4){0.f, 0.f, 0.f, 0.f};
    v4u rQ, rK, rV; float gi = 0.f, gf = 0.f, m_in = 0.f;
    const int sr = tid >> 3, sc = tid & 7;
#define MM_LOAD(ck) do { const size_t _r = (size_t)(b * TPB + scan_row(dir, (ck) * 64 + sr)); \
        rQ = *(const v4u*)(Qm + _r * 512 + head * 64 + sc * 8); rK = *(const v4u*)(Km + _r * 512 + head * 64 + sc * 8); rV = *(const v4u*)(Vm + _r * 1024 + head * 128 + jh * 64 + sc * 8); \
        if (tid < 64) { const size_t _g = (size_t)(b * TPB + scan_row(dir, (ck) * 64 + tid)); gi = G[_g * 32 + (2 * dir) * 8 + head] * LOG2E; gf = G[_g * 32 + (2 * dir + 1) * 8 + head] * LOG2E; } } while (0)
#define MM_STAGE1() do { if (w == 0) { float Fc = gf; \
            _Pragma("unroll") for (int o = 1; o < 64; o <<= 1) { const float t_ = __shfl_up(Fc, o); if (lane >= o) Fc += t_; } \
            float Gm = gi - Fc; \
            _Pragma("unroll") for (int o = 1; o < 64; o <<= 1) { const float t_ = __shfl_up(Gm, o); if (lane >= o) Gm = fmaxf(Gm, t_); } \
            const float mt = Fc + fmaxf(m_in, Gm); BCU[lane] = Fc; IGA[lane] = gi; MTA[lane] = mt; \
            if (lane == 63) { SCA[0] = Fc; SCA[1] = m_in; SCA[2] = mt; } \
            m_in = __shfl(mt, 63); } \
        *(LAS v4u*)(Ql + sr * QSTR + sc * 16) = rQ; *(LAS v4u*)(Kl + sr * QSTR + sc * 16) = rK; *(LAS v4u*)(Vl + sr * VSTR + sc * 16) = rV; } while (0)
#define MM_STAGE2() do { const float ws_ = fast_exp2(SCA[0] - BCU[sr] + IGA[sr] - SCA[2]); v4u _o; \
        _o.x = cvt_pk_bf16(bflo(rK.x) * ws_, bfhi(rK.x) * ws_); _o.y = cvt_pk_bf16(bflo(rK.y) * ws_, bfhi(rK.y) * ws_); _o.z = cvt_pk_bf16(bflo(rK.z) * ws_, bfhi(rK.z) * ws_); _o.w = cvt_pk_bf16(bflo(rK.w) * ws_, bfhi(rK.w) * ws_); \
        *(LAS v4u*)(Kw + sr * WSTR + sc * 16) = _o; } while (0)
    __syncthreads();
    MM_LOAD(0); MM_STAGE1(); __syncthreads(); MM_STAGE2(); __syncthreads();
    for (int ck = 0; ck < 68; ++ck) { const int cur = ck & 1;
        if (ck + 1 < 68) MM_LOAD(ck + 1);
        const LAS unsigned char* Cc = Cb + cur * (80 * CSTR); LAS unsigned char* Cn = Cb + (cur ^ 1) * (80 * CSTR);
        bf16x8 qf[2];
#pragma unroll
        for (int ks = 0; ks < 2; ++ks) qf[ks] = *(const LAS bf16x8*)(Ql + (16 * lt + fr) * QSTR + (32 * ks + 8 * fq) * 2);
        const float bl = BCU[16 * lt + fr], ml = MTA[16 * lt + fr], m0 = SCA[1];
        const float dl = fast_exp2(bl + m0 - ml);
        f32x4 nacc[2]; float den;
#pragma unroll
        for (int ji = 0; ji < 2; ++ji) { f32x4 a = (f32x4){0.f, 0.f, 0.f, 0.f};
#pragma unroll
            for (int ks = 0; ks < 2; ++ks) { const bf16x8 cfr = *(const LAS bf16x8*)(Cc + (16 * (2 * jg + ji) + fr) * CSTR + (32 * ks + 8 * fq) * 2); a = __builtin_amdgcn_mfma_f32_16x16x32_bf16(cfr, qf[ks], a, 0, 0, 0); }
            nacc[ji] = a * dl; }
        { f32x4 a = (f32x4){0.f, 0.f, 0.f, 0.f};
#pragma unroll
          for (int ks = 0; ks < 2; ++ks) { const bf16x8 cfr = *(const LAS bf16x8*)(Cc + (64 + fr) * CSTR + (32 * ks + 8 * fq) * 2); a = __builtin_amdgcn_mfma_f32_16x16x32_bf16(cfr, qf[ks], a, 0, 0, 0); }
          den = __shfl(a[0], fr) * dl; }
        f32x4 pm[4]; float dsum = 0.f;
#pragma unroll
        for (int st = 0; st < 4; ++st) { pm[st] = (f32x4){0.f, 0.f, 0.f, 0.f};
            if (st <= lt) { f32x4 g = (f32x4){0.f, 0.f, 0.f, 0.f};
#pragma unroll
                for (int ks = 0; ks < 2; ++ks) { const bf16x8 kfr = *(const LAS bf16x8*)(Kl + (16 * st + fr) * QSTR + (32 * ks + 8 * fq) * 2); g = __builtin_amdgcn_mfma_f32_16x16x32_bf16(kfr, qf[ks], g, 0, 0, 0); }
                const f32x4 bs = *(const LAS f32x4*)(BCU + 16 * st + 4 * fq), is = *(const LAS f32x4*)(IGA + 16 * st + 4 * fq);
#pragma unroll
                for (int j = 0; j < 4; ++j) { const bool ok = (16 * st + 4 * fq + j) <= (16 * lt + fr); const float v = ok ? g[j] * fast_exp2(bl - bs[j] + is[j] - ml) : 0.f; pm[st][j] = v; dsum += v; } } }
        dsum += __shfl_xor(dsum, 16); dsum += __shfl_xor(dsum, 32);
        den += dsum;
#pragma unroll
        for (int ks2 = 0; ks2 < 2; ++ks2) { if (2 * ks2 <= lt) { const v4u pw = pack8(pm[2 * ks2], pm[2 * ks2 + 1]); const bf16x8 pf = __builtin_bit_cast(bf16x8, pw);
#pragma unroll
                for (int ji = 0; ji < 2; ++ji) { const LAS unsigned char* vb = Vl + (32 * ks2 + 4 * fq + lq) * VSTR + (16 * (2 * jg + ji) + 4 * lp) * 2;
                    const s16x4 v0 = __builtin_amdgcn_ds_read_tr16_b64_v4i16((LAS s16x4*)vb), v1 = __builtin_amdgcn_ds_read_tr16_b64_v4i16((LAS s16x4*)(vb + 16 * VSTR));
                    bf16x8 vf; vf[0] = v0[0]; vf[1] = v0[1]; vf[2] = v0[2]; vf[3] = v0[3]; vf[4] = v1[0]; vf[5] = v1[1]; vf[6] = v1[2]; vf[7] = v1[3];
                    nacc[ji] = __builtin_amdgcn_mfma_f32_16x16x32_bf16(vf, pf, nacc[ji], 0, 0, 0); } } }
        { const float inv = 1.0f / fmaxf(fabsf(den), fast_exp2(-ml)); const size_t ro = (size_t)(b * TPB + scan_row(dir, ck * 64 + 16 * lt + fr));
#pragma unroll
          for (int ji = 0; ji < 2; ++ji) { v2u o; o.x = cvt_pk_bf16(nacc[ji][0] * inv, nacc[ji][1] * inv); o.y = cvt_pk_bf16(nacc[ji][2] * inv, nacc[ji][3] * inv);
              *(v2u*)(Hout + ro * 1024 + head * 128 + jh * 64 + 16 * (2 * jg + ji) + 4 * fq) = o; } }
        { const float gdec = fast_exp2(SCA[0] + m0 - SCA[2]);
          bf16x8 kwf[2];
#pragma unroll
          for (int ks2 = 0; ks2 < 2; ++ks2) { const LAS unsigned char* kb = Kw + (32 * ks2 + 8 * fq + lq) * WSTR + (16 * lt + 4 * lp) * 2;
              const s16x4 v0 = __builtin_amdgcn_ds_read_tr16_b64_v4i16((LAS s16x4*)kb), v1 = __builtin_amdgcn_ds_read_tr16_b64_v4i16((LAS s16x4*)(kb + 4 * WSTR));
              kwf[ks2][0] = v0[0]; kwf[ks2][1] = v0[1]; kwf[ks2][2] = v0[2]; kwf[ks2][3] = v0[3]; kwf[ks2][4] = v1[0]; kwf[ks2][5] = v1[1]; kwf[ks2][6] = v1[2]; kwf[ks2][7] = v1[3]; }
#pragma unroll
          for (int i = 0; i < 3; ++i) { if (jg == 0 || i < 2) { const int jt = jg == 0 ? i : 3 + i; f32x4 a = sacc[i] * gdec;
#pragma unroll
              for (int ks2 = 0; ks2 < 2; ++ks2) { const LAS unsigned char* vb = Vl + (32 * ks2 + 8 * fq + lq) * VSTR + (16 * jt + 4 * lp) * 2;
                  const s16x4 v0 = __builtin_amdgcn_ds_read_tr16_b64_v4i16((LAS s16x4*)vb), v1 = __builtin_amdgcn_ds_read_tr16_b64_v4i16((LAS s16x4*)(vb + 4 * VSTR));
                  bf16x8 vt; vt[0] = v0[0]; vt[1] = v0[1]; vt[2] = v0[2]; vt[3] = v0[3]; vt[4] = v1[0]; vt[5] = v1[1]; vt[6] = v1[2]; vt[7] = v1[3];
                  a = __builtin_amdgcn_mfma_f32_16x16x32_bf16(vt, kwf[ks2], a, 0, 0, 0); }
              sacc[i] = a;
#pragma unroll
              for (int j = 0; j < 4; ++j) *(LAS bf16*)(Cn + (16 * jt + 4 * fq + j) * CSTR + (16 * lt + fr) * 2) = (bf16)f2bf(a[j]); } } }
        __syncthreads();
        if (ck + 1 < 68) MM_STAGE1();
        __syncthreads();
        if (ck + 1 < 68) MM_STAGE2();
        __syncthreads();
    }
#undef MM_LOAD
#undef MM_STAGE1
#undef MM_STAGE2
}

__device__ __forceinline__ void mg_load(GnRow& R, unsigned (&ow)[8], const bf16* Hf, const bf16* Hb, const bf16* Om, size_t off) {
    const v4u a0 = *(const v4u*)(Hf + off), a1 = *(const v4u*)(Hf + off + 8), b0 = *(const v4u*)(Hb + off), b1 = *(const v4u*)(Hb + off + 8), o0 = *(const v4u*)(Om + off), o1 = *(const v4u*)(Om + off + 8);
    const unsigned aw[8] = {a0.x, a0.y, a0.z, a0.w, a1.x, a1.y, a1.z, a1.w}, bw[8] = {b0.x, b0.y, b0.z, b0.w, b1.x, b1.y, b1.z, b1.w};
    ow[0] = o0.x; ow[1] = o0.y; ow[2] = o0.z; ow[3] = o0.w; ow[4] = o1.x; ow[5] = o1.y; ow[6] = o1.z; ow[7] = o1.w;
    float ss = 0.f;
#pragma unroll
    for (int i = 0; i < 8; ++i) { R.v[2 * i] = bflo(aw[i]) + bflo(bw[i]); R.v[2 * i + 1] = bfhi(aw[i]) + bfhi(bw[i]); ss += R.v[2 * i] * R.v[2 * i] + R.v[2 * i + 1] * R.v[2 * i + 1]; }
    R.ss = ss;
}
__device__ __forceinline__ void mg_store(const GnRow& R, const unsigned (&ow)[8], float rs, const float* ng, bf16* dst) {
    unsigned res[8];
#pragma unroll
    for (int i = 0; i < 8; ++i) res[i] = cvt_pk_bf16(R.v[2 * i] * rs * ng[2 * i] * sigmoid_f(bflo(ow[i])), R.v[2 * i + 1] * rs * ng[2 * i + 1] * sigmoid_f(bfhi(ow[i])));
    *(v4u*)(dst) = (v4u){res[0], res[1], res[2], res[3]}; *(v4u*)(dst + 8) = (v4u){res[4], res[5], res[6], res[7]};
}
__device__ __forceinline__ void phase_mlstm_gnorm(Frame& F, const float* const* in, const bf16* Hf, const bf16* Hb, const bf16* Om, bf16* Hn) {
    const int gw = F.vcu * NWAVES + F.wave, NGW = GRID * NWAVES; const float* ng = in[28] + 16 * F.lane;
    for (int r = gw; r < M; r += 2 * NGW) { const int r2 = r + NGW < M ? r + NGW : r; const size_t o1 = (size_t)r * 1024 + 16 * F.lane, o2 = (size_t)r2 * 1024 + 16 * F.lane;
        GnRow A, B; unsigned wa[8], wb[8]; mg_load(A, wa, Hf, Hb, Om, o1); mg_load(B, wb, Hf, Hb, Om, o2);
        float sa = A.ss, sb = B.ss;
        sa += __shfl_xor(sa, 1); sb += __shfl_xor(sb, 1); sa += __shfl_xor(sa, 2); sb += __shfl_xor(sb, 2); sa += __shfl_xor(sa, 4); sb += __shfl_xor(sb, 4);
        mg_store(A, wa, rsqrtf(sa * (1.f / 128.f) + EPS), ng, Hn + o1);
        if (r2 != r) mg_store(B, wb, rsqrtf(sb * (1.f / 128.f) + EPS), ng, Hn + o2); }
}
struct Args { const float* in[37]; float* out; unsigned char* ws; };

__device__ __forceinline__ void moe_phases(Frame& F, const float* const* in, int layer, const XcdBarrier& bar) {
#if defined(PROBE_ROUTE2)
    phase_norm2_route(F, in, layer, true); __syncthreads();
#endif
    phase_norm2_route(F, in, layer);
    SYNC_GRID();
    bf16* Hb = (bf16*)(F.ws + WS_H); bf16* ACT = (bf16*)(F.ws + MOE_ACT); bf16* X = (bf16*)(F.ws + WS_X);
    const float* mod = (const float*)(F.ws + WS_MOD) + (size_t)layer * 9 * 6144;
    { MoeOrder<0> S; S.W = (const bf16*)(F.ws + WS_WGU); S.G = GRID; S.c = F.vcu; moe_setup(F, layer, S);
      pg8::Gemm g{Hb, 1024, 1024, 1 << 30}; EpiMoeAct E{ACT, S.tbl};
      pg8::gemm_phase(F.lds, g, S, E);
#if defined(PROBE_GM1)
      __syncthreads(); pg8::gemm_phase(F.lds, g, S, E);
#endif
      }
    SYNC_GRID();
    { MoeOrder<1> S; S.W = (const bf16*)(F.ws + WS_WDN); S.G = GRID; S.c = F.vcu; moe_setup(F, layer, S);
      pg8::Gemm g{ACT, 512, 256, 4};
#if defined(PROBE_OUT2)
      { EpiMoeDown E0{X, (const float*)(F.ws + WS_CTL + 262144), S.tbl}; pg8::gemm_phase(F.lds, g, S, E0); VM_WAIT(); __syncthreads(); __builtin_amdgcn_fence(__ATOMIC_ACQUIRE, "agent"); VM_WAIT(); __syncthreads(); refresh(F); }
#endif
      EpiMoeDown E{X, mod + 5 * 1024, S.tbl};
      pg8::gemm_phase(F.lds, g, S, E); }
    SYNC_GRID();
}
__device__ __forceinline__ void outproj_phase(Frame& F, const bf16* A, const bf16* Wt, int K, int ldb, int layer, const float* xin = nullptr, const float* cin = nullptr) {
    pg8::Gemm g{A, K, ldb, 1 << 30}; pg8::StaticOrder S; S.init(M, 1024, GRID, (int)blockIdx.x, Wt, ldb);
#if defined(PROBE_OUT2)
    { EpiResid E0{(bf16*)(F.ws + WS_X), (const float*)(F.ws + WS_CTL + 262144), xin, cin}; pg8::gemm_phase(F.lds, g, S, E0); VM_WAIT(); __syncthreads(); __builtin_amdgcn_fence(__ATOMIC_ACQUIRE, "agent"); VM_WAIT(); __syncthreads(); refresh(F); }
#endif
    EpiResid E{(bf16*)(F.ws + WS_X), (const float*)(F.ws + WS_MOD) + (size_t)layer * 9 * 6144 + 2 * 1024, xin, cin};
    pg8::gemm_phase(F.lds, g, S, E);
}

__device__ __forceinline__ void ssm_gp_phases(Frame& F, const float* const* in, const int gp, const XcdBarrier& bar) {
    unsigned char* scr = F.ws + WS_SCR; unsigned char* scr2 = (unsigned char*)F.out; bf16* H = (bf16*)(F.ws + WS_H); bf16* WM = (bf16*)(F.ws + WS_WMIX);
    bf16* Z = (bf16*)scr; bf16* XP = (bf16*)(scr + 68 * MiB); bf16* XS = (bf16*)(scr + 170 * MiB); float* DT = (float*)(scr + 238 * MiB); float* ACUM = (float*)(scr + 243 * MiB); bf16* BC = (bf16*)scr2; bf16* Yb = (bf16*)(scr2 + 34 * MiB);
    { pg8::Gemm g{H, 1024, 1024, 1 << 30}; pg8::StaticOrder S; S.init(M, 2816, GRID, (int)blockIdx.x, WM + (size_t)gp * 2816 * 1024, 1024);
      EpiSsmIn E{Z, XP, DT, in[21] + gp * 16};
      pg8::gemm_phase(F.lds, g, S, E);
#if defined(PROBE_GEMM2)
        __syncthreads(); pg8::gemm_phase(F.lds, g, S, E);
#endif
        }
    SYNC_GRID();
    phase_ssm_conv(F, in, gp, XP, XS, BC, DT, ACUM);
#if defined(PROBE_MEM2)
    phase_ssm_conv(F, in, gp, XP, XS, BC, DT, ACUM);
#endif
    SYNC_GRID();
#if defined(SSD_VALU)
    phase_ssm_scan(F, in, gp, XS, BC, DT, Z, XP);
    SYNC_GRID();
    phase_ssm_gnorm(F, in, gp, XP);
    SYNC_GRID();
#else
    phase_ssm_scan_mfma(F, in, gp, XS, BC, DT, ACUM, XP, Yb);
#if defined(PROBE_SSDM2)
    VM_WAIT(); __syncthreads(); __builtin_amdgcn_fence(__ATOMIC_ACQUIRE, "agent"); VM_WAIT(); __syncthreads(); refresh(F); phase_ssm_scan_mfma(F, in, gp, XS, BC, DT, ACUM, XP, Yb);
#endif
    SYNC_GRID();
    phase_ssm_gnorm2(F, in, gp, XP, Yb, XS, Z);
    SYNC_GRID();
#endif
    outproj_phase(F, XP, WM + 6 * MiB + (size_t)gp * 1024, 1024, 2048, 1);
    SYNC_GRID();
}

__global__ void __launch_bounds__(NTHR, 2) fwd_kernel(Args args) {
    extern __shared__ __attribute__((aligned(16))) unsigned char lds_raw[];
    Frame F;
    F.lds = (LAS unsigned char*)lds_raw; F.ws = args.ws; F.ctl = (unsigned*)(args.ws + WS_CTL); F.out = args.out;
    refresh(F);
    { const int bx = blockIdx.x; F.vcu = (bx % 8) * (GRID / 8) + bx / 8; }
    volatile LAS unsigned* MISC = (volatile LAS unsigned*)(F.lds + LDS_MISC);
    for (int u = F.tid; u < 256; u += NTHR) MISC[u] = 0u;
    __syncthreads();
    const XcdBarrier bar = xcd_barrier_post(F.ctl + CW_BAR, MISC + 8);
    const float* const* in = args.in;
    unsigned char* ws = F.ws; unsigned char* scr = ws + WS_SCR; unsigned char* scr2 = (unsigned char*)F.out;
    bf16* H = (bf16*)(ws + WS_H); bf16* WM = (bf16*)(ws + WS_WMIX);

#if defined(PROBE_MEM2)
    for (int rep = 0; rep < 2; ++rep) {
#endif
    phase_prologue(F, in);
    __syncthreads(); refresh(F);
    convert_matrix<MAP_ATTN_IN>(F, in[15], 1024, 1536, WM, 0, nullptr);
    convert_matrix<MAP_ID>(F, in[17], 1024, 1024, WM + 2 * MiB, 0, nullptr);
    convert_moe(F, in, 0);
#if defined(PROBE_MEM2)
    __syncthreads(); }
#endif
    SYNC_GRID();

#ifndef SKIP_L0
    phase_norm1(F, in, 0);
#if defined(PROBE_MEM2)
    phase_norm1(F, in, 0);
#endif
    SYNC_GRID();
    { bf16* Q = (bf16*)scr; bf16* Kb = (bf16*)(scr + 68 * MiB); bf16* Vb = (bf16*)(scr + 85 * MiB);
      { pg8::Gemm g{H, 1024, 1024, 1 << 30}; pg8::StaticOrder S; S.init(M, 1536, GRID, (int)blockIdx.x, WM, 1024);
        EpiAttnIn E{Q, Kb, Vb, (const f32x2*)(ws + WS_TABA), 0.125f * LOG2E};
        pg8::gemm_phase(F.lds, g, S, E);
#if defined(PROBE_GEMM2)
        __syncthreads(); pg8::gemm_phase(F.lds, g, S, E);
#endif
        }
      SYNC_GRID();
#if defined(PROBE_WIN2)
      phase_attn_window(F, in, Q, Kb, Vb, (bf16*)scr2); __syncthreads();
#endif
      phase_attn_window(F, in, Q, Kb, Vb);
      SYNC_GRID();
      outproj_phase(F, Q, WM + 2 * MiB, 1024, 1024, 0, in[0], in[2]);
      SYNC_GRID(); }
    moe_phases(F, in, 0, bar);

#endif
#ifndef SKIP_L1
#if defined(PROBE_MEM2)
    for (int rep = 0; rep < 2; ++rep) {
#endif
    phase_norm1(F, in, 1);
    convert_matrix<MAP_SSM_IN>(F, in[18], 1024, 5184, WM, 0, nullptr);
    zero_rows(F, WM, 2592, 224, 1024); zero_rows(F, WM, 2816 + 2592, 224, 1024);
    convert_matrix<MAP_ID>(F, in[25], 2048, 1024, WM + 6 * MiB, 0, nullptr);
    convert_moe(F, in, 1);
#if defined(PROBE_MEM2)
    __syncthreads(); }
#endif
    SYNC_GRID();
    ssm_gp_phases(F, in, 0, bar);
    ssm_gp_phases(F, in, 1, bar);
    moe_phases(F, in, 1, bar);

#endif
#ifndef SKIP_L2
#if defined(PROBE_MEM2)
    for (int rep = 0; rep < 2; ++rep) {
#endif
    phase_norm1(F, in, 2);
    convert_matrix<MAP_ID>(F, in[26], 1024, 3104, WM, 0, nullptr);
    zero_rows(F, WM, 3104, 224, 1024);
    convert_matrix<MAP_ID>(F, in[29], 1024, 1024, WM + 4 * MiB, 0, nullptr);
    convert_moe(F, in, 2);
#if defined(PROBE_MEM2)
    __syncthreads(); }
#endif
    SYNC_GRID();
    { bf16* Qm = (bf16*)scr; bf16* Km = (bf16*)(scr + 34 * MiB); bf16* Vm = (bf16*)(scr + 68 * MiB); bf16* Om = (bf16*)(scr + 136 * MiB); float* Gt = (float*)(scr + 204 * MiB);
      bf16* Hf = (bf16*)scr2; bf16* Hbw = H;
      { pg8::Gemm g{H, 1024, 1024, 1 << 30}; pg8::StaticOrder S; S.init(M, 3328, GRID, (int)blockIdx.x, WM, 1024);
        EpiMlIn E{Qm, Km, Vm, Om, Gt, in[27]};
        pg8::gemm_phase(F.lds, g, S, E);
#if defined(PROBE_GEMM2)
        __syncthreads(); pg8::gemm_phase(F.lds, g, S, E);
#endif
        }
      SYNC_GRID();
#if defined(ML_VALU)
      phase_mlstm_scan(F, Qm, Km, Vm, Gt, Hf, Hbw);
#else
      phase_mlstm_scan_mfma(F, Qm, Km, Vm, Gt, Hf, Hbw);
#if defined(PROBE_MLM2)
      __syncthreads(); phase_mlstm_scan_mfma(F, Qm, Km, Vm, Gt, Hf, Hbw);
#endif
#endif
      SYNC_GRID();
      phase_mlstm_gnorm(F, in, Hf, Hbw, Om, Om);
      SYNC_GRID();
      outproj_phase(F, Om, WM + 4 * MiB, 1024, 1024, 2);
      SYNC_GRID(); }
    moe_phases(F, in, 2, bar);

#endif
#ifndef SKIP_L3
#if defined(PROBE_MEM2)
    for (int rep = 0; rep < 2; ++rep) {
#endif
    phase_norm1(F, in, 3);
    convert_matrix<MAP_MLA_IN>(F, in[30], 1024, 544, WM, 0, nullptr);
    zero_rows(F, WM, 544, 224, 1024);
    convert_matrix<MAP_MLA_QUP>(F, in[32], 256, 1536, WM + 1 * MiB, 0, in[31]);
    convert_matrix<MAP_ID>(F, in[34], 256, 2048, WM + 2 * MiB, 0, in[33]);
    convert_matrix<MAP_ID>(F, in[35], 1024, 1024, WM + 3 * MiB, 0, nullptr);
    convert_moe(F, in, 3);
#if defined(PROBE_MEM2)
    __syncthreads(); }
#endif
    SYNC_GRID();
    { bf16* CQ = (bf16*)scr; bf16* CKV = (bf16*)(scr + 17 * MiB); float* SSQ = (float*)(scr + 34 * MiB); bf16* KF = (bf16*)(scr + 36 * MiB); bf16* V3 = (bf16*)(scr + 138 * MiB);
      bf16* Q3 = (bf16*)scr2; bf16* O3 = H; const f32x2* tabm = (const f32x2*)(ws + WS_TABM);
      { pg8::Gemm g{H, 1024, 1024, 1 << 30}; pg8::StaticOrder S; S.init(M, 768, GRID, (int)blockIdx.x, WM, 1024);
        EpiMlaIn E{CQ, CKV, KF, SSQ, tabm};
        pg8::gemm_phase(F.lds, g, S, E);
#if defined(PROBE_GEMM2)
        __syncthreads(); pg8::gemm_phase(F.lds, g, S, E);
#endif
        }
      SYNC_GRID();
      { pg8::Gemm g{CQ, 256, 256, 1 << 30}; pg8::StaticOrder S; S.init(M, 1536, GRID, (int)blockIdx.x, WM + 1 * MiB, 256);
        EpiMlaQ E{Q3, SSQ, tabm, 0.10206207261596577f * LOG2E};
        pg8::gemm_phase(F.lds, g, S, E);
#if defined(PROBE_GEMM2)
        __syncthreads(); pg8::gemm_phase(F.lds, g, S, E);
#endif
        }
      { pg8::Gemm g{CKV, 256, 256, 1 << 30}; pg8::StaticOrder S; S.init(M, 2048, GRID, (int)blockIdx.x, WM + 2 * MiB, 256);
        EpiMlaKV E{KF, V3, SSQ};
        pg8::gemm_phase(F.lds, g, S, E);
#if defined(PROBE_GEMM2)
        __syncthreads(); pg8::gemm_phase(F.lds, g, S, E);
#endif
        }
      SYNC_GRID();
      phase_attn_mla(F, Q3, KF, V3, O3);
#if defined(PROBE_MLA2)
      __syncthreads(); phase_attn_mla(F, Q3, KF, V3, O3);
#endif
      SYNC_GRID();
      outproj_phase(F, O3, WM + 3 * MiB, 1024, 1024, 3);
      SYNC_GRID(); }
    moe_phases(F, in, 3, bar);

#endif
    const bool poison = __hip_atomic_load(F.ctl + CW_BAR + XB_TMO, RLX_AGENT) != 0u || __hip_atomic_load(F.ctl + CW_POISON, RLX_AGENT) != 0u;
    phase_final(F, in, poison);
#if defined(PROBE_MEM2)
    phase_final(F, in, poison);
#endif
}

extern "C" void kernel_launch(void* const* d_in, const int* in_sizes, int n_in, void* d_out, int out_size, void* d_ws, size_t ws_size, hipStream_t stream) {
    static int ready = 0;
    if (ready == 0) {
        ready = -1;
        if (n_in != 37 || in_sizes[0] != NB * SEQ * D || out_size != NB * SEQ * D || ws_size < WS_END) { fprintf(stderr, "kernel_launch: unexpected problem shape (n_in %d, in0 %d, out %d, ws %zu)\n", n_in, n_in > 0 ? in_sizes[0] : -1, out_size, ws_size); return; }
        int dev = 0, cus = 0;
        if (hipGetDevice(&dev) != hipSuccess || hipDeviceGetAttribute(&cus, hipDeviceAttributeMultiprocessorCount, dev) != hipSuccess) { fprintf(stderr, "kernel_launch: device query failed\n"); return; }
        if (cus < GRID) { fprintf(stderr, "kernel_launch: needs %d CUs, device has %d\n", GRID, cus); return; }
        if (hipFuncSetAttribute((const void*)fwd_kernel, hipFuncAttributeMaxDynamicSharedMemorySize, LDS_BYTES) != hipSuccess) { fprintf(stderr, "kernel_launch: hipFuncSetAttribute failed\n"); return; }
        int per_cu = 0;
        if (hipOccupancyMaxActiveBlocksPerMultiprocessor(&per_cu, (const void*)fwd_kernel, NTHR, LDS_BYTES) != hipSuccess || per_cu < 1) { fprintf(stderr, "kernel_launch: occupancy query reports %d blocks per CU\n", per_cu); }
        (void)hipGetLastError();
        ready = 1;
    }
    if (ready < 0) return;
    if (hipMemsetAsync((char*)d_ws + WS_CTL, 0, CTL_ZERO_BYTES, stream) != hipSuccess) { fprintf(stderr, "kernel_launch: memset failed\n"); return; }
    Args a{};
    for (int i = 0; i < 37; ++i) a.in[i] = (const float*)d_in[i];
    a.out = (float*)d_out; a.ws = (unsigned char*)d_ws;
    hipLaunchKernelGGL(fwd_kernel, dim3(GRID), dim3(NTHR), LDS_BYTES, stream, a);
    const hipError_t le = hipPeekAtLastError();
    if (le != hipSuccess) fprintf(stderr, "kernel_launch: launch failed: %s\n", hipGetErrorName(le));
}
```

```cpp
#include <hip/hip_runtime.h>
#include <cstdio>
#include <cstdint>

#define GAS __attribute__((address_space(1)))
#define LAS __attribute__((address_space(3)))
typedef unsigned short bf16;
typedef unsigned v4u __attribute__((ext_vector_type(4)));
typedef unsigned v2u __attribute__((ext_vector_type(2)));
typedef float f32x4 __attribute__((ext_vector_type(4)));
typedef float f32x2 __attribute__((ext_vector_type(2)));
typedef short bf16x8 __attribute__((ext_vector_type(8)));
typedef short s16x4 __attribute__((ext_vector_type(4)));
#define RLX_AGENT __ATOMIC_RELAXED, __HIP_MEMORY_SCOPE_AGENT

constexpr int D = 1024, NB = 8, SEQ = 4096, CTX = 256, TPB = SEQ + CTX  , M = NB * TPB  ;
constexpr int NWAVES = 8, NTHR = 512, GRID = 256;
constexpr float EPS = 1e-6f;
constexpr float LOG2E = 1.4426950408889634f;

__device__ __forceinline__ unsigned f2bf(float f) { unsigned u = __builtin_bit_cast(unsigned, f); return (u + 0x7fffu + ((u >> 16) & 1u)) >> 16; }
__device__ __forceinline__ float bf2f(unsigned b) { return __builtin_bit_cast(float, b << 16); }
__device__ __forceinline__ float bflo(unsigned w) { return __builtin_bit_cast(float, w << 16); }
__device__ __forceinline__ float bfhi(unsigned w) { return __builtin_bit_cast(float, w & 0xffff0000u); }
typedef __bf16 nbf16x2 __attribute__((ext_vector_type(2)));
__device__ __forceinline__ unsigned cvt_pk_bf16(float lo, float hi) { const nbf16x2 r = __builtin_convertvector((f32x2){lo, hi}, nbf16x2); return __builtin_bit_cast(unsigned, r); }
__device__ __forceinline__ float fast_exp2(float x) { return __builtin_amdgcn_exp2f(x); }
__device__ __forceinline__ float fast_rcp(float x) { return __builtin_amdgcn_rcpf(x); }
__device__ __forceinline__ float silu_f(float x) { return x * fast_rcp(1.0f + fast_exp2(-x * LOG2E)); }
__device__ __forceinline__ float sigmoid_f(float x) { return fast_rcp(1.0f + fast_exp2(-x * LOG2E)); }
__device__ __forceinline__ float fast_log(float x) { return __builtin_amdgcn_logf(x) * 0.6931471805599453f; }
__device__ __forceinline__ float fast_exp(float x) { return __builtin_amdgcn_exp2f(x * LOG2E); }
__device__ __forceinline__ float softplus_f(float x) { if (x > 20.f) return x; const float e = fast_exp(x); return e < 0.01f ? e * (1.0f - e * (0.5f - e * (1.0f / 3.0f))) : fast_log(1.0f + e); }
__device__ __forceinline__ v4u pack8(const f32x4 a, const f32x4 b) { v4u w; w.x = cvt_pk_bf16(a[0], a[1]); w.y = cvt_pk_bf16(a[2], a[3]); w.z = cvt_pk_bf16(b[0], b[1]); w.w = cvt_pk_bf16(b[2], b[3]); return w; }
#define DPPF(old, src, ctrl, rm, bc) __builtin_bit_cast(float, __builtin_amdgcn_update_dpp(__builtin_bit_cast(int, (float)(old)), __builtin_bit_cast(int, (float)(src)), ctrl, rm, 0xF, bc))
__device__ __forceinline__ float xor32(float x) {
    const unsigned u = __builtin_bit_cast(unsigned, x);
    const auto r = __builtin_amdgcn_permlane32_swap(u, u, false, false);
    return __builtin_bit_cast(float, (threadIdx.x & 32u) ? r[0] : r[1]);
}
__device__ __forceinline__ float wave_scan_sum(float v) {
    v += DPPF(0.f, v, 0x111, 0xF, true); v += DPPF(0.f, v, 0x112, 0xF, true); v += DPPF(0.f, v, 0x114, 0xF, true); v += DPPF(0.f, v, 0x118, 0xF, true);
    v += DPPF(0.f, v, 0x142, 0xA, false); v += DPPF(0.f, v, 0x143, 0xC, false); return v;
}
__device__ __forceinline__ float wave_scan_max(float v) {
    v = fmaxf(v, DPPF(-3.0e38f, v, 0x111, 0xF, false)); v = fmaxf(v, DPPF(-3.0e38f, v, 0x112, 0xF, false)); v = fmaxf(v, DPPF(-3.0e38f, v, 0x114, 0xF, false)); v = fmaxf(v, DPPF(-3.0e38f, v, 0x118, 0xF, false));
    v = fmaxf(v, DPPF(-3.0e38f, v, 0x142, 0xA, false)); v = fmaxf(v, DPPF(-3.0e38f, v, 0x143, 0xC, false)); return v;
}
__device__ __forceinline__ float wave_sum(float v) {
    v += DPPF(0.f, v, 0xB1, 0xF, true); v += DPPF(0.f, v, 0x4E, 0xF, true); v += DPPF(0.f, v, 0x141, 0xF, true); v += DPPF(0.f, v, 0x140, 0xF, true);
    v += DPPF(0.f, v, 0x142, 0xA, false); v += DPPF(0.f, v, 0x143, 0xC, false);
    return __builtin_bit_cast(float, __builtin_amdgcn_readlane(__builtin_bit_cast(int, v), 63));
}
__device__ __forceinline__ int opaque_tid() { int t = threadIdx.x; asm volatile("" : "+v"(t)); return t; }
__device__ __forceinline__ float xrow_max(float v) {
    { auto r = __builtin_amdgcn_permlane16_swap(__builtin_bit_cast(unsigned, v), __builtin_bit_cast(unsigned, v), false, false); v = fmaxf(__builtin_bit_cast(float, r[0]), __builtin_bit_cast(float, r[1])); }
    { auto r = __builtin_amdgcn_permlane32_swap(__builtin_bit_cast(unsigned, v), __builtin_bit_cast(unsigned, v), false, false); v = fmaxf(__builtin_bit_cast(float, r[0]), __builtin_bit_cast(float, r[1])); }
    return v; }
__device__ __forceinline__ float xrow_sum(float v) {
    { auto r = __builtin_amdgcn_permlane16_swap(__builtin_bit_cast(unsigned, v), __builtin_bit_cast(unsigned, v), false, false); v = __builtin_bit_cast(float, r[0]) + __builtin_bit_cast(float, r[1]); }
    { auto r = __builtin_amdgcn_permlane32_swap(__builtin_bit_cast(unsigned, v), __builtin_bit_cast(unsigned, v), false, false); v = __builtin_bit_cast(float, r[0]) + __builtin_bit_cast(float, r[1]); }
    return v; }
#define LDS_WAIT() asm volatile("s_waitcnt lgkmcnt(0)" ::: "memory")
#define VM_WAIT() asm volatile("s_waitcnt vmcnt(0)" ::: "memory")

namespace pg8 {
constexpr int BM = 256, BK = 64, HALF = 128, HTB = HALF * BK * 2, STAGE_BYTES = 8 * HTB, NXCD = 8, WGM = 8;
__host__ __device__ __forceinline__ int lds_byte(int r, int c) { const int st = (r >> 4) * 2 + (c >> 5), rr = r & 15, cc = c & 31, ob = rr * 64 + cc * 2; return st * 1024 + (ob ^ (((ob >> 9) & 1) << 5)); }
__host__ __device__ __forceinline__ void stage_rc(int b, int& R, int& C) { const int st = b / 1024, sb = b % 1024, swz = sb ^ (((sb >> 9) & 1) << 5); R = (st >> 1) * 16 + swz / 64; C = (st & 1) * 32 + (swz % 64) / 2; }
__host__ __device__ __forceinline__ int perm32(int rho) { const int n = rho >> 4, i = rho & 15; return 8 * (i >> 2) + 4 * n + (i & 3); }

struct Unit { int pm, pn, aux; };
struct Gemm { const bf16* A; int K; int ldb; int ksplit; };

struct StaticOrder {
    static constexpr bool GATHER = false;
    int nM, nN, nwg, G, c; const bf16* Bt; int ldb; bool skipctx;
    __device__ void init(int M_, int N_, int G_, int c_, const bf16* Bt_, int ldb_, bool skipctx_ = false) { skipctx = skipctx_; nM = skipctx ? 128 : M_ / BM; nN = N_ / BM; nwg = nM * nN; G = G_; c = c_; Bt = Bt_; ldb = ldb_; }
    __device__ __forceinline__ bool next(int i, Unit& u) const {
        const long L = (long)i * G + c; if (L >= nwg) return false;
        int wgid = (int)L; { const int q = nwg / NXCD, r = nwg % NXCD, xcd = wgid % NXCD, off = wgid / NXCD; wgid = (xcd < r ? xcd * (q + 1) : r * (q + 1) + (xcd - r) * q) + off; }
        const int nig = WGM * nN, gid = wgid / nig, fm = gid * WGM, gsz = (nM - fm) < WGM ? (nM - fm) : WGM;
        u.pm = fm + ((wgid % nig) % gsz); u.pn = (wgid % nig) / gsz; u.aux = 0; if (skipctx) u.pm = (u.pm >> 4) * 17 + 1 + (u.pm & 15); return true;
    }
    __device__ __forceinline__ int a_row(const Unit& u, int r) const { return u.pm * BM + r; }
    __device__ __forceinline__ const char* b_seg(const Unit& u, int seg) const { return (const char*)(Bt + (size_t)u.pn * BM * ldb); }
};

template <class Epi, class Sched>
__device__ __forceinline__ void gemm_phase(LAS unsigned char* lds, const Gemm g, const Sched& S, const Epi& E) {
    const int tid = opaque_tid(), wid = __builtin_amdgcn_readfirstlane(tid >> 6), lane = tid & 63, wr = wid >> 2, wc = wid & 3, fr = lane & 15, fq = lane >> 4;
    const int K = g.K, nt = K / BK, ldb = g.ldb, ksplit = g.ksplit;
    int Rst[2], Cst[2]; unsigned voffB[2], voffA[2];
#pragma unroll
    for (int i = 0; i < 2; ++i) { int R, C; stage_rc(tid * 16 + i * 8192, R, C); const int Rb = Epi::PERM ? ((R & ~31) + perm32(R & 31)) : R; Rst[i] = R; Cst[i] = C;
        voffB[i] = (unsigned)(Rb * ldb + C) * 2u; voffA[i] = (unsigned)(R * K + C) * 2u; }
    const size_t hstepA = (size_t)HALF * K * 2;
    const size_t kstep = (size_t)(BK * 2);
    const size_t hstepB = (size_t)HALF * ldb * 2;
    const unsigned ldsw = (unsigned)wid * 1024u;
    const int aoff = lds_byte(wr * 64 + fr, fq * 8), boff = lds_byte(wc * 32 + fr, fq * 8);
#define PG8_SA(b, h) (((b) * 2 + (h)) * HTB)
#define PG8_SB(b, h) ((4 + (b) * 2 + (h)) * HTB)
#define PG8_STAGEB(bufoff, gbase) do { _Pragma("unroll") for (int _i = 0; _i < 2; ++_i) \
        __builtin_amdgcn_global_load_lds((const unsigned*)((const char*)(gbase) + voffB[_i]), (LAS unsigned*)(lds + (bufoff) + ldsw + _i * 8192), 16, 0, 0); } while (0)
#define PG8_STAGEA(bufoff, nextsel, h, kt) do { if constexpr (Sched::GATHER) { _Pragma("unroll") for (int _i = 0; _i < 2; ++_i) \
        __builtin_amdgcn_global_load_lds((const unsigned*)(gA + (size_t)(kt) * kstep + ((nextsel) ? vN[h][_i] : vA[h][_i])), (LAS unsigned*)(lds + (bufoff) + ldsw + _i * 8192), 16, 0, 0); } \
      else { const char* _ab = ((nextsel) ? nA : cA) + (size_t)(h) * hstepA + (size_t)(kt) * kstep; _Pragma("unroll") for (int _i = 0; _i < 2; ++_i) \
        __builtin_amdgcn_global_load_lds((const unsigned*)(_ab + voffA[_i]), (LAS unsigned*)(lds + (bufoff) + ldsw + _i * 8192), 16, 0, 0); } } while (0)
#define PG8_LDA(dst, b, h) do { _Pragma("unroll") for (int m = 0; m < 4; ++m) _Pragma("unroll") for (int k = 0; k < 2; ++k) dst[m][k] = *(const LAS bf16x8*)(lds + PG8_SA(b, h) + aoff + m * 2048 + k * 1024); } while (0)
#define PG8_LDB(dst, b, h) do { _Pragma("unroll") for (int n = 0; n < 2; ++n) _Pragma("unroll") for (int k = 0; k < 2; ++k) dst[n][k] = *(const LAS bf16x8*)(lds + PG8_SB(b, h) + boff + n * 2048 + k * 1024); } while (0)
#define PG8_MMA(ai, bj, At, Bt) do { __builtin_amdgcn_s_setprio(1); _Pragma("unroll") for (int m = 0; m < 4; ++m) _Pragma("unroll") for (int n = 0; n < 2; ++n) _Pragma("unroll") for (int k = 0; k < 2; ++k) \
        acc[ai][bj][m][n] = __builtin_amdgcn_mfma_f32_16x16x32_bf16(Bt[n][k], At[m][k], acc[ai][bj][m][n], 0, 0, 0); __builtin_amdgcn_s_setprio(0); } while (0)
#define PG8_WAIT_V(n) asm volatile("s_waitcnt vmcnt(" #n ")" ::: "memory")
#define PG8_WAIT_L(n) asm volatile("s_waitcnt lgkmcnt(" #n ")" ::: "memory")
#define PG8_BAR __builtin_amdgcn_s_barrier()
#define PG8_SCHED __builtin_amdgcn_sched_barrier(0)
#define PG8_AOFFS(dst, u) do { _Pragma("unroll") for (int _h = 0; _h < 2; ++_h) _Pragma("unroll") for (int _i = 0; _i < 2; ++_i) \
        dst[_h][_i] = (unsigned)S.a_row(u, _h * HALF + Rst[_i]) * (unsigned)(K * 2) + (unsigned)(Cst[_i] * 2); } while (0)
    Unit cur, nxt; int ui = 0;
    if (!S.next(0, cur)) return;
#if defined(GEMM_STAGGER)
    { const unsigned long long t0 = __builtin_amdgcn_s_memrealtime(); const unsigned long long dly = (unsigned long long)((blockIdx.x >> 3) & 3) * GEMM_STAGGER;
      while (__builtin_amdgcn_s_memrealtime() - t0 < dly) __builtin_amdgcn_s_sleep(2); }
#endif
    const char* const gA = (const char*)g.A;
    f32x4 acc[2][2][4][2];
#pragma unroll
    for (int a = 0; a < 2; ++a)
#pragma unroll
        for (int b = 0; b < 2; ++b)
#pragma unroll
            for (int m = 0; m < 4; ++m)
#pragma unroll
                for (int n = 0; n < 2; ++n) acc[a][b][m][n] = (f32x4){0.f, 0.f, 0.f, 0.f};
    bf16x8 At[4][2], B0[2][2], B1[2][2];
    unsigned vA[2][2], vN[2][2];
    const char* cA = gA; const char* nA = gA;
    if constexpr (Sched::GATHER) { PG8_AOFFS(vA, cur); } else { cA = gA + (size_t)S.a_row(cur, 0) * K * 2; }
    const char* cB0 = S.b_seg(cur, 0); const char* cB1 = S.b_seg(cur, 1);
    PG8_STAGEB(PG8_SB(0, 0), cB0); PG8_STAGEB(PG8_SB(0, 1), cB0 + hstepB); PG8_STAGEA(PG8_SA(0, 0), false, 0, 0); PG8_STAGEA(PG8_SA(0, 1), false, 1, 0);
    if (wr == 1) PG8_BAR;
    PG8_WAIT_V(2); PG8_BAR;
    PG8_STAGEB(PG8_SB(1, 0), cB0 + kstep); PG8_STAGEA(PG8_SA(1, 0), false, 0, 1); PG8_STAGEB(PG8_SB(1, 1), cB0 + hstepB + kstep);
    PG8_WAIT_V(6); PG8_BAR;
    for (;;) {
        const bool has_next = S.next(ui + 1, nxt);
        const char* nB0 = cB0;
        nA = cA;
        if (has_next) { nB0 = S.b_seg(nxt, 0); if constexpr (Sched::GATHER) { PG8_AOFFS(vN, nxt); } else { nA = gA + (size_t)S.a_row(nxt, 0) * K * 2; } }
        else { if constexpr (Sched::GATHER) {
#pragma unroll
            for (int h = 0; h < 2; ++h)
#pragma unroll
                for (int i = 0; i < 2; ++i) vN[h][i] = vA[h][i]; } }
#pragma unroll 1
        for (int t = 0; t < nt; t += 2) {
            const bool last = (t == nt - 2);
            const char* b2 = last ? nB0 : ((t + 2 < ksplit) ? cB0 + (size_t)(t + 2) * kstep : cB1 + (size_t)(t + 2 - ksplit) * kstep);
            const char* b3 = b2 + kstep;
            const int kt2 = last ? 0 : t + 2;
            PG8_LDB(B0, 0, 0); PG8_LDB(B1, 0, 1); PG8_SCHED; PG8_LDA(At, 0, 0); PG8_STAGEA(PG8_SA(1, 1), false, 1, t + 1);
            PG8_WAIT_V(8); PG8_WAIT_L(0); PG8_BAR; PG8_MMA(0, 0, At, B0); PG8_MMA(0, 1, At, B1); PG8_BAR; PG8_SCHED;
            PG8_LDA(At, 0, 1); PG8_STAGEB(PG8_SB(0, 0), b2); PG8_STAGEB(PG8_SB(0, 1), b2 + hstepB); PG8_STAGEA(PG8_SA(0, 0), last, 0, kt2);
            PG8_WAIT_V(8); PG8_WAIT_L(0); PG8_BAR; PG8_MMA(1, 0, At, B0); PG8_MMA(1, 1, At, B1); PG8_BAR; PG8_SCHED;
            PG8_LDB(B0, 1, 0); PG8_LDB(B1, 1, 1); PG8_SCHED; PG8_LDA(At, 1, 0); PG8_STAGEA(PG8_SA(0, 1), last, 1, kt2);
            PG8_WAIT_V(8); PG8_WAIT_L(0); PG8_BAR; PG8_MMA(0, 0, At, B0); PG8_MMA(0, 1, At, B1); PG8_BAR; PG8_SCHED;
            PG8_LDA(At, 1, 1); PG8_STAGEB(PG8_SB(1, 0), b3); PG8_STAGEB(PG8_SB(1, 1), b3 + hstepB); PG8_STAGEA(PG8_SA(1, 0), last, 0, kt2 + 1);
            PG8_WAIT_V(8); PG8_WAIT_L(0); PG8_BAR; PG8_MMA(1, 0, At, B0); PG8_MMA(1, 1, At, B1); PG8_BAR; PG8_SCHED;
        }
        if (wr == 0) PG8_BAR;
        { int tz = tid; asm volatile("" : "+v"(tz));
          const int lz = tz & 63; E(acc, cur, ui, wr, wc, lz & 15, lz >> 4); }
        if (!has_next) break;
#pragma unroll
        for (int a = 0; a < 2; ++a)
#pragma unroll
            for (int b = 0; b < 2; ++b)
#pragma unroll
                for (int m = 0; m < 4; ++m)
#pragma unroll
                    for (int n = 0; n < 2; ++n) acc[a][b][m][n] = (f32x4){0.f, 0.f, 0.f, 0.f};
        cur = nxt; cB0 = nB0; cB1 = S.b_seg(cur, 1); cA = nA; ++ui;
        if constexpr (Sched::GATHER) {
#pragma unroll
        for (int h = 0; h < 2; ++h)
#pragma unroll
            for (int i = 0; i < 2; ++i) vA[h][i] = vN[h][i]; }
        if (wr == 1) PG8_BAR;
    }
    PG8_WAIT_V(0);
    PG8_BAR;
#undef PG8_SA
#undef PG8_SB
#undef PG8_STAGEA
#undef PG8_STAGEB
#undef PG8_LDA
#undef PG8_LDB
#undef PG8_MMA
#undef PG8_WAIT_V
#undef PG8_WAIT_L
#undef PG8_BAR
#undef PG8_SCHED
#undef PG8_AOFFS
}
}
#define XB_TMO      128
#define XB_XCNT(j)  (256  + 64 * (j))
#define XB_XSUB(j)  (1280 + 64 * (j))
#define XB_XGEN(j)  (2304 + 64 * (j))
#define XB_TOP      3328
#define XB_TOPGEN   3392
#define XCD_BAR_WORDS 3456
#define XB_SPIN_CAP (1u << 22)
__device__ __forceinline__ unsigned xb_ld(unsigned* p)              { return __hip_atomic_load(p, __ATOMIC_RELAXED, __HIP_MEMORY_SCOPE_AGENT); }
__device__ __forceinline__ unsigned xb_add(unsigned* p, unsigned v) { return __hip_atomic_fetch_add(p, v, __ATOMIC_RELAXED, __HIP_MEMORY_SCOPE_AGENT); }
__device__ __forceinline__ unsigned xb_xcc_id() { return (unsigned)__builtin_amdgcn_s_getreg((3 << 11) | 20) & 0xFu; }
#define XB_SPIN(cond, bar) do { unsigned _sp = 0; while (cond) { __builtin_amdgcn_s_sleep(1); \
    if ((++_sp & 255u) == 0u) { if (xb_ld(&(bar)[XB_TMO])) break; if (_sp > XB_SPIN_CAP) { atomicAdd(&(bar)[XB_TMO], 1u); break; } } } } while (0)
struct XcdBarrier { unsigned* bar; unsigned x; volatile LAS unsigned* st; };
__device__ __forceinline__ XcdBarrier xcd_barrier_post(unsigned* bar, volatile LAS unsigned* st) {
    XcdBarrier b; b.bar = bar; b.x = xb_xcc_id(); b.st = st;
    if (threadIdx.x == 0) (void)xb_add(&bar[XB_XCNT(b.x)], 1u);
    return b;
}
__device__ __forceinline__ void xcd_barrier_complete(unsigned* bar, unsigned x, unsigned& nloc, unsigned& nx) {
    const unsigned G = gridDim.x * gridDim.y * gridDim.z;
    unsigned sum, cnt, mine, sp = 0u;
    for (;;) {
        sum = 0u; cnt = 0u; mine = 0u;
#pragma unroll
        for (unsigned j = 0; j < 16; ++j) { const unsigned c = xb_ld(&bar[XB_XCNT(j)]); sum += c; cnt += (c > 0u) ? 1u : 0u; mine = (j == x) ? c : mine; }
        if (sum == G) break;
        __builtin_amdgcn_s_sleep(1);
        if ((++sp & 255u) == 0u) { if (xb_ld(&bar[XB_TMO])) break; if (sp > XB_SPIN_CAP) { atomicAdd(&bar[XB_TMO], 1u); break; } }
    }
    nloc = mine > 0u ? mine : 1u; nx = cnt > 0u ? cnt : 1u;
}
__device__ __forceinline__ void xcd_barrier(const XcdBarrier& b) {
    asm volatile("s_waitcnt vmcnt(0)" ::: "memory");
    __syncthreads();
    if (threadIdx.x == 0) {
        unsigned* bar = b.bar;
        __builtin_amdgcn_s_waitcnt(0);
        unsigned nloc = b.st[0], nx = b.st[1];
        if (nloc == 0u) { xcd_barrier_complete(bar, b.x, nloc, nx); b.st[0] = nloc; b.st[1] = nx; }
        const unsigned old = xb_add(&bar[XB_XSUB(b.x)], 1u);
        const unsigned gen = old / nloc;
        if (old + 1u == (gen + 1u) * nloc) {
            __builtin_amdgcn_fence(__ATOMIC_RELEASE, "agent");
            asm volatile("s_waitcnt vmcnt(0)" ::: "memory");
            const unsigned og = xb_add(&bar[XB_TOP], 1u);
            const unsigned tg = og / nx;
            if (og + 1u == (tg + 1u) * nx) xb_add(&bar[XB_TOPGEN], 1u);
            else XB_SPIN(xb_ld(&bar[XB_TOPGEN]) == tg, bar);
            __builtin_amdgcn_fence(__ATOMIC_ACQUIRE, "agent");
            xb_add(&bar[XB_XGEN(b.x)], 1u);
            asm volatile("s_waitcnt vmcnt(0)" ::: "memory");
        } else {
            XB_SPIN(xb_ld(&bar[XB_XGEN(b.x)]) == gen, bar);
            __builtin_amdgcn_fence(__ATOMIC_ACQUIRE, "agent");
            asm volatile("s_waitcnt vmcnt(0)" ::: "memory");
        }
    }
    __syncthreads();
}

constexpr size_t MiB = 1u << 20;
constexpr size_t WS_CTL = 0, CTL_ZERO_BYTES = 1 * MiB;
constexpr size_t WS_MOD = 1 * MiB;
constexpr size_t WS_TABA = 2 * MiB;
constexpr size_t WS_TABM = 3 * MiB;
constexpr size_t WS_WGU = 4 * MiB;
constexpr size_t WS_WDN = 20 * MiB;
constexpr size_t WS_WMIX = 28 * MiB;
constexpr size_t WS_X = 52 * MiB;
constexpr size_t WS_W1 = 116 * MiB;
__device__ __forceinline__ size_t wofs(int layer) { return (layer & 1) ? WS_W1 : 0; }
constexpr size_t WS_H = 188 * MiB;
constexpr size_t WS_SCR = 256 * MiB;
constexpr size_t WS_END = 512 * MiB;
constexpr size_t MOE_ACT = WS_SCR;
constexpr size_t MOE_SL = WS_SCR + 48 * MiB;
constexpr size_t MOE_WT = WS_SCR + 52 * MiB;
constexpr int CW_BAR = 4096;
constexpr int CW_MOECNT = 16384;
constexpr int CW_POISON = 20000;

constexpr int RING_BYTES = 131072;
constexpr int LDS_MISC = RING_BYTES;
constexpr int LDS_TB = RING_BYTES + 512;
constexpr int LDS_TBL = RING_BYTES + 1024;
constexpr int LDS_BYTES = RING_BYTES + 1024 + 16384;

struct Frame {
    LAS unsigned char* lds;
    unsigned* ctl;
    unsigned char* ws;
    float* out;
    int tid, lane, wave, vcu;
};

__device__ __forceinline__ void refresh(Frame& F) { F.tid = opaque_tid(); F.lane = F.tid & 63; F.wave = __builtin_amdgcn_readfirstlane(F.tid >> 6); }
#if defined(PROBE_BAR2)
#define SYNC_GRID() do { xcd_barrier(bar); xcd_barrier(bar); refresh(F); } while (0)
#else
#define SYNC_GRID() do { xcd_barrier(bar); refresh(F); } while (0)
#endif
__device__ __forceinline__ int modrow_of(int row) { const int b = row / TPB, t = row - b * TPB; return t < CTX ? 8 : b; }

enum { MAP_ID = 0, MAP_ATTN_IN, MAP_SSM_IN, MAP_MLA_IN, MAP_MLA_QUP, MAP_MOE_G, MAP_MOE_U };
template <int KIND> __device__ __forceinline__ int map_row(int n, int aux) {
    if (KIND == MAP_ID) return aux + n;
    if (KIND == MAP_ATTN_IN) { if (n >= 1280) return n; const int hb = n & ~63, d = n & 63; return hb + (d < 32 ? 2 * d : 2 * (d - 32) + 1); }
    if (KIND == MAP_SSM_IN) {
        if (n < 2048) { const int gp = n >> 10; return gp * 2816 + (n & 1023); }
        if (n < 4096) { const int c = n - 2048, gp = c >> 10; return gp * 2816 + 1024 + (c & 1023); }
        if (n < 4608) { const int c = n - 4096, gp = c >> 8; return gp * 2816 + 2048 + (c & 255); }
        if (n < 5120) { const int c = n - 4608, gp = c >> 8; return gp * 2816 + 2304 + (c & 255); }
        { const int c = n - 5120, dir = c >> 5, h = c & 31, gp = h >> 4; return gp * 2816 + 2560 + dir * 16 + (h & 15); }
    }
    if (KIND == MAP_MLA_IN) { if (n < 512) return n; const int d = n - 512; return 512 + (d < 16 ? 2 * d : 2 * (d - 16) + 1); }
    if (KIND == MAP_MLA_QUP) { const int h = n / 96, e = n - h * 96; if (e < 64) return n; const int d = e - 64; return h * 96 + 64 + (d < 16 ? 2 * d : 2 * (d - 16) + 1); }
    if (KIND == MAP_MOE_G) return aux + (n >> 7) * 256 + (n & 127);
    if (KIND == MAP_MOE_U) return aux + (n >> 7) * 256 + 128 + (n & 127);
    return n;
}
template <int KIND>
__device__ __forceinline__ void transpose_item(const float* W, int K, int N, bf16* WT, int aux, const float* kscale, LAS float* scr, int item, int lane) {
    const int nblk = N / 32, kb = item / nblk, nb = item % nblk, k0 = 64 * kb, n0 = 32 * nb;
#pragma unroll 8
    for (int i = 0; i < 32; ++i) { const int kk = 2 * i + (lane >> 5); float v = W[(size_t)(k0 + kk) * N + n0 + (lane & 31)]; if (kscale) v *= kscale[k0 + kk]; scr[kk * 33 + (lane & 31)] = v; }
    LDS_WAIT(); asm volatile("" ::: "memory");
    const int c = lane & 7;
#pragma unroll
    for (int j = 0; j < 4; ++j) { const int n = (lane >> 3) + 8 * j; const LAS float* s = scr + (8 * c) * 33 + n;
        v4u o; o.x = cvt_pk_bf16(s[0 * 33], s[1 * 33]); o.y = cvt_pk_bf16(s[2 * 33], s[3 * 33]); o.z = cvt_pk_bf16(s[4 * 33], s[5 * 33]); o.w = cvt_pk_bf16(s[6 * 33], s[7 * 33]);
        *(v4u*)(WT + (size_t)map_row<KIND>(n0 + n, aux) * K + k0 + 8 * c) = o; }
    LDS_WAIT(); asm volatile("" ::: "memory");
}
struct ConvGrid { int gw, ngw; };
__device__ __forceinline__ ConvGrid conv_all(Frame& F) { ConvGrid g; g.gw = F.vcu * NWAVES + F.wave; g.ngw = GRID * NWAVES; return g; }
template <int KIND>
__device__ __forceinline__ void convert_matrix(Frame& F, ConvGrid cg, const float* W, int K, int N, bf16* WT, int aux, const float* kscale) {
    LAS float* scr = (LAS float*)(F.lds + F.wave * 16384);
    const int nitems = (K / 64) * (N / 32);
    for (int it = cg.gw; it < nitems; it += cg.ngw) transpose_item<KIND>(W, K, N, WT, aux, kscale, scr, it, F.lane);
}
__device__ __forceinline__ void zero_rows(Frame& F, ConvGrid cg, bf16* WT, int row0, int nrows, int K) {
    const size_t n16 = (size_t)nrows * K / 8; v4u* p = (v4u*)(WT + (size_t)row0 * K);
    for (size_t i = (size_t)cg.gw * 64 + F.lane; i < n16; i += (size_t)cg.ngw * 64) p[i] = (v4u){0u, 0u, 0u, 0u};
}
__device__ __forceinline__ void convert_moe(Frame& F, ConvGrid cg, const float* const* in, int layer) {
    bf16* GU = (bf16*)(F.ws + WS_WGU + wofs(layer)); bf16* DN = (bf16*)(F.ws + WS_WDN + wofs(layer));
    const float* wg = in[12] + (size_t)layer * 16 * 1024 * 256; const float* wu = in[13] + (size_t)layer * 16 * 1024 * 256; const float* wd = in[14] + (size_t)layer * 16 * 256 * 1024;
    LAS float* scr = (LAS float*)(F.lds + F.wave * 16384);
    for (int it = cg.gw; it < 16 * 384; it += cg.ngw) { const int e = it / 384, r = it - e * 384, kind = r >> 7, sub = r & 127;
        if (kind == 0) transpose_item<MAP_MOE_G>(wg + (size_t)e * 1024 * 256, 1024, 256, GU, e * 512, nullptr, scr, sub, F.lane);
        else if (kind == 1) transpose_item<MAP_MOE_U>(wu + (size_t)e * 1024 * 256, 1024, 256, GU, e * 512, nullptr, scr, sub, F.lane);
        else transpose_item<MAP_ID>(wd + (size_t)e * 256 * 1024, 256, 1024, DN, e * 1024, nullptr, scr, sub, F.lane); }
}
__device__ __forceinline__ void convert_layer(Frame& F, ConvGrid cg, const float* const* in, int layer) {
    bf16* WM = (bf16*)(F.ws + WS_WMIX + wofs(layer));
    if (layer == 0) { convert_matrix<MAP_ATTN_IN>(F, cg, in[15], 1024, 1536, WM, 0, nullptr); convert_matrix<MAP_ID>(F, cg, in[17], 1024, 1024, WM + 2 * MiB, 0, nullptr); }
    else if (layer == 1) { convert_matrix<MAP_SSM_IN>(F, cg, in[18], 1024, 5184, WM, 0, nullptr); zero_rows(F, cg, WM, 2592, 224, 1024); zero_rows(F, cg, WM, 2816 + 2592, 224, 1024);
        convert_matrix<MAP_ID>(F, cg, in[25], 2048, 1024, WM + 6 * MiB, 0, nullptr); }
    else if (layer == 2) { convert_matrix<MAP_ID>(F, cg, in[26], 1024, 3104, WM, 0, nullptr); zero_rows(F, cg, WM, 3104, 224, 1024); convert_matrix<MAP_ID>(F, cg, in[29], 1024, 1024, WM + 4 * MiB, 0, nullptr); }
    else { convert_matrix<MAP_MLA_IN>(F, cg, in[30], 1024, 544, WM, 0, nullptr); zero_rows(F, cg, WM, 544, 224, 1024);
        convert_matrix<MAP_MLA_QUP>(F, cg, in[32], 256, 1536, WM + 1 * MiB, 0, in[31]); convert_matrix<MAP_ID>(F, cg, in[34], 256, 2048, WM + 2 * MiB, 0, in[33]);
        convert_matrix<MAP_ID>(F, cg, in[35], 1024, 1024, WM + 3 * MiB, 0, nullptr); }
    convert_moe(F, cg, in, layer);
}

__device__ __forceinline__ const float* src_row(const float* const* in, int r) { const int b = r / TPB, t = r - b * TPB; return t < CTX ? in[2] + ((size_t)b * CTX + t) * D : in[0] + ((size_t)b * SEQ + (t - CTX)) * D; }
__device__ __forceinline__ float row_load_ss(const bf16* xrow, int lane, f32x4 (&v)[4]) {
    const v4u a = *((const v4u*)xrow + lane), b = *((const v4u*)xrow + 64 + lane);
    v[0] = (f32x4){bflo(a.x), bfhi(a.x), bflo(a.y), bfhi(a.y)}; v[1] = (f32x4){bflo(a.z), bfhi(a.z), bflo(a.w), bfhi(a.w)};
    v[2] = (f32x4){bflo(b.x), bfhi(b.x), bflo(b.y), bfhi(b.y)}; v[3] = (f32x4){bflo(b.z), bfhi(b.z), bflo(b.w), bfhi(b.w)};
    float s = 0.f;
#pragma unroll
    for (int j = 0; j < 4; ++j) s += (v[j].x * v[j].x + v[j].y * v[j].y) + (v[j].z * v[j].z + v[j].w * v[j].w);
    return s;
}
__device__ __forceinline__ float row_load_ss_f32(const float* xrow, int lane, f32x4 (&v)[4]) {
    float s = 0.f;
#pragma unroll
    for (int j = 0; j < 2; ++j) { v[2 * j] = *(const f32x4*)(xrow + 512 * j + 8 * lane); v[2 * j + 1] = *(const f32x4*)(xrow + 512 * j + 8 * lane + 4); }
#pragma unroll
    for (int j = 0; j < 4; ++j) s += (v[j].x * v[j].x + v[j].y * v[j].y) + (v[j].z * v[j].z + v[j].w * v[j].w);
    return s;
}
__device__ __forceinline__ void row_finish(const f32x4 (&v)[4], float ss, const float* g, const float* sc, const float* sh, bf16* orow, int lane, f32x4 (&hv)[4]) {
    const float rstd = rsqrtf(ss * (1.f / D) + EPS);
#pragma unroll
    for (int j = 0; j < 2; ++j) {
#pragma unroll
        for (int q = 0; q < 2; ++q) { const int o = 512 * j + 8 * lane + 4 * q;
            hv[2 * j + q] = v[2 * j + q] * rstd * *(const f32x4*)(g + o) * (*(const f32x4*)(sc + o) + 1.0f) + *(const f32x4*)(sh + o); }
        *((v4u*)orow + 64 * j + lane) = pack8(hv[2 * j], hv[2 * j + 1]);
    }
}
struct ModRegs { f32x4 a[4], b[4]; };
__device__ __forceinline__ void mod_load(ModRegs& Mr, const float* g, const float* sc, const float* sh, int lane) {
#pragma unroll
    for (int j = 0; j < 4; ++j) { const int o = 512 * (j >> 1) + 8 * lane + 4 * (j & 1); Mr.a[j] = *(const f32x4*)(g + o) * (*(const f32x4*)(sc + o) + 1.0f); Mr.b[j] = *(const f32x4*)(sh + o); }
}
__device__ __forceinline__ void row_finish_regs(const f32x4 (&v)[4], float ss, const ModRegs& Mr, bf16* orow, int lane, f32x4 (&hv)[4]) {
    const float rstd = rsqrtf(ss * (1.f / D) + EPS);
#pragma unroll
    for (int j = 0; j < 4; ++j) hv[j] = v[j] * rstd * Mr.a[j] + Mr.b[j];
    *((v4u*)orow + lane) = pack8(hv[0], hv[1]); *((v4u*)orow + 64 + lane) = pack8(hv[2], hv[3]);
}
__device__ __forceinline__ void phase_norm1(Frame& F, const float* const* in, int layer) {
    const bf16* X = (const bf16*)(F.ws + WS_X); bf16* H = (bf16*)(F.ws + WS_H);
    const float* g = in[4] + layer * D; const float* mod = (const float*)(F.ws + WS_MOD) + (size_t)layer * 9 * 6144;
    const int gw = F.vcu * NWAVES + F.wave; constexpr int RPWV = M / (GRID * NWAVES);
    const int rbase = gw * RPWV; int cur = -1; ModRegs Mr;
    constexpr int RG = 6;
    for (int k0 = 0; k0 < RPWV; k0 += RG) { f32x4 v[RG][4], hv[4]; float ss[RG]; int rr[RG];
#pragma unroll
        for (int q = 0; q < RG; ++q) { rr[q] = (k0 + q < RPWV) ? rbase + k0 + q : rbase + k0; ss[q] = layer == 0 ? row_load_ss_f32(src_row(in, rr[q]), F.lane, v[q]) : row_load_ss(X + (size_t)rr[q] * D, F.lane, v[q]); }
#pragma unroll
        for (int q = 0; q < RG; ++q) ss[q] = wave_sum(ss[q]);
#pragma unroll
        for (int q = 0; q < RG; ++q) { if (q == 0 || k0 + q < RPWV) { const int mr = modrow_of(rr[q]);
                if (mr != cur) { cur = mr; const float* mp = mod + (size_t)mr * 6144; mod_load(Mr, g, mp + 1024, mp, F.lane); }
                row_finish_regs(v[q], ss[q], Mr, H + (size_t)rr[q] * D, F.lane, hv); } } }
}

__device__ __forceinline__ void phase_mod(Frame& F, const float* const* in, const int l0, const int l1, const int u0, const int ustride) {
    LAS float* sc = (LAS float*)F.lds;
    LAS float* part = (LAS float*)(F.lds + 40960);
    for (int i = F.tid; i < 9 * 1024; i += NTHR) { const int r = i >> 10, k = i & 1023; const float c = r < 8 ? in[1][r * 1024 + k] : in[3][k]; sc[i] = silu_f(c); }
    __syncthreads();
    float* MOD = (float*)(F.ws + WS_MOD);
    const int cq = F.tid & 15, ks = F.tid >> 4;
    for (int u = u0; u < (l1 - l0) * 96; u += ustride) { const int l = l0 + u / 96, cb = u % 96;
        const float* w = in[6] + (size_t)l * 1024 * 6144 + cb * 64 + cq * 4; f32x4 a[9];
#pragma unroll
        for (int r = 0; r < 9; ++r) a[r] = (f32x4){0.f, 0.f, 0.f, 0.f};
#pragma unroll 8
        for (int k = ks * 32; k < ks * 32 + 32; ++k) { const f32x4 wv = *(const f32x4*)(w + (size_t)k * 6144);
#pragma unroll
            for (int r = 0; r < 9; ++r) a[r] = a[r] + wv * sc[r * 1024 + k]; }
#pragma unroll
        for (int r = 0; r < 9; ++r) *(LAS f32x4*)(part + (ks * 9 + r) * 64 + cq * 4) = a[r];
        __syncthreads();
        for (int i = F.tid; i < 9 * 64; i += NTHR) { const int r = i >> 6, c = i & 63; float s = 0.f;
#pragma unroll
            for (int q = 0; q < 32; ++q) s += part[(q * 9 + r) * 64 + c];
            MOD[((size_t)l * 9 + r) * 6144 + cb * 64 + c] = s + in[7][l * 6144 + cb * 64 + c]; }
        __syncthreads(); }
}
__device__ __forceinline__ void phase_prologue(Frame& F, const float* const* in) {
    { f32x2* TA = (f32x2*)(F.ws + WS_TABA); f32x2* TM = (f32x2*)(F.ws + WS_TABM);
      for (int i = blockIdx.x * NTHR + F.tid; i < SEQ * 32; i += GRID * NTHR) { const int pos = i >> 5, a = i & 31; const float p = (a < 16) ? (float)(pos >> 6) : (float)(pos & 63);
          const float inv = fast_exp2(-(float)(a & 15) * (13.287712379549449f / 16.0f)); const float rev = p * inv * 0.15915494309189535f; TA[i] = (f32x2){__builtin_amdgcn_cosf(rev), __builtin_amdgcn_sinf(rev)}; }
      for (int i = blockIdx.x * NTHR + F.tid; i < SEQ * 16; i += GRID * NTHR) { const int pos = i >> 4, a = i & 15; const float p = (a < 8) ? (float)(pos >> 6) : (float)(pos & 63);
          const float inv = fast_exp2(-(float)(a & 7) * (13.287712379549449f / 8.0f)); const float rev = p * inv * 0.15915494309189535f; TM[i] = (f32x2){__builtin_amdgcn_cosf(rev), __builtin_amdgcn_sinf(rev)}; } }
    phase_mod(F, in, 0, 1, F.vcu, GRID);
}

__device__ __forceinline__ void phase_norm2_route(Frame& F, const float* const* in, int layer, bool dry = false) {
    constexpr int RPW = M / GRID;
    LAS float* wl = (LAS float*)F.lds;
    LAS int* lcnt = (LAS int*)(F.lds + 81920);
    LAS int* lbase = (LAS int*)(F.lds + 81920 + 128);
    LAS int* rcls = (LAS int*)(F.lds + 81920 + 256);
    LAS int* rrank = (LAS int*)(F.lds + 81920 + 256 + 1024);
    LAS float* lgw = (LAS float*)(F.lds + 81920 + 4096);
    const float* wrg = in[8] + (size_t)layer * 1024 * 4; const float* wre = in[10] + (size_t)layer * 1024 * 16;
#pragma unroll
    for (int m = 0; m < 2; ++m) { const int k = F.tid + NTHR * m; const f32x4 w = *(const f32x4*)(wrg + k * 4);
        wl[0 * 1024 + k] = w.x; wl[1 * 1024 + k] = w.y; wl[2 * 1024 + k] = w.z; wl[3 * 1024 + k] = w.w; }
#pragma unroll
    for (int o4 = 0; o4 < 4; ++o4)
#pragma unroll
        for (int m = 0; m < 2; ++m) { const int k = F.tid + NTHR * m; const f32x4 w = *(const f32x4*)(wre + k * 16 + 4 * o4);
            wl[(4 + 4 * o4 + 0) * 1024 + k] = w.x; wl[(4 + 4 * o4 + 1) * 1024 + k] = w.y; wl[(4 + 4 * o4 + 2) * 1024 + k] = w.z; wl[(4 + 4 * o4 + 3) * 1024 + k] = w.w; }
    LAS float* rbias = (LAS float*)(F.lds + 81920 + 8192);
    if (F.tid < 24) lcnt[F.tid] = 0;
    if (F.tid < 4) rbias[F.tid] = (in[9] + layer * 4)[F.tid]; else if (F.tid < 20) rbias[F.tid] = (in[11] + layer * 16)[F.tid - 4];
    __syncthreads();
    const bf16* X = (const bf16*)(F.ws + WS_X); bf16* H = (bf16*)(F.ws + WS_H);
    const float* g = in[5] + layer * D; const float* mod = (const float*)(F.ws + WS_MOD) + (size_t)layer * 9 * 6144;
    float* WT = (float*)(F.ws + MOE_WT); int* SL = (int*)(F.ws + MOE_SL);
    const int row0 = blockIdx.x * RPW; int curm = -1; ModRegs Mr;
    for (int i0 = F.wave; i0 < RPW; i0 += 2 * NWAVES) { const int i1 = i0 + NWAVES; const bool two = i1 < RPW; const int ra = row0 + i0, rb = two ? row0 + i1 : ra;
        f32x4 va[4], vb[4], ha[4], hb[4];
        float sa = row_load_ss(X + (size_t)ra * D, F.lane, va), sb = row_load_ss(X + (size_t)rb * D, F.lane, vb);
        sa = wave_sum(sa); sb = wave_sum(sb);
        { const int mra = modrow_of(ra); if (mra != curm) { curm = mra; const float* mp = mod + (size_t)mra * 6144; mod_load(Mr, g, mp + 4 * 1024, mp + 3 * 1024, F.lane); }
          row_finish_regs(va, sa, Mr, H + (size_t)ra * D, F.lane, ha); }
        { const int mrb = modrow_of(rb); if (mrb != curm) { curm = mrb; const float* mp = mod + (size_t)mrb * 6144; mod_load(Mr, g, mp + 4 * 1024, mp + 3 * 1024, F.lane); }
          row_finish_regs(vb, sb, Mr, H + (size_t)rb * D, F.lane, hb); }
        float ga[4], gb[4];
#pragma unroll
        for (int o = 0; o < 4; ++o) { float s = 0.f, t = 0.f;
#pragma unroll
            for (int j = 0; j < 4; ++j) { const f32x4 w = *(const LAS f32x4*)(wl + o * 1024 + 512 * (j >> 1) + 8 * F.lane + 4 * (j & 1));
                s += (ha[j].x * w.x + ha[j].y * w.y) + (ha[j].z * w.z + ha[j].w * w.w); t += (hb[j].x * w.x + hb[j].y * w.y) + (hb[j].z * w.z + hb[j].w * w.w); }
            ga[o] = wave_sum(s) + rbias[o]; gb[o] = wave_sum(t) + rbias[o]; }
        for (int q = 0; q < (two ? 2 : 1); ++q) { const int r = q ? rb : ra, i = q ? i1 : i0;
        const float g0 = q ? gb[0] : ga[0], g1 = q ? gb[1] : ga[1], g2 = q ? gb[2] : ga[2], g3 = q ? gb[3] : ga[3];
        int gs = 0; float gm = g0; if (g1 > gm) { gm = g1; gs = 1; } if (g2 > gm) { gm = g2; gs = 2; } if (g3 > gm) { gm = g3; gs = 3; }
        const float pg = 1.0f / (fast_exp(g0 - gm) + fast_exp(g1 - gm) + fast_exp(g2 - gm) + fast_exp(g3 - gm));
        float ev[4];
#pragma unroll
        for (int o = 0; o < 4; ++o) { float s = 0.f; const LAS float* wrow = wl + (4 + gs * 4 + o) * 1024;
#pragma unroll
            for (int j = 0; j < 4; ++j) { const f32x4 w = *(const LAS f32x4*)(wrow + 512 * (j >> 1) + 8 * F.lane + 4 * (j & 1)); const f32x4 hq = q ? hb[j] : ha[j];
                s += (hq.x * w.x + hq.y * w.y) + (hq.z * w.z + hq.w * w.w); }
            ev[o] = wave_sum(s) + rbias[4 + gs * 4 + o]; }
        const float e0 = ev[0], e1 = ev[1], e2 = ev[2], e3 = ev[3];
        int i1x = 0; float v1 = e0; if (e1 > v1) { v1 = e1; i1x = 1; } if (e2 > v1) { v1 = e2; i1x = 2; } if (e3 > v1) { v1 = e3; i1x = 3; }
        int i2x = -1; float v2 = -3.0e38f;
        if (i1x != 0 && e0 > v2) { v2 = e0; i2x = 0; } if (i1x != 1 && e1 > v2) { v2 = e1; i2x = 1; } if (i1x != 2 && e2 > v2) { v2 = e2; i2x = 2; } if (i1x != 3 && e3 > v2) { v2 = e3; i2x = 3; }
        const float ex = fast_exp(v2 - v1), w1 = pg / (1.0f + ex), w2 = pg * ex / (1.0f + ex);
        const int lo = i1x < i2x ? i1x : i2x, hi = i1x < i2x ? i2x : i1x; const float wlo = i1x < i2x ? w1 : w2, whi = i1x < i2x ? w2 : w1;
        const int pair = lo == 0 ? hi - 1 : (lo == 1 ? hi + 1 : 5);
        const int cls = gs * 6 + pair;
        if (F.lane == 0 && !dry) { WT[2 * (size_t)r] = wlo; WT[2 * (size_t)r + 1] = whi; rcls[i] = cls; rrank[i] = atomicAdd((int*)&lcnt[cls], 1); }
        }
        LDS_WAIT(); asm volatile("" ::: "memory");
    }
    __syncthreads();
    if (dry) return;
    if (F.tid < 24) lbase[F.tid] = (int)atomicAdd(F.ctl + CW_MOECNT + layer * 64 + F.tid, (unsigned)lcnt[F.tid]);
    __syncthreads();
    for (int i = F.tid; i < RPW; i += NTHR) { const int c = rcls[i]; SL[(size_t)c * M + lbase[c] + rrank[i]] = row0 + i; }
}

__device__ __forceinline__ void phase_final(Frame& F, const float* const* in, bool poison) {
    const bf16* X = (const bf16*)(F.ws + WS_X); const float* g = in[36];
    const int gw = F.vcu * NWAVES + F.wave, NGW = GRID * NWAVES;
    f32x4 gg[4];
#pragma unroll
    for (int j = 0; j < 4; ++j) gg[j] = *(const f32x4*)(g + 512 * (j >> 1) + 8 * F.lane + 4 * (j & 1));
    for (int q0 = gw; q0 < NB * SEQ; q0 += 4 * NGW) { f32x4 v[4][4]; float ss[4];
#pragma unroll
        for (int k = 0; k < 4; ++k) { const int q = q0 + k * NGW; ss[k] = row_load_ss(X + (size_t)((q / SEQ) * TPB + CTX + (q % SEQ)) * D, F.lane, v[k]); }
#pragma unroll
        for (int k = 0; k < 4; ++k) ss[k] = wave_sum(ss[k]);
#pragma unroll
        for (int k = 0; k < 4; ++k) { float rs = rsqrtf(ss[k] * (1.f / D) + EPS); if (poison) rs = __builtin_nanf(""); float* op = F.out + (size_t)(q0 + k * NGW) * D;
#pragma unroll
            for (int j = 0; j < 4; ++j) { const int o = 512 * (j >> 1) + 8 * F.lane + 4 * (j & 1); *(f32x4*)(op + o) = v[k][j] * rs * gg[j]; } } }
}
typedef f32x4 AccT[2][2][4][2];
using pg8::Unit;

__device__ __forceinline__ void rope8c(f32x4& a, f32x4& b, const f32x4 c01, const f32x4 c23) {
    float t;
    t = a[0] * c01[0] - a[1] * c01[1]; a[1] = a[1] * c01[0] + a[0] * c01[1]; a[0] = t;
    t = a[2] * c01[2] - a[3] * c01[3]; a[3] = a[3] * c01[2] + a[2] * c01[3]; a[2] = t;
    t = b[0] * c23[0] - b[1] * c23[1]; b[1] = b[1] * c23[0] + b[0] * c23[1]; b[0] = t;
    t = b[2] * c23[2] - b[3] * c23[3]; b[3] = b[3] * c23[2] + b[2] * c23[3]; b[2] = t;
}
__device__ __forceinline__ void rope8(f32x4& a, f32x4& b, const f32x2* cs) {
    const f32x4 c01 = *(const f32x4*)cs, c23 = *(const f32x4*)(cs + 2);
    float t;
    t = a[0] * c01[0] - a[1] * c01[1]; a[1] = a[1] * c01[0] + a[0] * c01[1]; a[0] = t;
    t = a[2] * c01[2] - a[3] * c01[3]; a[3] = a[3] * c01[2] + a[2] * c01[3]; a[2] = t;
    t = b[0] * c23[0] - b[1] * c23[1]; b[1] = b[1] * c23[0] + b[0] * c23[1]; b[0] = t;
    t = b[2] * c23[2] - b[3] * c23[3]; b[3] = b[3] * c23[2] + b[2] * c23[3]; b[2] = t;
}

__device__ __forceinline__ void unpack8(const v4u w, f32x4& a, f32x4& b) { a = (f32x4){bflo(w.x), bfhi(w.x), bflo(w.y), bfhi(w.y)}; b = (f32x4){bflo(w.z), bfhi(w.z), bflo(w.w), bfhi(w.w)}; }
struct EpiResid {
    static constexpr bool PERM = true;
    bf16* X; const float* gate; const float* x_in; const float* ctx_in;
    __device__ __forceinline__ void operator()(const AccT& acc, const Unit& u, int ui, int wr, int wc, int fr, int fq) const {
        const int tb = u.pm % 17, b = u.pm / 17; const float* gv = gate + (size_t)(tb == 0 ? 8 : b) * 6144;
        const float* src = x_in ? (tb == 0 ? ctx_in + (size_t)b * CTX * D : x_in + ((size_t)b * SEQ + (tb - 1) * 256) * D) : nullptr;
        const int rl0 = wr * 64 + fr, col0 = u.pn * 256 + wc * 32 + 8 * fq;
        f32x4 g4[2][2];
#pragma unroll
        for (int bj = 0; bj < 2; ++bj)
#pragma unroll
            for (int n = 0; n < 2; ++n) g4[bj][n] = *(const f32x4*)(gv + col0 + bj * 128 + n * 4);
        if (!src) {
            v4u raw[2][2][2][2];
#pragma unroll
            for (int ai = 0; ai < 2; ++ai)
#pragma unroll
                for (int mp = 0; mp < 2; ++mp)
#pragma unroll
                    for (int mm = 0; mm < 2; ++mm) { const int rl = rl0 + ai * 128 + (2 * mp + mm) * 16;
#pragma unroll
                        for (int bj = 0; bj < 2; ++bj) raw[ai][mp][mm][bj] = *(const v4u*)(X + ((size_t)u.pm * 256 + rl) * D + col0 + bj * 128); }
#pragma unroll
            for (int ai = 0; ai < 2; ++ai)
#pragma unroll
                for (int mp = 0; mp < 2; ++mp) {
#pragma unroll
                    for (int mm = 0; mm < 2; ++mm) { const int rl = rl0 + ai * 128 + (2 * mp + mm) * 16;
#pragma unroll
                        for (int bj = 0; bj < 2; ++bj) { f32x4 x0, x1; unpack8(raw[ai][mp][mm][bj], x0, x1);
                            *(v4u*)(X + ((size_t)u.pm * 256 + rl) * D + col0 + bj * 128) = pack8(x0 + g4[bj][0] * acc[ai][bj][2 * mp + mm][0], x1 + g4[bj][1] * acc[ai][bj][2 * mp + mm][1]); } }
                    asm volatile("" ::: "memory"); }
            return; }
#pragma unroll
        for (int ai = 0; ai < 2; ++ai) { f32x4 xin[2][2][2][2];
#pragma unroll
            for (int mp = 0; mp < 2; ++mp)
#pragma unroll
                for (int mm = 0; mm < 2; ++mm) { const int rl = rl0 + ai * 128 + (2 * mp + mm) * 16;
#pragma unroll
                    for (int bj = 0; bj < 2; ++bj) { const float* sp = src + (size_t)rl * D + col0 + bj * 128; xin[mp][mm][bj][0] = *(const f32x4*)sp; xin[mp][mm][bj][1] = *(const f32x4*)(sp + 4); } }
#pragma unroll
            for (int mp = 0; mp < 2; ++mp) {
#pragma unroll
                for (int mm = 0; mm < 2; ++mm) { const int rl = rl0 + ai * 128 + (2 * mp + mm) * 16;
#pragma unroll
                    for (int bj = 0; bj < 2; ++bj) *(v4u*)(X + ((size_t)u.pm * 256 + rl) * D + col0 + bj * 128) =
                        pack8(xin[mp][mm][bj][0] + g4[bj][0] * acc[ai][bj][2 * mp + mm][0], xin[mp][mm][bj][1] + g4[bj][1] * acc[ai][bj][2 * mp + mm][1]); }
                asm volatile("" ::: "memory"); } }
    }
};

struct EpiAttnIn {
    static constexpr bool PERM = true;
    bf16 *Q, *Kb, *Vb; const f32x2* tab; float qscale;
    __device__ __forceinline__ void operator()(const AccT& acc, const Unit& u, int ui, int wr, int wc, int fr, int fq) const {
        const int tb = u.pm % 17; const bool lat = tb != 0; const int pos0 = (tb - 1) * 256;
        bf16* base; int ld, colt; float sc = 1.f; bool rope = lat;
        if (u.pn < 4) { base = Q; ld = 1024; colt = u.pn * 256; sc = qscale; } else if (u.pn == 4) { base = Kb; ld = 256; colt = 0; } else { base = Vb; ld = 256; colt = 0; rope = false; }
#pragma unroll
        for (int ai = 0; ai < 2; ++ai) {
            f32x4 rc[4][2];
            if (rope) {
#pragma unroll
                for (int m = 0; m < 4; ++m) { const f32x2* cs = tab + (size_t)(pos0 + ai * 128 + wr * 64 + m * 16 + fr) * 32 + (((wc * 32 + 8 * fq) & 63) >> 1); rc[m][0] = *(const f32x4*)cs; rc[m][1] = *(const f32x4*)(cs + 2); } }
#pragma unroll
            for (int m = 0; m < 4; ++m) { const int rl = ai * 128 + wr * 64 + m * 16 + fr; const size_t row = (size_t)u.pm * 256 + rl;
#pragma unroll
                for (int bj = 0; bj < 2; ++bj) { const int cl = bj * 128 + wc * 32 + 8 * fq;
                    f32x4 a = acc[ai][bj][m][0] * sc, b = acc[ai][bj][m][1] * sc;
                    if (rope) rope8c(a, b, rc[m][0], rc[m][1]);
                    *(v4u*)(base + row * ld + colt + cl) = pack8(a, b); }
                asm volatile("" ::: "memory"); } }
    }
};

struct EpiSsmIn {
    static constexpr bool PERM = true;
    bf16 *Z, *XBC; float* DT; const float* dtb;
    __device__ __forceinline__ void operator()(const AccT& acc, const Unit& u, int ui, int wr, int wc, int fr, int fq) const {
#pragma unroll
        for (int ai = 0; ai < 2; ++ai)
#pragma unroll
            for (int m = 0; m < 4; ++m) { const size_t row = (size_t)u.pm * 256 + ai * 128 + wr * 64 + m * 16 + fr;
#pragma unroll
                for (int bj = 0; bj < 2; ++bj) { const int c = u.pn * 256 + bj * 128 + wc * 32 + 8 * fq;
                    const f32x4 a = acc[ai][bj][m][0], b = acc[ai][bj][m][1];
                    if (c < 1024) *(v4u*)(Z + row * 1024 + c) = pack8(a, b);
                    else if (c < 2560) *(v4u*)(XBC + row * 1536 + (c - 1024)) = pack8(a, b);
                    else if (c < 2592) { const int cc = c - 2560; f32x4 o0, o1;
#pragma unroll
                        for (int j = 0; j < 4; ++j) { o0[j] = softplus_f(a[j] + dtb[(cc >> 4) * 32 + (cc & 15) + j]); o1[j] = softplus_f(b[j] + dtb[(cc >> 4) * 32 + (cc & 15) + 4 + j]); }
                        *(f32x4*)(DT + row * 32 + cc) = o0; *(f32x4*)(DT + row * 32 + cc + 4) = o1; } } }
    }
};

struct EpiMlIn {
    static constexpr bool PERM = true;
    bf16 *Qm, *Km, *Vm, *Om; float* G; const float* gb;
    __device__ __forceinline__ void operator()(const AccT& acc, const Unit& u, int ui, int wr, int wc, int fr, int fq) const {
#pragma unroll
        for (int ai = 0; ai < 2; ++ai)
#pragma unroll
            for (int m = 0; m < 4; ++m) { const size_t row = (size_t)u.pm * 256 + ai * 128 + wr * 64 + m * 16 + fr;
#pragma unroll
                for (int bj = 0; bj < 2; ++bj) { const int c = u.pn * 256 + bj * 128 + wc * 32 + 8 * fq;
                    const f32x4 a = acc[ai][bj][m][0], b = acc[ai][bj][m][1];
                    if (c < 512) *(v4u*)(Qm + row * 512 + c) = pack8(a, b);
                    else if (c < 1024) *(v4u*)(Km + row * 512 + (c - 512)) = pack8(a * 0.125f, b * 0.125f);
                    else if (c < 2048) *(v4u*)(Vm + row * 1024 + (c - 1024)) = pack8(a, b);
                    else if (c < 3072) *(v4u*)(Om + row * 1024 + (c - 2048)) = pack8(a, b);
                    else if (c < 3104) { const int cc = c - 3072; f32x4 o0, o1; const bool fg = ((cc >> 3) & 1) != 0;
#pragma unroll
                        for (int j = 0; j < 4; ++j) { float x0 = a[j] + gb[cc + j], x1 = b[j] + gb[cc + 4 + j];
                            o0[j] = fg ? -softplus_f(-x0) : x0; o1[j] = fg ? -softplus_f(-x1) : x1; }
                        *(f32x4*)(G + row * 32 + cc) = o0; *(f32x4*)(G + row * 32 + cc + 4) = o1; } } }
    }
};

struct EpiMlaIn {
    static constexpr bool PERM = true;
    bf16 *CQ, *CKV, *KF; float* SSQ; const f32x2* tab;
    __device__ __forceinline__ void operator()(const AccT& acc, const Unit& u, int ui, int wr, int wc, int fr, int fq) const {
        const int tb = u.pm % 17; const bool lat = tb != 0; const int pos0 = (tb - 1) * 256;
#pragma unroll
        for (int ai = 0; ai < 2; ++ai)
#pragma unroll
            for (int m = 0; m < 4; ++m) { const int rl = ai * 128 + wr * 64 + m * 16 + fr; const size_t row = (size_t)u.pm * 256 + rl;
                if (u.pn < 2) { bf16* dst = u.pn == 0 ? CQ : CKV; float ss = 0.f;
#pragma unroll
                    for (int bj = 0; bj < 2; ++bj) { const int c = bj * 128 + wc * 32 + 8 * fq; const f32x4 a = acc[ai][bj][m][0], b = acc[ai][bj][m][1];
                        ss += (a[0] * a[0] + a[1] * a[1]) + (a[2] * a[2] + a[3] * a[3]) + (b[0] * b[0] + b[1] * b[1]) + (b[2] * b[2] + b[3] * b[3]);
                        *(v4u*)(dst + row * 256 + c) = pack8(a, b); }
                    ss += __shfl_xor(ss, 16); ss += __shfl_xor(ss, 32);
                    if (fq == 0) SSQ[row * 8 + u.pn * 4 + wc] = ss;
                } else if (wc == 0) {
                    f32x4 a = acc[ai][0][m][0], b = acc[ai][0][m][1]; const int cl = 8 * fq;
                    if (lat) rope8(a, b, tab + (size_t)(pos0 + rl) * 16 + (cl >> 1));
                    const v4u w = pack8(a, b);
#pragma unroll
                    for (int h = 0; h < 16; ++h) *(v4u*)(KF + row * 1536 + h * 96 + 64 + cl) = w; }
                asm volatile("" ::: "memory"); }
    }
};
struct EpiMlaQ {
    static constexpr bool PERM = true;
    bf16* Q3; const float* SSQ; const f32x2* tab; float qscale;
    __device__ __forceinline__ void operator()(const AccT& acc, const Unit& u, int ui, int wr, int wc, int fr, int fq) const {
        const int tb = u.pm % 17; const bool lat = tb != 0; const int pos0 = (tb - 1) * 256;
        f32x4 sq[2][4];
#pragma unroll
        for (int ai = 0; ai < 2; ++ai)
#pragma unroll
            for (int m = 0; m < 4; ++m) sq[ai][m] = *(const f32x4*)(SSQ + ((size_t)u.pm * 256 + ai * 128 + wr * 64 + m * 16 + fr) * 8);
        const int e0 = (u.pn * 256 + wc * 32 + 8 * fq) % 96, e1 = (u.pn * 256 + 128 + wc * 32 + 8 * fq) % 96; const int er = e0 >= 64 ? e0 : e1; const bool anyr = lat && er >= 64;
#pragma unroll
        for (int ai = 0; ai < 2; ++ai) {
            f32x4 rc[4][2];
            if (anyr) {
#pragma unroll
                for (int m = 0; m < 4; ++m) { const f32x2* cs = tab + (size_t)(pos0 + ai * 128 + wr * 64 + m * 16 + fr) * 16 + ((er - 64) >> 1); rc[m][0] = *(const f32x4*)cs; rc[m][1] = *(const f32x4*)(cs + 2); } }
#pragma unroll
            for (int m = 0; m < 4; ++m) { const int rl = ai * 128 + wr * 64 + m * 16 + fr; const size_t row = (size_t)u.pm * 256 + rl;
                const f32x4 s4 = sq[ai][m]; const float rs = rsqrtf(((s4[0] + s4[1]) + (s4[2] + s4[3])) * (1.f / 256.f) + EPS) * qscale;
#pragma unroll
                for (int bj = 0; bj < 2; ++bj) { const int c = u.pn * 256 + bj * 128 + wc * 32 + 8 * fq; const int e = bj ? e1 : e0;
                    f32x4 a = acc[ai][bj][m][0] * rs, b = acc[ai][bj][m][1] * rs;
                    if (lat && e >= 64) rope8c(a, b, rc[m][0], rc[m][1]);
                    *(v4u*)(Q3 + row * 1536 + c) = pack8(a, b); }
                asm volatile("" ::: "memory"); } }
    }
};
struct EpiMlaKV {
    static constexpr bool PERM = true;
    bf16 *KF, *V3; const float* SSQ;
    __device__ __forceinline__ void operator()(const AccT& acc, const Unit& u, int ui, int wr, int wc, int fr, int fq) const {
        f32x4 sq[2][4];
#pragma unroll
        for (int ai = 0; ai < 2; ++ai)
#pragma unroll
            for (int m = 0; m < 4; ++m) sq[ai][m] = *(const f32x4*)(SSQ + ((size_t)u.pm * 256 + ai * 128 + wr * 64 + m * 16 + fr) * 8 + 4);
#pragma unroll
        for (int ai = 0; ai < 2; ++ai)
#pragma unroll
            for (int m = 0; m < 4; ++m) { const size_t row = (size_t)u.pm * 256 + ai * 128 + wr * 64 + m * 16 + fr;
                const f32x4 s4 = sq[ai][m]; const float rs = rsqrtf(((s4[0] + s4[1]) + (s4[2] + s4[3])) * (1.f / 256.f) + EPS);
#pragma unroll
                for (int bj = 0; bj < 2; ++bj) { const int c = u.pn * 256 + bj * 128 + wc * 32 + 8 * fq; const int h = c >> 7, e = c & 127;
                    const v4u w = pack8(acc[ai][bj][m][0] * rs, acc[ai][bj][m][1] * rs);
                    if (e < 64) *(v4u*)(KF + row * 1536 + h * 96 + e) = w; else *(v4u*)(V3 + row * 1024 + h * 64 + (e - 64)) = w; }
                asm volatile("" ::: "memory"); }
    }
};

struct TblEnt { int tok; float w0, w1; int pad; };
__device__ __forceinline__ int cls_expert(int cls, int which) { const int g = cls / 6, p = cls - g * 6; const int lo = p < 3 ? 0 : (p < 5 ? 1 : 2), hi = p < 3 ? p + 1 : (p < 5 ? p - 1 : 3); return g * 4 + (which ? hi : lo); }
template <int MODE> struct MoeOrder {
    static constexpr bool GATHER = (MODE == 0);
    const LAS int* tb;
    const LAS unsigned char* tcls;
    const LAS TblEnt* tbl;
    const bf16* W; int G, c;
    __device__ __forceinline__ bool next(int i, Unit& u) const {
        const int L = i * G + c, tile = L >> 2; if (tile >= tb[24]) return false;
        const int cls = tcls[tile];
        u.pm = tile; u.pn = L & 3; u.aux = cls | (i << 8); return true;
    }
    __device__ __forceinline__ int a_row(const Unit& u, int r) const {
        if (MODE == 1) return u.pm * 256 + r;
        const int t = tbl[(u.aux >> 8) * 256 + r].tok; return t < 0 ? 0 : t;
    }
    __device__ __forceinline__ const char* b_seg(const Unit& u, int seg) const {
        const int cls = u.aux & 255;
        if (MODE == 0) return (const char*)(W + ((size_t)cls_expert(cls, u.pn >> 1) * 512 + (u.pn & 1) * 256) * 1024);
        return (const char*)(W + ((size_t)cls_expert(cls, seg) * 1024 + u.pn * 256) * 256);
    }
};
template <int MODE> __device__ __forceinline__ void moe_setup(Frame& F, int layer, MoeOrder<MODE>& S) {
    LAS int* tb = (LAS int*)(F.lds + LDS_TB); LAS int* cn = tb + 32; LAS TblEnt* tbl = (LAS TblEnt*)(F.lds + LDS_TBL);
    if (MODE == 1) {
        S.tb = tb; S.tbl = tbl; S.tcls = (const LAS unsigned char*)(F.lds + LDS_TB + 256); __syncthreads(); return; }
    LAS unsigned char* tcls = (LAS unsigned char*)(F.lds + LDS_TB + 256);
    if (F.wave == 0) { const int k = F.lane; const int n = k < 24 ? (int)__hip_atomic_load(F.ctl + CW_MOECNT + layer * 64 + k, RLX_AGENT) : 0;
        const int nt = (n + 255) >> 8; const int incl = (int)wave_scan_sum((float)nt); const int t0 = incl - nt;
        if (k < 24) { cn[k] = n; tb[k] = t0; for (int t = t0; t < incl; ++t) tcls[t] = (unsigned char)k; }
        if (k == 23) tb[24] = incl; }
    __syncthreads();
    S.tb = tb; S.tbl = tbl; S.tcls = tcls;
    const int* SL = (const int*)(F.ws + MOE_SL); const float* WT = (const float*)(F.ws + MOE_WT);
    if (F.tid < 256) { bool ok[4]; int tok[4]; f32x2 w[4];
#pragma unroll
        for (int i = 0; i < 4; ++i) { Unit u; ok[i] = S.next(i, u); tok[i] = -1;
            if (ok[i]) { const int cls = u.aux & 255, idx = (u.pm - tb[cls]) * 256 + F.tid; if (idx < cn[cls]) tok[i] = SL[(size_t)cls * M + idx]; } }
#pragma unroll
        for (int i = 0; i < 4; ++i) { w[i] = (f32x2){0.f, 0.f}; if (tok[i] >= 0) w[i] = *(const f32x2*)(WT + 2 * (size_t)tok[i]); }
#pragma unroll
        for (int i = 0; i < 4; ++i) { if (ok[i]) { LAS TblEnt* te = tbl + i * 256 + F.tid; te->tok = tok[i]; te->w0 = w[i].x; te->w1 = w[i].y; te->pad = 0; } } }
    __syncthreads();
}
struct EpiMoeAct {
    static constexpr bool PERM = true;
    bf16* ACT; const LAS TblEnt* tbl;
    __device__ __forceinline__ void operator()(const AccT& acc, const Unit& u, int ui, int wr, int wc, int fr, int fq) const {
        const int slot = u.pn >> 1, colb = slot * 256 + (u.pn & 1) * 128 + wc * 32 + 8 * fq;
#pragma unroll
        for (int ai = 0; ai < 2; ++ai)
#pragma unroll
            for (int m = 0; m < 4; ++m) { const int rl = ai * 128 + wr * 64 + m * 16 + fr; const LAS TblEnt* te = tbl + (u.aux >> 8) * 256 + rl; const float w = slot ? te->w1 : te->w0;
                f32x4 a, b;
#pragma unroll
                for (int j = 0; j < 4; ++j) { a[j] = silu_f(acc[ai][0][m][0][j]) * acc[ai][1][m][0][j] * w; b[j] = silu_f(acc[ai][0][m][1][j]) * acc[ai][1][m][1][j] * w; }
                *(v4u*)(ACT + ((size_t)u.pm * 256 + rl) * 512 + colb) = pack8(a, b);
                asm volatile("" ::: "memory"); }
    }
};
struct EpiMoeDown {
    static constexpr bool PERM = true;
    bf16* X; const float* gate; const LAS TblEnt* tbl;
    __device__ __forceinline__ void operator()(const AccT& acc, const Unit& u, int ui, int wr, int wc, int fr, int fq) const {
        const int col0 = u.pn * 256 + wc * 32 + 8 * fq;
#pragma unroll
        for (int ai = 0; ai < 2; ++ai) {
            int tk[2][2]; v4u raw[2][2][2];
#pragma unroll
            for (int mp = 0; mp < 2; ++mp)
#pragma unroll
                for (int mm = 0; mm < 2; ++mm) { const int rl = ai * 128 + wr * 64 + (2 * mp + mm) * 16 + fr; const int tok = tbl[(u.aux >> 8) * 256 + rl].tok; tk[mp][mm] = tok; const int t0 = tok < 0 ? 0 : tok;
                    const bf16* rowp = X + (size_t)t0 * D + col0;
#pragma unroll
                    for (int bj = 0; bj < 2; ++bj) raw[mp][mm][bj] = *(const v4u*)(rowp + bj * 128); }
#pragma unroll
            for (int mp = 0; mp < 2; ++mp) { f32x4 gin[2][2][2];
#pragma unroll
                for (int mm = 0; mm < 2; ++mm) { const int tok = tk[mp][mm]; const int t0 = tok < 0 ? 0 : tok; const float* gv = gate + (size_t)modrow_of(t0) * 6144 + col0;
#pragma unroll
                    for (int bj = 0; bj < 2; ++bj) { gin[mm][bj][0] = *(const f32x4*)(gv + bj * 128); gin[mm][bj][1] = *(const f32x4*)(gv + bj * 128 + 4); } }
#pragma unroll
                for (int mm = 0; mm < 2; ++mm) { if (tk[mp][mm] >= 0) { bf16* rowp = X + (size_t)tk[mp][mm] * D + col0;
#pragma unroll
                    for (int bj = 0; bj < 2; ++bj) { f32x4 x0, x1; unpack8(raw[mp][mm][bj], x0, x1);
                        *(v4u*)(rowp + bj * 128) = pack8(x0 + gin[mm][bj][0] * acc[ai][bj][2 * mp + mm][0], x1 + gin[mm][bj][1] * acc[ai][bj][2 * mp + mm][1]); } } }
                asm volatile("" ::: "memory"); } }
    }
};
template <int DQK, bool WIN>
__device__ __forceinline__ void flash_unit(LAS unsigned char* lds, const int tid, const int lane, const int grpB,
        const bf16* Kg, const int ldk, const bf16* Vg, const int ldv,
        const bf16* Qg, const int ldq, bf16* Og, const int ldo,
        const int ntiles, const int krow_ctx0, const int krow_lat0, const int kpos0, const int qpos_wave, const float sink2, const bool has_sink) {
    constexpr int KSTR = DQK * 2 + 16, VSTR = 160, KBUF = 64 * KSTR, VBUF = 64 * VSTR, CPR = DQK / 8, NKC = 64 * CPR, NKR = (NKC + 511) / 512, NKS = DQK / 32;
    LAS unsigned char* Kl = lds; LAS unsigned char* Vl = lds + 2 * KBUF;
    const int fr = lane & 15, fq = lane >> 4;
    bf16x8 qf[2][NKS];
#pragma unroll
    for (int qt = 0; qt < 2; ++qt)
#pragma unroll
        for (int ks = 0; ks < NKS; ++ks) qf[qt][ks] = *(const bf16x8*)(Qg + (size_t)(16 * qt + fr) * ldq + 32 * ks + 8 * fq);
    f32x4 oacc[4][2];
#pragma unroll
    for (int c = 0; c < 4; ++c) { oacc[c][0] = (f32x4){0.f, 0.f, 0.f, 0.f}; oacc[c][1] = (f32x4){0.f, 0.f, 0.f, 0.f}; }
    float mrun[2] = {-1.0e30f, -1.0e30f}, lsum[2] = {0.f, 0.f};
    v4u kreg[NKR], vreg;
    bf16x8 pf[2][2]; bool pvalid = false; int pvb = 0;
#pragma unroll
    for (int a = 0; a < 2; ++a)
#pragma unroll
        for (int b2 = 0; b2 < 2; ++b2)
#pragma unroll
            for (int e = 0; e < 8; ++e) pf[a][b2][e] = 0;
#define FA_LOAD(j) do { const int _rb = (j) < 4 ? krow_ctx0 + 64 * (j) : krow_lat0 + 64 * ((j) - 4); \
        _Pragma("unroll") for (int _i = 0; _i < NKR; ++_i) { const int _c = tid + 512 * _i; if (_c < NKC) kreg[_i] = *(const v4u*)(Kg + (size_t)(_rb + _c / CPR) * ldk + (_c % CPR) * 8); } \
        vreg = *(const v4u*)(Vg + (size_t)(_rb + (tid >> 3)) * ldv + (tid & 7) * 8); } while (0)
#define FA_STORE(kb, vb) do { _Pragma("unroll") for (int _i = 0; _i < NKR; ++_i) { const int _c = tid + 512 * _i; if (_c < NKC) *(LAS v4u*)(Kl + (kb) * KBUF + (_c / CPR) * KSTR + (_c % CPR) * 16) = kreg[_i]; } \
        *(LAS v4u*)(Vl + (vb) * VBUF + (tid >> 3) * VSTR + (tid & 7) * 16) = vreg; } while (0)
#define FA_PV(vbuf) do { _Pragma("unroll") for (int ks2 = 0; ks2 < 2; ++ks2) _Pragma("unroll") for (int c = 0; c < 4; ++c) { \
            const LAS unsigned char* vb_ = Vl + (vbuf) * VBUF + (32 * ks2 + 4 * fq + ((lane & 15) >> 2)) * VSTR + (16 * c + 4 * (lane & 3)) * 2; \
            const s16x4 v0 = __builtin_amdgcn_ds_read_tr16_b64_v4i16((LAS s16x4*)vb_); const s16x4 v1 = __builtin_amdgcn_ds_read_tr16_b64_v4i16((LAS s16x4*)(vb_ + 16 * VSTR)); \
            bf16x8 vf; vf[0] = v0[0]; vf[1] = v0[1]; vf[2] = v0[2]; vf[3] = v0[3]; vf[4] = v1[0]; vf[5] = v1[1]; vf[6] = v1[2]; vf[7] = v1[3]; \
            oacc[c][0] = __builtin_amdgcn_mfma_f32_16x16x32_bf16(vf, pf[0][ks2], oacc[c][0], 0, 0, 0); \
            oacc[c][1] = __builtin_amdgcn_mfma_f32_16x16x32_bf16(vf, pf[1][ks2], oacc[c][1], 0, 0, 0); } } while (0)
    FA_LOAD(0); FA_STORE(0, 0); __syncthreads();
    int vcur = 0;
    for (int j = 0; j < ntiles; ++j) {
        const int kb = j & 1;
        if (j + 1 < ntiles) FA_LOAD(j + 1);
        if (grpB && pvalid) { __builtin_amdgcn_s_setprio(1); FA_PV(pvb); __builtin_amdgcn_s_setprio(0); }
        bool skip = false; const int kp = kpos0 + 64 * (j - 4);
        if (WIN && j >= 4) skip = (kp + 63 < qpos_wave - 128) || (kp > qpos_wave + 31 + 128);
        pvalid = !skip; pvb = vcur;
        if (!skip) {
            f32x4 sacc[4][2];
#pragma unroll
            for (int kt = 0; kt < 4; ++kt) { sacc[kt][0] = (f32x4){0.f, 0.f, 0.f, 0.f}; sacc[kt][1] = (f32x4){0.f, 0.f, 0.f, 0.f}; }
            __builtin_amdgcn_s_setprio(1);
#pragma unroll
            for (int ks = 0; ks < NKS; ++ks) { bf16x8 kf[4];
#pragma unroll
                for (int kt = 0; kt < 4; ++kt) kf[kt] = *(const LAS bf16x8*)(Kl + kb * KBUF + (16 * kt + fr) * KSTR + (32 * ks + 8 * fq) * 2);
#pragma unroll
                for (int kt = 0; kt < 4; ++kt) { sacc[kt][0] = __builtin_amdgcn_mfma_f32_16x16x32_bf16(kf[kt], qf[0][ks], sacc[kt][0], 0, 0, 0);
                                                 sacc[kt][1] = __builtin_amdgcn_mfma_f32_16x16x32_bf16(kf[kt], qf[1][ks], sacc[kt][1], 0, 0, 0); } }
            __builtin_amdgcn_s_setprio(0);
            if (WIN && j >= 4) {
#pragma unroll
                for (int kt = 0; kt < 4; ++kt)
#pragma unroll
                    for (int qt = 0; qt < 2; ++qt)
#pragma unroll
                        for (int jj = 0; jj < 4; ++jj) { const int d = (kp + 16 * kt + 4 * fq + jj) - (qpos_wave + 16 * qt + fr); if (d < -128 || d > 128) sacc[kt][qt][jj] = -1.0e30f; } }
#pragma unroll
            for (int qt = 0; qt < 2; ++qt) {
                float mx = sacc[0][qt][0];
#pragma unroll
                for (int kt = 0; kt < 4; ++kt)
#pragma unroll
                    for (int jj = 0; jj < 4; ++jj) mx = fmaxf(mx, sacc[kt][qt][jj]);
                mx = fmaxf(mx, __shfl_xor(mx, 16)); mx = fmaxf(mx, xor32(mx));
                float mnew = mrun[qt];
                if (__builtin_amdgcn_ballot_w64(mx > mrun[qt] + 11.5f) != 0ull) {
                    mnew = fmaxf(mrun[qt], mx); const float alpha = fast_exp2(mrun[qt] - mnew); lsum[qt] *= alpha;
#pragma unroll
                    for (int c = 0; c < 4; ++c) oacc[c][qt] = oacc[c][qt] * alpha; }
                mrun[qt] = mnew;
                float ps = 0.f;
#pragma unroll
                for (int kt = 0; kt < 4; ++kt)
#pragma unroll
                    for (int jj = 0; jj < 4; ++jj) { const float p = fast_exp2(sacc[kt][qt][jj] - mnew); sacc[kt][qt][jj] = p; ps += p; }
                lsum[qt] += ps;
#pragma unroll
                for (int ks2 = 0; ks2 < 2; ++ks2) { const v4u w = pack8(sacc[2 * ks2][qt], sacc[2 * ks2 + 1][qt]); pf[qt][ks2] = __builtin_bit_cast(bf16x8, w); }
            }
            if (!grpB) { __builtin_amdgcn_s_setprio(1); FA_PV(vcur); __builtin_amdgcn_s_setprio(0); }
        }
        const int vnext = vcur == 2 ? 0 : vcur + 1;
        if (j + 1 < ntiles) FA_STORE(kb ^ 1, vnext);
        vcur = vnext;
        __syncthreads();
    }
    if (grpB && pvalid) FA_PV(pvb);
    __syncthreads();
#pragma unroll
    for (int qt = 0; qt < 2; ++qt) { float l = lsum[qt]; l += __shfl_xor(l, 16); l += xor32(l); if (has_sink) l += fast_exp2(sink2 - mrun[qt]);
        const float inv = 1.0f / l;
#pragma unroll
        for (int c = 0; c < 4; ++c) { const f32x4 o = oacc[c][qt] * inv; v2u w; w.x = cvt_pk_bf16(o[0], o[1]); w.y = cvt_pk_bf16(o[2], o[3]);
            *(v2u*)(Og + (size_t)(16 * qt + fr) * ldo + 16 * c + 4 * fq) = w; } }
#undef FA_LOAD
#undef FA_STORE
#undef FA_PV
}

template <int DQK>
__device__ __forceinline__ void flash_unit2(LAS unsigned char* lds, const int tid, const int lane, const int grpB,
        const bf16* Kg, const int ldk, const bf16* Vg, const int ldv,
        const bf16* Qg, const int ldq, bf16* Og, const int ldo,
        const int ntiles, const int krow_ctx0, const int krow_lat0, const int kpos0, const int qpos_wave, const float sink2, const bool has_sink) {
    constexpr bool WIN = false; constexpr int KSTR = DQK * 2 + 16, VSTR = 160, KBUF = 128 * KSTR, VBUF = 128 * VSTR, CPR = DQK / 8, NKC = 128 * CPR, NKR = (NKC + 511) / 512, NKS = DQK / 32;
    LAS unsigned char* Kl = lds; LAS unsigned char* Vl = lds + 2 * KBUF;
    const int fr = lane & 15, fq = lane >> 4;
    bf16x8 qf[2][NKS];
#pragma unroll
    for (int qt = 0; qt < 2; ++qt)
#pragma unroll
        for (int ks = 0; ks < NKS; ++ks) qf[qt][ks] = *(const bf16x8*)(Qg + (size_t)(16 * qt + fr) * ldq + 32 * ks + 8 * fq);
    f32x4 oacc[4][2];
#pragma unroll
    for (int c = 0; c < 4; ++c) { oacc[c][0] = (f32x4){0.f, 0.f, 0.f, 0.f}; oacc[c][1] = (f32x4){0.f, 0.f, 0.f, 0.f}; }
    float mrun[2] = {-1.0e30f, -1.0e30f}, lsum[2] = {0.f, 0.f};
    v4u kreg[NKR], vreg[2];
    bf16x8 pf[2][2]; bool pvalid = false; int pvb = 0;
#pragma unroll
    for (int a = 0; a < 2; ++a)
#pragma unroll
        for (int b2 = 0; b2 < 2; ++b2)
#pragma unroll
            for (int e = 0; e < 8; ++e) pf[a][b2][e] = 0;
#define FA_LOAD(p) do { const int _rb = krow_ctx0 + 128 * (p); \
        _Pragma("unroll") for (int _i = 0; _i < NKR; ++_i) { const int _c = tid + 512 * _i; if (_c < NKC) kreg[_i] = *(const v4u*)(Kg + (size_t)(_rb + _c / CPR) * ldk + (_c % CPR) * 8); } \
        _Pragma("unroll") for (int _i = 0; _i < 2; ++_i) { const int _c = tid + 512 * _i; vreg[_i] = *(const v4u*)(Vg + (size_t)(_rb + (_c >> 3)) * ldv + (_c & 7) * 8); } } while (0)
#define FA_STORE(kb, vb) do { _Pragma("unroll") for (int _i = 0; _i < NKR; ++_i) { const int _c = tid + 512 * _i; if (_c < NKC) *(LAS v4u*)(Kl + (kb) * KBUF + (_c / CPR) * KSTR + (_c % CPR) * 16) = kreg[_i]; } \
        _Pragma("unroll") for (int _i = 0; _i < 2; ++_i) { const int _c = tid + 512 * _i; *(LAS v4u*)(Vl + (vb) * VBUF + (_c >> 3) * VSTR + (_c & 7) * 16) = vreg[_i]; } } while (0)
#define FA_PV(vbuf) do { _Pragma("unroll") for (int ks2 = 0; ks2 < 2; ++ks2) _Pragma("unroll") for (int c = 0; c < 4; ++c) { \
            const LAS unsigned char* vb_ = Vl + (vbuf) + (32 * ks2 + 4 * fq + ((lane & 15) >> 2)) * VSTR + (16 * c + 4 * (lane & 3)) * 2; \
            const s16x4 v0 = __builtin_amdgcn_ds_read_tr16_b64_v4i16((LAS s16x4*)vb_); const s16x4 v1 = __builtin_amdgcn_ds_read_tr16_b64_v4i16((LAS s16x4*)(vb_ + 16 * VSTR)); \
            bf16x8 vf; vf[0] = v0[0]; vf[1] = v0[1]; vf[2] = v0[2]; vf[3] = v0[3]; vf[4] = v1[0]; vf[5] = v1[1]; vf[6] = v1[2]; vf[7] = v1[3]; \
            oacc[c][0] = __builtin_amdgcn_mfma_f32_16x16x32_bf16(vf, pf[0][ks2], oacc[c][0], 0, 0, 0); \
            oacc[c][1] = __builtin_amdgcn_mfma_f32_16x16x32_bf16(vf, pf[1][ks2], oacc[c][1], 0, 0, 0); } } while (0)
    FA_LOAD(0); FA_STORE(0, 0); __syncthreads();
    int vcur = 0;
    const int npairs = ntiles >> 1;
    for (int p = 0; p < npairs; ++p) {
        const int kb = p & 1;
        if (p + 1 < npairs) FA_LOAD(p + 1);
#pragma unroll
      for (int sub = 0; sub < 2; ++sub) { const int j = 2 * p + sub; const int koff = kb * KBUF + sub * 64 * KSTR; const int voff = vcur * VBUF + sub * 64 * VSTR;
        if (grpB && pvalid) { __builtin_amdgcn_s_setprio(1); FA_PV(pvb); __builtin_amdgcn_s_setprio(0); }
        bool skip = false; const int kp = kpos0 + 64 * (j - 4);
        if (WIN && j >= 4) skip = (kp + 63 < qpos_wave - 128) || (kp > qpos_wave + 31 + 128);
        pvalid = !skip; pvb = voff;
        if (!skip) {
            f32x4 sacc[4][2];
#pragma unroll
            for (int kt = 0; kt < 4; ++kt) { sacc[kt][0] = (f32x4){0.f, 0.f, 0.f, 0.f}; sacc[kt][1] = (f32x4){0.f, 0.f, 0.f, 0.f}; }
            __builtin_amdgcn_s_setprio(1);
#pragma unroll
            for (int ks = 0; ks < NKS; ++ks) { bf16x8 kf[4];
#pragma unroll
                for (int kt = 0; kt < 4; ++kt) kf[kt] = *(const LAS bf16x8*)(Kl + koff + (16 * kt + fr) * KSTR + (32 * ks + 8 * fq) * 2);
#pragma unroll
                for (int kt = 0; kt < 4; ++kt) { sacc[kt][0] = __builtin_amdgcn_mfma_f32_16x16x32_bf16(kf[kt], qf[0][ks], sacc[kt][0], 0, 0, 0);
                                                 sacc[kt][1] = __builtin_amdgcn_mfma_f32_16x16x32_bf16(kf[kt], qf[1][ks], sacc[kt][1], 0, 0, 0); } }
            __builtin_amdgcn_s_setprio(0);
            if (WIN && j >= 4) {
#pragma unroll
                for (int kt = 0; kt < 4; ++kt)
#pragma unroll
                    for (int qt = 0; qt < 2; ++qt)
#pragma unroll
                        for (int jj = 0; jj < 4; ++jj) { const int d = (kp + 16 * kt + 4 * fq + jj) - (qpos_wave + 16 * qt + fr); if (d < -128 || d > 128) sacc[kt][qt][jj] = -1.0e30f; } }
#pragma unroll
            for (int qt = 0; qt < 2; ++qt) {
                float mx = sacc[0][qt][0];
#pragma unroll
                for (int kt = 0; kt < 4; ++kt)
#pragma unroll
                    for (int jj = 0; jj < 4; ++jj) mx = fmaxf(mx, sacc[kt][qt][jj]);
                mx = fmaxf(mx, __shfl_xor(mx, 16)); mx = fmaxf(mx, xor32(mx));
                float mnew = mrun[qt];
                if (__builtin_amdgcn_ballot_w64(mx > mrun[qt] + 11.5f) != 0ull) {
                    mnew = fmaxf(mrun[qt], mx); const float alpha = fast_exp2(mrun[qt] - mnew); lsum[qt] *= alpha;
#pragma unroll
                    for (int c = 0; c < 4; ++c) oacc[c][qt] = oacc[c][qt] * alpha; }
                mrun[qt] = mnew;
                float ps = 0.f;
#pragma unroll
                for (int kt = 0; kt < 4; ++kt)
#pragma unroll
                    for (int jj = 0; jj < 4; ++jj) { const float p = fast_exp2(sacc[kt][qt][jj] - mnew); sacc[kt][qt][jj] = p; ps += p; }
                lsum[qt] += ps;
#pragma unroll
                for (int ks2 = 0; ks2 < 2; ++ks2) { const v4u w = pack8(sacc[2 * ks2][qt], sacc[2 * ks2 + 1][qt]); pf[qt][ks2] = __builtin_bit_cast(bf16x8, w); }
            }
            if (!grpB) { __builtin_amdgcn_s_setprio(1); FA_PV(voff); __builtin_amdgcn_s_setprio(0); }
        }
      }
        const int vnext = vcur == 2 ? 0 : vcur + 1;
        if (p + 1 < npairs) FA_STORE(kb ^ 1, vnext);
        vcur = vnext;
        __syncthreads();
    }
    if (grpB && pvalid) FA_PV(pvb);
    __syncthreads();
#pragma unroll
    for (int qt = 0; qt < 2; ++qt) { float l = lsum[qt]; l += __shfl_xor(l, 16); l += xor32(l); if (has_sink) l += fast_exp2(sink2 - mrun[qt]);
        const float inv = 1.0f / l;
#pragma unroll
        for (int c = 0; c < 4; ++c) { const f32x4 o = oacc[c][qt] * inv; v2u w; w.x = cvt_pk_bf16(o[0], o[1]); w.y = cvt_pk_bf16(o[2], o[3]);
            *(v2u*)(Og + (size_t)(16 * qt + fr) * ldo + 16 * c + 4 * fq) = w; } }
#undef FA_LOAD
#undef FA_STORE
#undef FA_PV
}

typedef float f32x16 __attribute__((ext_vector_type(16)));
template <int DQK>
__device__ __forceinline__ void flash_unit4(LAS unsigned char* lds, const int tid, const int lane,
        const bf16* Kg, const int ldk, const bf16* Vg, const int ldv, const bf16* Qg, const int ldq, bf16* Og, const int ldo, const int npairs, const int krow0) {
    constexpr int KSTR = DQK * 2 + 16, VSTR = 160, KBUF = 128 * KSTR, VBUF = 128 * VSTR, CPR = DQK / 8, NKC = 128 * CPR, NKR = (NKC + 511) / 512, NKS = DQK / 16;
    LAS unsigned char* Kl = lds; LAS unsigned char* Vl = lds + 2 * KBUF;
    const int r5 = lane & 31, h = lane >> 5;
    bf16x8 qf[NKS];
#pragma unroll
    for (int ks = 0; ks < NKS; ++ks) qf[ks] = *(const bf16x8*)(Qg + (size_t)r5 * ldq + 16 * ks + 8 * h);
    f32x16 oacc[2];
#pragma unroll
    for (int dt = 0; dt < 2; ++dt)
#pragma unroll
        for (int e = 0; e < 16; ++e) oacc[dt][e] = 0.f;
    float mrun = -1.0e30f, lsum = 0.f;
    v4u kreg[NKR], vreg[2];
    unsigned kgo[NKR], vgo[2];
#pragma unroll
    for (int i = 0; i < NKR; ++i) { const int c = tid + 512 * i; kgo[i] = (unsigned)(((c / CPR) * ldk + (c % CPR) * 8) * 2); }
#pragma unroll
    for (int i = 0; i < 2; ++i) { const int c = tid + 512 * i; vgo[i] = (unsigned)(((c >> 3) * ldv + (c & 7) * 8) * 2); }
#define F4_LOAD(p) do { const char* _kb = (const char*)Kg + (size_t)(krow0 + 128 * (p)) * ldk * 2; const char* _vb = (const char*)Vg + (size_t)(krow0 + 128 * (p)) * ldv * 2; \
        _Pragma("unroll") for (int _i = 0; _i < NKR; ++_i) { if (tid + 512 * _i < NKC) kreg[_i] = *(const v4u*)(_kb + kgo[_i]); } \
        _Pragma("unroll") for (int _i = 0; _i < 2; ++_i) vreg[_i] = *(const v4u*)(_vb + vgo[_i]); } while (0)
#define F4_STORE(b) do { _Pragma("unroll") for (int _i = 0; _i < NKR; ++_i) { const int _c = tid + 512 * _i; if (_c < NKC) *(LAS v4u*)(Kl + (b) * KBUF + (_c / CPR) * KSTR + (_c % CPR) * 16) = kreg[_i]; } \
        _Pragma("unroll") for (int _i = 0; _i < 2; ++_i) { const int _c = tid + 512 * _i; *(LAS v4u*)(Vl + (b) * VBUF + (_c >> 3) * VSTR + (_c & 7) * 16) = vreg[_i]; } } while (0)
    F4_LOAD(0); F4_STORE(0); __syncthreads();
    const int vlane = (4 * h + ((lane & 15) >> 2)) * VSTR + (16 * ((lane >> 4) & 1) + 4 * (lane & 3)) * 2;
    for (int p = 0; p < npairs; ++p) { const int bb = p & 1;
        if (p + 1 < npairs) F4_LOAD(p + 1);
#pragma unroll
        for (int sub = 0; sub < 2; ++sub) { const LAS unsigned char* Kt = Kl + bb * KBUF + sub * 64 * KSTR; const LAS unsigned char* Vt = Vl + bb * VBUF + sub * 64 * VSTR;
            bf16x8 kfr[NKS][2];
#pragma unroll
            for (int ks = 0; ks < NKS; ++ks)
#pragma unroll
                for (int kt = 0; kt < 2; ++kt) kfr[ks][kt] = *(const LAS bf16x8*)(Kt + (32 * kt + r5) * KSTR + (16 * ks + 8 * h) * 2);
            f32x16 sacc[2];
#pragma unroll
            for (int kt = 0; kt < 2; ++kt)
#pragma unroll
                for (int e = 0; e < 16; ++e) sacc[kt][e] = 0.f;
            __builtin_amdgcn_s_setprio(1);
#pragma unroll
            for (int ks = 0; ks < NKS; ++ks)
#pragma unroll
                for (int kt = 0; kt < 2; ++kt) sacc[kt] = __builtin_amdgcn_mfma_f32_32x32x16_bf16(kfr[ks][kt], qf[ks], sacc[kt], 0, 0, 0);
            __builtin_amdgcn_s_setprio(0);
            float mx = sacc[0][0];
#pragma unroll
            for (int kt = 0; kt < 2; ++kt)
#pragma unroll
                for (int e = 0; e < 16; ++e) mx = fmaxf(mx, sacc[kt][e]);
            mx = fmaxf(mx, xor32(mx));
            if (__builtin_amdgcn_ballot_w64(mx > mrun + 11.5f) != 0ull) { const float mnew = fmaxf(mrun, mx), alpha = fast_exp2(mrun - mnew); lsum *= alpha; mrun = mnew;
#pragma unroll
                for (int dt = 0; dt < 2; ++dt) oacc[dt] = oacc[dt] * alpha; }
            float ps = 0.f;
#pragma unroll
            for (int kt = 0; kt < 2; ++kt)
#pragma unroll
                for (int e = 0; e < 16; ++e) { const float pv = fast_exp2(sacc[kt][e] - mrun); sacc[kt][e] = pv; ps += pv; }
            lsum += ps;
            bf16x8 vfr[2][2][2];
#pragma unroll
            for (int kt = 0; kt < 2; ++kt)
#pragma unroll
                for (int s = 0; s < 2; ++s)
#pragma unroll
                    for (int dt = 0; dt < 2; ++dt) { const LAS unsigned char* vb = Vt + (32 * kt + 16 * s) * VSTR + vlane + 64 * dt;
                        const s16x4 v0 = __builtin_amdgcn_ds_read_tr16_b64_v4i16((LAS s16x4*)vb), v1 = __builtin_amdgcn_ds_read_tr16_b64_v4i16((LAS s16x4*)(vb + 8 * VSTR));
                        bf16x8 vf; vf[0] = v0[0]; vf[1] = v0[1]; vf[2] = v0[2]; vf[3] = v0[3]; vf[4] = v1[0]; vf[5] = v1[1]; vf[6] = v1[2]; vf[7] = v1[3]; vfr[kt][s][dt] = vf; }
            v4u pw[2][2];
#pragma unroll
            for (int kt = 0; kt < 2; ++kt)
#pragma unroll
                for (int s = 0; s < 2; ++s) { pw[kt][s].x = cvt_pk_bf16(sacc[kt][8 * s + 0], sacc[kt][8 * s + 1]); pw[kt][s].y = cvt_pk_bf16(sacc[kt][8 * s + 2], sacc[kt][8 * s + 3]);
                    pw[kt][s].z = cvt_pk_bf16(sacc[kt][8 * s + 4], sacc[kt][8 * s + 5]); pw[kt][s].w = cvt_pk_bf16(sacc[kt][8 * s + 6], sacc[kt][8 * s + 7]); }
            __builtin_amdgcn_s_setprio(1);
#pragma unroll
            for (int kt = 0; kt < 2; ++kt)
#pragma unroll
                for (int s = 0; s < 2; ++s)
#pragma unroll
                    for (int dt = 0; dt < 2; ++dt) oacc[dt] = __builtin_amdgcn_mfma_f32_32x32x16_bf16(vfr[kt][s][dt], __builtin_bit_cast(bf16x8, pw[kt][s]), oacc[dt], 0, 0, 0);
            __builtin_amdgcn_s_setprio(0);
        }
        if (p + 1 < npairs) F4_STORE(bb ^ 1);
        __syncthreads();
    }
    { float l = lsum; l += xor32(l); const float inv = 1.0f / l;
#pragma unroll
      for (int dt = 0; dt < 2; ++dt)
#pragma unroll
          for (int g4 = 0; g4 < 4; ++g4) { v2u w; w.x = cvt_pk_bf16(oacc[dt][4 * g4 + 0] * inv, oacc[dt][4 * g4 + 1] * inv); w.y = cvt_pk_bf16(oacc[dt][4 * g4 + 2] * inv, oacc[dt][4 * g4 + 3] * inv);
              *(v2u*)(Og + (size_t)r5 * ldo + 32 * dt + 8 * g4 + 4 * h) = w; } }
#undef F4_LOAD
#undef F4_STORE
}

__device__ __forceinline__ void phase_attn_window(Frame& F, const float* const* in, bf16* Q, const bf16* Kb, const bf16* Vb, bf16* Oalt = nullptr) {
    constexpr int NLAT = NB * 4 * 64, NCTX = NB * 4 * 4;
    for (int un = F.vcu; un < NLAT + NCTX; un += GRID) {
        int b, kvh, q0, ntiles, kpos0, qrow0;
        if (un < NLAT) { b = un >> 8; kvh = (un >> 6) & 3; q0 = (un & 63) * 64; kpos0 = q0 >= 128 ? q0 - 128 : 0; const int kend = q0 + 192 <= SEQ ? q0 + 192 : SEQ; ntiles = 4 + (kend - kpos0) / 64; qrow0 = b * TPB + CTX + q0; }
        else { const int v = un - NLAT; b = v >> 4; kvh = (v >> 2) & 3; q0 = (v & 3) * 64; kpos0 = 0; ntiles = 4; qrow0 = b * TPB + q0; }
        const int g = F.wave >> 1, half = F.wave & 1, head = kvh * 4 + g;
        bf16* qp = Q + (size_t)(qrow0 + 32 * half) * 1024 + head * 64;
        bf16* op = Oalt ? Oalt + (size_t)(qrow0 + 32 * half) * 1024 + head * 64 : qp;
        flash_unit<64, true>(F.lds, F.tid, F.lane, F.wave >> 2, Kb + kvh * 64, 256, Vb + kvh * 64, 256, qp, 1024, op, 1024,
                             ntiles, b * TPB, b * TPB + CTX + kpos0, kpos0, q0 + 32 * half, in[16][head] * LOG2E, true);
    }
}
__device__ __forceinline__ void phase_attn_mla(Frame& F, const bf16* Q3, const bf16* KF, const bf16* V3, bf16* O) {
    for (int un = F.vcu; un < NB * 16 * 16; un += GRID) { const int b = un >> 8, head = (un >> 4) & 15, qb = un & 15; const int qrow = b * TPB + CTX + qb * 256 + 32 * F.wave;
        flash_unit4<96>(F.lds, F.tid, F.lane, KF + head * 96, 1536, V3 + head * 64, 1024, Q3 + (size_t)qrow * 1536 + head * 96, 1536, O + (size_t)qrow * 1024 + head * 64, 1024, 34, b * TPB);
    }
}
#ifndef SSD_PF
#define SSD_PF 2
#endif
#ifndef ML_PF
#define ML_PF 2
#endif
__device__ __forceinline__ int scan_row(int dir, int tau) { return dir == 0 ? tau : (tau < CTX ? CTX - 1 - tau : (TPB + CTX - 1) - tau); }

__device__ __forceinline__ void phase_ssm_conv(Frame& F, const float* const* in, int gp, const bf16* XP, bf16* XS, bf16* BC, const float* DT, float* ACUM) {
    constexpr int RPW = M / GRID;
    if (F.tid < 384) {
    const int cg = F.tid % 192, rsub = F.tid / 192, c0 = cg * 8;
    const int oc = c0 < 1024 ? gp * 1024 + c0 : (c0 < 1280 ? 2048 + gp * 256 + (c0 - 1024) : 2560 + gp * 256 + (c0 - 1280));
    float w[5][8], bb[8];
#pragma unroll
    for (int k = 0; k < 5; ++k)
#pragma unroll
        for (int i = 0; i < 8; ++i) w[k][i] = in[19][k * 3072 + oc + i];
#pragma unroll
    for (int i = 0; i < 8; ++i) bb[i] = in[20][oc + i];
    const int rbeg = blockIdx.x * RPW + rsub * (RPW / 2), rend = rbeg + RPW / 2;
    for (int g0 = rbeg; g0 < rend; g0 += 8) {
        v4u xin[12];
#pragma unroll
        for (int j = 0; j < 12; ++j) { const int rr = g0 - 2 + j; xin[j] = (rr >= 0 && rr < M) ? *(const v4u*)(XP + (size_t)rr * 1536 + c0) : (v4u){0u, 0u, 0u, 0u}; }
#pragma unroll
        for (int i = 0; i < 8; ++i) { const int r = g0 + i; if (r < rend) { const int t = r % TPB; const int lo = t < CTX ? 0 : CTX, hi = t < CTX ? CTX : TPB;
            float a[8];
#pragma unroll
            for (int q = 0; q < 8; ++q) a[q] = bb[q];
#pragma unroll
            for (int k = 0; k < 5; ++k) { const int tt = t + k - 2; if (tt >= lo && tt < hi) { const v4u x = xin[i + k];
                    a[0] += w[k][0] * bflo(x.x); a[1] += w[k][1] * bfhi(x.x); a[2] += w[k][2] * bflo(x.y); a[3] += w[k][3] * bfhi(x.y);
                    a[4] += w[k][4] * bflo(x.z); a[5] += w[k][5] * bfhi(x.z); a[6] += w[k][6] * bflo(x.w); a[7] += w[k][7] * bfhi(x.w); } }
            v4u o; o.x = cvt_pk_bf16(silu_f(a[0]), silu_f(a[1])); o.y = cvt_pk_bf16(silu_f(a[2]), silu_f(a[3])); o.z = cvt_pk_bf16(silu_f(a[4]), silu_f(a[5])); o.w = cvt_pk_bf16(silu_f(a[6]), silu_f(a[7]));
            if (c0 < 1024) *(v4u*)(XS + (size_t)r * 1024 + c0) = o; else *(v4u*)(BC + (size_t)r * 512 + (c0 - 1024)) = o; } } }
    } else {
        const int chain = blockIdx.x * 128 + (F.tid - 384);
        if (chain < NB * 2 * 16 * 68) { const int ck = chain % 68, hl = (chain / 68) & 15, dir = (chain / (68 * 16)) & 1, b = chain / (68 * 32);
            const float Ah = -fast_exp(in[22][dir * 32 + gp * 16 + hl]) * LOG2E; float acc = 0.f;
#pragma unroll 1
            for (int h2 = 0; h2 < 2; ++h2) { float dv[32];
#pragma unroll
                for (int s = 0; s < 32; ++s) dv[s] = DT[(size_t)(b * TPB + scan_row(dir, ck * 64 + h2 * 32 + s)) * 32 + dir * 16 + hl];
#pragma unroll
                for (int s = 0; s < 32; ++s) { acc += dv[s] * Ah; ACUM[(size_t)(b * TPB + scan_row(dir, ck * 64 + h2 * 32 + s)) * 32 + dir * 16 + hl] = acc; } } }
    }
}

__device__ __forceinline__ void phase_ssm_scan(Frame& F, const float* const* in, int gp, const bf16* XS, const bf16* BC, const float* DT, const bf16* Z, bf16* Y) {
    constexpr int T = 32;
    LAS float* Bf = (LAS float*)F.lds;
    LAS float* Cf = (LAS float*)(F.lds + 16384);
    LAS float* U = (LAS float*)(F.lds + 32768);
    LAS float* XT = (LAS float*)(F.lds + 40960);
    LAS float* DEC = (LAS float*)(F.lds + 49152);
    LAS float* PART = (LAS float*)(F.lds + 49152 + 256);
    const int it = blockIdx.x, b = it >> 5, hl = (it >> 1) & 15, ph = it & 1, head = gp * 16 + hl, gl = hl >> 3;
    const int col = hl * 64 + ph * 32;
    const int p = F.tid & 31, ns = F.tid >> 5;
    const float dskip = in[23][head] + in[23][32 + head];
    const int st = F.tid >> 4, sch = F.tid & 15;
    const int xt = F.tid >> 2, xch = F.tid & 3;
    for (int dir = 0; dir < 2; ++dir) {
        const float Ah = -fast_exp(in[22][dir * 32 + head]) * LOG2E;
        float S[8];
#pragma unroll
        for (int i = 0; i < 8; ++i) S[i] = 0.f;
        v4u rb, rc, rx; float rdt = 0.f;
#define SS_LOAD(tile) do { const int _rB = b * TPB + scan_row(dir, (tile) * T + st); rb = *(const v4u*)(BC + (size_t)_rB * 512 + gl * 128 + sch * 8); rc = *(const v4u*)(BC + (size_t)_rB * 512 + 256 + gl * 128 + sch * 8); \
            if (F.tid < 128) { const int _rX = b * TPB + scan_row(dir, (tile) * T + xt); rx = *(const v4u*)(XS + (size_t)_rX * 1024 + col + xch * 8); rdt = DT[(size_t)_rX * 32 + dir * 16 + hl]; } } while (0)
#define SS_STORE(nb) do { LAS float* _b = Bf + st * 128 + sch * 8; LAS float* _c = Cf + st * 128 + sch * 8; \
            *(LAS f32x4*)_b = (f32x4){bflo(rb.x), bfhi(rb.x), bflo(rb.y), bfhi(rb.y)}; *(LAS f32x4*)(_b + 4) = (f32x4){bflo(rb.z), bfhi(rb.z), bflo(rb.w), bfhi(rb.w)}; \
            *(LAS f32x4*)_c = (f32x4){bflo(rc.x), bfhi(rc.x), bflo(rc.y), bfhi(rc.y)}; *(LAS f32x4*)(_c + 4) = (f32x4){bflo(rc.z), bfhi(rc.z), bflo(rc.w), bfhi(rc.w)}; \
            if (F.tid < 128) { const f32x4 x0 = (f32x4){bflo(rx.x), bfhi(rx.x), bflo(rx.y), bfhi(rx.y)}, x1 = (f32x4){bflo(rx.z), bfhi(rx.z), bflo(rx.w), bfhi(rx.w)}; \
                LAS float* _x = XT + (nb) * 1024 + xt * 32 + xch * 8; LAS float* _u = U + (nb) * 1024 + xt * 32 + xch * 8; \
                *(LAS f32x4*)_x = x0; *(LAS f32x4*)(_x + 4) = x1; *(LAS f32x4*)_u = x0 * rdt; *(LAS f32x4*)(_u + 4) = x1 * rdt; \
                if (xch == 0) DEC[(nb) * 32 + xt] = fast_exp2(rdt * Ah); } } while (0)
        __syncthreads();
        SS_LOAD(0); SS_STORE(0); __syncthreads();
        constexpr int NT = TPB / T;
        for (int tile = 0; tile < NT; ++tile) { const int cb = tile & 1;
            if (tile + 1 < NT) SS_LOAD(tile + 1);
            const LAS float* u_ = U + cb * 1024 + p; const LAS float* d_ = DEC + cb * 32;
#pragma unroll 4
            for (int t = 0; t < T; ++t) {
                const float dec = d_[t], u = u_[t * 32];
                const f32x4 b0 = *(const LAS f32x4*)(Bf + t * 128 + ns * 8), b1 = *(const LAS f32x4*)(Bf + t * 128 + ns * 8 + 4);
                const f32x4 c0 = *(const LAS f32x4*)(Cf + t * 128 + ns * 8), c1 = *(const LAS f32x4*)(Cf + t * 128 + ns * 8 + 4);
                float pt = 0.f;
#pragma unroll
                for (int i = 0; i < 4; ++i) { S[i] = S[i] * dec + b0[i] * u; pt += c0[i] * S[i]; S[4 + i] = S[4 + i] * dec + b1[i] * u; pt += c1[i] * S[4 + i]; }
                pt += __shfl_xor(pt, 32);
                if (F.lane < 32) PART[(F.wave * 32 + t) * 32 + p] = pt;
            }
            __syncthreads();
#pragma unroll
            for (int k = 0; k < 2; ++k) { const int t = (F.tid >> 5) + 16 * k; float y = 0.f;
#pragma unroll
                for (int w = 0; w < 8; ++w) y += PART[(w * 32 + t) * 32 + p];
                const size_t ro = (size_t)(b * TPB + scan_row(dir, tile * T + t));
                if (dir == 0) Y[ro * 1024 + col + p] = (bf16)f2bf(y);
                else { const float yt = y + bf2f(Y[ro * 1024 + col + p]) + dskip * XT[cb * 1024 + t * 32 + p]; const float zz = bf2f(Z[ro * 1024 + col + p]);
                    Y[ro * 1024 + col + p] = (bf16)f2bf(yt * silu_f(zz)); } }
            if (tile + 1 < NT) SS_STORE(cb ^ 1);
            __syncthreads();
        }
#undef SS_LOAD
#undef SS_STORE
    }
}
__device__ __forceinline__ void phase_ssm_gnorm(Frame& F, const float* const* in, int gp, bf16* Y) {
    const int gw = F.vcu * NWAVES + F.wave, NGW = GRID * NWAVES; const float* ng = in[24] + gp * 1024 + 16 * F.lane;
    for (int r = gw; r < M; r += NGW) { v4u* p = (v4u*)(Y + (size_t)r * 1024 + 16 * F.lane); const v4u a = p[0], c = p[1];
        float v[16] = {bflo(a.x), bfhi(a.x), bflo(a.y), bfhi(a.y), bflo(a.z), bfhi(a.z), bflo(a.w), bfhi(a.w), bflo(c.x), bfhi(c.x), bflo(c.y), bfhi(c.y), bflo(c.z), bfhi(c.z), bflo(c.w), bfhi(c.w)};
        float ss = 0.f;
#pragma unroll
        for (int i = 0; i < 16; ++i) ss += v[i] * v[i];
#pragma unroll
        for (int o = 1; o < 32; o <<= 1) ss += __shfl_xor(ss, o);
        const float rs = rsqrtf(ss * (1.f / 512.f) + EPS);
        v4u o0, o1;
        o0.x = cvt_pk_bf16(v[0] * rs * ng[0], v[1] * rs * ng[1]); o0.y = cvt_pk_bf16(v[2] * rs * ng[2], v[3] * rs * ng[3]); o0.z = cvt_pk_bf16(v[4] * rs * ng[4], v[5] * rs * ng[5]); o0.w = cvt_pk_bf16(v[6] * rs * ng[6], v[7] * rs * ng[7]);
        o1.x = cvt_pk_bf16(v[8] * rs * ng[8], v[9] * rs * ng[9]); o1.y = cvt_pk_bf16(v[10] * rs * ng[10], v[11] * rs * ng[11]); o1.z = cvt_pk_bf16(v[12] * rs * ng[12], v[13] * rs * ng[13]); o1.w = cvt_pk_bf16(v[14] * rs * ng[14], v[15] * rs * ng[15]);
        p[0] = o0; p[1] = o1; }
}


__device__ __forceinline__ void phase_ssm_scan_mfma(Frame& F, const float* const* in, int gp, const bf16* XS, const bf16* BC, const float* DT, const float* ACUM, bf16* Yf, bf16* Yb) {
    constexpr int BSTR = 272, XSTR = 160;
    LAS unsigned char* Bl = F.lds;
    LAS unsigned char* Cl = F.lds + 17408;
    LAS unsigned char* Xl = F.lds + 34816;
    LAS unsigned char* Xw = F.lds + 45056;
    LAS float* AC = (LAS float*)(F.lds + 55296);
    LAS float* DTs = (LAS float*)(F.lds + 55296 + 256);
    LAS unsigned char* Sb = F.lds + 55808;
    const int it = F.vcu, b = it >> 5, dir = (it >> 4) & 1, hl = it & 15, gl = hl >> 3;
    bf16* Y = dir == 0 ? Yf : Yb;
    const float dsk = in[23][dir * 32 + gp * 16 + hl];
    const int tid = F.tid, lane = F.lane, w = F.wave, fr = lane & 15, fq = lane >> 4, lq = (lane & 15) >> 2, lp = lane & 3;
    const int ph = w >> 2, lt = ph ? 3 - (w & 3) : (w & 3);
    for (int i = tid; i < 64 * BSTR / 16; i += NTHR) *(LAS v4u*)(Sb + i * 16) = (v4u){0u, 0u, 0u, 0u};
    f32x4 sacc[4];
#pragma unroll
    for (int i = 0; i < 4; ++i) sacc[i] = (f32x4){0.f, 0.f, 0.f, 0.f};
    constexpr int PF = SSD_PF;
    v4u rB[PF][2], rC[PF][2], rX[PF]; float rac[PF], ral[PF], rdt[PF];
    const int xr = tid >> 3, xc = tid & 7;
#define SM_LOAD(S, ckv) do { const int _ck = (ckv) < 68 ? (ckv) : 67; \
        _Pragma("unroll") for (int _i = 0; _i < 2; ++_i) { const int _c = tid + 512 * _i; const size_t _r = (size_t)(b * TPB + scan_row(dir, _ck * 64 + (_c >> 4))); \
            rB[S][_i] = *(const v4u*)(BC + _r * 512 + gl * 128 + (_c & 15) * 8); rC[S][_i] = *(const v4u*)(BC + _r * 512 + 256 + gl * 128 + (_c & 15) * 8); } \
        { const size_t _r = (size_t)(b * TPB + scan_row(dir, _ck * 64 + xr)); const size_t _rl = (size_t)(b * TPB + scan_row(dir, _ck * 64 + 63)); rX[S] = *(const v4u*)(XS + _r * 1024 + hl * 64 + xc * 8); \
          rac[S] = ACUM[_r * 32 + dir * 16 + hl]; ral[S] = ACUM[_rl * 32 + dir * 16 + hl]; rdt[S] = DT[_r * 32 + dir * 16 + hl]; } } while (0)
#define SM_STORE(S) do { _Pragma("unroll") for (int _i = 0; _i < 2; ++_i) { const int _c = tid + 512 * _i; *(LAS v4u*)(Bl + (_c >> 4) * BSTR + (_c & 15) * 16) = rB[S][_i]; *(LAS v4u*)(Cl + (_c >> 4) * BSTR + (_c & 15) * 16) = rC[S][_i]; } \
        *(LAS v4u*)(Xl + xr * XSTR + xc * 16) = rX[S]; \
        { const float rxs = rdt[S] * fast_exp2(ral[S] - rac[S]); const v4u _x = rX[S]; v4u _o; _o.x = cvt_pk_bf16(bflo(_x.x) * rxs, bfhi(_x.x) * rxs); _o.y = cvt_pk_bf16(bflo(_x.y) * rxs, bfhi(_x.y) * rxs); _o.z = cvt_pk_bf16(bflo(_x.z) * rxs, bfhi(_x.z) * rxs); _o.w = cvt_pk_bf16(bflo(_x.w) * rxs, bfhi(_x.w) * rxs); \
          *(LAS v4u*)(Xw + xr * XSTR + xc * 16) = _o; } \
        if (xc == 0) { AC[xr] = rac[S]; DTs[xr] = rdt[S]; } } while (0)
    SM_LOAD(0, 0); SM_STORE(0);
#pragma unroll
    for (int k = 1; k < PF; ++k) SM_LOAD(k, k);
    __syncthreads();
#pragma unroll 1
    for (int ck0 = 0; ck0 < 68; ck0 += PF) {
#pragma unroll
      for (int u = 0; u < PF; ++u) { const int ck = ck0 + u; const int cur = u & 1;
        SM_LOAD(u, ck + PF);
        const LAS unsigned char* Sc = Sb + cur * (64 * BSTR); LAS unsigned char* Sn = Sb + (cur ^ 1) * (64 * BSTR);
        bf16x8 cf[4], sf[2][4], bfr[4][4];
#pragma unroll
        for (int ks = 0; ks < 4; ++ks) cf[ks] = *(const LAS bf16x8*)(Cl + (16 * lt + fr) * BSTR + (32 * ks + 8 * fq) * 2);
#pragma unroll
        for (int pi = 0; pi < 2; ++pi)
#pragma unroll
            for (int ks = 0; ks < 4; ++ks) sf[pi][ks] = *(const LAS bf16x8*)(Sc + (16 * (2 * ph + pi) + fr) * BSTR + (32 * ks + 8 * fq) * 2);
#pragma unroll
        for (int st = 0; st < 4; ++st) { if (true) {
#pragma unroll
            for (int ks = 0; ks < 4; ++ks) bfr[st][ks] = *(const LAS bf16x8*)(Bl + (16 * st + fr) * BSTR + (32 * ks + 8 * fq) * 2); } }
        const float acl = AC[16 * lt + fr];
        f32x4 acs[4], dts[4];
#pragma unroll
        for (int st = 0; st < 4; ++st) { acs[st] = *(const LAS f32x4*)(AC + 16 * st + 4 * fq); dts[st] = *(const LAS f32x4*)(DTs + 16 * st + 4 * fq); }
        const float gdec = fast_exp2(AC[63]);
        bf16x8 xf[2][2];
#pragma unroll
        for (int ks2 = 0; ks2 < 2; ++ks2) { if (true) {
#pragma unroll
            for (int pi = 0; pi < 2; ++pi) { const LAS unsigned char* xb = Xl + (32 * ks2 + 4 * fq + lq) * XSTR + (16 * (2 * ph + pi) + 4 * lp) * 2;
                const s16x4 v0 = __builtin_amdgcn_ds_read_tr16_b64_v4i16((LAS s16x4*)xb), v1 = __builtin_amdgcn_ds_read_tr16_b64_v4i16((LAS s16x4*)(xb + 16 * XSTR));
                xf[ks2][pi][0] = v0[0]; xf[ks2][pi][1] = v0[1]; xf[ks2][pi][2] = v0[2]; xf[ks2][pi][3] = v0[3]; xf[ks2][pi][4] = v1[0]; xf[ks2][pi][5] = v1[1]; xf[ks2][pi][6] = v1[2]; xf[ks2][pi][7] = v1[3]; } } }
        f32x4 yacc[2];
#pragma unroll
        for (int pi = 0; pi < 2; ++pi) { f32x4 a = (f32x4){0.f, 0.f, 0.f, 0.f};
#pragma unroll
            for (int ks = 0; ks < 4; ++ks) a = __builtin_amdgcn_mfma_f32_16x16x32_bf16(sf[pi][ks], cf[ks], a, 0, 0, 0);
            yacc[pi] = a * fast_exp2(acl); }
        f32x4 pm[4];
#pragma unroll
        for (int st = 0; st < 4; ++st) { pm[st] = (f32x4){0.f, 0.f, 0.f, 0.f};
            if (st <= lt) { f32x4 g = (f32x4){0.f, 0.f, 0.f, 0.f};
#pragma unroll
                for (int ks = 0; ks < 4; ++ks) g = __builtin_amdgcn_mfma_f32_16x16x32_bf16(bfr[st][ks], cf[ks], g, 0, 0, 0);
#pragma unroll
                for (int j = 0; j < 4; ++j) { const bool ok = (16 * st + 4 * fq + j) <= (16 * lt + fr); pm[st][j] = ok ? g[j] * fast_exp2(acl - acs[st][j]) * dts[st][j] : 0.f; } } }
        bf16x8 xwf[2], btf[4][2];
#pragma unroll
        for (int ks2 = 0; ks2 < 2; ++ks2) { const LAS unsigned char* xb = Xw + (32 * ks2 + 8 * fq + lq) * XSTR + (16 * lt + 4 * lp) * 2;
            const s16x4 v0 = __builtin_amdgcn_ds_read_tr16_b64_v4i16((LAS s16x4*)xb), v1 = __builtin_amdgcn_ds_read_tr16_b64_v4i16((LAS s16x4*)(xb + 4 * XSTR));
            xwf[ks2][0] = v0[0]; xwf[ks2][1] = v0[1]; xwf[ks2][2] = v0[2]; xwf[ks2][3] = v0[3]; xwf[ks2][4] = v1[0]; xwf[ks2][5] = v1[1]; xwf[ks2][6] = v1[2]; xwf[ks2][7] = v1[3]; }
#pragma unroll
        for (int i = 0; i < 4; ++i)
#pragma unroll
            for (int ks2 = 0; ks2 < 2; ++ks2) { const LAS unsigned char* bb = Bl + (32 * ks2 + 8 * fq + lq) * BSTR + (16 * (4 * ph + i) + 4 * lp) * 2;
                const s16x4 v0 = __builtin_amdgcn_ds_read_tr16_b64_v4i16((LAS s16x4*)bb), v1 = __builtin_amdgcn_ds_read_tr16_b64_v4i16((LAS s16x4*)(bb + 4 * BSTR));
                btf[i][ks2][0] = v0[0]; btf[i][ks2][1] = v0[1]; btf[i][ks2][2] = v0[2]; btf[i][ks2][3] = v0[3]; btf[i][ks2][4] = v1[0]; btf[i][ks2][5] = v1[1]; btf[i][ks2][6] = v1[2]; btf[i][ks2][7] = v1[3]; }
#pragma unroll
        for (int ks2 = 0; ks2 < 2; ++ks2) { if (2 * ks2 <= lt) { const v4u pw = pack8(pm[2 * ks2], pm[2 * ks2 + 1]); const bf16x8 pf = __builtin_bit_cast(bf16x8, pw);
#pragma unroll
                for (int pi = 0; pi < 2; ++pi) yacc[pi] = __builtin_amdgcn_mfma_f32_16x16x32_bf16(xf[ks2][pi], pf, yacc[pi], 0, 0, 0); } }
        { const size_t ro = (size_t)(b * TPB + scan_row(dir, ck * 64 + 16 * lt + fr));
#pragma unroll
          for (int pi = 0; pi < 2; ++pi) { const v2u xr_ = *(const LAS v2u*)(Xl + (16 * lt + fr) * XSTR + (16 * (2 * ph + pi) + 4 * fq) * 2);
              yacc[pi][0] += dsk * bflo(xr_.x); yacc[pi][1] += dsk * bfhi(xr_.x); yacc[pi][2] += dsk * bflo(xr_.y); yacc[pi][3] += dsk * bfhi(xr_.y);
              v2u o; o.x = cvt_pk_bf16(yacc[pi][0], yacc[pi][1]); o.y = cvt_pk_bf16(yacc[pi][2], yacc[pi][3]);
              *(v2u*)(Y + ro * 1024 + hl * 64 + 16 * (2 * ph + pi) + 4 * fq) = o; } }
#pragma unroll
        for (int i = 0; i < 4; ++i) { const int nt = 4 * ph + i; f32x4 a = sacc[i] * gdec;
#pragma unroll
            for (int ks2 = 0; ks2 < 2; ++ks2) a = __builtin_amdgcn_mfma_f32_16x16x32_bf16(xwf[ks2], btf[i][ks2], a, 0, 0, 0);
            sacc[i] = a;
#pragma unroll
            for (int j = 0; j < 4; ++j) *(LAS bf16*)(Sn + (16 * lt + 4 * fq + j) * BSTR + (16 * nt + fr) * 2) = (bf16)f2bf(a[j]); }
        __syncthreads();
        if (ck + 1 < 68) SM_STORE((u + 1) % PF);
        __syncthreads();
      } }
#undef SM_LOAD
#undef SM_STORE
}
struct GnRow { float v[16]; float ss; };
__device__ __forceinline__ void gn2_load(GnRow& R, const bf16* Yf, const bf16* Yb, const bf16* Z, size_t off) {
    const v4u a0 = *(const v4u*)(Yf + off), a1 = *(const v4u*)(Yf + off + 8), b0 = *(const v4u*)(Yb + off), b1 = *(const v4u*)(Yb + off + 8);
    const v4u z0 = *(const v4u*)(Z + off), z1 = *(const v4u*)(Z + off + 8);
    const unsigned aw[8] = {a0.x, a0.y, a0.z, a0.w, a1.x, a1.y, a1.z, a1.w}, bw[8] = {b0.x, b0.y, b0.z, b0.w, b1.x, b1.y, b1.z, b1.w};
    const unsigned zw[8] = {z0.x, z0.y, z0.z, z0.w, z1.x, z1.y, z1.z, z1.w};
    float ss = 0.f;
#pragma unroll
    for (int i = 0; i < 8; ++i) { R.v[2 * i] = (bflo(aw[i]) + bflo(bw[i])) * silu_f(bflo(zw[i])); R.v[2 * i + 1] = (bfhi(aw[i]) + bfhi(bw[i])) * silu_f(bfhi(zw[i]));
        ss += R.v[2 * i] * R.v[2 * i] + R.v[2 * i + 1] * R.v[2 * i + 1]; }
    R.ss = ss;
}
__device__ __forceinline__ void gn_store(const GnRow& R, float rs, const float (&ng)[16], bf16* dst) {
    unsigned res[8];
#pragma unroll
    for (int i = 0; i < 8; ++i) res[i] = cvt_pk_bf16(R.v[2 * i] * rs * ng[2 * i], R.v[2 * i + 1] * rs * ng[2 * i + 1]);
    *(v4u*)(dst) = (v4u){res[0], res[1], res[2], res[3]}; *(v4u*)(dst + 8) = (v4u){res[4], res[5], res[6], res[7]};
}
__device__ __forceinline__ void phase_ssm_gnorm2(Frame& F, const float* const* in, int gp, bf16* Yf, const bf16* Yb, const bf16* XS, const bf16* Z, bf16* dst = nullptr) {
    if (!dst) dst = Yf;
    const int gw = F.vcu * NWAVES + F.wave, NGW = GRID * NWAVES; float ng[16];
#pragma unroll
    for (int i = 0; i < 16; ++i) ng[i] = in[24][gp * 1024 + 16 * F.lane + i];
    for (int r0 = gw; r0 < M; r0 += 4 * NGW) { GnRow R[4]; size_t of[4]; bool ok[4];
#pragma unroll
        for (int q = 0; q < 4; ++q) { const int r = r0 + q * NGW; ok[q] = r < M; of[q] = (size_t)(ok[q] ? r : r0) * 1024 + 16 * F.lane; gn2_load(R[q], Yf, Yb, Z, of[q]); }
#pragma unroll
        for (int o = 1; o < 32; o <<= 1) {
#pragma unroll
            for (int q = 0; q < 4; ++q) R[q].ss += __shfl_xor(R[q].ss, o); }
#pragma unroll
        for (int q = 0; q < 4; ++q) if (ok[q]) gn_store(R[q], rsqrtf(R[q].ss * (1.f / 512.f) + EPS), ng, dst + of[q]); }
}

__device__ __forceinline__ void phase_mlstm_scan(Frame& F, const bf16* Qm, const bf16* Km, const bf16* Vm, const float* G, bf16* Hf, bf16* Hb) {
    constexpr int T = 32;
    LAS float* Qf = (LAS float*)F.lds;
    LAS float* KW = (LAS float*)(F.lds + 8192);
    LAS float* Vf = (LAS float*)(F.lds + 16384);
    LAS float* FD = (LAS float*)(F.lds + 24576);
    LAS float* IW = (LAS float*)(F.lds + 24576 + 256);
    LAS float* EM = (LAS float*)(F.lds + 24576 + 512);
    LAS float* PN = (LAS float*)(F.lds + 32768);
    LAS float* PD = (LAS float*)(F.lds + 32768 + 65536);
    const int it = blockIdx.x, b = it >> 5, dir = (it >> 4) & 1, head = (it >> 1) & 7, jh = it & 1;
    bf16* Hout = dir == 0 ? Hf : Hb;
    const int w = F.wave, lane = F.lane, d7 = 8 * w + (lane & 7);
    float C[8], nst = 0.f, m_in = 0.f;
#pragma unroll
    for (int i = 0; i < 8; ++i) C[i] = 0.f;
    const int st = (F.tid & 255) >> 3, sch = F.tid & 7;
    v4u r0, r1; float gi = 0.f, gf = 0.f;
#define ML_LOAD(tile) do { const size_t _r = (size_t)(b * TPB + scan_row(dir, (tile) * T + st)); \
        if (F.tid < 256) { r0 = *(const v4u*)(Qm + _r * 512 + head * 64 + sch * 8); r1 = *(const v4u*)(Vm + _r * 1024 + head * 128 + jh * 64 + sch * 8); } \
        else { r0 = *(const v4u*)(Km + _r * 512 + head * 64 + sch * 8); } \
        if (F.tid < 32) { const size_t _g = (size_t)(b * TPB + scan_row(dir, (tile) * T + F.tid)); gi = G[_g * 32 + (2 * dir) * 8 + head]; gf = G[_g * 32 + (2 * dir + 1) * 8 + head]; } } while (0)
#define UNPK(dst, r) do { *(LAS f32x4*)(dst) = (f32x4){bflo(r.x), bfhi(r.x), bflo(r.y), bfhi(r.y)}; *(LAS f32x4*)((dst) + 4) = (f32x4){bflo(r.z), bfhi(r.z), bflo(r.w), bfhi(r.w)}; } while (0)
#define ML_GATES(nb) do { if (w == 0) { float Fc = lane < 32 ? gf : 0.f; \
            _Pragma("unroll") for (int o = 1; o < 32; o <<= 1) { const float t_ = __shfl_up(Fc, o); if (lane >= o) Fc += t_; } \
            float Gm = lane < 32 ? gi - Fc : -3.0e38f; \
            _Pragma("unroll") for (int o = 1; o < 32; o <<= 1) { const float t_ = __shfl_up(Gm, o); if (lane >= o) Gm = fmaxf(Gm, t_); } \
            const float mt = Fc + fmaxf(m_in, Gm); float mp = __shfl_up(mt, 1); if (lane == 0) mp = m_in; \
            if (lane < 32) { FD[(nb) * 32 + lane] = fast_exp2((gf + mp - mt) * LOG2E); IW[(nb) * 32 + lane] = fast_exp2((gi - mt) * LOG2E); EM[(nb) * 32 + lane] = fast_exp2(-mt * LOG2E); } \
            m_in = __shfl(mt, 31); } } while (0)
    __syncthreads();
    ML_LOAD(0); ML_GATES(0);
    if (F.tid < 256) { UNPK(Qf + st * 64 + sch * 8, r0); UNPK(Vf + st * 64 + sch * 8, r1); }
    __syncthreads();
    if (F.tid >= 256) { const float iw = IW[st]; LAS float* dk = KW + st * 64 + sch * 8;
        *(LAS f32x4*)dk = (f32x4){bflo(r0.x), bfhi(r0.x), bflo(r0.y), bfhi(r0.y)} * iw; *(LAS f32x4*)(dk + 4) = (f32x4){bflo(r0.z), bfhi(r0.z), bflo(r0.w), bfhi(r0.w)} * iw; }
    __syncthreads();
    constexpr int NT = TPB / T;
    for (int tile = 0; tile < NT; ++tile) { const int cb = tile & 1;
        if (tile + 1 < NT) ML_LOAD(tile + 1);
#pragma unroll 4
        for (int t = 0; t < T; ++t) {
            const float fd = FD[cb * 32 + t], v = Vf[t * 64 + lane];
            const f32x4 q0 = *(const LAS f32x4*)(Qf + t * 64 + 8 * w), q1 = *(const LAS f32x4*)(Qf + t * 64 + 8 * w + 4);
            const f32x4 k0 = *(const LAS f32x4*)(KW + t * 64 + 8 * w), k1 = *(const LAS f32x4*)(KW + t * 64 + 8 * w + 4);
            float pn = 0.f;
#pragma unroll
            for (int i = 0; i < 4; ++i) { C[i] = C[i] * fd + k0[i] * v; pn += q0[i] * C[i]; C[4 + i] = C[4 + i] * fd + k1[i] * v; pn += q1[i] * C[4 + i]; }
            PN[(w * 32 + t) * 64 + lane] = pn;
            nst = nst * fd + KW[t * 64 + d7];
            float pd = Qf[t * 64 + d7] * nst;
            pd += __shfl_xor(pd, 1); pd += __shfl_xor(pd, 2); pd += __shfl_xor(pd, 4);
            if (lane == 0) PD[w * 32 + t] = pd;
        }
        __syncthreads();
#pragma unroll
        for (int k = 0; k < 4; ++k) { const int t = (F.tid >> 6) + 8 * k; float num = 0.f, den = 0.f;
#pragma unroll
            for (int ww = 0; ww < 8; ++ww) { num += PN[(ww * 32 + t) * 64 + lane]; den += PD[ww * 32 + t]; }
            const float h = num / fmaxf(fabsf(den), EM[cb * 32 + t]);
            Hout[(size_t)(b * TPB + scan_row(dir, tile * T + t)) * 1024 + head * 128 + jh * 64 + lane] = (bf16)f2bf(h); }
        if (tile + 1 < NT) { ML_GATES(cb ^ 1); if (F.tid < 256) { UNPK(Qf + st * 64 + sch * 8, r0); UNPK(Vf + st * 64 + sch * 8, r1); } }
        __syncthreads();
        if (tile + 1 < NT && F.tid >= 256) { const float iw = IW[(cb ^ 1) * 32 + st]; LAS float* dk = KW + st * 64 + sch * 8;
            *(LAS f32x4*)dk = (f32x4){bflo(r0.x), bfhi(r0.x), bflo(r0.y), bfhi(r0.y)} * iw; *(LAS f32x4*)(dk + 4) = (f32x4){bflo(r0.z), bfhi(r0.z), bflo(r0.w), bfhi(r0.w)} * iw; }
        __syncthreads();
    }
#undef ML_LOAD
#undef ML_GATES
#undef UNPK
}

__device__ __forceinline__ void phase_mlstm_scan_mfma(Frame& F, const bf16* Qm, const bf16* Km, const bf16* Vm, const float* G, bf16* Hf, bf16* Hb) {
    constexpr int QSTR = 144, WSTR = 160, VSTR = 176, CSTR = 144;
    LAS unsigned char* Ql = F.lds;
    LAS unsigned char* Kl = F.lds + 9216;
    LAS unsigned char* Kw = F.lds + 18432;
    LAS unsigned char* Vl = F.lds + 28672;
    LAS unsigned char* Cb = F.lds + 39936;
    LAS float* GB = (LAS float*)(F.lds + 62976);
    const int it = F.vcu, b = it >> 5, dir = (it >> 4) & 1, head = (it >> 1) & 7, jh = it & 1;
    bf16* Hout = dir == 0 ? Hf : Hb;
    const int tid = F.tid, lane = F.lane, w = F.wave, fr = lane & 15, fq = lane >> 4, lq = (lane & 15) >> 2, lp = lane & 3;
    const int jg = w >> 2, lt = jg ? 3 - (w & 3) : (w & 3);
    for (int i = tid; i < 80 * CSTR / 16; i += NTHR) *(LAS v4u*)(Cb + i * 16) = (v4u){0u, 0u, 0u, 0u};
    for (int i = tid; i < 64 * 2; i += NTHR) { const int s = i >> 1, hh = i & 1; *(LAS v4u*)(Vl + s * VSTR + 128 + hh * 16) = hh == 0 ? (v4u){0x3F80u, 0u, 0u, 0u} : (v4u){0u, 0u, 0u, 0u}; }
    f32x4 sacc[3];
#pragma unroll
    for (int i = 0; i < 3; ++i) sacc[i] = (f32x4){0.f, 0.f, 0.f, 0.f};
    constexpr int PF = ML_PF;
    v4u rQ[PF], rK[PF], rV[PF]; float gi[PF], gf[PF]; float m_in = 0.f;
    const int sr = tid >> 3, sc = tid & 7;
#define MM_LOAD(S, ckv) do { const int _ck = (ckv) < 68 ? (ckv) : 67; const size_t _r = (size_t)(b * TPB + scan_row(dir, _ck * 64 + sr)); \
        rQ[S] = *(const v4u*)(Qm + _r * 512 + head * 64 + sc * 8); rK[S] = *(const v4u*)(Km + _r * 512 + head * 64 + sc * 8); rV[S] = *(const v4u*)(Vm + _r * 1024 + head * 128 + jh * 64 + sc * 8); \
        { const size_t _g = (size_t)(b * TPB + scan_row(dir, _ck * 64 + lane)); gi[S] = G[_g * 32 + (2 * dir) * 8 + head]; gf[S] = G[_g * 32 + (2 * dir + 1) * 8 + head]; } } while (0)
#define MM_GSCAN(S, GP) do { if (w == 0) { LAS float* _g = (GP); const float gil = gi[S] * LOG2E; const float Fc = wave_scan_sum(gf[S] * LOG2E); \
            const float Gm = wave_scan_max(gil - Fc); \
            const float mt = Fc + fmaxf(m_in, Gm); _g[lane] = Fc; _g[64 + lane] = gil; _g[128 + lane] = mt; \
            if (lane == 63) { _g[192] = Fc; _g[193] = m_in; _g[194] = mt; } \
            m_in = __shfl(mt, 63); } } while (0)
#define MM_STAGE(S, GP) do { const LAS float* _g = (GP); \
        *(LAS v4u*)(Ql + sr * QSTR + sc * 16) = rQ[S]; *(LAS v4u*)(Kl + sr * QSTR + sc * 16) = rK[S]; *(LAS v4u*)(Vl + sr * VSTR + sc * 16) = rV[S]; \
        const float ws_ = fast_exp2(_g[192] - _g[sr] + _g[64 + sr] - _g[194]); const v4u _k = rK[S]; v4u _o; \
        _o.x = cvt_pk_bf16(bflo(_k.x) * ws_, bfhi(_k.x) * ws_); _o.y = cvt_pk_bf16(bflo(_k.y) * ws_, bfhi(_k.y) * ws_); _o.z = cvt_pk_bf16(bflo(_k.z) * ws_, bfhi(_k.z) * ws_); _o.w = cvt_pk_bf16(bflo(_k.w) * ws_, bfhi(_k.w) * ws_); \
        *(LAS v4u*)(Kw + sr * WSTR + sc * 16) = _o; } while (0)
    __syncthreads();
    MM_LOAD(0, 0); MM_GSCAN(0, GB); __syncthreads(); MM_STAGE(0, GB);
#pragma unroll
    for (int k = 1; k < PF; ++k) MM_LOAD(k, k);
    __syncthreads();
#pragma unroll 1
    for (int ck0 = 0; ck0 < 68; ck0 += PF) {
#pragma unroll
      for (int u = 0; u < PF; ++u) { const int ck = ck0 + u; const int cur = u & 1;
        const LAS float* BCU = GB + cur * 256; const LAS float* IGA = BCU + 64; const LAS float* MTA = BCU + 128; const LAS float* SCA = BCU + 192;
        if (ck + 1 < 68) MM_GSCAN((u + 1) % PF, GB + (cur ^ 1) * 256);
        MM_LOAD(u, ck + PF);
        const LAS unsigned char* Cc = Cb + cur * (80 * CSTR); LAS unsigned char* Cn = Cb + (cur ^ 1) * (80 * CSTR);
        bf16x8 qf[2], cfr[3][2], kfr[4][2];
#pragma unroll
        for (int ks = 0; ks < 2; ++ks) qf[ks] = *(const LAS bf16x8*)(Ql + (16 * lt + fr) * QSTR + (32 * ks + 8 * fq) * 2);
#pragma unroll
        for (int ji = 0; ji < 3; ++ji) { const int row = ji < 2 ? 16 * (2 * jg + ji) + fr : 64 + fr;
#pragma unroll
            for (int ks = 0; ks < 2; ++ks) cfr[ji][ks] = *(const LAS bf16x8*)(Cc + row * CSTR + (32 * ks + 8 * fq) * 2); }
#pragma unroll
        for (int st = 0; st < 4; ++st) { if (st <= lt) {
#pragma unroll
            for (int ks = 0; ks < 2; ++ks) kfr[st][ks] = *(const LAS bf16x8*)(Kl + (16 * st + fr) * QSTR + (32 * ks + 8 * fq) * 2); } }
        const float bl = BCU[16 * lt + fr], ml = MTA[16 * lt + fr], m0 = SCA[1];
        f32x4 bsv[4], isv[4];
#pragma unroll
        for (int st = 0; st < 4; ++st) { bsv[st] = *(const LAS f32x4*)(BCU + 16 * st + 4 * fq); isv[st] = *(const LAS f32x4*)(IGA + 16 * st + 4 * fq); }
        const float gdec = fast_exp2(SCA[0] + m0 - SCA[2]);
        bf16x8 vfr[2][2];
#pragma unroll
        for (int ks2 = 0; ks2 < 2; ++ks2) { if (2 * ks2 <= lt) {
#pragma unroll
            for (int ji = 0; ji < 2; ++ji) { const LAS unsigned char* vb = Vl + (32 * ks2 + 4 * fq + lq) * VSTR + (16 * (2 * jg + ji) + 4 * lp) * 2;
                const s16x4 v0 = __builtin_amdgcn_ds_read_tr16_b64_v4i16((LAS s16x4*)vb), v1 = __builtin_amdgcn_ds_read_tr16_b64_v4i16((LAS s16x4*)(vb + 16 * VSTR));
                vfr[ks2][ji][0] = v0[0]; vfr[ks2][ji][1] = v0[1]; vfr[ks2][ji][2] = v0[2]; vfr[ks2][ji][3] = v0[3]; vfr[ks2][ji][4] = v1[0]; vfr[ks2][ji][5] = v1[1]; vfr[ks2][ji][6] = v1[2]; vfr[ks2][ji][7] = v1[3]; } } }
        const float dl = fast_exp2(bl + m0 - ml);
        f32x4 nacc[2]; float den;
#pragma unroll
        for (int ji = 0; ji < 2; ++ji) { f32x4 a = (f32x4){0.f, 0.f, 0.f, 0.f};
#pragma unroll
            for (int ks = 0; ks < 2; ++ks) a = __builtin_amdgcn_mfma_f32_16x16x32_bf16(cfr[ji][ks], qf[ks], a, 0, 0, 0);
            nacc[ji] = a * dl; }
        { f32x4 a = (f32x4){0.f, 0.f, 0.f, 0.f};
#pragma unroll
          for (int ks = 0; ks < 2; ++ks) a = __builtin_amdgcn_mfma_f32_16x16x32_bf16(cfr[2][ks], qf[ks], a, 0, 0, 0);
          den = __shfl(a[0], fr) * dl; }
        f32x4 pm[4]; float dsum = 0.f;
#pragma unroll
        for (int st = 0; st < 4; ++st) { pm[st] = (f32x4){0.f, 0.f, 0.f, 0.f};
            if (st <= lt) { f32x4 g = (f32x4){0.f, 0.f, 0.f, 0.f};
#pragma unroll
                for (int ks = 0; ks < 2; ++ks) g = __builtin_amdgcn_mfma_f32_16x16x32_bf16(kfr[st][ks], qf[ks], g, 0, 0, 0);
#pragma unroll
                for (int j = 0; j < 4; ++j) { const bool ok = (16 * st + 4 * fq + j) <= (16 * lt + fr); const float v = ok ? g[j] * fast_exp2(bl - bsv[st][j] + isv[st][j] - ml) : 0.f; pm[st][j] = v; dsum += v; } } }
        bf16x8 kwf[2], vtf[3][2];
#pragma unroll
        for (int ks2 = 0; ks2 < 2; ++ks2) { const LAS unsigned char* kb = Kw + (32 * ks2 + 8 * fq + lq) * WSTR + (16 * lt + 4 * lp) * 2;
            const s16x4 v0 = __builtin_amdgcn_ds_read_tr16_b64_v4i16((LAS s16x4*)kb), v1 = __builtin_amdgcn_ds_read_tr16_b64_v4i16((LAS s16x4*)(kb + 4 * WSTR));
            kwf[ks2][0] = v0[0]; kwf[ks2][1] = v0[1]; kwf[ks2][2] = v0[2]; kwf[ks2][3] = v0[3]; kwf[ks2][4] = v1[0]; kwf[ks2][5] = v1[1]; kwf[ks2][6] = v1[2]; kwf[ks2][7] = v1[3]; }
#pragma unroll
        for (int i = 0; i < 3; ++i) { if (jg == 0 || i < 2) { const int jt = jg == 0 ? i : 3 + i;
#pragma unroll
            for (int ks2 = 0; ks2 < 2; ++ks2) { const LAS unsigned char* vb = Vl + (32 * ks2 + 8 * fq + lq) * VSTR + (16 * jt + 4 * lp) * 2;
                const s16x4 v0 = __builtin_amdgcn_ds_read_tr16_b64_v4i16((LAS s16x4*)vb), v1 = __builtin_amdgcn_ds_read_tr16_b64_v4i16((LAS s16x4*)(vb + 4 * VSTR));
                vtf[i][ks2][0] = v0[0]; vtf[i][ks2][1] = v0[1]; vtf[i][ks2][2] = v0[2]; vtf[i][ks2][3] = v0[3]; vtf[i][ks2][4] = v1[0]; vtf[i][ks2][5] = v1[1]; vtf[i][ks2][6] = v1[2]; vtf[i][ks2][7] = v1[3]; } } }
        dsum += __shfl_xor(dsum, 16); dsum += xor32(dsum);
        den += dsum;
#pragma unroll
        for (int ks2 = 0; ks2 < 2; ++ks2) { if (2 * ks2 <= lt) { const v4u pw = pack8(pm[2 * ks2], pm[2 * ks2 + 1]); const bf16x8 pf = __builtin_bit_cast(bf16x8, pw);
#pragma unroll
                for (int ji = 0; ji < 2; ++ji) nacc[ji] = __builtin_amdgcn_mfma_f32_16x16x32_bf16(vfr[ks2][ji], pf, nacc[ji], 0, 0, 0); } }
        { const float inv = 1.0f / fmaxf(fabsf(den), fast_exp2(-ml)); const size_t ro = (size_t)(b * TPB + scan_row(dir, ck * 64 + 16 * lt + fr));
#pragma unroll
          for (int ji = 0; ji < 2; ++ji) { v2u o; o.x = cvt_pk_bf16(nacc[ji][0] * inv, nacc[ji][1] * inv); o.y = cvt_pk_bf16(nacc[ji][2] * inv, nacc[ji][3] * inv);
              *(v2u*)(Hout + ro * 1024 + head * 128 + jh * 64 + 16 * (2 * jg + ji) + 4 * fq) = o; } }
#pragma unroll
        for (int i = 0; i < 3; ++i) { if (jg == 0 || i < 2) { const int jt = jg == 0 ? i : 3 + i; f32x4 a = sacc[i] * gdec;
#pragma unroll
            for (int ks2 = 0; ks2 < 2; ++ks2) a = __builtin_amdgcn_mfma_f32_16x16x32_bf16(vtf[i][ks2], kwf[ks2], a, 0, 0, 0);
            sacc[i] = a;
#pragma unroll
            for (int j = 0; j < 4; ++j) *(LAS bf16*)(Cn + (16 * jt + 4 * fq + j) * CSTR + (16 * lt + fr) * 2) = (bf16)f2bf(a[j]); } }
        __syncthreads();
        if (ck + 1 < 68) MM_STAGE((u + 1) % PF, GB + (cur ^ 1) * 256);
        __syncthreads();
      } }
#undef MM_LOAD
#undef MM_GSCAN
#undef MM_STAGE
}

__device__ __forceinline__ void mg_load(GnRow& R, unsigned (&ow)[8], const bf16* Hf, const bf16* Hb, const bf16* Om, size_t off) {
    const v4u a0 = *(const v4u*)(Hf + off), a1 = *(const v4u*)(Hf + off + 8), b0 = *(const v4u*)(Hb + off), b1 = *(const v4u*)(Hb + off + 8), o0 = *(const v4u*)(Om + off), o1 = *(const v4u*)(Om + off + 8);
    const unsigned aw[8] = {a0.x, a0.y, a0.z, a0.w, a1.x, a1.y, a1.z, a1.w}, bw[8] = {b0.x, b0.y, b0.z, b0.w, b1.x, b1.y, b1.z, b1.w};
    ow[0] = o0.x; ow[1] = o0.y; ow[2] = o0.z; ow[3] = o0.w; ow[4] = o1.x; ow[5] = o1.y; ow[6] = o1.z; ow[7] = o1.w;
    float ss = 0.f;
#pragma unroll
    for (int i = 0; i < 8; ++i) { R.v[2 * i] = bflo(aw[i]) + bflo(bw[i]); R.v[2 * i + 1] = bfhi(aw[i]) + bfhi(bw[i]); ss += R.v[2 * i] * R.v[2 * i] + R.v[2 * i + 1] * R.v[2 * i + 1]; }
    R.ss = ss;
}
__device__ __forceinline__ void mg_store(const GnRow& R, const unsigned (&ow)[8], float rs, const float (&ng)[16], bf16* dst) {
    unsigned res[8];
#pragma unroll
    for (int i = 0; i < 8; ++i) res[i] = cvt_pk_bf16(R.v[2 * i] * rs * ng[2 * i] * sigmoid_f(bflo(ow[i])), R.v[2 * i + 1] * rs * ng[2 * i + 1] * sigmoid_f(bfhi(ow[i])));
    *(v4u*)(dst) = (v4u){res[0], res[1], res[2], res[3]}; *(v4u*)(dst + 8) = (v4u){res[4], res[5], res[6], res[7]};
}
__device__ __forceinline__ void phase_mlstm_gnorm(Frame& F, const float* const* in, const bf16* Hf, const bf16* Hb, const bf16* Om, bf16* Hn) {
    const int gw = F.vcu * NWAVES + F.wave, NGW = GRID * NWAVES; float ng[16];
#pragma unroll
    for (int i = 0; i < 16; ++i) ng[i] = in[28][16 * F.lane + i];
    for (int r0 = gw; r0 < M; r0 += 4 * NGW) { GnRow R[4]; unsigned ww[4][8]; size_t of[4]; bool ok[4];
#pragma unroll
        for (int q = 0; q < 4; ++q) { const int r = r0 + q * NGW; ok[q] = r < M; of[q] = (size_t)(ok[q] ? r : r0) * 1024 + 16 * F.lane; mg_load(R[q], ww[q], Hf, Hb, Om, of[q]); }
#pragma unroll
        for (int o = 1; o < 8; o <<= 1) {
#pragma unroll
            for (int q = 0; q < 4; ++q) R[q].ss += __shfl_xor(R[q].ss, o); }
#pragma unroll
        for (int q = 0; q < 4; ++q) if (ok[q]) mg_store(R[q], ww[q], rsqrtf(R[q].ss * (1.f / 128.f) + EPS), ng, Hn + of[q]); }
}
struct Args { const float* in[37]; float* out; unsigned char* ws; };

__device__ __forceinline__ void moe_phases(Frame& F, const float* const* in, int layer, const XcdBarrier& bar) {
#if defined(PROBE_ROUTE2)
    phase_norm2_route(F, in, layer, true); __syncthreads();
#endif
    phase_norm2_route(F, in, layer);
    SYNC_GRID();
    bf16* Hb = (bf16*)(F.ws + WS_H); bf16* ACT = (bf16*)(F.ws + MOE_ACT); bf16* X = (bf16*)(F.ws + WS_X);
    const float* mod = (const float*)(F.ws + WS_MOD) + (size_t)layer * 9 * 6144;
    { MoeOrder<0> S; S.W = (const bf16*)(F.ws + WS_WGU + wofs(layer)); S.G = GRID; S.c = F.vcu; moe_setup(F, layer, S);
      pg8::Gemm g{Hb, 1024, 1024, 1 << 30}; EpiMoeAct E{ACT, S.tbl};
      pg8::gemm_phase(F.lds, g, S, E);
#if defined(PROBE_GM1)
      __syncthreads(); pg8::gemm_phase(F.lds, g, S, E);
#endif
      }
    if (layer < 3 && F.vcu >= 128) { __syncthreads(); refresh(F); phase_mod(F, in, layer + 1, layer + 2, F.vcu - 128, 128); }
    SYNC_GRID();
    { MoeOrder<1> S; S.W = (const bf16*)(F.ws + WS_WDN + wofs(layer)); S.G = GRID; S.c = F.vcu; moe_setup(F, layer, S);
      pg8::Gemm g{ACT, 512, 256, 4};
#if defined(PROBE_OUT2)
      { EpiMoeDown E0{X, (const float*)(F.ws + WS_CTL + 262144), S.tbl}; pg8::gemm_phase(F.lds, g, S, E0); VM_WAIT(); __syncthreads(); __builtin_amdgcn_fence(__ATOMIC_ACQUIRE, "agent"); VM_WAIT(); __syncthreads(); refresh(F); }
#endif
      EpiMoeDown E{X, mod + 5 * 1024, S.tbl};
      pg8::gemm_phase(F.lds, g, S, E); }
    SYNC_GRID();
}
__device__ __forceinline__ void outproj_phase(Frame& F, const float* const* in, const bf16* A, const bf16* Wt, int K, int ldb, int layer, int conv_next, const float* xin = nullptr, const float* cin = nullptr) {
    pg8::Gemm g{A, K, ldb, 1 << 30}; pg8::StaticOrder S; S.init(M, 1024, GRID, (int)blockIdx.x, Wt, ldb, layer == 3);
    EpiResid E{(bf16*)(F.ws + WS_X), (const float*)(F.ws + WS_MOD) + (size_t)layer * 9 * 6144 + 2 * 1024, xin, cin};
    pg8::gemm_phase(F.lds, g, S, E);
    if (conv_next >= 0 && blockIdx.x >= 32) { refresh(F); ConvGrid cg; cg.gw = ((int)blockIdx.x - 32) * NWAVES + F.wave; cg.ngw = (GRID - 32) * NWAVES; convert_layer(F, cg, in, conv_next); }
}

__device__ __forceinline__ void ssm_inproj(Frame& F, const float* const* in, const int gp, const int c, bf16* Z, bf16* PRE, float* DT) {
    const bf16* H = (const bf16*)(F.ws + WS_H); const bf16* WM = (const bf16*)(F.ws + WS_WMIX + wofs(1));
    pg8::Gemm g{H, 1024, 1024, 1 << 30}; pg8::StaticOrder S; S.init(M, 2816, GRID, c, WM + (size_t)gp * 2816 * 1024, 1024);
    EpiSsmIn E{Z, PRE, DT, in[21] + gp * 16};
    pg8::gemm_phase(F.lds, g, S, E);
}
__device__ __forceinline__ void ssm_gp_phases(Frame& F, const float* const* in, const int gp, const XcdBarrier& bar) {
    unsigned char* scr = F.ws + WS_SCR; unsigned char* scr2 = (unsigned char*)F.out; bf16* WM = (bf16*)(F.ws + WS_WMIX + wofs(1));
    bf16* Z = (bf16*)scr; bf16* XP = (bf16*)(scr + 68 * MiB); bf16* XS = (bf16*)(scr + 170 * MiB); float* DT = (float*)(scr + 238 * MiB); float* ACUM = (float*)(scr + 243 * MiB); bf16* Yb = (bf16*)(scr2 + 34 * MiB);
    bf16* PRE = gp == 0 ? XP : (bf16*)scr2; bf16* BC = gp == 0 ? (bf16*)scr2 : (bf16*)(scr + 136 * MiB);
    if (gp == 0) { ssm_inproj(F, in, 0, (int)blockIdx.x, Z, PRE, DT); SYNC_GRID(); }
    phase_ssm_conv(F, in, gp, PRE, XS, BC, DT, ACUM);
    SYNC_GRID();
    phase_ssm_scan_mfma(F, in, gp, XS, BC, DT, ACUM, XP, Yb);
    SYNC_GRID();
    phase_ssm_gnorm2(F, in, gp, XP, Yb, XS, Z);
    SYNC_GRID();
    if (gp == 0) {
        outproj_phase(F, in, XP, WM + 6 * MiB, 1024, 2048, 1, -1);
        __syncthreads(); refresh(F);
        ssm_inproj(F, in, 1, ((int)blockIdx.x + 224) & 255, Z, (bf16*)scr2, DT);
    } else outproj_phase(F, in, XP, WM + 6 * MiB + 1024, 1024, 2048, 1, 2);
    SYNC_GRID();
}

__global__ void __launch_bounds__(NTHR, 2) fwd_kernel(Args args) {
    extern __shared__ __attribute__((aligned(16))) unsigned char lds_raw[];
    Frame F;
    F.lds = (LAS unsigned char*)lds_raw; F.ws = args.ws; F.ctl = (unsigned*)(args.ws + WS_CTL); F.out = args.out;
    refresh(F);
    { const int bx = blockIdx.x; F.vcu = (bx % 8) * (GRID / 8) + bx / 8; }
    volatile LAS unsigned* MISC = (volatile LAS unsigned*)(F.lds + LDS_MISC);
    for (int u = F.tid; u < 256; u += NTHR) MISC[u] = 0u;
    __syncthreads();
    const XcdBarrier bar = xcd_barrier_post(F.ctl + CW_BAR, MISC + 8);
    const float* const* in = args.in;
    unsigned char* ws = F.ws; unsigned char* scr = ws + WS_SCR; unsigned char* scr2 = (unsigned char*)F.out;
    bf16* H = (bf16*)(ws + WS_H);

#if defined(PROBE_MEM2) || defined(PROBE_PRO2)
    for (int rep = 0; rep < 2; ++rep) {
#endif
    phase_prologue(F, in);
    __syncthreads(); refresh(F);
    convert_layer(F, conv_all(F), in, 0);
#if defined(PROBE_MEM2) || defined(PROBE_PRO2)
    __syncthreads(); }
#endif
    SYNC_GRID();

#ifndef SKIP_L0
    phase_norm1(F, in, 0);
#if defined(PROBE_MEM2)
    phase_norm1(F, in, 0);
#endif
    SYNC_GRID();
    { bf16* WM = (bf16*)(ws + WS_WMIX + wofs(0)); bf16* Q = (bf16*)scr; bf16* Kb = (bf16*)(scr + 68 * MiB); bf16* Vb = (bf16*)(scr + 85 * MiB);
      { pg8::Gemm g{H, 1024, 1024, 1 << 30}; pg8::StaticOrder S; S.init(M, 1536, GRID, (int)blockIdx.x, WM, 1024);
        EpiAttnIn E{Q, Kb, Vb, (const f32x2*)(ws + WS_TABA), 0.125f * LOG2E};
        pg8::gemm_phase(F.lds, g, S, E);
#if defined(PROBE_GEMM2)
        __syncthreads(); pg8::gemm_phase(F.lds, g, S, E);
#endif
        }
      SYNC_GRID();
#if defined(PROBE_WIN2)
      phase_attn_window(F, in, Q, Kb, Vb, (bf16*)scr2); __syncthreads();
#endif
      phase_attn_window(F, in, Q, Kb, Vb);
      SYNC_GRID();
      outproj_phase(F, in, Q, WM + 2 * MiB, 1024, 1024, 0, 1, in[0], in[2]);
      SYNC_GRID(); }
    moe_phases(F, in, 0, bar);

#endif
#ifndef SKIP_L1
#if defined(PROBE_MEM2)
    for (int rep = 0; rep < 2; ++rep) {
#endif
    phase_norm1(F, in, 1);
#if defined(PROBE_MEM2)
    __syncthreads(); }
#endif
    SYNC_GRID();
    ssm_gp_phases(F, in, 0, bar);
    ssm_gp_phases(F, in, 1, bar);
    moe_phases(F, in, 1, bar);

#endif
#ifndef SKIP_L2
#if defined(PROBE_MEM2)
    for (int rep = 0; rep < 2; ++rep) {
#endif
    phase_norm1(F, in, 2);
#if defined(PROBE_MEM2)
    __syncthreads(); }
#endif
    SYNC_GRID();
    { bf16* WM = (bf16*)(ws + WS_WMIX + wofs(2)); bf16* Qm = (bf16*)scr; bf16* Km = (bf16*)(scr + 34 * MiB); bf16* Vm = (bf16*)(scr + 68 * MiB); bf16* Om = (bf16*)(scr + 136 * MiB); float* Gt = (float*)(scr + 204 * MiB);
      bf16* Hf = (bf16*)scr2; bf16* Hbw = H;
      { pg8::Gemm g{H, 1024, 1024, 1 << 30}; pg8::StaticOrder S; S.init(M, 3328, GRID, (int)blockIdx.x, WM, 1024);
        EpiMlIn E{Qm, Km, Vm, Om, Gt, in[27]};
        pg8::gemm_phase(F.lds, g, S, E);
#if defined(PROBE_GEMM2)
        __syncthreads(); pg8::gemm_phase(F.lds, g, S, E);
#endif
        }
      SYNC_GRID();
#if defined(ML_VALU)
      phase_mlstm_scan(F, Qm, Km, Vm, Gt, Hf, Hbw);
#else
      phase_mlstm_scan_mfma(F, Qm, Km, Vm, Gt, Hf, Hbw);
#if defined(PROBE_MLM2)
      __syncthreads(); phase_mlstm_scan_mfma(F, Qm, Km, Vm, Gt, Hf, Hbw);
#endif
#endif
      SYNC_GRID();
#if defined(PROBE_GN2)
      phase_mlstm_gnorm(F, in, Hf, Hbw, Om, Qm); __syncthreads();
#endif
      phase_mlstm_gnorm(F, in, Hf, Hbw, Om, Om);
      SYNC_GRID();
      outproj_phase(F, in, Om, WM + 4 * MiB, 1024, 1024, 2, 3);
      SYNC_GRID(); }
    moe_phases(F, in, 2, bar);

#endif
#ifndef SKIP_L3
#if defined(PROBE_MEM2)
    for (int rep = 0; rep < 2; ++rep) {
#endif
    phase_norm1(F, in, 3);
#if defined(PROBE_MEM2)
    __syncthreads(); }
#endif
    SYNC_GRID();
    { bf16* WM = (bf16*)(ws + WS_WMIX + wofs(3)); bf16* CQ = (bf16*)scr; bf16* CKV = (bf16*)(scr + 17 * MiB); float* SSQ = (float*)(scr + 34 * MiB); bf16* KF = (bf16*)(scr + 36 * MiB); bf16* V3 = (bf16*)(scr + 138 * MiB);
      bf16* Q3 = (bf16*)scr2; bf16* O3 = H; const f32x2* tabm = (const f32x2*)(ws + WS_TABM);
      { pg8::Gemm g{H, 1024, 1024, 1 << 30}; pg8::StaticOrder S; S.init(M, 768, GRID, (int)blockIdx.x, WM, 1024);
        EpiMlaIn E{CQ, CKV, KF, SSQ, tabm};
        pg8::gemm_phase(F.lds, g, S, E);
#if defined(PROBE_GEMM2)
        __syncthreads(); pg8::gemm_phase(F.lds, g, S, E);
#endif
        }
      SYNC_GRID();
      { pg8::Gemm g{CQ, 256, 256, 1 << 30}; pg8::StaticOrder S; S.init(M, 1536, GRID, (int)blockIdx.x, WM + 1 * MiB, 256);
        EpiMlaQ E{Q3, SSQ, tabm, 0.10206207261596577f * LOG2E};
        pg8::gemm_phase(F.lds, g, S, E);
#if defined(PROBE_GEMM2)
        __syncthreads(); pg8::gemm_phase(F.lds, g, S, E);
#endif
        }
      { pg8::Gemm g{CKV, 256, 256, 1 << 30}; pg8::StaticOrder S; S.init(M, 2048, GRID, ((int)blockIdx.x + 192) & 255, WM + 2 * MiB, 256);
        EpiMlaKV E{KF, V3, SSQ};
        pg8::gemm_phase(F.lds, g, S, E);
#if defined(PROBE_GEMM2)
        __syncthreads(); pg8::gemm_phase(F.lds, g, S, E);
#endif
        }
      SYNC_GRID();
      phase_attn_mla(F, Q3, KF, V3, O3);
#if defined(PROBE_MLA2)
      __syncthreads(); phase_attn_mla(F, Q3, KF, V3, O3);
#endif
      SYNC_GRID();
      outproj_phase(F, in, O3, WM + 3 * MiB, 1024, 1024, 3, -1);
      SYNC_GRID(); }
    moe_phases(F, in, 3, bar);

#endif
    const bool poison = __hip_atomic_load(F.ctl + CW_BAR + XB_TMO, RLX_AGENT) != 0u || __hip_atomic_load(F.ctl + CW_POISON, RLX_AGENT) != 0u;
    phase_final(F, in, poison);
#if defined(PROBE_MEM2)
    phase_final(F, in, poison);
#endif
}

extern "C" void kernel_launch(void* const* d_in, const int* in_sizes, int n_in, void* d_out, int out_size, void* d_ws, size_t ws_size, hipStream_t stream) {
    static int ready = 0;
    if (ready == 0) {
        ready = -1;
        if (n_in != 37 || in_sizes[0] != NB * SEQ * D || out_size != NB * SEQ * D || ws_size < WS_END) { fprintf(stderr, "kernel_launch: unexpected problem shape (n_in %d, in0 %d, out %d, ws %zu)\n", n_in, n_in > 0 ? in_sizes[0] : -1, out_size, ws_size); return; }
        int dev = 0, cus = 0;
        if (hipGetDevice(&dev) != hipSuccess || hipDeviceGetAttribute(&cus, hipDeviceAttributeMultiprocessorCount, dev) != hipSuccess) { fprintf(stderr, "kernel_launch: device query failed\n"); return; }
        if (cus < GRID) { fprintf(stderr, "kernel_launch: needs %d CUs, device has %d\n", GRID, cus); return; }
        if (hipFuncSetAttribute((const void*)fwd_kernel, hipFuncAttributeMaxDynamicSharedMemorySize, LDS_BYTES) != hipSuccess) { fprintf(stderr, "kernel_launch: hipFuncSetAttribute failed\n"); return; }
        int per_cu = 0;
        if (hipOccupancyMaxActiveBlocksPerMultiprocessor(&per_cu, (const void*)fwd_kernel, NTHR, LDS_BYTES) != hipSuccess || per_cu < 1) { fprintf(stderr, "kernel_launch: occupancy query reports %d blocks per CU\n", per_cu); }
        (void)hipGetLastError();
        ready = 1;
    }
    if (ready < 0) return;
    if (hipMemsetAsync((char*)d_ws + WS_CTL, 0, CTL_ZERO_BYTES, stream) != hipSuccess) { fprintf(stderr, "kernel_launch: memset failed\n"); return; }
    Args a{};
    for (int i = 0; i < 37; ++i) a.in[i] = (const float*)d_in[i];
    a.out = (float*)d_out; a.ws = (unsigned char*)d_ws;
    hipLaunchKernelGGL(fwd_kernel, dim3(GRID), dim3(NTHR), LDS_BYTES, stream, a);
    const hipError_t le = hipPeekAtLastError();
    if (le != hipSuccess) fprintf(stderr, "kernel_launch: launch failed: %s\n", hipGetErrorName(le));
}
```

```cpp
#include <hip/hip_runtime.h>
#include <cstdio>
#include <cstdint>

#define GAS __attribute__((address_space(1)))
#define LAS __attribute__((address_space(3)))
typedef unsigned short bf16;
typedef unsigned v4u __attribute__((ext_vector_type(4)));
typedef unsigned v2u __attribute__((ext_vector_type(2)));
typedef float f32x4 __attribute__((ext_vector_type(4)));
typedef float f32x2 __attribute__((ext_vector_type(2)));
typedef short bf16x8 __attribute__((ext_vector_type(8)));
typedef short s16x4 __attribute__((ext_vector_type(4)));
#define RLX_AGENT __ATOMIC_RELAXED, __HIP_MEMORY_SCOPE_AGENT

constexpr int D = 1024, NB = 8, SEQ = 4096, CTX = 256, TPB = SEQ + CTX  , M = NB * TPB  ;
constexpr int NWAVES = 8, NTHR = 512, GRID = 256;
constexpr float EPS = 1e-6f;
constexpr float LOG2E = 1.4426950408889634f;

__device__ __forceinline__ unsigned f2bf(float f) { unsigned u = __builtin_bit_cast(unsigned, f); return (u + 0x7fffu + ((u >> 16) & 1u)) >> 16; }
__device__ __forceinline__ float bf2f(unsigned b) { return __builtin_bit_cast(float, b << 16); }
__device__ __forceinline__ float bflo(unsigned w) { return __builtin_bit_cast(float, w << 16); }
__device__ __forceinline__ float bfhi(unsigned w) { return __builtin_bit_cast(float, w & 0xffff0000u); }
typedef __bf16 nbf16x2 __attribute__((ext_vector_type(2)));
__device__ __forceinline__ unsigned cvt_pk_bf16(float lo, float hi) { const nbf16x2 r = __builtin_convertvector((f32x2){lo, hi}, nbf16x2); return __builtin_bit_cast(unsigned, r); }
__device__ __forceinline__ float fast_exp2(float x) { return __builtin_amdgcn_exp2f(x); }
__device__ __forceinline__ float fast_rcp(float x) { return __builtin_amdgcn_rcpf(x); }
__device__ __forceinline__ float silu_f(float x) { return x * fast_rcp(1.0f + fast_exp2(-x * LOG2E)); }
__device__ __forceinline__ float sigmoid_f(float x) { return fast_rcp(1.0f + fast_exp2(-x * LOG2E)); }
__device__ __forceinline__ float fast_log(float x) { return __builtin_amdgcn_logf(x) * 0.6931471805599453f; }
__device__ __forceinline__ float fast_exp(float x) { return __builtin_amdgcn_exp2f(x * LOG2E); }
__device__ __forceinline__ float softplus_f(float x) { if (x > 20.f) return x; const float e = fast_exp(x); return e < 0.01f ? e * (1.0f - e * (0.5f - e * (1.0f / 3.0f))) : fast_log(1.0f + e); }
__device__ __forceinline__ v4u pack8(const f32x4 a, const f32x4 b) { v4u w; w.x = cvt_pk_bf16(a[0], a[1]); w.y = cvt_pk_bf16(a[2], a[3]); w.z = cvt_pk_bf16(b[0], b[1]); w.w = cvt_pk_bf16(b[2], b[3]); return w; }
#define DPPF(old, src, ctrl, rm, bc) __builtin_bit_cast(float, __builtin_amdgcn_update_dpp(__builtin_bit_cast(int, (float)(old)), __builtin_bit_cast(int, (float)(src)), ctrl, rm, 0xF, bc))
__device__ __forceinline__ float xor32(float x) {
    const unsigned u = __builtin_bit_cast(unsigned, x);
    const auto r = __builtin_amdgcn_permlane32_swap(u, u, false, false);
    return __builtin_bit_cast(float, (threadIdx.x & 32u) ? r[0] : r[1]);
}
__device__ __forceinline__ float wave_scan_sum(float v) {
    v += DPPF(0.f, v, 0x111, 0xF, true); v += DPPF(0.f, v, 0x112, 0xF, true); v += DPPF(0.f, v, 0x114, 0xF, true); v += DPPF(0.f, v, 0x118, 0xF, true);
    v += DPPF(0.f, v, 0x142, 0xA, false); v += DPPF(0.f, v, 0x143, 0xC, false); return v;
}
__device__ __forceinline__ float wave_scan_max(float v) {
    v = fmaxf(v, DPPF(-3.0e38f, v, 0x111, 0xF, false)); v = fmaxf(v, DPPF(-3.0e38f, v, 0x112, 0xF, false)); v = fmaxf(v, DPPF(-3.0e38f, v, 0x114, 0xF, false)); v = fmaxf(v, DPPF(-3.0e38f, v, 0x118, 0xF, false));
    v = fmaxf(v, DPPF(-3.0e38f, v, 0x142, 0xA, false)); v = fmaxf(v, DPPF(-3.0e38f, v, 0x143, 0xC, false)); return v;
}
__device__ __forceinline__ float wave_sum(float v) {
    v += DPPF(0.f, v, 0xB1, 0xF, true); v += DPPF(0.f, v, 0x4E, 0xF, true); v += DPPF(0.f, v, 0x141, 0xF, true); v += DPPF(0.f, v, 0x140, 0xF, true);
    v += DPPF(0.f, v, 0x142, 0xA, false); v += DPPF(0.f, v, 0x143, 0xC, false);
    return __builtin_bit_cast(float, __builtin_amdgcn_readlane(__builtin_bit_cast(int, v), 63));
}
__device__ __forceinline__ int opaque_tid() { int t = threadIdx.x; asm volatile("" : "+v"(t)); return t; }
__device__ __forceinline__ float xrow_max(float v) {
    { auto r = __builtin_amdgcn_permlane16_swap(__builtin_bit_cast(unsigned, v), __builtin_bit_cast(unsigned, v), false, false); v = fmaxf(__builtin_bit_cast(float, r[0]), __builtin_bit_cast(float, r[1])); }
    { auto r = __builtin_amdgcn_permlane32_swap(__builtin_bit_cast(unsigned, v), __builtin_bit_cast(unsigned, v), false, false); v = fmaxf(__builtin_bit_cast(float, r[0]), __builtin_bit_cast(float, r[1])); }
    return v; }
__device__ __forceinline__ float xrow_sum(float v) {
    { auto r = __builtin_amdgcn_permlane16_swap(__builtin_bit_cast(unsigned, v), __builtin_bit_cast(unsigned, v), false, false); v = __builtin_bit_cast(float, r[0]) + __builtin_bit_cast(float, r[1]); }
    { auto r = __builtin_amdgcn_permlane32_swap(__builtin_bit_cast(unsigned, v), __builtin_bit_cast(unsigned, v), false, false); v = __builtin_bit_cast(float, r[0]) + __builtin_bit_cast(float, r[1]); }
    return v; }
#define LDS_WAIT() asm volatile("s_waitcnt lgkmcnt(0)" ::: "memory")
#define VM_WAIT() asm volatile("s_waitcnt vmcnt(0)" ::: "memory")

namespace pg8 {
constexpr int BM = 256, BK = 64, HALF = 128, HTB = HALF * BK * 2, STAGE_BYTES = 8 * HTB, NXCD = 8, WGM = 8;
__host__ __device__ __forceinline__ int lds_byte(int r, int c) { const int st = (r >> 4) * 2 + (c >> 5), rr = r & 15, cc = c & 31, ob = rr * 64 + cc * 2; return st * 1024 + (ob ^ (((ob >> 9) & 1) << 5)); }
__host__ __device__ __forceinline__ void stage_rc(int b, int& R, int& C) { const int st = b / 1024, sb = b % 1024, swz = sb ^ (((sb >> 9) & 1) << 5); R = (st >> 1) * 16 + swz / 64; C = (st & 1) * 32 + (swz % 64) / 2; }
__host__ __device__ __forceinline__ int perm32(int rho) { const int n = rho >> 4, i = rho & 15; return 8 * (i >> 2) + 4 * n + (i & 3); }

struct Unit { int pm, pn, aux; };
struct Gemm { const bf16* A; int K; int ldb; int ksplit; };

struct StaticOrder {
    static constexpr bool GATHER = false;
    int nM, nN, nwg, G, c; const bf16* Bt; int ldb; bool skipctx;
    __device__ void init(int M_, int N_, int G_, int c_, const bf16* Bt_, int ldb_, bool skipctx_ = false) { skipctx = skipctx_; nM = skipctx ? 128 : M_ / BM; nN = N_ / BM; nwg = nM * nN; G = G_; c = c_; Bt = Bt_; ldb = ldb_; }
    __device__ __forceinline__ bool next(int i, Unit& u) const {
        const long L = (long)i * G + c; if (L >= nwg) return false;
        int wgid = (int)L; { const int q = nwg / NXCD, r = nwg % NXCD, xcd = wgid % NXCD, off = wgid / NXCD; wgid = (xcd < r ? xcd * (q + 1) : r * (q + 1) + (xcd - r) * q) + off; }
        const int nig = WGM * nN, gid = wgid / nig, fm = gid * WGM; constexpr int gsz = WGM;
        u.pm = fm + ((wgid % nig) % gsz); u.pn = (wgid % nig) / gsz; u.aux = 0; if (skipctx) u.pm = (u.pm >> 4) * 17 + 1 + (u.pm & 15); return true;
    }
    __device__ __forceinline__ int a_row(const Unit& u, int r) const { return u.pm * BM + r; }
    __device__ __forceinline__ const char* b_seg(const Unit& u, int seg) const { return (const char*)(Bt + (size_t)u.pn * BM * ldb); }
};

template <class Epi, class Sched>
__device__ __forceinline__ void gemm_phase(LAS unsigned char* lds, const Gemm g, const Sched& S, const Epi& E) {
    const int tid = opaque_tid(), wid = __builtin_amdgcn_readfirstlane(tid >> 6), lane = tid & 63, wr = wid >> 2, wc = wid & 3, fr = lane & 15, fq = lane >> 4;
    const int K = g.K, nt = K / BK, ldb = g.ldb, ksplit = g.ksplit;
    int Rst[2], Cst[2]; unsigned voffB[2], voffA[2];
#pragma unroll
    for (int i = 0; i < 2; ++i) { int R, C; stage_rc(tid * 16 + i * 8192, R, C); const int Rb = Epi::PERM ? ((R & ~31) + perm32(R & 31)) : R; Rst[i] = R; Cst[i] = C;
        voffB[i] = (unsigned)(Rb * ldb + C) * 2u; voffA[i] = (unsigned)(R * K + C) * 2u; }
    const size_t hstepA = (size_t)HALF * K * 2;
    const size_t kstep = (size_t)(BK * 2);
    const size_t hstepB = (size_t)HALF * ldb * 2;
    const unsigned ldsw = (unsigned)wid * 1024u;
    const int aoff = lds_byte(wr * 64 + fr, fq * 8), boff = lds_byte(wc * 32 + fr, fq * 8);
#define PG8_SA(b, h) (((b) * 2 + (h)) * HTB)
#define PG8_SB(b, h) ((4 + (b) * 2 + (h)) * HTB)
#define PG8_STAGEB(bufoff, gbase) do { _Pragma("unroll") for (int _i = 0; _i < 2; ++_i) \
        __builtin_amdgcn_global_load_lds((const unsigned*)((const char*)(gbase) + voffB[_i]), (LAS unsigned*)(lds + (bufoff) + ldsw + _i * 8192), 16, 0, 0); } while (0)
#define PG8_STAGEA(bufoff, nextsel, h, kt) do { if constexpr (Sched::GATHER) { _Pragma("unroll") for (int _i = 0; _i < 2; ++_i) \
        __builtin_amdgcn_global_load_lds((const unsigned*)(gA + (size_t)(kt) * kstep + ((nextsel) ? vN[h][_i] : vA[h][_i])), (LAS unsigned*)(lds + (bufoff) + ldsw + _i * 8192), 16, 0, 0); } \
      else { const char* _ab = ((nextsel) ? nA : cA) + (size_t)(h) * hstepA + (size_t)(kt) * kstep; _Pragma("unroll") for (int _i = 0; _i < 2; ++_i) \
        __builtin_amdgcn_global_load_lds((const unsigned*)(_ab + voffA[_i]), (LAS unsigned*)(lds + (bufoff) + ldsw + _i * 8192), 16, 0, 0); } } while (0)
#define PG8_LDA(dst, b, h) do { _Pragma("unroll") for (int m = 0; m < 4; ++m) _Pragma("unroll") for (int k = 0; k < 2; ++k) dst[m][k] = *(const LAS bf16x8*)(lds + PG8_SA(b, h) + aoff + m * 2048 + k * 1024); } while (0)
#define PG8_LDB(dst, b, h) do { _Pragma("unroll") for (int n = 0; n < 2; ++n) _Pragma("unroll") for (int k = 0; k < 2; ++k) dst[n][k] = *(const LAS bf16x8*)(lds + PG8_SB(b, h) + boff + n * 2048 + k * 1024); } while (0)
#define PG8_MMA(ai, bj, At, Bt) do { __builtin_amdgcn_s_setprio(1); _Pragma("unroll") for (int m = 0; m < 4; ++m) _Pragma("unroll") for (int n = 0; n < 2; ++n) _Pragma("unroll") for (int k = 0; k < 2; ++k) \
        acc[ai][bj][m][n] = __builtin_amdgcn_mfma_f32_16x16x32_bf16(Bt[n][k], At[m][k], acc[ai][bj][m][n], 0, 0, 0); __builtin_amdgcn_s_setprio(0); } while (0)
#define PG8_WAIT_V(n) asm volatile("s_waitcnt vmcnt(" #n ")" ::: "memory")
#define PG8_WAIT_L(n) asm volatile("s_waitcnt lgkmcnt(" #n ")" ::: "memory")
#define PG8_BAR __builtin_amdgcn_s_barrier()
#define PG8_SCHED __builtin_amdgcn_sched_barrier(0)
#define PG8_AOFFS(dst, u) do { _Pragma("unroll") for (int _h = 0; _h < 2; ++_h) _Pragma("unroll") for (int _i = 0; _i < 2; ++_i) \
        dst[_h][_i] = (unsigned)S.a_row(u, _h * HALF + Rst[_i]) * (unsigned)(K * 2) + (unsigned)(Cst[_i] * 2); } while (0)
    Unit cur, nxt; int ui = 0;
    if (!S.next(0, cur)) return;
#if defined(GEMM_STAGGER)
    { const unsigned long long t0 = __builtin_amdgcn_s_memrealtime(); const unsigned long long dly = (unsigned long long)((blockIdx.x >> 3) & 3) * GEMM_STAGGER;
      while (__builtin_amdgcn_s_memrealtime() - t0 < dly) __builtin_amdgcn_s_sleep(2); }
#endif
    const char* const gA = (const char*)g.A;
    f32x4 acc[2][2][4][2];
#pragma unroll
    for (int a = 0; a < 2; ++a)
#pragma unroll
        for (int b = 0; b < 2; ++b)
#pragma unroll
            for (int m = 0; m < 4; ++m)
#pragma unroll
                for (int n = 0; n < 2; ++n) acc[a][b][m][n] = (f32x4){0.f, 0.f, 0.f, 0.f};
    bf16x8 At[4][2], B0[2][2], B1[2][2];
    unsigned vA[2][2], vN[2][2];
    const char* cA = gA; const char* nA = gA;
    if constexpr (Sched::GATHER) { PG8_AOFFS(vA, cur); } else { cA = gA + (size_t)S.a_row(cur, 0) * K * 2; }
    const char* cB0 = S.b_seg(cur, 0); const char* cB1 = S.b_seg(cur, 1);
    PG8_STAGEB(PG8_SB(0, 0), cB0); PG8_STAGEB(PG8_SB(0, 1), cB0 + hstepB); PG8_STAGEA(PG8_SA(0, 0), false, 0, 0); PG8_STAGEA(PG8_SA(0, 1), false, 1, 0);
    if (wr == 1) PG8_BAR;
    PG8_WAIT_V(2); PG8_BAR;
    PG8_STAGEB(PG8_SB(1, 0), cB0 + kstep); PG8_STAGEA(PG8_SA(1, 0), false, 0, 1); PG8_STAGEB(PG8_SB(1, 1), cB0 + hstepB + kstep);
    PG8_WAIT_V(6); PG8_BAR;
    for (;;) {
        const bool has_next = S.next(ui + 1, nxt);
        const char* nB0 = cB0;
        nA = cA;
        if (has_next) { nB0 = S.b_seg(nxt, 0); if constexpr (Sched::GATHER) { PG8_AOFFS(vN, nxt); } else { nA = gA + (size_t)S.a_row(nxt, 0) * K * 2; } }
        else { if constexpr (Sched::GATHER) {
#pragma unroll
            for (int h = 0; h < 2; ++h)
#pragma unroll
                for (int i = 0; i < 2; ++i) vN[h][i] = vA[h][i]; } }
#pragma unroll 1
        for (int t = 0; t < nt; t += 2) {
            const bool last = (t == nt - 2);
            const char* b2 = last ? nB0 : ((t + 2 < ksplit) ? cB0 + (size_t)(t + 2) * kstep : cB1 + (size_t)(t + 2 - ksplit) * kstep);
            const char* b3 = b2 + kstep;
            const int kt2 = last ? 0 : t + 2;
            PG8_LDB(B0, 0, 0); PG8_LDB(B1, 0, 1); PG8_SCHED; PG8_LDA(At, 0, 0); PG8_STAGEA(PG8_SA(1, 1), false, 1, t + 1);
            PG8_WAIT_V(8); PG8_WAIT_L(0); PG8_BAR; PG8_MMA(0, 0, At, B0); PG8_MMA(0, 1, At, B1); PG8_BAR; PG8_SCHED;
            PG8_LDA(At, 0, 1); PG8_STAGEB(PG8_SB(0, 0), b2); PG8_STAGEB(PG8_SB(0, 1), b2 + hstepB); PG8_STAGEA(PG8_SA(0, 0), last, 0, kt2);
            PG8_WAIT_V(8); PG8_WAIT_L(0); PG8_BAR; PG8_MMA(1, 0, At, B0); PG8_MMA(1, 1, At, B1); PG8_BAR; PG8_SCHED;
            PG8_LDB(B0, 1, 0); PG8_LDB(B1, 1, 1); PG8_SCHED; PG8_LDA(At, 1, 0); PG8_STAGEA(PG8_SA(0, 1), last, 1, kt2);
            PG8_WAIT_V(8); PG8_WAIT_L(0); PG8_BAR; PG8_MMA(0, 0, At, B0); PG8_MMA(0, 1, At, B1); PG8_BAR; PG8_SCHED;
            PG8_LDA(At, 1, 1); PG8_STAGEB(PG8_SB(1, 0), b3); PG8_STAGEB(PG8_SB(1, 1), b3 + hstepB); PG8_STAGEA(PG8_SA(1, 0), last, 0, kt2 + 1);
            PG8_WAIT_V(8); PG8_WAIT_L(0); PG8_BAR; PG8_MMA(1, 0, At, B0); PG8_MMA(1, 1, At, B1); PG8_BAR; PG8_SCHED;
        }
        if (wr == 0) PG8_BAR;
        { int tz = tid; asm volatile("" : "+v"(tz));
          const int lz = tz & 63; E(acc, cur, ui, wr, wc, lz & 15, lz >> 4); }
        if (!has_next) break;
#pragma unroll
        for (int a = 0; a < 2; ++a)
#pragma unroll
            for (int b = 0; b < 2; ++b)
#pragma unroll
                for (int m = 0; m < 4; ++m)
#pragma unroll
                    for (int n = 0; n < 2; ++n) acc[a][b][m][n] = (f32x4){0.f, 0.f, 0.f, 0.f};
        cur = nxt; cB0 = nB0; cB1 = S.b_seg(cur, 1); cA = nA; ++ui;
        if constexpr (Sched::GATHER) {
#pragma unroll
        for (int h = 0; h < 2; ++h)
#pragma unroll
            for (int i = 0; i < 2; ++i) vA[h][i] = vN[h][i]; }
        if (wr == 1) PG8_BAR;
    }
    PG8_WAIT_V(0);
    PG8_BAR;
#undef PG8_SA
#undef PG8_SB
#undef PG8_STAGEA
#undef PG8_STAGEB
#undef PG8_LDA
#undef PG8_LDB
#undef PG8_MMA
#undef PG8_WAIT_V
#undef PG8_WAIT_L
#undef PG8_BAR
#undef PG8_SCHED
#undef PG8_AOFFS
}
}
#define XB_TMO      128
#define XB_XCNT(j)  (256  + 64 * (j))
#define XB_XSUB(j)  (1280 + 64 * (j))
#define XB_XGEN(j)  (2304 + 64 * (j))
#define XB_TOP      3328
#define XB_TOPGEN   3392
#define XCD_BAR_WORDS 3456
#define XB_SPIN_CAP (1u << 22)
__device__ __forceinline__ unsigned xb_ld(unsigned* p)              { return __hip_atomic_load(p, __ATOMIC_RELAXED, __HIP_MEMORY_SCOPE_AGENT); }
__device__ __forceinline__ unsigned xb_add(unsigned* p, unsigned v) { return __hip_atomic_fetch_add(p, v, __ATOMIC_RELAXED, __HIP_MEMORY_SCOPE_AGENT); }
__device__ __forceinline__ unsigned xb_xcc_id() { return (unsigned)__builtin_amdgcn_s_getreg((3 << 11) | 20) & 0xFu; }
#define XB_SPIN(cond, bar) do { unsigned _sp = 0; while (cond) { __builtin_amdgcn_s_sleep(1); \
    if ((++_sp & 255u) == 0u) { if (xb_ld(&(bar)[XB_TMO])) break; if (_sp > XB_SPIN_CAP) { atomicAdd(&(bar)[XB_TMO], 1u); break; } } } } while (0)
struct XcdBarrier { unsigned* bar; unsigned x; volatile LAS unsigned* st; };
__device__ __forceinline__ XcdBarrier xcd_barrier_post(unsigned* bar, volatile LAS unsigned* st) {
    XcdBarrier b; b.bar = bar; b.x = xb_xcc_id(); b.st = st;
    if (threadIdx.x == 0) (void)xb_add(&bar[XB_XCNT(b.x)], 1u);
    return b;
}
__device__ __forceinline__ void xcd_barrier_complete(unsigned* bar, unsigned x, unsigned& nloc, unsigned& nx) {
    const unsigned G = gridDim.x * gridDim.y * gridDim.z;
    unsigned sum, cnt, mine, sp = 0u;
    for (;;) {
        sum = 0u; cnt = 0u; mine = 0u;
#pragma unroll
        for (unsigned j = 0; j < 16; ++j) { const unsigned c = xb_ld(&bar[XB_XCNT(j)]); sum += c; cnt += (c > 0u) ? 1u : 0u; mine = (j == x) ? c : mine; }
        if (sum == G) break;
        __builtin_amdgcn_s_sleep(1);
        if ((++sp & 255u) == 0u) { if (xb_ld(&bar[XB_TMO])) break; if (sp > XB_SPIN_CAP) { atomicAdd(&bar[XB_TMO], 1u); break; } }
    }
    nloc = mine > 0u ? mine : 1u; nx = cnt > 0u ? cnt : 1u;
}
__device__ __forceinline__ void xcd_barrier(const XcdBarrier& b) {
    asm volatile("s_waitcnt vmcnt(0)" ::: "memory");
    __syncthreads();
    if (threadIdx.x == 0) {
        unsigned* bar = b.bar;
        __builtin_amdgcn_s_waitcnt(0);
        unsigned nloc = b.st[0], nx = b.st[1];
        if (nloc == 0u) { xcd_barrier_complete(bar, b.x, nloc, nx); b.st[0] = nloc; b.st[1] = nx; }
        const unsigned old = xb_add(&bar[XB_XSUB(b.x)], 1u);
        const unsigned gen = old / nloc;
        if (old + 1u == (gen + 1u) * nloc) {
            __builtin_amdgcn_fence(__ATOMIC_RELEASE, "agent");
            asm volatile("s_waitcnt vmcnt(0)" ::: "memory");
            const unsigned og = xb_add(&bar[XB_TOP], 1u);
            const unsigned tg = og / nx;
            if (og + 1u == (tg + 1u) * nx) xb_add(&bar[XB_TOPGEN], 1u);
            else XB_SPIN(xb_ld(&bar[XB_TOPGEN]) == tg, bar);
            __builtin_amdgcn_fence(__ATOMIC_ACQUIRE, "agent");
            xb_add(&bar[XB_XGEN(b.x)], 1u);
            asm volatile("s_waitcnt vmcnt(0)" ::: "memory");
        } else {
            XB_SPIN(xb_ld(&bar[XB_XGEN(b.x)]) == gen, bar);
            __builtin_amdgcn_fence(__ATOMIC_ACQUIRE, "agent");
            asm volatile("s_waitcnt vmcnt(0)" ::: "memory");
        }
    }
    __syncthreads();
}

constexpr size_t MiB = 1u << 20;
constexpr size_t WS_CTL = 0, CTL_ZERO_BYTES = 1 * MiB;
constexpr size_t WS_MOD = 1 * MiB;
constexpr size_t WS_TABA = 2 * MiB;
constexpr size_t WS_TABM = 3 * MiB;
constexpr size_t WS_WGU = 4 * MiB;
constexpr size_t WS_WDN = 20 * MiB;
constexpr size_t WS_WMIX = 28 * MiB;
constexpr size_t WS_X = 52 * MiB;
constexpr size_t WS_W1 = 116 * MiB;
__device__ __forceinline__ size_t wofs(int layer) { return (layer & 1) ? WS_W1 : 0; }
constexpr size_t WS_H = 188 * MiB;
constexpr size_t WS_SCR = 256 * MiB;
constexpr size_t WS_END = 512 * MiB;
constexpr size_t MOE_ACT = WS_SCR;
constexpr size_t MOE_SL = WS_SCR + 48 * MiB;
constexpr size_t MOE_WT = WS_SCR + 52 * MiB;
constexpr int CW_BAR = 4096;
constexpr int CW_MOECNT = 16384;
constexpr int CW_POISON = 20000;

constexpr int RING_BYTES = 131072;
constexpr int LDS_MISC = RING_BYTES;
constexpr int LDS_TB = RING_BYTES + 512;
constexpr int LDS_TBL = RING_BYTES + 1024;
constexpr int LDS_BYTES = RING_BYTES + 1024 + 16384;

struct Frame {
    LAS unsigned char* lds;
    unsigned* ctl;
    unsigned char* ws;
    float* out;
    int tid, lane, wave, vcu;
};

__device__ __forceinline__ void refresh(Frame& F) { F.tid = opaque_tid(); F.lane = F.tid & 63; F.wave = __builtin_amdgcn_readfirstlane(F.tid >> 6); }
#if defined(PROBE_BAR2)
#define SYNC_GRID() do { xcd_barrier(bar); xcd_barrier(bar); refresh(F); } while (0)
#else
#define SYNC_GRID() do { xcd_barrier(bar); refresh(F); } while (0)
#endif
__device__ __forceinline__ int modrow_of(int row) { const int b = row / TPB, t = row - b * TPB; return t < CTX ? 8 : b; }

enum { MAP_ID = 0, MAP_ATTN_IN, MAP_SSM_IN, MAP_MLA_IN, MAP_MLA_QUP, MAP_MOE_G, MAP_MOE_U };
template <int KIND> __device__ __forceinline__ int map_row(int n, int aux) {
    if (KIND == MAP_ID) return aux + n;
    if (KIND == MAP_ATTN_IN) { if (n >= 1280) return n; const int hb = n & ~63, d = n & 63; return hb + (d < 32 ? 2 * d : 2 * (d - 32) + 1); }
    if (KIND == MAP_SSM_IN) {
        if (n < 2048) { const int gp = n >> 10; return gp * 2816 + (n & 1023); }
        if (n < 4096) { const int c = n - 2048, gp = c >> 10; return gp * 2816 + 1024 + (c & 1023); }
        if (n < 4608) { const int c = n - 4096, gp = c >> 8; return gp * 2816 + 2048 + (c & 255); }
        if (n < 5120) { const int c = n - 4608, gp = c >> 8; return gp * 2816 + 2304 + (c & 255); }
        { const int c = n - 5120, dir = c >> 5, h = c & 31, gp = h >> 4; return gp * 2816 + 2560 + dir * 16 + (h & 15); }
    }
    if (KIND == MAP_MLA_IN) { if (n < 512) return n; const int d = n - 512; return 512 + (d < 16 ? 2 * d : 2 * (d - 16) + 1); }
    if (KIND == MAP_MLA_QUP) { const int h = n / 96, e = n - h * 96; if (e < 64) return n; const int d = e - 64; return h * 96 + 64 + (d < 16 ? 2 * d : 2 * (d - 16) + 1); }
    if (KIND == MAP_MOE_G) return aux + (n >> 7) * 256 + (n & 127);
    if (KIND == MAP_MOE_U) return aux + (n >> 7) * 256 + 128 + (n & 127);
    return n;
}
template <int KIND>
__device__ __forceinline__ void transpose_item(const float* W, int K, int N, bf16* WT, int aux, const float* kscale, LAS float* scr, int item, int lane) {
    const int nblk = N / 32, kb = item / nblk, nb = item % nblk, k0 = 64 * kb, n0 = 32 * nb;
#pragma unroll 8
    for (int i = 0; i < 32; ++i) { const int kk = 2 * i + (lane >> 5); float v = W[(size_t)(k0 + kk) * N + n0 + (lane & 31)]; if (kscale) v *= kscale[k0 + kk]; scr[kk * 33 + (lane & 31)] = v; }
    LDS_WAIT(); asm volatile("" ::: "memory");
    const int c = lane & 7;
#pragma unroll
    for (int j = 0; j < 4; ++j) { const int n = (lane >> 3) + 8 * j; const LAS float* s = scr + (8 * c) * 33 + n;
        v4u o; o.x = cvt_pk_bf16(s[0 * 33], s[1 * 33]); o.y = cvt_pk_bf16(s[2 * 33], s[3 * 33]); o.z = cvt_pk_bf16(s[4 * 33], s[5 * 33]); o.w = cvt_pk_bf16(s[6 * 33], s[7 * 33]);
        *(v4u*)(WT + (size_t)map_row<KIND>(n0 + n, aux) * K + k0 + 8 * c) = o; }
    LDS_WAIT(); asm volatile("" ::: "memory");
}
struct ConvGrid { int gw, ngw; };
__device__ __forceinline__ ConvGrid conv_all(Frame& F) { ConvGrid g; g.gw = F.vcu * NWAVES + F.wave; g.ngw = GRID * NWAVES; return g; }
template <int KIND>
__device__ __forceinline__ void convert_matrix(Frame& F, ConvGrid cg, const float* W, int K, int N, bf16* WT, int aux, const float* kscale) {
    LAS float* scr = (LAS float*)(F.lds + F.wave * 16384);
    const int nitems = (K / 64) * (N / 32);
    for (int it = cg.gw; it < nitems; it += cg.ngw) transpose_item<KIND>(W, K, N, WT, aux, kscale, scr, it, F.lane);
}
__device__ __forceinline__ void zero_rows(Frame& F, ConvGrid cg, bf16* WT, int row0, int nrows, int K) {
    const size_t n16 = (size_t)nrows * K / 8; v4u* p = (v4u*)(WT + (size_t)row0 * K);
    for (size_t i = (size_t)cg.gw * 64 + F.lane; i < n16; i += (size_t)cg.ngw * 64) p[i] = (v4u){0u, 0u, 0u, 0u};
}
__device__ __forceinline__ void convert_moe(Frame& F, ConvGrid cg, const float* const* in, int layer) {
    bf16* GU = (bf16*)(F.ws + WS_WGU + wofs(layer)); bf16* DN = (bf16*)(F.ws + WS_WDN + wofs(layer));
    const float* wg = in[12] + (size_t)layer * 16 * 1024 * 256; const float* wu = in[13] + (size_t)layer * 16 * 1024 * 256; const float* wd = in[14] + (size_t)layer * 16 * 256 * 1024;
    LAS float* scr = (LAS float*)(F.lds + F.wave * 16384);
    for (int it = cg.gw; it < 16 * 384; it += cg.ngw) { const int e = it / 384, r = it - e * 384, kind = r >> 7, sub = r & 127;
        if (kind == 0) transpose_item<MAP_MOE_G>(wg + (size_t)e * 1024 * 256, 1024, 256, GU, e * 512, nullptr, scr, sub, F.lane);
        else if (kind == 1) transpose_item<MAP_MOE_U>(wu + (size_t)e * 1024 * 256, 1024, 256, GU, e * 512, nullptr, scr, sub, F.lane);
        else transpose_item<MAP_ID>(wd + (size_t)e * 256 * 1024, 256, 1024, DN, e * 1024, nullptr, scr, sub, F.lane); }
}
__device__ __forceinline__ void convert_layer(Frame& F, ConvGrid cg, const float* const* in, int layer) {
    bf16* WM = (bf16*)(F.ws + WS_WMIX + wofs(layer));
    if (layer == 0) { convert_matrix<MAP_ATTN_IN>(F, cg, in[15], 1024, 1536, WM, 0, nullptr); convert_matrix<MAP_ID>(F, cg, in[17], 1024, 1024, WM + 2 * MiB, 0, nullptr); }
    else if (layer == 1) { convert_matrix<MAP_SSM_IN>(F, cg, in[18], 1024, 5184, WM, 0, nullptr); zero_rows(F, cg, WM, 2592, 224, 1024); zero_rows(F, cg, WM, 2816 + 2592, 224, 1024);
        convert_matrix<MAP_ID>(F, cg, in[25], 2048, 1024, WM + 6 * MiB, 0, nullptr); }
    else if (layer == 2) { convert_matrix<MAP_ID>(F, cg, in[26], 1024, 3104, WM, 0, nullptr); zero_rows(F, cg, WM, 3104, 224, 1024); convert_matrix<MAP_ID>(F, cg, in[29], 1024, 1024, WM + 4 * MiB, 0, nullptr); }
    else { convert_matrix<MAP_MLA_IN>(F, cg, in[30], 1024, 544, WM, 0, nullptr); zero_rows(F, cg, WM, 544, 224, 1024);
        convert_matrix<MAP_MLA_QUP>(F, cg, in[32], 256, 1536, WM + 1 * MiB, 0, in[31]); convert_matrix<MAP_ID>(F, cg, in[34], 256, 2048, WM + 2 * MiB, 0, in[33]);
        convert_matrix<MAP_ID>(F, cg, in[35], 1024, 1024, WM + 3 * MiB, 0, nullptr); }
    convert_moe(F, cg, in, layer);
}

__device__ __forceinline__ const float* src_row(const float* const* in, int r) { const int b = r / TPB, t = r - b * TPB; return t < CTX ? in[2] + ((size_t)b * CTX + t) * D : in[0] + ((size_t)b * SEQ + (t - CTX)) * D; }
__device__ __forceinline__ float row_load_ss(const bf16* xrow, int lane, f32x4 (&v)[4]) {
    const v4u a = *((const v4u*)xrow + lane), b = *((const v4u*)xrow + 64 + lane);
    v[0] = (f32x4){bflo(a.x), bfhi(a.x), bflo(a.y), bfhi(a.y)}; v[1] = (f32x4){bflo(a.z), bfhi(a.z), bflo(a.w), bfhi(a.w)};
    v[2] = (f32x4){bflo(b.x), bfhi(b.x), bflo(b.y), bfhi(b.y)}; v[3] = (f32x4){bflo(b.z), bfhi(b.z), bflo(b.w), bfhi(b.w)};
    float s = 0.f;
#pragma unroll
    for (int j = 0; j < 4; ++j) s += (v[j].x * v[j].x + v[j].y * v[j].y) + (v[j].z * v[j].z + v[j].w * v[j].w);
    return s;
}
__device__ __forceinline__ float row_load_ss_f32(const float* xrow, int lane, f32x4 (&v)[4]) {
    float s = 0.f;
#pragma unroll
    for (int j = 0; j < 2; ++j) { v[2 * j] = *(const f32x4*)(xrow + 512 * j + 8 * lane); v[2 * j + 1] = *(const f32x4*)(xrow + 512 * j + 8 * lane + 4); }
#pragma unroll
    for (int j = 0; j < 4; ++j) s += (v[j].x * v[j].x + v[j].y * v[j].y) + (v[j].z * v[j].z + v[j].w * v[j].w);
    return s;
}
__device__ __forceinline__ void row_finish(const f32x4 (&v)[4], float ss, const float* g, const float* sc, const float* sh, bf16* orow, int lane, f32x4 (&hv)[4]) {
    const float rstd = rsqrtf(ss * (1.f / D) + EPS);
#pragma unroll
    for (int j = 0; j < 2; ++j) {
#pragma unroll
        for (int q = 0; q < 2; ++q) { const int o = 512 * j + 8 * lane + 4 * q;
            hv[2 * j + q] = v[2 * j + q] * rstd * *(const f32x4*)(g + o) * (*(const f32x4*)(sc + o) + 1.0f) + *(const f32x4*)(sh + o); }
        *((v4u*)orow + 64 * j + lane) = pack8(hv[2 * j], hv[2 * j + 1]);
    }
}
struct ModRegs { f32x4 a[4], b[4]; };
__device__ __forceinline__ void mod_load(ModRegs& Mr, const float* g, const float* sc, const float* sh, int lane) {
#pragma unroll
    for (int j = 0; j < 4; ++j) { const int o = 512 * (j >> 1) + 8 * lane + 4 * (j & 1); Mr.a[j] = *(const f32x4*)(g + o) * (*(const f32x4*)(sc + o) + 1.0f); Mr.b[j] = *(const f32x4*)(sh + o); }
}
__device__ __forceinline__ void row_finish_regs(const f32x4 (&v)[4], float ss, const ModRegs& Mr, bf16* orow, int lane, f32x4 (&hv)[4]) {
    const float rstd = rsqrtf(ss * (1.f / D) + EPS);
#pragma unroll
    for (int j = 0; j < 4; ++j) hv[j] = v[j] * rstd * Mr.a[j] + Mr.b[j];
    *((v4u*)orow + lane) = pack8(hv[0], hv[1]); *((v4u*)orow + 64 + lane) = pack8(hv[2], hv[3]);
}
__device__ __forceinline__ void phase_norm1(Frame& F, const float* const* in, int layer) {
    const bf16* X = (const bf16*)(F.ws + WS_X); bf16* H = (bf16*)(F.ws + WS_H);
    const float* g = in[4] + layer * D; const float* mod = (const float*)(F.ws + WS_MOD) + (size_t)layer * 9 * 6144;
    const int gw = F.vcu * NWAVES + F.wave; constexpr int RPWV = M / (GRID * NWAVES);
    const int rbase = gw * RPWV; int cur = -1; ModRegs Mr;
    for (int k0 = 0; k0 < RPWV; k0 += 4) { f32x4 v[4][4], hv[4]; float ss[4]; int rr[4];
#pragma unroll
        for (int q = 0; q < 4; ++q) { rr[q] = (k0 + q < RPWV) ? rbase + k0 + q : rbase + k0; ss[q] = layer == 0 ? row_load_ss_f32(src_row(in, rr[q]), F.lane, v[q]) : row_load_ss(X + (size_t)rr[q] * D, F.lane, v[q]); }
#pragma unroll
        for (int q = 0; q < 4; ++q) ss[q] = wave_sum(ss[q]);
#pragma unroll
        for (int q = 0; q < 4; ++q) { if (q == 0 || k0 + q < RPWV) { const int mr = modrow_of(rr[q]);
                if (mr != cur) { cur = mr; const float* mp = mod + (size_t)mr * 6144; mod_load(Mr, g, mp + 1024, mp, F.lane); }
                row_finish_regs(v[q], ss[q], Mr, H + (size_t)rr[q] * D, F.lane, hv); } } }
}

__device__ __forceinline__ void phase_mod(Frame& F, const float* const* in, const int l0, const int l1, const int u0, const int ustride) {
    LAS float* sc = (LAS float*)F.lds;
    LAS float* part = (LAS float*)(F.lds + 40960);
    for (int i = F.tid; i < 9 * 1024; i += NTHR) { const int r = i >> 10, k = i & 1023; const float c = r < 8 ? in[1][r * 1024 + k] : in[3][k]; sc[i] = silu_f(c); }
    __syncthreads();
    float* MOD = (float*)(F.ws + WS_MOD);
    const int cq = F.tid & 15, ks = F.tid >> 4;
    for (int u = u0; u < (l1 - l0) * 96; u += ustride) { const int l = l0 + u / 96, cb = u % 96;
        const float* w = in[6] + (size_t)l * 1024 * 6144 + cb * 64 + cq * 4; f32x4 a[9];
#pragma unroll
        for (int r = 0; r < 9; ++r) a[r] = (f32x4){0.f, 0.f, 0.f, 0.f};
#pragma unroll 8
        for (int k = ks * 32; k < ks * 32 + 32; ++k) { const f32x4 wv = *(const f32x4*)(w + (size_t)k * 6144);
#pragma unroll
            for (int r = 0; r < 9; ++r) a[r] = a[r] + wv * sc[r * 1024 + k]; }
#pragma unroll
        for (int r = 0; r < 9; ++r) *(LAS f32x4*)(part + (ks * 9 + r) * 64 + cq * 4) = a[r];
        __syncthreads();
        for (int i = F.tid; i < 9 * 64; i += NTHR) { const int r = i >> 6, c = i & 63; float s = 0.f;
#pragma unroll
            for (int q = 0; q < 32; ++q) s += part[(q * 9 + r) * 64 + c];
            MOD[((size_t)l * 9 + r) * 6144 + cb * 64 + c] = s + in[7][l * 6144 + cb * 64 + c]; }
        __syncthreads(); }
}
__device__ __forceinline__ void phase_prologue(Frame& F, const float* const* in) {
    { f32x2* TA = (f32x2*)(F.ws + WS_TABA); f32x2* TM = (f32x2*)(F.ws + WS_TABM);
      for (int i = blockIdx.x * NTHR + F.tid; i < SEQ * 32; i += GRID * NTHR) { const int pos = i >> 5, a = i & 31; const float p = (a < 16) ? (float)(pos >> 6) : (float)(pos & 63);
          const float inv = fast_exp2(-(float)(a & 15) * (13.287712379549449f / 16.0f)); const float rev = p * inv * 0.15915494309189535f; TA[i] = (f32x2){__builtin_amdgcn_cosf(rev), __builtin_amdgcn_sinf(rev)}; }
      for (int i = blockIdx.x * NTHR + F.tid; i < SEQ * 16; i += GRID * NTHR) { const int pos = i >> 4, a = i & 15; const float p = (a < 8) ? (float)(pos >> 6) : (float)(pos & 63);
          const float inv = fast_exp2(-(float)(a & 7) * (13.287712379549449f / 8.0f)); const float rev = p * inv * 0.15915494309189535f; TM[i] = (f32x2){__builtin_amdgcn_cosf(rev), __builtin_amdgcn_sinf(rev)}; } }
    phase_mod(F, in, 0, 1, F.vcu, GRID);
}

__device__ __forceinline__ void phase_norm2_route(Frame& F, const float* const* in, int layer, bool dry = false) {
    constexpr int RPW = M / GRID;
    LAS float* wl = (LAS float*)F.lds;
    LAS int* lcnt = (LAS int*)(F.lds + 81920);
    LAS int* lbase = (LAS int*)(F.lds + 81920 + 128);
    LAS int* rcls = (LAS int*)(F.lds + 81920 + 256);
    LAS int* rrank = (LAS int*)(F.lds + 81920 + 256 + 1024);
    LAS float* lgw = (LAS float*)(F.lds + 81920 + 4096);
    const float* wrg = in[8] + (size_t)layer * 1024 * 4; const float* wre = in[10] + (size_t)layer * 1024 * 16;
#pragma unroll
    for (int m = 0; m < 2; ++m) { const int k = F.tid + NTHR * m; const f32x4 w = *(const f32x4*)(wrg + k * 4);
        wl[0 * 1024 + k] = w.x; wl[1 * 1024 + k] = w.y; wl[2 * 1024 + k] = w.z; wl[3 * 1024 + k] = w.w; }
#pragma unroll
    for (int o4 = 0; o4 < 4; ++o4)
#pragma unroll
        for (int m = 0; m < 2; ++m) { const int k = F.tid + NTHR * m; const f32x4 w = *(const f32x4*)(wre + k * 16 + 4 * o4);
            wl[(4 + 4 * o4 + 0) * 1024 + k] = w.x; wl[(4 + 4 * o4 + 1) * 1024 + k] = w.y; wl[(4 + 4 * o4 + 2) * 1024 + k] = w.z; wl[(4 + 4 * o4 + 3) * 1024 + k] = w.w; }
    LAS float* rbias = (LAS float*)(F.lds + 81920 + 8192);
    if (F.tid < 24) lcnt[F.tid] = 0;
    if (F.tid < 4) rbias[F.tid] = (in[9] + layer * 4)[F.tid]; else if (F.tid < 20) rbias[F.tid] = (in[11] + layer * 16)[F.tid - 4];
    __syncthreads();
    const bf16* X = (const bf16*)(F.ws + WS_X); bf16* H = (bf16*)(F.ws + WS_H);
    const float* g = in[5] + layer * D; const float* mod = (const float*)(F.ws + WS_MOD) + (size_t)layer * 9 * 6144;
    float* WT = (float*)(F.ws + MOE_WT); int* SL = (int*)(F.ws + MOE_SL);
    const int row0 = blockIdx.x * RPW; int curm = -1; ModRegs Mr;
    for (int i0 = F.wave; i0 < RPW; i0 += 2 * NWAVES) { const int i1 = i0 + NWAVES; const bool two = i1 < RPW; const int ra = row0 + i0, rb = two ? row0 + i1 : ra;
        f32x4 va[4], vb[4], ha[4], hb[4];
        float sa = row_load_ss(X + (size_t)ra * D, F.lane, va), sb = row_load_ss(X + (size_t)rb * D, F.lane, vb);
        sa = wave_sum(sa); sb = wave_sum(sb);
        { const int mra = modrow_of(ra); if (mra != curm) { curm = mra; const float* mp = mod + (size_t)mra * 6144; mod_load(Mr, g, mp + 4 * 1024, mp + 3 * 1024, F.lane); }
          row_finish_regs(va, sa, Mr, H + (size_t)ra * D, F.lane, ha); }
        { const int mrb = modrow_of(rb); if (mrb != curm) { curm = mrb; const float* mp = mod + (size_t)mrb * 6144; mod_load(Mr, g, mp + 4 * 1024, mp + 3 * 1024, F.lane); }
          row_finish_regs(vb, sb, Mr, H + (size_t)rb * D, F.lane, hb); }
        float ga[4], gb[4];
#pragma unroll
        for (int o = 0; o < 4; ++o) { float s = 0.f, t = 0.f;
#pragma unroll
            for (int j = 0; j < 4; ++j) { const f32x4 w = *(const LAS f32x4*)(wl + o * 1024 + 512 * (j >> 1) + 8 * F.lane + 4 * (j & 1));
                s += (ha[j].x * w.x + ha[j].y * w.y) + (ha[j].z * w.z + ha[j].w * w.w); t += (hb[j].x * w.x + hb[j].y * w.y) + (hb[j].z * w.z + hb[j].w * w.w); }
            ga[o] = wave_sum(s) + rbias[o]; gb[o] = wave_sum(t) + rbias[o]; }
        for (int q = 0; q < (two ? 2 : 1); ++q) { const int r = q ? rb : ra, i = q ? i1 : i0;
        const float g0 = q ? gb[0] : ga[0], g1 = q ? gb[1] : ga[1], g2 = q ? gb[2] : ga[2], g3 = q ? gb[3] : ga[3];
        int gs = 0; float gm = g0; if (g1 > gm) { gm = g1; gs = 1; } if (g2 > gm) { gm = g2; gs = 2; } if (g3 > gm) { gm = g3; gs = 3; }
        const float pg = 1.0f / (fast_exp(g0 - gm) + fast_exp(g1 - gm) + fast_exp(g2 - gm) + fast_exp(g3 - gm));
        float ev[4];
#pragma unroll
        for (int o = 0; o < 4; ++o) { float s = 0.f; const LAS float* wrow = wl + (4 + gs * 4 + o) * 1024;
#pragma unroll
            for (int j = 0; j < 4; ++j) { const f32x4 w = *(const LAS f32x4*)(wrow + 512 * (j >> 1) + 8 * F.lane + 4 * (j & 1)); const f32x4 hq = q ? hb[j] : ha[j];
                s += (hq.x * w.x + hq.y * w.y) + (hq.z * w.z + hq.w * w.w); }
            ev[o] = wave_sum(s) + rbias[4 + gs * 4 + o]; }
        const float e0 = ev[0], e1 = ev[1], e2 = ev[2], e3 = ev[3];
        int i1x = 0; float v1 = e0; if (e1 > v1) { v1 = e1; i1x = 1; } if (e2 > v1) { v1 = e2; i1x = 2; } if (e3 > v1) { v1 = e3; i1x = 3; }
        int i2x = -1; float v2 = -3.0e38f;
        if (i1x != 0 && e0 > v2) { v2 = e0; i2x = 0; } if (i1x != 1 && e1 > v2) { v2 = e1; i2x = 1; } if (i1x != 2 && e2 > v2) { v2 = e2; i2x = 2; } if (i1x != 3 && e3 > v2) { v2 = e3; i2x = 3; }
        const float ex = fast_exp(v2 - v1), w1 = pg / (1.0f + ex), w2 = pg * ex / (1.0f + ex);
        const int lo = i1x < i2x ? i1x : i2x, hi = i1x < i2x ? i2x : i1x; const float wlo = i1x < i2x ? w1 : w2, whi = i1x < i2x ? w2 : w1;
        const int pair = lo == 0 ? hi - 1 : (lo == 1 ? hi + 1 : 5);
        const int cls = gs * 6 + pair;
        if (F.lane == 0 && !dry) { WT[2 * (size_t)r] = wlo; WT[2 * (size_t)r + 1] = whi; rcls[i] = cls; rrank[i] = atomicAdd((int*)&lcnt[cls], 1); }
        }
        LDS_WAIT(); asm volatile("" ::: "memory");
    }
    __syncthreads();
    if (dry) return;
    if (F.tid < 24) lbase[F.tid] = (int)atomicAdd(F.ctl + CW_MOECNT + layer * 64 + F.tid, (unsigned)lcnt[F.tid]);
    __syncthreads();
    for (int i = F.tid; i < RPW; i += NTHR) { const int c = rcls[i]; SL[(size_t)c * M + lbase[c] + rrank[i]] = row0 + i; }
}

__device__ __forceinline__ void phase_final(Frame& F, const float* const* in, bool poison) {
    const bf16* X = (const bf16*)(F.ws + WS_X); const float* g = in[36];
    const int gw = F.vcu * NWAVES + F.wave, NGW = GRID * NWAVES;
    f32x4 gg[4];
#pragma unroll
    for (int j = 0; j < 4; ++j) gg[j] = *(const f32x4*)(g + 512 * (j >> 1) + 8 * F.lane + 4 * (j & 1));
    for (int q0 = gw; q0 < NB * SEQ; q0 += 4 * NGW) { f32x4 v[4][4]; float ss[4];
#pragma unroll
        for (int k = 0; k < 4; ++k) { const int q = q0 + k * NGW; ss[k] = row_load_ss(X + (size_t)((q / SEQ) * TPB + CTX + (q % SEQ)) * D, F.lane, v[k]); }
#pragma unroll
        for (int k = 0; k < 4; ++k) ss[k] = wave_sum(ss[k]);
#pragma unroll
        for (int k = 0; k < 4; ++k) { float rs = rsqrtf(ss[k] * (1.f / D) + EPS); if (poison) rs = __builtin_nanf(""); float* op = F.out + (size_t)(q0 + k * NGW) * D;
#pragma unroll
            for (int j = 0; j < 4; ++j) { const int o = 512 * (j >> 1) + 8 * F.lane + 4 * (j & 1); *(f32x4*)(op + o) = v[k][j] * rs * gg[j]; } } }
}
typedef f32x4 AccT[2][2][4][2];
using pg8::Unit;

__device__ __forceinline__ void rope8c(f32x4& a, f32x4& b, const f32x4 c01, const f32x4 c23) {
    float t;
    t = a[0] * c01[0] - a[1] * c01[1]; a[1] = a[1] * c01[0] + a[0] * c01[1]; a[0] = t;
    t = a[2] * c01[2] - a[3] * c01[3]; a[3] = a[3] * c01[2] + a[2] * c01[3]; a[2] = t;
    t = b[0] * c23[0] - b[1] * c23[1]; b[1] = b[1] * c23[0] + b[0] * c23[1]; b[0] = t;
    t = b[2] * c23[2] - b[3] * c23[3]; b[3] = b[3] * c23[2] + b[2] * c23[3]; b[2] = t;
}
__device__ __forceinline__ void rope8(f32x4& a, f32x4& b, const f32x2* cs) {
    const f32x4 c01 = *(const f32x4*)cs, c23 = *(const f32x4*)(cs + 2);
    float t;
    t = a[0] * c01[0] - a[1] * c01[1]; a[1] = a[1] * c01[0] + a[0] * c01[1]; a[0] = t;
    t = a[2] * c01[2] - a[3] * c01[3]; a[3] = a[3] * c01[2] + a[2] * c01[3]; a[2] = t;
    t = b[0] * c23[0] - b[1] * c23[1]; b[1] = b[1] * c23[0] + b[0] * c23[1]; b[0] = t;
    t = b[2] * c23[2] - b[3] * c23[3]; b[3] = b[3] * c23[2] + b[2] * c23[3]; b[2] = t;
}

__device__ __forceinline__ void unpack8(const v4u w, f32x4& a, f32x4& b) { a = (f32x4){bflo(w.x), bfhi(w.x), bflo(w.y), bfhi(w.y)}; b = (f32x4){bflo(w.z), bfhi(w.z), bflo(w.w), bfhi(w.w)}; }
struct EpiResid {
    static constexpr bool PERM = true;
    bf16* X; const float* gate; const float* x_in; const float* ctx_in;
    __device__ __forceinline__ void operator()(const AccT& acc, const Unit& u, int ui, int wr, int wc, int fr, int fq) const {
        const int tb = u.pm % 17, b = u.pm / 17; const float* gv = gate + (size_t)(tb == 0 ? 8 : b) * 6144;
        const float* src = x_in ? (tb == 0 ? ctx_in + (size_t)b * CTX * D : x_in + ((size_t)b * SEQ + (tb - 1) * 256) * D) : nullptr;
        const int rl0 = wr * 64 + fr, col0 = u.pn * 256 + wc * 32 + 8 * fq;
        f32x4 g4[2][2];
#pragma unroll
        for (int bj = 0; bj < 2; ++bj)
#pragma unroll
            for (int n = 0; n < 2; ++n) g4[bj][n] = *(const f32x4*)(gv + col0 + bj * 128 + n * 4);
        if (!src) {
            v4u raw[2][2][2][2];
#pragma unroll
            for (int ai = 0; ai < 2; ++ai)
#pragma unroll
                for (int mp = 0; mp < 2; ++mp)
#pragma unroll
                    for (int mm = 0; mm < 2; ++mm) { const int rl = rl0 + ai * 128 + (2 * mp + mm) * 16;
#pragma unroll
                        for (int bj = 0; bj < 2; ++bj) raw[ai][mp][mm][bj] = *(const v4u*)(X + ((size_t)u.pm * 256 + rl) * D + col0 + bj * 128); }
#pragma unroll
            for (int ai = 0; ai < 2; ++ai)
#pragma unroll
                for (int mp = 0; mp < 2; ++mp) {
#pragma unroll
                    for (int mm = 0; mm < 2; ++mm) { const int rl = rl0 + ai * 128 + (2 * mp + mm) * 16;
#pragma unroll
                        for (int bj = 0; bj < 2; ++bj) { f32x4 x0, x1; unpack8(raw[ai][mp][mm][bj], x0, x1);
                            *(v4u*)(X + ((size_t)u.pm * 256 + rl) * D + col0 + bj * 128) = pack8(x0 + g4[bj][0] * acc[ai][bj][2 * mp + mm][0], x1 + g4[bj][1] * acc[ai][bj][2 * mp + mm][1]); } }
                    asm volatile("" ::: "memory"); }
            return; }
#pragma unroll
        for (int ai = 0; ai < 2; ++ai) { f32x4 xin[2][2][2][2];
#pragma unroll
            for (int mp = 0; mp < 2; ++mp)
#pragma unroll
                for (int mm = 0; mm < 2; ++mm) { const int rl = rl0 + ai * 128 + (2 * mp + mm) * 16;
#pragma unroll
                    for (int bj = 0; bj < 2; ++bj) { const float* sp = src + (size_t)rl * D + col0 + bj * 128; xin[mp][mm][bj][0] = *(const f32x4*)sp; xin[mp][mm][bj][1] = *(const f32x4*)(sp + 4); } }
#pragma unroll
            for (int mp = 0; mp < 2; ++mp) {
#pragma unroll
                for (int mm = 0; mm < 2; ++mm) { const int rl = rl0 + ai * 128 + (2 * mp + mm) * 16;
#pragma unroll
                    for (int bj = 0; bj < 2; ++bj) *(v4u*)(X + ((size_t)u.pm * 256 + rl) * D + col0 + bj * 128) =
                        pack8(xin[mp][mm][bj][0] + g4[bj][0] * acc[ai][bj][2 * mp + mm][0], xin[mp][mm][bj][1] + g4[bj][1] * acc[ai][bj][2 * mp + mm][1]); }
                asm volatile("" ::: "memory"); } }
    }
};

struct EpiAttnIn {
    static constexpr bool PERM = true;
    bf16 *Q, *Kb, *Vb; const f32x2* tab; float qscale;
    __device__ __forceinline__ void operator()(const AccT& acc, const Unit& u, int ui, int wr, int wc, int fr, int fq) const {
        const int tb = u.pm % 17; const bool lat = tb != 0; const int pos0 = (tb - 1) * 256;
        bf16* base; int ld, colt; float sc = 1.f; bool rope = lat;
        if (u.pn < 4) { base = Q; ld = 1024; colt = u.pn * 256; sc = qscale; } else if (u.pn == 4) { base = Kb; ld = 256; colt = 0; } else { base = Vb; ld = 256; colt = 0; rope = false; }
#pragma unroll
        for (int ai = 0; ai < 2; ++ai) {
            f32x4 rc[4][2];
            if (rope) {
#pragma unroll
                for (int m = 0; m < 4; ++m) { const f32x2* cs = tab + (size_t)(pos0 + ai * 128 + wr * 64 + m * 16 + fr) * 32 + (((wc * 32 + 8 * fq) & 63) >> 1); rc[m][0] = *(const f32x4*)cs; rc[m][1] = *(const f32x4*)(cs + 2); } }
#pragma unroll
            for (int m = 0; m < 4; ++m) { const int rl = ai * 128 + wr * 64 + m * 16 + fr; const size_t row = (size_t)u.pm * 256 + rl;
#pragma unroll
                for (int bj = 0; bj < 2; ++bj) { const int cl = bj * 128 + wc * 32 + 8 * fq;
                    f32x4 a = acc[ai][bj][m][0] * sc, b = acc[ai][bj][m][1] * sc;
                    if (rope) rope8c(a, b, rc[m][0], rc[m][1]);
                    *(v4u*)(base + row * ld + colt + cl) = pack8(a, b); }
                asm volatile("" ::: "memory"); } }
    }
};

struct EpiSsmIn {
    static constexpr bool PERM = true;
    bf16 *Z, *XBC; float* DT; const float* dtb;
    __device__ __forceinline__ void operator()(const AccT& acc, const Unit& u, int ui, int wr, int wc, int fr, int fq) const {
#pragma unroll
        for (int ai = 0; ai < 2; ++ai)
#pragma unroll
            for (int m = 0; m < 4; ++m) { const size_t row = (size_t)u.pm * 256 + ai * 128 + wr * 64 + m * 16 + fr;
#pragma unroll
                for (int bj = 0; bj < 2; ++bj) { const int c = u.pn * 256 + bj * 128 + wc * 32 + 8 * fq;
                    const f32x4 a = acc[ai][bj][m][0], b = acc[ai][bj][m][1];
                    if (c < 1024) *(v4u*)(Z + row * 1024 + c) = pack8(a, b);
                    else if (c < 2560) *(v4u*)(XBC + row * 1536 + (c - 1024)) = pack8(a, b);
                    else if (c < 2592) { const int cc = c - 2560; f32x4 o0, o1;
#pragma unroll
                        for (int j = 0; j < 4; ++j) { o0[j] = softplus_f(a[j] + dtb[(cc >> 4) * 32 + (cc & 15) + j]); o1[j] = softplus_f(b[j] + dtb[(cc >> 4) * 32 + (cc & 15) + 4 + j]); }
                        *(f32x4*)(DT + row * 32 + cc) = o0; *(f32x4*)(DT + row * 32 + cc + 4) = o1; } } }
    }
};

struct EpiMlIn {
    static constexpr bool PERM = true;
    bf16 *Qm, *Km, *Vm, *Om; float* G; const float* gb;
    __device__ __forceinline__ void operator()(const AccT& acc, const Unit& u, int ui, int wr, int wc, int fr, int fq) const {
#pragma unroll
        for (int ai = 0; ai < 2; ++ai)
#pragma unroll
            for (int m = 0; m < 4; ++m) { const size_t row = (size_t)u.pm * 256 + ai * 128 + wr * 64 + m * 16 + fr;
#pragma unroll
                for (int bj = 0; bj < 2; ++bj) { const int c = u.pn * 256 + bj * 128 + wc * 32 + 8 * fq;
                    const f32x4 a = acc[ai][bj][m][0], b = acc[ai][bj][m][1];
                    if (c < 512) *(v4u*)(Qm + row * 512 + c) = pack8(a, b);
                    else if (c < 1024) *(v4u*)(Km + row * 512 + (c - 512)) = pack8(a * 0.125f, b * 0.125f);
                    else if (c < 2048) *(v4u*)(Vm + row * 1024 + (c - 1024)) = pack8(a, b);
                    else if (c < 3072) *(v4u*)(Om + row * 1024 + (c - 2048)) = pack8(a, b);
                    else if (c < 3104) { const int cc = c - 3072; f32x4 o0, o1; const bool fg = ((cc >> 3) & 1) != 0;
#pragma unroll
                        for (int j = 0; j < 4; ++j) { float x0 = a[j] + gb[cc + j], x1 = b[j] + gb[cc + 4 + j];
                            o0[j] = fg ? -softplus_f(-x0) : x0; o1[j] = fg ? -softplus_f(-x1) : x1; }
                        *(f32x4*)(G + row * 32 + cc) = o0; *(f32x4*)(G + row * 32 + cc + 4) = o1; } } }
    }
};

struct EpiMlaIn {
    static constexpr bool PERM = true;
    bf16 *CQ, *CKV, *KF; float* SSQ; const f32x2* tab;
    __device__ __forceinline__ void operator()(const AccT& acc, const Unit& u, int ui, int wr, int wc, int fr, int fq) const {
        const int tb = u.pm % 17; const bool lat = tb != 0; const int pos0 = (tb - 1) * 256;
#pragma unroll
        for (int ai = 0; ai < 2; ++ai)
#pragma unroll
            for (int m = 0; m < 4; ++m) { const int rl = ai * 128 + wr * 64 + m * 16 + fr; const size_t row = (size_t)u.pm * 256 + rl;
                if (u.pn < 2) { bf16* dst = u.pn == 0 ? CQ : CKV; float ss = 0.f;
#pragma unroll
                    for (int bj = 0; bj < 2; ++bj) { const int c = bj * 128 + wc * 32 + 8 * fq; const f32x4 a = acc[ai][bj][m][0], b = acc[ai][bj][m][1];
                        ss += (a[0] * a[0] + a[1] * a[1]) + (a[2] * a[2] + a[3] * a[3]) + (b[0] * b[0] + b[1] * b[1]) + (b[2] * b[2] + b[3] * b[3]);
                        *(v4u*)(dst + row * 256 + c) = pack8(a, b); }
                    ss += __shfl_xor(ss, 16); ss += __shfl_xor(ss, 32);
                    if (fq == 0) SSQ[row * 8 + u.pn * 4 + wc] = ss;
                } else if (wc == 0) {
                    f32x4 a = acc[ai][0][m][0], b = acc[ai][0][m][1]; const int cl = 8 * fq;
                    if (lat) rope8(a, b, tab + (size_t)(pos0 + rl) * 16 + (cl >> 1));
                    const v4u w = pack8(a, b);
#pragma unroll
                    for (int h = 0; h < 16; ++h) *(v4u*)(KF + row * 1536 + h * 96 + 64 + cl) = w; }
                asm volatile("" ::: "memory"); }
    }
};
struct EpiMlaQ {
    static constexpr bool PERM = true;
    bf16* Q3; const float* SSQ; const f32x2* tab; float qscale;
    __device__ __forceinline__ void operator()(const AccT& acc, const Unit& u, int ui, int wr, int wc, int fr, int fq) const {
        const int tb = u.pm % 17; const bool lat = tb != 0; const int pos0 = (tb - 1) * 256;
        f32x4 sq[2][4];
#pragma unroll
        for (int ai = 0; ai < 2; ++ai)
#pragma unroll
            for (int m = 0; m < 4; ++m) sq[ai][m] = *(const f32x4*)(SSQ + ((size_t)u.pm * 256 + ai * 128 + wr * 64 + m * 16 + fr) * 8);
        const int e0 = (u.pn * 256 + wc * 32 + 8 * fq) % 96, e1 = (u.pn * 256 + 128 + wc * 32 + 8 * fq) % 96; const int er = e0 >= 64 ? e0 : e1; const bool anyr = lat && er >= 64;
#pragma unroll
        for (int ai = 0; ai < 2; ++ai) {
            f32x4 rc[4][2];
            if (anyr) {
#pragma unroll
                for (int m = 0; m < 4; ++m) { const f32x2* cs = tab + (size_t)(pos0 + ai * 128 + wr * 64 + m * 16 + fr) * 16 + ((er - 64) >> 1); rc[m][0] = *(const f32x4*)cs; rc[m][1] = *(const f32x4*)(cs + 2); } }
#pragma unroll
            for (int m = 0; m < 4; ++m) { const int rl = ai * 128 + wr * 64 + m * 16 + fr; const size_t row = (size_t)u.pm * 256 + rl;
                const f32x4 s4 = sq[ai][m]; const float rs = rsqrtf(((s4[0] + s4[1]) + (s4[2] + s4[3])) * (1.f / 256.f) + EPS) * qscale;
#pragma unroll
                for (int bj = 0; bj < 2; ++bj) { const int c = u.pn * 256 + bj * 128 + wc * 32 + 8 * fq; const int e = bj ? e1 : e0;
                    f32x4 a = acc[ai][bj][m][0] * rs, b = acc[ai][bj][m][1] * rs;
                    if (lat && e >= 64) rope8c(a, b, rc[m][0], rc[m][1]);
                    *(v4u*)(Q3 + row * 1536 + c) = pack8(a, b); }
                asm volatile("" ::: "memory"); } }
    }
};
struct EpiMlaKV {
    static constexpr bool PERM = true;
    bf16 *KF, *V3; const float* SSQ;
    __device__ __forceinline__ void operator()(const AccT& acc, const Unit& u, int ui, int wr, int wc, int fr, int fq) const {
        f32x4 sq[2][4];
#pragma unroll
        for (int ai = 0; ai < 2; ++ai)
#pragma unroll
            for (int m = 0; m < 4; ++m) sq[ai][m] = *(const f32x4*)(SSQ + ((size_t)u.pm * 256 + ai * 128 + wr * 64 + m * 16 + fr) * 8 + 4);
#pragma unroll
        for (int ai = 0; ai < 2; ++ai)
#pragma unroll
            for (int m = 0; m < 4; ++m) { const size_t row = (size_t)u.pm * 256 + ai * 128 + wr * 64 + m * 16 + fr;
                const f32x4 s4 = sq[ai][m]; const float rs = rsqrtf(((s4[0] + s4[1]) + (s4[2] + s4[3])) * (1.f / 256.f) + EPS);
#pragma unroll
                for (int bj = 0; bj < 2; ++bj) { const int c = u.pn * 256 + bj * 128 + wc * 32 + 8 * fq; const int h = c >> 7, e = c & 127;
                    const v4u w = pack8(acc[ai][bj][m][0] * rs, acc[ai][bj][m][1] * rs);
                    if (e < 64) *(v4u*)(KF + row * 1536 + h * 96 + e) = w; else *(v4u*)(V3 + row * 1024 + h * 64 + (e - 64)) = w; }
                asm volatile("" ::: "memory"); }
    }
};

struct TblEnt { int tok; float w0, w1; int pad; };
__device__ __forceinline__ int cls_expert(int cls, int which) { const int g = cls / 6, p = cls - g * 6; const int lo = p < 3 ? 0 : (p < 5 ? 1 : 2), hi = p < 3 ? p + 1 : (p < 5 ? p - 1 : 3); return g * 4 + (which ? hi : lo); }
template <int MODE> struct MoeOrder {
    static constexpr bool GATHER = (MODE == 0);
    const LAS int* tb;
    const LAS unsigned char* tcls;
    const LAS TblEnt* tbl;
    const bf16* W; int G, c;
    __device__ __forceinline__ bool next(int i, Unit& u) const {
        const int L = i * G + c, tile = L >> 2; if (tile >= tb[24]) return false;
        const int cls = tcls[tile];
        u.pm = tile; u.pn = L & 3; u.aux = cls | (i << 8); return true;
    }
    __device__ __forceinline__ int a_row(const Unit& u, int r) const {
        if (MODE == 1) return u.pm * 256 + r;
        const int t = tbl[(u.aux >> 8) * 256 + r].tok; return t < 0 ? 0 : t;
    }
    __device__ __forceinline__ const char* b_seg(const Unit& u, int seg) const {
        const int cls = u.aux & 255;
        if (MODE == 0) return (const char*)(W + ((size_t)cls_expert(cls, u.pn >> 1) * 512 + (u.pn & 1) * 256) * 1024);
        return (const char*)(W + ((size_t)cls_expert(cls, seg) * 1024 + u.pn * 256) * 256);
    }
};
template <int MODE> __device__ __forceinline__ void moe_setup(Frame& F, int layer, MoeOrder<MODE>& S) {
    LAS int* tb = (LAS int*)(F.lds + LDS_TB); LAS int* cn = tb + 32; LAS TblEnt* tbl = (LAS TblEnt*)(F.lds + LDS_TBL);
    if (MODE == 1) {
        S.tb = tb; S.tbl = tbl; S.tcls = (const LAS unsigned char*)(F.lds + LDS_TB + 256); __syncthreads(); return; }
    LAS unsigned char* tcls = (LAS unsigned char*)(F.lds + LDS_TB + 256);
    if (F.wave == 0) { const int k = F.lane; const int n = k < 24 ? (int)__hip_atomic_load(F.ctl + CW_MOECNT + layer * 64 + k, RLX_AGENT) : 0;
        const int nt = (n + 255) >> 8; const int incl = (int)wave_scan_sum((float)nt); const int t0 = incl - nt;
        if (k < 24) { cn[k] = n; tb[k] = t0; for (int t = t0; t < incl; ++t) tcls[t] = (unsigned char)k; }
        if (k == 23) tb[24] = incl; }
    __syncthreads();
    S.tb = tb; S.tbl = tbl; S.tcls = tcls;
    const int* SL = (const int*)(F.ws + MOE_SL); const float* WT = (const float*)(F.ws + MOE_WT);
    if (F.tid < 256) { bool ok[4]; int tok[4]; f32x2 w[4];
#pragma unroll
        for (int i = 0; i < 4; ++i) { Unit u; ok[i] = S.next(i, u); tok[i] = -1;
            if (ok[i]) { const int cls = u.aux & 255, idx = (u.pm - tb[cls]) * 256 + F.tid; if (idx < cn[cls]) tok[i] = SL[(size_t)cls * M + idx]; } }
#pragma unroll
        for (int i = 0; i < 4; ++i) { w[i] = (f32x2){0.f, 0.f}; if (tok[i] >= 0) w[i] = *(const f32x2*)(WT + 2 * (size_t)tok[i]); }
#pragma unroll
        for (int i = 0; i < 4; ++i) { if (ok[i]) { LAS TblEnt* te = tbl + i * 256 + F.tid; te->tok = tok[i]; te->w0 = w[i].x; te->w1 = w[i].y; te->pad = 0; } } }
    __syncthreads();
}
struct EpiMoeAct {
    static constexpr bool PERM = true;
    bf16* ACT; const LAS TblEnt* tbl;
    __device__ __forceinline__ void operator()(const AccT& acc, const Unit& u, int ui, int wr, int wc, int fr, int fq) const {
        const int slot = u.pn >> 1, colb = slot * 256 + (u.pn & 1) * 128 + wc * 32 + 8 * fq;
#pragma unroll
        for (int ai = 0; ai < 2; ++ai)
#pragma unroll
            for (int m = 0; m < 4; ++m) { const int rl = ai * 128 + wr * 64 + m * 16 + fr; const LAS TblEnt* te = tbl + (u.aux >> 8) * 256 + rl; const float w = slot ? te->w1 : te->w0;
                f32x4 a, b;
#pragma unroll
                for (int j = 0; j < 4; ++j) { a[j] = silu_f(acc[ai][0][m][0][j]) * acc[ai][1][m][0][j] * w; b[j] = silu_f(acc[ai][0][m][1][j]) * acc[ai][1][m][1][j] * w; }
                *(v4u*)(ACT + ((size_t)u.pm * 256 + rl) * 512 + colb) = pack8(a, b);
                asm volatile("" ::: "memory"); }
    }
};
struct EpiMoeDown {
    static constexpr bool PERM = true;
    bf16* X; const float* gate; const LAS TblEnt* tbl;
    __device__ __forceinline__ void operator()(const AccT& acc, const Unit& u, int ui, int wr, int wc, int fr, int fq) const {
        const int col0 = u.pn * 256 + wc * 32 + 8 * fq;
#pragma unroll
        for (int ai = 0; ai < 2; ++ai) {
            int tk[2][2]; v4u raw[2][2][2];
#pragma unroll
            for (int mp = 0; mp < 2; ++mp)
#pragma unroll
                for (int mm = 0; mm < 2; ++mm) { const int rl = ai * 128 + wr * 64 + (2 * mp + mm) * 16 + fr; const int tok = tbl[(u.aux >> 8) * 256 + rl].tok; tk[mp][mm] = tok; const int t0 = tok < 0 ? 0 : tok;
                    const bf16* rowp = X + (size_t)t0 * D + col0;
#pragma unroll
                    for (int bj = 0; bj < 2; ++bj) raw[mp][mm][bj] = *(const v4u*)(rowp + bj * 128); }
#pragma unroll
            for (int mp = 0; mp < 2; ++mp) { f32x4 gin[2][2][2];
#pragma unroll
                for (int mm = 0; mm < 2; ++mm) { const int tok = tk[mp][mm]; const int t0 = tok < 0 ? 0 : tok; const float* gv = gate + (size_t)modrow_of(t0) * 6144 + col0;
#pragma unroll
                    for (int bj = 0; bj < 2; ++bj) { gin[mm][bj][0] = *(const f32x4*)(gv + bj * 128); gin[mm][bj][1] = *(const f32x4*)(gv + bj * 128 + 4); } }
#pragma unroll
                for (int mm = 0; mm < 2; ++mm) { if (tk[mp][mm] >= 0) { bf16* rowp = X + (size_t)tk[mp][mm] * D + col0;
#pragma unroll
                    for (int bj = 0; bj < 2; ++bj) { f32x4 x0, x1; unpack8(raw[mp][mm][bj], x0, x1);
                        *(v4u*)(rowp + bj * 128) = pack8(x0 + gin[mm][bj][0] * acc[ai][bj][2 * mp + mm][0], x1 + gin[mm][bj][1] * acc[ai][bj][2 * mp + mm][1]); } } }
                asm volatile("" ::: "memory"); } }
    }
};
template <int DQK, bool WIN>
__device__ __forceinline__ void flash_unit(LAS unsigned char* lds, const int tid, const int lane, const int grpB,
        const bf16* Kg, const int ldk, const bf16* Vg, const int ldv,
        const bf16* Qg, const int ldq, bf16* Og, const int ldo,
        const int ntiles, const int krow_ctx0, const int krow_lat0, const int kpos0, const int qpos_wave, const float sink2, const bool has_sink) {
    constexpr int KSTR = DQK * 2 + 16, VSTR = 160, KBUF = 64 * KSTR, VBUF = 64 * VSTR, CPR = DQK / 8, NKC = 64 * CPR, NKR = (NKC + 511) / 512, NKS = DQK / 32;
    LAS unsigned char* Kl = lds; LAS unsigned char* Vl = lds + 2 * KBUF;
    const int fr = lane & 15, fq = lane >> 4;
    bf16x8 qf[2][NKS];
#pragma unroll
    for (int qt = 0; qt < 2; ++qt)
#pragma unroll
        for (int ks = 0; ks < NKS; ++ks) qf[qt][ks] = *(const bf16x8*)(Qg + (size_t)(16 * qt + fr) * ldq + 32 * ks + 8 * fq);
    f32x4 oacc[4][2];
#pragma unroll
    for (int c = 0; c < 4; ++c) { oacc[c][0] = (f32x4){0.f, 0.f, 0.f, 0.f}; oacc[c][1] = (f32x4){0.f, 0.f, 0.f, 0.f}; }
    float mrun[2] = {-1.0e30f, -1.0e30f}, lsum[2] = {0.f, 0.f};
    v4u kreg[NKR], vreg;
    bf16x8 pf[2][2]; bool pvalid = false; int pvb = 0;
#pragma unroll
    for (int a = 0; a < 2; ++a)
#pragma unroll
        for (int b2 = 0; b2 < 2; ++b2)
#pragma unroll
            for (int e = 0; e < 8; ++e) pf[a][b2][e] = 0;
#define FA_LOAD(j) do { const int _rb = (j) < 4 ? krow_ctx0 + 64 * (j) : krow_lat0 + 64 * ((j) - 4); \
        _Pragma("unroll") for (int _i = 0; _i < NKR; ++_i) { const int _c = tid + 512 * _i; if (_c < NKC) kreg[_i] = *(const v4u*)(Kg + (size_t)(_rb + _c / CPR) * ldk + (_c % CPR) * 8); } \
        vreg = *(const v4u*)(Vg + (size_t)(_rb + (tid >> 3)) * ldv + (tid & 7) * 8); } while (0)
#define FA_STORE(kb, vb) do { _Pragma("unroll") for (int _i = 0; _i < NKR; ++_i) { const int _c = tid + 512 * _i; if (_c < NKC) *(LAS v4u*)(Kl + (kb) * KBUF + (_c / CPR) * KSTR + (_c % CPR) * 16) = kreg[_i]; } \
        *(LAS v4u*)(Vl + (vb) * VBUF + (tid >> 3) * VSTR + (tid & 7) * 16) = vreg; } while (0)
#define FA_PV(vbuf) do { _Pragma("unroll") for (int ks2 = 0; ks2 < 2; ++ks2) _Pragma("unroll") for (int c = 0; c < 4; ++c) { \
            const LAS unsigned char* vb_ = Vl + (vbuf) * VBUF + (32 * ks2 + 4 * fq + ((lane & 15) >> 2)) * VSTR + (16 * c + 4 * (lane & 3)) * 2; \
            const s16x4 v0 = __builtin_amdgcn_ds_read_tr16_b64_v4i16((LAS s16x4*)vb_); const s16x4 v1 = __builtin_amdgcn_ds_read_tr16_b64_v4i16((LAS s16x4*)(vb_ + 16 * VSTR)); \
            bf16x8 vf; vf[0] = v0[0]; vf[1] = v0[1]; vf[2] = v0[2]; vf[3] = v0[3]; vf[4] = v1[0]; vf[5] = v1[1]; vf[6] = v1[2]; vf[7] = v1[3]; \
            oacc[c][0] = __builtin_amdgcn_mfma_f32_16x16x32_bf16(vf, pf[0][ks2], oacc[c][0], 0, 0, 0); \
            oacc[c][1] = __builtin_amdgcn_mfma_f32_16x16x32_bf16(vf, pf[1][ks2], oacc[c][1], 0, 0, 0); } } while (0)
    FA_LOAD(0); FA_STORE(0, 0); __syncthreads();
    int vcur = 0;
    for (int j = 0; j < ntiles; ++j) {
        const int kb = j & 1;
        if (j + 1 < ntiles) FA_LOAD(j + 1);
        if (grpB && pvalid) { __builtin_amdgcn_s_setprio(1); FA_PV(pvb); __builtin_amdgcn_s_setprio(0); }
        bool skip = false; const int kp = kpos0 + 64 * (j - 4);
        if (WIN && j >= 4) skip = (kp + 63 < qpos_wave - 128) || (kp > qpos_wave + 31 + 128);
        pvalid = !skip; pvb = vcur;
        if (!skip) {
            f32x4 sacc[4][2];
#pragma unroll
            for (int kt = 0; kt < 4; ++kt) { sacc[kt][0] = (f32x4){0.f, 0.f, 0.f, 0.f}; sacc[kt][1] = (f32x4){0.f, 0.f, 0.f, 0.f}; }
            __builtin_amdgcn_s_setprio(1);
#pragma unroll
            for (int ks = 0; ks < NKS; ++ks) { bf16x8 kf[4];
#pragma unroll
                for (int kt = 0; kt < 4; ++kt) kf[kt] = *(const LAS bf16x8*)(Kl + kb * KBUF + (16 * kt + fr) * KSTR + (32 * ks + 8 * fq) * 2);
#pragma unroll
                for (int kt = 0; kt < 4; ++kt) { sacc[kt][0] = __builtin_amdgcn_mfma_f32_16x16x32_bf16(kf[kt], qf[0][ks], sacc[kt][0], 0, 0, 0);
                                                 sacc[kt][1] = __builtin_amdgcn_mfma_f32_16x16x32_bf16(kf[kt], qf[1][ks], sacc[kt][1], 0, 0, 0); } }
            __builtin_amdgcn_s_setprio(0);
            if (WIN && j >= 4) {
#pragma unroll
                for (int kt = 0; kt < 4; ++kt)
#pragma unroll
                    for (int qt = 0; qt < 2; ++qt)
#pragma unroll
                        for (int jj = 0; jj < 4; ++jj) { const int d = (kp + 16 * kt + 4 * fq + jj) - (qpos_wave + 16 * qt + fr); if (d < -128 || d > 128) sacc[kt][qt][jj] = -1.0e30f; } }
#pragma unroll
            for (int qt = 0; qt < 2; ++qt) {
                float mx = sacc[0][qt][0];
#pragma unroll
                for (int kt = 0; kt < 4; ++kt)
#pragma unroll
                    for (int jj = 0; jj < 4; ++jj) mx = fmaxf(mx, sacc[kt][qt][jj]);
                mx = fmaxf(mx, __shfl_xor(mx, 16)); mx = fmaxf(mx, xor32(mx));
                float mnew = mrun[qt];
                if (__builtin_amdgcn_ballot_w64(mx > mrun[qt] + 11.5f) != 0ull) {
                    mnew = fmaxf(mrun[qt], mx); const float alpha = fast_exp2(mrun[qt] - mnew); lsum[qt] *= alpha;
#pragma unroll
                    for (int c = 0; c < 4; ++c) oacc[c][qt] = oacc[c][qt] * alpha; }
                mrun[qt] = mnew;
                float ps = 0.f;
#pragma unroll
                for (int kt = 0; kt < 4; ++kt)
#pragma unroll
                    for (int jj = 0; jj < 4; ++jj) { const float p = fast_exp2(sacc[kt][qt][jj] - mnew); sacc[kt][qt][jj] = p; ps += p; }
                lsum[qt] += ps;
#pragma unroll
                for (int ks2 = 0; ks2 < 2; ++ks2) { const v4u w = pack8(sacc[2 * ks2][qt], sacc[2 * ks2 + 1][qt]); pf[qt][ks2] = __builtin_bit_cast(bf16x8, w); }
            }
            if (!grpB) { __builtin_amdgcn_s_setprio(1); FA_PV(vcur); __builtin_amdgcn_s_setprio(0); }
        }
        const int vnext = vcur == 2 ? 0 : vcur + 1;
        if (j + 1 < ntiles) FA_STORE(kb ^ 1, vnext);
        vcur = vnext;
        __syncthreads();
    }
    if (grpB && pvalid) FA_PV(pvb);
    __syncthreads();
#pragma unroll
    for (int qt = 0; qt < 2; ++qt) { float l = lsum[qt]; l += __shfl_xor(l, 16); l += xor32(l); if (has_sink) l += fast_exp2(sink2 - mrun[qt]);
        const float inv = 1.0f / l;
#pragma unroll
        for (int c = 0; c < 4; ++c) { const f32x4 o = oacc[c][qt] * inv; v2u w; w.x = cvt_pk_bf16(o[0], o[1]); w.y = cvt_pk_bf16(o[2], o[3]);
            *(v2u*)(Og + (size_t)(16 * qt + fr) * ldo + 16 * c + 4 * fq) = w; } }
#undef FA_LOAD
#undef FA_STORE
#undef FA_PV
}

template <int DQK>
__device__ __forceinline__ void flash_unit2(LAS unsigned char* lds, const int tid, const int lane, const int grpB,
        const bf16* Kg, const int ldk, const bf16* Vg, const int ldv,
        const bf16* Qg, const int ldq, bf16* Og, const int ldo,
        const int ntiles, const int krow_ctx0, const int krow_lat0, const int kpos0, const int qpos_wave, const float sink2, const bool has_sink) {
    constexpr bool WIN = false; constexpr int KSTR = DQK * 2 + 16, VSTR = 160, KBUF = 128 * KSTR, VBUF = 128 * VSTR, CPR = DQK / 8, NKC = 128 * CPR, NKR = (NKC + 511) / 512, NKS = DQK / 32;
    LAS unsigned char* Kl = lds; LAS unsigned char* Vl = lds + 2 * KBUF;
    const int fr = lane & 15, fq = lane >> 4;
    bf16x8 qf[2][NKS];
#pragma unroll
    for (int qt = 0; qt < 2; ++qt)
#pragma unroll
        for (int ks = 0; ks < NKS; ++ks) qf[qt][ks] = *(const bf16x8*)(Qg + (size_t)(16 * qt + fr) * ldq + 32 * ks + 8 * fq);
    f32x4 oacc[4][2];
#pragma unroll
    for (int c = 0; c < 4; ++c) { oacc[c][0] = (f32x4){0.f, 0.f, 0.f, 0.f}; oacc[c][1] = (f32x4){0.f, 0.f, 0.f, 0.f}; }
    float mrun[2] = {-1.0e30f, -1.0e30f}, lsum[2] = {0.f, 0.f};
    v4u kreg[NKR], vreg[2];
    bf16x8 pf[2][2]; bool pvalid = false; int pvb = 0;
#pragma unroll
    for (int a = 0; a < 2; ++a)
#pragma unroll
        for (int b2 = 0; b2 < 2; ++b2)
#pragma unroll
            for (int e = 0; e < 8; ++e) pf[a][b2][e] = 0;
#define FA_LOAD(p) do { const int _rb = krow_ctx0 + 128 * (p); \
        _Pragma("unroll") for (int _i = 0; _i < NKR; ++_i) { const int _c = tid + 512 * _i; if (_c < NKC) kreg[_i] = *(const v4u*)(Kg + (size_t)(_rb + _c / CPR) * ldk + (_c % CPR) * 8); } \
        _Pragma("unroll") for (int _i = 0; _i < 2; ++_i) { const int _c = tid + 512 * _i; vreg[_i] = *(const v4u*)(Vg + (size_t)(_rb + (_c >> 3)) * ldv + (_c & 7) * 8); } } while (0)
#define FA_STORE(kb, vb) do { _Pragma("unroll") for (int _i = 0; _i < NKR; ++_i) { const int _c = tid + 512 * _i; if (_c < NKC) *(LAS v4u*)(Kl + (kb) * KBUF + (_c / CPR) * KSTR + (_c % CPR) * 16) = kreg[_i]; } \
        _Pragma("unroll") for (int _i = 0; _i < 2; ++_i) { const int _c = tid + 512 * _i; *(LAS v4u*)(Vl + (vb) * VBUF + (_c >> 3) * VSTR + (_c & 7) * 16) = vreg[_i]; } } while (0)
#define FA_PV(vbuf) do { _Pragma("unroll") for (int ks2 = 0; ks2 < 2; ++ks2) _Pragma("unroll") for (int c = 0; c < 4; ++c) { \
            const LAS unsigned char* vb_ = Vl + (vbuf) + (32 * ks2 + 4 * fq + ((lane & 15) >> 2)) * VSTR + (16 * c + 4 * (lane & 3)) * 2; \
            const s16x4 v0 = __builtin_amdgcn_ds_read_tr16_b64_v4i16((LAS s16x4*)vb_); const s16x4 v1 = __builtin_amdgcn_ds_read_tr16_b64_v4i16((LAS s16x4*)(vb_ + 16 * VSTR)); \
            bf16x8 vf; vf[0] = v0[0]; vf[1] = v0[1]; vf[2] = v0[2]; vf[3] = v0[3]; vf[4] = v1[0]; vf[5] = v1[1]; vf[6] = v1[2]; vf[7] = v1[3]; \
            oacc[c][0] = __builtin_amdgcn_mfma_f32_16x16x32_bf16(vf, pf[0][ks2], oacc[c][0], 0, 0, 0); \
            oacc[c][1] = __builtin_amdgcn_mfma_f32_16x16x32_bf16(vf, pf[1][ks2], oacc[c][1], 0, 0, 0); } } while (0)
    FA_LOAD(0); FA_STORE(0, 0); __syncthreads();
    int vcur = 0;
    const int npairs = ntiles >> 1;
    for (int p = 0; p < npairs; ++p) {
        const int kb = p & 1;
        if (p + 1 < npairs) FA_LOAD(p + 1);
#pragma unroll
      for (int sub = 0; sub < 2; ++sub) { const int j = 2 * p + sub; const int koff = kb * KBUF + sub * 64 * KSTR; const int voff = vcur * VBUF + sub * 64 * VSTR;
        if (grpB && pvalid) { __builtin_amdgcn_s_setprio(1); FA_PV(pvb); __builtin_amdgcn_s_setprio(0); }
        bool skip = false; const int kp = kpos0 + 64 * (j - 4);
        if (WIN && j >= 4) skip = (kp + 63 < qpos_wave - 128) || (kp > qpos_wave + 31 + 128);
        pvalid = !skip; pvb = voff;
        if (!skip) {
            f32x4 sacc[4][2];
#pragma unroll
            for (int kt = 0; kt < 4; ++kt) { sacc[kt][0] = (f32x4){0.f, 0.f, 0.f, 0.f}; sacc[kt][1] = (f32x4){0.f, 0.f, 0.f, 0.f}; }
            __builtin_amdgcn_s_setprio(1);
#pragma unroll
            for (int ks = 0; ks < NKS; ++ks) { bf16x8 kf[4];
#pragma unroll
                for (int kt = 0; kt < 4; ++kt) kf[kt] = *(const LAS bf16x8*)(Kl + koff + (16 * kt + fr) * KSTR + (32 * ks + 8 * fq) * 2);
#pragma unroll
                for (int kt = 0; kt < 4; ++kt) { sacc[kt][0] = __builtin_amdgcn_mfma_f32_16x16x32_bf16(kf[kt], qf[0][ks], sacc[kt][0], 0, 0, 0);
                                                 sacc[kt][1] = __builtin_amdgcn_mfma_f32_16x16x32_bf16(kf[kt], qf[1][ks], sacc[kt][1], 0, 0, 0); } }
            __builtin_amdgcn_s_setprio(0);
            if (WIN && j >= 4) {
#pragma unroll
                for (int kt = 0; kt < 4; ++kt)
#pragma unroll
                    for (int qt = 0; qt < 2; ++qt)
#pragma unroll
                        for (int jj = 0; jj < 4; ++jj) { const int d = (kp + 16 * kt + 4 * fq + jj) - (qpos_wave + 16 * qt + fr); if (d < -128 || d > 128) sacc[kt][qt][jj] = -1.0e30f; } }
#pragma unroll
            for (int qt = 0; qt < 2; ++qt) {
                float mx = sacc[0][qt][0];
#pragma unroll
                for (int kt = 0; kt < 4; ++kt)
#pragma unroll
                    for (int jj = 0; jj < 4; ++jj) mx = fmaxf(mx, sacc[kt][qt][jj]);
                mx = fmaxf(mx, __shfl_xor(mx, 16)); mx = fmaxf(mx, xor32(mx));
                float mnew = mrun[qt];
                if (__builtin_amdgcn_ballot_w64(mx > mrun[qt] + 11.5f) != 0ull) {
                    mnew = fmaxf(mrun[qt], mx); const float alpha = fast_exp2(mrun[qt] - mnew); lsum[qt] *= alpha;
#pragma unroll
                    for (int c = 0; c < 4; ++c) oacc[c][qt] = oacc[c][qt] * alpha; }
                mrun[qt] = mnew;
                float ps = 0.f;
#pragma unroll
                for (int kt = 0; kt < 4; ++kt)
#pragma unroll
                    for (int jj = 0; jj < 4; ++jj) { const float p = fast_exp2(sacc[kt][qt][jj] - mnew); sacc[kt][qt][jj] = p; ps += p; }
                lsum[qt] += ps;
#pragma unroll
                for (int ks2 = 0; ks2 < 2; ++ks2) { const v4u w = pack8(sacc[2 * ks2][qt], sacc[2 * ks2 + 1][qt]); pf[qt][ks2] = __builtin_bit_cast(bf16x8, w); }
            }
            if (!grpB) { __builtin_amdgcn_s_setprio(1); FA_PV(voff); __builtin_amdgcn_s_setprio(0); }
        }
      }
        const int vnext = vcur == 2 ? 0 : vcur + 1;
        if (p + 1 < npairs) FA_STORE(kb ^ 1, vnext);
        vcur = vnext;
        __syncthreads();
    }
    if (grpB && pvalid) FA_PV(pvb);
    __syncthreads();
#pragma unroll
    for (int qt = 0; qt < 2; ++qt) { float l = lsum[qt]; l += __shfl_xor(l, 16); l += xor32(l); if (has_sink) l += fast_exp2(sink2 - mrun[qt]);
        const float inv = 1.0f / l;
#pragma unroll
        for (int c = 0; c < 4; ++c) { const f32x4 o = oacc[c][qt] * inv; v2u w; w.x = cvt_pk_bf16(o[0], o[1]); w.y = cvt_pk_bf16(o[2], o[3]);
            *(v2u*)(Og + (size_t)(16 * qt + fr) * ldo + 16 * c + 4 * fq) = w; } }
#undef FA_LOAD
#undef FA_STORE
#undef FA_PV
}

typedef float f32x16 __attribute__((ext_vector_type(16)));
template <int DQK>
__device__ __forceinline__ void flash_unit4(LAS unsigned char* lds, const int tid, const int lane,
        const bf16* Kg, const int ldk, const bf16* Vg, const int ldv, const bf16* Qg, const int ldq, bf16* Og, const int ldo, const int npairs, const int krow0) {
    constexpr int KSTR = DQK * 2 + 16, VSTR = 160, KBUF = 128 * KSTR, VBUF = 128 * VSTR, CPR = DQK / 8, NKC = 128 * CPR, NKR = (NKC + 511) / 512, NKS = DQK / 16;
    LAS unsigned char* Kl = lds; LAS unsigned char* Vl = lds + 2 * KBUF;
    const int r5 = lane & 31, h = lane >> 5;
    bf16x8 qf[NKS];
#pragma unroll
    for (int ks = 0; ks < NKS; ++ks) qf[ks] = *(const bf16x8*)(Qg + (size_t)r5 * ldq + 16 * ks + 8 * h);
    f32x16 oacc[2];
#pragma unroll
    for (int dt = 0; dt < 2; ++dt)
#pragma unroll
        for (int e = 0; e < 16; ++e) oacc[dt][e] = 0.f;
    float mrun = -1.0e30f, lsum = 0.f;
    v4u kreg[NKR], vreg[2];
    unsigned kgo[NKR], vgo[2];
#pragma unroll
    for (int i = 0; i < NKR; ++i) { const int c = tid + 512 * i; kgo[i] = (unsigned)(((c / CPR) * ldk + (c % CPR) * 8) * 2); }
#pragma unroll
    for (int i = 0; i < 2; ++i) { const int c = tid + 512 * i; vgo[i] = (unsigned)(((c >> 3) * ldv + (c & 7) * 8) * 2); }
#define F4_LOAD(p) do { const char* _kb = (const char*)Kg + (size_t)(krow0 + 128 * (p)) * ldk * 2; const char* _vb = (const char*)Vg + (size_t)(krow0 + 128 * (p)) * ldv * 2; \
        _Pragma("unroll") for (int _i = 0; _i < NKR; ++_i) { if (tid + 512 * _i < NKC) kreg[_i] = *(const v4u*)(_kb + kgo[_i]); } \
        _Pragma("unroll") for (int _i = 0; _i < 2; ++_i) vreg[_i] = *(const v4u*)(_vb + vgo[_i]); } while (0)
#define F4_STORE(b) do { _Pragma("unroll") for (int _i = 0; _i < NKR; ++_i) { const int _c = tid + 512 * _i; if (_c < NKC) *(LAS v4u*)(Kl + (b) * KBUF + (_c / CPR) * KSTR + (_c % CPR) * 16) = kreg[_i]; } \
        _Pragma("unroll") for (int _i = 0; _i < 2; ++_i) { const int _c = tid + 512 * _i; *(LAS v4u*)(Vl + (b) * VBUF + (_c >> 3) * VSTR + (_c & 7) * 16) = vreg[_i]; } } while (0)
    F4_LOAD(0); F4_STORE(0); __syncthreads();
    const int vlane = (4 * h + ((lane & 15) >> 2)) * VSTR + (16 * ((lane >> 4) & 1) + 4 * (lane & 3)) * 2;
    for (int p = 0; p < npairs; ++p) { const int bb = p & 1;
        if (p + 1 < npairs) F4_LOAD(p + 1);
#pragma unroll
        for (int sub = 0; sub < 2; ++sub) { const LAS unsigned char* Kt = Kl + bb * KBUF + sub * 64 * KSTR; const LAS unsigned char* Vt = Vl + bb * VBUF + sub * 64 * VSTR;
            bf16x8 kfr[NKS][2];
#pragma unroll
            for (int ks = 0; ks < NKS; ++ks)
#pragma unroll
                for (int kt = 0; kt < 2; ++kt) kfr[ks][kt] = *(const LAS bf16x8*)(Kt + (32 * kt + r5) * KSTR + (16 * ks + 8 * h) * 2);
            f32x16 sacc[2];
#pragma unroll
            for (int kt = 0; kt < 2; ++kt)
#pragma unroll
                for (int e = 0; e < 16; ++e) sacc[kt][e] = 0.f;
            __builtin_amdgcn_s_setprio(1);
#pragma unroll
            for (int ks = 0; ks < NKS; ++ks)
#pragma unroll
                for (int kt = 0; kt < 2; ++kt) sacc[kt] = __builtin_amdgcn_mfma_f32_32x32x16_bf16(kfr[ks][kt], qf[ks], sacc[kt], 0, 0, 0);
            __builtin_amdgcn_s_setprio(0);
            float mx = sacc[0][0];
#pragma unroll
            for (int kt = 0; kt < 2; ++kt)
#pragma unroll
                for (int e = 0; e < 16; ++e) mx = fmaxf(mx, sacc[kt][e]);
            mx = fmaxf(mx, xor32(mx));
            if (__builtin_amdgcn_ballot_w64(mx > mrun + 11.5f) != 0ull) { const float mnew = fmaxf(mrun, mx), alpha = fast_exp2(mrun - mnew); lsum *= alpha; mrun = mnew;
#pragma unroll
                for (int dt = 0; dt < 2; ++dt) oacc[dt] = oacc[dt] * alpha; }
            float ps = 0.f;
#pragma unroll
            for (int kt = 0; kt < 2; ++kt)
#pragma unroll
                for (int e = 0; e < 16; ++e) { const float pv = fast_exp2(sacc[kt][e] - mrun); sacc[kt][e] = pv; ps += pv; }
            lsum += ps;
            bf16x8 vfr[2][2][2];
#pragma unroll
            for (int kt = 0; kt < 2; ++kt)
#pragma unroll
                for (int s = 0; s < 2; ++s)
#pragma unroll
                    for (int dt = 0; dt < 2; ++dt) { const LAS unsigned char* vb = Vt + (32 * kt + 16 * s) * VSTR + vlane + 64 * dt;
                        const s16x4 v0 = __builtin_amdgcn_ds_read_tr16_b64_v4i16((LAS s16x4*)vb), v1 = __builtin_amdgcn_ds_read_tr16_b64_v4i16((LAS s16x4*)(vb + 8 * VSTR));
                        bf16x8 vf; vf[0] = v0[0]; vf[1] = v0[1]; vf[2] = v0[2]; vf[3] = v0[3]; vf[4] = v1[0]; vf[5] = v1[1]; vf[6] = v1[2]; vf[7] = v1[3]; vfr[kt][s][dt] = vf; }
            v4u pw[2][2];
#pragma unroll
            for (int kt = 0; kt < 2; ++kt)
#pragma unroll
                for (int s = 0; s < 2; ++s) { pw[kt][s].x = cvt_pk_bf16(sacc[kt][8 * s + 0], sacc[kt][8 * s + 1]); pw[kt][s].y = cvt_pk_bf16(sacc[kt][8 * s + 2], sacc[kt][8 * s + 3]);
                    pw[kt][s].z = cvt_pk_bf16(sacc[kt][8 * s + 4], sacc[kt][8 * s + 5]); pw[kt][s].w = cvt_pk_bf16(sacc[kt][8 * s + 6], sacc[kt][8 * s + 7]); }
            __builtin_amdgcn_s_setprio(1);
#pragma unroll
            for (int kt = 0; kt < 2; ++kt)
#pragma unroll
                for (int s = 0; s < 2; ++s)
#pragma unroll
                    for (int dt = 0; dt < 2; ++dt) oacc[dt] = __builtin_amdgcn_mfma_f32_32x32x16_bf16(vfr[kt][s][dt], __builtin_bit_cast(bf16x8, pw[kt][s]), oacc[dt], 0, 0, 0);
            __builtin_amdgcn_s_setprio(0);
        }
        if (p + 1 < npairs) F4_STORE(bb ^ 1);
        __syncthreads();
    }
    { float l = lsum; l += xor32(l); const float inv = 1.0f / l;
#pragma unroll
      for (int dt = 0; dt < 2; ++dt)
#pragma unroll
          for (int g4 = 0; g4 < 4; ++g4) { v2u w; w.x = cvt_pk_bf16(oacc[dt][4 * g4 + 0] * inv, oacc[dt][4 * g4 + 1] * inv); w.y = cvt_pk_bf16(oacc[dt][4 * g4 + 2] * inv, oacc[dt][4 * g4 + 3] * inv);
              *(v2u*)(Og + (size_t)r5 * ldo + 32 * dt + 8 * g4 + 4 * h) = w; } }
#undef F4_LOAD
#undef F4_STORE
}

__device__ __forceinline__ void phase_attn_window(Frame& F, const float* const* in, bf16* Q, const bf16* Kb, const bf16* Vb, bf16* Oalt = nullptr) {
    constexpr int NLAT = NB * 4 * 64, NCTX = NB * 4 * 4;
    for (int un = F.vcu; un < NLAT + NCTX; un += GRID) {
        int b, kvh, q0, ntiles, kpos0, qrow0;
        if (un < NLAT) { b = un >> 8; kvh = (un >> 6) & 3; q0 = (un & 63) * 64; kpos0 = q0 >= 128 ? q0 - 128 : 0; const int kend = q0 + 192 <= SEQ ? q0 + 192 : SEQ; ntiles = 4 + (kend - kpos0) / 64; qrow0 = b * TPB + CTX + q0; }
        else { const int v = un - NLAT; b = v >> 4; kvh = (v >> 2) & 3; q0 = (v & 3) * 64; kpos0 = 0; ntiles = 4; qrow0 = b * TPB + q0; }
        const int g = F.wave >> 1, half = F.wave & 1, head = kvh * 4 + g;
        bf16* qp = Q + (size_t)(qrow0 + 32 * half) * 1024 + head * 64;
        bf16* op = Oalt ? Oalt + (size_t)(qrow0 + 32 * half) * 1024 + head * 64 : qp;
        flash_unit<64, true>(F.lds, F.tid, F.lane, F.wave >> 2, Kb + kvh * 64, 256, Vb + kvh * 64, 256, qp, 1024, op, 1024,
                             ntiles, b * TPB, b * TPB + CTX + kpos0, kpos0, q0 + 32 * half, in[16][head] * LOG2E, true);
    }
}
__device__ __forceinline__ void phase_attn_mla(Frame& F, const bf16* Q3, const bf16* KF, const bf16* V3, bf16* O) {
    for (int un = F.vcu; un < NB * 16 * 16; un += GRID) { const int b = un >> 8, head = (un >> 4) & 15, qb = un & 15; const int qrow = b * TPB + CTX + qb * 256 + 32 * F.wave;
        flash_unit4<96>(F.lds, F.tid, F.lane, KF + head * 96, 1536, V3 + head * 64, 1024, Q3 + (size_t)qrow * 1536 + head * 96, 1536, O + (size_t)qrow * 1024 + head * 64, 1024, 34, b * TPB);
    }
}
#ifndef SSD_PF
#define SSD_PF 2
#endif
#ifndef ML_PF
#define ML_PF 2
#endif
__device__ __forceinline__ int scan_row(int dir, int tau) { return dir == 0 ? tau : (tau < CTX ? CTX - 1 - tau : (TPB + CTX - 1) - tau); }

__device__ __forceinline__ void phase_ssm_conv(Frame& F, const float* const* in, int gp, const bf16* XP, bf16* XS, bf16* BC, const float* DT, float* ACUM) {
    constexpr int RPW = M / GRID;
    if (F.tid < 384) {
    const int cg = F.tid % 192, rsub = F.tid / 192, c0 = cg * 8;
    const int oc = c0 < 1024 ? gp * 1024 + c0 : (c0 < 1280 ? 2048 + gp * 256 + (c0 - 1024) : 2560 + gp * 256 + (c0 - 1280));
    float w[5][8], bb[8];
#pragma unroll
    for (int k = 0; k < 5; ++k)
#pragma unroll
        for (int i = 0; i < 8; ++i) w[k][i] = in[19][k * 3072 + oc + i];
#pragma unroll
    for (int i = 0; i < 8; ++i) bb[i] = in[20][oc + i];
    const int rbeg = blockIdx.x * RPW + rsub * (RPW / 2), rend = rbeg + RPW / 2;
    for (int g0 = rbeg; g0 < rend; g0 += 8) {
        v4u xin[12];
#pragma unroll
        for (int j = 0; j < 12; ++j) { const int rr = g0 - 2 + j; xin[j] = (rr >= 0 && rr < M) ? *(const v4u*)(XP + (size_t)rr * 1536 + c0) : (v4u){0u, 0u, 0u, 0u}; }
#pragma unroll
        for (int i = 0; i < 8; ++i) { const int r = g0 + i; if (r < rend) { const int t = r % TPB; const int lo = t < CTX ? 0 : CTX, hi = t < CTX ? CTX : TPB;
            float a[8];
#pragma unroll
            for (int q = 0; q < 8; ++q) a[q] = bb[q];
#pragma unroll
            for (int k = 0; k < 5; ++k) { const int tt = t + k - 2; if (tt >= lo && tt < hi) { const v4u x = xin[i + k];
                    a[0] += w[k][0] * bflo(x.x); a[1] += w[k][1] * bfhi(x.x); a[2] += w[k][2] * bflo(x.y); a[3] += w[k][3] * bfhi(x.y);
                    a[4] += w[k][4] * bflo(x.z); a[5] += w[k][5] * bfhi(x.z); a[6] += w[k][6] * bflo(x.w); a[7] += w[k][7] * bfhi(x.w); } }
            v4u o; o.x = cvt_pk_bf16(silu_f(a[0]), silu_f(a[1])); o.y = cvt_pk_bf16(silu_f(a[2]), silu_f(a[3])); o.z = cvt_pk_bf16(silu_f(a[4]), silu_f(a[5])); o.w = cvt_pk_bf16(silu_f(a[6]), silu_f(a[7]));
            if (c0 < 1024) *(v4u*)(XS + (size_t)r * 1024 + c0) = o; else *(v4u*)(BC + (size_t)r * 512 + (c0 - 1024)) = o; } } }
    } else {
        const int chain = blockIdx.x * 128 + (F.tid - 384);
        if (chain < NB * 2 * 16 * 68) { const int ck = chain % 68, hl = (chain / 68) & 15, dir = (chain / (68 * 16)) & 1, b = chain / (68 * 32);
            const float Ah = -fast_exp(in[22][dir * 32 + gp * 16 + hl]) * LOG2E; float acc = 0.f;
#pragma unroll 1
            for (int h2 = 0; h2 < 2; ++h2) { float dv[32];
#pragma unroll
                for (int s = 0; s < 32; ++s) dv[s] = DT[(size_t)(b * TPB + scan_row(dir, ck * 64 + h2 * 32 + s)) * 32 + dir * 16 + hl];
#pragma unroll
                for (int s = 0; s < 32; ++s) { acc += dv[s] * Ah; ACUM[(size_t)(b * TPB + scan_row(dir, ck * 64 + h2 * 32 + s)) * 32 + dir * 16 + hl] = acc; } } }
    }
}

__device__ __forceinline__ void phase_ssm_scan(Frame& F, const float* const* in, int gp, const bf16* XS, const bf16* BC, const float* DT, const bf16* Z, bf16* Y) {
    constexpr int T = 32;
    LAS float* Bf = (LAS float*)F.lds;
    LAS float* Cf = (LAS float*)(F.lds + 16384);
    LAS float* U = (LAS float*)(F.lds + 32768);
    LAS float* XT = (LAS float*)(F.lds + 40960);
    LAS float* DEC = (LAS float*)(F.lds + 49152);
    LAS float* PART = (LAS float*)(F.lds + 49152 + 256);
    const int it = blockIdx.x, b = it >> 5, hl = (it >> 1) & 15, ph = it & 1, head = gp * 16 + hl, gl = hl >> 3;
    const int col = hl * 64 + ph * 32;
    const int p = F.tid & 31, ns = F.tid >> 5;
    const float dskip = in[23][head] + in[23][32 + head];
    const int st = F.tid >> 4, sch = F.tid & 15;
    const int xt = F.tid >> 2, xch = F.tid & 3;
    for (int dir = 0; dir < 2; ++dir) {
        const float Ah = -fast_exp(in[22][dir * 32 + head]) * LOG2E;
        float S[8];
#pragma unroll
        for (int i = 0; i < 8; ++i) S[i] = 0.f;
        v4u rb, rc, rx; float rdt = 0.f;
#define SS_LOAD(tile) do { const int _rB = b * TPB + scan_row(dir, (tile) * T + st); rb = *(const v4u*)(BC + (size_t)_rB * 512 + gl * 128 + sch * 8); rc = *(const v4u*)(BC + (size_t)_rB * 512 + 256 + gl * 128 + sch * 8); \
            if (F.tid < 128) { const int _rX = b * TPB + scan_row(dir, (tile) * T + xt); rx = *(const v4u*)(XS + (size_t)_rX * 1024 + col + xch * 8); rdt = DT[(size_t)_rX * 32 + dir * 16 + hl]; } } while (0)
#define SS_STORE(nb) do { LAS float* _b = Bf + st * 128 + sch * 8; LAS float* _c = Cf + st * 128 + sch * 8; \
            *(LAS f32x4*)_b = (f32x4){bflo(rb.x), bfhi(rb.x), bflo(rb.y), bfhi(rb.y)}; *(LAS f32x4*)(_b + 4) = (f32x4){bflo(rb.z), bfhi(rb.z), bflo(rb.w), bfhi(rb.w)}; \
            *(LAS f32x4*)_c = (f32x4){bflo(rc.x), bfhi(rc.x), bflo(rc.y), bfhi(rc.y)}; *(LAS f32x4*)(_c + 4) = (f32x4){bflo(rc.z), bfhi(rc.z), bflo(rc.w), bfhi(rc.w)}; \
            if (F.tid < 128) { const f32x4 x0 = (f32x4){bflo(rx.x), bfhi(rx.x), bflo(rx.y), bfhi(rx.y)}, x1 = (f32x4){bflo(rx.z), bfhi(rx.z), bflo(rx.w), bfhi(rx.w)}; \
                LAS float* _x = XT + (nb) * 1024 + xt * 32 + xch * 8; LAS float* _u = U + (nb) * 1024 + xt * 32 + xch * 8; \
                *(LAS f32x4*)_x = x0; *(LAS f32x4*)(_x + 4) = x1; *(LAS f32x4*)_u = x0 * rdt; *(LAS f32x4*)(_u + 4) = x1 * rdt; \
                if (xch == 0) DEC[(nb) * 32 + xt] = fast_exp2(rdt * Ah); } } while (0)
        __syncthreads();
        SS_LOAD(0); SS_STORE(0); __syncthreads();
        constexpr int NT = TPB / T;
        for (int tile = 0; tile < NT; ++tile) { const int cb = tile & 1;
            if (tile + 1 < NT) SS_LOAD(tile + 1);
            const LAS float* u_ = U + cb * 1024 + p; const LAS float* d_ = DEC + cb * 32;
#pragma unroll 4
            for (int t = 0; t < T; ++t) {
                const float dec = d_[t], u = u_[t * 32];
                const f32x4 b0 = *(const LAS f32x4*)(Bf + t * 128 + ns * 8), b1 = *(const LAS f32x4*)(Bf + t * 128 + ns * 8 + 4);
                const f32x4 c0 = *(const LAS f32x4*)(Cf + t * 128 + ns * 8), c1 = *(const LAS f32x4*)(Cf + t * 128 + ns * 8 + 4);
                float pt = 0.f;
#pragma unroll
                for (int i = 0; i < 4; ++i) { S[i] = S[i] * dec + b0[i] * u; pt += c0[i] * S[i]; S[4 + i] = S[4 + i] * dec + b1[i] * u; pt += c1[i] * S[4 + i]; }
                pt += __shfl_xor(pt, 32);
                if (F.lane < 32) PART[(F.wave * 32 + t) * 32 + p] = pt;
            }
            __syncthreads();
#pragma unroll
            for (int k = 0; k < 2; ++k) { const int t = (F.tid >> 5) + 16 * k; float y = 0.f;
#pragma unroll
                for (int w = 0; w < 8; ++w) y += PART[(w * 32 + t) * 32 + p];
                const size_t ro = (size_t)(b * TPB + scan_row(dir, tile * T + t));
                if (dir == 0) Y[ro * 1024 + col + p] = (bf16)f2bf(y);
                else { const float yt = y + bf2f(Y[ro * 1024 + col + p]) + dskip * XT[cb * 1024 + t * 32 + p]; const float zz = bf2f(Z[ro * 1024 + col + p]);
                    Y[ro * 1024 + col + p] = (bf16)f2bf(yt * silu_f(zz)); } }
            if (tile + 1 < NT) SS_STORE(cb ^ 1);
            __syncthreads();
        }
#undef SS_LOAD
#undef SS_STORE
    }
}
__device__ __forceinline__ void phase_ssm_gnorm(Frame& F, const float* const* in, int gp, bf16* Y) {
    const int gw = F.vcu * NWAVES + F.wave, NGW = GRID * NWAVES; const float* ng = in[24] + gp * 1024 + 16 * F.lane;
    for (int r = gw; r < M; r += NGW) { v4u* p = (v4u*)(Y + (size_t)r * 1024 + 16 * F.lane); const v4u a = p[0], c = p[1];
        float v[16] = {bflo(a.x), bfhi(a.x), bflo(a.y), bfhi(a.y), bflo(a.z), bfhi(a.z), bflo(a.w), bfhi(a.w), bflo(c.x), bfhi(c.x), bflo(c.y), bfhi(c.y), bflo(c.z), bfhi(c.z), bflo(c.w), bfhi(c.w)};
        float ss = 0.f;
#pragma unroll
        for (int i = 0; i < 16; ++i) ss += v[i] * v[i];
#pragma unroll
        for (int o = 1; o < 32; o <<= 1) ss += __shfl_xor(ss, o);
        const float rs = rsqrtf(ss * (1.f / 512.f) + EPS);
        v4u o0, o1;
        o0.x = cvt_pk_bf16(v[0] * rs * ng[0], v[1] * rs * ng[1]); o0.y = cvt_pk_bf16(v[2] * rs * ng[2], v[3] * rs * ng[3]); o0.z = cvt_pk_bf16(v[4] * rs * ng[4], v[5] * rs * ng[5]); o0.w = cvt_pk_bf16(v[6] * rs * ng[6], v[7] * rs * ng[7]);
        o1.x = cvt_pk_bf16(v[8] * rs * ng[8], v[9] * rs * ng[9]); o1.y = cvt_pk_bf16(v[10] * rs * ng[10], v[11] * rs * ng[11]); o1.z = cvt_pk_bf16(v[12] * rs * ng[12], v[13] * rs * ng[13]); o1.w = cvt_pk_bf16(v[14] * rs * ng[14], v[15] * rs * ng[15]);
        p[0] = o0; p[1] = o1; }
}


__device__ __forceinline__ void phase_ssm_scan_mfma(Frame& F, const float* const* in, int gp, const bf16* XS, const bf16* BC, const float* DT, const float* ACUM, bf16* Yf, bf16* Yb) {
    constexpr int BSTR = 272, XSTR = 160;
    LAS unsigned char* Bl = F.lds;
    LAS unsigned char* Cl = F.lds + 17408;
    LAS unsigned char* Xl = F.lds + 34816;
    LAS unsigned char* Xw = F.lds + 45056;
    LAS float* AC = (LAS float*)(F.lds + 55296);
    LAS float* DTs = (LAS float*)(F.lds + 55296 + 256);
    LAS unsigned char* Sb = F.lds + 55808;
    const int it = F.vcu, b = it >> 5, dir = (it >> 4) & 1, hl = it & 15, gl = hl >> 3;
    bf16* Y = dir == 0 ? Yf : Yb;
    const float dsk = in[23][dir * 32 + gp * 16 + hl];
    const int tid = F.tid, lane = F.lane, w = F.wave, fr = lane & 15, fq = lane >> 4, lq = (lane & 15) >> 2, lp = lane & 3;
    const int ph = w >> 2, lt = ph ? 3 - (w & 3) : (w & 3);
    for (int i = tid; i < 64 * BSTR / 16; i += NTHR) *(LAS v4u*)(Sb + i * 16) = (v4u){0u, 0u, 0u, 0u};
    f32x4 sacc[4];
#pragma unroll
    for (int i = 0; i < 4; ++i) sacc[i] = (f32x4){0.f, 0.f, 0.f, 0.f};
    constexpr int PF = SSD_PF;
    v4u rB[PF][2], rC[PF][2], rX[PF]; float rac[PF], ral[PF], rdt[PF];
    const int xr = tid >> 3, xc = tid & 7;
#define SM_LOAD(S, ckv) do { const int _ck = (ckv) < 68 ? (ckv) : 67; \
        _Pragma("unroll") for (int _i = 0; _i < 2; ++_i) { const int _c = tid + 512 * _i; const size_t _r = (size_t)(b * TPB + scan_row(dir, _ck * 64 + (_c >> 4))); \
            rB[S][_i] = *(const v4u*)(BC + _r * 512 + gl * 128 + (_c & 15) * 8); rC[S][_i] = *(const v4u*)(BC + _r * 512 + 256 + gl * 128 + (_c & 15) * 8); } \
        { const size_t _r = (size_t)(b * TPB + scan_row(dir, _ck * 64 + xr)); const size_t _rl = (size_t)(b * TPB + scan_row(dir, _ck * 64 + 63)); rX[S] = *(const v4u*)(XS + _r * 1024 + hl * 64 + xc * 8); \
          rac[S] = ACUM[_r * 32 + dir * 16 + hl]; ral[S] = ACUM[_rl * 32 + dir * 16 + hl]; rdt[S] = DT[_r * 32 + dir * 16 + hl]; } } while (0)
#define SM_STORE(S) do { _Pragma("unroll") for (int _i = 0; _i < 2; ++_i) { const int _c = tid + 512 * _i; *(LAS v4u*)(Bl + (_c >> 4) * BSTR + (_c & 15) * 16) = rB[S][_i]; *(LAS v4u*)(Cl + (_c >> 4) * BSTR + (_c & 15) * 16) = rC[S][_i]; } \
        *(LAS v4u*)(Xl + xr * XSTR + xc * 16) = rX[S]; \
        { const float rxs = rdt[S] * fast_exp2(ral[S] - rac[S]); const v4u _x = rX[S]; v4u _o; _o.x = cvt_pk_bf16(bflo(_x.x) * rxs, bfhi(_x.x) * rxs); _o.y = cvt_pk_bf16(bflo(_x.y) * rxs, bfhi(_x.y) * rxs); _o.z = cvt_pk_bf16(bflo(_x.z) * rxs, bfhi(_x.z) * rxs); _o.w = cvt_pk_bf16(bflo(_x.w) * rxs, bfhi(_x.w) * rxs); \
          *(LAS v4u*)(Xw + xr * XSTR + xc * 16) = _o; } \
        if (xc == 0) { AC[xr] = rac[S]; DTs[xr] = rdt[S]; } } while (0)
    SM_LOAD(0, 0); SM_STORE(0);
#pragma unroll
    for (int k = 1; k < PF; ++k) SM_LOAD(k, k);
    __syncthreads();
#pragma unroll 1
    for (int ck0 = 0; ck0 < 68; ck0 += PF) {
#pragma unroll
      for (int u = 0; u < PF; ++u) { const int ck = ck0 + u; const int cur = u & 1;
        SM_LOAD(u, ck + PF);
        const LAS unsigned char* Sc = Sb + cur * (64 * BSTR); LAS unsigned char* Sn = Sb + (cur ^ 1) * (64 * BSTR);
        bf16x8 cf[4], sf[2][4], bfr[4][4];
#pragma unroll
        for (int ks = 0; ks < 4; ++ks) cf[ks] = *(const LAS bf16x8*)(Cl + (16 * lt + fr) * BSTR + (32 * ks + 8 * fq) * 2);
#pragma unroll
        for (int pi = 0; pi < 2; ++pi)
#pragma unroll
            for (int ks = 0; ks < 4; ++ks) sf[pi][ks] = *(const LAS bf16x8*)(Sc + (16 * (2 * ph + pi) + fr) * BSTR + (32 * ks + 8 * fq) * 2);
#pragma unroll
        for (int st = 0; st < 4; ++st) { if (true) {
#pragma unroll
            for (int ks = 0; ks < 4; ++ks) bfr[st][ks] = *(const LAS bf16x8*)(Bl + (16 * st + fr) * BSTR + (32 * ks + 8 * fq) * 2); } }
        const float acl = AC[16 * lt + fr];
        f32x4 acs[4], dts[4];
#pragma unroll
        for (int st = 0; st < 4; ++st) { acs[st] = *(const LAS f32x4*)(AC + 16 * st + 4 * fq); dts[st] = *(const LAS f32x4*)(DTs + 16 * st + 4 * fq); }
        const float gdec = fast_exp2(AC[63]);
        bf16x8 xf[2][2];
#pragma unroll
        for (int ks2 = 0; ks2 < 2; ++ks2) { if (true) {
#pragma unroll
            for (int pi = 0; pi < 2; ++pi) { const LAS unsigned char* xb = Xl + (32 * ks2 + 4 * fq + lq) * XSTR + (16 * (2 * ph + pi) + 4 * lp) * 2;
                const s16x4 v0 = __builtin_amdgcn_ds_read_tr16_b64_v4i16((LAS s16x4*)xb), v1 = __builtin_amdgcn_ds_read_tr16_b64_v4i16((LAS s16x4*)(xb + 16 * XSTR));
                xf[ks2][pi][0] = v0[0]; xf[ks2][pi][1] = v0[1]; xf[ks2][pi][2] = v0[2]; xf[ks2][pi][3] = v0[3]; xf[ks2][pi][4] = v1[0]; xf[ks2][pi][5] = v1[1]; xf[ks2][pi][6] = v1[2]; xf[ks2][pi][7] = v1[3]; } } }
        f32x4 yacc[2];
#pragma unroll
        for (int pi = 0; pi < 2; ++pi) { f32x4 a = (f32x4){0.f, 0.f, 0.f, 0.f};
#pragma unroll
            for (int ks = 0; ks < 4; ++ks) a = __builtin_amdgcn_mfma_f32_16x16x32_bf16(sf[pi][ks], cf[ks], a, 0, 0, 0);
            yacc[pi] = a * fast_exp2(acl); }
        f32x4 pm[4];
#pragma unroll
        for (int st = 0; st < 4; ++st) { pm[st] = (f32x4){0.f, 0.f, 0.f, 0.f};
            if (st <= lt) { f32x4 g = (f32x4){0.f, 0.f, 0.f, 0.f};
#pragma unroll
                for (int ks = 0; ks < 4; ++ks) g = __builtin_amdgcn_mfma_f32_16x16x32_bf16(bfr[st][ks], cf[ks], g, 0, 0, 0);
#pragma unroll
                for (int j = 0; j < 4; ++j) { const bool ok = (16 * st + 4 * fq + j) <= (16 * lt + fr); pm[st][j] = ok ? g[j] * fast_exp2(acl - acs[st][j]) * dts[st][j] : 0.f; } } }
        bf16x8 xwf[2], btf[4][2];
#pragma unroll
        for (int ks2 = 0; ks2 < 2; ++ks2) { const LAS unsigned char* xb = Xw + (32 * ks2 + 8 * fq + lq) * XSTR + (16 * lt + 4 * lp) * 2;
            const s16x4 v0 = __builtin_amdgcn_ds_read_tr16_b64_v4i16((LAS s16x4*)xb), v1 = __builtin_amdgcn_ds_read_tr16_b64_v4i16((LAS s16x4*)(xb + 4 * XSTR));
            xwf[ks2][0] = v0[0]; xwf[ks2][1] = v0[1]; xwf[ks2][2] = v0[2]; xwf[ks2][3] = v0[3]; xwf[ks2][4] = v1[0]; xwf[ks2][5] = v1[1]; xwf[ks2][6] = v1[2]; xwf[ks2][7] = v1[3]; }
#pragma unroll
        for (int i = 0; i < 4; ++i)
#pragma unroll
            for (int ks2 = 0; ks2 < 2; ++ks2) { const LAS unsigned char* bb = Bl + (32 * ks2 + 8 * fq + lq) * BSTR + (16 * (4 * ph + i) + 4 * lp) * 2;
                const s16x4 v0 = __builtin_amdgcn_ds_read_tr16_b64_v4i16((LAS s16x4*)bb), v1 = __builtin_amdgcn_ds_read_tr16_b64_v4i16((LAS s16x4*)(bb + 4 * BSTR));
                btf[i][ks2][0] = v0[0]; btf[i][ks2][1] = v0[1]; btf[i][ks2][2] = v0[2]; btf[i][ks2][3] = v0[3]; btf[i][ks2][4] = v1[0]; btf[i][ks2][5] = v1[1]; btf[i][ks2][6] = v1[2]; btf[i][ks2][7] = v1[3]; }
#pragma unroll
        for (int ks2 = 0; ks2 < 2; ++ks2) { if (2 * ks2 <= lt) { const v4u pw = pack8(pm[2 * ks2], pm[2 * ks2 + 1]); const bf16x8 pf = __builtin_bit_cast(bf16x8, pw);
#pragma unroll
                for (int pi = 0; pi < 2; ++pi) yacc[pi] = __builtin_amdgcn_mfma_f32_16x16x32_bf16(xf[ks2][pi], pf, yacc[pi], 0, 0, 0); } }
        { const size_t ro = (size_t)(b * TPB + scan_row(dir, ck * 64 + 16 * lt + fr));
#pragma unroll
          for (int pi = 0; pi < 2; ++pi) { const v2u xr_ = *(const LAS v2u*)(Xl + (16 * lt + fr) * XSTR + (16 * (2 * ph + pi) + 4 * fq) * 2);
              yacc[pi][0] += dsk * bflo(xr_.x); yacc[pi][1] += dsk * bfhi(xr_.x); yacc[pi][2] += dsk * bflo(xr_.y); yacc[pi][3] += dsk * bfhi(xr_.y);
              v2u o; o.x = cvt_pk_bf16(yacc[pi][0], yacc[pi][1]); o.y = cvt_pk_bf16(yacc[pi][2], yacc[pi][3]);
              *(v2u*)(Y + ro * 1024 + hl * 64 + 16 * (2 * ph + pi) + 4 * fq) = o; } }
#pragma unroll
        for (int i = 0; i < 4; ++i) { const int nt = 4 * ph + i; f32x4 a = sacc[i] * gdec;
#pragma unroll
            for (int ks2 = 0; ks2 < 2; ++ks2) a = __builtin_amdgcn_mfma_f32_16x16x32_bf16(xwf[ks2], btf[i][ks2], a, 0, 0, 0);
            sacc[i] = a;
#pragma unroll
            for (int j = 0; j < 4; ++j) *(LAS bf16*)(Sn + (16 * lt + 4 * fq + j) * BSTR + (16 * nt + fr) * 2) = (bf16)f2bf(a[j]); }
        __syncthreads();
        if (ck + 1 < 68) SM_STORE((u + 1) % PF);
        __syncthreads();
      } }
#undef SM_LOAD
#undef SM_STORE
}
struct GnRow { float v[16]; float ss; };
__device__ __forceinline__ void gn2_load(GnRow& R, const bf16* Yf, const bf16* Yb, const bf16* Z, size_t off) {
    const v4u a0 = *(const v4u*)(Yf + off), a1 = *(const v4u*)(Yf + off + 8), b0 = *(const v4u*)(Yb + off), b1 = *(const v4u*)(Yb + off + 8);
    const v4u z0 = *(const v4u*)(Z + off), z1 = *(const v4u*)(Z + off + 8);
    const unsigned aw[8] = {a0.x, a0.y, a0.z, a0.w, a1.x, a1.y, a1.z, a1.w}, bw[8] = {b0.x, b0.y, b0.z, b0.w, b1.x, b1.y, b1.z, b1.w};
    const unsigned zw[8] = {z0.x, z0.y, z0.z, z0.w, z1.x, z1.y, z1.z, z1.w};
    float ss = 0.f;
#pragma unroll
    for (int i = 0; i < 8; ++i) { R.v[2 * i] = (bflo(aw[i]) + bflo(bw[i])) * silu_f(bflo(zw[i])); R.v[2 * i + 1] = (bfhi(aw[i]) + bfhi(bw[i])) * silu_f(bfhi(zw[i]));
        ss += R.v[2 * i] * R.v[2 * i] + R.v[2 * i + 1] * R.v[2 * i + 1]; }
    R.ss = ss;
}
__device__ __forceinline__ void gn_store(const GnRow& R, float rs, const float (&ng)[16], bf16* dst) {
    unsigned res[8];
#pragma unroll
    for (int i = 0; i < 8; ++i) res[i] = cvt_pk_bf16(R.v[2 * i] * rs * ng[2 * i], R.v[2 * i + 1] * rs * ng[2 * i + 1]);
    *(v4u*)(dst) = (v4u){res[0], res[1], res[2], res[3]}; *(v4u*)(dst + 8) = (v4u){res[4], res[5], res[6], res[7]};
}
__device__ __forceinline__ void phase_ssm_gnorm2(Frame& F, const float* const* in, int gp, bf16* Yf, const bf16* Yb, const bf16* XS, const bf16* Z, bf16* dst = nullptr) {
    if (!dst) dst = Yf;
    const int gw = F.vcu * NWAVES + F.wave, NGW = GRID * NWAVES; float ng[16];
#pragma unroll
    for (int i = 0; i < 16; ++i) ng[i] = in[24][gp * 1024 + 16 * F.lane + i];
    for (int r0 = gw; r0 < M; r0 += 4 * NGW) { GnRow R[4]; size_t of[4]; bool ok[4];
#pragma unroll
        for (int q = 0; q < 4; ++q) { const int r = r0 + q * NGW; ok[q] = r < M; of[q] = (size_t)(ok[q] ? r : r0) * 1024 + 16 * F.lane; gn2_load(R[q], Yf, Yb, Z, of[q]); }
#pragma unroll
        for (int o = 1; o < 32; o <<= 1) {
#pragma unroll
            for (int q = 0; q < 4; ++q) R[q].ss += __shfl_xor(R[q].ss, o); }
#pragma unroll
        for (int q = 0; q < 4; ++q) if (ok[q]) gn_store(R[q], rsqrtf(R[q].ss * (1.f / 512.f) + EPS), ng, dst + of[q]); }
}

__device__ __forceinline__ void phase_mlstm_scan(Frame& F, const bf16* Qm, const bf16* Km, const bf16* Vm, const float* G, bf16* Hf, bf16* Hb) {
    constexpr int T = 32;
    LAS float* Qf = (LAS float*)F.lds;
    LAS float* KW = (LAS float*)(F.lds + 8192);
    LAS float* Vf = (LAS float*)(F.lds + 16384);
    LAS float* FD = (LAS float*)(F.lds + 24576);
    LAS float* IW = (LAS float*)(F.lds + 24576 + 256);
    LAS float* EM = (LAS float*)(F.lds + 24576 + 512);
    LAS float* PN = (LAS float*)(F.lds + 32768);
    LAS float* PD = (LAS float*)(F.lds + 32768 + 65536);
    const int it = blockIdx.x, b = it >> 5, dir = (it >> 4) & 1, head = (it >> 1) & 7, jh = it & 1;
    bf16* Hout = dir == 0 ? Hf : Hb;
    const int w = F.wave, lane = F.lane, d7 = 8 * w + (lane & 7);
    float C[8], nst = 0.f, m_in = 0.f;
#pragma unroll
    for (int i = 0; i < 8; ++i) C[i] = 0.f;
    const int st = (F.tid & 255) >> 3, sch = F.tid & 7;
    v4u r0, r1; float gi = 0.f, gf = 0.f;
#define ML_LOAD(tile) do { const size_t _r = (size_t)(b * TPB + scan_row(dir, (tile) * T + st)); \
        if (F.tid < 256) { r0 = *(const v4u*)(Qm + _r * 512 + head * 64 + sch * 8); r1 = *(const v4u*)(Vm + _r * 1024 + head * 128 + jh * 64 + sch * 8); } \
        else { r0 = *(const v4u*)(Km + _r * 512 + head * 64 + sch * 8); } \
        if (F.tid < 32) { const size_t _g = (size_t)(b * TPB + scan_row(dir, (tile) * T + F.tid)); gi = G[_g * 32 + (2 * dir) * 8 + head]; gf = G[_g * 32 + (2 * dir + 1) * 8 + head]; } } while (0)
#define UNPK(dst, r) do { *(LAS f32x4*)(dst) = (f32x4){bflo(r.x), bfhi(r.x), bflo(r.y), bfhi(r.y)}; *(LAS f32x4*)((dst) + 4) = (f32x4){bflo(r.z), bfhi(r.z), bflo(r.w), bfhi(r.w)}; } while (0)
#define ML_GATES(nb) do { if (w == 0) { float Fc = lane < 32 ? gf : 0.f; \
            _Pragma("unroll") for (int o = 1; o < 32; o <<= 1) { const float t_ = __shfl_up(Fc, o); if (lane >= o) Fc += t_; } \
            float Gm = lane < 32 ? gi - Fc : -3.0e38f; \
            _Pragma("unroll") for (int o = 1; o < 32; o <<= 1) { const float t_ = __shfl_up(Gm, o); if (lane >= o) Gm = fmaxf(Gm, t_); } \
            const float mt = Fc + fmaxf(m_in, Gm); float mp = __shfl_up(mt, 1); if (lane == 0) mp = m_in; \
            if (lane < 32) { FD[(nb) * 32 + lane] = fast_exp2((gf + mp - mt) * LOG2E); IW[(nb) * 32 + lane] = fast_exp2((gi - mt) * LOG2E); EM[(nb) * 32 + lane] = fast_exp2(-mt * LOG2E); } \
            m_in = __shfl(mt, 31); } } while (0)
    __syncthreads();
    ML_LOAD(0); ML_GATES(0);
    if (F.tid < 256) { UNPK(Qf + st * 64 + sch * 8, r0); UNPK(Vf + st * 64 + sch * 8, r1); }
    __syncthreads();
    if (F.tid >= 256) { const float iw = IW[st]; LAS float* dk = KW + st * 64 + sch * 8;
        *(LAS f32x4*)dk = (f32x4){bflo(r0.x), bfhi(r0.x), bflo(r0.y), bfhi(r0.y)} * iw; *(LAS f32x4*)(dk + 4) = (f32x4){bflo(r0.z), bfhi(r0.z), bflo(r0.w), bfhi(r0.w)} * iw; }
    __syncthreads();
    constexpr int NT = TPB / T;
    for (int tile = 0; tile < NT; ++tile) { const int cb = tile & 1;
        if (tile + 1 < NT) ML_LOAD(tile + 1);
#pragma unroll 4
        for (int t = 0; t < T; ++t) {
            const float fd = FD[cb * 32 + t], v = Vf[t * 64 + lane];
            const f32x4 q0 = *(const LAS f32x4*)(Qf + t * 64 + 8 * w), q1 = *(const LAS f32x4*)(Qf + t * 64 + 8 * w + 4);
            const f32x4 k0 = *(const LAS f32x4*)(KW + t * 64 + 8 * w), k1 = *(const LAS f32x4*)(KW + t * 64 + 8 * w + 4);
            float pn = 0.f;
#pragma unroll
            for (int i = 0; i < 4; ++i) { C[i] = C[i] * fd + k0[i] * v; pn += q0[i] * C[i]; C[4 + i] = C[4 + i] * fd + k1[i] * v; pn += q1[i] * C[4 + i]; }
            PN[(w * 32 + t) * 64 + lane] = pn;
            nst = nst * fd + KW[t * 64 + d7];
            float pd = Qf[t * 64 + d7] * nst;
            pd += __shfl_xor(pd, 1); pd += __shfl_xor(pd, 2); pd += __shfl_xor(pd, 4);
            if (lane == 0) PD[w * 32 + t] = pd;
        }
        __syncthreads();
#pragma unroll
        for (int k = 0; k < 4; ++k) { const int t = (F.tid >> 6) + 8 * k; float num = 0.f, den = 0.f;
#pragma unroll
            for (int ww = 0; ww < 8; ++ww) { num += PN[(ww * 32 + t) * 64 + lane]; den += PD[ww * 32 + t]; }
            const float h = num / fmaxf(fabsf(den), EM[cb * 32 + t]);
            Hout[(size_t)(b * TPB + scan_row(dir, tile * T + t)) * 1024 + head * 128 + jh * 64 + lane] = (bf16)f2bf(h); }
        if (tile + 1 < NT) { ML_GATES(cb ^ 1); if (F.tid < 256) { UNPK(Qf + st * 64 + sch * 8, r0); UNPK(Vf + st * 64 + sch * 8, r1); } }
        __syncthreads();
        if (tile + 1 < NT && F.tid >= 256) { const float iw = IW[(cb ^ 1) * 32 + st]; LAS float* dk = KW + st * 64 + sch * 8;
            *(LAS f32x4*)dk = (f32x4){bflo(r0.x), bfhi(r0.x), bflo(r0.y), bfhi(r0.y)} * iw; *(LAS f32x4*)(dk + 4) = (f32x4){bflo(r0.z), bfhi(r0.z), bflo(r0.w), bfhi(r0.w)} * iw; }
        __syncthreads();
    }
#undef ML_LOAD
#undef ML_GATES
#undef UNPK
}

__device__ __forceinline__ void phase_mlstm_scan_mfma(Frame& F, const bf16* Qm, const bf16* Km, const bf16* Vm, const float* G, bf16* Hf, bf16* Hb) {
    constexpr int QSTR = 144, WSTR = 160, VSTR = 176, CSTR = 144;
    LAS unsigned char* Ql = F.lds;
    LAS unsigned char* Kl = F.lds + 9216;
    LAS unsigned char* Kw = F.lds + 18432;
    LAS unsigned char* Vl = F.lds + 28672;
    LAS unsigned char* Cb = F.lds + 39936;
    LAS float* GB = (LAS float*)(F.lds + 62976);
    const int it = F.vcu, b = it >> 5, dir = (it >> 4) & 1, head = (it >> 1) & 7, jh = it & 1;
    bf16* Hout = dir == 0 ? Hf : Hb;
    const int tid = F.tid, lane = F.lane, w = F.wave, fr = lane & 15, fq = lane >> 4, lq = (lane & 15) >> 2, lp = lane & 3;
    const int jg = w >> 2, lt = jg ? 3 - (w & 3) : (w & 3);
    for (int i = tid; i < 80 * CSTR / 16; i += NTHR) *(LAS v4u*)(Cb + i * 16) = (v4u){0u, 0u, 0u, 0u};
    for (int i = tid; i < 64 * 2; i += NTHR) { const int s = i >> 1, hh = i & 1; *(LAS v4u*)(Vl + s * VSTR + 128 + hh * 16) = hh == 0 ? (v4u){0x3F80u, 0u, 0u, 0u} : (v4u){0u, 0u, 0u, 0u}; }
    f32x4 sacc[3];
#pragma unroll
    for (int i = 0; i < 3; ++i) sacc[i] = (f32x4){0.f, 0.f, 0.f, 0.f};
    constexpr int PF = ML_PF;
    v4u rQ[PF], rK[PF], rV[PF]; float gi[PF], gf[PF]; float m_in = 0.f;
    const int sr = tid >> 3, sc = tid & 7;
#define MM_LOAD(S, ckv) do { const int _ck = (ckv) < 68 ? (ckv) : 67; const size_t _r = (size_t)(b * TPB + scan_row(dir, _ck * 64 + sr)); \
        rQ[S] = *(const v4u*)(Qm + _r * 512 + head * 64 + sc * 8); rK[S] = *(const v4u*)(Km + _r * 512 + head * 64 + sc * 8); rV[S] = *(const v4u*)(Vm + _r * 1024 + head * 128 + jh * 64 + sc * 8); \
        { const size_t _g = (size_t)(b * TPB + scan_row(dir, _ck * 64 + lane)); gi[S] = G[_g * 32 + (2 * dir) * 8 + head]; gf[S] = G[_g * 32 + (2 * dir + 1) * 8 + head]; } } while (0)
#define MM_GSCAN(S, GP) do { if (w == 0) { LAS float* _g = (GP); const float gil = gi[S] * LOG2E; const float Fc = wave_scan_sum(gf[S] * LOG2E); \
            const float Gm = wave_scan_max(gil - Fc); \
            const float mt = Fc + fmaxf(m_in, Gm); _g[lane] = Fc; _g[64 + lane] = gil; _g[128 + lane] = mt; \
            if (lane == 63) { _g[192] = Fc; _g[193] = m_in; _g[194] = mt; } \
            m_in = __shfl(mt, 63); } } while (0)
#define MM_STAGE(S, GP) do { const LAS float* _g = (GP); \
        *(LAS v4u*)(Ql + sr * QSTR + sc * 16) = rQ[S]; *(LAS v4u*)(Kl + sr * QSTR + sc * 16) = rK[S]; *(LAS v4u*)(Vl + sr * VSTR + sc * 16) = rV[S]; \
        const float ws_ = fast_exp2(_g[192] - _g[sr] + _g[64 + sr] - _g[194]); const v4u _k = rK[S]; v4u _o; \
        _o.x = cvt_pk_bf16(bflo(_k.x) * ws_, bfhi(_k.x) * ws_); _o.y = cvt_pk_bf16(bflo(_k.y) * ws_, bfhi(_k.y) * ws_); _o.z = cvt_pk_bf16(bflo(_k.z) * ws_, bfhi(_k.z) * ws_); _o.w = cvt_pk_bf16(bflo(_k.w) * ws_, bfhi(_k.w) * ws_); \
        *(LAS v4u*)(Kw + sr * WSTR + sc * 16) = _o; } while (0)
    __syncthreads();
    MM_LOAD(0, 0); MM_GSCAN(0, GB); __syncthreads(); MM_STAGE(0, GB);
#pragma unroll
    for (int k = 1; k < PF; ++k) MM_LOAD(k, k);
    __syncthreads();
#pragma unroll 1
    for (int ck0 = 0; ck0 < 68; ck0 += PF) {
#pragma unroll
      for (int u = 0; u < PF; ++u) { const int ck = ck0 + u; const int cur = u & 1;
        const LAS float* BCU = GB + cur * 256; const LAS float* IGA = BCU + 64; const LAS float* MTA = BCU + 128; const LAS float* SCA = BCU + 192;
        if (ck + 1 < 68) MM_GSCAN((u + 1) % PF, GB + (cur ^ 1) * 256);
        MM_LOAD(u, ck + PF);
        const LAS unsigned char* Cc = Cb + cur * (80 * CSTR); LAS unsigned char* Cn = Cb + (cur ^ 1) * (80 * CSTR);
        bf16x8 qf[2], cfr[3][2], kfr[4][2];
#pragma unroll
        for (int ks = 0; ks < 2; ++ks) qf[ks] = *(const LAS bf16x8*)(Ql + (16 * lt + fr) * QSTR + (32 * ks + 8 * fq) * 2);
#pragma unroll
        for (int ji = 0; ji < 3; ++ji) { const int row = ji < 2 ? 16 * (2 * jg + ji) + fr : 64 + fr;
#pragma unroll
            for (int ks = 0; ks < 2; ++ks) cfr[ji][ks] = *(const LAS bf16x8*)(Cc + row * CSTR + (32 * ks + 8 * fq) * 2); }
#pragma unroll
        for (int st = 0; st < 4; ++st) { if (st <= lt) {
#pragma unroll
            for (int ks = 0; ks < 2; ++ks) kfr[st][ks] = *(const LAS bf16x8*)(Kl + (16 * st + fr) * QSTR + (32 * ks + 8 * fq) * 2); } }
        const float bl = BCU[16 * lt + fr], ml = MTA[16 * lt + fr], m0 = SCA[1];
        f32x4 bsv[4], isv[4];
#pragma unroll
        for (int st = 0; st < 4; ++st) { bsv[st] = *(const LAS f32x4*)(BCU + 16 * st + 4 * fq); isv[st] = *(const LAS f32x4*)(IGA + 16 * st + 4 * fq); }
        const float gdec = fast_exp2(SCA[0] + m0 - SCA[2]);
        bf16x8 vfr[2][2];
#pragma unroll
        for (int ks2 = 0; ks2 < 2; ++ks2) { if (2 * ks2 <= lt) {
#pragma unroll
            for (int ji = 0; ji < 2; ++ji) { const LAS unsigned char* vb = Vl + (32 * ks2 + 4 * fq + lq) * VSTR + (16 * (2 * jg + ji) + 4 * lp) * 2;
                const s16x4 v0 = __builtin_amdgcn_ds_read_tr16_b64_v4i16((LAS s16x4*)vb), v1 = __builtin_amdgcn_ds_read_tr16_b64_v4i16((LAS s16x4*)(vb + 16 * VSTR));
                vfr[ks2][ji][0] = v0[0]; vfr[ks2][ji][1] = v0[1]; vfr[ks2][ji][2] = v0[2]; vfr[ks2][ji][3] = v0[3]; vfr[ks2][ji][4] = v1[0]; vfr[ks2][ji][5] = v1[1]; vfr[ks2][ji][6] = v1[2]; vfr[ks2][ji][7] = v1[3]; } } }
        const float dl = fast_exp2(bl + m0 - ml);
        f32x4 nacc[2]; float den;
#pragma unroll
        for (int ji = 0; ji < 2; ++ji) { f32x4 a = (f32x4){0.f, 0.f, 0.f, 0.f};
#pragma unroll
            for (int ks = 0; ks < 2; ++ks) a = __builtin_amdgcn_mfma_f32_16x16x32_bf16(cfr[ji][ks], qf[ks], a, 0, 0, 0);
            nacc[ji] = a * dl; }
        { f32x4 a = (f32x4){0.f, 0.f, 0.f, 0.f};
#pragma unroll
          for (int ks = 0; ks < 2; ++ks) a = __builtin_amdgcn_mfma_f32_16x16x32_bf16(cfr[2][ks], qf[ks], a, 0, 0, 0);
          den = __shfl(a[0], fr) * dl; }
        f32x4 pm[4]; float dsum = 0.f;
#pragma unroll
        for (int st = 0; st < 4; ++st) { pm[st] = (f32x4){0.f, 0.f, 0.f, 0.f};
            if (st <= lt) { f32x4 g = (f32x4){0.f, 0.f, 0.f, 0.f};
#pragma unroll
                for (int ks = 0; ks < 2; ++ks) g = __builtin_amdgcn_mfma_f32_16x16x32_bf16(kfr[st][ks], qf[ks], g, 0, 0, 0);
#pragma unroll
                for (int j = 0; j < 4; ++j) { const bool ok = (16 * st + 4 * fq + j) <= (16 * lt + fr); const float v = ok ? g[j] * fast_exp2(bl - bsv[st][j] + isv[st][j] - ml) : 0.f; pm[st][j] = v; dsum += v; } } }
        bf16x8 kwf[2], vtf[3][2];
#pragma unroll
        for (int ks2 = 0; ks2 < 2; ++ks2) { const LAS unsigned char* kb = Kw + (32 * ks2 + 8 * fq + lq) * WSTR + (16 * lt + 4 * lp) * 2;
            const s16x4 v0 = __builtin_amdgcn_ds_read_tr16_b64_v4i16((LAS s16x4*)kb), v1 = __builtin_amdgcn_ds_read_tr16_b64_v4i16((LAS s16x4*)(kb + 4 * WSTR));
            kwf[ks2][0] = v0[0]; kwf[ks2][1] = v0[1]; kwf[ks2][2] = v0[2]; kwf[ks2][3] = v0[3]; kwf[ks2][4] = v1[0]; kwf[ks2][5] = v1[1]; kwf[ks2][6] = v1[2]; kwf[ks2][7] = v1[3]; }
#pragma unroll
        for (int i = 0; i < 3; ++i) { if (jg == 0 || i < 2) { const int jt = jg == 0 ? i : 3 + i;
#pragma unroll
            for (int ks2 = 0; ks2 < 2; ++ks2) { const LAS unsigned char* vb = Vl + (32 * ks2 + 8 * fq + lq) * VSTR + (16 * jt + 4 * lp) * 2;
                const s16x4 v0 = __builtin_amdgcn_ds_read_tr16_b64_v4i16((LAS s16x4*)vb), v1 = __builtin_amdgcn_ds_read_tr16_b64_v4i16((LAS s16x4*)(vb + 4 * VSTR));
                vtf[i][ks2][0] = v0[0]; vtf[i][ks2][1] = v0[1]; vtf[i][ks2][2] = v0[2]; vtf[i][ks2][3] = v0[3]; vtf[i][ks2][4] = v1[0]; vtf[i][ks2][5] = v1[1]; vtf[i][ks2][6] = v1[2]; vtf[i][ks2][7] = v1[3]; } } }
        dsum += __shfl_xor(dsum, 16); dsum += xor32(dsum);
        den += dsum;
#pragma unroll
        for (int ks2 = 0; ks2 < 2; ++ks2) { if (2 * ks2 <= lt) { const v4u pw = pack8(pm[2 * ks2], pm[2 * ks2 + 1]); const bf16x8 pf = __builtin_bit_cast(bf16x8, pw);
#pragma unroll
                for (int ji = 0; ji < 2; ++ji) nacc[ji] = __builtin_amdgcn_mfma_f32_16x16x32_bf16(vfr[ks2][ji], pf, nacc[ji], 0, 0, 0); } }
        { const float inv = 1.0f / fmaxf(fabsf(den), fast_exp2(-ml)); const size_t ro = (size_t)(b * TPB + scan_row(dir, ck * 64 + 16 * lt + fr));
#pragma unroll
          for (int ji = 0; ji < 2; ++ji) { v2u o; o.x = cvt_pk_bf16(nacc[ji][0] * inv, nacc[ji][1] * inv); o.y = cvt_pk_bf16(nacc[ji][2] * inv, nacc[ji][3] * inv);
              *(v2u*)(Hout + ro * 1024 + head * 128 + jh * 64 + 16 * (2 * jg + ji) + 4 * fq) = o; } }
#pragma unroll
        for (int i = 0; i < 3; ++i) { if (jg == 0 || i < 2) { const int jt = jg == 0 ? i : 3 + i; f32x4 a = sacc[i] * gdec;
#pragma unroll
            for (int ks2 = 0; ks2 < 2; ++ks2) a = __builtin_amdgcn_mfma_f32_16x16x32_bf16(vtf[i][ks2], kwf[ks2], a, 0, 0, 0);
            sacc[i] = a;
#pragma unroll
            for (int j = 0; j < 4; ++j) *(LAS bf16*)(Cn + (16 * jt + 4 * fq + j) * CSTR + (16 * lt + fr) * 2) = (bf16)f2bf(a[j]); } }
        __syncthreads();
        if (ck + 1 < 68) MM_STAGE((u + 1) % PF, GB + (cur ^ 1) * 256);
        __syncthreads();
      } }
#undef MM_LOAD
#undef MM_GSCAN
#undef MM_STAGE
}

__device__ __forceinline__ void mg_load(GnRow& R, unsigned (&ow)[8], const bf16* Hf, const bf16* Hb, const bf16* Om, size_t off) {
    const v4u a0 = *(const v4u*)(Hf + off), a1 = *(const v4u*)(Hf + off + 8), b0 = *(const v4u*)(Hb + off), b1 = *(const v4u*)(Hb + off + 8), o0 = *(const v4u*)(Om + off), o1 = *(const v4u*)(Om + off + 8);
    const unsigned aw[8] = {a0.x, a0.y, a0.z, a0.w, a1.x, a1.y, a1.z, a1.w}, bw[8] = {b0.x, b0.y, b0.z, b0.w, b1.x, b1.y, b1.z, b1.w};
    ow[0] = o0.x; ow[1] = o0.y; ow[2] = o0.z; ow[3] = o0.w; ow[4] = o1.x; ow[5] = o1.y; ow[6] = o1.z; ow[7] = o1.w;
    float ss = 0.f;
#pragma unroll
    for (int i = 0; i < 8; ++i) { R.v[2 * i] = bflo(aw[i]) + bflo(bw[i]); R.v[2 * i + 1] = bfhi(aw[i]) + bfhi(bw[i]); ss += R.v[2 * i] * R.v[2 * i] + R.v[2 * i + 1] * R.v[2 * i + 1]; }
    R.ss = ss;
}
__device__ __forceinline__ void mg_store(const GnRow& R, const unsigned (&ow)[8], float rs, const float (&ng)[16], bf16* dst) {
    unsigned res[8];
#pragma unroll
    for (int i = 0; i < 8; ++i) res[i] = cvt_pk_bf16(R.v[2 * i] * rs * ng[2 * i] * sigmoid_f(bflo(ow[i])), R.v[2 * i + 1] * rs * ng[2 * i + 1] * sigmoid_f(bfhi(ow[i])));
    *(v4u*)(dst) = (v4u){res[0], res[1], res[2], res[3]}; *(v4u*)(dst + 8) = (v4u){res[4], res[5], res[6], res[7]};
}
__device__ __forceinline__ void phase_mlstm_gnorm(Frame& F, const float* const* in, const bf16* Hf, const bf16* Hb, const bf16* Om, bf16* Hn) {
    const int gw = F.vcu * NWAVES + F.wave, NGW = GRID * NWAVES; float ng[16];
#pragma unroll
    for (int i = 0; i < 16; ++i) ng[i] = in[28][16 * F.lane + i];
    for (int r0 = gw; r0 < M; r0 += 4 * NGW) { GnRow R[4]; unsigned ww[4][8]; size_t of[4]; bool ok[4];
#pragma unroll
        for (int q = 0; q < 4; ++q) { const int r = r0 + q * NGW; ok[q] = r < M; of[q] = (size_t)(ok[q] ? r : r0) * 1024 + 16 * F.lane; mg_load(R[q], ww[q], Hf, Hb, Om, of[q]); }
#pragma unroll
        for (int o = 1; o < 8; o <<= 1) {
#pragma unroll
            for (int q = 0; q < 4; ++q) R[q].ss += __shfl_xor(R[q].ss, o); }
#pragma unroll
        for (int q = 0; q < 4; ++q) if (ok[q]) mg_store(R[q], ww[q], rsqrtf(R[q].ss * (1.f / 128.f) + EPS), ng, Hn + of[q]); }
}
struct Args { const float* in[37]; float* out; unsigned char* ws; };

__device__ __forceinline__ void moe_phases(Frame& F, const float* const* in, int layer, const XcdBarrier& bar) {
#if defined(PROBE_ROUTE2)
    phase_norm2_route(F, in, layer, true); __syncthreads();
#endif
    phase_norm2_route(F, in, layer);
    SYNC_GRID();
    bf16* Hb = (bf16*)(F.ws + WS_H); bf16* ACT = (bf16*)(F.ws + MOE_ACT); bf16* X = (bf16*)(F.ws + WS_X);
    const float* mod = (const float*)(F.ws + WS_MOD) + (size_t)layer * 9 * 6144;
    { MoeOrder<0> S; S.W = (const bf16*)(F.ws + WS_WGU + wofs(layer)); S.G = GRID; S.c = F.vcu; moe_setup(F, layer, S);
      pg8::Gemm g{Hb, 1024, 1024, 1 << 30}; EpiMoeAct E{ACT, S.tbl};
      pg8::gemm_phase(F.lds, g, S, E);
#if defined(PROBE_GM1)
      __syncthreads(); pg8::gemm_phase(F.lds, g, S, E);
#endif
      }
    if (layer < 3 && F.vcu >= 128) { __syncthreads(); refresh(F); phase_mod(F, in, layer + 1, layer + 2, F.vcu - 128, 128); }
    SYNC_GRID();
    { MoeOrder<1> S; S.W = (const bf16*)(F.ws + WS_WDN + wofs(layer)); S.G = GRID; S.c = F.vcu; moe_setup(F, layer, S);
      pg8::Gemm g{ACT, 512, 256, 4};
#if defined(PROBE_OUT2)
      { EpiMoeDown E0{X, (const float*)(F.ws + WS_CTL + 262144), S.tbl}; pg8::gemm_phase(F.lds, g, S, E0); VM_WAIT(); __syncthreads(); __builtin_amdgcn_fence(__ATOMIC_ACQUIRE, "agent"); VM_WAIT(); __syncthreads(); refresh(F); }
#endif
      EpiMoeDown E{X, mod + 5 * 1024, S.tbl};
      pg8::gemm_phase(F.lds, g, S, E); }
    SYNC_GRID();
}
__device__ __forceinline__ void outproj_phase(Frame& F, const float* const* in, const bf16* A, const bf16* Wt, int K, int ldb, int layer, int conv_next, const float* xin = nullptr, const float* cin = nullptr) {
    pg8::Gemm g{A, K, ldb, 1 << 30}; pg8::StaticOrder S; S.init(M, 1024, GRID, (int)blockIdx.x, Wt, ldb, layer == 3);
    EpiResid E{(bf16*)(F.ws + WS_X), (const float*)(F.ws + WS_MOD) + (size_t)layer * 9 * 6144 + 2 * 1024, xin, cin};
    pg8::gemm_phase(F.lds, g, S, E);
    if (conv_next >= 0 && blockIdx.x >= 32) { refresh(F); ConvGrid cg; cg.gw = ((int)blockIdx.x - 32) * NWAVES + F.wave; cg.ngw = (GRID - 32) * NWAVES; convert_layer(F, cg, in, conv_next); }
}

__device__ __forceinline__ void ssm_inproj(Frame& F, const float* const* in, const int gp, const int c, bf16* Z, bf16* PRE, float* DT) {
    const bf16* H = (const bf16*)(F.ws + WS_H); const bf16* WM = (const bf16*)(F.ws + WS_WMIX + wofs(1));
    pg8::Gemm g{H, 1024, 1024, 1 << 30}; pg8::StaticOrder S; S.init(M, 2816, GRID, c, WM + (size_t)gp * 2816 * 1024, 1024);
    EpiSsmIn E{Z, PRE, DT, in[21] + gp * 16};
    pg8::gemm_phase(F.lds, g, S, E);
}
__device__ __forceinline__ void ssm_gp_phases(Frame& F, const float* const* in, const int gp, const XcdBarrier& bar) {
    unsigned char* scr = F.ws + WS_SCR; unsigned char* scr2 = (unsigned char*)F.out; bf16* WM = (bf16*)(F.ws + WS_WMIX + wofs(1));
    bf16* Z = (bf16*)scr; bf16* XP = (bf16*)(scr + 68 * MiB); bf16* XS = (bf16*)(scr + 170 * MiB); float* DT = (float*)(scr + 238 * MiB); float* ACUM = (float*)(scr + 243 * MiB); bf16* Yb = (bf16*)(scr2 + 34 * MiB);
    bf16* PRE = gp == 0 ? XP : (bf16*)scr2; bf16* BC = gp == 0 ? (bf16*)scr2 : (bf16*)(scr + 136 * MiB);
    if (gp == 0) { ssm_inproj(F, in, 0, (int)blockIdx.x, Z, PRE, DT); SYNC_GRID(); }
    phase_ssm_conv(F, in, gp, PRE, XS, BC, DT, ACUM);
    SYNC_GRID();
    phase_ssm_scan_mfma(F, in, gp, XS, BC, DT, ACUM, XP, Yb);
    SYNC_GRID();
    phase_ssm_gnorm2(F, in, gp, XP, Yb, XS, Z);
    SYNC_GRID();
    if (gp == 0) {
        outproj_phase(F, in, XP, WM + 6 * MiB, 1024, 2048, 1, -1);
        __syncthreads(); refresh(F);
        ssm_inproj(F, in, 1, ((int)blockIdx.x + 224) & 255, Z, (bf16*)scr2, DT);
    } else outproj_phase(F, in, XP, WM + 6 * MiB + 1024, 1024, 2048, 1, 2);
    SYNC_GRID();
}

__global__ void __launch_bounds__(NTHR, 2) fwd_kernel(Args args) {
    extern __shared__ __attribute__((aligned(16))) unsigned char lds_raw[];
    Frame F;
    F.lds = (LAS unsigned char*)lds_raw; F.ws = args.ws; F.ctl = (unsigned*)(args.ws + WS_CTL); F.out = args.out;
    refresh(F);
    { const int bx = blockIdx.x; F.vcu = (bx % 8) * (GRID / 8) + bx / 8; }
    volatile LAS unsigned* MISC = (volatile LAS unsigned*)(F.lds + LDS_MISC);
    for (int u = F.tid; u < 256; u += NTHR) MISC[u] = 0u;
    __syncthreads();
    const XcdBarrier bar = xcd_barrier_post(F.ctl + CW_BAR, MISC + 8);
    const float* const* in = args.in;
    unsigned char* ws = F.ws; unsigned char* scr = ws + WS_SCR; unsigned char* scr2 = (unsigned char*)F.out;
    bf16* H = (bf16*)(ws + WS_H);

#if defined(PROBE_MEM2) || defined(PROBE_PRO2)
    for (int rep = 0; rep < 2; ++rep) {
#endif
    phase_prologue(F, in);
    __syncthreads(); refresh(F);
    convert_layer(F, conv_all(F), in, 0);
#if defined(PROBE_MEM2) || defined(PROBE_PRO2)
    __syncthreads(); }
#endif
    SYNC_GRID();

#ifndef SKIP_L0
    phase_norm1(F, in, 0);
#if defined(PROBE_MEM2)
    phase_norm1(F, in, 0);
#endif
    SYNC_GRID();
    { bf16* WM = (bf16*)(ws + WS_WMIX + wofs(0)); bf16* Q = (bf16*)scr; bf16* Kb = (bf16*)(scr + 68 * MiB); bf16* Vb = (bf16*)(scr + 85 * MiB);
      { pg8::Gemm g{H, 1024, 1024, 1 << 30}; pg8::StaticOrder S; S.init(M, 1536, GRID, (int)blockIdx.x, WM, 1024);
        EpiAttnIn E{Q, Kb, Vb, (const f32x2*)(ws + WS_TABA), 0.125f * LOG2E};
        pg8::gemm_phase(F.lds, g, S, E);
#if defined(PROBE_GEMM2)
        __syncthreads(); pg8::gemm_phase(F.lds, g, S, E);
#endif
        }
      SYNC_GRID();
#if defined(PROBE_WIN2)
      phase_attn_window(F, in, Q, Kb, Vb, (bf16*)scr2); __syncthreads();
#endif
      phase_attn_window(F, in, Q, Kb, Vb);
      SYNC_GRID();
      outproj_phase(F, in, Q, WM + 2 * MiB, 1024, 1024, 0, 1, in[0], in[2]);
      SYNC_GRID(); }
    moe_phases(F, in, 0, bar);

#endif
#ifndef SKIP_L1
#if defined(PROBE_MEM2)
    for (int rep = 0; rep < 2; ++rep) {
#endif
    phase_norm1(F, in, 1);
#if defined(PROBE_MEM2)
    __syncthreads(); }
#endif
    SYNC_GRID();
    ssm_gp_phases(F, in, 0, bar);
    ssm_gp_phases(F, in, 1, bar);
    moe_phases(F, in, 1, bar);

#endif
#ifndef SKIP_L2
#if defined(PROBE_MEM2)
    for (int rep = 0; rep < 2; ++rep) {
#endif
    phase_norm1(F, in, 2);
#if defined(PROBE_MEM2)
    __syncthreads(); }
#endif
    SYNC_GRID();
    { bf16* WM = (bf16*)(ws + WS_WMIX + wofs(2)); bf16* Qm = (bf16*)scr; bf16* Km = (bf16*)(scr + 34 * MiB); bf16* Vm = (bf16*)(scr + 68 * MiB); bf16* Om = (bf16*)(scr + 136 * MiB); float* Gt = (float*)(scr + 204 * MiB);
      bf16* Hf = (bf16*)scr2; bf16* Hbw = H;
      { pg8::Gemm g{H, 1024, 1024, 1 << 30}; pg8::StaticOrder S; S.init(M, 3328, GRID, (int)blockIdx.x, WM, 1024);
        EpiMlIn E{Qm, Km, Vm, Om, Gt, in[27]};
        pg8::gemm_phase(F.lds, g, S, E);
#if defined(PROBE_GEMM2)
        __syncthreads(); pg8::gemm_phase(F.lds, g, S, E);
#endif
        }
      SYNC_GRID();
#if defined(ML_VALU)
      phase_mlstm_scan(F, Qm, Km, Vm, Gt, Hf, Hbw);
#else
      phase_mlstm_scan_mfma(F, Qm, Km, Vm, Gt, Hf, Hbw);
#if defined(PROBE_MLM2)
      __syncthreads(); phase_mlstm_scan_mfma(F, Qm, Km, Vm, Gt, Hf, Hbw);
#endif
#endif
      SYNC_GRID();
#if defined(PROBE_GN2)
      phase_mlstm_gnorm(F, in, Hf, Hbw, Om, Qm); __syncthreads();
#endif
      phase_mlstm_gnorm(F, in, Hf, Hbw, Om, Om);
      SYNC_GRID();
      outproj_phase(F, in, Om, WM + 4 * MiB, 1024, 1024, 2, 3);
      SYNC_GRID(); }
    moe_phases(F, in, 2, bar);

#endif
#ifndef SKIP_L3
#if defined(PROBE_MEM2)
    for (int rep = 0; rep < 2; ++rep) {
#endif
    phase_norm1(F, in, 3);
#if defined(PROBE_MEM2)
    __syncthreads(); }
#endif
    SYNC_GRID();
    { bf16* WM = (bf16*)(ws + WS_WMIX + wofs(3)); bf16* CQ = (bf16*)scr; bf16* CKV = (bf16*)(scr + 17 * MiB); float* SSQ = (float*)(scr + 34 * MiB); bf16* KF = (bf16*)(scr + 36 * MiB); bf16* V3 = (bf16*)(scr + 138 * MiB);
      bf16* Q3 = (bf16*)scr2; bf16* O3 = H; const f32x2* tabm = (const f32x2*)(ws + WS_TABM);
      { pg8::Gemm g{H, 1024, 1024, 1 << 30}; pg8::StaticOrder S; S.init(M, 768, GRID, (int)blockIdx.x, WM, 1024);
        EpiMlaIn E{CQ, CKV, KF, SSQ, tabm};
        pg8::gemm_phase(F.lds, g, S, E);
#if defined(PROBE_GEMM2)
        __syncthreads(); pg8::gemm_phase(F.lds, g, S, E);
#endif
        }
      SYNC_GRID();
      { pg8::Gemm g{CQ, 256, 256, 1 << 30}; pg8::StaticOrder S; S.init(M, 1536, GRID, (int)blockIdx.x, WM + 1 * MiB, 256);
        EpiMlaQ E{Q3, SSQ, tabm, 0.10206207261596577f * LOG2E};
        pg8::gemm_phase(F.lds, g, S, E);
#if defined(PROBE_GEMM2)
        __syncthreads(); pg8::gemm_phase(F.lds, g, S, E);
#endif
        }
      { pg8::Gemm g{CKV, 256, 256, 1 << 30}; pg8::StaticOrder S; S.init(M, 2048, GRID, ((int)blockIdx.x + 192) & 255, WM + 2 * MiB, 256);
        EpiMlaKV E{KF, V3, SSQ};
        pg8::gemm_phase(F.lds, g, S, E);
#if defined(PROBE_GEMM2)
        __syncthreads(); pg8::gemm_phase(F.lds, g, S, E);
#endif
        }
      SYNC_GRID();
      phase_attn_mla(F, Q3, KF, V3, O3);
#if defined(PROBE_MLA2)
      __syncthreads(); phase_attn_mla(F, Q3, KF, V3, O3);
#endif
      SYNC_GRID();
      outproj_phase(F, in, O3, WM + 3 * MiB, 1024, 1024, 3, -1);
      SYNC_GRID(); }
    moe_phases(F, in, 3, bar);

#endif
    const bool poison = __hip_atomic_load(F.ctl + CW_BAR + XB_TMO, RLX_AGENT) != 0u || __hip_atomic_load(F.ctl + CW_POISON, RLX_AGENT) != 0u;
    phase_final(F, in, poison);
#if defined(PROBE_MEM2)
    phase_final(F, in, poison);
#endif
}

extern "C" void kernel_launch(void* const* d_in, const int* in_sizes, int n_in, void* d_out, int out_size, void* d_ws, size_t ws_size, hipStream_t stream) {
    static int ready = 0;
    if (ready == 0) {
        ready = -1;
        if (n_in != 37 || in_sizes[0] != NB * SEQ * D || out_size != NB * SEQ * D || ws_size < WS_END) { fprintf(stderr, "kernel_launch: unexpected problem shape (n_in %d, in0 %d, out %d, ws %zu)\n", n_in, n_in > 0 ? in_sizes[0] : -1, out_size, ws_size); return; }
        int dev = 0, cus = 0;
        if (hipGetDevice(&dev) != hipSuccess || hipDeviceGetAttribute(&cus, hipDeviceAttributeMultiprocessorCount, dev) != hipSuccess) { fprintf(stderr, "kernel_launch: device query failed\n"); return; }
        if (cus < GRID) { fprintf(stderr, "kernel_launch: needs %d CUs, device has %d\n", GRID, cus); return; }
        if (hipFuncSetAttribute((const void*)fwd_kernel, hipFuncAttributeMaxDynamicSharedMemorySize, LDS_BYTES) != hipSuccess) { fprintf(stderr, "kernel_launch: hipFuncSetAttribute failed\n"); return; }
        int per_cu = 0;
        if (hipOccupancyMaxActiveBlocksPerMultiprocessor(&per_cu, (const void*)fwd_kernel, NTHR, LDS_BYTES) != hipSuccess || per_cu < 1) { fprintf(stderr, "kernel_launch: occupancy query reports %d blocks per CU\n", per_cu); }
        (void)hipGetLastError();
        ready = 1;
    }
    if (ready < 0) return;
    if (hipMemsetAsync((char*)d_ws + WS_CTL, 0, CTL_ZERO_BYTES, stream) != hipSuccess) { fprintf(stderr, "kernel_launch: memset failed\n"); return; }
    Args a{};
    for (int i = 0; i < 37; ++i) a.in[i] = (const float*)d_in[i];
    a.out = (float*)d_out; a.ws = (unsigned char*)d_ws;
    hipLaunchKernelGGL(fwd_kernel, dim3(GRID), dim3(NTHR), LDS_BYTES, stream, a);
    const hipError_t le = hipPeekAtLastError();
    if (le != hipSuccess) fprintf(stderr, "kernel_launch: launch failed: %s\n", hipGetErrorName(le));
}
```

```cpp
#include <hip/hip_runtime.h>
#include <cstdio>
#include <cstdint>

#define GAS __attribute__((address_space(1)))
#define LAS __attribute__((address_space(3)))
typedef unsigned short bf16;
typedef unsigned v4u __attribute__((ext_vector_type(4)));
typedef unsigned v2u __attribute__((ext_vector_type(2)));
typedef float f32x4 __attribute__((ext_vector_type(4)));
typedef float f32x2 __attribute__((ext_vector_type(2)));
typedef short bf16x8 __attribute__((ext_vector_type(8)));
typedef short s16x4 __attribute__((ext_vector_type(4)));
#define RLX_AGENT __ATOMIC_RELAXED, __HIP_MEMORY_SCOPE_AGENT

constexpr int D = 1024, NB = 8, SEQ = 4096, CTX = 256, TPB = SEQ + CTX  , M = NB * TPB  ;
constexpr int NWAVES = 8, NTHR = 512, GRID = 256;
constexpr float EPS = 1e-6f;
constexpr float LOG2E = 1.4426950408889634f;

__device__ __forceinline__ unsigned f2bf(float f) { unsigned u = __builtin_bit_cast(unsigned, f); return (u + 0x7fffu + ((u >> 16) & 1u)) >> 16; }
__device__ __forceinline__ float bf2f(unsigned b) { return __builtin_bit_cast(float, b << 16); }
__device__ __forceinline__ float bflo(unsigned w) { return __builtin_bit_cast(float, w << 16); }
__device__ __forceinline__ float bfhi(unsigned w) { return __builtin_bit_cast(float, w & 0xffff0000u); }
typedef __bf16 nbf16x2 __attribute__((ext_vector_type(2)));
__device__ __forceinline__ unsigned cvt_pk_bf16(float lo, float hi) { const nbf16x2 r = __builtin_convertvector((f32x2){lo, hi}, nbf16x2); return __builtin_bit_cast(unsigned, r); }
__device__ __forceinline__ float fast_exp2(float x) { return __builtin_amdgcn_exp2f(x); }
__device__ __forceinline__ float fast_rcp(float x) { return __builtin_amdgcn_rcpf(x); }
__device__ __forceinline__ float silu_f(float x) { return x * fast_rcp(1.0f + fast_exp2(-x * LOG2E)); }
__device__ __forceinline__ float sigmoid_f(float x) { return fast_rcp(1.0f + fast_exp2(-x * LOG2E)); }
__device__ __forceinline__ float fast_log(float x) { return __builtin_amdgcn_logf(x) * 0.6931471805599453f; }
__device__ __forceinline__ float fast_exp(float x) { return __builtin_amdgcn_exp2f(x * LOG2E); }
__device__ __forceinline__ float softplus_f(float x) { if (x > 20.f) return x; const float e = fast_exp(x); return e < 0.01f ? e * (1.0f - e * (0.5f - e * (1.0f / 3.0f))) : fast_log(1.0f + e); }
__device__ __forceinline__ v4u pack8(const f32x4 a, const f32x4 b) { v4u w; w.x = cvt_pk_bf16(a[0], a[1]); w.y = cvt_pk_bf16(a[2], a[3]); w.z = cvt_pk_bf16(b[0], b[1]); w.w = cvt_pk_bf16(b[2], b[3]); return w; }
#define DPPF(old, src, ctrl, rm, bc) __builtin_bit_cast(float, __builtin_amdgcn_update_dpp(__builtin_bit_cast(int, (float)(old)), __builtin_bit_cast(int, (float)(src)), ctrl, rm, 0xF, bc))
__device__ __forceinline__ float xor32(float x) {
    const unsigned u = __builtin_bit_cast(unsigned, x);
    const auto r = __builtin_amdgcn_permlane32_swap(u, u, false, false);
    return __builtin_bit_cast(float, (threadIdx.x & 32u) ? r[0] : r[1]);
}
__device__ __forceinline__ float wave_scan_sum(float v) {
    v += DPPF(0.f, v, 0x111, 0xF, true); v += DPPF(0.f, v, 0x112, 0xF, true); v += DPPF(0.f, v, 0x114, 0xF, true); v += DPPF(0.f, v, 0x118, 0xF, true);
    v += DPPF(0.f, v, 0x142, 0xA, false); v += DPPF(0.f, v, 0x143, 0xC, false); return v;
}
__device__ __forceinline__ float wave_scan_max(float v) {
    v = fmaxf(v, DPPF(-3.0e38f, v, 0x111, 0xF, false)); v = fmaxf(v, DPPF(-3.0e38f, v, 0x112, 0xF, false)); v = fmaxf(v, DPPF(-3.0e38f, v, 0x114, 0xF, false)); v = fmaxf(v, DPPF(-3.0e38f, v, 0x118, 0xF, false));
    v = fmaxf(v, DPPF(-3.0e38f, v, 0x142, 0xA, false)); v = fmaxf(v, DPPF(-3.0e38f, v, 0x143, 0xC, false)); return v;
}
__device__ __forceinline__ float wave_sum(float v) {
    v += DPPF(0.f, v, 0xB1, 0xF, true); v += DPPF(0.f, v, 0x4E, 0xF, true); v += DPPF(0.f, v, 0x141, 0xF, true); v += DPPF(0.f, v, 0x140, 0xF, true);
    v += DPPF(0.f, v, 0x142, 0xA, false); v += DPPF(0.f, v, 0x143, 0xC, false);
    return __builtin_bit_cast(float, __builtin_amdgcn_readlane(__builtin_bit_cast(int, v), 63));
}
__device__ __forceinline__ int opaque_tid() { int t = threadIdx.x; asm volatile("" : "+v"(t)); return t; }
__device__ __forceinline__ float xrow_max(float v) {
    { auto r = __builtin_amdgcn_permlane16_swap(__builtin_bit_cast(unsigned, v), __builtin_bit_cast(unsigned, v), false, false); v = fmaxf(__builtin_bit_cast(float, r[0]), __builtin_bit_cast(float, r[1])); }
    { auto r = __builtin_amdgcn_permlane32_swap(__builtin_bit_cast(unsigned, v), __builtin_bit_cast(unsigned, v), false, false); v = fmaxf(__builtin_bit_cast(float, r[0]), __builtin_bit_cast(float, r[1])); }
    return v; }
__device__ __forceinline__ float xrow_sum(float v) {
    { auto r = __builtin_amdgcn_permlane16_swap(__builtin_bit_cast(unsigned, v), __builtin_bit_cast(unsigned, v), false, false); v = __builtin_bit_cast(float, r[0]) + __builtin_bit_cast(float, r[1]); }
    { auto r = __builtin_amdgcn_permlane32_swap(__builtin_bit_cast(unsigned, v), __builtin_bit_cast(unsigned, v), false, false); v = __builtin_bit_cast(float, r[0]) + __builtin_bit_cast(float, r[1]); }
    return v; }
#define LDS_WAIT() asm volatile("s_waitcnt lgkmcnt(0)" ::: "memory")
#define VM_WAIT() asm volatile("s_waitcnt vmcnt(0)" ::: "memory")

namespace pg8 {
constexpr int BM = 256, BK = 64, HALF = 128, HTB = HALF * BK * 2, STAGE_BYTES = 8 * HTB, NXCD = 8, WGM = 8;
__host__ __device__ __forceinline__ int lds_byte(int r, int c) { const int st = (r >> 4) * 2 + (c >> 5), rr = r & 15, cc = c & 31, ob = rr * 64 + cc * 2; return st * 1024 + (ob ^ (((ob >> 9) & 1) << 5)); }
__host__ __device__ __forceinline__ void stage_rc(int b, int& R, int& C) { const int st = b / 1024, sb = b % 1024, swz = sb ^ (((sb >> 9) & 1) << 5); R = (st >> 1) * 16 + swz / 64; C = (st & 1) * 32 + (swz % 64) / 2; }
__host__ __device__ __forceinline__ int perm32(int rho) { const int n = rho >> 4, i = rho & 15; return 8 * (i >> 2) + 4 * n + (i & 3); }

struct Unit { int pm, pn, aux; };
struct Gemm { const bf16* A; int K; int ldb; int ksplit; };

struct StaticOrder {
    static constexpr bool GATHER = false;
    int nM, nN, nwg, G, c; const bf16* Bt; int ldb; bool skipctx;
    __device__ void init(int M_, int N_, int G_, int c_, const bf16* Bt_, int ldb_, bool skipctx_ = false) { skipctx = skipctx_; nM = skipctx ? 128 : M_ / BM; nN = N_ / BM; nwg = nM * nN; G = G_; c = c_; Bt = Bt_; ldb = ldb_; }
    __device__ __forceinline__ bool next(int i, Unit& u) const {
        const long L = (long)i * G + c; if (L >= nwg) return false;
        int wgid = (int)L; { const int q = nwg / NXCD, r = nwg % NXCD, xcd = wgid % NXCD, off = wgid / NXCD; wgid = (xcd < r ? xcd * (q + 1) : r * (q + 1) + (xcd - r) * q) + off; }
        const int nig = WGM * nN, gid = wgid / nig, fm = gid * WGM; constexpr int gsz = WGM;
        u.pm = fm + ((wgid % nig) % gsz); u.pn = (wgid % nig) / gsz; u.aux = 0; if (skipctx) u.pm = (u.pm >> 4) * 17 + 1 + (u.pm & 15); return true;
    }
    __device__ __forceinline__ int a_row(const Unit& u, int r) const { return u.pm * BM + r; }
    __device__ __forceinline__ const char* b_seg(const Unit& u, int seg) const { return (const char*)(Bt + (size_t)u.pn * BM * ldb); }
};

template <class Epi, class Sched>
__device__ __forceinline__ void gemm_phase(LAS unsigned char* lds, const Gemm g, const Sched& S, const Epi& E) {
    const int tid = opaque_tid(), wid = __builtin_amdgcn_readfirstlane(tid >> 6), lane = tid & 63, wr = wid >> 2, wc = wid & 3, fr = lane & 15, fq = lane >> 4;
    const int K = g.K, nt = K / BK, ldb = g.ldb, ksplit = g.ksplit;
    int Rst[2], Cst[2]; unsigned voffB[2], voffA[2];
#pragma unroll
    for (int i = 0; i < 2; ++i) { int R, C; stage_rc(tid * 16 + i * 8192, R, C); const int Rb = Epi::PERM ? ((R & ~31) + perm32(R & 31)) : R; Rst[i] = R; Cst[i] = C;
        voffB[i] = (unsigned)(Rb * ldb + C) * 2u; voffA[i] = (unsigned)(R * K + C) * 2u; }
    const size_t hstepA = (size_t)HALF * K * 2;
    const size_t kstep = (size_t)(BK * 2);
    const size_t hstepB = (size_t)HALF * ldb * 2;
    const unsigned ldsw = (unsigned)wid * 1024u;
    const int aoff = lds_byte(wr * 64 + fr, fq * 8), boff = lds_byte(wc * 32 + fr, fq * 8);
#define PG8_SA(b, h) (((b) * 2 + (h)) * HTB)
#define PG8_SB(b, h) ((4 + (b) * 2 + (h)) * HTB)
#define PG8_STAGEB(bufoff, gbase) do { _Pragma("unroll") for (int _i = 0; _i < 2; ++_i) \
        __builtin_amdgcn_global_load_lds((const unsigned*)((const char*)(gbase) + voffB[_i]), (LAS unsigned*)(lds + (bufoff) + ldsw + _i * 8192), 16, 0, 0); } while (0)
#define PG8_STAGEA(bufoff, nextsel, h, kt) do { if constexpr (Sched::GATHER) { _Pragma("unroll") for (int _i = 0; _i < 2; ++_i) \
        __builtin_amdgcn_global_load_lds((const unsigned*)(gA + (size_t)(kt) * kstep + ((nextsel) ? vN[h][_i] : vA[h][_i])), (LAS unsigned*)(lds + (bufoff) + ldsw + _i * 8192), 16, 0, 0); } \
      else { const char* _ab = ((nextsel) ? nA : cA) + (size_t)(h) * hstepA + (size_t)(kt) * kstep; _Pragma("unroll") for (int _i = 0; _i < 2; ++_i) \
        __builtin_amdgcn_global_load_lds((const unsigned*)(_ab + voffA[_i]), (LAS unsigned*)(lds + (bufoff) + ldsw + _i * 8192), 16, 0, 0); } } while (0)
#define PG8_LDA(dst, b, h) do { _Pragma("unroll") for (int m = 0; m < 4; ++m) _Pragma("unroll") for (int k = 0; k < 2; ++k) dst[m][k] = *(const LAS bf16x8*)(lds + PG8_SA(b, h) + aoff + m * 2048 + k * 1024); } while (0)
#define PG8_LDB(dst, b, h) do { _Pragma("unroll") for (int n = 0; n < 2; ++n) _Pragma("unroll") for (int k = 0; k < 2; ++k) dst[n][k] = *(const LAS bf16x8*)(lds + PG8_SB(b, h) + boff + n * 2048 + k * 1024); } while (0)
#define PG8_MMA(ai, bj, At, Bt) do { __builtin_amdgcn_s_setprio(1); _Pragma("unroll") for (int m = 0; m < 4; ++m) _Pragma("unroll") for (int n = 0; n < 2; ++n) _Pragma("unroll") for (int k = 0; k < 2; ++k) \
        acc[ai][bj][m][n] = __builtin_amdgcn_mfma_f32_16x16x32_bf16(Bt[n][k], At[m][k], acc[ai][bj][m][n], 0, 0, 0); __builtin_amdgcn_s_setprio(0); } while (0)
#define PG8_WAIT_V(n) asm volatile("s_waitcnt vmcnt(" #n ")" ::: "memory")
#define PG8_WAIT_L(n) asm volatile("s_waitcnt lgkmcnt(" #n ")" ::: "memory")
#define PG8_BAR __builtin_amdgcn_s_barrier()
#define PG8_SCHED __builtin_amdgcn_sched_barrier(0)
#define PG8_AOFFS(dst, u) do { _Pragma("unroll") for (int _h = 0; _h < 2; ++_h) _Pragma("unroll") for (int _i = 0; _i < 2; ++_i) \
        dst[_h][_i] = (unsigned)S.a_row(u, _h * HALF + Rst[_i]) * (unsigned)(K * 2) + (unsigned)(Cst[_i] * 2); } while (0)
    Unit cur, nxt; int ui = 0;
    if (!S.next(0, cur)) return;
#if defined(GEMM_STAGGER)
    { const unsigned long long t0 = __builtin_amdgcn_s_memrealtime(); const unsigned long long dly = (unsigned long long)((blockIdx.x >> 3) & 3) * GEMM_STAGGER;
      while (__builtin_amdgcn_s_memrealtime() - t0 < dly) __builtin_amdgcn_s_sleep(2); }
#endif
    const char* const gA = (const char*)g.A;
    f32x4 acc[2][2][4][2];
#pragma unroll
    for (int a = 0; a < 2; ++a)
#pragma unroll
        for (int b = 0; b < 2; ++b)
#pragma unroll
            for (int m = 0; m < 4; ++m)
#pragma unroll
                for (int n = 0; n < 2; ++n) acc[a][b][m][n] = (f32x4){0.f, 0.f, 0.f, 0.f};
    bf16x8 At[4][2], B0[2][2], B1[2][2];
    unsigned vA[2][2], vN[2][2];
    const char* cA = gA; const char* nA = gA;
    if constexpr (Sched::GATHER) { PG8_AOFFS(vA, cur); } else { cA = gA + (size_t)S.a_row(cur, 0) * K * 2; }
    const char* cB0 = S.b_seg(cur, 0); const char* cB1 = S.b_seg(cur, 1);
    PG8_STAGEB(PG8_SB(0, 0), cB0); PG8_STAGEB(PG8_SB(0, 1), cB0 + hstepB); PG8_STAGEA(PG8_SA(0, 0), false, 0, 0); PG8_STAGEA(PG8_SA(0, 1), false, 1, 0);
    if (wr == 1) PG8_BAR;
    PG8_WAIT_V(2); PG8_BAR;
    PG8_STAGEB(PG8_SB(1, 0), cB0 + kstep); PG8_STAGEA(PG8_SA(1, 0), false, 0, 1); PG8_STAGEB(PG8_SB(1, 1), cB0 + hstepB + kstep);
    PG8_WAIT_V(6); PG8_BAR;
    for (;;) {
        const bool has_next = S.next(ui + 1, nxt);
        const char* nB0 = cB0;
        nA = cA;
        if (has_next) { nB0 = S.b_seg(nxt, 0); if constexpr (Sched::GATHER) { PG8_AOFFS(vN, nxt); } else { nA = gA + (size_t)S.a_row(nxt, 0) * K * 2; } }
        else { if constexpr (Sched::GATHER) {
#pragma unroll
            for (int h = 0; h < 2; ++h)
#pragma unroll
                for (int i = 0; i < 2; ++i) vN[h][i] = vA[h][i]; } }
#pragma unroll 1
        for (int t = 0; t < nt; t += 2) {
            const bool last = (t == nt - 2);
            const char* b2 = last ? nB0 : ((t + 2 < ksplit) ? cB0 + (size_t)(t + 2) * kstep : cB1 + (size_t)(t + 2 - ksplit) * kstep);
            const char* b3 = b2 + kstep;
            const int kt2 = last ? 0 : t + 2;
            PG8_LDB(B0, 0, 0); PG8_LDB(B1, 0, 1); PG8_SCHED; PG8_LDA(At, 0, 0); PG8_STAGEA(PG8_SA(1, 1), false, 1, t + 1);
            PG8_WAIT_V(8); PG8_WAIT_L(0); PG8_BAR; PG8_MMA(0, 0, At, B0); PG8_MMA(0, 1, At, B1); PG8_BAR; PG8_SCHED;
            PG8_LDA(At, 0, 1); PG8_STAGEB(PG8_SB(0, 0), b2); PG8_STAGEB(PG8_SB(0, 1), b2 + hstepB); PG8_STAGEA(PG8_SA(0, 0), last, 0, kt2);
            PG8_WAIT_V(8); PG8_WAIT_L(0); PG8_BAR; PG8_MMA(1, 0, At, B0); PG8_MMA(1, 1, At, B1); PG8_BAR; PG8_SCHED;
            PG8_LDB(B0, 1, 0); PG8_LDB(B1, 1, 1); PG8_SCHED; PG8_LDA(At, 1, 0); PG8_STAGEA(PG8_SA(0, 1), last, 1, kt2);
            PG8_WAIT_V(8); PG8_WAIT_L(0); PG8_BAR; PG8_MMA(0, 0, At, B0); PG8_MMA(0, 1, At, B1); PG8_BAR; PG8_SCHED;
            PG8_LDA(At, 1, 1); PG8_STAGEB(PG8_SB(1, 0), b3); PG8_STAGEB(PG8_SB(1, 1), b3 + hstepB); PG8_STAGEA(PG8_SA(1, 0), last, 0, kt2 + 1);
            PG8_WAIT_V(8); PG8_WAIT_L(0); PG8_BAR; PG8_MMA(1, 0, At, B0); PG8_MMA(1, 1, At, B1); PG8_BAR; PG8_SCHED;
        }
        if (wr == 0) PG8_BAR;
        { int tz = tid; asm volatile("" : "+v"(tz));
          const int lz = tz & 63; E(acc, cur, ui, wr, wc, lz & 15, lz >> 4); }
        if (!has_next) break;
#pragma unroll
        for (int a = 0; a < 2; ++a)
#pragma unroll
            for (int b = 0; b < 2; ++b)
#pragma unroll
                for (int m = 0; m < 4; ++m)
#pragma unroll
                    for (int n = 0; n < 2; ++n) acc[a][b][m][n] = (f32x4){0.f, 0.f, 0.f, 0.f};
        cur = nxt; cB0 = nB0; cB1 = S.b_seg(cur, 1); cA = nA; ++ui;
        if constexpr (Sched::GATHER) {
#pragma unroll
        for (int h = 0; h < 2; ++h)
#pragma unroll
            for (int i = 0; i < 2; ++i) vA[h][i] = vN[h][i]; }
        if (wr == 1) PG8_BAR;
    }
    PG8_WAIT_V(0);
    PG8_BAR;
#undef PG8_SA
#undef PG8_SB
#undef PG8_STAGEA
#undef PG8_STAGEB
#undef PG8_LDA
#undef PG8_LDB
#undef PG8_MMA
#undef PG8_WAIT_V
#undef PG8_WAIT_L
#undef PG8_BAR
#undef PG8_SCHED
#undef PG8_AOFFS
}
}
#define XB_TMO      128
#define XB_XCNT(j)  (256  + 64 * (j))
#define XB_XSUB(j)  (1280 + 64 * (j))
#define XB_XGEN(j)  (2304 + 64 * (j))
#define XB_TOP      3328
#define XB_TOPGEN   3392
#define XCD_BAR_WORDS 3456
#define XB_SPIN_CAP (1u << 22)
__device__ __forceinline__ unsigned xb_ld(unsigned* p)              { return __hip_atomic_load(p, __ATOMIC_RELAXED, __HIP_MEMORY_SCOPE_AGENT); }
__device__ __forceinline__ unsigned xb_add(unsigned* p, unsigned v) { return __hip_atomic_fetch_add(p, v, __ATOMIC_RELAXED, __HIP_MEMORY_SCOPE_AGENT); }
__device__ __forceinline__ unsigned xb_xcc_id() { return (unsigned)__builtin_amdgcn_s_getreg((3 << 11) | 20) & 0xFu; }
#define XB_SPIN(cond, bar) do { unsigned _sp = 0; while (cond) { __builtin_amdgcn_s_sleep(1); \
    if ((++_sp & 255u) == 0u) { if (xb_ld(&(bar)[XB_TMO])) break; if (_sp > XB_SPIN_CAP) { atomicAdd(&(bar)[XB_TMO], 1u); break; } } } } while (0)
struct XcdBarrier { unsigned* bar; unsigned x; volatile LAS unsigned* st; };
__device__ __forceinline__ XcdBarrier xcd_barrier_post(unsigned* bar, volatile LAS unsigned* st) {
    XcdBarrier b; b.bar = bar; b.x = xb_xcc_id(); b.st = st;
    if (threadIdx.x == 0) (void)xb_add(&bar[XB_XCNT(b.x)], 1u);
    return b;
}
__device__ __forceinline__ void xcd_barrier_complete(unsigned* bar, unsigned x, unsigned& nloc, unsigned& nx) {
    const unsigned G = gridDim.x * gridDim.y * gridDim.z;
    unsigned sum, cnt, mine, sp = 0u;
    for (;;) {
        sum = 0u; cnt = 0u; mine = 0u;
#pragma unroll
        for (unsigned j = 0; j < 16; ++j) { const unsigned c = xb_ld(&bar[XB_XCNT(j)]); sum += c; cnt += (c > 0u) ? 1u : 0u; mine = (j == x) ? c : mine; }
        if (sum == G) break;
        __builtin_amdgcn_s_sleep(1);
        if ((++sp & 255u) == 0u) { if (xb_ld(&bar[XB_TMO])) break; if (sp > XB_SPIN_CAP) { atomicAdd(&bar[XB_TMO], 1u); break; } }
    }
    nloc = mine > 0u ? mine : 1u; nx = cnt > 0u ? cnt : 1u;
}
__device__ __forceinline__ void xcd_barrier(const XcdBarrier& b) {
    asm volatile("s_waitcnt vmcnt(0)" ::: "memory");
    __syncthreads();
    if (threadIdx.x == 0) {
        unsigned* bar = b.bar;
        __builtin_amdgcn_s_waitcnt(0);
        unsigned nloc = b.st[0], nx = b.st[1];
        if (nloc == 0u) { xcd_barrier_complete(bar, b.x, nloc, nx); b.st[0] = nloc; b.st[1] = nx; }
        const unsigned old = xb_add(&bar[XB_XSUB(b.x)], 1u);
        const unsigned gen = old / nloc;
        if (old + 1u == (gen + 1u) * nloc) {
            __builtin_amdgcn_fence(__ATOMIC_RELEASE, "agent");
            asm volatile("s_waitcnt vmcnt(0)" ::: "memory");
            const unsigned og = xb_add(&bar[XB_TOP], 1u);
            const unsigned tg = og / nx;
            if (og + 1u == (tg + 1u) * nx) xb_add(&bar[XB_TOPGEN], 1u);
            else XB_SPIN(xb_ld(&bar[XB_TOPGEN]) == tg, bar);
            __builtin_amdgcn_fence(__ATOMIC_ACQUIRE, "agent");
            xb_add(&bar[XB_XGEN(b.x)], 1u);
            asm volatile("s_waitcnt vmcnt(0)" ::: "memory");
        } else {
            XB_SPIN(xb_ld(&bar[XB_XGEN(b.x)]) == gen, bar);
            __builtin_amdgcn_fence(__ATOMIC_ACQUIRE, "agent");
            asm volatile("s_waitcnt vmcnt(0)" ::: "memory");
        }
    }
    __syncthreads();
}

constexpr size_t MiB = 1u << 20;
constexpr size_t WS_CTL = 0, CTL_ZERO_BYTES = 1 * MiB;
constexpr size_t WS_MOD = 1 * MiB;
constexpr size_t WS_MODB = 1 * MiB + 884736;
constexpr size_t WS_TABA = 2 * MiB;
constexpr size_t WS_TABM = 3 * MiB;
constexpr size_t WS_WGU = 4 * MiB;
constexpr size_t WS_WDN = 20 * MiB;
constexpr size_t WS_WMIX = 28 * MiB;
constexpr size_t WS_X = 52 * MiB;
constexpr size_t WS_W1 = 116 * MiB;
__device__ __forceinline__ size_t wofs(int layer) { return (layer & 1) ? WS_W1 : 0; }
constexpr size_t WS_H = 188 * MiB;
constexpr size_t WS_SCR = 256 * MiB;
constexpr size_t WS_END = 512 * MiB;
constexpr size_t MOE_ACT = WS_SCR;
constexpr size_t MOE_SL = WS_SCR + 48 * MiB;
constexpr size_t MOE_WT = WS_SCR + 52 * MiB;
constexpr int CW_BAR = 4096;
constexpr int CW_MOECNT = 16384;
constexpr int CW_POISON = 20000;

constexpr int RING_BYTES = 131072;
constexpr int LDS_MISC = RING_BYTES;
constexpr int LDS_TB = RING_BYTES + 512;
constexpr int LDS_TBL = RING_BYTES + 1024;
constexpr int LDS_BYTES = RING_BYTES + 1024 + 16384;

struct Frame {
    LAS unsigned char* lds;
    unsigned* ctl;
    unsigned char* ws;
    float* out;
    int tid, lane, wave, vcu;
};

__device__ __forceinline__ void refresh(Frame& F) { F.tid = opaque_tid(); F.lane = F.tid & 63; F.wave = __builtin_amdgcn_readfirstlane(F.tid >> 6); }
#if defined(PROBE_BAR2)
#define SYNC_GRID() do { xcd_barrier(bar); xcd_barrier(bar); refresh(F); } while (0)
#else
#define SYNC_GRID() do { xcd_barrier(bar); refresh(F); } while (0)
#endif
__device__ __forceinline__ int modrow_of(int row) { const int b = row / TPB, t = row - b * TPB; return t < CTX ? 8 : b; }

enum { MAP_ID = 0, MAP_ATTN_IN, MAP_SSM_IN, MAP_MLA_IN, MAP_MLA_QUP, MAP_MOE_G, MAP_MOE_U };
template <int KIND> __device__ __forceinline__ int map_row(int n, int aux) {
    if (KIND == MAP_ID) return aux + n;
    if (KIND == MAP_ATTN_IN) { if (n >= 1280) return n; const int hb = n & ~63, d = n & 63; return hb + (d < 32 ? 2 * d : 2 * (d - 32) + 1); }
    if (KIND == MAP_SSM_IN) {
        if (n < 2048) { const int gp = n >> 10; return gp * 2816 + (n & 1023); }
        if (n < 4096) { const int c = n - 2048, gp = c >> 10; return gp * 2816 + 1024 + (c & 1023); }
        if (n < 4608) { const int c = n - 4096, gp = c >> 8; return gp * 2816 + 2048 + (c & 255); }
        if (n < 5120) { const int c = n - 4608, gp = c >> 8; return gp * 2816 + 2304 + (c & 255); }
        { const int c = n - 5120, dir = c >> 5, h = c & 31, gp = h >> 4; return gp * 2816 + 2560 + dir * 16 + (h & 15); }
    }
    if (KIND == MAP_MLA_IN) { if (n < 512) return n; const int d = n - 512; return 512 + (d < 16 ? 2 * d : 2 * (d - 16) + 1); }
    if (KIND == MAP_MLA_QUP) { const int h = n / 96, e = n - h * 96; if (e < 64) return n; const int d = e - 64; return h * 96 + 64 + (d < 16 ? 2 * d : 2 * (d - 16) + 1); }
    if (KIND == MAP_MOE_G) return aux + (n >> 7) * 256 + (n & 127);
    if (KIND == MAP_MOE_U) return aux + (n >> 7) * 256 + 128 + (n & 127);
    return n;
}
template <int KIND>
__device__ __forceinline__ void transpose_item(const float* W, int K, int N, bf16* WT, int aux, const float* kscale, LAS float* scr, int item, int lane) {
    const int nblk = N / 32, kb = item / nblk, nb = item % nblk, k0 = 64 * kb, n0 = 32 * nb;
#pragma unroll 8
    for (int i = 0; i < 32; ++i) { const int kk = 2 * i + (lane >> 5); float v = W[(size_t)(k0 + kk) * N + n0 + (lane & 31)]; if (kscale) v *= kscale[k0 + kk]; scr[kk * 33 + (lane & 31)] = v; }
    LDS_WAIT(); asm volatile("" ::: "memory");
    const int c = lane & 7;
#pragma unroll
    for (int j = 0; j < 4; ++j) { const int n = (lane >> 3) + 8 * j; const LAS float* s = scr + (8 * c) * 33 + n;
        v4u o; o.x = cvt_pk_bf16(s[0 * 33], s[1 * 33]); o.y = cvt_pk_bf16(s[2 * 33], s[3 * 33]); o.z = cvt_pk_bf16(s[4 * 33], s[5 * 33]); o.w = cvt_pk_bf16(s[6 * 33], s[7 * 33]);
        *(v4u*)(WT + (size_t)map_row<KIND>(n0 + n, aux) * K + k0 + 8 * c) = o; }
    LDS_WAIT(); asm volatile("" ::: "memory");
}
struct ConvGrid { int gw, ngw; };
__device__ __forceinline__ ConvGrid conv_all(Frame& F) { ConvGrid g; g.gw = F.vcu * NWAVES + F.wave; g.ngw = GRID * NWAVES; return g; }
template <int KIND>
__device__ __forceinline__ void convert_matrix(Frame& F, ConvGrid cg, const float* W, int K, int N, bf16* WT, int aux, const float* kscale) {
    LAS float* scr = (LAS float*)(F.lds + F.wave * 16384);
    const int nitems = (K / 64) * (N / 32);
    for (int it = cg.gw; it < nitems; it += cg.ngw) transpose_item<KIND>(W, K, N, WT, aux, kscale, scr, it, F.lane);
}
__device__ __forceinline__ void zero_rows(Frame& F, ConvGrid cg, bf16* WT, int row0, int nrows, int K) {
    const size_t n16 = (size_t)nrows * K / 8; v4u* p = (v4u*)(WT + (size_t)row0 * K);
    for (size_t i = (size_t)cg.gw * 64 + F.lane; i < n16; i += (size_t)cg.ngw * 64) p[i] = (v4u){0u, 0u, 0u, 0u};
}
__device__ __forceinline__ void convert_moe(Frame& F, ConvGrid cg, const float* const* in, int layer) {
    bf16* GU = (bf16*)(F.ws + WS_WGU + wofs(layer)); bf16* DN = (bf16*)(F.ws + WS_WDN + wofs(layer));
    const float* wg = in[12] + (size_t)layer * 16 * 1024 * 256; const float* wu = in[13] + (size_t)layer * 16 * 1024 * 256; const float* wd = in[14] + (size_t)layer * 16 * 256 * 1024;
    LAS float* scr = (LAS float*)(F.lds + F.wave * 16384);
    for (int it = cg.gw; it < 16 * 384; it += cg.ngw) { const int e = it / 384, r = it - e * 384, kind = r >> 7, sub = r & 127;
        if (kind == 0) transpose_item<MAP_MOE_G>(wg + (size_t)e * 1024 * 256, 1024, 256, GU, e * 512, nullptr, scr, sub, F.lane);
        else if (kind == 1) transpose_item<MAP_MOE_U>(wu + (size_t)e * 1024 * 256, 1024, 256, GU, e * 512, nullptr, scr, sub, F.lane);
        else transpose_item<MAP_ID>(wd + (size_t)e * 256 * 1024, 256, 1024, DN, e * 1024, nullptr, scr, sub, F.lane); }
}
__device__ __forceinline__ void convert_layer(Frame& F, ConvGrid cg, const float* const* in, int layer) {
    bf16* WM = (bf16*)(F.ws + WS_WMIX + wofs(layer));
    if (layer == 0) { convert_matrix<MAP_ATTN_IN>(F, cg, in[15], 1024, 1536, WM, 0, nullptr); convert_matrix<MAP_ID>(F, cg, in[17], 1024, 1024, WM + 2 * MiB, 0, nullptr); }
    else if (layer == 1) { convert_matrix<MAP_SSM_IN>(F, cg, in[18], 1024, 5184, WM, 0, nullptr); zero_rows(F, cg, WM, 2592, 224, 1024); zero_rows(F, cg, WM, 2816 + 2592, 224, 1024);
        convert_matrix<MAP_ID>(F, cg, in[25], 2048, 1024, WM + 6 * MiB, 0, nullptr); }
    else if (layer == 2) { convert_matrix<MAP_ID>(F, cg, in[26], 1024, 3104, WM, 0, nullptr); zero_rows(F, cg, WM, 3104, 224, 1024); convert_matrix<MAP_ID>(F, cg, in[29], 1024, 1024, WM + 4 * MiB, 0, nullptr); }
    else { convert_matrix<MAP_MLA_IN>(F, cg, in[30], 1024, 544, WM, 0, nullptr); zero_rows(F, cg, WM, 544, 224, 1024);
        convert_matrix<MAP_MLA_QUP>(F, cg, in[32], 256, 1536, WM + 1 * MiB, 0, in[31]); convert_matrix<MAP_ID>(F, cg, in[34], 256, 2048, WM + 2 * MiB, 0, in[33]);
        convert_matrix<MAP_ID>(F, cg, in[35], 1024, 1024, WM + 3 * MiB, 0, nullptr); }
    convert_moe(F, cg, in, layer);
}

__device__ __forceinline__ const float* src_row(const float* const* in, int r) { const int b = r / TPB, t = r - b * TPB; return t < CTX ? in[2] + ((size_t)b * CTX + t) * D : in[0] + ((size_t)b * SEQ + (t - CTX)) * D; }
__device__ __forceinline__ float row_load_ss(const bf16* xrow, int lane, f32x4 (&v)[4]) {
    const v4u a = *((const v4u*)xrow + lane), b = *((const v4u*)xrow + 64 + lane);
    v[0] = (f32x4){bflo(a.x), bfhi(a.x), bflo(a.y), bfhi(a.y)}; v[1] = (f32x4){bflo(a.z), bfhi(a.z), bflo(a.w), bfhi(a.w)};
    v[2] = (f32x4){bflo(b.x), bfhi(b.x), bflo(b.y), bfhi(b.y)}; v[3] = (f32x4){bflo(b.z), bfhi(b.z), bflo(b.w), bfhi(b.w)};
    float s = 0.f;
#pragma unroll
    for (int j = 0; j < 4; ++j) s += (v[j].x * v[j].x + v[j].y * v[j].y) + (v[j].z * v[j].z + v[j].w * v[j].w);
    return s;
}
__device__ __forceinline__ float row_load_ss_f32(const float* xrow, int lane, f32x4 (&v)[4]) {
    float s = 0.f;
#pragma unroll
    for (int j = 0; j < 2; ++j) { v[2 * j] = *(const f32x4*)(xrow + 512 * j + 8 * lane); v[2 * j + 1] = *(const f32x4*)(xrow + 512 * j + 8 * lane + 4); }
#pragma unroll
    for (int j = 0; j < 4; ++j) s += (v[j].x * v[j].x + v[j].y * v[j].y) + (v[j].z * v[j].z + v[j].w * v[j].w);
    return s;
}
__device__ __forceinline__ void row_finish(const f32x4 (&v)[4], float ss, const float* g, const float* sc, const float* sh, bf16* orow, int lane, f32x4 (&hv)[4]) {
    const float rstd = rsqrtf(ss * (1.f / D) + EPS);
#pragma unroll
    for (int j = 0; j < 2; ++j) {
#pragma unroll
        for (int q = 0; q < 2; ++q) { const int o = 512 * j + 8 * lane + 4 * q;
            hv[2 * j + q] = v[2 * j + q] * rstd * *(const f32x4*)(g + o) * (*(const f32x4*)(sc + o) + 1.0f) + *(const f32x4*)(sh + o); }
        *((v4u*)orow + 64 * j + lane) = pack8(hv[2 * j], hv[2 * j + 1]);
    }
}
struct ModRegs { f32x4 a[4], b[4]; };
__device__ __forceinline__ void mod_load(ModRegs& Mr, const float* g, const float* sc, const float* sh, int lane) {
#pragma unroll
    for (int j = 0; j < 4; ++j) { const int o = 512 * (j >> 1) + 8 * lane + 4 * (j & 1); Mr.a[j] = *(const f32x4*)(g + o) * (*(const f32x4*)(sc + o) + 1.0f); Mr.b[j] = *(const f32x4*)(sh + o); }
}
__device__ __forceinline__ void row_finish_regs(const f32x4 (&v)[4], float ss, const ModRegs& Mr, bf16* orow, int lane, f32x4 (&hv)[4]) {
    const float rstd = rsqrtf(ss * (1.f / D) + EPS);
#pragma unroll
    for (int j = 0; j < 4; ++j) hv[j] = v[j] * rstd * Mr.a[j] + Mr.b[j];
    *((v4u*)orow + lane) = pack8(hv[0], hv[1]); *((v4u*)orow + 64 + lane) = pack8(hv[2], hv[3]);
}
__device__ __forceinline__ void phase_norm1(Frame& F, const float* const* in, int layer) {
    const bf16* X = (const bf16*)(F.ws + WS_X); bf16* H = (bf16*)(F.ws + WS_H);
    const float* g = in[4] + layer * D; const float* mod = (const float*)(F.ws + WS_MOD) + (size_t)layer * 9 * 6144;
    const int gw = F.vcu * NWAVES + F.wave; constexpr int RPWV = M / (GRID * NWAVES);
    const int rbase = gw * RPWV; int cur = -1; ModRegs Mr;
    for (int k0 = 0; k0 < RPWV; k0 += 4) { f32x4 v[4][4], hv[4]; float ss[4]; int rr[4];
#pragma unroll
        for (int q = 0; q < 4; ++q) { rr[q] = (k0 + q < RPWV) ? rbase + k0 + q : rbase + k0; ss[q] = layer == 0 ? row_load_ss_f32(src_row(in, rr[q]), F.lane, v[q]) : row_load_ss(X + (size_t)rr[q] * D, F.lane, v[q]); }
#pragma unroll
        for (int q = 0; q < 4; ++q) ss[q] = wave_sum(ss[q]);
#pragma unroll
        for (int q = 0; q < 4; ++q) { if (q == 0 || k0 + q < RPWV) { const int mr = modrow_of(rr[q]);
                if (mr != cur) { cur = mr; const float* mp = mod + (size_t)mr * 6144; mod_load(Mr, g, mp + 1024, mp, F.lane); }
                row_finish_regs(v[q], ss[q], Mr, H + (size_t)rr[q] * D, F.lane, hv); } } }
}

__device__ __forceinline__ void phase_mod(Frame& F, const float* const* in, const int l0, const int l1, const int u0, const int ustride) {
    LAS float* sc = (LAS float*)F.lds;
    LAS float* part = (LAS float*)(F.lds + 40960);
    for (int i = F.tid; i < 9 * 1024; i += NTHR) { const int r = i >> 10, k = i & 1023; const float c = r < 8 ? in[1][r * 1024 + k] : in[3][k]; sc[i] = silu_f(c); }
    __syncthreads();
    float* MOD = (float*)(F.ws + WS_MOD);
    const int cq = F.tid & 15, ks = F.tid >> 4;
    for (int u = u0; u < (l1 - l0) * 96; u += ustride) { const int l = l0 + u / 96, cb = u % 96;
        const float* w = in[6] + (size_t)l * 1024 * 6144 + cb * 64 + cq * 4; f32x4 a[9];
#pragma unroll
        for (int r = 0; r < 9; ++r) a[r] = (f32x4){0.f, 0.f, 0.f, 0.f};
#pragma unroll 8
        for (int k = ks * 32; k < ks * 32 + 32; ++k) { const f32x4 wv = *(const f32x4*)(w + (size_t)k * 6144);
#pragma unroll
            for (int r = 0; r < 9; ++r) a[r] = a[r] + wv * sc[r * 1024 + k]; }
#pragma unroll
        for (int r = 0; r < 9; ++r) *(LAS f32x4*)(part + (ks * 9 + r) * 64 + cq * 4) = a[r];
        __syncthreads();
        for (int i = F.tid; i < 9 * 64; i += NTHR) { const int r = i >> 6, c = i & 63; float s = 0.f;
#pragma unroll
            for (int q = 0; q < 32; ++q) s += part[(q * 9 + r) * 64 + c];
            const float mv = s + in[7][l * 6144 + cb * 64 + c]; MOD[((size_t)l * 9 + r) * 6144 + cb * 64 + c] = mv;
            if (cb >= 80) ((bf16*)(F.ws + WS_MODB))[((size_t)l * 9 + r) * 1024 + (cb - 80) * 64 + c] = f2bf(mv); }
        __syncthreads(); }
}
__device__ __forceinline__ void phase_prologue(Frame& F, const float* const* in) {
    { f32x2* TA = (f32x2*)(F.ws + WS_TABA); f32x2* TM = (f32x2*)(F.ws + WS_TABM);
      for (int i = blockIdx.x * NTHR + F.tid; i < SEQ * 32; i += GRID * NTHR) { const int pos = i >> 5, a = i & 31; const float p = (a < 16) ? (float)(pos >> 6) : (float)(pos & 63);
          const float inv = fast_exp2(-(float)(a & 15) * (13.287712379549449f / 16.0f)); const float rev = p * inv * 0.15915494309189535f; TA[i] = (f32x2){__builtin_amdgcn_cosf(rev), __builtin_amdgcn_sinf(rev)}; }
      for (int i = blockIdx.x * NTHR + F.tid; i < SEQ * 16; i += GRID * NTHR) { const int pos = i >> 4, a = i & 15; const float p = (a < 8) ? (float)(pos >> 6) : (float)(pos & 63);
          const float inv = fast_exp2(-(float)(a & 7) * (13.287712379549449f / 8.0f)); const float rev = p * inv * 0.15915494309189535f; TM[i] = (f32x2){__builtin_amdgcn_cosf(rev), __builtin_amdgcn_sinf(rev)}; } }
    phase_mod(F, in, 0, 1, F.vcu, GRID);
}

__device__ __forceinline__ void phase_norm2_route(Frame& F, const float* const* in, int layer, bool dry = false) {
    constexpr int RPW = M / GRID;
    LAS float* wl = (LAS float*)F.lds;
    LAS int* lcnt = (LAS int*)(F.lds + 81920);
    LAS int* lbase = (LAS int*)(F.lds + 81920 + 128);
    LAS int* rcls = (LAS int*)(F.lds + 81920 + 256);
    LAS int* rrank = (LAS int*)(F.lds + 81920 + 256 + 1024);
    LAS float* lgw = (LAS float*)(F.lds + 81920 + 4096);
    const float* wrg = in[8] + (size_t)layer * 1024 * 4; const float* wre = in[10] + (size_t)layer * 1024 * 16;
#pragma unroll
    for (int m = 0; m < 2; ++m) { const int k = F.tid + NTHR * m; const f32x4 w = *(const f32x4*)(wrg + k * 4);
        wl[0 * 1024 + k] = w.x; wl[1 * 1024 + k] = w.y; wl[2 * 1024 + k] = w.z; wl[3 * 1024 + k] = w.w; }
#pragma unroll
    for (int o4 = 0; o4 < 4; ++o4)
#pragma unroll
        for (int m = 0; m < 2; ++m) { const int k = F.tid + NTHR * m; const f32x4 w = *(const f32x4*)(wre + k * 16 + 4 * o4);
            wl[(4 + 4 * o4 + 0) * 1024 + k] = w.x; wl[(4 + 4 * o4 + 1) * 1024 + k] = w.y; wl[(4 + 4 * o4 + 2) * 1024 + k] = w.z; wl[(4 + 4 * o4 + 3) * 1024 + k] = w.w; }
    LAS float* rbias = (LAS float*)(F.lds + 81920 + 8192);
    if (F.tid < 24) lcnt[F.tid] = 0;
    if (F.tid < 4) rbias[F.tid] = (in[9] + layer * 4)[F.tid]; else if (F.tid < 20) rbias[F.tid] = (in[11] + layer * 16)[F.tid - 4];
    __syncthreads();
    const bf16* X = (const bf16*)(F.ws + WS_X); bf16* H = (bf16*)(F.ws + WS_H);
    const float* g = in[5] + layer * D; const float* mod = (const float*)(F.ws + WS_MOD) + (size_t)layer * 9 * 6144;
    float* WT = (float*)(F.ws + MOE_WT); int* SL = (int*)(F.ws + MOE_SL);
    const int row0 = blockIdx.x * RPW; int curm = -1; ModRegs Mr;
    for (int i0 = F.wave; i0 < RPW; i0 += 2 * NWAVES) { const int i1 = i0 + NWAVES; const bool two = i1 < RPW; const int ra = row0 + i0, rb = two ? row0 + i1 : ra;
        f32x4 va[4], vb[4], ha[4], hb[4];
        float sa = row_load_ss(X + (size_t)ra * D, F.lane, va), sb = row_load_ss(X + (size_t)rb * D, F.lane, vb);
        sa = wave_sum(sa); sb = wave_sum(sb);
        { const int mra = modrow_of(ra); if (mra != curm) { curm = mra; const float* mp = mod + (size_t)mra * 6144; mod_load(Mr, g, mp + 4 * 1024, mp + 3 * 1024, F.lane); }
          row_finish_regs(va, sa, Mr, H + (size_t)ra * D, F.lane, ha); }
        { const int mrb = modrow_of(rb); if (mrb != curm) { curm = mrb; const float* mp = mod + (size_t)mrb * 6144; mod_load(Mr, g, mp + 4 * 1024, mp + 3 * 1024, F.lane); }
          row_finish_regs(vb, sb, Mr, H + (size_t)rb * D, F.lane, hb); }
        float ga[4], gb[4];
#pragma unroll
        for (int o = 0; o < 4; ++o) { float s = 0.f, t = 0.f;
#pragma unroll
            for (int j = 0; j < 4; ++j) { const f32x4 w = *(const LAS f32x4*)(wl + o * 1024 + 512 * (j >> 1) + 8 * F.lane + 4 * (j & 1));
                s += (ha[j].x * w.x + ha[j].y * w.y) + (ha[j].z * w.z + ha[j].w * w.w); t += (hb[j].x * w.x + hb[j].y * w.y) + (hb[j].z * w.z + hb[j].w * w.w); }
            ga[o] = wave_sum(s) + rbias[o]; gb[o] = wave_sum(t) + rbias[o]; }
        for (int q = 0; q < (two ? 2 : 1); ++q) { const int r = q ? rb : ra, i = q ? i1 : i0;
        const float g0 = q ? gb[0] : ga[0], g1 = q ? gb[1] : ga[1], g2 = q ? gb[2] : ga[2], g3 = q ? gb[3] : ga[3];
        int gs = 0; float gm = g0; if (g1 > gm) { gm = g1; gs = 1; } if (g2 > gm) { gm = g2; gs = 2; } if (g3 > gm) { gm = g3; gs = 3; }
        const float pg = 1.0f / (fast_exp(g0 - gm) + fast_exp(g1 - gm) + fast_exp(g2 - gm) + fast_exp(g3 - gm));
        float ev[4];
#pragma unroll
        for (int o = 0; o < 4; ++o) { float s = 0.f; const LAS float* wrow = wl + (4 + gs * 4 + o) * 1024;
#pragma unroll
            for (int j = 0; j < 4; ++j) { const f32x4 w = *(const LAS f32x4*)(wrow + 512 * (j >> 1) + 8 * F.lane + 4 * (j & 1)); const f32x4 hq = q ? hb[j] : ha[j];
                s += (hq.x * w.x + hq.y * w.y) + (hq.z * w.z + hq.w * w.w); }
            ev[o] = wave_sum(s) + rbias[4 + gs * 4 + o]; }
        const float e0 = ev[0], e1 = ev[1], e2 = ev[2], e3 = ev[3];
        int i1x = 0; float v1 = e0; if (e1 > v1) { v1 = e1; i1x = 1; } if (e2 > v1) { v1 = e2; i1x = 2; } if (e3 > v1) { v1 = e3; i1x = 3; }
        int i2x = -1; float v2 = -3.0e38f;
        if (i1x != 0 && e0 > v2) { v2 = e0; i2x = 0; } if (i1x != 1 && e1 > v2) { v2 = e1; i2x = 1; } if (i1x != 2 && e2 > v2) { v2 = e2; i2x = 2; } if (i1x != 3 && e3 > v2) { v2 = e3; i2x = 3; }
        const float ex = fast_exp(v2 - v1), w1 = pg / (1.0f + ex), w2 = pg * ex / (1.0f + ex);
        const int lo = i1x < i2x ? i1x : i2x, hi = i1x < i2x ? i2x : i1x; const float wlo = i1x < i2x ? w1 : w2, whi = i1x < i2x ? w2 : w1;
        const int pair = lo == 0 ? hi - 1 : (lo == 1 ? hi + 1 : 5);
        const int cls = gs * 6 + pair;
        if (F.lane == 0 && !dry) { WT[2 * (size_t)r] = wlo; WT[2 * (size_t)r + 1] = whi; rcls[i] = cls; rrank[i] = atomicAdd((int*)&lcnt[cls], 1); }
        }
        LDS_WAIT(); asm volatile("" ::: "memory");
    }
    __syncthreads();
    if (dry) return;
    if (F.tid < 24) lbase[F.tid] = (int)atomicAdd(F.ctl + CW_MOECNT + layer * 64 + F.tid, (unsigned)lcnt[F.tid]);
    __syncthreads();
    for (int i = F.tid; i < RPW; i += NTHR) { const int c = rcls[i]; SL[(size_t)c * M + lbase[c] + rrank[i]] = row0 + i; }
}

__device__ __forceinline__ void phase_final(Frame& F, const float* const* in, bool poison) {
    const bf16* X = (const bf16*)(F.ws + WS_X); const float* g = in[36];
    const int gw = F.vcu * NWAVES + F.wave, NGW = GRID * NWAVES;
    f32x4 gg[4];
#pragma unroll
    for (int j = 0; j < 4; ++j) gg[j] = *(const f32x4*)(g + 512 * (j >> 1) + 8 * F.lane + 4 * (j & 1));
    for (int q0 = gw; q0 < NB * SEQ; q0 += 4 * NGW) { f32x4 v[4][4]; float ss[4];
#pragma unroll
        for (int k = 0; k < 4; ++k) { const int q = q0 + k * NGW; ss[k] = row_load_ss(X + (size_t)((q / SEQ) * TPB + CTX + (q % SEQ)) * D, F.lane, v[k]); }
#pragma unroll
        for (int k = 0; k < 4; ++k) ss[k] = wave_sum(ss[k]);
#pragma unroll
        for (int k = 0; k < 4; ++k) { float rs = rsqrtf(ss[k] * (1.f / D) + EPS); if (poison) rs = __builtin_nanf(""); float* op = F.out + (size_t)(q0 + k * NGW) * D;
#pragma unroll
            for (int j = 0; j < 4; ++j) { const int o = 512 * (j >> 1) + 8 * F.lane + 4 * (j & 1); *(f32x4*)(op + o) = v[k][j] * rs * gg[j]; } } }
}
typedef f32x4 AccT[2][2][4][2];
using pg8::Unit;

__device__ __forceinline__ void rope8c(f32x4& a, f32x4& b, const f32x4 c01, const f32x4 c23) {
    float t;
    t = a[0] * c01[0] - a[1] * c01[1]; a[1] = a[1] * c01[0] + a[0] * c01[1]; a[0] = t;
    t = a[2] * c01[2] - a[3] * c01[3]; a[3] = a[3] * c01[2] + a[2] * c01[3]; a[2] = t;
    t = b[0] * c23[0] - b[1] * c23[1]; b[1] = b[1] * c23[0] + b[0] * c23[1]; b[0] = t;
    t = b[2] * c23[2] - b[3] * c23[3]; b[3] = b[3] * c23[2] + b[2] * c23[3]; b[2] = t;
}
__device__ __forceinline__ void rope8(f32x4& a, f32x4& b, const f32x2* cs) {
    const f32x4 c01 = *(const f32x4*)cs, c23 = *(const f32x4*)(cs + 2);
    float t;
    t = a[0] * c01[0] - a[1] * c01[1]; a[1] = a[1] * c01[0] + a[0] * c01[1]; a[0] = t;
    t = a[2] * c01[2] - a[3] * c01[3]; a[3] = a[3] * c01[2] + a[2] * c01[3]; a[2] = t;
    t = b[0] * c23[0] - b[1] * c23[1]; b[1] = b[1] * c23[0] + b[0] * c23[1]; b[0] = t;
    t = b[2] * c23[2] - b[3] * c23[3]; b[3] = b[3] * c23[2] + b[2] * c23[3]; b[2] = t;
}

__device__ __forceinline__ void unpack8(const v4u w, f32x4& a, f32x4& b) { a = (f32x4){bflo(w.x), bfhi(w.x), bflo(w.y), bfhi(w.y)}; b = (f32x4){bflo(w.z), bfhi(w.z), bflo(w.w), bfhi(w.w)}; }
struct EpiResid {
    static constexpr bool PERM = true;
    bf16* X; const float* gate; const float* x_in; const float* ctx_in;
    __device__ __forceinline__ void operator()(const AccT& acc, const Unit& u, int ui, int wr, int wc, int fr, int fq) const {
        const int tb = u.pm % 17, b = u.pm / 17; const float* gv = gate + (size_t)(tb == 0 ? 8 : b) * 6144;
        const float* src = x_in ? (tb == 0 ? ctx_in + (size_t)b * CTX * D : x_in + ((size_t)b * SEQ + (tb - 1) * 256) * D) : nullptr;
        const int rl0 = wr * 64 + fr, col0 = u.pn * 256 + wc * 32 + 8 * fq;
        f32x4 g4[2][2];
#pragma unroll
        for (int bj = 0; bj < 2; ++bj)
#pragma unroll
            for (int n = 0; n < 2; ++n) g4[bj][n] = *(const f32x4*)(gv + col0 + bj * 128 + n * 4);
        if (!src) {
            v4u raw[2][2][2][2];
#pragma unroll
            for (int ai = 0; ai < 2; ++ai)
#pragma unroll
                for (int mp = 0; mp < 2; ++mp)
#pragma unroll
                    for (int mm = 0; mm < 2; ++mm) { const int rl = rl0 + ai * 128 + (2 * mp + mm) * 16;
#pragma unroll
                        for (int bj = 0; bj < 2; ++bj) raw[ai][mp][mm][bj] = *(const v4u*)(X + ((size_t)u.pm * 256 + rl) * D + col0 + bj * 128); }
#pragma unroll
            for (int ai = 0; ai < 2; ++ai)
#pragma unroll
                for (int mp = 0; mp < 2; ++mp) {
#pragma unroll
                    for (int mm = 0; mm < 2; ++mm) { const int rl = rl0 + ai * 128 + (2 * mp + mm) * 16;
#pragma unroll
                        for (int bj = 0; bj < 2; ++bj) { f32x4 x0, x1; unpack8(raw[ai][mp][mm][bj], x0, x1);
                            *(v4u*)(X + ((size_t)u.pm * 256 + rl) * D + col0 + bj * 128) = pack8(x0 + g4[bj][0] * acc[ai][bj][2 * mp + mm][0], x1 + g4[bj][1] * acc[ai][bj][2 * mp + mm][1]); } }
                    asm volatile("" ::: "memory"); }
            return; }
#pragma unroll
        for (int ai = 0; ai < 2; ++ai) { f32x4 xin[2][2][2][2];
#pragma unroll
            for (int mp = 0; mp < 2; ++mp)
#pragma unroll
                for (int mm = 0; mm < 2; ++mm) { const int rl = rl0 + ai * 128 + (2 * mp + mm) * 16;
#pragma unroll
                    for (int bj = 0; bj < 2; ++bj) { const float* sp = src + (size_t)rl * D + col0 + bj * 128; xin[mp][mm][bj][0] = *(const f32x4*)sp; xin[mp][mm][bj][1] = *(const f32x4*)(sp + 4); } }
#pragma unroll
            for (int mp = 0; mp < 2; ++mp) {
#pragma unroll
                for (int mm = 0; mm < 2; ++mm) { const int rl = rl0 + ai * 128 + (2 * mp + mm) * 16;
#pragma unroll
                    for (int bj = 0; bj < 2; ++bj) *(v4u*)(X + ((size_t)u.pm * 256 + rl) * D + col0 + bj * 128) =
                        pack8(xin[mp][mm][bj][0] + g4[bj][0] * acc[ai][bj][2 * mp + mm][0], xin[mp][mm][bj][1] + g4[bj][1] * acc[ai][bj][2 * mp + mm][1]); }
                asm volatile("" ::: "memory"); } }
    }
};

struct EpiAttnIn {
    static constexpr bool PERM = true;
    bf16 *Q, *Kb, *Vb; const f32x2* tab; float qscale;
    __device__ __forceinline__ void operator()(const AccT& acc, const Unit& u, int ui, int wr, int wc, int fr, int fq) const {
        const int tb = u.pm % 17; const bool lat = tb != 0; const int pos0 = (tb - 1) * 256;
        bf16* base; int ld, colt; float sc = 1.f; bool rope = lat;
        if (u.pn < 4) { base = Q; ld = 1024; colt = u.pn * 256; sc = qscale; } else if (u.pn == 4) { base = Kb; ld = 256; colt = 0; } else { base = Vb; ld = 256; colt = 0; rope = false; }
#pragma unroll
        for (int ai = 0; ai < 2; ++ai) {
            f32x4 rc[4][2];
            if (rope) {
#pragma unroll
                for (int m = 0; m < 4; ++m) { const f32x2* cs = tab + (size_t)(pos0 + ai * 128 + wr * 64 + m * 16 + fr) * 32 + (((wc * 32 + 8 * fq) & 63) >> 1); rc[m][0] = *(const f32x4*)cs; rc[m][1] = *(const f32x4*)(cs + 2); } }
#pragma unroll
            for (int m = 0; m < 4; ++m) { const int rl = ai * 128 + wr * 64 + m * 16 + fr; const size_t row = (size_t)u.pm * 256 + rl;
#pragma unroll
                for (int bj = 0; bj < 2; ++bj) { const int cl = bj * 128 + wc * 32 + 8 * fq;
                    f32x4 a = acc[ai][bj][m][0] * sc, b = acc[ai][bj][m][1] * sc;
                    if (rope) rope8c(a, b, rc[m][0], rc[m][1]);
                    *(v4u*)(base + row * ld + colt + cl) = pack8(a, b); }
                asm volatile("" ::: "memory"); } }
    }
};

struct EpiSsmIn {
    static constexpr bool PERM = true;
    bf16 *Z, *XBC; float* DT; const float* dtb;
    __device__ __forceinline__ void operator()(const AccT& acc, const Unit& u, int ui, int wr, int wc, int fr, int fq) const {
#pragma unroll
        for (int ai = 0; ai < 2; ++ai)
#pragma unroll
            for (int m = 0; m < 4; ++m) { const size_t row = (size_t)u.pm * 256 + ai * 128 + wr * 64 + m * 16 + fr;
#pragma unroll
                for (int bj = 0; bj < 2; ++bj) { const int c = u.pn * 256 + bj * 128 + wc * 32 + 8 * fq;
                    const f32x4 a = acc[ai][bj][m][0], b = acc[ai][bj][m][1];
                    if (c < 1024) *(v4u*)(Z + row * 1024 + c) = pack8(a, b);
                    else if (c < 2560) *(v4u*)(XBC + row * 1536 + (c - 1024)) = pack8(a, b);
                    else if (c < 2592) { const int cc = c - 2560; f32x4 o0, o1;
#pragma unroll
                        for (int j = 0; j < 4; ++j) { o0[j] = softplus_f(a[j] + dtb[(cc >> 4) * 32 + (cc & 15) + j]); o1[j] = softplus_f(b[j] + dtb[(cc >> 4) * 32 + (cc & 15) + 4 + j]); }
                        *(f32x4*)(DT + row * 32 + cc) = o0; *(f32x4*)(DT + row * 32 + cc + 4) = o1; } } }
    }
};

struct EpiMlIn {
    static constexpr bool PERM = true;
    bf16 *Qm, *Km, *Vm, *Om; float* G; const float* gb;
    __device__ __forceinline__ void operator()(const AccT& acc, const Unit& u, int ui, int wr, int wc, int fr, int fq) const {
#pragma unroll
        for (int ai = 0; ai < 2; ++ai)
#pragma unroll
            for (int m = 0; m < 4; ++m) { const size_t row = (size_t)u.pm * 256 + ai * 128 + wr * 64 + m * 16 + fr;
#pragma unroll
                for (int bj = 0; bj < 2; ++bj) { const int c = u.pn * 256 + bj * 128 + wc * 32 + 8 * fq;
                    const f32x4 a = acc[ai][bj][m][0], b = acc[ai][bj][m][1];
                    if (c < 512) *(v4u*)(Qm + row * 512 + c) = pack8(a, b);
                    else if (c < 1024) *(v4u*)(Km + row * 512 + (c - 512)) = pack8(a * 0.125f, b * 0.125f);
                    else if (c < 2048) *(v4u*)(Vm + row * 1024 + (c - 1024)) = pack8(a, b);
                    else if (c < 3072) *(v4u*)(Om + row * 1024 + (c - 2048)) = pack8(a, b);
                    else if (c < 3104) { const int cc = c - 3072; f32x4 o0, o1; const bool fg = ((cc >> 3) & 1) != 0;
#pragma unroll
                        for (int j = 0; j < 4; ++j) { float x0 = a[j] + gb[cc + j], x1 = b[j] + gb[cc + 4 + j];
                            o0[j] = fg ? -softplus_f(-x0) : x0; o1[j] = fg ? -softplus_f(-x1) : x1; }
                        *(f32x4*)(G + row * 32 + cc) = o0; *(f32x4*)(G + row * 32 + cc + 4) = o1; } } }
    }
};

struct EpiMlaIn {
    static constexpr bool PERM = true;
    bf16 *CQ, *CKV, *KF; float* SSQ; const f32x2* tab;
    __device__ __forceinline__ void operator()(const AccT& acc, const Unit& u, int ui, int wr, int wc, int fr, int fq) const {
        const int tb = u.pm % 17; const bool lat = tb != 0; const int pos0 = (tb - 1) * 256;
#pragma unroll
        for (int ai = 0; ai < 2; ++ai)
#pragma unroll
            for (int m = 0; m < 4; ++m) { const int rl = ai * 128 + wr * 64 + m * 16 + fr; const size_t row = (size_t)u.pm * 256 + rl;
                if (u.pn < 2) { bf16* dst = u.pn == 0 ? CQ : CKV; float ss = 0.f;
#pragma unroll
                    for (int bj = 0; bj < 2; ++bj) { const int c = bj * 128 + wc * 32 + 8 * fq; const f32x4 a = acc[ai][bj][m][0], b = acc[ai][bj][m][1];
                        ss += (a[0] * a[0] + a[1] * a[1]) + (a[2] * a[2] + a[3] * a[3]) + (b[0] * b[0] + b[1] * b[1]) + (b[2] * b[2] + b[3] * b[3]);
                        *(v4u*)(dst + row * 256 + c) = pack8(a, b); }
                    ss += __shfl_xor(ss, 16); ss += __shfl_xor(ss, 32);
                    if (fq == 0) SSQ[row * 8 + u.pn * 4 + wc] = ss;
                } else if (wc == 0) {
                    f32x4 a = acc[ai][0][m][0], b = acc[ai][0][m][1]; const int cl = 8 * fq;
                    if (lat) rope8(a, b, tab + (size_t)(pos0 + rl) * 16 + (cl >> 1));
                    const v4u w = pack8(a, b);
#pragma unroll
                    for (int h = 0; h < 16; ++h) *(v4u*)(KF + row * 1536 + h * 96 + 64 + cl) = w; }
                asm volatile("" ::: "memory"); }
    }
};
struct EpiMlaQ {
    static constexpr bool PERM = true;
    bf16* Q3; const float* SSQ; const f32x2* tab; float qscale;
    __device__ __forceinline__ void operator()(const AccT& acc, const Unit& u, int ui, int wr, int wc, int fr, int fq) const {
        const int tb = u.pm % 17; const bool lat = tb != 0; const int pos0 = (tb - 1) * 256;
        f32x4 sq[2][4];
#pragma unroll
        for (int ai = 0; ai < 2; ++ai)
#pragma unroll
            for (int m = 0; m < 4; ++m) sq[ai][m] = *(const f32x4*)(SSQ + ((size_t)u.pm * 256 + ai * 128 + wr * 64 + m * 16 + fr) * 8);
        const int e0 = (u.pn * 256 + wc * 32 + 8 * fq) % 96, e1 = (u.pn * 256 + 128 + wc * 32 + 8 * fq) % 96; const int er = e0 >= 64 ? e0 : e1; const bool anyr = lat && er >= 64;
#pragma unroll
        for (int ai = 0; ai < 2; ++ai) {
            f32x4 rc[4][2];
            if (anyr) {
#pragma unroll
                for (int m = 0; m < 4; ++m) { const f32x2* cs = tab + (size_t)(pos0 + ai * 128 + wr * 64 + m * 16 + fr) * 16 + ((er - 64) >> 1); rc[m][0] = *(const f32x4*)cs; rc[m][1] = *(const f32x4*)(cs + 2); } }
#pragma unroll
            for (int m = 0; m < 4; ++m) { const int rl = ai * 128 + wr * 64 + m * 16 + fr; const size_t row = (size_t)u.pm * 256 + rl;
                const f32x4 s4 = sq[ai][m]; const float rs = rsqrtf(((s4[0] + s4[1]) + (s4[2] + s4[3])) * (1.f / 256.f) + EPS) * qscale;
#pragma unroll
                for (int bj = 0; bj < 2; ++bj) { const int c = u.pn * 256 + bj * 128 + wc * 32 + 8 * fq; const int e = bj ? e1 : e0;
                    f32x4 a = acc[ai][bj][m][0] * rs, b = acc[ai][bj][m][1] * rs;
                    if (lat && e >= 64) rope8c(a, b, rc[m][0], rc[m][1]);
                    *(v4u*)(Q3 + row * 1536 + c) = pack8(a, b); }
                asm volatile("" ::: "memory"); } }
    }
};
struct EpiMlaKV {
    static constexpr bool PERM = true;
    bf16 *KF, *V3; const float* SSQ;
    __device__ __forceinline__ void operator()(const AccT& acc, const Unit& u, int ui, int wr, int wc, int fr, int fq) const {
        f32x4 sq[2][4];
#pragma unroll
        for (int ai = 0; ai < 2; ++ai)
#pragma unroll
            for (int m = 0; m < 4; ++m) sq[ai][m] = *(const f32x4*)(SSQ + ((size_t)u.pm * 256 + ai * 128 + wr * 64 + m * 16 + fr) * 8 + 4);
#pragma unroll
        for (int ai = 0; ai < 2; ++ai)
#pragma unroll
            for (int m = 0; m < 4; ++m) { const size_t row = (size_t)u.pm * 256 + ai * 128 + wr * 64 + m * 16 + fr;
                const f32x4 s4 = sq[ai][m]; const float rs = rsqrtf(((s4[0] + s4[1]) + (s4[2] + s4[3])) * (1.f / 256.f) + EPS);
#pragma unroll
                for (int bj = 0; bj < 2; ++bj) { const int c = u.pn * 256 + bj * 128 + wc * 32 + 8 * fq; const int h = c >> 7, e = c & 127;
                    const v4u w = pack8(acc[ai][bj][m][0] * rs, acc[ai][bj][m][1] * rs);
                    if (e < 64) *(v4u*)(KF + row * 1536 + h * 96 + e) = w; else *(v4u*)(V3 + row * 1024 + h * 64 + (e - 64)) = w; }
                asm volatile("" ::: "memory"); }
    }
};

struct TblEnt { int tok; float w0, w1; int pad; };
__device__ __forceinline__ int cls_expert(int cls, int which) { const int g = cls / 6, p = cls - g * 6; const int lo = p < 3 ? 0 : (p < 5 ? 1 : 2), hi = p < 3 ? p + 1 : (p < 5 ? p - 1 : 3); return g * 4 + (which ? hi : lo); }
template <int MODE> struct MoeOrder {
    static constexpr bool GATHER = (MODE == 0);
    const LAS int* tb;
    const LAS unsigned char* tcls;
    const LAS TblEnt* tbl;
    const bf16* W; int G, c;
    __device__ __forceinline__ bool next(int i, Unit& u) const {
        const int L = i * G + c, tile = L >> 2; if (tile >= tb[24]) return false;
        const int cls = tcls[tile];
        u.pm = tile; u.pn = L & 3; u.aux = cls | (i << 8); return true;
    }
    __device__ __forceinline__ int a_row(const Unit& u, int r) const {
        if (MODE == 1) return u.pm * 256 + r;
        const int t = tbl[(u.aux >> 8) * 256 + r].tok; return t < 0 ? 0 : t;
    }
    __device__ __forceinline__ const char* b_seg(const Unit& u, int seg) const {
        const int cls = u.aux & 255;
        if (MODE == 0) return (const char*)(W + ((size_t)cls_expert(cls, u.pn >> 1) * 512 + (u.pn & 1) * 256) * 1024);
        return (const char*)(W + ((size_t)cls_expert(cls, seg) * 1024 + u.pn * 256) * 256);
    }
};
template <int MODE> __device__ __forceinline__ void moe_setup(Frame& F, int layer, MoeOrder<MODE>& S) {
    LAS int* tb = (LAS int*)(F.lds + LDS_TB); LAS int* cn = tb + 32; LAS TblEnt* tbl = (LAS TblEnt*)(F.lds + LDS_TBL);
    if (MODE == 1) {
        S.tb = tb; S.tbl = tbl; S.tcls = (const LAS unsigned char*)(F.lds + LDS_TB + 256); __syncthreads(); return; }
    LAS unsigned char* tcls = (LAS unsigned char*)(F.lds + LDS_TB + 256);
    if (F.wave == 0) { const int k = F.lane; const int n = k < 24 ? (int)__hip_atomic_load(F.ctl + CW_MOECNT + layer * 64 + k, RLX_AGENT) : 0;
        const int nt = (n + 255) >> 8; const int incl = (int)wave_scan_sum((float)nt); const int t0 = incl - nt;
        if (k < 24) { cn[k] = n; tb[k] = t0; for (int t = t0; t < incl; ++t) tcls[t] = (unsigned char)k; }
        if (k == 23) tb[24] = incl; }
    __syncthreads();
    S.tb = tb; S.tbl = tbl; S.tcls = tcls;
    const int* SL = (const int*)(F.ws + MOE_SL); const float* WT = (const float*)(F.ws + MOE_WT);
    if (F.tid < 256) { bool ok[4]; int tok[4]; f32x2 w[4];
#pragma unroll
        for (int i = 0; i < 4; ++i) { Unit u; ok[i] = S.next(i, u); tok[i] = -1;
            if (ok[i]) { const int cls = u.aux & 255, idx = (u.pm - tb[cls]) * 256 + F.tid; if (idx < cn[cls]) tok[i] = SL[(size_t)cls * M + idx]; } }
#pragma unroll
        for (int i = 0; i < 4; ++i) { w[i] = (f32x2){0.f, 0.f}; if (tok[i] >= 0) w[i] = *(const f32x2*)(WT + 2 * (size_t)tok[i]); }
#pragma unroll
        for (int i = 0; i < 4; ++i) { if (ok[i]) { LAS TblEnt* te = tbl + i * 256 + F.tid; te->tok = tok[i]; te->w0 = w[i].x; te->w1 = w[i].y; te->pad = 0; } } }
    __syncthreads();
}
struct EpiMoeAct {
    static constexpr bool PERM = true;
    bf16* ACT; const LAS TblEnt* tbl;
    __device__ __forceinline__ void operator()(const AccT& acc, const Unit& u, int ui, int wr, int wc, int fr, int fq) const {
        const int slot = u.pn >> 1, colb = slot * 256 + (u.pn & 1) * 128 + wc * 32 + 8 * fq;
#pragma unroll
        for (int ai = 0; ai < 2; ++ai)
#pragma unroll
            for (int m = 0; m < 4; ++m) { const int rl = ai * 128 + wr * 64 + m * 16 + fr; const LAS TblEnt* te = tbl + (u.aux >> 8) * 256 + rl; const float w = slot ? te->w1 : te->w0;
                f32x4 a, b;
#pragma unroll
                for (int j = 0; j < 4; ++j) { a[j] = silu_f(acc[ai][0][m][0][j]) * acc[ai][1][m][0][j] * w; b[j] = silu_f(acc[ai][0][m][1][j]) * acc[ai][1][m][1][j] * w; }
                *(v4u*)(ACT + ((size_t)u.pm * 256 + rl) * 512 + colb) = pack8(a, b);
                asm volatile("" ::: "memory"); }
    }
};
struct EpiMoeDown {
    static constexpr bool PERM = true;
    bf16* X; const bf16* gateb; const LAS TblEnt* tbl;
    __device__ __forceinline__ void operator()(const AccT& acc, const Unit& u, int ui, int wr, int wc, int fr, int fq) const {
        const int col0 = u.pn * 256 + wc * 32 + 8 * fq;
#pragma unroll
        for (int ai = 0; ai < 2; ++ai) {
            int tk[2][2]; v4u raw[2][2][2], gw[2][2][2];
#pragma unroll
            for (int mp = 0; mp < 2; ++mp)
#pragma unroll
                for (int mm = 0; mm < 2; ++mm) { const int rl = ai * 128 + wr * 64 + (2 * mp + mm) * 16 + fr; const int tok = tbl[(u.aux >> 8) * 256 + rl].tok; tk[mp][mm] = tok; const int t0 = tok < 0 ? 0 : tok;
                    const bf16* rowp = X + (size_t)t0 * D + col0; const bf16* gv = gateb + (size_t)modrow_of(t0) * 1024 + col0;
#pragma unroll
                    for (int bj = 0; bj < 2; ++bj) { raw[mp][mm][bj] = *(const v4u*)(rowp + bj * 128); gw[mp][mm][bj] = *(const v4u*)(gv + bj * 128); } }
#pragma unroll
            for (int mp = 0; mp < 2; ++mp) {
#pragma unroll
                for (int mm = 0; mm < 2; ++mm) { if (tk[mp][mm] >= 0) { bf16* rowp = X + (size_t)tk[mp][mm] * D + col0;
#pragma unroll
                    for (int bj = 0; bj < 2; ++bj) { f32x4 x0, x1, g0, g1; unpack8(raw[mp][mm][bj], x0, x1); unpack8(gw[mp][mm][bj], g0, g1);
                        *(v4u*)(rowp + bj * 128) = pack8(x0 + g0 * acc[ai][bj][2 * mp + mm][0], x1 + g1 * acc[ai][bj][2 * mp + mm][1]); } } }
                asm volatile("" ::: "memory"); } }
    }
};
template <int DQK, bool WIN>
__device__ __forceinline__ void flash_unit(LAS unsigned char* lds, const int tid, const int lane, const int grpB,
        const bf16* Kg, const int ldk, const bf16* Vg, const int ldv,
        const bf16* Qg, const int ldq, bf16* Og, const int ldo,
        const int ntiles, const int krow_ctx0, const int krow_lat0, const int kpos0, const int qpos_wave, const float sink2, const bool has_sink) {
    constexpr int KSTR = DQK * 2 + 16, VSTR = 160, KBUF = 64 * KSTR, VBUF = 64 * VSTR, CPR = DQK / 8, NKC = 64 * CPR, NKR = (NKC + 511) / 512, NKS = DQK / 32;
    LAS unsigned char* Kl = lds; LAS unsigned char* Vl = lds + 2 * KBUF;
    const int fr = lane & 15, fq = lane >> 4;
    bf16x8 qf[2][NKS];
#pragma unroll
    for (int qt = 0; qt < 2; ++qt)
#pragma unroll
        for (int ks = 0; ks < NKS; ++ks) qf[qt][ks] = *(const bf16x8*)(Qg + (size_t)(16 * qt + fr) * ldq + 32 * ks + 8 * fq);
    f32x4 oacc[4][2];
#pragma unroll
    for (int c = 0; c < 4; ++c) { oacc[c][0] = (f32x4){0.f, 0.f, 0.f, 0.f}; oacc[c][1] = (f32x4){0.f, 0.f, 0.f, 0.f}; }
    float mrun[2] = {-1.0e30f, -1.0e30f}, lsum[2] = {0.f, 0.f};
    v4u kreg[NKR], vreg;
    bf16x8 pf[2][2]; bool pvalid = false; int pvb = 0;
#pragma unroll
    for (int a = 0; a < 2; ++a)
#pragma unroll
        for (int b2 = 0; b2 < 2; ++b2)
#pragma unroll
            for (int e = 0; e < 8; ++e) pf[a][b2][e] = 0;
#define FA_LOAD(j) do { const int _rb = (j) < 4 ? krow_ctx0 + 64 * (j) : krow_lat0 + 64 * ((j) - 4); \
        _Pragma("unroll") for (int _i = 0; _i < NKR; ++_i) { const int _c = tid + 512 * _i; if (_c < NKC) kreg[_i] = *(const v4u*)(Kg + (size_t)(_rb + _c / CPR) * ldk + (_c % CPR) * 8); } \
        vreg = *(const v4u*)(Vg + (size_t)(_rb + (tid >> 3)) * ldv + (tid & 7) * 8); } while (0)
#define FA_STORE(kb, vb) do { _Pragma("unroll") for (int _i = 0; _i < NKR; ++_i) { const int _c = tid + 512 * _i; if (_c < NKC) *(LAS v4u*)(Kl + (kb) * KBUF + (_c / CPR) * KSTR + (_c % CPR) * 16) = kreg[_i]; } \
        *(LAS v4u*)(Vl + (vb) * VBUF + (tid >> 3) * VSTR + (tid & 7) * 16) = vreg; } while (0)
#define FA_PV(vbuf) do { _Pragma("unroll") for (int ks2 = 0; ks2 < 2; ++ks2) _Pragma("unroll") for (int c = 0; c < 4; ++c) { \
            const LAS unsigned char* vb_ = Vl + (vbuf) * VBUF + (32 * ks2 + 4 * fq + ((lane & 15) >> 2)) * VSTR + (16 * c + 4 * (lane & 3)) * 2; \
            const s16x4 v0 = __builtin_amdgcn_ds_read_tr16_b64_v4i16((LAS s16x4*)vb_); const s16x4 v1 = __builtin_amdgcn_ds_read_tr16_b64_v4i16((LAS s16x4*)(vb_ + 16 * VSTR)); \
            bf16x8 vf; vf[0] = v0[0]; vf[1] = v0[1]; vf[2] = v0[2]; vf[3] = v0[3]; vf[4] = v1[0]; vf[5] = v1[1]; vf[6] = v1[2]; vf[7] = v1[3]; \
            oacc[c][0] = __builtin_amdgcn_mfma_f32_16x16x32_bf16(vf, pf[0][ks2], oacc[c][0], 0, 0, 0); \
            oacc[c][1] = __builtin_amdgcn_mfma_f32_16x16x32_bf16(vf, pf[1][ks2], oacc[c][1], 0, 0, 0); } } while (0)
    FA_LOAD(0); FA_STORE(0, 0); __syncthreads();
    int vcur = 0;
    for (int j = 0; j < ntiles; ++j) {
        const int kb = j & 1;
        if (j + 1 < ntiles) FA_LOAD(j + 1);
        if (grpB && pvalid) { __builtin_amdgcn_s_setprio(1); FA_PV(pvb); __builtin_amdgcn_s_setprio(0); }
        bool skip = false; const int kp = kpos0 + 64 * (j - 4);
        if (WIN && j >= 4) skip = (kp + 63 < qpos_wave - 128) || (kp > qpos_wave + 31 + 128);
        pvalid = !skip; pvb = vcur;
        if (!skip) {
            f32x4 sacc[4][2];
#pragma unroll
            for (int kt = 0; kt < 4; ++kt) { sacc[kt][0] = (f32x4){0.f, 0.f, 0.f, 0.f}; sacc[kt][1] = (f32x4){0.f, 0.f, 0.f, 0.f}; }
            __builtin_amdgcn_s_setprio(1);
#pragma unroll
            for (int ks = 0; ks < NKS; ++ks) { bf16x8 kf[4];
#pragma unroll
                for (int kt = 0; kt < 4; ++kt) kf[kt] = *(const LAS bf16x8*)(Kl + kb * KBUF + (16 * kt + fr) * KSTR + (32 * ks + 8 * fq) * 2);
#pragma unroll
                for (int kt = 0; kt < 4; ++kt) { sacc[kt][0] = __builtin_amdgcn_mfma_f32_16x16x32_bf16(kf[kt], qf[0][ks], sacc[kt][0], 0, 0, 0);
                                                 sacc[kt][1] = __builtin_amdgcn_mfma_f32_16x16x32_bf16(kf[kt], qf[1][ks], sacc[kt][1], 0, 0, 0); } }
            __builtin_amdgcn_s_setprio(0);
            if (WIN && j >= 4) {
#pragma unroll
                for (int kt = 0; kt < 4; ++kt)
#pragma unroll
                    for (int qt = 0; qt < 2; ++qt)
#pragma unroll
                        for (int jj = 0; jj < 4; ++jj) { const int d = (kp + 16 * kt + 4 * fq + jj) - (qpos_wave + 16 * qt + fr); if (d < -128 || d > 128) sacc[kt][qt][jj] = -1.0e30f; } }
#pragma unroll
            for (int qt = 0; qt < 2; ++qt) {
                float mx = sacc[0][qt][0];
#pragma unroll
                for (int kt = 0; kt < 4; ++kt)
#pragma unroll
                    for (int jj = 0; jj < 4; ++jj) mx = fmaxf(mx, sacc[kt][qt][jj]);
                mx = fmaxf(mx, __shfl_xor(mx, 16)); mx = fmaxf(mx, xor32(mx));
                float mnew = mrun[qt];
                if (__builtin_amdgcn_ballot_w64(mx > mrun[qt] + 11.5f) != 0ull) {
                    mnew = fmaxf(mrun[qt], mx); const float alpha = fast_exp2(mrun[qt] - mnew); lsum[qt] *= alpha;
#pragma unroll
                    for (int c = 0; c < 4; ++c) oacc[c][qt] = oacc[c][qt] * alpha; }
                mrun[qt] = mnew;
                float ps = 0.f;
#pragma unroll
                for (int kt = 0; kt < 4; ++kt)
#pragma unroll
                    for (int jj = 0; jj < 4; ++jj) { const float p = fast_exp2(sacc[kt][qt][jj] - mnew); sacc[kt][qt][jj] = p; ps += p; }
                lsum[qt] += ps;
#pragma unroll
                for (int ks2 = 0; ks2 < 2; ++ks2) { const v4u w = pack8(sacc[2 * ks2][qt], sacc[2 * ks2 + 1][qt]); pf[qt][ks2] = __builtin_bit_cast(bf16x8, w); }
            }
            if (!grpB) { __builtin_amdgcn_s_setprio(1); FA_PV(vcur); __builtin_amdgcn_s_setprio(0); }
        }
        const int vnext = vcur == 2 ? 0 : vcur + 1;
        if (j + 1 < ntiles) FA_STORE(kb ^ 1, vnext);
        vcur = vnext;
        __syncthreads();
    }
    if (grpB && pvalid) FA_PV(pvb);
    __syncthreads();
#pragma unroll
    for (int qt = 0; qt < 2; ++qt) { float l = lsum[qt]; l += __shfl_xor(l, 16); l += xor32(l); if (has_sink) l += fast_exp2(sink2 - mrun[qt]);
        const float inv = 1.0f / l;
#pragma unroll
        for (int c = 0; c < 4; ++c) { const f32x4 o = oacc[c][qt] * inv; v2u w; w.x = cvt_pk_bf16(o[0], o[1]); w.y = cvt_pk_bf16(o[2], o[3]);
            *(v2u*)(Og + (size_t)(16 * qt + fr) * ldo + 16 * c + 4 * fq) = w; } }
#undef FA_LOAD
#undef FA_STORE
#undef FA_PV
}

template <int DQK>
__device__ __forceinline__ void flash_unit2(LAS unsigned char* lds, const int tid, const int lane, const int grpB,
        const bf16* Kg, const int ldk, const bf16* Vg, const int ldv,
        const bf16* Qg, const int ldq, bf16* Og, const int ldo,
        const int ntiles, const int krow_ctx0, const int krow_lat0, const int kpos0, const int qpos_wave, const float sink2, const bool has_sink) {
    constexpr bool WIN = false; constexpr int KSTR = DQK * 2 + 16, VSTR = 160, KBUF = 128 * KSTR, VBUF = 128 * VSTR, CPR = DQK / 8, NKC = 128 * CPR, NKR = (NKC + 511) / 512, NKS = DQK / 32;
    LAS unsigned char* Kl = lds; LAS unsigned char* Vl = lds + 2 * KBUF;
    const int fr = lane & 15, fq = lane >> 4;
    bf16x8 qf[2][NKS];
#pragma unroll
    for (int qt = 0; qt < 2; ++qt)
#pragma unroll
        for (int ks = 0; ks < NKS; ++ks) qf[qt][ks] = *(const bf16x8*)(Qg + (size_t)(16 * qt + fr) * ldq + 32 * ks + 8 * fq);
    f32x4 oacc[4][2];
#pragma unroll
    for (int c = 0; c < 4; ++c) { oacc[c][0] = (f32x4){0.f, 0.f, 0.f, 0.f}; oacc[c][1] = (f32x4){0.f, 0.f, 0.f, 0.f}; }
    float mrun[2] = {-1.0e30f, -1.0e30f}, lsum[2] = {0.f, 0.f};
    v4u kreg[NKR], vreg[2];
    bf16x8 pf[2][2]; bool pvalid = false; int pvb = 0;
#pragma unroll
    for (int a = 0; a < 2; ++a)
#pragma unroll
        for (int b2 = 0; b2 < 2; ++b2)
#pragma unroll
            for (int e = 0; e < 8; ++e) pf[a][b2][e] = 0;
#define FA_LOAD(p) do { const int _rb = krow_ctx0 + 128 * (p); \
        _Pragma("unroll") for (int _i = 0; _i < NKR; ++_i) { const int _c = tid + 512 * _i; if (_c < NKC) kreg[_i] = *(const v4u*)(Kg + (size_t)(_rb + _c / CPR) * ldk + (_c % CPR) * 8); } \
        _Pragma("unroll") for (int _i = 0; _i < 2; ++_i) { const int _c = tid + 512 * _i; vreg[_i] = *(const v4u*)(Vg + (size_t)(_rb + (_c >> 3)) * ldv + (_c & 7) * 8); } } while (0)
#define FA_STORE(kb, vb) do { _Pragma("unroll") for (int _i = 0; _i < NKR; ++_i) { const int _c = tid + 512 * _i; if (_c < NKC) *(LAS v4u*)(Kl + (kb) * KBUF + (_c / CPR) * KSTR + (_c % CPR) * 16) = kreg[_i]; } \
        _Pragma("unroll") for (int _i = 0; _i < 2; ++_i) { const int _c = tid + 512 * _i; *(LAS v4u*)(Vl + (vb) * VBUF + (_c >> 3) * VSTR + (_c & 7) * 16) = vreg[_i]; } } while (0)
#define FA_PV(vbuf) do { _Pragma("unroll") for (int ks2 = 0; ks2 < 2; ++ks2) _Pragma("unroll") for (int c = 0; c < 4; ++c) { \
            const LAS unsigned char* vb_ = Vl + (vbuf) + (32 * ks2 + 4 * fq + ((lane & 15) >> 2)) * VSTR + (16 * c + 4 * (lane & 3)) * 2; \
            const s16x4 v0 = __builtin_amdgcn_ds_read_tr16_b64_v4i16((LAS s16x4*)vb_); const s16x4 v1 = __builtin_amdgcn_ds_read_tr16_b64_v4i16((LAS s16x4*)(vb_ + 16 * VSTR)); \
            bf16x8 vf; vf[0] = v0[0]; vf[1] = v0[1]; vf[2] = v0[2]; vf[3] = v0[3]; vf[4] = v1[0]; vf[5] = v1[1]; vf[6] = v1[2]; vf[7] = v1[3]; \
            oacc[c][0] = __builtin_amdgcn_mfma_f32_16x16x32_bf16(vf, pf[0][ks2], oacc[c][0], 0, 0, 0); \
            oacc[c][1] = __builtin_amdgcn_mfma_f32_16x16x32_bf16(vf, pf[1][ks2], oacc[c][1], 0, 0, 0); } } while (0)
    FA_LOAD(0); FA_STORE(0, 0); __syncthreads();
    int vcur = 0;
    const int npairs = ntiles >> 1;
    for (int p = 0; p < npairs; ++p) {
        const int kb = p & 1;
        if (p + 1 < npairs) FA_LOAD(p + 1);
#pragma unroll
      for (int sub = 0; sub < 2; ++sub) { const int j = 2 * p + sub; const int koff = kb * KBUF + sub * 64 * KSTR; const int voff = vcur * VBUF + sub * 64 * VSTR;
        if (grpB && pvalid) { __builtin_amdgcn_s_setprio(1); FA_PV(pvb); __builtin_amdgcn_s_setprio(0); }
        bool skip = false; const int kp = kpos0 + 64 * (j - 4);
        if (WIN && j >= 4) skip = (kp + 63 < qpos_wave - 128) || (kp > qpos_wave + 31 + 128);
        pvalid = !skip; pvb = voff;
        if (!skip) {
            f32x4 sacc[4][2];
#pragma unroll
            for (int kt = 0; kt < 4; ++kt) { sacc[kt][0] = (f32x4){0.f, 0.f, 0.f, 0.f}; sacc[kt][1] = (f32x4){0.f, 0.f, 0.f, 0.f}; }
            __builtin_amdgcn_s_setprio(1);
#pragma unroll
            for (int ks = 0; ks < NKS; ++ks) { bf16x8 kf[4];
#pragma unroll
                for (int kt = 0; kt < 4; ++kt) kf[kt] = *(const LAS bf16x8*)(Kl + koff + (16 * kt + fr) * KSTR + (32 * ks + 8 * fq) * 2);
#pragma unroll
                for (int kt = 0; kt < 4; ++kt) { sacc[kt][0] = __builtin_amdgcn_mfma_f32_16x16x32_bf16(kf[kt], qf[0][ks], sacc[kt][0], 0, 0, 0);
                                                 sacc[kt][1] = __builtin_amdgcn_mfma_f32_16x16x32_bf16(kf[kt], qf[1][ks], sacc[kt][1], 0, 0, 0); } }
            __builtin_amdgcn_s_setprio(0);
            if (WIN && j >= 4) {
#pragma unroll
                for (int kt = 0; kt < 4; ++kt)
#pragma unroll
                    for (int qt = 0; qt < 2; ++qt)
#pragma unroll
                        for (int jj = 0; jj < 4; ++jj) { const int d = (kp + 16 * kt + 4 * fq + jj) - (qpos_wave + 16 * qt + fr); if (d < -128 || d > 128) sacc[kt][qt][jj] = -1.0e30f; } }
#pragma unroll
            for (int qt = 0; qt < 2; ++qt) {
                float mx = sacc[0][qt][0];
#pragma unroll
                for (int kt = 0; kt < 4; ++kt)
#pragma unroll
                    for (int jj = 0; jj < 4; ++jj) mx = fmaxf(mx, sacc[kt][qt][jj]);
                mx = fmaxf(mx, __shfl_xor(mx, 16)); mx = fmaxf(mx, xor32(mx));
                float mnew = mrun[qt];
                if (__builtin_amdgcn_ballot_w64(mx > mrun[qt] + 11.5f) != 0ull) {
                    mnew = fmaxf(mrun[qt], mx); const float alpha = fast_exp2(mrun[qt] - mnew); lsum[qt] *= alpha;
#pragma unroll
                    for (int c = 0; c < 4; ++c) oacc[c][qt] = oacc[c][qt] * alpha; }
                mrun[qt] = mnew;
                float ps = 0.f;
#pragma unroll
                for (int kt = 0; kt < 4; ++kt)
#pragma unroll
                    for (int jj = 0; jj < 4; ++jj) { const float p = fast_exp2(sacc[kt][qt][jj] - mnew); sacc[kt][qt][jj] = p; ps += p; }
                lsum[qt] += ps;
#pragma unroll
                for (int ks2 = 0; ks2 < 2; ++ks2) { const v4u w = pack8(sacc[2 * ks2][qt], sacc[2 * ks2 + 1][qt]); pf[qt][ks2] = __builtin_bit_cast(bf16x8, w); }
            }
            if (!grpB) { __builtin_amdgcn_s_setprio(1); FA_PV(voff); __builtin_amdgcn_s_setprio(0); }
        }
      }
        const int vnext = vcur == 2 ? 0 : vcur + 1;
        if (p + 1 < npairs) FA_STORE(kb ^ 1, vnext);
        vcur = vnext;
        __syncthreads();
    }
    if (grpB && pvalid) FA_PV(pvb);
    __syncthreads();
#pragma unroll
    for (int qt = 0; qt < 2; ++qt) { float l = lsum[qt]; l += __shfl_xor(l, 16); l += xor32(l); if (has_sink) l += fast_exp2(sink2 - mrun[qt]);
        const float inv = 1.0f / l;
#pragma unroll
        for (int c = 0; c < 4; ++c) { const f32x4 o = oacc[c][qt] * inv; v2u w; w.x = cvt_pk_bf16(o[0], o[1]); w.y = cvt_pk_bf16(o[2], o[3]);
            *(v2u*)(Og + (size_t)(16 * qt + fr) * ldo + 16 * c + 4 * fq) = w; } }
#undef FA_LOAD
#undef FA_STORE
#undef FA_PV
}

typedef float f32x16 __attribute__((ext_vector_type(16)));
template <int DQK>
__device__ __forceinline__ void flash_unit4(LAS unsigned char* lds, const int tid, const int lane,
        const bf16* Kg, const int ldk, const bf16* Vg, const int ldv, const bf16* Qg, const int ldq, bf16* Og, const int ldo, const int npairs, const int krow0) {
    constexpr int KSTR = DQK * 2 + 16, VSTR = 160, KBUF = 128 * KSTR, VBUF = 128 * VSTR, CPR = DQK / 8, NKC = 128 * CPR, NKR = (NKC + 511) / 512, NKS = DQK / 16;
    LAS unsigned char* Kl = lds; LAS unsigned char* Vl = lds + 2 * KBUF;
    const int r5 = lane & 31, h = lane >> 5;
    bf16x8 qf[NKS];
#pragma unroll
    for (int ks = 0; ks < NKS; ++ks) qf[ks] = *(const bf16x8*)(Qg + (size_t)r5 * ldq + 16 * ks + 8 * h);
    f32x16 oacc[2];
#pragma unroll
    for (int dt = 0; dt < 2; ++dt)
#pragma unroll
        for (int e = 0; e < 16; ++e) oacc[dt][e] = 0.f;
    float mrun = -1.0e30f, lsum = 0.f;
    v4u kreg[NKR], vreg[2];
    unsigned kgo[NKR], vgo[2];
#pragma unroll
    for (int i = 0; i < NKR; ++i) { const int c = tid + 512 * i; kgo[i] = (unsigned)(((c / CPR) * ldk + (c % CPR) * 8) * 2); }
#pragma unroll
    for (int i = 0; i < 2; ++i) { const int c = tid + 512 * i; vgo[i] = (unsigned)(((c >> 3) * ldv + (c & 7) * 8) * 2); }
#define F4_LOAD(p) do { const char* _kb = (const char*)Kg + (size_t)(krow0 + 128 * (p)) * ldk * 2; const char* _vb = (const char*)Vg + (size_t)(krow0 + 128 * (p)) * ldv * 2; \
        _Pragma("unroll") for (int _i = 0; _i < NKR; ++_i) { if (tid + 512 * _i < NKC) kreg[_i] = *(const v4u*)(_kb + kgo[_i]); } \
        _Pragma("unroll") for (int _i = 0; _i < 2; ++_i) vreg[_i] = *(const v4u*)(_vb + vgo[_i]); } while (0)
#define F4_STORE(b) do { _Pragma("unroll") for (int _i = 0; _i < NKR; ++_i) { const int _c = tid + 512 * _i; if (_c < NKC) *(LAS v4u*)(Kl + (b) * KBUF + (_c / CPR) * KSTR + (_c % CPR) * 16) = kreg[_i]; } \
        _Pragma("unroll") for (int _i = 0; _i < 2; ++_i) { const int _c = tid + 512 * _i; *(LAS v4u*)(Vl + (b) * VBUF + (_c >> 3) * VSTR + (_c & 7) * 16) = vreg[_i]; } } while (0)
    F4_LOAD(0); F4_STORE(0); __syncthreads();
    const int vlane = (4 * h + ((lane & 15) >> 2)) * VSTR + (16 * ((lane >> 4) & 1) + 4 * (lane & 3)) * 2;
    for (int p = 0; p < npairs; ++p) { const int bb = p & 1;
        if (p + 1 < npairs) F4_LOAD(p + 1);
#pragma unroll
        for (int sub = 0; sub < 2; ++sub) { const LAS unsigned char* Kt = Kl + bb * KBUF + sub * 64 * KSTR; const LAS unsigned char* Vt = Vl + bb * VBUF + sub * 64 * VSTR;
            bf16x8 kfr[NKS][2];
#pragma unroll
            for (int ks = 0; ks < NKS; ++ks)
#pragma unroll
                for (int kt = 0; kt < 2; ++kt) kfr[ks][kt] = *(const LAS bf16x8*)(Kt + (32 * kt + r5) * KSTR + (16 * ks + 8 * h) * 2);
            f32x16 sacc[2];
#pragma unroll
            for (int kt = 0; kt < 2; ++kt)
#pragma unroll
                for (int e = 0; e < 16; ++e) sacc[kt][e] = 0.f;
            __builtin_amdgcn_s_setprio(1);
#pragma unroll
            for (int ks = 0; ks < NKS; ++ks)
#pragma unroll
                for (int kt = 0; kt < 2; ++kt) sacc[kt] = __builtin_amdgcn_mfma_f32_32x32x16_bf16(kfr[ks][kt], qf[ks], sacc[kt], 0, 0, 0);
            __builtin_amdgcn_s_setprio(0);
            float mx = sacc[0][0];
#pragma unroll
            for (int kt = 0; kt < 2; ++kt)
#pragma unroll
                for (int e = 0; e < 16; ++e) mx = fmaxf(mx, sacc[kt][e]);
            mx = fmaxf(mx, xor32(mx));
            if (__builtin_amdgcn_ballot_w64(mx > mrun + 11.5f) != 0ull) { const float mnew = fmaxf(mrun, mx), alpha = fast_exp2(mrun - mnew); lsum *= alpha; mrun = mnew;
#pragma unroll
                for (int dt = 0; dt < 2; ++dt) oacc[dt] = oacc[dt] * alpha; }
            float ps = 0.f;
#pragma unroll
            for (int kt = 0; kt < 2; ++kt)
#pragma unroll
                for (int e = 0; e < 16; ++e) { const float pv = fast_exp2(sacc[kt][e] - mrun); sacc[kt][e] = pv; ps += pv; }
            lsum += ps;
            bf16x8 vfr[2][2][2];
#pragma unroll
            for (int kt = 0; kt < 2; ++kt)
#pragma unroll
                for (int s = 0; s < 2; ++s)
#pragma unroll
                    for (int dt = 0; dt < 2; ++dt) { const LAS unsigned char* vb = Vt + (32 * kt + 16 * s) * VSTR + vlane + 64 * dt;
                        const s16x4 v0 = __builtin_amdgcn_ds_read_tr16_b64_v4i16((LAS s16x4*)vb), v1 = __builtin_amdgcn_ds_read_tr16_b64_v4i16((LAS s16x4*)(vb + 8 * VSTR));
                        bf16x8 vf; vf[0] = v0[0]; vf[1] = v0[1]; vf[2] = v0[2]; vf[3] = v0[3]; vf[4] = v1[0]; vf[5] = v1[1]; vf[6] = v1[2]; vf[7] = v1[3]; vfr[kt][s][dt] = vf; }
            v4u pw[2][2];
#pragma unroll
            for (int kt = 0; kt < 2; ++kt)
#pragma unroll
                for (int s = 0; s < 2; ++s) { pw[kt][s].x = cvt_pk_bf16(sacc[kt][8 * s + 0], sacc[kt][8 * s + 1]); pw[kt][s].y = cvt_pk_bf16(sacc[kt][8 * s + 2], sacc[kt][8 * s + 3]);
                    pw[kt][s].z = cvt_pk_bf16(sacc[kt][8 * s + 4], sacc[kt][8 * s + 5]); pw[kt][s].w = cvt_pk_bf16(sacc[kt][8 * s + 6], sacc[kt][8 * s + 7]); }
            __builtin_amdgcn_s_setprio(1);
#pragma unroll
            for (int kt = 0; kt < 2; ++kt)
#pragma unroll
                for (int s = 0; s < 2; ++s)
#pragma unroll
                    for (int dt = 0; dt < 2; ++dt) oacc[dt] = __builtin_amdgcn_mfma_f32_32x32x16_bf16(vfr[kt][s][dt], __builtin_bit_cast(bf16x8, pw[kt][s]), oacc[dt], 0, 0, 0);
            __builtin_amdgcn_s_setprio(0);
        }
        if (p + 1 < npairs) F4_STORE(bb ^ 1);
        __syncthreads();
    }
    { float l = lsum; l += xor32(l); const float inv = 1.0f / l;
#pragma unroll
      for (int dt = 0; dt < 2; ++dt)
#pragma unroll
          for (int g4 = 0; g4 < 4; ++g4) { v2u w; w.x = cvt_pk_bf16(oacc[dt][4 * g4 + 0] * inv, oacc[dt][4 * g4 + 1] * inv); w.y = cvt_pk_bf16(oacc[dt][4 * g4 + 2] * inv, oacc[dt][4 * g4 + 3] * inv);
              *(v2u*)(Og + (size_t)r5 * ldo + 32 * dt + 8 * g4 + 4 * h) = w; } }
#undef F4_LOAD
#undef F4_STORE
}

__device__ __forceinline__ void phase_attn_window(Frame& F, const float* const* in, bf16* Q, const bf16* Kb, const bf16* Vb, bf16* Oalt = nullptr) {
    constexpr int NLAT = NB * 4 * 64, NCTX = NB * 4 * 4;
    for (int un = F.vcu; un < NLAT + NCTX; un += GRID) {
        int b, kvh, q0, ntiles, kpos0, qrow0;
        if (un < NLAT) { b = un >> 8; kvh = (un >> 6) & 3; q0 = (un & 63) * 64; kpos0 = q0 >= 128 ? q0 - 128 : 0; const int kend = q0 + 192 <= SEQ ? q0 + 192 : SEQ; ntiles = 4 + (kend - kpos0) / 64; qrow0 = b * TPB + CTX + q0; }
        else { const int v = un - NLAT; b = v >> 4; kvh = (v >> 2) & 3; q0 = (v & 3) * 64; kpos0 = 0; ntiles = 4; qrow0 = b * TPB + q0; }
        const int g = F.wave >> 1, half = F.wave & 1, head = kvh * 4 + g;
        bf16* qp = Q + (size_t)(qrow0 + 32 * half) * 1024 + head * 64;
        bf16* op = Oalt ? Oalt + (size_t)(qrow0 + 32 * half) * 1024 + head * 64 : qp;
        flash_unit<64, true>(F.lds, F.tid, F.lane, F.wave >> 2, Kb + kvh * 64, 256, Vb + kvh * 64, 256, qp, 1024, op, 1024,
                             ntiles, b * TPB, b * TPB + CTX + kpos0, kpos0, q0 + 32 * half, in[16][head] * LOG2E, true);
    }
}
__device__ __forceinline__ void phase_attn_mla(Frame& F, const bf16* Q3, const bf16* KF, const bf16* V3, bf16* O) {
    for (int un = F.vcu; un < NB * 16 * 16; un += GRID) { const int b = un >> 8, head = (un >> 4) & 15, qb = un & 15; const int qrow = b * TPB + CTX + qb * 256 + 32 * F.wave;
        flash_unit4<96>(F.lds, F.tid, F.lane, KF + head * 96, 1536, V3 + head * 64, 1024, Q3 + (size_t)qrow * 1536 + head * 96, 1536, O + (size_t)qrow * 1024 + head * 64, 1024, 34, b * TPB);
    }
}
#ifndef SSD_PF
#define SSD_PF 2
#endif
#ifndef ML_PF
#define ML_PF 2
#endif
__device__ __forceinline__ int scan_row(int dir, int tau) { return dir == 0 ? tau : (tau < CTX ? CTX - 1 - tau : (TPB + CTX - 1) - tau); }

__device__ __forceinline__ void phase_ssm_conv(Frame& F, const float* const* in, int gp, const bf16* XP, bf16* XS, bf16* BC, const float* DT, float* ACUM) {
    constexpr int RPW = M / GRID;
    if (F.tid < 384) {
    const int cg = F.tid % 192, rsub = F.tid / 192, c0 = cg * 8;
    const int oc = c0 < 1024 ? gp * 1024 + c0 : (c0 < 1280 ? 2048 + gp * 256 + (c0 - 1024) : 2560 + gp * 256 + (c0 - 1280));
    float w[5][8], bb[8];
#pragma unroll
    for (int k = 0; k < 5; ++k)
#pragma unroll
        for (int i = 0; i < 8; ++i) w[k][i] = in[19][k * 3072 + oc + i];
#pragma unroll
    for (int i = 0; i < 8; ++i) bb[i] = in[20][oc + i];
    const int rbeg = blockIdx.x * RPW + rsub * (RPW / 2), rend = rbeg + RPW / 2;
    for (int g0 = rbeg; g0 < rend; g0 += 8) {
        v4u xin[12];
#pragma unroll
        for (int j = 0; j < 12; ++j) { const int rr = g0 - 2 + j; xin[j] = (rr >= 0 && rr < M) ? *(const v4u*)(XP + (size_t)rr * 1536 + c0) : (v4u){0u, 0u, 0u, 0u}; }
#pragma unroll
        for (int i = 0; i < 8; ++i) { const int r = g0 + i; if (r < rend) { const int t = r % TPB; const int lo = t < CTX ? 0 : CTX, hi = t < CTX ? CTX : TPB;
            float a[8];
#pragma unroll
            for (int q = 0; q < 8; ++q) a[q] = bb[q];
#pragma unroll
            for (int k = 0; k < 5; ++k) { const int tt = t + k - 2; if (tt >= lo && tt < hi) { const v4u x = xin[i + k];
                    a[0] += w[k][0] * bflo(x.x); a[1] += w[k][1] * bfhi(x.x); a[2] += w[k][2] * bflo(x.y); a[3] += w[k][3] * bfhi(x.y);
                    a[4] += w[k][4] * bflo(x.z); a[5] += w[k][5] * bfhi(x.z); a[6] += w[k][6] * bflo(x.w); a[7] += w[k][7] * bfhi(x.w); } }
            v4u o; o.x = cvt_pk_bf16(silu_f(a[0]), silu_f(a[1])); o.y = cvt_pk_bf16(silu_f(a[2]), silu_f(a[3])); o.z = cvt_pk_bf16(silu_f(a[4]), silu_f(a[5])); o.w = cvt_pk_bf16(silu_f(a[6]), silu_f(a[7]));
            if (c0 < 1024) *(v4u*)(XS + (size_t)r * 1024 + c0) = o; else *(v4u*)(BC + (size_t)r * 512 + (c0 - 1024)) = o; } } }
    } else {
        const int chain = blockIdx.x * 128 + (F.tid - 384);
        if (chain < NB * 2 * 16 * 68) { const int ck = chain % 68, hl = (chain / 68) & 15, dir = (chain / (68 * 16)) & 1, b = chain / (68 * 32);
            const float Ah = -fast_exp(in[22][dir * 32 + gp * 16 + hl]) * LOG2E; float acc = 0.f;
#pragma unroll 1
            for (int h2 = 0; h2 < 2; ++h2) { float dv[32];
#pragma unroll
                for (int s = 0; s < 32; ++s) dv[s] = DT[(size_t)(b * TPB + scan_row(dir, ck * 64 + h2 * 32 + s)) * 32 + dir * 16 + hl];
#pragma unroll
                for (int s = 0; s < 32; ++s) { acc += dv[s] * Ah; ACUM[(size_t)(b * TPB + scan_row(dir, ck * 64 + h2 * 32 + s)) * 32 + dir * 16 + hl] = acc; } } }
    }
}

__device__ __forceinline__ void phase_ssm_scan(Frame& F, const float* const* in, int gp, const bf16* XS, const bf16* BC, const float* DT, const bf16* Z, bf16* Y) {
    constexpr int T = 32;
    LAS float* Bf = (LAS float*)F.lds;
    LAS float* Cf = (LAS float*)(F.lds + 16384);
    LAS float* U = (LAS float*)(F.lds + 32768);
    LAS float* XT = (LAS float*)(F.lds + 40960);
    LAS float* DEC = (LAS float*)(F.lds + 49152);
    LAS float* PART = (LAS float*)(F.lds + 49152 + 256);
    const int it = blockIdx.x, b = it >> 5, hl = (it >> 1) & 15, ph = it & 1, head = gp * 16 + hl, gl = hl >> 3;
    const int col = hl * 64 + ph * 32;
    const int p = F.tid & 31, ns = F.tid >> 5;
    const float dskip = in[23][head] + in[23][32 + head];
    const int st = F.tid >> 4, sch = F.tid & 15;
    const int xt = F.tid >> 2, xch = F.tid & 3;
    for (int dir = 0; dir < 2; ++dir) {
        const float Ah = -fast_exp(in[22][dir * 32 + head]) * LOG2E;
        float S[8];
#pragma unroll
        for (int i = 0; i < 8; ++i) S[i] = 0.f;
        v4u rb, rc, rx; float rdt = 0.f;
#define SS_LOAD(tile) do { const int _rB = b * TPB + scan_row(dir, (tile) * T + st); rb = *(const v4u*)(BC + (size_t)_rB * 512 + gl * 128 + sch * 8); rc = *(const v4u*)(BC + (size_t)_rB * 512 + 256 + gl * 128 + sch * 8); \
            if (F.tid < 128) { const int _rX = b * TPB + scan_row(dir, (tile) * T + xt); rx = *(const v4u*)(XS + (size_t)_rX * 1024 + col + xch * 8); rdt = DT[(size_t)_rX * 32 + dir * 16 + hl]; } } while (0)
#define SS_STORE(nb) do { LAS float* _b = Bf + st * 128 + sch * 8; LAS float* _c = Cf + st * 128 + sch * 8; \
            *(LAS f32x4*)_b = (f32x4){bflo(rb.x), bfhi(rb.x), bflo(rb.y), bfhi(rb.y)}; *(LAS f32x4*)(_b + 4) = (f32x4){bflo(rb.z), bfhi(rb.z), bflo(rb.w), bfhi(rb.w)}; \
            *(LAS f32x4*)_c = (f32x4){bflo(rc.x), bfhi(rc.x), bflo(rc.y), bfhi(rc.y)}; *(LAS f32x4*)(_c + 4) = (f32x4){bflo(rc.z), bfhi(rc.z), bflo(rc.w), bfhi(rc.w)}; \
            if (F.tid < 128) { const f32x4 x0 = (f32x4){bflo(rx.x), bfhi(rx.x), bflo(rx.y), bfhi(rx.y)}, x1 = (f32x4){bflo(rx.z), bfhi(rx.z), bflo(rx.w), bfhi(rx.w)}; \
                LAS float* _x = XT + (nb) * 1024 + xt * 32 + xch * 8; LAS float* _u = U + (nb) * 1024 + xt * 32 + xch * 8; \
                *(LAS f32x4*)_x = x0; *(LAS f32x4*)(_x + 4) = x1; *(LAS f32x4*)_u = x0 * rdt; *(LAS f32x4*)(_u + 4) = x1 * rdt; \
                if (xch == 0) DEC[(nb) * 32 + xt] = fast_exp2(rdt * Ah); } } while (0)
        __syncthreads();
        SS_LOAD(0); SS_STORE(0); __syncthreads();
        constexpr int NT = TPB / T;
        for (int tile = 0; tile < NT; ++tile) { const int cb = tile & 1;
            if (tile + 1 < NT) SS_LOAD(tile + 1);
            const LAS float* u_ = U + cb * 1024 + p; const LAS float* d_ = DEC + cb * 32;
#pragma unroll 4
            for (int t = 0; t < T; ++t) {
                const float dec = d_[t], u = u_[t * 32];
                const f32x4 b0 = *(const LAS f32x4*)(Bf + t * 128 + ns * 8), b1 = *(const LAS f32x4*)(Bf + t * 128 + ns * 8 + 4);
                const f32x4 c0 = *(const LAS f32x4*)(Cf + t * 128 + ns * 8), c1 = *(const LAS f32x4*)(Cf + t * 128 + ns * 8 + 4);
                float pt = 0.f;
#pragma unroll
                for (int i = 0; i < 4; ++i) { S[i] = S[i] * dec + b0[i] * u; pt += c0[i] * S[i]; S[4 + i] = S[4 + i] * dec + b1[i] * u; pt += c1[i] * S[4 + i]; }
                pt += __shfl_xor(pt, 32);
                if (F.lane < 32) PART[(F.wave * 32 + t) * 32 + p] = pt;
            }
            __syncthreads();
#pragma unroll
            for (int k = 0; k < 2; ++k) { const int t = (F.tid >> 5) + 16 * k; float y = 0.f;
#pragma unroll
                for (int w = 0; w < 8; ++w) y += PART[(w * 32 + t) * 32 + p];
                const size_t ro = (size_t)(b * TPB + scan_row(dir, tile * T + t));
                if (dir == 0) Y[ro * 1024 + col + p] = (bf16)f2bf(y);
                else { const float yt = y + bf2f(Y[ro * 1024 + col + p]) + dskip * XT[cb * 1024 + t * 32 + p]; const float zz = bf2f(Z[ro * 1024 + col + p]);
                    Y[ro * 1024 + col + p] = (bf16)f2bf(yt * silu_f(zz)); } }
            if (tile + 1 < NT) SS_STORE(cb ^ 1);
            __syncthreads();
        }
#undef SS_LOAD
#undef SS_STORE
    }
}
__device__ __forceinline__ void phase_ssm_gnorm(Frame& F, const float* const* in, int gp, bf16* Y) {
    const int gw = F.vcu * NWAVES + F.wave, NGW = GRID * NWAVES; const float* ng = in[24] + gp * 1024 + 16 * F.lane;
    for (int r = gw; r < M; r += NGW) { v4u* p = (v4u*)(Y + (size_t)r * 1024 + 16 * F.lane); const v4u a = p[0], c = p[1];
        float v[16] = {bflo(a.x), bfhi(a.x), bflo(a.y), bfhi(a.y), bflo(a.z), bfhi(a.z), bflo(a.w), bfhi(a.w), bflo(c.x), bfhi(c.x), bflo(c.y), bfhi(c.y), bflo(c.z), bfhi(c.z), bflo(c.w), bfhi(c.w)};
        float ss = 0.f;
#pragma unroll
        for (int i = 0; i < 16; ++i) ss += v[i] * v[i];
#pragma unroll
        for (int o = 1; o < 32; o <<= 1) ss += __shfl_xor(ss, o);
        const float rs = rsqrtf(ss * (1.f / 512.f) + EPS);
        v4u o0, o1;
        o0.x = cvt_pk_bf16(v[0] * rs * ng[0], v[1] * rs * ng[1]); o0.y = cvt_pk_bf16(v[2] * rs * ng[2], v[3] * rs * ng[3]); o0.z = cvt_pk_bf16(v[4] * rs * ng[4], v[5] * rs * ng[5]); o0.w = cvt_pk_bf16(v[6] * rs * ng[6], v[7] * rs * ng[7]);
        o1.x = cvt_pk_bf16(v[8] * rs * ng[8], v[9] * rs * ng[9]); o1.y = cvt_pk_bf16(v[10] * rs * ng[10], v[11] * rs * ng[11]); o1.z = cvt_pk_bf16(v[12] * rs * ng[12], v[13] * rs * ng[13]); o1.w = cvt_pk_bf16(v[14] * rs * ng[14], v[15] * rs * ng[15]);
        p[0] = o0; p[1] = o1; }
}


__device__ __forceinline__ void phase_ssm_scan_mfma(Frame& F, const float* const* in, int gp, const bf16* XS, const bf16* BC, const float* DT, const float* ACUM, bf16* Yf, bf16* Yb) {
    constexpr int BSTR = 272, XSTR = 160;
    LAS unsigned char* Bl = F.lds;
    LAS unsigned char* Cl = F.lds + 17408;
    LAS unsigned char* Xl = F.lds + 34816;
    LAS unsigned char* Xw = F.lds + 45056;
    LAS float* AC = (LAS float*)(F.lds + 55296);
    LAS float* DTs = (LAS float*)(F.lds + 55296 + 256);
    LAS unsigned char* Sb = F.lds + 55808;
    const int it = F.vcu, b = it >> 5, dir = (it >> 4) & 1, hl = it & 15, gl = hl >> 3;
    bf16* Y = dir == 0 ? Yf : Yb;
    const float dsk = in[23][dir * 32 + gp * 16 + hl];
    const int tid = F.tid, lane = F.lane, w = F.wave, fr = lane & 15, fq = lane >> 4, lq = (lane & 15) >> 2, lp = lane & 3;
    const int ph = w >> 2, lt = ph ? 3 - (w & 3) : (w & 3);
    for (int i = tid; i < 64 * BSTR / 16; i += NTHR) *(LAS v4u*)(Sb + i * 16) = (v4u){0u, 0u, 0u, 0u};
    f32x4 sacc[4];
#pragma unroll
    for (int i = 0; i < 4; ++i) sacc[i] = (f32x4){0.f, 0.f, 0.f, 0.f};
    constexpr int PF = SSD_PF;
    v4u rB[PF][2], rC[PF][2], rX[PF]; float rac[PF], ral[PF], rdt[PF];
    const int xr = tid >> 3, xc = tid & 7;
#define SM_LOAD(S, ckv) do { const int _ck = (ckv) < 68 ? (ckv) : 67; \
        _Pragma("unroll") for (int _i = 0; _i < 2; ++_i) { const int _c = tid + 512 * _i; const size_t _r = (size_t)(b * TPB + scan_row(dir, _ck * 64 + (_c >> 4))); \
            rB[S][_i] = *(const v4u*)(BC + _r * 512 + gl * 128 + (_c & 15) * 8); rC[S][_i] = *(const v4u*)(BC + _r * 512 + 256 + gl * 128 + (_c & 15) * 8); } \
        { const size_t _r = (size_t)(b * TPB + scan_row(dir, _ck * 64 + xr)); const size_t _rl = (size_t)(b * TPB + scan_row(dir, _ck * 64 + 63)); rX[S] = *(const v4u*)(XS + _r * 1024 + hl * 64 + xc * 8); \
          rac[S] = ACUM[_r * 32 + dir * 16 + hl]; ral[S] = ACUM[_rl * 32 + dir * 16 + hl]; rdt[S] = DT[_r * 32 + dir * 16 + hl]; } } while (0)
#define SM_STORE(S) do { _Pragma("unroll") for (int _i = 0; _i < 2; ++_i) { const int _c = tid + 512 * _i; *(LAS v4u*)(Bl + (_c >> 4) * BSTR + (_c & 15) * 16) = rB[S][_i]; *(LAS v4u*)(Cl + (_c >> 4) * BSTR + (_c & 15) * 16) = rC[S][_i]; } \
        *(LAS v4u*)(Xl + xr * XSTR + xc * 16) = rX[S]; \
        { const float rxs = rdt[S] * fast_exp2(ral[S] - rac[S]); const v4u _x = rX[S]; v4u _o; _o.x = cvt_pk_bf16(bflo(_x.x) * rxs, bfhi(_x.x) * rxs); _o.y = cvt_pk_bf16(bflo(_x.y) * rxs, bfhi(_x.y) * rxs); _o.z = cvt_pk_bf16(bflo(_x.z) * rxs, bfhi(_x.z) * rxs); _o.w = cvt_pk_bf16(bflo(_x.w) * rxs, bfhi(_x.w) * rxs); \
          *(LAS v4u*)(Xw + xr * XSTR + xc * 16) = _o; } \
        if (xc == 0) { AC[xr] = rac[S]; DTs[xr] = rdt[S]; } } while (0)
    SM_LOAD(0, 0); SM_STORE(0);
#pragma unroll
    for (int k = 1; k < PF; ++k) SM_LOAD(k, k);
    __syncthreads();
#pragma unroll 1
    for (int ck0 = 0; ck0 < 68; ck0 += PF) {
#pragma unroll
      for (int u = 0; u < PF; ++u) { const int ck = ck0 + u; const int cur = u & 1;
        SM_LOAD(u, ck + PF);
        const LAS unsigned char* Sc = Sb + cur * (64 * BSTR); LAS unsigned char* Sn = Sb + (cur ^ 1) * (64 * BSTR);
        bf16x8 cf[4], sf[2][4], bfr[4][4];
#pragma unroll
        for (int ks = 0; ks < 4; ++ks) cf[ks] = *(const LAS bf16x8*)(Cl + (16 * lt + fr) * BSTR + (32 * ks + 8 * fq) * 2);
#pragma unroll
        for (int pi = 0; pi < 2; ++pi)
#pragma unroll
            for (int ks = 0; ks < 4; ++ks) sf[pi][ks] = *(const LAS bf16x8*)(Sc + (16 * (2 * ph + pi) + fr) * BSTR + (32 * ks + 8 * fq) * 2);
#pragma unroll
        for (int st = 0; st < 4; ++st) { if (true) {
#pragma unroll
            for (int ks = 0; ks < 4; ++ks) bfr[st][ks] = *(const LAS bf16x8*)(Bl + (16 * st + fr) * BSTR + (32 * ks + 8 * fq) * 2); } }
        const float acl = AC[16 * lt + fr];
        f32x4 acs[4], dts[4];
#pragma unroll
        for (int st = 0; st < 4; ++st) { acs[st] = *(const LAS f32x4*)(AC + 16 * st + 4 * fq); dts[st] = *(const LAS f32x4*)(DTs + 16 * st + 4 * fq); }
        const float gdec = fast_exp2(AC[63]);
        bf16x8 xf[2][2];
#pragma unroll
        for (int ks2 = 0; ks2 < 2; ++ks2) { if (true) {
#pragma unroll
            for (int pi = 0; pi < 2; ++pi) { const LAS unsigned char* xb = Xl + (32 * ks2 + 4 * fq + lq) * XSTR + (16 * (2 * ph + pi) + 4 * lp) * 2;
                const s16x4 v0 = __builtin_amdgcn_ds_read_tr16_b64_v4i16((LAS s16x4*)xb), v1 = __builtin_amdgcn_ds_read_tr16_b64_v4i16((LAS s16x4*)(xb + 16 * XSTR));
                xf[ks2][pi][0] = v0[0]; xf[ks2][pi][1] = v0[1]; xf[ks2][pi][2] = v0[2]; xf[ks2][pi][3] = v0[3]; xf[ks2][pi][4] = v1[0]; xf[ks2][pi][5] = v1[1]; xf[ks2][pi][6] = v1[2]; xf[ks2][pi][7] = v1[3]; } } }
        f32x4 yacc[2];
#pragma unroll
        for (int pi = 0; pi < 2; ++pi) { f32x4 a = (f32x4){0.f, 0.f, 0.f, 0.f};
#pragma unroll
            for (int ks = 0; ks < 4; ++ks) a = __builtin_amdgcn_mfma_f32_16x16x32_bf16(sf[pi][ks], cf[ks], a, 0, 0, 0);
            yacc[pi] = a * fast_exp2(acl); }
        f32x4 pm[4];
#pragma unroll
        for (int st = 0; st < 4; ++st) { pm[st] = (f32x4){0.f, 0.f, 0.f, 0.f};
            if (st <= lt) { f32x4 g = (f32x4){0.f, 0.f, 0.f, 0.f};
#pragma unroll
                for (int ks = 0; ks < 4; ++ks) g = __builtin_amdgcn_mfma_f32_16x16x32_bf16(bfr[st][ks], cf[ks], g, 0, 0, 0);
#pragma unroll
                for (int j = 0; j < 4; ++j) { const bool ok = (16 * st + 4 * fq + j) <= (16 * lt + fr); pm[st][j] = ok ? g[j] * fast_exp2(acl - acs[st][j]) * dts[st][j] : 0.f; } } }
        bf16x8 xwf[2], btf[4][2];
#pragma unroll
        for (int ks2 = 0; ks2 < 2; ++ks2) { const LAS unsigned char* xb = Xw + (32 * ks2 + 8 * fq + lq) * XSTR + (16 * lt + 4 * lp) * 2;
            const s16x4 v0 = __builtin_amdgcn_ds_read_tr16_b64_v4i16((LAS s16x4*)xb), v1 = __builtin_amdgcn_ds_read_tr16_b64_v4i16((LAS s16x4*)(xb + 4 * XSTR));
            xwf[ks2][0] = v0[0]; xwf[ks2][1] = v0[1]; xwf[ks2][2] = v0[2]; xwf[ks2][3] = v0[3]; xwf[ks2][4] = v1[0]; xwf[ks2][5] = v1[1]; xwf[ks2][6] = v1[2]; xwf[ks2][7] = v1[3]; }
#pragma unroll
        for (int i = 0; i < 4; ++i)
#pragma unroll
            for (int ks2 = 0; ks2 < 2; ++ks2) { const LAS unsigned char* bb = Bl + (32 * ks2 + 8 * fq + lq) * BSTR + (16 * (4 * ph + i) + 4 * lp) * 2;
                const s16x4 v0 = __builtin_amdgcn_ds_read_tr16_b64_v4i16((LAS s16x4*)bb), v1 = __builtin_amdgcn_ds_read_tr16_b64_v4i16((LAS s16x4*)(bb + 4 * BSTR));
                btf[i][ks2][0] = v0[0]; btf[i][ks2][1] = v0[1]; btf[i][ks2][2] = v0[2]; btf[i][ks2][3] = v0[3]; btf[i][ks2][4] = v1[0]; btf[i][ks2][5] = v1[1]; btf[i][ks2][6] = v1[2]; btf[i][ks2][7] = v1[3]; }
#pragma unroll
        for (int ks2 = 0; ks2 < 2; ++ks2) { if (2 * ks2 <= lt) { const v4u pw = pack8(pm[2 * ks2], pm[2 * ks2 + 1]); const bf16x8 pf = __builtin_bit_cast(bf16x8, pw);
#pragma unroll
                for (int pi = 0; pi < 2; ++pi) yacc[pi] = __builtin_amdgcn_mfma_f32_16x16x32_bf16(xf[ks2][pi], pf, yacc[pi], 0, 0, 0); } }
        { const size_t ro = (size_t)(b * TPB + scan_row(dir, ck * 64 + 16 * lt + fr));
#pragma unroll
          for (int pi = 0; pi < 2; ++pi) { const v2u xr_ = *(const LAS v2u*)(Xl + (16 * lt + fr) * XSTR + (16 * (2 * ph + pi) + 4 * fq) * 2);
              yacc[pi][0] += dsk * bflo(xr_.x); yacc[pi][1] += dsk * bfhi(xr_.x); yacc[pi][2] += dsk * bflo(xr_.y); yacc[pi][3] += dsk * bfhi(xr_.y);
              v2u o; o.x = cvt_pk_bf16(yacc[pi][0], yacc[pi][1]); o.y = cvt_pk_bf16(yacc[pi][2], yacc[pi][3]);
              *(v2u*)(Y + ro * 1024 + hl * 64 + 16 * (2 * ph + pi) + 4 * fq) = o; } }
#pragma unroll
        for (int i = 0; i < 4; ++i) { const int nt = 4 * ph + i; f32x4 a = sacc[i] * gdec;
#pragma unroll
            for (int ks2 = 0; ks2 < 2; ++ks2) a = __builtin_amdgcn_mfma_f32_16x16x32_bf16(xwf[ks2], btf[i][ks2], a, 0, 0, 0);
            sacc[i] = a;
#pragma unroll
            for (int j = 0; j < 4; ++j) *(LAS bf16*)(Sn + (16 * lt + 4 * fq + j) * BSTR + (16 * nt + fr) * 2) = (bf16)f2bf(a[j]); }
        __syncthreads();
        if (ck + 1 < 68) SM_STORE((u + 1) % PF);
        __syncthreads();
      } }
#undef SM_LOAD
#undef SM_STORE
}
struct GnRow { float v[16]; float ss; };
__device__ __forceinline__ void gn2_load(GnRow& R, const bf16* Yf, const bf16* Yb, const bf16* Z, size_t off) {
    const v4u a0 = *(const v4u*)(Yf + off), a1 = *(const v4u*)(Yf + off + 8), b0 = *(const v4u*)(Yb + off), b1 = *(const v4u*)(Yb + off + 8);
    const v4u z0 = *(const v4u*)(Z + off), z1 = *(const v4u*)(Z + off + 8);
    const unsigned aw[8] = {a0.x, a0.y, a0.z, a0.w, a1.x, a1.y, a1.z, a1.w}, bw[8] = {b0.x, b0.y, b0.z, b0.w, b1.x, b1.y, b1.z, b1.w};
    const unsigned zw[8] = {z0.x, z0.y, z0.z, z0.w, z1.x, z1.y, z1.z, z1.w};
    float ss = 0.f;
#pragma unroll
    for (int i = 0; i < 8; ++i) { R.v[2 * i] = (bflo(aw[i]) + bflo(bw[i])) * silu_f(bflo(zw[i])); R.v[2 * i + 1] = (bfhi(aw[i]) + bfhi(bw[i])) * silu_f(bfhi(zw[i]));
        ss += R.v[2 * i] * R.v[2 * i] + R.v[2 * i + 1] * R.v[2 * i + 1]; }
    R.ss = ss;
}
__device__ __forceinline__ void gn_store(const GnRow& R, float rs, const float (&ng)[16], bf16* dst) {
    unsigned res[8];
#pragma unroll
    for (int i = 0; i < 8; ++i) res[i] = cvt_pk_bf16(R.v[2 * i] * rs * ng[2 * i], R.v[2 * i + 1] * rs * ng[2 * i + 1]);
    *(v4u*)(dst) = (v4u){res[0], res[1], res[2], res[3]}; *(v4u*)(dst + 8) = (v4u){res[4], res[5], res[6], res[7]};
}
__device__ __forceinline__ void phase_ssm_gnorm2(Frame& F, const float* const* in, int gp, bf16* Yf, const bf16* Yb, const bf16* XS, const bf16* Z, bf16* dst = nullptr) {
    if (!dst) dst = Yf;
    const int gw = F.vcu * NWAVES + F.wave, NGW = GRID * NWAVES; float ng[16];
#pragma unroll
    for (int i = 0; i < 16; ++i) ng[i] = in[24][gp * 1024 + 16 * F.lane + i];
    for (int r0 = gw; r0 < M; r0 += 4 * NGW) { GnRow R[4]; size_t of[4]; bool ok[4];
#pragma unroll
        for (int q = 0; q < 4; ++q) { const int r = r0 + q * NGW; ok[q] = r < M; of[q] = (size_t)(ok[q] ? r : r0) * 1024 + 16 * F.lane; gn2_load(R[q], Yf, Yb, Z, of[q]); }
#pragma unroll
        for (int o = 1; o < 32; o <<= 1) {
#pragma unroll
            for (int q = 0; q < 4; ++q) R[q].ss += __shfl_xor(R[q].ss, o); }
#pragma unroll
        for (int q = 0; q < 4; ++q) if (ok[q]) gn_store(R[q], rsqrtf(R[q].ss * (1.f / 512.f) + EPS), ng, dst + of[q]); }
}

__device__ __forceinline__ void phase_mlstm_scan(Frame& F, const bf16* Qm, const bf16* Km, const bf16* Vm, const float* G, bf16* Hf, bf16* Hb) {
    constexpr int T = 32;
    LAS float* Qf = (LAS float*)F.lds;
    LAS float* KW = (LAS float*)(F.lds + 8192);
    LAS float* Vf = (LAS float*)(F.lds + 16384);
    LAS float* FD = (LAS float*)(F.lds + 24576);
    LAS float* IW = (LAS float*)(F.lds + 24576 + 256);
    LAS float* EM = (LAS float*)(F.lds + 24576 + 512);
    LAS float* PN = (LAS float*)(F.lds + 32768);
    LAS float* PD = (LAS float*)(F.lds + 32768 + 65536);
    const int it = blockIdx.x, b = it >> 5, dir = (it >> 4) & 1, head = (it >> 1) & 7, jh = it & 1;
    bf16* Hout = dir == 0 ? Hf : Hb;
    const int w = F.wave, lane = F.lane, d7 = 8 * w + (lane & 7);
    float C[8], nst = 0.f, m_in = 0.f;
#pragma unroll
    for (int i = 0; i < 8; ++i) C[i] = 0.f;
    const int st = (F.tid & 255) >> 3, sch = F.tid & 7;
    v4u r0, r1; float gi = 0.f, gf = 0.f;
#define ML_LOAD(tile) do { const size_t _r = (size_t)(b * TPB + scan_row(dir, (tile) * T + st)); \
        if (F.tid < 256) { r0 = *(const v4u*)(Qm + _r * 512 + head * 64 + sch * 8); r1 = *(const v4u*)(Vm + _r * 1024 + head * 128 + jh * 64 + sch * 8); } \
        else { r0 = *(const v4u*)(Km + _r * 512 + head * 64 + sch * 8); } \
        if (F.tid < 32) { const size_t _g = (size_t)(b * TPB + scan_row(dir, (tile) * T + F.tid)); gi = G[_g * 32 + (2 * dir) * 8 + head]; gf = G[_g * 32 + (2 * dir + 1) * 8 + head]; } } while (0)
#define UNPK(dst, r) do { *(LAS f32x4*)(dst) = (f32x4){bflo(r.x), bfhi(r.x), bflo(r.y), bfhi(r.y)}; *(LAS f32x4*)((dst) + 4) = (f32x4){bflo(r.z), bfhi(r.z), bflo(r.w), bfhi(r.w)}; } while (0)
#define ML_GATES(nb) do { if (w == 0) { float Fc = lane < 32 ? gf : 0.f; \
            _Pragma("unroll") for (int o = 1; o < 32; o <<= 1) { const float t_ = __shfl_up(Fc, o); if (lane >= o) Fc += t_; } \
            float Gm = lane < 32 ? gi - Fc : -3.0e38f; \
            _Pragma("unroll") for (int o = 1; o < 32; o <<= 1) { const float t_ = __shfl_up(Gm, o); if (lane >= o) Gm = fmaxf(Gm, t_); } \
            const float mt = Fc + fmaxf(m_in, Gm); float mp = __shfl_up(mt, 1); if (lane == 0) mp = m_in; \
            if (lane < 32) { FD[(nb) * 32 + lane] = fast_exp2((gf + mp - mt) * LOG2E); IW[(nb) * 32 + lane] = fast_exp2((gi - mt) * LOG2E); EM[(nb) * 32 + lane] = fast_exp2(-mt * LOG2E); } \
            m_in = __shfl(mt, 31); } } while (0)
    __syncthreads();
    ML_LOAD(0); ML_GATES(0);
    if (F.tid < 256) { UNPK(Qf + st * 64 + sch * 8, r0); UNPK(Vf + st * 64 + sch * 8, r1); }
    __syncthreads();
    if (F.tid >= 256) { const float iw = IW[st]; LAS float* dk = KW + st * 64 + sch * 8;
        *(LAS f32x4*)dk = (f32x4){bflo(r0.x), bfhi(r0.x), bflo(r0.y), bfhi(r0.y)} * iw; *(LAS f32x4*)(dk + 4) = (f32x4){bflo(r0.z), bfhi(r0.z), bflo(r0.w), bfhi(r0.w)} * iw; }
    __syncthreads();
    constexpr int NT = TPB / T;
    for (int tile = 0; tile < NT; ++tile) { const int cb = tile & 1;
        if (tile + 1 < NT) ML_LOAD(tile + 1);
#pragma unroll 4
        for (int t = 0; t < T; ++t) {
            const float fd = FD[cb * 32 + t], v = Vf[t * 64 + lane];
            const f32x4 q0 = *(const LAS f32x4*)(Qf + t * 64 + 8 * w), q1 = *(const LAS f32x4*)(Qf + t * 64 + 8 * w + 4);
            const f32x4 k0 = *(const LAS f32x4*)(KW + t * 64 + 8 * w), k1 = *(const LAS f32x4*)(KW + t * 64 + 8 * w + 4);
            float pn = 0.f;
#pragma unroll
            for (int i = 0; i < 4; ++i) { C[i] = C[i] * fd + k0[i] * v; pn += q0[i] * C[i]; C[4 + i] = C[4 + i] * fd + k1[i] * v; pn += q1[i] * C[4 + i]; }
            PN[(w * 32 + t) * 64 + lane] = pn;
            nst = nst * fd + KW[t * 64 + d7];
            float pd = Qf[t * 64 + d7] * nst;
            pd += __shfl_xor(pd, 1); pd += __shfl_xor(pd, 2); pd += __shfl_xor(pd, 4);
            if (lane == 0) PD[w * 32 + t] = pd;
        }
        __syncthreads();
#pragma unroll
        for (int k = 0; k < 4; ++k) { const int t = (F.tid >> 6) + 8 * k; float num = 0.f, den = 0.f;
#pragma unroll
            for (int ww = 0; ww < 8; ++ww) { num += PN[(ww * 32 + t) * 64 + lane]; den += PD[ww * 32 + t]; }
            const float h = num / fmaxf(fabsf(den), EM[cb * 32 + t]);
            Hout[(size_t)(b * TPB + scan_row(dir, tile * T + t)) * 1024 + head * 128 + jh * 64 + lane] = (bf16)f2bf(h); }
        if (tile + 1 < NT) { ML_GATES(cb ^ 1); if (F.tid < 256) { UNPK(Qf + st * 64 + sch * 8, r0); UNPK(Vf + st * 64 + sch * 8, r1); } }
        __syncthreads();
        if (tile + 1 < NT && F.tid >= 256) { const float iw = IW[(cb ^ 1) * 32 + st]; LAS float* dk = KW + st * 64 + sch * 8;
            *(LAS f32x4*)dk = (f32x4){bflo(r0.x), bfhi(r0.x), bflo(r0.y), bfhi(r0.y)} * iw; *(LAS f32x4*)(dk + 4) = (f32x4){bflo(r0.z), bfhi(r0.z), bflo(r0.w), bfhi(r0.w)} * iw; }
        __syncthreads();
    }
#undef ML_LOAD
#undef ML_GATES
#undef UNPK
}

__device__ __forceinline__ void phase_mlstm_scan_mfma(Frame& F, const bf16* Qm, const bf16* Km, const bf16* Vm, const float* G, bf16* Hf, bf16* Hb) {
    constexpr int QSTR = 144, WSTR = 160, VSTR = 176, CSTR = 144;
    LAS unsigned char* Ql = F.lds;
    LAS unsigned char* Kl = F.lds + 9216;
    LAS unsigned char* Kw = F.lds + 18432;
    LAS unsigned char* Vl = F.lds + 28672;
    LAS unsigned char* Cb = F.lds + 39936;
    LAS float* GB = (LAS float*)(F.lds + 62976);
    const int it = F.vcu, b = it >> 5, dir = (it >> 4) & 1, head = (it >> 1) & 7, jh = it & 1;
    bf16* Hout = dir == 0 ? Hf : Hb;
    const int tid = F.tid, lane = F.lane, w = F.wave, fr = lane & 15, fq = lane >> 4, lq = (lane & 15) >> 2, lp = lane & 3;
    const int jg = w >> 2, lt = jg ? 3 - (w & 3) : (w & 3);
    for (int i = tid; i < 80 * CSTR / 16; i += NTHR) *(LAS v4u*)(Cb + i * 16) = (v4u){0u, 0u, 0u, 0u};
    for (int i = tid; i < 64 * 2; i += NTHR) { const int s = i >> 1, hh = i & 1; *(LAS v4u*)(Vl + s * VSTR + 128 + hh * 16) = hh == 0 ? (v4u){0x3F80u, 0u, 0u, 0u} : (v4u){0u, 0u, 0u, 0u}; }
    f32x4 sacc[3];
#pragma unroll
    for (int i = 0; i < 3; ++i) sacc[i] = (f32x4){0.f, 0.f, 0.f, 0.f};
    constexpr int PF = ML_PF;
    v4u rQ[PF], rK[PF], rV[PF]; float gi[PF], gf[PF]; float m_in = 0.f;
    const int sr = tid >> 3, sc = tid & 7;
#define MM_LOAD(S, ckv) do { const int _ck = (ckv) < 68 ? (ckv) : 67; const size_t _r = (size_t)(b * TPB + scan_row(dir, _ck * 64 + sr)); \
        rQ[S] = *(const v4u*)(Qm + _r * 512 + head * 64 + sc * 8); rK[S] = *(const v4u*)(Km + _r * 512 + head * 64 + sc * 8); rV[S] = *(const v4u*)(Vm + _r * 1024 + head * 128 + jh * 64 + sc * 8); \
        { const size_t _g = (size_t)(b * TPB + scan_row(dir, _ck * 64 + lane)); gi[S] = G[_g * 32 + (2 * dir) * 8 + head]; gf[S] = G[_g * 32 + (2 * dir + 1) * 8 + head]; } } while (0)
#define MM_GSCAN(S, GP) do { if (w == 0) { LAS float* _g = (GP); const float gil = gi[S] * LOG2E; const float Fc = wave_scan_sum(gf[S] * LOG2E); \
            const float Gm = wave_scan_max(gil - Fc); \
            const float mt = Fc + fmaxf(m_in, Gm); _g[lane] = Fc; _g[64 + lane] = gil; _g[128 + lane] = mt; \
            if (lane == 63) { _g[192] = Fc; _g[193] = m_in; _g[194] = mt; } \
            m_in = __shfl(mt, 63); } } while (0)
#define MM_STAGE(S, GP) do { const LAS float* _g = (GP); \
        *(LAS v4u*)(Ql + sr * QSTR + sc * 16) = rQ[S]; *(LAS v4u*)(Kl + sr * QSTR + sc * 16) = rK[S]; *(LAS v4u*)(Vl + sr * VSTR + sc * 16) = rV[S]; \
        const float ws_ = fast_exp2(_g[192] - _g[sr] + _g[64 + sr] - _g[194]); const v4u _k = rK[S]; v4u _o; \
        _o.x = cvt_pk_bf16(bflo(_k.x) * ws_, bfhi(_k.x) * ws_); _o.y = cvt_pk_bf16(bflo(_k.y) * ws_, bfhi(_k.y) * ws_); _o.z = cvt_pk_bf16(bflo(_k.z) * ws_, bfhi(_k.z) * ws_); _o.w = cvt_pk_bf16(bflo(_k.w) * ws_, bfhi(_k.w) * ws_); \
        *(LAS v4u*)(Kw + sr * WSTR + sc * 16) = _o; } while (0)
    __syncthreads();
    MM_LOAD(0, 0); MM_GSCAN(0, GB); __syncthreads(); MM_STAGE(0, GB);
#pragma unroll
    for (int k = 1; k < PF; ++k) MM_LOAD(k, k);
    __syncthreads();
#pragma unroll 1
    for (int ck0 = 0; ck0 < 68; ck0 += PF) {
#pragma unroll
      for (int u = 0; u < PF; ++u) { const int ck = ck0 + u; const int cur = u & 1;
        const LAS float* BCU = GB + cur * 256; const LAS float* IGA = BCU + 64; const LAS float* MTA = BCU + 128; const LAS float* SCA = BCU + 192;
        if (ck + 1 < 68) MM_GSCAN((u + 1) % PF, GB + (cur ^ 1) * 256);
        MM_LOAD(u, ck + PF);
        const LAS unsigned char* Cc = Cb + cur * (80 * CSTR); LAS unsigned char* Cn = Cb + (cur ^ 1) * (80 * CSTR);
        bf16x8 qf[2], cfr[3][2], kfr[4][2];
#pragma unroll
        for (int ks = 0; ks < 2; ++ks) qf[ks] = *(const LAS bf16x8*)(Ql + (16 * lt + fr) * QSTR + (32 * ks + 8 * fq) * 2);
#pragma unroll
        for (int ji = 0; ji < 3; ++ji) { const int row = ji < 2 ? 16 * (2 * jg + ji) + fr : 64 + fr;
#pragma unroll
            for (int ks = 0; ks < 2; ++ks) cfr[ji][ks] = *(const LAS bf16x8*)(Cc + row * CSTR + (32 * ks + 8 * fq) * 2); }
#pragma unroll
        for (int st = 0; st < 4; ++st) { if (st <= lt) {
#pragma unroll
            for (int ks = 0; ks < 2; ++ks) kfr[st][ks] = *(const LAS bf16x8*)(Kl + (16 * st + fr) * QSTR + (32 * ks + 8 * fq) * 2); } }
        const float bl = BCU[16 * lt + fr], ml = MTA[16 * lt + fr], m0 = SCA[1];
        f32x4 bsv[4], isv[4];
#pragma unroll
        for (int st = 0; st < 4; ++st) { bsv[st] = *(const LAS f32x4*)(BCU + 16 * st + 4 * fq); isv[st] = *(const LAS f32x4*)(IGA + 16 * st + 4 * fq); }
        const float gdec = fast_exp2(SCA[0] + m0 - SCA[2]);
        bf16x8 vfr[2][2];
#pragma unroll
        for (int ks2 = 0; ks2 < 2; ++ks2) { if (2 * ks2 <= lt) {
#pragma unroll
            for (int ji = 0; ji < 2; ++ji) { const LAS unsigned char* vb = Vl + (32 * ks2 + 4 * fq + lq) * VSTR + (16 * (2 * jg + ji) + 4 * lp) * 2;
                const s16x4 v0 = __builtin_amdgcn_ds_read_tr16_b64_v4i16((LAS s16x4*)vb), v1 = __builtin_amdgcn_ds_read_tr16_b64_v4i16((LAS s16x4*)(vb + 16 * VSTR));
                vfr[ks2][ji][0] = v0[0]; vfr[ks2][ji][1] = v0[1]; vfr[ks2][ji][2] = v0[2]; vfr[ks2][ji][3] = v0[3]; vfr[ks2][ji][4] = v1[0]; vfr[ks2][ji][5] = v1[1]; vfr[ks2][ji][6] = v1[2]; vfr[ks2][ji][7] = v1[3]; } } }
        const float dl = fast_exp2(bl + m0 - ml);
        f32x4 nacc[2]; float den;
#pragma unroll
        for (int ji = 0; ji < 2; ++ji) { f32x4 a = (f32x4){0.f, 0.f, 0.f, 0.f};
#pragma unroll
            for (int ks = 0; ks < 2; ++ks) a = __builtin_amdgcn_mfma_f32_16x16x32_bf16(cfr[ji][ks], qf[ks], a, 0, 0, 0);
            nacc[ji] = a * dl; }
        { f32x4 a = (f32x4){0.f, 0.f, 0.f, 0.f};
#pragma unroll
          for (int ks = 0; ks < 2; ++ks) a = __builtin_amdgcn_mfma_f32_16x16x32_bf16(cfr[2][ks], qf[ks], a, 0, 0, 0);
          den = __shfl(a[0], fr) * dl; }
        f32x4 pm[4]; float dsum = 0.f;
#pragma unroll
        for (int st = 0; st < 4; ++st) { pm[st] = (f32x4){0.f, 0.f, 0.f, 0.f};
            if (st <= lt) { f32x4 g = (f32x4){0.f, 0.f, 0.f, 0.f};
#pragma unroll
                for (int ks = 0; ks < 2; ++ks) g = __builtin_amdgcn_mfma_f32_16x16x32_bf16(kfr[st][ks], qf[ks], g, 0, 0, 0);
#pragma unroll
                for (int j = 0; j < 4; ++j) { const bool ok = (16 * st + 4 * fq + j) <= (16 * lt + fr); const float v = ok ? g[j] * fast_exp2(bl - bsv[st][j] + isv[st][j] - ml) : 0.f; pm[st][j] = v; dsum += v; } } }
        bf16x8 kwf[2], vtf[3][2];
#pragma unroll
        for (int ks2 = 0; ks2 < 2; ++ks2) { const LAS unsigned char* kb = Kw + (32 * ks2 + 8 * fq + lq) * WSTR + (16 * lt + 4 * lp) * 2;
            const s16x4 v0 = __builtin_amdgcn_ds_read_tr16_b64_v4i16((LAS s16x4*)kb), v1 = __builtin_amdgcn_ds_read_tr16_b64_v4i16((LAS s16x4*)(kb + 4 * WSTR));
            kwf[ks2][0] = v0[0]; kwf[ks2][1] = v0[1]; kwf[ks2][2] = v0[2]; kwf[ks2][3] = v0[3]; kwf[ks2][4] = v1[0]; kwf[ks2][5] = v1[1]; kwf[ks2][6] = v1[2]; kwf[ks2][7] = v1[3]; }
#pragma unroll
        for (int i = 0; i < 3; ++i) { if (jg == 0 || i < 2) { const int jt = jg == 0 ? i : 3 + i;
#pragma unroll
            for (int ks2 = 0; ks2 < 2; ++ks2) { const LAS unsigned char* vb = Vl + (32 * ks2 + 8 * fq + lq) * VSTR + (16 * jt + 4 * lp) * 2;
                const s16x4 v0 = __builtin_amdgcn_ds_read_tr16_b64_v4i16((LAS s16x4*)vb), v1 = __builtin_amdgcn_ds_read_tr16_b64_v4i16((LAS s16x4*)(vb + 4 * VSTR));
                vtf[i][ks2][0] = v0[0]; vtf[i][ks2][1] = v0[1]; vtf[i][ks2][2] = v0[2]; vtf[i][ks2][3] = v0[3]; vtf[i][ks2][4] = v1[0]; vtf[i][ks2][5] = v1[1]; vtf[i][ks2][6] = v1[2]; vtf[i][ks2][7] = v1[3]; } } }
        dsum += __shfl_xor(dsum, 16); dsum += xor32(dsum);
        den += dsum;
#pragma unroll
        for (int ks2 = 0; ks2 < 2; ++ks2) { if (2 * ks2 <= lt) { const v4u pw = pack8(pm[2 * ks2], pm[2 * ks2 + 1]); const bf16x8 pf = __builtin_bit_cast(bf16x8, pw);
#pragma unroll
                for (int ji = 0; ji < 2; ++ji) nacc[ji] = __builtin_amdgcn_mfma_f32_16x16x32_bf16(vfr[ks2][ji], pf, nacc[ji], 0, 0, 0); } }
        { const float inv = 1.0f / fmaxf(fabsf(den), fast_exp2(-ml)); const size_t ro = (size_t)(b * TPB + scan_row(dir, ck * 64 + 16 * lt + fr));
#pragma unroll
          for (int ji = 0; ji < 2; ++ji) { v2u o; o.x = cvt_pk_bf16(nacc[ji][0] * inv, nacc[ji][1] * inv); o.y = cvt_pk_bf16(nacc[ji][2] * inv, nacc[ji][3] * inv);
              *(v2u*)(Hout + ro * 1024 + head * 128 + jh * 64 + 16 * (2 * jg + ji) + 4 * fq) = o; } }
#pragma unroll
        for (int i = 0; i < 3; ++i) { if (jg == 0 || i < 2) { const int jt = jg == 0 ? i : 3 + i; f32x4 a = sacc[i] * gdec;
#pragma unroll
            for (int ks2 = 0; ks2 < 2; ++ks2) a = __builtin_amdgcn_mfma_f32_16x16x32_bf16(vtf[i][ks2], kwf[ks2], a, 0, 0, 0);
            sacc[i] = a;
#pragma unroll
            for (int j = 0; j < 4; ++j) *(LAS bf16*)(Cn + (16 * jt + 4 * fq + j) * CSTR + (16 * lt + fr) * 2) = (bf16)f2bf(a[j]); } }
        __syncthreads();
        if (ck + 1 < 68) MM_STAGE((u + 1) % PF, GB + (cur ^ 1) * 256);
        __syncthreads();
      } }
#undef MM_LOAD
#undef MM_GSCAN
#undef MM_STAGE
}

__device__ __forceinline__ void mg_load(GnRow& R, unsigned (&ow)[8], const bf16* Hf, const bf16* Hb, const bf16* Om, size_t off) {
    const v4u a0 = *(const v4u*)(Hf + off), a1 = *(const v4u*)(Hf + off + 8), b0 = *(const v4u*)(Hb + off), b1 = *(const v4u*)(Hb + off + 8), o0 = *(const v4u*)(Om + off), o1 = *(const v4u*)(Om + off + 8);
    const unsigned aw[8] = {a0.x, a0.y, a0.z, a0.w, a1.x, a1.y, a1.z, a1.w}, bw[8] = {b0.x, b0.y, b0.z, b0.w, b1.x, b1.y, b1.z, b1.w};
    ow[0] = o0.x; ow[1] = o0.y; ow[2] = o0.z; ow[3] = o0.w; ow[4] = o1.x; ow[5] = o1.y; ow[6] = o1.z; ow[7] = o1.w;
    float ss = 0.f;
#pragma unroll
    for (int i = 0; i < 8; ++i) { R.v[2 * i] = bflo(aw[i]) + bflo(bw[i]); R.v[2 * i + 1] = bfhi(aw[i]) + bfhi(bw[i]); ss += R.v[2 * i] * R.v[2 * i] + R.v[2 * i + 1] * R.v[2 * i + 1]; }
    R.ss = ss;
}
__device__ __forceinline__ void mg_store(const GnRow& R, const unsigned (&ow)[8], float rs, const float (&ng)[16], bf16* dst) {
    unsigned res[8];
#pragma unroll
    for (int i = 0; i < 8; ++i) res[i] = cvt_pk_bf16(R.v[2 * i] * rs * ng[2 * i] * sigmoid_f(bflo(ow[i])), R.v[2 * i + 1] * rs * ng[2 * i + 1] * sigmoid_f(bfhi(ow[i])));
    *(v4u*)(dst) = (v4u){res[0], res[1], res[2], res[3]}; *(v4u*)(dst + 8) = (v4u){res[4], res[5], res[6], res[7]};
}
__device__ __forceinline__ void phase_mlstm_gnorm(Frame& F, const float* const* in, const bf16* Hf, const bf16* Hb, const bf16* Om, bf16* Hn) {
    const int gw = F.vcu * NWAVES + F.wave, NGW = GRID * NWAVES; float ng[16];
#pragma unroll
    for (int i = 0; i < 16; ++i) ng[i] = in[28][16 * F.lane + i];
    for (int r0 = gw; r0 < M; r0 += 4 * NGW) { GnRow R[4]; unsigned ww[4][8]; size_t of[4]; bool ok[4];
#pragma unroll
        for (int q = 0; q < 4; ++q) { const int r = r0 + q * NGW; ok[q] = r < M; of[q] = (size_t)(ok[q] ? r : r0) * 1024 + 16 * F.lane; mg_load(R[q], ww[q], Hf, Hb, Om, of[q]); }
#pragma unroll
        for (int o = 1; o < 8; o <<= 1) {
#pragma unroll
            for (int q = 0; q < 4; ++q) R[q].ss += __shfl_xor(R[q].ss, o); }
#pragma unroll
        for (int q = 0; q < 4; ++q) if (ok[q]) mg_store(R[q], ww[q], rsqrtf(R[q].ss * (1.f / 128.f) + EPS), ng, Hn + of[q]); }
}
struct Args { const float* in[37]; float* out; unsigned char* ws; };

__device__ __forceinline__ void moe_phases(Frame& F, const float* const* in, int layer, const XcdBarrier& bar) {
#if defined(PROBE_ROUTE2)
    phase_norm2_route(F, in, layer, true); __syncthreads();
#endif
    phase_norm2_route(F, in, layer);
    SYNC_GRID();
    bf16* Hb = (bf16*)(F.ws + WS_H); bf16* ACT = (bf16*)(F.ws + MOE_ACT); bf16* X = (bf16*)(F.ws + WS_X);
    const float* mod = (const float*)(F.ws + WS_MOD) + (size_t)layer * 9 * 6144;
    { MoeOrder<0> S; S.W = (const bf16*)(F.ws + WS_WGU + wofs(layer)); S.G = GRID; S.c = F.vcu; moe_setup(F, layer, S);
      pg8::Gemm g{Hb, 1024, 1024, 1 << 30}; EpiMoeAct E{ACT, S.tbl};
      pg8::gemm_phase(F.lds, g, S, E);
#if defined(PROBE_GM1)
      __syncthreads(); pg8::gemm_phase(F.lds, g, S, E);
#endif
      }
    if (layer < 3 && F.vcu >= 128) { __syncthreads(); refresh(F); phase_mod(F, in, layer + 1, layer + 2, F.vcu - 128, 128); }
    SYNC_GRID();
    { MoeOrder<1> S; S.W = (const bf16*)(F.ws + WS_WDN + wofs(layer)); S.G = GRID; S.c = F.vcu; moe_setup(F, layer, S);
      pg8::Gemm g{ACT, 512, 256, 4};
#if defined(PROBE_OUT2)
      { EpiMoeDown E0{X, (const bf16*)(F.ws + WS_CTL + 262144), S.tbl}; pg8::gemm_phase(F.lds, g, S, E0); VM_WAIT(); __syncthreads(); __builtin_amdgcn_fence(__ATOMIC_ACQUIRE, "agent"); VM_WAIT(); __syncthreads(); refresh(F); }
#endif
      EpiMoeDown E{X, (const bf16*)(F.ws + WS_MODB) + (size_t)layer * 9 * 1024, S.tbl};
      pg8::gemm_phase(F.lds, g, S, E); }
    SYNC_GRID();
}
__device__ __forceinline__ void outproj_phase(Frame& F, const float* const* in, const bf16* A, const bf16* Wt, int K, int ldb, int layer, int conv_next, const float* xin = nullptr, const float* cin = nullptr) {
    pg8::Gemm g{A, K, ldb, 1 << 30}; pg8::StaticOrder S; S.init(M, 1024, GRID, (int)blockIdx.x, Wt, ldb, layer == 3);
    EpiResid E{(bf16*)(F.ws + WS_X), (const float*)(F.ws + WS_MOD) + (size_t)layer * 9 * 6144 + 2 * 1024, xin, cin};
    pg8::gemm_phase(F.lds, g, S, E);
    if (conv_next >= 0 && blockIdx.x >= 32) { refresh(F); ConvGrid cg; cg.gw = ((int)blockIdx.x - 32) * NWAVES + F.wave; cg.ngw = (GRID - 32) * NWAVES; convert_layer(F, cg, in, conv_next); }
}

__device__ __forceinline__ void ssm_inproj(Frame& F, const float* const* in, const int gp, const int c, bf16* Z, bf16* PRE, float* DT) {
    const bf16* H = (const bf16*)(F.ws + WS_H); const bf16* WM = (const bf16*)(F.ws + WS_WMIX + wofs(1));
    pg8::Gemm g{H, 1024, 1024, 1 << 30}; pg8::StaticOrder S; S.init(M, 2816, GRID, c, WM + (size_t)gp * 2816 * 1024, 1024);
    EpiSsmIn E{Z, PRE, DT, in[21] + gp * 16};
    pg8::gemm_phase(F.lds, g, S, E);
}
__device__ __forceinline__ void ssm_gp_phases(Frame& F, const float* const* in, const int gp, const XcdBarrier& bar) {
    unsigned char* scr = F.ws + WS_SCR; unsigned char* scr2 = (unsigned char*)F.out; bf16* WM = (bf16*)(F.ws + WS_WMIX + wofs(1));
    bf16* Z = (bf16*)scr; bf16* XP = (bf16*)(scr + 68 * MiB); bf16* XS = (bf16*)(scr + 170 * MiB); float* DT = (float*)(scr + 238 * MiB); float* ACUM = (float*)(scr + 243 * MiB); bf16* Yb = (bf16*)(scr2 + 34 * MiB);
    bf16* PRE = gp == 0 ? XP : (bf16*)scr2; bf16* BC = gp == 0 ? (bf16*)scr2 : (bf16*)(scr + 136 * MiB);
    if (gp == 0) { ssm_inproj(F, in, 0, (int)blockIdx.x, Z, PRE, DT); SYNC_GRID(); }
    phase_ssm_conv(F, in, gp, PRE, XS, BC, DT, ACUM);
    SYNC_GRID();
    phase_ssm_scan_mfma(F, in, gp, XS, BC, DT, ACUM, XP, Yb);
    SYNC_GRID();
    phase_ssm_gnorm2(F, in, gp, XP, Yb, XS, Z);
    SYNC_GRID();
    if (gp == 0) {
        outproj_phase(F, in, XP, WM + 6 * MiB, 1024, 2048, 1, -1);
        __syncthreads(); refresh(F);
        ssm_inproj(F, in, 1, ((int)blockIdx.x + 224) & 255, Z, (bf16*)scr2, DT);
    } else outproj_phase(F, in, XP, WM + 6 * MiB + 1024, 1024, 2048, 1, 2);
    SYNC_GRID();
}

__global__ void __launch_bounds__(NTHR, 2) fwd_kernel(Args args) {
    extern __shared__ __attribute__((aligned(16))) unsigned char lds_raw[];
    Frame F;
    F.lds = (LAS unsigned char*)lds_raw; F.ws = args.ws; F.ctl = (unsigned*)(args.ws + WS_CTL); F.out = args.out;
    refresh(F);
    { const int bx = blockIdx.x; F.vcu = (bx % 8) * (GRID / 8) + bx / 8; }
    volatile LAS unsigned* MISC = (volatile LAS unsigned*)(F.lds + LDS_MISC);
    for (int u = F.tid; u < 256; u += NTHR) MISC[u] = 0u;
    __syncthreads();
    const XcdBarrier bar = xcd_barrier_post(F.ctl + CW_BAR, MISC + 8);
    const float* const* in = args.in;
    unsigned char* ws = F.ws; unsigned char* scr = ws + WS_SCR; unsigned char* scr2 = (unsigned char*)F.out;
    bf16* H = (bf16*)(ws + WS_H);

#if defined(PROBE_MEM2) || defined(PROBE_PRO2)
    for (int rep = 0; rep < 2; ++rep) {
#endif
    phase_prologue(F, in);
    __syncthreads(); refresh(F);
    convert_layer(F, conv_all(F), in, 0);
#if defined(PROBE_MEM2) || defined(PROBE_PRO2)
    __syncthreads(); }
#endif
    SYNC_GRID();

#ifndef SKIP_L0
    phase_norm1(F, in, 0);
#if defined(PROBE_MEM2)
    phase_norm1(F, in, 0);
#endif
    SYNC_GRID();
    { bf16* WM = (bf16*)(ws + WS_WMIX + wofs(0)); bf16* Q = (bf16*)scr; bf16* Kb = (bf16*)(scr + 68 * MiB); bf16* Vb = (bf16*)(scr + 85 * MiB);
      { pg8::Gemm g{H, 1024, 1024, 1 << 30}; pg8::StaticOrder S; S.init(M, 1536, GRID, (int)blockIdx.x, WM, 1024);
        EpiAttnIn E{Q, Kb, Vb, (const f32x2*)(ws + WS_TABA), 0.125f * LOG2E};
        pg8::gemm_phase(F.lds, g, S, E);
#if defined(PROBE_GEMM2)
        __syncthreads(); pg8::gemm_phase(F.lds, g, S, E);
#endif
        }
      SYNC_GRID();
#if defined(PROBE_WIN2)
      phase_attn_window(F, in, Q, Kb, Vb, (bf16*)scr2); __syncthreads();
#endif
      phase_attn_window(F, in, Q, Kb, Vb);
      SYNC_GRID();
      outproj_phase(F, in, Q, WM + 2 * MiB, 1024, 1024, 0, 1, in[0], in[2]);
      SYNC_GRID(); }
    moe_phases(F, in, 0, bar);

#endif
#ifndef SKIP_L1
#if defined(PROBE_MEM2)
    for (int rep = 0; rep < 2; ++rep) {
#endif
    phase_norm1(F, in, 1);
#if defined(PROBE_MEM2)
    __syncthreads(); }
#endif
    SYNC_GRID();
    ssm_gp_phases(F, in, 0, bar);
    ssm_gp_phases(F, in, 1, bar);
    moe_phases(F, in, 1, bar);

#endif
#ifndef SKIP_L2
#if defined(PROBE_MEM2)
    for (int rep = 0; rep < 2; ++rep) {
#endif
    phase_norm1(F, in, 2);
#if defined(PROBE_MEM2)
    __syncthreads(); }
#endif
    SYNC_GRID();
    { bf16* WM = (bf16*)(ws + WS_WMIX + wofs(2)); bf16* Qm = (bf16*)scr; bf16* Km = (bf16*)(scr + 34 * MiB); bf16* Vm = (bf16*)(scr + 68 * MiB); bf16* Om = (bf16*)(scr + 136 * MiB); float* Gt = (float*)(scr + 204 * MiB);
      bf16* Hf = (bf16*)scr2; bf16* Hbw = H;
      { pg8::Gemm g{H, 1024, 1024, 1 << 30}; pg8::StaticOrder S; S.init(M, 3328, GRID, (int)blockIdx.x, WM, 1024);
        EpiMlIn E{Qm, Km, Vm, Om, Gt, in[27]};
        pg8::gemm_phase(F.lds, g, S, E);
#if defined(PROBE_GEMM2)
        __syncthreads(); pg8::gemm_phase(F.lds, g, S, E);
#endif
        }
      SYNC_GRID();
#if defined(ML_VALU)
      phase_mlstm_scan(F, Qm, Km, Vm, Gt, Hf, Hbw);
#else
      phase_mlstm_scan_mfma(F, Qm, Km, Vm, Gt, Hf, Hbw);
#if defined(PROBE_MLM2)
      __syncthreads(); phase_mlstm_scan_mfma(F, Qm, Km, Vm, Gt, Hf, Hbw);
#endif
#endif
      SYNC_GRID();
#if defined(PROBE_GN2)
      phase_mlstm_gnorm(F, in, Hf, Hbw, Om, Qm); __syncthreads();
#endif
      phase_mlstm_gnorm(F, in, Hf, Hbw, Om, Om);
      SYNC_GRID();
      outproj_phase(F, in, Om, WM + 4 * MiB, 1024, 1024, 2, 3);
      SYNC_GRID(); }
    moe_phases(F, in, 2, bar);

#endif
#ifndef SKIP_L3
#if defined(PROBE_MEM2)
    for (int rep = 0; rep < 2; ++rep) {
#endif
    phase_norm1(F, in, 3);
#if defined(PROBE_MEM2)
    __syncthreads(); }
#endif
    SYNC_GRID();
    { bf16* WM = (bf16*)(ws + WS_WMIX + wofs(3)); bf16* CQ = (bf16*)scr; bf16* CKV = (bf16*)(scr + 17 * MiB); float* SSQ = (float*)(scr + 34 * MiB); bf16* KF = (bf16*)(scr + 36 * MiB); bf16* V3 = (bf16*)(scr + 138 * MiB);
      bf16* Q3 = (bf16*)scr2; bf16* O3 = H; const f32x2* tabm = (const f32x2*)(ws + WS_TABM);
      { pg8::Gemm g{H, 1024, 1024, 1 << 30}; pg8::StaticOrder S; S.init(M, 768, GRID, (int)blockIdx.x, WM, 1024);
        EpiMlaIn E{CQ, CKV, KF, SSQ, tabm};
        pg8::gemm_phase(F.lds, g, S, E);
#if defined(PROBE_GEMM2)
        __syncthreads(); pg8::gemm_phase(F.lds, g, S, E);
#endif
        }
      SYNC_GRID();
      { pg8::Gemm g{CQ, 256, 256, 1 << 30}; pg8::StaticOrder S; S.init(M, 1536, GRID, (int)blockIdx.x, WM + 1 * MiB, 256);
        EpiMlaQ E{Q3, SSQ, tabm, 0.10206207261596577f * LOG2E};
        pg8::gemm_phase(F.lds, g, S, E);
#if defined(PROBE_GEMM2)
        __syncthreads(); pg8::gemm_phase(F.lds, g, S, E);
#endif
        }
      { pg8::Gemm g{CKV, 256, 256, 1 << 30}; pg8::StaticOrder S; S.init(M, 2048, GRID, ((int)blockIdx.x + 192) & 255, WM + 2 * MiB, 256);
        EpiMlaKV E{KF, V3, SSQ};
        pg8::gemm_phase(F.lds, g, S, E);
#if defined(PROBE_GEMM2)
        __syncthreads(); pg8::gemm_phase(F.lds, g, S, E);
#endif
        }
      SYNC_GRID();
      phase_attn_mla(F, Q3, KF, V3, O3);
#if defined(PROBE_MLA2)
      __syncthreads(); phase_attn_mla(F, Q3, KF, V3, O3);
#endif
      SYNC_GRID();
      outproj_phase(F, in, O3, WM + 3 * MiB, 1024, 1024, 3, -1);
      SYNC_GRID(); }
    moe_phases(F, in, 3, bar);

#endif
    const bool poison = __hip_atomic_load(F.ctl + CW_BAR + XB_TMO, RLX_AGENT) != 0u || __hip_atomic_load(F.ctl + CW_POISON, RLX_AGENT) != 0u;
    phase_final(F, in, poison);
#if defined(PROBE_MEM2)
    phase_final(F, in, poison);
#endif
}

extern "C" void kernel_launch(void* const* d_in, const int* in_sizes, int n_in, void* d_out, int out_size, void* d_ws, size_t ws_size, hipStream_t stream) {
    static int ready = 0;
    if (ready == 0) {
        ready = -1;
        if (n_in != 37 || in_sizes[0] != NB * SEQ * D || out_size != NB * SEQ * D || ws_size < WS_END) { fprintf(stderr, "kernel_launch: unexpected problem shape (n_in %d, in0 %d, out %d, ws %zu)\n", n_in, n_in > 0 ? in_sizes[0] : -1, out_size, ws_size); return; }
        int dev = 0, cus = 0;
        if (hipGetDevice(&dev) != hipSuccess || hipDeviceGetAttribute(&cus, hipDeviceAttributeMultiprocessorCount, dev) != hipSuccess) { fprintf(stderr, "kernel_launch: device query failed\n"); return; }
        if (cus < GRID) { fprintf(stderr, "kernel_launch: needs %d CUs, device has %d\n", GRID, cus); return; }
        if (hipFuncSetAttribute((const void*)fwd_kernel, hipFuncAttributeMaxDynamicSharedMemorySize, LDS_BYTES) != hipSuccess) { fprintf(stderr, "kernel_launch: hipFuncSetAttribute failed\n"); return; }
        int per_cu = 0;
        if (hipOccupancyMaxActiveBlocksPerMultiprocessor(&per_cu, (const void*)fwd_kernel, NTHR, LDS_BYTES) != hipSuccess || per_cu < 1) { fprintf(stderr, "kernel_launch: occupancy query reports %d blocks per CU\n", per_cu); }
        (void)hipGetLastError();
        ready = 1;
    }
    if (ready < 0) return;
    if (hipMemsetAsync((char*)d_ws + WS_CTL, 0, CTL_ZERO_BYTES, stream) != hipSuccess) { fprintf(stderr, "kernel_launch: memset failed\n"); return; }
    Args a{};
    for (int i = 0; i < 37; ++i) a.in[i] = (const float*)d_in[i];
    a.out = (float*)d_out; a.ws = (unsigned char*)d_ws;
    hipLaunchKernelGGL(fwd_kernel, dim3(GRID), dim3(NTHR), LDS_BYTES, stream, a);
    const hipError_t le = hipPeekAtLastError();
    if (le != hipSuccess) fprintf(stderr, "kernel_launch: launch failed: %s\n", hipGetErrorName(le));
}
```

```cpp
#include <hip/hip_runtime.h>
#include <cstdio>
#include <cstdint>

#define GAS __attribute__((address_space(1)))
#define LAS __attribute__((address_space(3)))
typedef unsigned short bf16;
typedef unsigned v4u __attribute__((ext_vector_type(4)));
typedef unsigned v2u __attribute__((ext_vector_type(2)));
typedef float f32x4 __attribute__((ext_vector_type(4)));
typedef float f32x2 __attribute__((ext_vector_type(2)));
typedef short bf16x8 __attribute__((ext_vector_type(8)));
typedef short s16x4 __attribute__((ext_vector_type(4)));
#define RLX_AGENT __ATOMIC_RELAXED, __HIP_MEMORY_SCOPE_AGENT

constexpr int D = 1024, NB = 8, SEQ = 4096, CTX = 256, TPB = SEQ + CTX  , M = NB * TPB  ;
constexpr int NWAVES = 8, NTHR = 512, GRID = 256;
constexpr float EPS = 1e-6f;
constexpr float LOG2E = 1.4426950408889634f;

__device__ __forceinline__ unsigned f2bf(float f) { unsigned u = __builtin_bit_cast(unsigned, f); return (u + 0x7fffu + ((u >> 16) & 1u)) >> 16; }
__device__ __forceinline__ float bf2f(unsigned b) { return __builtin_bit_cast(float, b << 16); }
__device__ __forceinline__ float bflo(unsigned w) { return __builtin_bit_cast(float, w << 16); }
__device__ __forceinline__ float bfhi(unsigned w) { return __builtin_bit_cast(float, w & 0xffff0000u); }
typedef __bf16 nbf16x2 __attribute__((ext_vector_type(2)));
__device__ __forceinline__ unsigned cvt_pk_bf16(float lo, float hi) { const nbf16x2 r = __builtin_convertvector((f32x2){lo, hi}, nbf16x2); return __builtin_bit_cast(unsigned, r); }
__device__ __forceinline__ float fast_exp2(float x) { return __builtin_amdgcn_exp2f(x); }
__device__ __forceinline__ float fast_rcp(float x) { return __builtin_amdgcn_rcpf(x); }
__device__ __forceinline__ float silu_f(float x) { return x * fast_rcp(1.0f + fast_exp2(-x * LOG2E)); }
__device__ __forceinline__ float sigmoid_f(float x) { return fast_rcp(1.0f + fast_exp2(-x * LOG2E)); }
__device__ __forceinline__ float fast_log(float x) { return __builtin_amdgcn_logf(x) * 0.6931471805599453f; }
__device__ __forceinline__ float fast_exp(float x) { return __builtin_amdgcn_exp2f(x * LOG2E); }
__device__ __forceinline__ float softplus_f(float x) { if (x > 20.f) return x; const float e = fast_exp(x); return e < 0.01f ? e * (1.0f - e * (0.5f - e * (1.0f / 3.0f))) : fast_log(1.0f + e); }
__device__ __forceinline__ v4u pack8(const f32x4 a, const f32x4 b) { v4u w; w.x = cvt_pk_bf16(a[0], a[1]); w.y = cvt_pk_bf16(a[2], a[3]); w.z = cvt_pk_bf16(b[0], b[1]); w.w = cvt_pk_bf16(b[2], b[3]); return w; }
#define DPPF(old, src, ctrl, rm, bc) __builtin_bit_cast(float, __builtin_amdgcn_update_dpp(__builtin_bit_cast(int, (float)(old)), __builtin_bit_cast(int, (float)(src)), ctrl, rm, 0xF, bc))
__device__ __forceinline__ float xor32(float x) {
    const unsigned u = __builtin_bit_cast(unsigned, x);
    const auto r = __builtin_amdgcn_permlane32_swap(u, u, false, false);
    return __builtin_bit_cast(float, (threadIdx.x & 32u) ? r[0] : r[1]);
}
__device__ __forceinline__ float wave_scan_sum(float v) {
    v += DPPF(0.f, v, 0x111, 0xF, true); v += DPPF(0.f, v, 0x112, 0xF, true); v += DPPF(0.f, v, 0x114, 0xF, true); v += DPPF(0.f, v, 0x118, 0xF, true);
    v += DPPF(0.f, v, 0x142, 0xA, false); v += DPPF(0.f, v, 0x143, 0xC, false); return v;
}
__device__ __forceinline__ float wave_scan_max(float v) {
    v = fmaxf(v, DPPF(-3.0e38f, v, 0x111, 0xF, false)); v = fmaxf(v, DPPF(-3.0e38f, v, 0x112, 0xF, false)); v = fmaxf(v, DPPF(-3.0e38f, v, 0x114, 0xF, false)); v = fmaxf(v, DPPF(-3.0e38f, v, 0x118, 0xF, false));
    v = fmaxf(v, DPPF(-3.0e38f, v, 0x142, 0xA, false)); v = fmaxf(v, DPPF(-3.0e38f, v, 0x143, 0xC, false)); return v;
}
__device__ __forceinline__ float wave_sum(float v) {
    v += DPPF(0.f, v, 0xB1, 0xF, true); v += DPPF(0.f, v, 0x4E, 0xF, true); v += DPPF(0.f, v, 0x141, 0xF, true); v += DPPF(0.f, v, 0x140, 0xF, true);
    v += DPPF(0.f, v, 0x142, 0xA, false); v += DPPF(0.f, v, 0x143, 0xC, false);
    return __builtin_bit_cast(float, __builtin_amdgcn_readlane(__builtin_bit_cast(int, v), 63));
}
__device__ __forceinline__ int opaque_tid() { int t = threadIdx.x; asm volatile("" : "+v"(t)); return t; }
__device__ __forceinline__ float xrow_max(float v) {
    { auto r = __builtin_amdgcn_permlane16_swap(__builtin_bit_cast(unsigned, v), __builtin_bit_cast(unsigned, v), false, false); v = fmaxf(__builtin_bit_cast(float, r[0]), __builtin_bit_cast(float, r[1])); }
    { auto r = __builtin_amdgcn_permlane32_swap(__builtin_bit_cast(unsigned, v), __builtin_bit_cast(unsigned, v), false, false); v = fmaxf(__builtin_bit_cast(float, r[0]), __builtin_bit_cast(float, r[1])); }
    return v; }
__device__ __forceinline__ float xrow_sum(float v) {
    { auto r = __builtin_amdgcn_permlane16_swap(__builtin_bit_cast(unsigned, v), __builtin_bit_cast(unsigned, v), false, false); v = __builtin_bit_cast(float, r[0]) + __builtin_bit_cast(float, r[1]); }
    { auto r = __builtin_amdgcn_permlane32_swap(__builtin_bit_cast(unsigned, v), __builtin_bit_cast(unsigned, v), false, false); v = __builtin_bit_cast(float, r[0]) + __builtin_bit_cast(float, r[1]); }
    return v; }
#define LDS_WAIT() asm volatile("s_waitcnt lgkmcnt(0)" ::: "memory")
#define VM_WAIT() asm volatile("s_waitcnt vmcnt(0)" ::: "memory")

namespace pg8 {
constexpr int BM = 256, BK = 64, HALF = 128, HTB = HALF * BK * 2, STAGE_BYTES = 8 * HTB, NXCD = 8, WGM = 8;
__host__ __device__ __forceinline__ int lds_byte(int r, int c) { const int st = (r >> 4) * 2 + (c >> 5), rr = r & 15, cc = c & 31, ob = rr * 64 + cc * 2; return st * 1024 + (ob ^ (((ob >> 9) & 1) << 5)); }
__host__ __device__ __forceinline__ void stage_rc(int b, int& R, int& C) { const int st = b / 1024, sb = b % 1024, swz = sb ^ (((sb >> 9) & 1) << 5); R = (st >> 1) * 16 + swz / 64; C = (st & 1) * 32 + (swz % 64) / 2; }
__host__ __device__ __forceinline__ int perm32(int rho) { const int n = rho >> 4, i = rho & 15; return 8 * (i >> 2) + 4 * n + (i & 3); }

struct Unit { int pm, pn, aux; };
struct Gemm { const bf16* A; int K; int ldb; int ksplit; };

struct StaticOrder {
    static constexpr bool GATHER = false;
    int nM, nN, nwg, G, c; const bf16* Bt; int ldb; bool skipctx;
    __device__ void init(int M_, int N_, int G_, int c_, const bf16* Bt_, int ldb_, bool skipctx_ = false) { skipctx = skipctx_; nM = skipctx ? 128 : M_ / BM; nN = N_ / BM; nwg = nM * nN; G = G_; c = c_; Bt = Bt_; ldb = ldb_; }
    __device__ __forceinline__ bool next(int i, Unit& u) const {
        const long L = (long)i * G + c; if (L >= nwg) return false;
        int wgid = (int)L; { const int q = nwg / NXCD, r = nwg % NXCD, xcd = wgid % NXCD, off = wgid / NXCD; wgid = (xcd < r ? xcd * (q + 1) : r * (q + 1) + (xcd - r) * q) + off; }
        const int nig = WGM * nN, gid = wgid / nig, fm = gid * WGM; constexpr int gsz = WGM;
        u.pm = fm + ((wgid % nig) % gsz); u.pn = (wgid % nig) / gsz; u.aux = 0; if (skipctx) u.pm = (u.pm >> 4) * 17 + 1 + (u.pm & 15); return true;
    }
    __device__ __forceinline__ int a_row(const Unit& u, int r) const { return u.pm * BM + r; }
    __device__ __forceinline__ const char* b_seg(const Unit& u, int seg) const { return (const char*)(Bt + (size_t)u.pn * BM * ldb); }
};

template <class Epi, class Sched>
__device__ __forceinline__ void gemm_phase(LAS unsigned char* lds, const Gemm g, const Sched& S, const Epi& E) {
    const int tid = opaque_tid(), wid = __builtin_amdgcn_readfirstlane(tid >> 6), lane = tid & 63, wr = wid >> 2, wc = wid & 3, fr = lane & 15, fq = lane >> 4;
    const int K = g.K, nt = K / BK, ldb = g.ldb, ksplit = g.ksplit;
    int Rst[2], Cst[2]; unsigned voffB[2], voffA[2];
#pragma unroll
    for (int i = 0; i < 2; ++i) { int R, C; stage_rc(tid * 16 + i * 8192, R, C); const int Rb = Epi::PERM ? ((R & ~31) + perm32(R & 31)) : R; Rst[i] = R; Cst[i] = C;
        voffB[i] = (unsigned)(Rb * ldb + C) * 2u; voffA[i] = (unsigned)(R * K + C) * 2u; }
    const size_t hstepA = (size_t)HALF * K * 2;
    const size_t kstep = (size_t)(BK * 2);
    const size_t hstepB = (size_t)HALF * ldb * 2;
    const unsigned ldsw = (unsigned)wid * 1024u;
    const int aoff = lds_byte(wr * 64 + fr, fq * 8), boff = lds_byte(wc * 32 + fr, fq * 8);
#define PG8_SA(b, h) (((b) * 2 + (h)) * HTB)
#define PG8_SB(b, h) ((4 + (b) * 2 + (h)) * HTB)
#define PG8_STAGEB(bufoff, gbase) do { _Pragma("unroll") for (int _i = 0; _i < 2; ++_i) \
        __builtin_amdgcn_global_load_lds((const unsigned*)((const char*)(gbase) + voffB[_i]), (LAS unsigned*)(lds + (bufoff) + ldsw + _i * 8192), 16, 0, 0); } while (0)
#define PG8_STAGEA(bufoff, nextsel, h, kt) do { if constexpr (Sched::GATHER) { _Pragma("unroll") for (int _i = 0; _i < 2; ++_i) \
        __builtin_amdgcn_global_load_lds((const unsigned*)(gA + (size_t)(kt) * kstep + ((nextsel) ? vN[h][_i] : vA[h][_i])), (LAS unsigned*)(lds + (bufoff) + ldsw + _i * 8192), 16, 0, 0); } \
      else { const char* _ab = ((nextsel) ? nA : cA) + (size_t)(h) * hstepA + (size_t)(kt) * kstep; _Pragma("unroll") for (int _i = 0; _i < 2; ++_i) \
        __builtin_amdgcn_global_load_lds((const unsigned*)(_ab + voffA[_i]), (LAS unsigned*)(lds + (bufoff) + ldsw + _i * 8192), 16, 0, 0); } } while (0)
#define PG8_LDA(dst, b, h) do { _Pragma("unroll") for (int m = 0; m < 4; ++m) _Pragma("unroll") for (int k = 0; k < 2; ++k) dst[m][k] = *(const LAS bf16x8*)(lds + PG8_SA(b, h) + aoff + m * 2048 + k * 1024); } while (0)
#define PG8_LDB(dst, b, h) do { _Pragma("unroll") for (int n = 0; n < 2; ++n) _Pragma("unroll") for (int k = 0; k < 2; ++k) dst[n][k] = *(const LAS bf16x8*)(lds + PG8_SB(b, h) + boff + n * 2048 + k * 1024); } while (0)
#define PG8_MMA(ai, bj, At, Bt) do { __builtin_amdgcn_s_setprio(1); _Pragma("unroll") for (int m = 0; m < 4; ++m) _Pragma("unroll") for (int n = 0; n < 2; ++n) _Pragma("unroll") for (int k = 0; k < 2; ++k) \
        acc[ai][bj][m][n] = __builtin_amdgcn_mfma_f32_16x16x32_bf16(Bt[n][k], At[m][k], acc[ai][bj][m][n], 0, 0, 0); __builtin_amdgcn_s_setprio(0); } while (0)
#define PG8_WAIT_V(n) asm volatile("s_waitcnt vmcnt(" #n ")" ::: "memory")
#define PG8_WAIT_L(n) asm volatile("s_waitcnt lgkmcnt(" #n ")" ::: "memory")
#define PG8_BAR __builtin_amdgcn_s_barrier()
#define PG8_SCHED __builtin_amdgcn_sched_barrier(0)
#define PG8_AOFFS(dst, u) do { _Pragma("unroll") for (int _h = 0; _h < 2; ++_h) _Pragma("unroll") for (int _i = 0; _i < 2; ++_i) \
        dst[_h][_i] = (unsigned)S.a_row(u, _h * HALF + Rst[_i]) * (unsigned)(K * 2) + (unsigned)(Cst[_i] * 2); } while (0)
    Unit cur, nxt; int ui = 0;
    if (!S.next(0, cur)) return;
#if defined(GEMM_STAGGER)
    { const unsigned long long t0 = __builtin_amdgcn_s_memrealtime(); const unsigned long long dly = (unsigned long long)((blockIdx.x >> 3) & 3) * GEMM_STAGGER;
      while (__builtin_amdgcn_s_memrealtime() - t0 < dly) __builtin_amdgcn_s_sleep(2); }
#endif
    const char* const gA = (const char*)g.A;
    f32x4 acc[2][2][4][2];
#pragma unroll
    for (int a = 0; a < 2; ++a)
#pragma unroll
        for (int b = 0; b < 2; ++b)
#pragma unroll
            for (int m = 0; m < 4; ++m)
#pragma unroll
                for (int n = 0; n < 2; ++n) acc[a][b][m][n] = (f32x4){0.f, 0.f, 0.f, 0.f};
    bf16x8 At[4][2], B0[2][2], B1[2][2];
    unsigned vA[2][2], vN[2][2];
    const char* cA = gA; const char* nA = gA;
    if constexpr (Sched::GATHER) { PG8_AOFFS(vA, cur); } else { cA = gA + (size_t)S.a_row(cur, 0) * K * 2; }
    const char* cB0 = S.b_seg(cur, 0); const char* cB1 = S.b_seg(cur, 1);
    PG8_STAGEB(PG8_SB(0, 0), cB0); PG8_STAGEB(PG8_SB(0, 1), cB0 + hstepB); PG8_STAGEA(PG8_SA(0, 0), false, 0, 0); PG8_STAGEA(PG8_SA(0, 1), false, 1, 0);
    if (wr == 1) PG8_BAR;
    PG8_WAIT_V(2); PG8_BAR;
    PG8_STAGEB(PG8_SB(1, 0), cB0 + kstep); PG8_STAGEA(PG8_SA(1, 0), false, 0, 1); PG8_STAGEB(PG8_SB(1, 1), cB0 + hstepB + kstep);
    PG8_WAIT_V(6); PG8_BAR;
    for (;;) {
        const bool has_next = S.next(ui + 1, nxt);
        const char* nB0 = cB0;
        nA = cA;
        if (has_next) { nB0 = S.b_seg(nxt, 0); if constexpr (Sched::GATHER) { PG8_AOFFS(vN, nxt); } else { nA = gA + (size_t)S.a_row(nxt, 0) * K * 2; } }
        else { if constexpr (Sched::GATHER) {
#pragma unroll
            for (int h = 0; h < 2; ++h)
#pragma unroll
                for (int i = 0; i < 2; ++i) vN[h][i] = vA[h][i]; } }
#pragma unroll 1
        for (int t = 0; t < nt; t += 2) {
            const bool last = (t == nt - 2);
            const char* b2 = last ? nB0 : ((t + 2 < ksplit) ? cB0 + (size_t)(t + 2) * kstep : cB1 + (size_t)(t + 2 - ksplit) * kstep);
            const char* b3 = b2 + kstep;
            const int kt2 = last ? 0 : t + 2;
            PG8_LDB(B0, 0, 0); PG8_LDB(B1, 0, 1); PG8_SCHED; PG8_LDA(At, 0, 0); PG8_STAGEA(PG8_SA(1, 1), false, 1, t + 1);
            PG8_WAIT_V(8); PG8_WAIT_L(0); PG8_BAR; PG8_MMA(0, 0, At, B0); PG8_MMA(0, 1, At, B1); PG8_BAR; PG8_SCHED;
            PG8_LDA(At, 0, 1); PG8_STAGEB(PG8_SB(0, 0), b2); PG8_STAGEB(PG8_SB(0, 1), b2 + hstepB); PG8_STAGEA(PG8_SA(0, 0), last, 0, kt2);
            PG8_WAIT_V(8); PG8_WAIT_L(0); PG8_BAR; PG8_MMA(1, 0, At, B0); PG8_MMA(1, 1, At, B1); PG8_BAR; PG8_SCHED;
            PG8_LDB(B0, 1, 0); PG8_LDB(B1, 1, 1); PG8_SCHED; PG8_LDA(At, 1, 0); PG8_STAGEA(PG8_SA(0, 1), last, 1, kt2);
            PG8_WAIT_V(8); PG8_WAIT_L(0); PG8_BAR; PG8_MMA(0, 0, At, B0); PG8_MMA(0, 1, At, B1); PG8_BAR; PG8_SCHED;
            PG8_LDA(At, 1, 1); PG8_STAGEB(PG8_SB(1, 0), b3); PG8_STAGEB(PG8_SB(1, 1), b3 + hstepB); PG8_STAGEA(PG8_SA(1, 0), last, 0, kt2 + 1);
            PG8_WAIT_V(8); PG8_WAIT_L(0); PG8_BAR; PG8_MMA(1, 0, At, B0); PG8_MMA(1, 1, At, B1); PG8_BAR; PG8_SCHED;
        }
        if (wr == 0) PG8_BAR;
        { int tz = tid; asm volatile("" : "+v"(tz));
          const int lz = tz & 63; E(acc, cur, ui, wr, wc, lz & 15, lz >> 4); }
        if (!has_next) break;
#pragma unroll
        for (int a = 0; a < 2; ++a)
#pragma unroll
            for (int b = 0; b < 2; ++b)
#pragma unroll
                for (int m = 0; m < 4; ++m)
#pragma unroll
                    for (int n = 0; n < 2; ++n) acc[a][b][m][n] = (f32x4){0.f, 0.f, 0.f, 0.f};
        cur = nxt; cB0 = nB0; cB1 = S.b_seg(cur, 1); cA = nA; ++ui;
        if constexpr (Sched::GATHER) {
#pragma unroll
        for (int h = 0; h < 2; ++h)
#pragma unroll
            for (int i = 0; i < 2; ++i) vA[h][i] = vN[h][i]; }
        if (wr == 1) PG8_BAR;
    }
    PG8_WAIT_V(0);
    PG8_BAR;
#undef PG8_SA
#undef PG8_SB
#undef PG8_STAGEA
#undef PG8_STAGEB
#undef PG8_LDA
#undef PG8_LDB
#undef PG8_MMA
#undef PG8_WAIT_V
#undef PG8_WAIT_L
#undef PG8_BAR
#undef PG8_SCHED
#undef PG8_AOFFS
}
}
#define XB_TMO      128
#define XB_XCNT(j)  (256  + 64 * (j))
#define XB_XSUB(j)  (1280 + 64 * (j))
#define XB_XGEN(j)  (2304 + 64 * (j))
#define XB_TOP      3328
#define XB_TOPGEN   3392
#define XCD_BAR_WORDS 3456
#define XB_SPIN_CAP (1u << 22)
__device__ __forceinline__ unsigned xb_ld(unsigned* p)              { return __hip_atomic_load(p, __ATOMIC_RELAXED, __HIP_MEMORY_SCOPE_AGENT); }
__device__ __forceinline__ unsigned xb_add(unsigned* p, unsigned v) { return __hip_atomic_fetch_add(p, v, __ATOMIC_RELAXED, __HIP_MEMORY_SCOPE_AGENT); }
__device__ __forceinline__ unsigned xb_xcc_id() { return (unsigned)__builtin_amdgcn_s_getreg((3 << 11) | 20) & 0xFu; }
#define XB_SPIN(cond, bar) do { unsigned _sp = 0; while (cond) { __builtin_amdgcn_s_sleep(1); \
    if ((++_sp & 255u) == 0u) { if (xb_ld(&(bar)[XB_TMO])) break; if (_sp > XB_SPIN_CAP) { atomicAdd(&(bar)[XB_TMO], 1u); break; } } } } while (0)
struct XcdBarrier { unsigned* bar; unsigned x; volatile LAS unsigned* st; };
__device__ __forceinline__ XcdBarrier xcd_barrier_post(unsigned* bar, volatile LAS unsigned* st) {
    XcdBarrier b; b.bar = bar; b.x = xb_xcc_id(); b.st = st;
    if (threadIdx.x == 0) (void)xb_add(&bar[XB_XCNT(b.x)], 1u);
    return b;
}
__device__ __forceinline__ void xcd_barrier_complete(unsigned* bar, unsigned x, unsigned& nloc, unsigned& nx) {
    const unsigned G = gridDim.x * gridDim.y * gridDim.z;
    unsigned sum, cnt, mine, sp = 0u;
    for (;;) {
        sum = 0u; cnt = 0u; mine = 0u;
#pragma unroll
        for (unsigned j = 0; j < 16; ++j) { const unsigned c = xb_ld(&bar[XB_XCNT(j)]); sum += c; cnt += (c > 0u) ? 1u : 0u; mine = (j == x) ? c : mine; }
        if (sum == G) break;
        __builtin_amdgcn_s_sleep(1);
        if ((++sp & 255u) == 0u) { if (xb_ld(&bar[XB_TMO])) break; if (sp > XB_SPIN_CAP) { atomicAdd(&bar[XB_TMO], 1u); break; } }
    }
    nloc = mine > 0u ? mine : 1u; nx = cnt > 0u ? cnt : 1u;
}
__device__ __forceinline__ void xcd_barrier(const XcdBarrier& b) {
    asm volatile("s_waitcnt vmcnt(0)" ::: "memory");
    __syncthreads();
    if (threadIdx.x == 0) {
        unsigned* bar = b.bar;
        __builtin_amdgcn_s_waitcnt(0);
        unsigned nloc = b.st[0], nx = b.st[1];
        if (nloc == 0u) { xcd_barrier_complete(bar, b.x, nloc, nx); b.st[0] = nloc; b.st[1] = nx; }
        const unsigned old = xb_add(&bar[XB_XSUB(b.x)], 1u);
        const unsigned gen = old / nloc;
        if (old + 1u == (gen + 1u) * nloc) {
            __builtin_amdgcn_fence(__ATOMIC_RELEASE, "agent");
            asm volatile("s_waitcnt vmcnt(0)" ::: "memory");
            const unsigned og = xb_add(&bar[XB_TOP], 1u);
            const unsigned tg = og / nx;
            if (og + 1u == (tg + 1u) * nx) xb_add(&bar[XB_TOPGEN], 1u);
            else XB_SPIN(xb_ld(&bar[XB_TOPGEN]) == tg, bar);
            __builtin_amdgcn_fence(__ATOMIC_ACQUIRE, "agent");
            xb_add(&bar[XB_XGEN(b.x)], 1u);
            asm volatile("s_waitcnt vmcnt(0)" ::: "memory");
        } else {
            XB_SPIN(xb_ld(&bar[XB_XGEN(b.x)]) == gen, bar);
            __builtin_amdgcn_fence(__ATOMIC_ACQUIRE, "agent");
            asm volatile("s_waitcnt vmcnt(0)" ::: "memory");
        }
    }
    __syncthreads();
}

constexpr size_t MiB = 1u << 20;
constexpr size_t WS_CTL = 0, CTL_ZERO_BYTES = 1 * MiB;
constexpr size_t WS_MOD = 1 * MiB;
constexpr size_t WS_MODB = 1 * MiB + 884736;
constexpr size_t WS_TABA = 2 * MiB;
constexpr size_t WS_TABM = 3 * MiB;
constexpr size_t WS_WGU = 4 * MiB;
constexpr size_t WS_WDN = 20 * MiB;
constexpr size_t WS_WMIX = 28 * MiB;
constexpr size_t WS_X = 52 * MiB;
constexpr size_t WS_W1 = 116 * MiB;
__device__ __forceinline__ size_t wofs(int layer) { return (layer & 1) ? WS_W1 : 0; }
constexpr size_t WS_H = 188 * MiB;
constexpr size_t WS_SCR = 256 * MiB;
constexpr size_t WS_END = 512 * MiB;
constexpr size_t MOE_ACT = WS_SCR;
constexpr size_t MOE_SL = WS_SCR + 48 * MiB;
constexpr size_t MOE_WT = WS_SCR + 52 * MiB;
constexpr int CW_BAR = 4096;
constexpr int CW_MOECNT = 16384;
constexpr int CW_POISON = 20000;

constexpr int RING_BYTES = 131072;
constexpr int LDS_MISC = RING_BYTES;
constexpr int LDS_TB = RING_BYTES + 512;
constexpr int LDS_TBL = RING_BYTES + 1024;
constexpr int LDS_BYTES = RING_BYTES + 1024 + 16384;

struct Frame {
    LAS unsigned char* lds;
    unsigned* ctl;
    unsigned char* ws;
    float* out;
    int tid, lane, wave, vcu;
};

__device__ __forceinline__ void refresh(Frame& F) { F.tid = opaque_tid(); F.lane = F.tid & 63; F.wave = __builtin_amdgcn_readfirstlane(F.tid >> 6); }
#if defined(PROBE_BAR2)
#define SYNC_GRID() do { xcd_barrier(bar); xcd_barrier(bar); refresh(F); } while (0)
#else
#define SYNC_GRID() do { xcd_barrier(bar); refresh(F); } while (0)
#endif
__device__ __forceinline__ int modrow_of(int row) { const int b = row / TPB, t = row - b * TPB; return t < CTX ? 8 : b; }

enum { MAP_ID = 0, MAP_ATTN_IN, MAP_SSM_IN, MAP_MLA_IN, MAP_MLA_QUP, MAP_MOE_G, MAP_MOE_U };
template <int KIND> __device__ __forceinline__ int map_row(int n, int aux) {
    if (KIND == MAP_ID) return aux + n;
    if (KIND == MAP_ATTN_IN) { if (n >= 1280) return n; const int hb = n & ~63, d = n & 63; return hb + (d < 32 ? 2 * d : 2 * (d - 32) + 1); }
    if (KIND == MAP_SSM_IN) {
        if (n < 2048) { const int gp = n >> 10; return gp * 2816 + (n & 1023); }
        if (n < 4096) { const int c = n - 2048, gp = c >> 10; return gp * 2816 + 1024 + (c & 1023); }
        if (n < 4608) { const int c = n - 4096, gp = c >> 8; return gp * 2816 + 2048 + (c & 255); }
        if (n < 5120) { const int c = n - 4608, gp = c >> 8; return gp * 2816 + 2304 + (c & 255); }
        { const int c = n - 5120, dir = c >> 5, h = c & 31, gp = h >> 4; return gp * 2816 + 2560 + dir * 16 + (h & 15); }
    }
    if (KIND == MAP_MLA_IN) { if (n < 512) return n; const int d = n - 512; return 512 + (d < 16 ? 2 * d : 2 * (d - 16) + 1); }
    if (KIND == MAP_MLA_QUP) { const int h = n / 96, e = n - h * 96; if (e < 64) return n; const int d = e - 64; return h * 96 + 64 + (d < 16 ? 2 * d : 2 * (d - 16) + 1); }
    if (KIND == MAP_MOE_G) return aux + (n >> 7) * 256 + (n & 127);
    if (KIND == MAP_MOE_U) return aux + (n >> 7) * 256 + 128 + (n & 127);
    return n;
}
template <int KIND>
__device__ __forceinline__ void transpose_item(const float* W, int K, int N, bf16* WT, int aux, const float* kscale, LAS float* scr, int item, int lane) {
    const int nblk = N / 32, kb = item / nblk, nb = item % nblk, k0 = 64 * kb, n0 = 32 * nb;
#pragma unroll 8
    for (int i = 0; i < 32; ++i) { const int kk = 2 * i + (lane >> 5); float v = W[(size_t)(k0 + kk) * N + n0 + (lane & 31)]; if (kscale) v *= kscale[k0 + kk]; scr[kk * 33 + (lane & 31)] = v; }
    LDS_WAIT(); asm volatile("" ::: "memory");
    const int c = lane & 7;
#pragma unroll
    for (int j = 0; j < 4; ++j) { const int n = (lane >> 3) + 8 * j; const LAS float* s = scr + (8 * c) * 33 + n;
        v4u o; o.x = cvt_pk_bf16(s[0 * 33], s[1 * 33]); o.y = cvt_pk_bf16(s[2 * 33], s[3 * 33]); o.z = cvt_pk_bf16(s[4 * 33], s[5 * 33]); o.w = cvt_pk_bf16(s[6 * 33], s[7 * 33]);
        *(v4u*)(WT + (size_t)map_row<KIND>(n0 + n, aux) * K + k0 + 8 * c) = o; }
    LDS_WAIT(); asm volatile("" ::: "memory");
}
struct ConvGrid { int gw, ngw; };
__device__ __forceinline__ ConvGrid conv_all(Frame& F) { ConvGrid g; g.gw = F.vcu * NWAVES + F.wave; g.ngw = GRID * NWAVES; return g; }
template <int KIND>
__device__ __forceinline__ void convert_matrix(Frame& F, ConvGrid cg, const float* W, int K, int N, bf16* WT, int aux, const float* kscale) {
    LAS float* scr = (LAS float*)(F.lds + F.wave * 16384);
    const int nitems = (K / 64) * (N / 32);
    for (int it = cg.gw; it < nitems; it += cg.ngw) transpose_item<KIND>(W, K, N, WT, aux, kscale, scr, it, F.lane);
}
__device__ __forceinline__ void zero_rows(Frame& F, ConvGrid cg, bf16* WT, int row0, int nrows, int K) {
    const size_t n16 = (size_t)nrows * K / 8; v4u* p = (v4u*)(WT + (size_t)row0 * K);
    for (size_t i = (size_t)cg.gw * 64 + F.lane; i < n16; i += (size_t)cg.ngw * 64) p[i] = (v4u){0u, 0u, 0u, 0u};
}
__device__ __forceinline__ void convert_moe(Frame& F, ConvGrid cg, const float* const* in, int layer) {
    bf16* GU = (bf16*)(F.ws + WS_WGU + wofs(layer)); bf16* DN = (bf16*)(F.ws + WS_WDN + wofs(layer));
    const float* wg = in[12] + (size_t)layer * 16 * 1024 * 256; const float* wu = in[13] + (size_t)layer * 16 * 1024 * 256; const float* wd = in[14] + (size_t)layer * 16 * 256 * 1024;
    LAS float* scr = (LAS float*)(F.lds + F.wave * 16384);
    for (int it = cg.gw; it < 16 * 384; it += cg.ngw) { const int e = it / 384, r = it - e * 384, kind = r >> 7, sub = r & 127;
        if (kind == 0) transpose_item<MAP_MOE_G>(wg + (size_t)e * 1024 * 256, 1024, 256, GU, e * 512, nullptr, scr, sub, F.lane);
        else if (kind == 1) transpose_item<MAP_MOE_U>(wu + (size_t)e * 1024 * 256, 1024, 256, GU, e * 512, nullptr, scr, sub, F.lane);
        else transpose_item<MAP_ID>(wd + (size_t)e * 256 * 1024, 256, 1024, DN, e * 1024, nullptr, scr, sub, F.lane); }
}
__device__ __forceinline__ void convert_layer(Frame& F, ConvGrid cg, const float* const* in, int layer) {
    bf16* WM = (bf16*)(F.ws + WS_WMIX + wofs(layer));
    if (layer == 0) { convert_matrix<MAP_ATTN_IN>(F, cg, in[15], 1024, 1536, WM, 0, nullptr); convert_matrix<MAP_ID>(F, cg, in[17], 1024, 1024, WM + 2 * MiB, 0, nullptr); }
    else if (layer == 1) { convert_matrix<MAP_SSM_IN>(F, cg, in[18], 1024, 5184, WM, 0, nullptr); zero_rows(F, cg, WM, 2592, 224, 1024); zero_rows(F, cg, WM, 2816 + 2592, 224, 1024);
        convert_matrix<MAP_ID>(F, cg, in[25], 2048, 1024, WM + 6 * MiB, 0, nullptr); }
    else if (layer == 2) { convert_matrix<MAP_ID>(F, cg, in[26], 1024, 3104, WM, 0, nullptr); zero_rows(F, cg, WM, 3104, 224, 1024); convert_matrix<MAP_ID>(F, cg, in[29], 1024, 1024, WM + 4 * MiB, 0, nullptr); }
    else { convert_matrix<MAP_MLA_IN>(F, cg, in[30], 1024, 544, WM, 0, nullptr); zero_rows(F, cg, WM, 544, 224, 1024);
        convert_matrix<MAP_MLA_QUP>(F, cg, in[32], 256, 1536, WM + 1 * MiB, 0, in[31]); convert_matrix<MAP_ID>(F, cg, in[34], 256, 2048, WM + 2 * MiB, 0, in[33]);
        convert_matrix<MAP_ID>(F, cg, in[35], 1024, 1024, WM + 3 * MiB, 0, nullptr); }
    convert_moe(F, cg, in, layer);
}

__device__ __forceinline__ const float* src_row(const float* const* in, int r) { const int b = r / TPB, t = r - b * TPB; return t < CTX ? in[2] + ((size_t)b * CTX + t) * D : in[0] + ((size_t)b * SEQ + (t - CTX)) * D; }
__device__ __forceinline__ float row_load_ss(const bf16* xrow, int lane, f32x4 (&v)[4]) {
    const v4u a = *((const v4u*)xrow + lane), b = *((const v4u*)xrow + 64 + lane);
    v[0] = (f32x4){bflo(a.x), bfhi(a.x), bflo(a.y), bfhi(a.y)}; v[1] = (f32x4){bflo(a.z), bfhi(a.z), bflo(a.w), bfhi(a.w)};
    v[2] = (f32x4){bflo(b.x), bfhi(b.x), bflo(b.y), bfhi(b.y)}; v[3] = (f32x4){bflo(b.z), bfhi(b.z), bflo(b.w), bfhi(b.w)};
    float s = 0.f;
#pragma unroll
    for (int j = 0; j < 4; ++j) s += (v[j].x * v[j].x + v[j].y * v[j].y) + (v[j].z * v[j].z + v[j].w * v[j].w);
    return s;
}
__device__ __forceinline__ float row_load_ss_f32(const float* xrow, int lane, f32x4 (&v)[4]) {
    float s = 0.f;
#pragma unroll
    for (int j = 0; j < 2; ++j) { v[2 * j] = *(const f32x4*)(xrow + 512 * j + 8 * lane); v[2 * j + 1] = *(const f32x4*)(xrow + 512 * j + 8 * lane + 4); }
#pragma unroll
    for (int j = 0; j < 4; ++j) s += (v[j].x * v[j].x + v[j].y * v[j].y) + (v[j].z * v[j].z + v[j].w * v[j].w);
    return s;
}
__device__ __forceinline__ void row_finish(const f32x4 (&v)[4], float ss, const float* g, const float* sc, const float* sh, bf16* orow, int lane, f32x4 (&hv)[4]) {
    const float rstd = rsqrtf(ss * (1.f / D) + EPS);
#pragma unroll
    for (int j = 0; j < 2; ++j) {
#pragma unroll
        for (int q = 0; q < 2; ++q) { const int o = 512 * j + 8 * lane + 4 * q;
            hv[2 * j + q] = v[2 * j + q] * rstd * *(const f32x4*)(g + o) * (*(const f32x4*)(sc + o) + 1.0f) + *(const f32x4*)(sh + o); }
        *((v4u*)orow + 64 * j + lane) = pack8(hv[2 * j], hv[2 * j + 1]);
    }
}
struct ModRegs { f32x4 a[4], b[4]; };
__device__ __forceinline__ void mod_load(ModRegs& Mr, const float* g, const float* sc, const float* sh, int lane) {
#pragma unroll
    for (int j = 0; j < 4; ++j) { const int o = 512 * (j >> 1) + 8 * lane + 4 * (j & 1); Mr.a[j] = *(const f32x4*)(g + o) * (*(const f32x4*)(sc + o) + 1.0f); Mr.b[j] = *(const f32x4*)(sh + o); }
}
__device__ __forceinline__ void row_finish_regs(const f32x4 (&v)[4], float ss, const ModRegs& Mr, bf16* orow, int lane, f32x4 (&hv)[4]) {
    const float rstd = rsqrtf(ss * (1.f / D) + EPS);
#pragma unroll
    for (int j = 0; j < 4; ++j) hv[j] = v[j] * rstd * Mr.a[j] + Mr.b[j];
    *((v4u*)orow + lane) = pack8(hv[0], hv[1]); *((v4u*)orow + 64 + lane) = pack8(hv[2], hv[3]);
}
__device__ __forceinline__ void phase_norm1(Frame& F, const float* const* in, int layer) {
    const bf16* X = (const bf16*)(F.ws + WS_X); bf16* H = (bf16*)(F.ws + WS_H);
    const float* g = in[4] + layer * D; const float* mod = (const float*)(F.ws + WS_MOD) + (size_t)layer * 9 * 6144;
    const int gw = F.vcu * NWAVES + F.wave; constexpr int RPWV = M / (GRID * NWAVES);
    const int rbase = gw * RPWV; int cur = -1; ModRegs Mr;
    for (int k0 = 0; k0 < RPWV; k0 += 4) { f32x4 v[4][4], hv[4]; float ss[4]; int rr[4];
#pragma unroll
        for (int q = 0; q < 4; ++q) { rr[q] = (k0 + q < RPWV) ? rbase + k0 + q : rbase + k0; ss[q] = layer == 0 ? row_load_ss_f32(src_row(in, rr[q]), F.lane, v[q]) : row_load_ss(X + (size_t)rr[q] * D, F.lane, v[q]); }
#pragma unroll
        for (int q = 0; q < 4; ++q) ss[q] = wave_sum(ss[q]);
#pragma unroll
        for (int q = 0; q < 4; ++q) { if (q == 0 || k0 + q < RPWV) { const int mr = modrow_of(rr[q]);
                if (mr != cur) { cur = mr; const float* mp = mod + (size_t)mr * 6144; mod_load(Mr, g, mp + 1024, mp, F.lane); }
                row_finish_regs(v[q], ss[q], Mr, H + (size_t)rr[q] * D, F.lane, hv); } } }
}

__device__ __forceinline__ void phase_mod(Frame& F, const float* const* in, const int l0, const int l1, const int u0, const int ustride) {
    LAS float* sc = (LAS float*)F.lds;
    LAS float* part = (LAS float*)(F.lds + 40960);
    for (int i = F.tid; i < 9 * 1024; i += NTHR) { const int r = i >> 10, k = i & 1023; const float c = r < 8 ? in[1][r * 1024 + k] : in[3][k]; sc[i] = silu_f(c); }
    __syncthreads();
    float* MOD = (float*)(F.ws + WS_MOD);
    const int cq = F.tid & 15, ks = F.tid >> 4;
    for (int u = u0; u < (l1 - l0) * 96; u += ustride) { const int l = l0 + u / 96, cb = u % 96;
        const float* w = in[6] + (size_t)l * 1024 * 6144 + cb * 64 + cq * 4; f32x4 a[9];
#pragma unroll
        for (int r = 0; r < 9; ++r) a[r] = (f32x4){0.f, 0.f, 0.f, 0.f};
#pragma unroll 8
        for (int k = ks * 32; k < ks * 32 + 32; ++k) { const f32x4 wv = *(const f32x4*)(w + (size_t)k * 6144);
#pragma unroll
            for (int r = 0; r < 9; ++r) a[r] = a[r] + wv * sc[r * 1024 + k]; }
#pragma unroll
        for (int r = 0; r < 9; ++r) *(LAS f32x4*)(part + (ks * 9 + r) * 64 + cq * 4) = a[r];
        __syncthreads();
        for (int i = F.tid; i < 9 * 64; i += NTHR) { const int r = i >> 6, c = i & 63; float s = 0.f;
#pragma unroll
            for (int q = 0; q < 32; ++q) s += part[(q * 9 + r) * 64 + c];
            const float mv = s + in[7][l * 6144 + cb * 64 + c]; MOD[((size_t)l * 9 + r) * 6144 + cb * 64 + c] = mv;
            if (cb >= 80) ((bf16*)(F.ws + WS_MODB))[((size_t)l * 9 + r) * 1024 + (cb - 80) * 64 + c] = f2bf(mv); }
        __syncthreads(); }
}
__device__ __forceinline__ void phase_prologue(Frame& F, const float* const* in) {
    { f32x2* TA = (f32x2*)(F.ws + WS_TABA); f32x2* TM = (f32x2*)(F.ws + WS_TABM);
      for (int i = blockIdx.x * NTHR + F.tid; i < SEQ * 32; i += GRID * NTHR) { const int pos = i >> 5, a = i & 31; const float p = (a < 16) ? (float)(pos >> 6) : (float)(pos & 63);
          const float inv = fast_exp2(-(float)(a & 15) * (13.287712379549449f / 16.0f)); const float rev = p * inv * 0.15915494309189535f; TA[i] = (f32x2){__builtin_amdgcn_cosf(rev), __builtin_amdgcn_sinf(rev)}; }
      for (int i = blockIdx.x * NTHR + F.tid; i < SEQ * 16; i += GRID * NTHR) { const int pos = i >> 4, a = i & 15; const float p = (a < 8) ? (float)(pos >> 6) : (float)(pos & 63);
          const float inv = fast_exp2(-(float)(a & 7) * (13.287712379549449f / 8.0f)); const float rev = p * inv * 0.15915494309189535f; TM[i] = (f32x2){__builtin_amdgcn_cosf(rev), __builtin_amdgcn_sinf(rev)}; } }
    phase_mod(F, in, 0, 1, F.vcu, GRID);
}

__device__ __forceinline__ void phase_norm2_route(Frame& F, const float* const* in, int layer, bool dry = false) {
    constexpr int RPW = M / GRID;
    LAS float* wl = (LAS float*)F.lds;
    LAS int* lcnt = (LAS int*)(F.lds + 81920);
    LAS int* lbase = (LAS int*)(F.lds + 81920 + 128);
    LAS int* rcls = (LAS int*)(F.lds + 81920 + 256);
    LAS int* rrank = (LAS int*)(F.lds + 81920 + 256 + 1024);
    LAS float* lgw = (LAS float*)(F.lds + 81920 + 4096);
    const float* wrg = in[8] + (size_t)layer * 1024 * 4; const float* wre = in[10] + (size_t)layer * 1024 * 16;
#pragma unroll
    for (int m = 0; m < 2; ++m) { const int k = F.tid + NTHR * m; const f32x4 w = *(const f32x4*)(wrg + k * 4);
        wl[0 * 1024 + k] = w.x; wl[1 * 1024 + k] = w.y; wl[2 * 1024 + k] = w.z; wl[3 * 1024 + k] = w.w; }
#pragma unroll
    for (int o4 = 0; o4 < 4; ++o4)
#pragma unroll
        for (int m = 0; m < 2; ++m) { const int k = F.tid + NTHR * m; const f32x4 w = *(const f32x4*)(wre + k * 16 + 4 * o4);
            wl[(4 + 4 * o4 + 0) * 1024 + k] = w.x; wl[(4 + 4 * o4 + 1) * 1024 + k] = w.y; wl[(4 + 4 * o4 + 2) * 1024 + k] = w.z; wl[(4 + 4 * o4 + 3) * 1024 + k] = w.w; }
    LAS float* rbias = (LAS float*)(F.lds + 81920 + 8192);
    if (F.tid < 24) lcnt[F.tid] = 0;
    if (F.tid < 4) rbias[F.tid] = (in[9] + layer * 4)[F.tid]; else if (F.tid < 20) rbias[F.tid] = (in[11] + layer * 16)[F.tid - 4];
    __syncthreads();
    const bf16* X = (const bf16*)(F.ws + WS_X); bf16* H = (bf16*)(F.ws + WS_H);
    const float* g = in[5] + layer * D; const float* mod = (const float*)(F.ws + WS_MOD) + (size_t)layer * 9 * 6144;
    float* WT = (float*)(F.ws + MOE_WT); int* SL = (int*)(F.ws + MOE_SL);
    const int row0 = blockIdx.x * RPW; int curm = -1; ModRegs Mr;
    for (int i0 = F.wave; i0 < RPW; i0 += 2 * NWAVES) { const int i1 = i0 + NWAVES; const bool two = i1 < RPW; const int ra = row0 + i0, rb = two ? row0 + i1 : ra;
        f32x4 va[4], vb[4], ha[4], hb[4];
        float sa = row_load_ss(X + (size_t)ra * D, F.lane, va), sb = row_load_ss(X + (size_t)rb * D, F.lane, vb);
        sa = wave_sum(sa); sb = wave_sum(sb);
        { const int mra = modrow_of(ra); if (mra != curm) { curm = mra; const float* mp = mod + (size_t)mra * 6144; mod_load(Mr, g, mp + 4 * 1024, mp + 3 * 1024, F.lane); }
          row_finish_regs(va, sa, Mr, H + (size_t)ra * D, F.lane, ha); }
        { const int mrb = modrow_of(rb); if (mrb != curm) { curm = mrb; const float* mp = mod + (size_t)mrb * 6144; mod_load(Mr, g, mp + 4 * 1024, mp + 3 * 1024, F.lane); }
          row_finish_regs(vb, sb, Mr, H + (size_t)rb * D, F.lane, hb); }
        float ga[4], gb[4];
#pragma unroll
        for (int o = 0; o < 4; ++o) { float s = 0.f, t = 0.f;
#pragma unroll
            for (int j = 0; j < 4; ++j) { const f32x4 w = *(const LAS f32x4*)(wl + o * 1024 + 512 * (j >> 1) + 8 * F.lane + 4 * (j & 1));
                s += (ha[j].x * w.x + ha[j].y * w.y) + (ha[j].z * w.z + ha[j].w * w.w); t += (hb[j].x * w.x + hb[j].y * w.y) + (hb[j].z * w.z + hb[j].w * w.w); }
            ga[o] = wave_sum(s) + rbias[o]; gb[o] = wave_sum(t) + rbias[o]; }
        for (int q = 0; q < (two ? 2 : 1); ++q) { const int r = q ? rb : ra, i = q ? i1 : i0;
        const float g0 = q ? gb[0] : ga[0], g1 = q ? gb[1] : ga[1], g2 = q ? gb[2] : ga[2], g3 = q ? gb[3] : ga[3];
        int gs = 0; float gm = g0; if (g1 > gm) { gm = g1; gs = 1; } if (g2 > gm) { gm = g2; gs = 2; } if (g3 > gm) { gm = g3; gs = 3; }
        const float pg = 1.0f / (fast_exp(g0 - gm) + fast_exp(g1 - gm) + fast_exp(g2 - gm) + fast_exp(g3 - gm));
        float ev[4];
#pragma unroll
        for (int o = 0; o < 4; ++o) { float s = 0.f; const LAS float* wrow = wl + (4 + gs * 4 + o) * 1024;
#pragma unroll
            for (int j = 0; j < 4; ++j) { const f32x4 w = *(const LAS f32x4*)(wrow + 512 * (j >> 1) + 8 * F.lane + 4 * (j & 1)); const f32x4 hq = q ? hb[j] : ha[j];
                s += (hq.x * w.x + hq.y * w.y) + (hq.z * w.z + hq.w * w.w); }
            ev[o] = wave_sum(s) + rbias[4 + gs * 4 + o]; }
        const float e0 = ev[0], e1 = ev[1], e2 = ev[2], e3 = ev[3];
        int i1x = 0; float v1 = e0; if (e1 > v1) { v1 = e1; i1x = 1; } if (e2 > v1) { v1 = e2; i1x = 2; } if (e3 > v1) { v1 = e3; i1x = 3; }
        int i2x = -1; float v2 = -3.0e38f;
        if (i1x != 0 && e0 > v2) { v2 = e0; i2x = 0; } if (i1x != 1 && e1 > v2) { v2 = e1; i2x = 1; } if (i1x != 2 && e2 > v2) { v2 = e2; i2x = 2; } if (i1x != 3 && e3 > v2) { v2 = e3; i2x = 3; }
        const float ex = fast_exp(v2 - v1), w1 = pg / (1.0f + ex), w2 = pg * ex / (1.0f + ex);
        const int lo = i1x < i2x ? i1x : i2x, hi = i1x < i2x ? i2x : i1x; const float wlo = i1x < i2x ? w1 : w2, whi = i1x < i2x ? w2 : w1;
        const int pair = lo == 0 ? hi - 1 : (lo == 1 ? hi + 1 : 5);
        const int cls = gs * 6 + pair;
        if (F.lane == 0 && !dry) { WT[2 * (size_t)r] = wlo; WT[2 * (size_t)r + 1] = whi; rcls[i] = cls; rrank[i] = atomicAdd((int*)&lcnt[cls], 1); }
        }
        LDS_WAIT(); asm volatile("" ::: "memory");
    }
    __syncthreads();
    if (dry) return;
    if (F.tid < 24) lbase[F.tid] = (int)atomicAdd(F.ctl + CW_MOECNT + layer * 64 + F.tid, (unsigned)lcnt[F.tid]);
    __syncthreads();
    for (int i = F.tid; i < RPW; i += NTHR) { const int c = rcls[i]; SL[(size_t)c * M + lbase[c] + rrank[i]] = row0 + i; }
}

__device__ __forceinline__ void phase_final(Frame& F, const float* const* in, bool poison) {
    const bf16* X = (const bf16*)(F.ws + WS_X); const float* g = in[36];
    const int gw = F.vcu * NWAVES + F.wave, NGW = GRID * NWAVES;
    f32x4 gg[4];
#pragma unroll
    for (int j = 0; j < 4; ++j) gg[j] = *(const f32x4*)(g + 512 * (j >> 1) + 8 * F.lane + 4 * (j & 1));
    for (int q0 = gw; q0 < NB * SEQ; q0 += 4 * NGW) { f32x4 v[4][4]; float ss[4];
#pragma unroll
        for (int k = 0; k < 4; ++k) { const int q = q0 + k * NGW; ss[k] = row_load_ss(X + (size_t)((q / SEQ) * TPB + CTX + (q % SEQ)) * D, F.lane, v[k]); }
#pragma unroll
        for (int k = 0; k < 4; ++k) ss[k] = wave_sum(ss[k]);
#pragma unroll
        for (int k = 0; k < 4; ++k) { float rs = rsqrtf(ss[k] * (1.f / D) + EPS); if (poison) rs = __builtin_nanf(""); float* op = F.out + (size_t)(q0 + k * NGW) * D;
#pragma unroll
            for (int j = 0; j < 4; ++j) { const int o = 512 * (j >> 1) + 8 * F.lane + 4 * (j & 1); *(f32x4*)(op + o) = v[k][j] * rs * gg[j]; } } }
}
typedef f32x4 AccT[2][2][4][2];
using pg8::Unit;

__device__ __forceinline__ void rope8c(f32x4& a, f32x4& b, const f32x4 c01, const f32x4 c23) {
    float t;
    t = a[0] * c01[0] - a[1] * c01[1]; a[1] = a[1] * c01[0] + a[0] * c01[1]; a[0] = t;
    t = a[2] * c01[2] - a[3] * c01[3]; a[3] = a[3] * c01[2] + a[2] * c01[3]; a[2] = t;
    t = b[0] * c23[0] - b[1] * c23[1]; b[1] = b[1] * c23[0] + b[0] * c23[1]; b[0] = t;
    t = b[2] * c23[2] - b[3] * c23[3]; b[3] = b[3] * c23[2] + b[2] * c23[3]; b[2] = t;
}
__device__ __forceinline__ void rope8(f32x4& a, f32x4& b, const f32x2* cs) {
    const f32x4 c01 = *(const f32x4*)cs, c23 = *(const f32x4*)(cs + 2);
    float t;
    t = a[0] * c01[0] - a[1] * c01[1]; a[1] = a[1] * c01[0] + a[0] * c01[1]; a[0] = t;
    t = a[2] * c01[2] - a[3] * c01[3]; a[3] = a[3] * c01[2] + a[2] * c01[3]; a[2] = t;
    t = b[0] * c23[0] - b[1] * c23[1]; b[1] = b[1] * c23[0] + b[0] * c23[1]; b[0] = t;
    t = b[2] * c23[2] - b[3] * c23[3]; b[3] = b[3] * c23[2] + b[2] * c23[3]; b[2] = t;
}

__device__ __forceinline__ void unpack8(const v4u w, f32x4& a, f32x4& b) { a = (f32x4){bflo(w.x), bfhi(w.x), bflo(w.y), bfhi(w.y)}; b = (f32x4){bflo(w.z), bfhi(w.z), bflo(w.w), bfhi(w.w)}; }
struct EpiResid {
    static constexpr bool PERM = true;
    bf16* X; const float* gate; const float* x_in; const float* ctx_in;
    __device__ __forceinline__ void operator()(const AccT& acc, const Unit& u, int ui, int wr, int wc, int fr, int fq) const {
        const int tb = u.pm % 17, b = u.pm / 17; const float* gv = gate + (size_t)(tb == 0 ? 8 : b) * 6144;
        const float* src = x_in ? (tb == 0 ? ctx_in + (size_t)b * CTX * D : x_in + ((size_t)b * SEQ + (tb - 1) * 256) * D) : nullptr;
        const int rl0 = wr * 64 + fr, col0 = u.pn * 256 + wc * 32 + 8 * fq;
        f32x4 g4[2][2];
#pragma unroll
        for (int bj = 0; bj < 2; ++bj)
#pragma unroll
            for (int n = 0; n < 2; ++n) g4[bj][n] = *(const f32x4*)(gv + col0 + bj * 128 + n * 4);
        if (!src) {
            v4u raw[2][2][2][2];
#pragma unroll
            for (int ai = 0; ai < 2; ++ai)
#pragma unroll
                for (int mp = 0; mp < 2; ++mp)
#pragma unroll
                    for (int mm = 0; mm < 2; ++mm) { const int rl = rl0 + ai * 128 + (2 * mp + mm) * 16;
#pragma unroll
                        for (int bj = 0; bj < 2; ++bj) raw[ai][mp][mm][bj] = *(const v4u*)(X + ((size_t)u.pm * 256 + rl) * D + col0 + bj * 128); }
#pragma unroll
            for (int ai = 0; ai < 2; ++ai)
#pragma unroll
                for (int mp = 0; mp < 2; ++mp) {
#pragma unroll
                    for (int mm = 0; mm < 2; ++mm) { const int rl = rl0 + ai * 128 + (2 * mp + mm) * 16;
#pragma unroll
                        for (int bj = 0; bj < 2; ++bj) { f32x4 x0, x1; unpack8(raw[ai][mp][mm][bj], x0, x1);
                            *(v4u*)(X + ((size_t)u.pm * 256 + rl) * D + col0 + bj * 128) = pack8(x0 + g4[bj][0] * acc[ai][bj][2 * mp + mm][0], x1 + g4[bj][1] * acc[ai][bj][2 * mp + mm][1]); } }
                    asm volatile("" ::: "memory"); }
            return; }
#pragma unroll
        for (int ai = 0; ai < 2; ++ai) { f32x4 xin[2][2][2][2];
#pragma unroll
            for (int mp = 0; mp < 2; ++mp)
#pragma unroll
                for (int mm = 0; mm < 2; ++mm) { const int rl = rl0 + ai * 128 + (2 * mp + mm) * 16;
#pragma unroll
                    for (int bj = 0; bj < 2; ++bj) { const float* sp = src + (size_t)rl * D + col0 + bj * 128; xin[mp][mm][bj][0] = *(const f32x4*)sp; xin[mp][mm][bj][1] = *(const f32x4*)(sp + 4); } }
#pragma unroll
            for (int mp = 0; mp < 2; ++mp) {
#pragma unroll
                for (int mm = 0; mm < 2; ++mm) { const int rl = rl0 + ai * 128 + (2 * mp + mm) * 16;
#pragma unroll
                    for (int bj = 0; bj < 2; ++bj) *(v4u*)(X + ((size_t)u.pm * 256 + rl) * D + col0 + bj * 128) =
                        pack8(xin[mp][mm][bj][0] + g4[bj][0] * acc[ai][bj][2 * mp + mm][0], xin[mp][mm][bj][1] + g4[bj][1] * acc[ai][bj][2 * mp + mm][1]); }
                asm volatile("" ::: "memory"); } }
    }
};

struct EpiAttnIn {
    static constexpr bool PERM = true;
    bf16 *Q, *Kb, *Vb; const f32x2* tab; float qscale;
    __device__ __forceinline__ void operator()(const AccT& acc, const Unit& u, int ui, int wr, int wc, int fr, int fq) const {
        const int tb = u.pm % 17; const bool lat = tb != 0; const int pos0 = (tb - 1) * 256;
        bf16* base; int ld, colt; float sc = 1.f; bool rope = lat;
        if (u.pn < 4) { base = Q; ld = 1024; colt = u.pn * 256; sc = qscale; } else if (u.pn == 4) { base = Kb; ld = 256; colt = 0; } else { base = Vb; ld = 256; colt = 0; rope = false; }
#pragma unroll
        for (int ai = 0; ai < 2; ++ai) {
            f32x4 rc[4][2];
            if (rope) {
#pragma unroll
                for (int m = 0; m < 4; ++m) { const f32x2* cs = tab + (size_t)(pos0 + ai * 128 + wr * 64 + m * 16 + fr) * 32 + (((wc * 32 + 8 * fq) & 63) >> 1); rc[m][0] = *(const f32x4*)cs; rc[m][1] = *(const f32x4*)(cs + 2); } }
#pragma unroll
            for (int m = 0; m < 4; ++m) { const int rl = ai * 128 + wr * 64 + m * 16 + fr; const size_t row = (size_t)u.pm * 256 + rl;
#pragma unroll
                for (int bj = 0; bj < 2; ++bj) { const int cl = bj * 128 + wc * 32 + 8 * fq;
                    f32x4 a = acc[ai][bj][m][0] * sc, b = acc[ai][bj][m][1] * sc;
                    if (rope) rope8c(a, b, rc[m][0], rc[m][1]);
                    *(v4u*)(base + row * ld + colt + cl) = pack8(a, b); }
                asm volatile("" ::: "memory"); } }
    }
};

struct EpiSsmIn {
    static constexpr bool PERM = true;
    bf16 *Z, *XBC; float* DT; const float* dtb;
    __device__ __forceinline__ void operator()(const AccT& acc, const Unit& u, int ui, int wr, int wc, int fr, int fq) const {
#pragma unroll
        for (int ai = 0; ai < 2; ++ai)
#pragma unroll
            for (int m = 0; m < 4; ++m) { const size_t row = (size_t)u.pm * 256 + ai * 128 + wr * 64 + m * 16 + fr;
#pragma unroll
                for (int bj = 0; bj < 2; ++bj) { const int c = u.pn * 256 + bj * 128 + wc * 32 + 8 * fq;
                    const f32x4 a = acc[ai][bj][m][0], b = acc[ai][bj][m][1];
                    if (c < 1024) *(v4u*)(Z + row * 1024 + c) = pack8(a, b);
                    else if (c < 2560) *(v4u*)(XBC + row * 1536 + (c - 1024)) = pack8(a, b);
                    else if (c < 2592) { const int cc = c - 2560; f32x4 o0, o1;
#pragma unroll
                        for (int j = 0; j < 4; ++j) { o0[j] = softplus_f(a[j] + dtb[(cc >> 4) * 32 + (cc & 15) + j]); o1[j] = softplus_f(b[j] + dtb[(cc >> 4) * 32 + (cc & 15) + 4 + j]); }
                        *(f32x4*)(DT + row * 32 + cc) = o0; *(f32x4*)(DT + row * 32 + cc + 4) = o1; } } }
    }
};

struct EpiMlIn {
    static constexpr bool PERM = true;
    bf16 *Qm, *Km, *Vm, *Om; float* G; const float* gb;
    __device__ __forceinline__ void operator()(const AccT& acc, const Unit& u, int ui, int wr, int wc, int fr, int fq) const {
#pragma unroll
        for (int ai = 0; ai < 2; ++ai)
#pragma unroll
            for (int m = 0; m < 4; ++m) { const size_t row = (size_t)u.pm * 256 + ai * 128 + wr * 64 + m * 16 + fr;
#pragma unroll
                for (int bj = 0; bj < 2; ++bj) { const int c = u.pn * 256 + bj * 128 + wc * 32 + 8 * fq;
                    const f32x4 a = acc[ai][bj][m][0], b = acc[ai][bj][m][1];
                    if (c < 512) *(v4u*)(Qm + row * 512 + c) = pack8(a, b);
                    else if (c < 1024) *(v4u*)(Km + row * 512 + (c - 512)) = pack8(a * 0.125f, b * 0.125f);
                    else if (c < 2048) *(v4u*)(Vm + row * 1024 + (c - 1024)) = pack8(a, b);
                    else if (c < 3072) *(v4u*)(Om + row * 1024 + (c - 2048)) = pack8(a, b);
                    else if (c < 3104) { const int cc = c - 3072; f32x4 o0, o1; const bool fg = ((cc >> 3) & 1) != 0;
#pragma unroll
                        for (int j = 0; j < 4; ++j) { float x0 = a[j] + gb[cc + j], x1 = b[j] + gb[cc + 4 + j];
                            o0[j] = fg ? -softplus_f(-x0) : x0; o1[j] = fg ? -softplus_f(-x1) : x1; }
                        *(f32x4*)(G + row * 32 + cc) = o0; *(f32x4*)(G + row * 32 + cc + 4) = o1; } } }
    }
};

struct EpiMlaIn {
    static constexpr bool PERM = true;
    bf16 *CQ, *CKV, *KF; float* SSQ; const f32x2* tab;
    __device__ __forceinline__ void operator()(const AccT& acc, const Unit& u, int ui, int wr, int wc, int fr, int fq) const {
        const int tb = u.pm % 17; const bool lat = tb != 0; const int pos0 = (tb - 1) * 256;
#pragma unroll
        for (int ai = 0; ai < 2; ++ai)
#pragma unroll
            for (int m = 0; m < 4; ++m) { const int rl = ai * 128 + wr * 64 + m * 16 + fr; const size_t row = (size_t)u.pm * 256 + rl;
                if (u.pn < 2) { bf16* dst = u.pn == 0 ? CQ : CKV; float ss = 0.f;
#pragma unroll
                    for (int bj = 0; bj < 2; ++bj) { const int c = bj * 128 + wc * 32 + 8 * fq; const f32x4 a = acc[ai][bj][m][0], b = acc[ai][bj][m][1];
                        ss += (a[0] * a[0] + a[1] * a[1]) + (a[2] * a[2] + a[3] * a[3]) + (b[0] * b[0] + b[1] * b[1]) + (b[2] * b[2] + b[3] * b[3]);
                        *(v4u*)(dst + row * 256 + c) = pack8(a, b); }
                    ss += __shfl_xor(ss, 16); ss += __shfl_xor(ss, 32);
                    if (fq == 0) SSQ[row * 8 + u.pn * 4 + wc] = ss;
                } else if (wc == 0) {
                    f32x4 a = acc[ai][0][m][0], b = acc[ai][0][m][1]; const int cl = 8 * fq;
                    if (lat) rope8(a, b, tab + (size_t)(pos0 + rl) * 16 + (cl >> 1));
                    const v4u w = pack8(a, b);
#pragma unroll
                    for (int h = 0; h < 16; ++h) *(v4u*)(KF + row * 1536 + h * 96 + 64 + cl) = w; }
                asm volatile("" ::: "memory"); }
    }
};
struct EpiMlaQ {
    static constexpr bool PERM = true;
    bf16* Q3; const float* SSQ; const f32x2* tab; float qscale;
    __device__ __forceinline__ void operator()(const AccT& acc, const Unit& u, int ui, int wr, int wc, int fr, int fq) const {
        const int tb = u.pm % 17; const bool lat = tb != 0; const int pos0 = (tb - 1) * 256;
        f32x4 sq[2][4];
#pragma unroll
        for (int ai = 0; ai < 2; ++ai)
#pragma unroll
            for (int m = 0; m < 4; ++m) sq[ai][m] = *(const f32x4*)(SSQ + ((size_t)u.pm * 256 + ai * 128 + wr * 64 + m * 16 + fr) * 8);
        const int e0 = (u.pn * 256 + wc * 32 + 8 * fq) % 96, e1 = (u.pn * 256 + 128 + wc * 32 + 8 * fq) % 96; const int er = e0 >= 64 ? e0 : e1; const bool anyr = lat && er >= 64;
#pragma unroll
        for (int ai = 0; ai < 2; ++ai) {
            f32x4 rc[4][2];
            if (anyr) {
#pragma unroll
                for (int m = 0; m < 4; ++m) { const f32x2* cs = tab + (size_t)(pos0 + ai * 128 + wr * 64 + m * 16 + fr) * 16 + ((er - 64) >> 1); rc[m][0] = *(const f32x4*)cs; rc[m][1] = *(const f32x4*)(cs + 2); } }
#pragma unroll
            for (int m = 0; m < 4; ++m) { const int rl = ai * 128 + wr * 64 + m * 16 + fr; const size_t row = (size_t)u.pm * 256 + rl;
                const f32x4 s4 = sq[ai][m]; const float rs = rsqrtf(((s4[0] + s4[1]) + (s4[2] + s4[3])) * (1.f / 256.f) + EPS) * qscale;
#pragma unroll
                for (int bj = 0; bj < 2; ++bj) { const int c = u.pn * 256 + bj * 128 + wc * 32 + 8 * fq; const int e = bj ? e1 : e0;
                    f32x4 a = acc[ai][bj][m][0] * rs, b = acc[ai][bj][m][1] * rs;
                    if (lat && e >= 64) rope8c(a, b, rc[m][0], rc[m][1]);
                    *(v4u*)(Q3 + row * 1536 + c) = pack8(a, b); }
                asm volatile("" ::: "memory"); } }
    }
};
struct EpiMlaKV {
    static constexpr bool PERM = true;
    bf16 *KF, *V3; const float* SSQ;
    __device__ __forceinline__ void operator()(const AccT& acc, const Unit& u, int ui, int wr, int wc, int fr, int fq) const {
        f32x4 sq[2][4];
#pragma unroll
        for (int ai = 0; ai < 2; ++ai)
#pragma unroll
            for (int m = 0; m < 4; ++m) sq[ai][m] = *(const f32x4*)(SSQ + ((size_t)u.pm * 256 + ai * 128 + wr * 64 + m * 16 + fr) * 8 + 4);
#pragma unroll
        for (int ai = 0; ai < 2; ++ai)
#pragma unroll
            for (int m = 0; m < 4; ++m) { const size_t row = (size_t)u.pm * 256 + ai * 128 + wr * 64 + m * 16 + fr;
                const f32x4 s4 = sq[ai][m]; const float rs = rsqrtf(((s4[0] + s4[1]) + (s4[2] + s4[3])) * (1.f / 256.f) + EPS);
#pragma unroll
                for (int bj = 0; bj < 2; ++bj) { const int c = u.pn * 256 + bj * 128 + wc * 32 + 8 * fq; const int h = c >> 7, e = c & 127;
                    const v4u w = pack8(acc[ai][bj][m][0] * rs, acc[ai][bj][m][1] * rs);
                    if (e < 64) *(v4u*)(KF + row * 1536 + h * 96 + e) = w; else *(v4u*)(V3 + row * 1024 + h * 64 + (e - 64)) = w; }
                asm volatile("" ::: "memory"); }
    }
};

struct TblEnt { int tok; float w0, w1; int pad; };
__device__ __forceinline__ int cls_expert(int cls, int which) { const int g = cls / 6, p = cls - g * 6; const int lo = p < 3 ? 0 : (p < 5 ? 1 : 2), hi = p < 3 ? p + 1 : (p < 5 ? p - 1 : 3); return g * 4 + (which ? hi : lo); }
template <int MODE> struct MoeOrder {
    static constexpr bool GATHER = (MODE == 0);
    const LAS int* tb;
    const LAS unsigned char* tcls;
    const LAS TblEnt* tbl;
    const bf16* W; int G, c;
    __device__ __forceinline__ bool next(int i, Unit& u) const {
        const int L = i * G + c, tile = L >> 2; if (tile >= tb[24]) return false;
        const int cls = tcls[tile];
        u.pm = tile; u.pn = L & 3; u.aux = cls | (i << 8); return true;
    }
    __device__ __forceinline__ int a_row(const Unit& u, int r) const {
        if (MODE == 1) return u.pm * 256 + r;
        const int t = tbl[(u.aux >> 8) * 256 + r].tok; return t < 0 ? 0 : t;
    }
    __device__ __forceinline__ const char* b_seg(const Unit& u, int seg) const {
        const int cls = u.aux & 255;
        if (MODE == 0) return (const char*)(W + ((size_t)cls_expert(cls, u.pn >> 1) * 512 + (u.pn & 1) * 256) * 1024);
        return (const char*)(W + ((size_t)cls_expert(cls, seg) * 1024 + u.pn * 256) * 256);
    }
};
template <int MODE> __device__ __forceinline__ void moe_setup(Frame& F, int layer, MoeOrder<MODE>& S) {
    LAS int* tb = (LAS int*)(F.lds + LDS_TB); LAS int* cn = tb + 32; LAS TblEnt* tbl = (LAS TblEnt*)(F.lds + LDS_TBL);
    if (MODE == 1) {
        S.tb = tb; S.tbl = tbl; S.tcls = (const LAS unsigned char*)(F.lds + LDS_TB + 256); __syncthreads(); return; }
    LAS unsigned char* tcls = (LAS unsigned char*)(F.lds + LDS_TB + 256);
    if (F.wave == 0) { const int k = F.lane; const int n = k < 24 ? (int)__hip_atomic_load(F.ctl + CW_MOECNT + layer * 64 + k, RLX_AGENT) : 0;
        const int nt = (n + 255) >> 8; const int incl = (int)wave_scan_sum((float)nt); const int t0 = incl - nt;
        if (k < 24) { cn[k] = n; tb[k] = t0; for (int t = t0; t < incl; ++t) tcls[t] = (unsigned char)k; }
        if (k == 23) tb[24] = incl; }
    __syncthreads();
    S.tb = tb; S.tbl = tbl; S.tcls = tcls;
    const int* SL = (const int*)(F.ws + MOE_SL); const float* WT = (const float*)(F.ws + MOE_WT);
    if (F.tid < 256) { bool ok[4]; int tok[4]; f32x2 w[4];
#pragma unroll
        for (int i = 0; i < 4; ++i) { Unit u; ok[i] = S.next(i, u); tok[i] = -1;
            if (ok[i]) { const int cls = u.aux & 255, idx = (u.pm - tb[cls]) * 256 + F.tid; if (idx < cn[cls]) tok[i] = SL[(size_t)cls * M + idx]; } }
#pragma unroll
        for (int i = 0; i < 4; ++i) { w[i] = (f32x2){0.f, 0.f}; if (tok[i] >= 0) w[i] = *(const f32x2*)(WT + 2 * (size_t)tok[i]); }
#pragma unroll
        for (int i = 0; i < 4; ++i) { if (ok[i]) { LAS TblEnt* te = tbl + i * 256 + F.tid; te->tok = tok[i]; te->w0 = w[i].x; te->w1 = w[i].y; te->pad = 0; } } }
    __syncthreads();
}
struct EpiMoeAct {
    static constexpr bool PERM = true;
    bf16* ACT; const LAS TblEnt* tbl;
    __device__ __forceinline__ void operator()(const AccT& acc, const Unit& u, int ui, int wr, int wc, int fr, int fq) const {
        const int slot = u.pn >> 1, colb = slot * 256 + (u.pn & 1) * 128 + wc * 32 + 8 * fq;
        float wv[2][4];
#pragma unroll
        for (int ai = 0; ai < 2; ++ai)
#pragma unroll
            for (int m = 0; m < 4; ++m) { const LAS TblEnt* te = tbl + (u.aux >> 8) * 256 + ai * 128 + wr * 64 + m * 16 + fr; wv[ai][m] = slot ? te->w1 : te->w0; }
#pragma unroll
        for (int ai = 0; ai < 2; ++ai)
#pragma unroll
            for (int m = 0; m < 4; ++m) { const int rl = ai * 128 + wr * 64 + m * 16 + fr; const float w = wv[ai][m];
                f32x4 a, b;
#pragma unroll
                for (int j = 0; j < 4; ++j) { a[j] = silu_f(acc[ai][0][m][0][j]) * acc[ai][1][m][0][j] * w; b[j] = silu_f(acc[ai][0][m][1][j]) * acc[ai][1][m][1][j] * w; }
                *(v4u*)(ACT + ((size_t)u.pm * 256 + rl) * 512 + colb) = pack8(a, b);
                asm volatile("" ::: "memory"); }
    }
};
struct EpiMoeDown {
    static constexpr bool PERM = true;
    bf16* X; const bf16* gateb; const LAS TblEnt* tbl;
    __device__ __forceinline__ void operator()(const AccT& acc, const Unit& u, int ui, int wr, int wc, int fr, int fq) const {
        const int col0 = u.pn * 256 + wc * 32 + 8 * fq;
#pragma unroll
        for (int ai = 0; ai < 2; ++ai) {
            int tk[2][2]; v4u raw[2][2][2], gw[2][2][2];
#pragma unroll
            for (int mp = 0; mp < 2; ++mp)
#pragma unroll
                for (int mm = 0; mm < 2; ++mm) { const int rl = ai * 128 + wr * 64 + (2 * mp + mm) * 16 + fr; const int tok = tbl[(u.aux >> 8) * 256 + rl].tok; tk[mp][mm] = tok; const int t0 = tok < 0 ? 0 : tok;
                    const bf16* rowp = X + (size_t)t0 * D + col0; const bf16* gv = gateb + (size_t)modrow_of(t0) * 1024 + col0;
#pragma unroll
                    for (int bj = 0; bj < 2; ++bj) { raw[mp][mm][bj] = *(const v4u*)(rowp + bj * 128); gw[mp][mm][bj] = *(const v4u*)(gv + bj * 128); } }
#pragma unroll
            for (int mp = 0; mp < 2; ++mp) {
#pragma unroll
                for (int mm = 0; mm < 2; ++mm) { if (tk[mp][mm] >= 0) { bf16* rowp = X + (size_t)tk[mp][mm] * D + col0;
#pragma unroll
                    for (int bj = 0; bj < 2; ++bj) { f32x4 x0, x1, g0, g1; unpack8(raw[mp][mm][bj], x0, x1); unpack8(gw[mp][mm][bj], g0, g1);
                        *(v4u*)(rowp + bj * 128) = pack8(x0 + g0 * acc[ai][bj][2 * mp + mm][0], x1 + g1 * acc[ai][bj][2 * mp + mm][1]); } } }
                asm volatile("" ::: "memory"); } }
    }
};
template <int DQK, bool WIN>
__device__ __forceinline__ void flash_unit(LAS unsigned char* lds, const int tid, const int lane, const int grpB,
        const bf16* Kg, const int ldk, const bf16* Vg, const int ldv,
        const bf16* Qg, const int ldq, bf16* Og, const int ldo,
        const int ntiles, const int krow_ctx0, const int krow_lat0, const int kpos0, const int qpos_wave, const float sink2, const bool has_sink) {
    constexpr int KSTR = DQK * 2 + 16, VSTR = 160, KBUF = 64 * KSTR, VBUF = 64 * VSTR, CPR = DQK / 8, NKC = 64 * CPR, NKR = (NKC + 511) / 512, NKS = DQK / 32;
    LAS unsigned char* Kl = lds; LAS unsigned char* Vl = lds + 2 * KBUF;
    const int fr = lane & 15, fq = lane >> 4;
    bf16x8 qf[2][NKS];
#pragma unroll
    for (int qt = 0; qt < 2; ++qt)
#pragma unroll
        for (int ks = 0; ks < NKS; ++ks) qf[qt][ks] = *(const bf16x8*)(Qg + (size_t)(16 * qt + fr) * ldq + 32 * ks + 8 * fq);
    f32x4 oacc[4][2];
#pragma unroll
    for (int c = 0; c < 4; ++c) { oacc[c][0] = (f32x4){0.f, 0.f, 0.f, 0.f}; oacc[c][1] = (f32x4){0.f, 0.f, 0.f, 0.f}; }
    float mrun[2] = {-1.0e30f, -1.0e30f}, lsum[2] = {0.f, 0.f};
    v4u kreg[NKR], vreg;
    bf16x8 pf[2][2]; bool pvalid = false; int pvb = 0;
#pragma unroll
    for (int a = 0; a < 2; ++a)
#pragma unroll
        for (int b2 = 0; b2 < 2; ++b2)
#pragma unroll
            for (int e = 0; e < 8; ++e) pf[a][b2][e] = 0;
#define FA_LOAD(j) do { const int _rb = (j) < 4 ? krow_ctx0 + 64 * (j) : krow_lat0 + 64 * ((j) - 4); \
        _Pragma("unroll") for (int _i = 0; _i < NKR; ++_i) { const int _c = tid + 512 * _i; if (_c < NKC) kreg[_i] = *(const v4u*)(Kg + (size_t)(_rb + _c / CPR) * ldk + (_c % CPR) * 8); } \
        vreg = *(const v4u*)(Vg + (size_t)(_rb + (tid >> 3)) * ldv + (tid & 7) * 8); } while (0)
#define FA_STORE(kb, vb) do { _Pragma("unroll") for (int _i = 0; _i < NKR; ++_i) { const int _c = tid + 512 * _i; if (_c < NKC) *(LAS v4u*)(Kl + (kb) * KBUF + (_c / CPR) * KSTR + (_c % CPR) * 16) = kreg[_i]; } \
        *(LAS v4u*)(Vl + (vb) * VBUF + (tid >> 3) * VSTR + (tid & 7) * 16) = vreg; } while (0)
#define FA_PV(vbuf) do { _Pragma("unroll") for (int ks2 = 0; ks2 < 2; ++ks2) _Pragma("unroll") for (int c = 0; c < 4; ++c) { \
            const LAS unsigned char* vb_ = Vl + (vbuf) * VBUF + (32 * ks2 + 4 * fq + ((lane & 15) >> 2)) * VSTR + (16 * c + 4 * (lane & 3)) * 2; \
            const s16x4 v0 = __builtin_amdgcn_ds_read_tr16_b64_v4i16((LAS s16x4*)vb_); const s16x4 v1 = __builtin_amdgcn_ds_read_tr16_b64_v4i16((LAS s16x4*)(vb_ + 16 * VSTR)); \
            bf16x8 vf; vf[0] = v0[0]; vf[1] = v0[1]; vf[2] = v0[2]; vf[3] = v0[3]; vf[4] = v1[0]; vf[5] = v1[1]; vf[6] = v1[2]; vf[7] = v1[3]; \
            oacc[c][0] = __builtin_amdgcn_mfma_f32_16x16x32_bf16(vf, pf[0][ks2], oacc[c][0], 0, 0, 0); \
            oacc[c][1] = __builtin_amdgcn_mfma_f32_16x16x32_bf16(vf, pf[1][ks2], oacc[c][1], 0, 0, 0); } } while (0)
    FA_LOAD(0); FA_STORE(0, 0); __syncthreads();
    int vcur = 0;
    for (int j = 0; j < ntiles; ++j) {
        const int kb = j & 1;
        if (j + 1 < ntiles) FA_LOAD(j + 1);
        if (grpB && pvalid) { __builtin_amdgcn_s_setprio(1); FA_PV(pvb); __builtin_amdgcn_s_setprio(0); }
        bool skip = false; const int kp = kpos0 + 64 * (j - 4);
        if (WIN && j >= 4) skip = (kp + 63 < qpos_wave - 128) || (kp > qpos_wave + 31 + 128);
        pvalid = !skip; pvb = vcur;
        if (!skip) {
            f32x4 sacc[4][2];
#pragma unroll
            for (int kt = 0; kt < 4; ++kt) { sacc[kt][0] = (f32x4){0.f, 0.f, 0.f, 0.f}; sacc[kt][1] = (f32x4){0.f, 0.f, 0.f, 0.f}; }
            __builtin_amdgcn_s_setprio(1);
#pragma unroll
            for (int ks = 0; ks < NKS; ++ks) { bf16x8 kf[4];
#pragma unroll
                for (int kt = 0; kt < 4; ++kt) kf[kt] = *(const LAS bf16x8*)(Kl + kb * KBUF + (16 * kt + fr) * KSTR + (32 * ks + 8 * fq) * 2);
#pragma unroll
                for (int kt = 0; kt < 4; ++kt) { sacc[kt][0] = __builtin_amdgcn_mfma_f32_16x16x32_bf16(kf[kt], qf[0][ks], sacc[kt][0], 0, 0, 0);
                                                 sacc[kt][1] = __builtin_amdgcn_mfma_f32_16x16x32_bf16(kf[kt], qf[1][ks], sacc[kt][1], 0, 0, 0); } }
            __builtin_amdgcn_s_setprio(0);
            if (WIN && j >= 4) {
#pragma unroll
                for (int kt = 0; kt < 4; ++kt)
#pragma unroll
                    for (int qt = 0; qt < 2; ++qt)
#pragma unroll
                        for (int jj = 0; jj < 4; ++jj) { const int d = (kp + 16 * kt + 4 * fq + jj) - (qpos_wave + 16 * qt + fr); if (d < -128 || d > 128) sacc[kt][qt][jj] = -1.0e30f; } }
#pragma unroll
            for (int qt = 0; qt < 2; ++qt) {
                float mx = sacc[0][qt][0];
#pragma unroll
                for (int kt = 0; kt < 4; ++kt)
#pragma unroll
                    for (int jj = 0; jj < 4; ++jj) mx = fmaxf(mx, sacc[kt][qt][jj]);
                mx = fmaxf(mx, __shfl_xor(mx, 16)); mx = fmaxf(mx, xor32(mx));
                float mnew = mrun[qt];
                if (__builtin_amdgcn_ballot_w64(mx > mrun[qt] + 11.5f) != 0ull) {
                    mnew = fmaxf(mrun[qt], mx); const float alpha = fast_exp2(mrun[qt] - mnew); lsum[qt] *= alpha;
#pragma unroll
                    for (int c = 0; c < 4; ++c) oacc[c][qt] = oacc[c][qt] * alpha; }
                mrun[qt] = mnew;
                float ps = 0.f;
#pragma unroll
                for (int kt = 0; kt < 4; ++kt)
#pragma unroll
                    for (int jj = 0; jj < 4; ++jj) { const float p = fast_exp2(sacc[kt][qt][jj] - mnew); sacc[kt][qt][jj] = p; ps += p; }
                lsum[qt] += ps;
#pragma unroll
                for (int ks2 = 0; ks2 < 2; ++ks2) { const v4u w = pack8(sacc[2 * ks2][qt], sacc[2 * ks2 + 1][qt]); pf[qt][ks2] = __builtin_bit_cast(bf16x8, w); }
            }
            if (!grpB) { __builtin_amdgcn_s_setprio(1); FA_PV(vcur); __builtin_amdgcn_s_setprio(0); }
        }
        const int vnext = vcur == 2 ? 0 : vcur + 1;
        if (j + 1 < ntiles) FA_STORE(kb ^ 1, vnext);
        vcur = vnext;
        __syncthreads();
    }
    if (grpB && pvalid) FA_PV(pvb);
    __syncthreads();
#pragma unroll
    for (int qt = 0; qt < 2; ++qt) { float l = lsum[qt]; l += __shfl_xor(l, 16); l += xor32(l); if (has_sink) l += fast_exp2(sink2 - mrun[qt]);
        const float inv = 1.0f / l;
#pragma unroll
        for (int c = 0; c < 4; ++c) { const f32x4 o = oacc[c][qt] * inv; v2u w; w.x = cvt_pk_bf16(o[0], o[1]); w.y = cvt_pk_bf16(o[2], o[3]);
            *(v2u*)(Og + (size_t)(16 * qt + fr) * ldo + 16 * c + 4 * fq) = w; } }
#undef FA_LOAD
#undef FA_STORE
#undef FA_PV
}

template <int DQK>
__device__ __forceinline__ void flash_unit2(LAS unsigned char* lds, const int tid, const int lane, const int grpB,
        const bf16* Kg, const int ldk, const bf16* Vg, const int ldv,
        const bf16* Qg, const int ldq, bf16* Og, const int ldo,
        const int ntiles, const int krow_ctx0, const int krow_lat0, const int kpos0, const int qpos_wave, const float sink2, const bool has_sink) {
    constexpr bool WIN = false; constexpr int KSTR = DQK * 2 + 16, VSTR = 160, KBUF = 128 * KSTR, VBUF = 128 * VSTR, CPR = DQK / 8, NKC = 128 * CPR, NKR = (NKC + 511) / 512, NKS = DQK / 32;
    LAS unsigned char* Kl = lds; LAS unsigned char* Vl = lds + 2 * KBUF;
    const int fr = lane & 15, fq = lane >> 4;
    bf16x8 qf[2][NKS];
#pragma unroll
    for (int qt = 0; qt < 2; ++qt)
#pragma unroll
        for (int ks = 0; ks < NKS; ++ks) qf[qt][ks] = *(const bf16x8*)(Qg + (size_t)(16 * qt + fr) * ldq + 32 * ks + 8 * fq);
    f32x4 oacc[4][2];
#pragma unroll
    for (int c = 0; c < 4; ++c) { oacc[c][0] = (f32x4){0.f, 0.f, 0.f, 0.f}; oacc[c][1] = (f32x4){0.f, 0.f, 0.f, 0.f}; }
    float mrun[2] = {-1.0e30f, -1.0e30f}, lsum[2] = {0.f, 0.f};
    v4u kreg[NKR], vreg[2];
    bf16x8 pf[2][2]; bool pvalid = false; int pvb = 0;
#pragma unroll
    for (int a = 0; a < 2; ++a)
#pragma unroll
        for (int b2 = 0; b2 < 2; ++b2)
#pragma unroll
            for (int e = 0; e < 8; ++e) pf[a][b2][e] = 0;
#define FA_LOAD(p) do { const int _rb = krow_ctx0 + 128 * (p); \
        _Pragma("unroll") for (int _i = 0; _i < NKR; ++_i) { const int _c = tid + 512 * _i; if (_c < NKC) kreg[_i] = *(const v4u*)(Kg + (size_t)(_rb + _c / CPR) * ldk + (_c % CPR) * 8); } \
        _Pragma("unroll") for (int _i = 0; _i < 2; ++_i) { const int _c = tid + 512 * _i; vreg[_i] = *(const v4u*)(Vg + (size_t)(_rb + (_c >> 3)) * ldv + (_c & 7) * 8); } } while (0)
#define FA_STORE(kb, vb) do { _Pragma("unroll") for (int _i = 0; _i < NKR; ++_i) { const int _c = tid + 512 * _i; if (_c < NKC) *(LAS v4u*)(Kl + (kb) * KBUF + (_c / CPR) * KSTR + (_c % CPR) * 16) = kreg[_i]; } \
        _Pragma("unroll") for (int _i = 0; _i < 2; ++_i) { const int _c = tid + 512 * _i; *(LAS v4u*)(Vl + (vb) * VBUF + (_c >> 3) * VSTR + (_c & 7) * 16) = vreg[_i]; } } while (0)
#define FA_PV(vbuf) do { _Pragma("unroll") for (int ks2 = 0; ks2 < 2; ++ks2) _Pragma("unroll") for (int c = 0; c < 4; ++c) { \
            const LAS unsigned char* vb_ = Vl + (vbuf) + (32 * ks2 + 4 * fq + ((lane & 15) >> 2)) * VSTR + (16 * c + 4 * (lane & 3)) * 2; \
            const s16x4 v0 = __builtin_amdgcn_ds_read_tr16_b64_v4i16((LAS s16x4*)vb_); const s16x4 v1 = __builtin_amdgcn_ds_read_tr16_b64_v4i16((LAS s16x4*)(vb_ + 16 * VSTR)); \
            bf16x8 vf; vf[0] = v0[0]; vf[1] = v0[1]; vf[2] = v0[2]; vf[3] = v0[3]; vf[4] = v1[0]; vf[5] = v1[1]; vf[6] = v1[2]; vf[7] = v1[3]; \
            oacc[c][0] = __builtin_amdgcn_mfma_f32_16x16x32_bf16(vf, pf[0][ks2], oacc[c][0], 0, 0, 0); \
            oacc[c][1] = __builtin_amdgcn_mfma_f32_16x16x32_bf16(vf, pf[1][ks2], oacc[c][1], 0, 0, 0); } } while (0)
    FA_LOAD(0); FA_STORE(0, 0); __syncthreads();
    int vcur = 0;
    const int npairs = ntiles >> 1;
    for (int p = 0; p < npairs; ++p) {
        const int kb = p & 1;
        if (p + 1 < npairs) FA_LOAD(p + 1);
#pragma unroll
      for (int sub = 0; sub < 2; ++sub) { const int j = 2 * p + sub; const int koff = kb * KBUF + sub * 64 * KSTR; const int voff = vcur * VBUF + sub * 64 * VSTR;
        if (grpB && pvalid) { __builtin_amdgcn_s_setprio(1); FA_PV(pvb); __builtin_amdgcn_s_setprio(0); }
        bool skip = false; const int kp = kpos0 + 64 * (j - 4);
        if (WIN && j >= 4) skip = (kp + 63 < qpos_wave - 128) || (kp > qpos_wave + 31 + 128);
        pvalid = !skip; pvb = voff;
        if (!skip) {
            f32x4 sacc[4][2];
#pragma unroll
            for (int kt = 0; kt < 4; ++kt) { sacc[kt][0] = (f32x4){0.f, 0.f, 0.f, 0.f}; sacc[kt][1] = (f32x4){0.f, 0.f, 0.f, 0.f}; }
            __builtin_amdgcn_s_setprio(1);
#pragma unroll
            for (int ks = 0; ks < NKS; ++ks) { bf16x8 kf[4];
#pragma unroll
                for (int kt = 0; kt < 4; ++kt) kf[kt] = *(const LAS bf16x8*)(Kl + koff + (16 * kt + fr) * KSTR + (32 * ks + 8 * fq) * 2);
#pragma unroll
                for (int kt = 0; kt < 4; ++kt) { sacc[kt][0] = __builtin_amdgcn_mfma_f32_16x16x32_bf16(kf[kt], qf[0][ks], sacc[kt][0], 0, 0, 0);
                                                 sacc[kt][1] = __builtin_amdgcn_mfma_f32_16x16x32_bf16(kf[kt], qf[1][ks], sacc[kt][1], 0, 0, 0); } }
            __builtin_amdgcn_s_setprio(0);
            if (WIN && j >= 4) {
#pragma unroll
                for (int kt = 0; kt < 4; ++kt)
#pragma unroll
                    for (int qt = 0; qt < 2; ++qt)
#pragma unroll
                        for (int jj = 0; jj < 4; ++jj) { const int d = (kp + 16 * kt + 4 * fq + jj) - (qpos_wave + 16 * qt + fr); if (d < -128 || d > 128) sacc[kt][qt][jj] = -1.0e30f; } }
#pragma unroll
            for (int qt = 0; qt < 2; ++qt) {
                float mx = sacc[0][qt][0];
#pragma unroll
                for (int kt = 0; kt < 4; ++kt)
#pragma unroll
                    for (int jj = 0; jj < 4; ++jj) mx = fmaxf(mx, sacc[kt][qt][jj]);
                mx = fmaxf(mx, __shfl_xor(mx, 16)); mx = fmaxf(mx, xor32(mx));
                float mnew = mrun[qt];
                if (__builtin_amdgcn_ballot_w64(mx > mrun[qt] + 11.5f) != 0ull) {
                    mnew = fmaxf(mrun[qt], mx); const float alpha = fast_exp2(mrun[qt] - mnew); lsum[qt] *= alpha;
#pragma unroll
                    for (int c = 0; c < 4; ++c) oacc[c][qt] = oacc[c][qt] * alpha; }
                mrun[qt] = mnew;
                float ps = 0.f;
#pragma unroll
                for (int kt = 0; kt < 4; ++kt)
#pragma unroll
                    for (int jj = 0; jj < 4; ++jj) { const float p = fast_exp2(sacc[kt][qt][jj] - mnew); sacc[kt][qt][jj] = p; ps += p; }
                lsum[qt] += ps;
#pragma unroll
                for (int ks2 = 0; ks2 < 2; ++ks2) { const v4u w = pack8(sacc[2 * ks2][qt], sacc[2 * ks2 + 1][qt]); pf[qt][ks2] = __builtin_bit_cast(bf16x8, w); }
            }
            if (!grpB) { __builtin_amdgcn_s_setprio(1); FA_PV(voff); __builtin_amdgcn_s_setprio(0); }
        }
      }
        const int vnext = vcur == 2 ? 0 : vcur + 1;
        if (p + 1 < npairs) FA_STORE(kb ^ 1, vnext);
        vcur = vnext;
        __syncthreads();
    }
    if (grpB && pvalid) FA_PV(pvb);
    __syncthreads();
#pragma unroll
    for (int qt = 0; qt < 2; ++qt) { float l = lsum[qt]; l += __shfl_xor(l, 16); l += xor32(l); if (has_sink) l += fast_exp2(sink2 - mrun[qt]);
        const float inv = 1.0f / l;
#pragma unroll
        for (int c = 0; c < 4; ++c) { const f32x4 o = oacc[c][qt] * inv; v2u w; w.x = cvt_pk_bf16(o[0], o[1]); w.y = cvt_pk_bf16(o[2], o[3]);
            *(v2u*)(Og + (size_t)(16 * qt + fr) * ldo + 16 * c + 4 * fq) = w; } }
#undef FA_LOAD
#undef FA_STORE
#undef FA_PV
}

typedef float f32x16 __attribute__((ext_vector_type(16)));
template <int DQK>
__device__ __forceinline__ void flash_unit4(LAS unsigned char* lds, const int tid, const int lane,
        const bf16* Kg, const int ldk, const bf16* Vg, const int ldv, const bf16* Qg, const int ldq, bf16* Og, const int ldo, const int npairs, const int krow0) {
    constexpr int KSTR = DQK * 2 + 16, VSTR = 160, KBUF = 128 * KSTR, VBUF = 128 * VSTR, CPR = DQK / 8, NKC = 128 * CPR, NKR = (NKC + 511) / 512, NKS = DQK / 16;
    LAS unsigned char* Kl = lds; LAS unsigned char* Vl = lds + 2 * KBUF;
    const int r5 = lane & 31, h = lane >> 5;
    bf16x8 qf[NKS];
#pragma unroll
    for (int ks = 0; ks < NKS; ++ks) qf[ks] = *(const bf16x8*)(Qg + (size_t)r5 * ldq + 16 * ks + 8 * h);
    f32x16 oacc[2];
#pragma unroll
    for (int dt = 0; dt < 2; ++dt)
#pragma unroll
        for (int e = 0; e < 16; ++e) oacc[dt][e] = 0.f;
    float mrun = -1.0e30f, lsum = 0.f;
    v4u kreg[NKR], vreg[2];
    unsigned kgo[NKR], vgo[2];
#pragma unroll
    for (int i = 0; i < NKR; ++i) { const int c = tid + 512 * i; kgo[i] = (unsigned)(((c / CPR) * ldk + (c % CPR) * 8) * 2); }
#pragma unroll
    for (int i = 0; i < 2; ++i) { const int c = tid + 512 * i; vgo[i] = (unsigned)(((c >> 3) * ldv + (c & 7) * 8) * 2); }
#define F4_LOAD(p) do { const char* _kb = (const char*)Kg + (size_t)(krow0 + 128 * (p)) * ldk * 2; const char* _vb = (const char*)Vg + (size_t)(krow0 + 128 * (p)) * ldv * 2; \
        _Pragma("unroll") for (int _i = 0; _i < NKR; ++_i) { if (tid + 512 * _i < NKC) kreg[_i] = *(const v4u*)(_kb + kgo[_i]); } \
        _Pragma("unroll") for (int _i = 0; _i < 2; ++_i) vreg[_i] = *(const v4u*)(_vb + vgo[_i]); } while (0)
#define F4_STORE(b) do { _Pragma("unroll") for (int _i = 0; _i < NKR; ++_i) { const int _c = tid + 512 * _i; if (_c < NKC) *(LAS v4u*)(Kl + (b) * KBUF + (_c / CPR) * KSTR + (_c % CPR) * 16) = kreg[_i]; } \
        _Pragma("unroll") for (int _i = 0; _i < 2; ++_i) { const int _c = tid + 512 * _i; *(LAS v4u*)(Vl + (b) * VBUF + (_c >> 3) * VSTR + (_c & 7) * 16) = vreg[_i]; } } while (0)
    F4_LOAD(0); F4_STORE(0); __syncthreads();
    const int vlane = (4 * h + ((lane & 15) >> 2)) * VSTR + (16 * ((lane >> 4) & 1) + 4 * (lane & 3)) * 2;
    for (int p = 0; p < npairs; ++p) { const int bb = p & 1;
        if (p + 1 < npairs) F4_LOAD(p + 1);
#pragma unroll
        for (int sub = 0; sub < 2; ++sub) { const LAS unsigned char* Kt = Kl + bb * KBUF + sub * 64 * KSTR; const LAS unsigned char* Vt = Vl + bb * VBUF + sub * 64 * VSTR;
            bf16x8 kfr[NKS][2];
#pragma unroll
            for (int ks = 0; ks < NKS; ++ks)
#pragma unroll
                for (int kt = 0; kt < 2; ++kt) kfr[ks][kt] = *(const LAS bf16x8*)(Kt + (32 * kt + r5) * KSTR + (16 * ks + 8 * h) * 2);
            f32x16 sacc[2];
#pragma unroll
            for (int kt = 0; kt < 2; ++kt)
#pragma unroll
                for (int e = 0; e < 16; ++e) sacc[kt][e] = 0.f;
            __builtin_amdgcn_s_setprio(1);
#pragma unroll
            for (int ks = 0; ks < NKS; ++ks)
#pragma unroll
                for (int kt = 0; kt < 2; ++kt) sacc[kt] = __builtin_amdgcn_mfma_f32_32x32x16_bf16(kfr[ks][kt], qf[ks], sacc[kt], 0, 0, 0);
            __builtin_amdgcn_s_setprio(0);
            float mx = sacc[0][0];
#pragma unroll
            for (int kt = 0; kt < 2; ++kt)
#pragma unroll
                for (int e = 0; e < 16; ++e) mx = fmaxf(mx, sacc[kt][e]);
            mx = fmaxf(mx, xor32(mx));
            if (__builtin_amdgcn_ballot_w64(mx > mrun + 11.5f) != 0ull) { const float mnew = fmaxf(mrun, mx), alpha = fast_exp2(mrun - mnew); lsum *= alpha; mrun = mnew;
#pragma unroll
                for (int dt = 0; dt < 2; ++dt) oacc[dt] = oacc[dt] * alpha; }
            float ps = 0.f;
#pragma unroll
            for (int kt = 0; kt < 2; ++kt)
#pragma unroll
                for (int e = 0; e < 16; ++e) { const float pv = fast_exp2(sacc[kt][e] - mrun); sacc[kt][e] = pv; ps += pv; }
            lsum += ps;
            bf16x8 vfr[2][2][2];
#pragma unroll
            for (int kt = 0; kt < 2; ++kt)
#pragma unroll
                for (int s = 0; s < 2; ++s)
#pragma unroll
                    for (int dt = 0; dt < 2; ++dt) { const LAS unsigned char* vb = Vt + (32 * kt + 16 * s) * VSTR + vlane + 64 * dt;
                        const s16x4 v0 = __builtin_amdgcn_ds_read_tr16_b64_v4i16((LAS s16x4*)vb), v1 = __builtin_amdgcn_ds_read_tr16_b64_v4i16((LAS s16x4*)(vb + 8 * VSTR));
                        bf16x8 vf; vf[0] = v0[0]; vf[1] = v0[1]; vf[2] = v0[2]; vf[3] = v0[3]; vf[4] = v1[0]; vf[5] = v1[1]; vf[6] = v1[2]; vf[7] = v1[3]; vfr[kt][s][dt] = vf; }
            v4u pw[2][2];
#pragma unroll
            for (int kt = 0; kt < 2; ++kt)
#pragma unroll
                for (int s = 0; s < 2; ++s) { pw[kt][s].x = cvt_pk_bf16(sacc[kt][8 * s + 0], sacc[kt][8 * s + 1]); pw[kt][s].y = cvt_pk_bf16(sacc[kt][8 * s + 2], sacc[kt][8 * s + 3]);
                    pw[kt][s].z = cvt_pk_bf16(sacc[kt][8 * s + 4], sacc[kt][8 * s + 5]); pw[kt][s].w = cvt_pk_bf16(sacc[kt][8 * s + 6], sacc[kt][8 * s + 7]); }
            __builtin_amdgcn_s_setprio(1);
#pragma unroll
            for (int kt = 0; kt < 2; ++kt)
#pragma unroll
                for (int s = 0; s < 2; ++s)
#pragma unroll
                    for (int dt = 0; dt < 2; ++dt) oacc[dt] = __builtin_amdgcn_mfma_f32_32x32x16_bf16(vfr[kt][s][dt], __builtin_bit_cast(bf16x8, pw[kt][s]), oacc[dt], 0, 0, 0);
            __builtin_amdgcn_s_setprio(0);
        }
        if (p + 1 < npairs) F4_STORE(bb ^ 1);
        __syncthreads();
    }
    { float l = lsum; l += xor32(l); const float inv = 1.0f / l;
#pragma unroll
      for (int dt = 0; dt < 2; ++dt)
#pragma unroll
          for (int g4 = 0; g4 < 4; ++g4) { v2u w; w.x = cvt_pk_bf16(oacc[dt][4 * g4 + 0] * inv, oacc[dt][4 * g4 + 1] * inv); w.y = cvt_pk_bf16(oacc[dt][4 * g4 + 2] * inv, oacc[dt][4 * g4 + 3] * inv);
              *(v2u*)(Og + (size_t)r5 * ldo + 32 * dt + 8 * g4 + 4 * h) = w; } }
#undef F4_LOAD
#undef F4_STORE
}

__device__ __forceinline__ void phase_attn_window(Frame& F, const float* const* in, bf16* Q, const bf16* Kb, const bf16* Vb, bf16* Oalt = nullptr) {
    constexpr int NLAT = NB * 4 * 64, NCTX = NB * 4 * 4;
    for (int un = F.vcu; un < NLAT + NCTX; un += GRID) {
        int b, kvh, q0, ntiles, kpos0, qrow0;
        if (un < NLAT) { b = un >> 8; kvh = (un >> 6) & 3; q0 = (un & 63) * 64; kpos0 = q0 >= 128 ? q0 - 128 : 0; const int kend = q0 + 192 <= SEQ ? q0 + 192 : SEQ; ntiles = 4 + (kend - kpos0) / 64; qrow0 = b * TPB + CTX + q0; }
        else { const int v = un - NLAT; b = v >> 4; kvh = (v >> 2) & 3; q0 = (v & 3) * 64; kpos0 = 0; ntiles = 4; qrow0 = b * TPB + q0; }
        const int g = F.wave >> 1, half = F.wave & 1, head = kvh * 4 + g;
        bf16* qp = Q + (size_t)(qrow0 + 32 * half) * 1024 + head * 64;
        bf16* op = Oalt ? Oalt + (size_t)(qrow0 + 32 * half) * 1024 + head * 64 : qp;
        flash_unit<64, true>(F.lds, F.tid, F.lane, F.wave >> 2, Kb + kvh * 64, 256, Vb + kvh * 64, 256, qp, 1024, op, 1024,
                             ntiles, b * TPB, b * TPB + CTX + kpos0, kpos0, q0 + 32 * half, in[16][head] * LOG2E, true);
    }
}
__device__ __forceinline__ void phase_attn_mla(Frame& F, const bf16* Q3, const bf16* KF, const bf16* V3, bf16* O) {
    for (int un = F.vcu; un < NB * 16 * 16; un += GRID) { const int b = un >> 8, head = (un >> 4) & 15, qb = un & 15; const int qrow = b * TPB + CTX + qb * 256 + 32 * F.wave;
        flash_unit4<96>(F.lds, F.tid, F.lane, KF + head * 96, 1536, V3 + head * 64, 1024, Q3 + (size_t)qrow * 1536 + head * 96, 1536, O + (size_t)qrow * 1024 + head * 64, 1024, 34, b * TPB);
    }
}
#ifndef SSD_PF
#define SSD_PF 2
#endif
#ifndef ML_PF
#define ML_PF 2
#endif
__device__ __forceinline__ int scan_row(int dir, int tau) { return dir == 0 ? tau : (tau < CTX ? CTX - 1 - tau : (TPB + CTX - 1) - tau); }

__device__ __forceinline__ void phase_ssm_conv(Frame& F, const float* const* in, int gp, const bf16* XP, bf16* XS, bf16* BC, const float* DT, float* ACUM) {
    constexpr int RPW = M / GRID;
    if (F.tid < 384) {
    const int cg = F.tid % 192, rsub = F.tid / 192, c0 = cg * 8;
    const int oc = c0 < 1024 ? gp * 1024 + c0 : (c0 < 1280 ? 2048 + gp * 256 + (c0 - 1024) : 2560 + gp * 256 + (c0 - 1280));
    float w[5][8], bb[8];
#pragma unroll
    for (int k = 0; k < 5; ++k)
#pragma unroll
        for (int i = 0; i < 8; ++i) w[k][i] = in[19][k * 3072 + oc + i];
#pragma unroll
    for (int i = 0; i < 8; ++i) bb[i] = in[20][oc + i];
    const int rbeg = blockIdx.x * RPW + rsub * (RPW / 2), rend = rbeg + RPW / 2;
    for (int g0 = rbeg; g0 < rend; g0 += 8) {
        v4u xin[12];
#pragma unroll
        for (int j = 0; j < 12; ++j) { const int rr = g0 - 2 + j; xin[j] = (rr >= 0 && rr < M) ? *(const v4u*)(XP + (size_t)rr * 1536 + c0) : (v4u){0u, 0u, 0u, 0u}; }
#pragma unroll
        for (int i = 0; i < 8; ++i) { const int r = g0 + i; if (r < rend) { const int t = r % TPB; const int lo = t < CTX ? 0 : CTX, hi = t < CTX ? CTX : TPB;
            float a[8];
#pragma unroll
            for (int q = 0; q < 8; ++q) a[q] = bb[q];
#pragma unroll
            for (int k = 0; k < 5; ++k) { const int tt = t + k - 2; if (tt >= lo && tt < hi) { const v4u x = xin[i + k];
                    a[0] += w[k][0] * bflo(x.x); a[1] += w[k][1] * bfhi(x.x); a[2] += w[k][2] * bflo(x.y); a[3] += w[k][3] * bfhi(x.y);
                    a[4] += w[k][4] * bflo(x.z); a[5] += w[k][5] * bfhi(x.z); a[6] += w[k][6] * bflo(x.w); a[7] += w[k][7] * bfhi(x.w); } }
            v4u o; o.x = cvt_pk_bf16(silu_f(a[0]), silu_f(a[1])); o.y = cvt_pk_bf16(silu_f(a[2]), silu_f(a[3])); o.z = cvt_pk_bf16(silu_f(a[4]), silu_f(a[5])); o.w = cvt_pk_bf16(silu_f(a[6]), silu_f(a[7]));
            if (c0 < 1024) *(v4u*)(XS + (size_t)r * 1024 + c0) = o; else *(v4u*)(BC + (size_t)r * 512 + (c0 - 1024)) = o; } } }
    } else {
        const int chain = blockIdx.x * 128 + (F.tid - 384);
        if (chain < NB * 2 * 16 * 68) { const int ck = chain % 68, hl = (chain / 68) & 15, dir = (chain / (68 * 16)) & 1, b = chain / (68 * 32);
            const float Ah = -fast_exp(in[22][dir * 32 + gp * 16 + hl]) * LOG2E; float acc = 0.f;
#pragma unroll 1
            for (int h2 = 0; h2 < 2; ++h2) { float dv[32];
#pragma unroll
                for (int s = 0; s < 32; ++s) dv[s] = DT[(size_t)(b * TPB + scan_row(dir, ck * 64 + h2 * 32 + s)) * 32 + dir * 16 + hl];
#pragma unroll
                for (int s = 0; s < 32; ++s) { acc += dv[s] * Ah; ACUM[(size_t)(b * TPB + scan_row(dir, ck * 64 + h2 * 32 + s)) * 32 + dir * 16 + hl] = acc; } } }
    }
}

__device__ __forceinline__ void phase_ssm_scan(Frame& F, const float* const* in, int gp, const bf16* XS, const bf16* BC, const float* DT, const bf16* Z, bf16* Y) {
    constexpr int T = 32;
    LAS float* Bf = (LAS float*)F.lds;
    LAS float* Cf = (LAS float*)(F.lds + 16384);
    LAS float* U = (LAS float*)(F.lds + 32768);
    LAS float* XT = (LAS float*)(F.lds + 40960);
    LAS float* DEC = (LAS float*)(F.lds + 49152);
    LAS float* PART = (LAS float*)(F.lds + 49152 + 256);
    const int it = blockIdx.x, b = it >> 5, hl = (it >> 1) & 15, ph = it & 1, head = gp * 16 + hl, gl = hl >> 3;
    const int col = hl * 64 + ph * 32;
    const int p = F.tid & 31, ns = F.tid >> 5;
    const float dskip = in[23][head] + in[23][32 + head];
    const int st = F.tid >> 4, sch = F.tid & 15;
    const int xt = F.tid >> 2, xch = F.tid & 3;
    for (int dir = 0; dir < 2; ++dir) {
        const float Ah = -fast_exp(in[22][dir * 32 + head]) * LOG2E;
        float S[8];
#pragma unroll
        for (int i = 0; i < 8; ++i) S[i] = 0.f;
        v4u rb, rc, rx; float rdt = 0.f;
#define SS_LOAD(tile) do { const int _rB = b * TPB + scan_row(dir, (tile) * T + st); rb = *(const v4u*)(BC + (size_t)_rB * 512 + gl * 128 + sch * 8); rc = *(const v4u*)(BC + (size_t)_rB * 512 + 256 + gl * 128 + sch * 8); \
            if (F.tid < 128) { const int _rX = b * TPB + scan_row(dir, (tile) * T + xt); rx = *(const v4u*)(XS + (size_t)_rX * 1024 + col + xch * 8); rdt = DT[(size_t)_rX * 32 + dir * 16 + hl]; } } while (0)
#define SS_STORE(nb) do { LAS float* _b = Bf + st * 128 + sch * 8; LAS float* _c = Cf + st * 128 + sch * 8; \
            *(LAS f32x4*)_b = (f32x4){bflo(rb.x), bfhi(rb.x), bflo(rb.y), bfhi(rb.y)}; *(LAS f32x4*)(_b + 4) = (f32x4){bflo(rb.z), bfhi(rb.z), bflo(rb.w), bfhi(rb.w)}; \
            *(LAS f32x4*)_c = (f32x4){bflo(rc.x), bfhi(rc.x), bflo(rc.y), bfhi(rc.y)}; *(LAS f32x4*)(_c + 4) = (f32x4){bflo(rc.z), bfhi(rc.z), bflo(rc.w), bfhi(rc.w)}; \
            if (F.tid < 128) { const f32x4 x0 = (f32x4){bflo(rx.x), bfhi(rx.x), bflo(rx.y), bfhi(rx.y)}, x1 = (f32x4){bflo(rx.z), bfhi(rx.z), bflo(rx.w), bfhi(rx.w)}; \
                LAS float* _x = XT + (nb) * 1024 + xt * 32 + xch * 8; LAS float* _u = U + (nb) * 1024 + xt * 32 + xch * 8; \
                *(LAS f32x4*)_x = x0; *(LAS f32x4*)(_x + 4) = x1; *(LAS f32x4*)_u = x0 * rdt; *(LAS f32x4*)(_u + 4) = x1 * rdt; \
                if (xch == 0) DEC[(nb) * 32 + xt] = fast_exp2(rdt * Ah); } } while (0)
        __syncthreads();
        SS_LOAD(0); SS_STORE(0); __syncthreads();
        constexpr int NT = TPB / T;
        for (int tile = 0; tile < NT; ++tile) { const int cb = tile & 1;
            if (tile + 1 < NT) SS_LOAD(tile + 1);
            const LAS float* u_ = U + cb * 1024 + p; const LAS float* d_ = DEC + cb * 32;
#pragma unroll 4
            for (int t = 0; t < T; ++t) {
                const float dec = d_[t], u = u_[t * 32];
                const f32x4 b0 = *(const LAS f32x4*)(Bf + t * 128 + ns * 8), b1 = *(const LAS f32x4*)(Bf + t * 128 + ns * 8 + 4);
                const f32x4 c0 = *(const LAS f32x4*)(Cf + t * 128 + ns * 8), c1 = *(const LAS f32x4*)(Cf + t * 128 + ns * 8 + 4);
                float pt = 0.f;
#pragma unroll
                for (int i = 0; i < 4; ++i) { S[i] = S[i] * dec + b0[i] * u; pt += c0[i] * S[i]; S[4 + i] = S[4 + i] * dec + b1[i] * u; pt += c1[i] * S[4 + i]; }
                pt += __shfl_xor(pt, 32);
                if (F.lane < 32) PART[(F.wave * 32 + t) * 32 + p] = pt;
            }
            __syncthreads();
#pragma unroll
            for (int k = 0; k < 2; ++k) { const int t = (F.tid >> 5) + 16 * k; float y = 0.f;
#pragma unroll
                for (int w = 0; w < 8; ++w) y += PART[(w * 32 + t) * 32 + p];
                const size_t ro = (size_t)(b * TPB + scan_row(dir, tile * T + t));
                if (dir == 0) Y[ro * 1024 + col + p] = (bf16)f2bf(y);
                else { const float yt = y + bf2f(Y[ro * 1024 + col + p]) + dskip * XT[cb * 1024 + t * 32 + p]; const float zz = bf2f(Z[ro * 1024 + col + p]);
                    Y[ro * 1024 + col + p] = (bf16)f2bf(yt * silu_f(zz)); } }
            if (tile + 1 < NT) SS_STORE(cb ^ 1);
            __syncthreads();
        }
#undef SS_LOAD
#undef SS_STORE
    }
}
__device__ __forceinline__ void phase_ssm_gnorm(Frame& F, const float* const* in, int gp, bf16* Y) {
    const int gw = F.vcu * NWAVES + F.wave, NGW = GRID * NWAVES; const float* ng = in[24] + gp * 1024 + 16 * F.lane;
    for (int r = gw; r < M; r += NGW) { v4u* p = (v4u*)(Y + (size_t)r * 1024 + 16 * F.lane); const v4u a = p[0], c = p[1];
        float v[16] = {bflo(a.x), bfhi(a.x), bflo(a.y), bfhi(a.y), bflo(a.z), bfhi(a.z), bflo(a.w), bfhi(a.w), bflo(c.x), bfhi(c.x), bflo(c.y), bfhi(c.y), bflo(c.z), bfhi(c.z), bflo(c.w), bfhi(c.w)};
        float ss = 0.f;
#pragma unroll
        for (int i = 0; i < 16; ++i) ss += v[i] * v[i];
#pragma unroll
        for (int o = 1; o < 32; o <<= 1) ss += __shfl_xor(ss, o);
        const float rs = rsqrtf(ss * (1.f / 512.f) + EPS);
        v4u o0, o1;
        o0.x = cvt_pk_bf16(v[0] * rs * ng[0], v[1] * rs * ng[1]); o0.y = cvt_pk_bf16(v[2] * rs * ng[2], v[3] * rs * ng[3]); o0.z = cvt_pk_bf16(v[4] * rs * ng[4], v[5] * rs * ng[5]); o0.w = cvt_pk_bf16(v[6] * rs * ng[6], v[7] * rs * ng[7]);
        o1.x = cvt_pk_bf16(v[8] * rs * ng[8], v[9] * rs * ng[9]); o1.y = cvt_pk_bf16(v[10] * rs * ng[10], v[11] * rs * ng[11]); o1.z = cvt_pk_bf16(v[12] * rs * ng[12], v[13] * rs * ng[13]); o1.w = cvt_pk_bf16(v[14] * rs * ng[14], v[15] * rs * ng[15]);
        p[0] = o0; p[1] = o1; }
}


__device__ __forceinline__ void phase_ssm_scan_mfma(Frame& F, const float* const* in, int gp, const bf16* XS, const bf16* BC, const float* DT, const float* ACUM, bf16* Yf, bf16* Yb) {
    constexpr int BSTR = 272, XSTR = 160;
    LAS unsigned char* Bl = F.lds;
    LAS unsigned char* Cl = F.lds + 17408;
    LAS unsigned char* Xl = F.lds + 34816;
    LAS unsigned char* Xw = F.lds + 45056;
    LAS float* AC = (LAS float*)(F.lds + 55296);
    LAS float* DTs = (LAS float*)(F.lds + 55296 + 256);
    LAS unsigned char* Sb = F.lds + 55808;
    const int it = F.vcu, b = it >> 5, dir = (it >> 4) & 1, hl = it & 15, gl = hl >> 3;
    bf16* Y = dir == 0 ? Yf : Yb;
    const float dsk = in[23][dir * 32 + gp * 16 + hl];
    const int tid = F.tid, lane = F.lane, w = F.wave, fr = lane & 15, fq = lane >> 4, lq = (lane & 15) >> 2, lp = lane & 3;
    const int ph = w >> 2, lt = ph ? 3 - (w & 3) : (w & 3);
    for (int i = tid; i < 64 * BSTR / 16; i += NTHR) *(LAS v4u*)(Sb + i * 16) = (v4u){0u, 0u, 0u, 0u};
    f32x4 sacc[4];
#pragma unroll
    for (int i = 0; i < 4; ++i) sacc[i] = (f32x4){0.f, 0.f, 0.f, 0.f};
    constexpr int PF = SSD_PF;
    v4u rB[PF][2], rC[PF][2], rX[PF]; float rac[PF], ral[PF], rdt[PF];
    const int xr = tid >> 3, xc = tid & 7;
#define SM_LOAD(S, ckv) do { const int _ck = (ckv) < 68 ? (ckv) : 67; \
        _Pragma("unroll") for (int _i = 0; _i < 2; ++_i) { const int _c = tid + 512 * _i; const size_t _r = (size_t)(b * TPB + scan_row(dir, _ck * 64 + (_c >> 4))); \
            rB[S][_i] = *(const v4u*)(BC + _r * 512 + gl * 128 + (_c & 15) * 8); rC[S][_i] = *(const v4u*)(BC + _r * 512 + 256 + gl * 128 + (_c & 15) * 8); } \
        { const size_t _r = (size_t)(b * TPB + scan_row(dir, _ck * 64 + xr)); const size_t _rl = (size_t)(b * TPB + scan_row(dir, _ck * 64 + 63)); rX[S] = *(const v4u*)(XS + _r * 1024 + hl * 64 + xc * 8); \
          rac[S] = ACUM[_r * 32 + dir * 16 + hl]; ral[S] = ACUM[_rl * 32 + dir * 16 + hl]; rdt[S] = DT[_r * 32 + dir * 16 + hl]; } } while (0)
#define SM_STORE(S) do { _Pragma("unroll") for (int _i = 0; _i < 2; ++_i) { const int _c = tid + 512 * _i; *(LAS v4u*)(Bl + (_c >> 4) * BSTR + (_c & 15) * 16) = rB[S][_i]; *(LAS v4u*)(Cl + (_c >> 4) * BSTR + (_c & 15) * 16) = rC[S][_i]; } \
        *(LAS v4u*)(Xl + xr * XSTR + xc * 16) = rX[S]; \
        { const float rxs = rdt[S] * fast_exp2(ral[S] - rac[S]); const v4u _x = rX[S]; v4u _o; _o.x = cvt_pk_bf16(bflo(_x.x) * rxs, bfhi(_x.x) * rxs); _o.y = cvt_pk_bf16(bflo(_x.y) * rxs, bfhi(_x.y) * rxs); _o.z = cvt_pk_bf16(bflo(_x.z) * rxs, bfhi(_x.z) * rxs); _o.w = cvt_pk_bf16(bflo(_x.w) * rxs, bfhi(_x.w) * rxs); \
          *(LAS v4u*)(Xw + xr * XSTR + xc * 16) = _o; } \
        if (xc == 0) { AC[xr] = rac[S]; DTs[xr] = rdt[S]; } } while (0)
    SM_LOAD(0, 0); SM_STORE(0);
#pragma unroll
    for (int k = 1; k < PF; ++k) SM_LOAD(k, k);
    __syncthreads();
#pragma unroll 1
    for (int ck0 = 0; ck0 < 68; ck0 += PF) {
#pragma unroll
      for (int u = 0; u < PF; ++u) { const int ck = ck0 + u; const int cur = u & 1;
        SM_LOAD(u, ck + PF);
        const LAS unsigned char* Sc = Sb + cur * (64 * BSTR); LAS unsigned char* Sn = Sb + (cur ^ 1) * (64 * BSTR);
        bf16x8 cf[4], sf[2][4], bfr[4][4];
#pragma unroll
        for (int ks = 0; ks < 4; ++ks) cf[ks] = *(const LAS bf16x8*)(Cl + (16 * lt + fr) * BSTR + (32 * ks + 8 * fq) * 2);
#pragma unroll
        for (int pi = 0; pi < 2; ++pi)
#pragma unroll
            for (int ks = 0; ks < 4; ++ks) sf[pi][ks] = *(const LAS bf16x8*)(Sc + (16 * (2 * ph + pi) + fr) * BSTR + (32 * ks + 8 * fq) * 2);
#pragma unroll
        for (int st = 0; st < 4; ++st) { if (true) {
#pragma unroll
            for (int ks = 0; ks < 4; ++ks) bfr[st][ks] = *(const LAS bf16x8*)(Bl + (16 * st + fr) * BSTR + (32 * ks + 8 * fq) * 2); } }
        const float acl = AC[16 * lt + fr];
        f32x4 acs[4], dts[4];
#pragma unroll
        for (int st = 0; st < 4; ++st) { acs[st] = *(const LAS f32x4*)(AC + 16 * st + 4 * fq); dts[st] = *(const LAS f32x4*)(DTs + 16 * st + 4 * fq); }
        const float gdec = fast_exp2(AC[63]);
        bf16x8 xf[2][2];
#pragma unroll
        for (int ks2 = 0; ks2 < 2; ++ks2) { if (true) {
#pragma unroll
            for (int pi = 0; pi < 2; ++pi) { const LAS unsigned char* xb = Xl + (32 * ks2 + 4 * fq + lq) * XSTR + (16 * (2 * ph + pi) + 4 * lp) * 2;
                const s16x4 v0 = __builtin_amdgcn_ds_read_tr16_b64_v4i16((LAS s16x4*)xb), v1 = __builtin_amdgcn_ds_read_tr16_b64_v4i16((LAS s16x4*)(xb + 16 * XSTR));
                xf[ks2][pi][0] = v0[0]; xf[ks2][pi][1] = v0[1]; xf[ks2][pi][2] = v0[2]; xf[ks2][pi][3] = v0[3]; xf[ks2][pi][4] = v1[0]; xf[ks2][pi][5] = v1[1]; xf[ks2][pi][6] = v1[2]; xf[ks2][pi][7] = v1[3]; } } }
        f32x4 yacc[2];
#pragma unroll
        for (int pi = 0; pi < 2; ++pi) { f32x4 a = (f32x4){0.f, 0.f, 0.f, 0.f};
#pragma unroll
            for (int ks = 0; ks < 4; ++ks) a = __builtin_amdgcn_mfma_f32_16x16x32_bf16(sf[pi][ks], cf[ks], a, 0, 0, 0);
            yacc[pi] = a * fast_exp2(acl); }
        f32x4 pm[4];
#pragma unroll
        for (int st = 0; st < 4; ++st) { pm[st] = (f32x4){0.f, 0.f, 0.f, 0.f};
            if (st <= lt) { f32x4 g = (f32x4){0.f, 0.f, 0.f, 0.f};
#pragma unroll
                for (int ks = 0; ks < 4; ++ks) g = __builtin_amdgcn_mfma_f32_16x16x32_bf16(bfr[st][ks], cf[ks], g, 0, 0, 0);
#pragma unroll
                for (int j = 0; j < 4; ++j) { const bool ok = (16 * st + 4 * fq + j) <= (16 * lt + fr); pm[st][j] = ok ? g[j] * fast_exp2(acl - acs[st][j]) * dts[st][j] : 0.f; } } }
        bf16x8 xwf[2], btf[4][2];
#pragma unroll
        for (int ks2 = 0; ks2 < 2; ++ks2) { const LAS unsigned char* xb = Xw + (32 * ks2 + 8 * fq + lq) * XSTR + (16 * lt + 4 * lp) * 2;
            const s16x4 v0 = __builtin_amdgcn_ds_read_tr16_b64_v4i16((LAS s16x4*)xb), v1 = __builtin_amdgcn_ds_read_tr16_b64_v4i16((LAS s16x4*)(xb + 4 * XSTR));
            xwf[ks2][0] = v0[0]; xwf[ks2][1] = v0[1]; xwf[ks2][2] = v0[2]; xwf[ks2][3] = v0[3]; xwf[ks2][4] = v1[0]; xwf[ks2][5] = v1[1]; xwf[ks2][6] = v1[2]; xwf[ks2][7] = v1[3]; }
#pragma unroll
        for (int i = 0; i < 4; ++i)
#pragma unroll
            for (int ks2 = 0; ks2 < 2; ++ks2) { const LAS unsigned char* bb = Bl + (32 * ks2 + 8 * fq + lq) * BSTR + (16 * (4 * ph + i) + 4 * lp) * 2;
                const s16x4 v0 = __builtin_amdgcn_ds_read_tr16_b64_v4i16((LAS s16x4*)bb), v1 = __builtin_amdgcn_ds_read_tr16_b64_v4i16((LAS s16x4*)(bb + 4 * BSTR));
                btf[i][ks2][0] = v0[0]; btf[i][ks2][1] = v0[1]; btf[i][ks2][2] = v0[2]; btf[i][ks2][3] = v0[3]; btf[i][ks2][4] = v1[0]; btf[i][ks2][5] = v1[1]; btf[i][ks2][6] = v1[2]; btf[i][ks2][7] = v1[3]; }
#pragma unroll
        for (int ks2 = 0; ks2 < 2; ++ks2) { if (2 * ks2 <= lt) { const v4u pw = pack8(pm[2 * ks2], pm[2 * ks2 + 1]); const bf16x8 pf = __builtin_bit_cast(bf16x8, pw);
#pragma unroll
                for (int pi = 0; pi < 2; ++pi) yacc[pi] = __builtin_amdgcn_mfma_f32_16x16x32_bf16(xf[ks2][pi], pf, yacc[pi], 0, 0, 0); } }
        { const size_t ro = (size_t)(b * TPB + scan_row(dir, ck * 64 + 16 * lt + fr));
#pragma unroll
          for (int pi = 0; pi < 2; ++pi) { const v2u xr_ = *(const LAS v2u*)(Xl + (16 * lt + fr) * XSTR + (16 * (2 * ph + pi) + 4 * fq) * 2);
              yacc[pi][0] += dsk * bflo(xr_.x); yacc[pi][1] += dsk * bfhi(xr_.x); yacc[pi][2] += dsk * bflo(xr_.y); yacc[pi][3] += dsk * bfhi(xr_.y);
              v2u o; o.x = cvt_pk_bf16(yacc[pi][0], yacc[pi][1]); o.y = cvt_pk_bf16(yacc[pi][2], yacc[pi][3]);
              *(v2u*)(Y + ro * 1024 + hl * 64 + 16 * (2 * ph + pi) + 4 * fq) = o; } }
#pragma unroll
        for (int i = 0; i < 4; ++i) { const int nt = 4 * ph + i; f32x4 a = sacc[i] * gdec;
#pragma unroll
            for (int ks2 = 0; ks2 < 2; ++ks2) a = __builtin_amdgcn_mfma_f32_16x16x32_bf16(xwf[ks2], btf[i][ks2], a, 0, 0, 0);
            sacc[i] = a;
#pragma unroll
            for (int j = 0; j < 4; ++j) *(LAS bf16*)(Sn + (16 * lt + 4 * fq + j) * BSTR + (16 * nt + fr) * 2) = (bf16)f2bf(a[j]); }
        __syncthreads();
        if (ck + 1 < 68) SM_STORE((u + 1) % PF);
        __syncthreads();
      } }
#undef SM_LOAD
#undef SM_STORE
}
struct GnRow { float v[16]; float ss; };
__device__ __forceinline__ void gn2_load(GnRow& R, const bf16* Yf, const bf16* Yb, const bf16* Z, size_t off) {
    const v4u a0 = *(const v4u*)(Yf + off), a1 = *(const v4u*)(Yf + off + 8), b0 = *(const v4u*)(Yb + off), b1 = *(const v4u*)(Yb + off + 8);
    const v4u z0 = *(const v4u*)(Z + off), z1 = *(const v4u*)(Z + off + 8);
    const unsigned aw[8] = {a0.x, a0.y, a0.z, a0.w, a1.x, a1.y, a1.z, a1.w}, bw[8] = {b0.x, b0.y, b0.z, b0.w, b1.x, b1.y, b1.z, b1.w};
    const unsigned zw[8] = {z0.x, z0.y, z0.z, z0.w, z1.x, z1.y, z1.z, z1.w};
    float ss = 0.f;
#pragma unroll
    for (int i = 0; i < 8; ++i) { R.v[2 * i] = (bflo(aw[i]) + bflo(bw[i])) * silu_f(bflo(zw[i])); R.v[2 * i + 1] = (bfhi(aw[i]) + bfhi(bw[i])) * silu_f(bfhi(zw[i]));
        ss += R.v[2 * i] * R.v[2 * i] + R.v[2 * i + 1] * R.v[2 * i + 1]; }
    R.ss = ss;
}
__device__ __forceinline__ void gn_store(const GnRow& R, float rs, const float (&ng)[16], bf16* dst) {
    unsigned res[8];
#pragma unroll
    for (int i = 0; i < 8; ++i) res[i] = cvt_pk_bf16(R.v[2 * i] * rs * ng[2 * i], R.v[2 * i + 1] * rs * ng[2 * i + 1]);
    *(v4u*)(dst) = (v4u){res[0], res[1], res[2], res[3]}; *(v4u*)(dst + 8) = (v4u){res[4], res[5], res[6], res[7]};
}
__device__ __forceinline__ void phase_ssm_gnorm2(Frame& F, const float* const* in, int gp, bf16* Yf, const bf16* Yb, const bf16* XS, const bf16* Z, bf16* dst = nullptr) {
    if (!dst) dst = Yf;
    const int gw = F.vcu * NWAVES + F.wave, NGW = GRID * NWAVES; float ng[16];
#pragma unroll
    for (int i = 0; i < 16; ++i) ng[i] = in[24][gp * 1024 + 16 * F.lane + i];
    for (int r0 = gw; r0 < M; r0 += 4 * NGW) { GnRow R[4]; size_t of[4]; bool ok[4];
#pragma unroll
        for (int q = 0; q < 4; ++q) { const int r = r0 + q * NGW; ok[q] = r < M; of[q] = (size_t)(ok[q] ? r : r0) * 1024 + 16 * F.lane; gn2_load(R[q], Yf, Yb, Z, of[q]); }
#pragma unroll
        for (int o = 1; o < 32; o <<= 1) {
#pragma unroll
            for (int q = 0; q < 4; ++q) R[q].ss += __shfl_xor(R[q].ss, o); }
#pragma unroll
        for (int q = 0; q < 4; ++q) if (ok[q]) gn_store(R[q], rsqrtf(R[q].ss * (1.f / 512.f) + EPS), ng, dst + of[q]); }
}

__device__ __forceinline__ void phase_mlstm_scan(Frame& F, const bf16* Qm, const bf16* Km, const bf16* Vm, const float* G, bf16* Hf, bf16* Hb) {
    constexpr int T = 32;
    LAS float* Qf = (LAS float*)F.lds;
    LAS float* KW = (LAS float*)(F.lds + 8192);
    LAS float* Vf = (LAS float*)(F.lds + 16384);
    LAS float* FD = (LAS float*)(F.lds + 24576);
    LAS float* IW = (LAS float*)(F.lds + 24576 + 256);
    LAS float* EM = (LAS float*)(F.lds + 24576 + 512);
    LAS float* PN = (LAS float*)(F.lds + 32768);
    LAS float* PD = (LAS float*)(F.lds + 32768 + 65536);
    const int it = blockIdx.x, b = it >> 5, dir = (it >> 4) & 1, head = (it >> 1) & 7, jh = it & 1;
    bf16* Hout = dir == 0 ? Hf : Hb;
    const int w = F.wave, lane = F.lane, d7 = 8 * w + (lane & 7);
    float C[8], nst = 0.f, m_in = 0.f;
#pragma unroll
    for (int i = 0; i < 8; ++i) C[i] = 0.f;
    const int st = (F.tid & 255) >> 3, sch = F.tid & 7;
    v4u r0, r1; float gi = 0.f, gf = 0.f;
#define ML_LOAD(tile) do { const size_t _r = (size_t)(b * TPB + scan_row(dir, (tile) * T + st)); \
        if (F.tid < 256) { r0 = *(const v4u*)(Qm + _r * 512 + head * 64 + sch * 8); r1 = *(const v4u*)(Vm + _r * 1024 + head * 128 + jh * 64 + sch * 8); } \
        else { r0 = *(const v4u*)(Km + _r * 512 + head * 64 + sch * 8); } \
        if (F.tid < 32) { const size_t _g = (size_t)(b * TPB + scan_row(dir, (tile) * T + F.tid)); gi = G[_g * 32 + (2 * dir) * 8 + head]; gf = G[_g * 32 + (2 * dir + 1) * 8 + head]; } } while (0)
#define UNPK(dst, r) do { *(LAS f32x4*)(dst) = (f32x4){bflo(r.x), bfhi(r.x), bflo(r.y), bfhi(r.y)}; *(LAS f32x4*)((dst) + 4) = (f32x4){bflo(r.z), bfhi(r.z), bflo(r.w), bfhi(r.w)}; } while (0)
#define ML_GATES(nb) do { if (w == 0) { float Fc = lane < 32 ? gf : 0.f; \
            _Pragma("unroll") for (int o = 1; o < 32; o <<= 1) { const float t_ = __shfl_up(Fc, o); if (lane >= o) Fc += t_; } \
            float Gm = lane < 32 ? gi - Fc : -3.0e38f; \
            _Pragma("unroll") for (int o = 1; o < 32; o <<= 1) { const float t_ = __shfl_up(Gm, o); if (lane >= o) Gm = fmaxf(Gm, t_); } \
            const float mt = Fc + fmaxf(m_in, Gm); float mp = __shfl_up(mt, 1); if (lane == 0) mp = m_in; \
            if (lane < 32) { FD[(nb) * 32 + lane] = fast_exp2((gf + mp - mt) * LOG2E); IW[(nb) * 32 + lane] = fast_exp2((gi - mt) * LOG2E); EM[(nb) * 32 + lane] = fast_exp2(-mt * LOG2E); } \
            m_in = __shfl(mt, 31); } } while (0)
    __syncthreads();
    ML_LOAD(0); ML_GATES(0);
    if (F.tid < 256) { UNPK(Qf + st * 64 + sch * 8, r0); UNPK(Vf + st * 64 + sch * 8, r1); }
    __syncthreads();
    if (F.tid >= 256) { const float iw = IW[st]; LAS float* dk = KW + st * 64 + sch * 8;
        *(LAS f32x4*)dk = (f32x4){bflo(r0.x), bfhi(r0.x), bflo(r0.y), bfhi(r0.y)} * iw; *(LAS f32x4*)(dk + 4) = (f32x4){bflo(r0.z), bfhi(r0.z), bflo(r0.w), bfhi(r0.w)} * iw; }
    __syncthreads();
    constexpr int NT = TPB / T;
    for (int tile = 0; tile < NT; ++tile) { const int cb = tile & 1;
        if (tile + 1 < NT) ML_LOAD(tile + 1);
#pragma unroll 4
        for (int t = 0; t < T; ++t) {
            const float fd = FD[cb * 32 + t], v = Vf[t * 64 + lane];
            const f32x4 q0 = *(const LAS f32x4*)(Qf + t * 64 + 8 * w), q1 = *(const LAS f32x4*)(Qf + t * 64 + 8 * w + 4);
            const f32x4 k0 = *(const LAS f32x4*)(KW + t * 64 + 8 * w), k1 = *(const LAS f32x4*)(KW + t * 64 + 8 * w + 4);
            float pn = 0.f;
#pragma unroll
            for (int i = 0; i < 4; ++i) { C[i] = C[i] * fd + k0[i] * v; pn += q0[i] * C[i]; C[4 + i] = C[4 + i] * fd + k1[i] * v; pn += q1[i] * C[4 + i]; }
            PN[(w * 32 + t) * 64 + lane] = pn;
            nst = nst * fd + KW[t * 64 + d7];
            float pd = Qf[t * 64 + d7] * nst;
            pd += __shfl_xor(pd, 1); pd += __shfl_xor(pd, 2); pd += __shfl_xor(pd, 4);
            if (lane == 0) PD[w * 32 + t] = pd;
        }
        __syncthreads();
#pragma unroll
        for (int k = 0; k < 4; ++k) { const int t = (F.tid >> 6) + 8 * k; float num = 0.f, den = 0.f;
#pragma unroll
            for (int ww = 0; ww < 8; ++ww) { num += PN[(ww * 32 + t) * 64 + lane]; den += PD[ww * 32 + t]; }
            const float h = num / fmaxf(fabsf(den), EM[cb * 32 + t]);
            Hout[(size_t)(b * TPB + scan_row(dir, tile * T + t)) * 1024 + head * 128 + jh * 64 + lane] = (bf16)f2bf(h); }
        if (tile + 1 < NT) { ML_GATES(cb ^ 1); if (F.tid < 256) { UNPK(Qf + st * 64 + sch * 8, r0); UNPK(Vf + st * 64 + sch * 8, r1); } }
        __syncthreads();
        if (tile + 1 < NT && F.tid >= 256) { const float iw = IW[(cb ^ 1) * 32 + st]; LAS float* dk = KW + st * 64 + sch * 8;
            *(LAS f32x4*)dk = (f32x4){bflo(r0.x), bfhi(r0.x), bflo(r0.y), bfhi(r0.y)} * iw; *(LAS f32x4*)(dk + 4) = (f32x4){bflo(r0.z), bfhi(r0.z), bflo(r0.w), bfhi(r0.w)} * iw; }
        __syncthreads();
    }
#undef ML_LOAD
#undef ML_GATES
#undef UNPK
}

__device__ __forceinline__ void phase_mlstm_scan_mfma(Frame& F, const bf16* Qm, const bf16* Km, const bf16* Vm, const float* G, bf16* Hf, bf16* Hb) {
    constexpr int QSTR = 144, WSTR = 160, VSTR = 176, CSTR = 144;
    LAS unsigned char* Ql = F.lds;
    LAS unsigned char* Kl = F.lds + 9216;
    LAS unsigned char* Kw = F.lds + 18432;
    LAS unsigned char* Vl = F.lds + 28672;
    LAS unsigned char* Cb = F.lds + 39936;
    LAS float* GB = (LAS float*)(F.lds + 62976);
    const int it = F.vcu, b = it >> 5, dir = (it >> 4) & 1, head = (it >> 1) & 7, jh = it & 1;
    bf16* Hout = dir == 0 ? Hf : Hb;
    const int tid = F.tid, lane = F.lane, w = F.wave, fr = lane & 15, fq = lane >> 4, lq = (lane & 15) >> 2, lp = lane & 3;
    const int jg = w >> 2, lt = jg ? 3 - (w & 3) : (w & 3);
    for (int i = tid; i < 80 * CSTR / 16; i += NTHR) *(LAS v4u*)(Cb + i * 16) = (v4u){0u, 0u, 0u, 0u};
    for (int i = tid; i < 64 * 2; i += NTHR) { const int s = i >> 1, hh = i & 1; *(LAS v4u*)(Vl + s * VSTR + 128 + hh * 16) = hh == 0 ? (v4u){0x3F80u, 0u, 0u, 0u} : (v4u){0u, 0u, 0u, 0u}; }
    f32x4 sacc[3];
#pragma unroll
    for (int i = 0; i < 3; ++i) sacc[i] = (f32x4){0.f, 0.f, 0.f, 0.f};
    constexpr int PF = ML_PF;
    v4u rQ[PF], rK[PF], rV[PF]; float gi[PF], gf[PF]; float m_in = 0.f;
    const int sr = tid >> 3, sc = tid & 7;
#define MM_LOAD(S, ckv) do { const int _ck = (ckv) < 68 ? (ckv) : 67; const size_t _r = (size_t)(b * TPB + scan_row(dir, _ck * 64 + sr)); \
        rQ[S] = *(const v4u*)(Qm + _r * 512 + head * 64 + sc * 8); rK[S] = *(const v4u*)(Km + _r * 512 + head * 64 + sc * 8); rV[S] = *(const v4u*)(Vm + _r * 1024 + head * 128 + jh * 64 + sc * 8); \
        { const size_t _g = (size_t)(b * TPB + scan_row(dir, _ck * 64 + lane)); gi[S] = G[_g * 32 + (2 * dir) * 8 + head]; gf[S] = G[_g * 32 + (2 * dir + 1) * 8 + head]; } } while (0)
#define MM_GSCAN(S, GP) do { if (w == 0) { LAS float* _g = (GP); const float gil = gi[S] * LOG2E; const float Fc = wave_scan_sum(gf[S] * LOG2E); \
            const float Gm = wave_scan_max(gil - Fc); \
            const float mt = Fc + fmaxf(m_in, Gm); _g[lane] = Fc; _g[64 + lane] = gil; _g[128 + lane] = mt; \
            if (lane == 63) { _g[192] = Fc; _g[193] = m_in; _g[194] = mt; } \
            m_in = __shfl(mt, 63); } } while (0)
#define MM_STAGE(S, GP) do { const LAS float* _g = (GP); \
        *(LAS v4u*)(Ql + sr * QSTR + sc * 16) = rQ[S]; *(LAS v4u*)(Kl + sr * QSTR + sc * 16) = rK[S]; *(LAS v4u*)(Vl + sr * VSTR + sc * 16) = rV[S]; \
        const float ws_ = fast_exp2(_g[192] - _g[sr] + _g[64 + sr] - _g[194]); const v4u _k = rK[S]; v4u _o; \
        _o.x = cvt_pk_bf16(bflo(_k.x) * ws_, bfhi(_k.x) * ws_); _o.y = cvt_pk_bf16(bflo(_k.y) * ws_, bfhi(_k.y) * ws_); _o.z = cvt_pk_bf16(bflo(_k.z) * ws_, bfhi(_k.z) * ws_); _o.w = cvt_pk_bf16(bflo(_k.w) * ws_, bfhi(_k.w) * ws_); \
        *(LAS v4u*)(Kw + sr * WSTR + sc * 16) = _o; } while (0)
    __syncthreads();
    MM_LOAD(0, 0); MM_GSCAN(0, GB); __syncthreads(); MM_STAGE(0, GB);
#pragma unroll
    for (int k = 1; k < PF; ++k) MM_LOAD(k, k);
    __syncthreads();
#pragma unroll 1
    for (int ck0 = 0; ck0 < 68; ck0 += PF) {
#pragma unroll
      for (int u = 0; u < PF; ++u) { const int ck = ck0 + u; const int cur = u & 1;
        const LAS float* BCU = GB + cur * 256; const LAS float* IGA = BCU + 64; const LAS float* MTA = BCU + 128; const LAS float* SCA = BCU + 192;
        if (ck + 1 < 68) MM_GSCAN((u + 1) % PF, GB + (cur ^ 1) * 256);
        MM_LOAD(u, ck + PF);
        const LAS unsigned char* Cc = Cb + cur * (80 * CSTR); LAS unsigned char* Cn = Cb + (cur ^ 1) * (80 * CSTR);
        bf16x8 qf[2], cfr[3][2], kfr[4][2];
#pragma unroll
        for (int ks = 0; ks < 2; ++ks) qf[ks] = *(const LAS bf16x8*)(Ql + (16 * lt + fr) * QSTR + (32 * ks + 8 * fq) * 2);
#pragma unroll
        for (int ji = 0; ji < 3; ++ji) { const int row = ji < 2 ? 16 * (2 * jg + ji) + fr : 64 + fr;
#pragma unroll
            for (int ks = 0; ks < 2; ++ks) cfr[ji][ks] = *(const LAS bf16x8*)(Cc + row * CSTR + (32 * ks + 8 * fq) * 2); }
#pragma unroll
        for (int st = 0; st < 4; ++st) { if (st <= lt) {
#pragma unroll
            for (int ks = 0; ks < 2; ++ks) kfr[st][ks] = *(const LAS bf16x8*)(Kl + (16 * st + fr) * QSTR + (32 * ks + 8 * fq) * 2); } }
        const float bl = BCU[16 * lt + fr], ml = MTA[16 * lt + fr], m0 = SCA[1];
        f32x4 bsv[4], isv[4];
#pragma unroll
        for (int st = 0; st < 4; ++st) { bsv[st] = *(const LAS f32x4*)(BCU + 16 * st + 4 * fq); isv[st] = *(const LAS f32x4*)(IGA + 16 * st + 4 * fq); }
        const float gdec = fast_exp2(SCA[0] + m0 - SCA[2]);
        bf16x8 vfr[2][2];
#pragma unroll
        for (int ks2 = 0; ks2 < 2; ++ks2) { if (2 * ks2 <= lt) {
#pragma unroll
            for (int ji = 0; ji < 2; ++ji) { const LAS unsigned char* vb = Vl + (32 * ks2 + 4 * fq + lq) * VSTR + (16 * (2 * jg + ji) + 4 * lp) * 2;
                const s16x4 v0 = __builtin_amdgcn_ds_read_tr16_b64_v4i16((LAS s16x4*)vb), v1 = __builtin_amdgcn_ds_read_tr16_b64_v4i16((LAS s16x4*)(vb + 16 * VSTR));
                vfr[ks2][ji][0] = v0[0]; vfr[ks2][ji][1] = v0[1]; vfr[ks2][ji][2] = v0[2]; vfr[ks2][ji][3] = v0[3]; vfr[ks2][ji][4] = v1[0]; vfr[ks2][ji][5] = v1[1]; vfr[ks2][ji][6] = v1[2]; vfr[ks2][ji][7] = v1[3]; } } }
        const float dl = fast_exp2(bl + m0 - ml);
        f32x4 nacc[2]; float den;
#pragma unroll
        for (int ji = 0; ji < 2; ++ji) { f32x4 a = (f32x4){0.f, 0.f, 0.f, 0.f};
#pragma unroll
            for (int ks = 0; ks < 2; ++ks) a = __builtin_amdgcn_mfma_f32_16x16x32_bf16(cfr[ji][ks], qf[ks], a, 0, 0, 0);
            nacc[ji] = a * dl; }
        { f32x4 a = (f32x4){0.f, 0.f, 0.f, 0.f};
#pragma unroll
          for (int ks = 0; ks < 2; ++ks) a = __builtin_amdgcn_mfma_f32_16x16x32_bf16(cfr[2][ks], qf[ks], a, 0, 0, 0);
          den = __shfl(a[0], fr) * dl; }
        f32x4 pm[4]; float dsum = 0.f;
#pragma unroll
        for (int st = 0; st < 4; ++st) { pm[st] = (f32x4){0.f, 0.f, 0.f, 0.f};
            if (st <= lt) { f32x4 g = (f32x4){0.f, 0.f, 0.f, 0.f};
#pragma unroll
                for (int ks = 0; ks < 2; ++ks) g = __builtin_amdgcn_mfma_f32_16x16x32_bf16(kfr[st][ks], qf[ks], g, 0, 0, 0);
#pragma unroll
                for (int j = 0; j < 4; ++j) { const bool ok = (16 * st + 4 * fq + j) <= (16 * lt + fr); const float v = ok ? g[j] * fast_exp2(bl - bsv[st][j] + isv[st][j] - ml) : 0.f; pm[st][j] = v; dsum += v; } } }
        bf16x8 kwf[2], vtf[3][2];
#pragma unroll
        for (int ks2 = 0; ks2 < 2; ++ks2) { const LAS unsigned char* kb = Kw + (32 * ks2 + 8 * fq + lq) * WSTR + (16 * lt + 4 * lp) * 2;
            const s16x4 v0 = __builtin_amdgcn_ds_read_tr16_b64_v4i16((LAS s16x4*)kb), v1 = __builtin_amdgcn_ds_read_tr16_b64_v4i16((LAS s16x4*)(kb + 4 * WSTR));
            kwf[ks2][0] = v0[0]; kwf[ks2][1] = v0[1]; kwf[ks2][2] = v0[2]; kwf[ks2][3] = v0[3]; kwf[ks2][4] = v1[0]; kwf[ks2][5] = v1[1]; kwf[ks2][6] = v1[2]; kwf[ks2][7] = v1[3]; }
#pragma unroll
        for (int i = 0; i < 3; ++i) { if (jg == 0 || i < 2) { const int jt = jg == 0 ? i : 3 + i;
#pragma unroll
            for (int ks2 = 0; ks2 < 2; ++ks2) { const LAS unsigned char* vb = Vl + (32 * ks2 + 8 * fq + lq) * VSTR + (16 * jt + 4 * lp) * 2;
                const s16x4 v0 = __builtin_amdgcn_ds_read_tr16_b64_v4i16((LAS s16x4*)vb), v1 = __builtin_amdgcn_ds_read_tr16_b64_v4i16((LAS s16x4*)(vb + 4 * VSTR));
                vtf[i][ks2][0] = v0[0]; vtf[i][ks2][1] = v0[1]; vtf[i][ks2][2] = v0[2]; vtf[i][ks2][3] = v0[3]; vtf[i][ks2][4] = v1[0]; vtf[i][ks2][5] = v1[1]; vtf[i][ks2][6] = v1[2]; vtf[i][ks2][7] = v1[3]; } } }
        dsum += __shfl_xor(dsum, 16); dsum += xor32(dsum);
        den += dsum;
#pragma unroll
        for (int ks2 = 0; ks2 < 2; ++ks2) { if (2 * ks2 <= lt) { const v4u pw = pack8(pm[2 * ks2], pm[2 * ks2 + 1]); const bf16x8 pf = __builtin_bit_cast(bf16x8, pw);
#pragma unroll
                for (int ji = 0; ji < 2; ++ji) nacc[ji] = __builtin_amdgcn_mfma_f32_16x16x32_bf16(vfr[ks2][ji], pf, nacc[ji], 0, 0, 0); } }
        { const float inv = 1.0f / fmaxf(fabsf(den), fast_exp2(-ml)); const size_t ro = (size_t)(b * TPB + scan_row(dir, ck * 64 + 16 * lt + fr));
#pragma unroll
          for (int ji = 0; ji < 2; ++ji) { v2u o; o.x = cvt_pk_bf16(nacc[ji][0] * inv, nacc[ji][1] * inv); o.y = cvt_pk_bf16(nacc[ji][2] * inv, nacc[ji][3] * inv);
              *(v2u*)(Hout + ro * 1024 + head * 128 + jh * 64 + 16 * (2 * jg + ji) + 4 * fq) = o; } }
#pragma unroll
        for (int i = 0; i < 3; ++i) { if (jg == 0 || i < 2) { const int jt = jg == 0 ? i : 3 + i; f32x4 a = sacc[i] * gdec;
#pragma unroll
            for (int ks2 = 0; ks2 < 2; ++ks2) a = __builtin_amdgcn_mfma_f32_16x16x32_bf16(vtf[i][ks2], kwf[ks2], a, 0, 0, 0);
            sacc[i] = a;
#pragma unroll
            for (int j = 0; j < 4; ++j) *(LAS bf16*)(Cn + (16 * jt + 4 * fq + j) * CSTR + (16 * lt + fr) * 2) = (bf16)f2bf(a[j]); } }
        __syncthreads();
        if (ck + 1 < 68) MM_STAGE((u + 1) % PF, GB + (cur ^ 1) * 256);
        __syncthreads();
      } }
#undef MM_LOAD
#undef MM_GSCAN
#undef MM_STAGE
}

__device__ __forceinline__ void mg_load(GnRow& R, unsigned (&ow)[8], const bf16* Hf, const bf16* Hb, const bf16* Om, size_t off) {
    const v4u a0 = *(const v4u*)(Hf + off), a1 = *(const v4u*)(Hf + off + 8), b0 = *(const v4u*)(Hb + off), b1 = *(const v4u*)(Hb + off + 8), o0 = *(const v4u*)(Om + off), o1 = *(const v4u*)(Om + off + 8);
    const unsigned aw[8] = {a0.x, a0.y, a0.z, a0.w, a1.x, a1.y, a1.z, a1.w}, bw[8] = {b0.x, b0.y, b0.z, b0.w, b1.x, b1.y, b1.z, b1.w};
    ow[0] = o0.x; ow[1] = o0.y; ow[2] = o0.z; ow[3] = o0.w; ow[4] = o1.x; ow[5] = o1.y; ow[6] = o1.z; ow[7] = o1.w;
    float ss = 0.f;
#pragma unroll
    for (int i = 0; i < 8; ++i) { R.v[2 * i] = bflo(aw[i]) + bflo(bw[i]); R.v[2 * i + 1] = bfhi(aw[i]) + bfhi(bw[i]); ss += R.v[2 * i] * R.v[2 * i] + R.v[2 * i + 1] * R.v[2 * i + 1]; }
    R.ss = ss;
}
__device__ __forceinline__ void mg_store(const GnRow& R, const unsigned (&ow)[8], float rs, const float (&ng)[16], bf16* dst) {
    unsigned res[8];
#pragma unroll
    for (int i = 0; i < 8; ++i) res[i] = cvt_pk_bf16(R.v[2 * i] * rs * ng[2 * i] * sigmoid_f(bflo(ow[i])), R.v[2 * i + 1] * rs * ng[2 * i + 1] * sigmoid_f(bfhi(ow[i])));
    *(v4u*)(dst) = (v4u){res[0], res[1], res[2], res[3]}; *(v4u*)(dst + 8) = (v4u){res[4], res[5], res[6], res[7]};
}
__device__ __forceinline__ void phase_mlstm_gnorm(Frame& F, const float* const* in, const bf16* Hf, const bf16* Hb, const bf16* Om, bf16* Hn) {
    const int gw = F.vcu * NWAVES + F.wave, NGW = GRID * NWAVES; float ng[16];
#pragma unroll
    for (int i = 0; i < 16; ++i) ng[i] = in[28][16 * F.lane + i];
    for (int r0 = gw; r0 < M; r0 += 4 * NGW) { GnRow R[4]; unsigned ww[4][8]; size_t of[4]; bool ok[4];
#pragma unroll
        for (int q = 0; q < 4; ++q) { const int r = r0 + q * NGW; ok[q] = r < M; of[q] = (size_t)(ok[q] ? r : r0) * 1024 + 16 * F.lane; mg_load(R[q], ww[q], Hf, Hb, Om, of[q]); }
#pragma unroll
        for (int o = 1; o < 8; o <<= 1) {
#pragma unroll
            for (int q = 0; q < 4; ++q) R[q].ss += __shfl_xor(R[q].ss, o); }
#pragma unroll
        for (int q = 0; q < 4; ++q) if (ok[q]) mg_store(R[q], ww[q], rsqrtf(R[q].ss * (1.f / 128.f) + EPS), ng, Hn + of[q]); }
}
struct Args { const float* in[37]; float* out; unsigned char* ws; };

__device__ __forceinline__ void moe_phases(Frame& F, const float* const* in, int layer, const XcdBarrier& bar) {
#if defined(PROBE_ROUTE2)
    phase_norm2_route(F, in, layer, true); __syncthreads();
#endif
    phase_norm2_route(F, in, layer);
    SYNC_GRID();
    bf16* Hb = (bf16*)(F.ws + WS_H); bf16* ACT = (bf16*)(F.ws + MOE_ACT); bf16* X = (bf16*)(F.ws + WS_X);
    const float* mod = (const float*)(F.ws + WS_MOD) + (size_t)layer * 9 * 6144;
    { MoeOrder<0> S; S.W = (const bf16*)(F.ws + WS_WGU + wofs(layer)); S.G = GRID; S.c = F.vcu; moe_setup(F, layer, S);
      pg8::Gemm g{Hb, 1024, 1024, 1 << 30}; EpiMoeAct E{ACT, S.tbl};
      pg8::gemm_phase(F.lds, g, S, E);
#if defined(PROBE_GM1)
      __syncthreads(); pg8::gemm_phase(F.lds, g, S, E);
#endif
      }
    if (layer < 3 && F.vcu >= 128) { __syncthreads(); refresh(F); phase_mod(F, in, layer + 1, layer + 2, F.vcu - 128, 128); }
    SYNC_GRID();
    { MoeOrder<1> S; S.W = (const bf16*)(F.ws + WS_WDN + wofs(layer)); S.G = GRID; S.c = F.vcu; moe_setup(F, layer, S);
      pg8::Gemm g{ACT, 512, 256, 4};
#if defined(PROBE_OUT2)
      { EpiMoeDown E0{X, (const bf16*)(F.ws + WS_CTL + 262144), S.tbl}; pg8::gemm_phase(F.lds, g, S, E0); VM_WAIT(); __syncthreads(); __builtin_amdgcn_fence(__ATOMIC_ACQUIRE, "agent"); VM_WAIT(); __syncthreads(); refresh(F); }
#endif
      EpiMoeDown E{X, (const bf16*)(F.ws + WS_MODB) + (size_t)layer * 9 * 1024, S.tbl};
      pg8::gemm_phase(F.lds, g, S, E); }
    SYNC_GRID();
}
__device__ __forceinline__ void outproj_phase(Frame& F, const float* const* in, const bf16* A, const bf16* Wt, int K, int ldb, int layer, int conv_next, const float* xin = nullptr, const float* cin = nullptr) {
    pg8::Gemm g{A, K, ldb, 1 << 30}; pg8::StaticOrder S; S.init(M, 1024, GRID, (int)blockIdx.x, Wt, ldb, layer == 3);
    EpiResid E{(bf16*)(F.ws + WS_X), (const float*)(F.ws + WS_MOD) + (size_t)layer * 9 * 6144 + 2 * 1024, xin, cin};
    pg8::gemm_phase(F.lds, g, S, E);
    if (conv_next >= 0 && blockIdx.x >= 32) { refresh(F); ConvGrid cg; cg.gw = ((int)blockIdx.x - 32) * NWAVES + F.wave; cg.ngw = (GRID - 32) * NWAVES; convert_layer(F, cg, in, conv_next); }
}

__device__ __forceinline__ void ssm_inproj(Frame& F, const float* const* in, const int gp, const int c, bf16* Z, bf16* PRE, float* DT) {
    const bf16* H = (const bf16*)(F.ws + WS_H); const bf16* WM = (const bf16*)(F.ws + WS_WMIX + wofs(1));
    pg8::Gemm g{H, 1024, 1024, 1 << 30}; pg8::StaticOrder S; S.init(M, 2816, GRID, c, WM + (size_t)gp * 2816 * 1024, 1024);
    EpiSsmIn E{Z, PRE, DT, in[21] + gp * 16};
    pg8::gemm_phase(F.lds, g, S, E);
}
__device__ __forceinline__ void ssm_gp_phases(Frame& F, const float* const* in, const int gp, const XcdBarrier& bar) {
    unsigned char* scr = F.ws + WS_SCR; unsigned char* scr2 = (unsigned char*)F.out; bf16* WM = (bf16*)(F.ws + WS_WMIX + wofs(1));
    bf16* Z = (bf16*)scr; bf16* XP = (bf16*)(scr + 68 * MiB); bf16* XS = (bf16*)(scr + 170 * MiB); float* DT = (float*)(scr + 238 * MiB); float* ACUM = (float*)(scr + 243 * MiB); bf16* Yb = (bf16*)(scr2 + 34 * MiB);
    bf16* PRE = gp == 0 ? XP : (bf16*)scr2; bf16* BC = gp == 0 ? (bf16*)scr2 : (bf16*)(scr + 136 * MiB);
    if (gp == 0) { ssm_inproj(F, in, 0, (int)blockIdx.x, Z, PRE, DT); SYNC_GRID(); }
    phase_ssm_conv(F, in, gp, PRE, XS, BC, DT, ACUM);
    SYNC_GRID();
    phase_ssm_scan_mfma(F, in, gp, XS, BC, DT, ACUM, XP, Yb);
    SYNC_GRID();
    phase_ssm_gnorm2(F, in, gp, XP, Yb, XS, Z);
    SYNC_GRID();
    if (gp == 0) {
        outproj_phase(F, in, XP, WM + 6 * MiB, 1024, 2048, 1, -1);
        __syncthreads(); refresh(F);
        ssm_inproj(F, in, 1, ((int)blockIdx.x + 224) & 255, Z, (bf16*)scr2, DT);
    } else outproj_phase(F, in, XP, WM + 6 * MiB + 1024, 1024, 2048, 1, 2);
    SYNC_GRID();
}

__global__ void __launch_bounds__(NTHR, 2) fwd_kernel(Args args) {
    extern __shared__ __attribute__((aligned(16))) unsigned char lds_raw[];
    Frame F;
    F.lds = (LAS unsigned char*)lds_raw; F.ws = args.ws; F.ctl = (unsigned*)(args.ws + WS_CTL); F.out = args.out;
    refresh(F);
    { const int bx = blockIdx.x; F.vcu = (bx % 8) * (GRID / 8) + bx / 8; }
    volatile LAS unsigned* MISC = (volatile LAS unsigned*)(F.lds + LDS_MISC);
    for (int u = F.tid; u < 256; u += NTHR) MISC[u] = 0u;
    __syncthreads();
    const XcdBarrier bar = xcd_barrier_post(F.ctl + CW_BAR, MISC + 8);
    const float* const* in = args.in;
    unsigned char* ws = F.ws; unsigned char* scr = ws + WS_SCR; unsigned char* scr2 = (unsigned char*)F.out;
    bf16* H = (bf16*)(ws + WS_H);

#if defined(PROBE_MEM2) || defined(PROBE_PRO2)
    for (int rep = 0; rep < 2; ++rep) {
#endif
    phase_prologue(F, in);
    __syncthreads(); refresh(F);
    convert_layer(F, conv_all(F), in, 0);
#if defined(PROBE_MEM2) || defined(PROBE_PRO2)
    __syncthreads(); }
#endif
    SYNC_GRID();

#ifndef SKIP_L0
    phase_norm1(F, in, 0);
#if defined(PROBE_MEM2)
    phase_norm1(F, in, 0);
#endif
    SYNC_GRID();
    { bf16* WM = (bf16*)(ws + WS_WMIX + wofs(0)); bf16* Q = (bf16*)scr; bf16* Kb = (bf16*)(scr + 68 * MiB); bf16* Vb = (bf16*)(scr + 85 * MiB);
      { pg8::Gemm g{H, 1024, 1024, 1 << 30}; pg8::StaticOrder S; S.init(M, 1536, GRID, (int)blockIdx.x, WM, 1024);
        EpiAttnIn E{Q, Kb, Vb, (const f32x2*)(ws + WS_TABA), 0.125f * LOG2E};
        pg8::gemm_phase(F.lds, g, S, E);
#if defined(PROBE_GEMM2)
        __syncthreads(); pg8::gemm_phase(F.lds, g, S, E);
#endif
        }
      SYNC_GRID();
#if defined(PROBE_WIN2)
      phase_attn_window(F, in, Q, Kb, Vb, (bf16*)scr2); __syncthreads();
#endif
      phase_attn_window(F, in, Q, Kb, Vb);
      SYNC_GRID();
      outproj_phase(F, in, Q, WM + 2 * MiB, 1024, 1024, 0, 1, in[0], in[2]);
      SYNC_GRID(); }
    moe_phases(F, in, 0, bar);

#endif
#ifndef SKIP_L1
#if defined(PROBE_MEM2)
    for (int rep = 0; rep < 2; ++rep) {
#endif
    phase_norm1(F, in, 1);
#if defined(PROBE_MEM2)
    __syncthreads(); }
#endif
    SYNC_GRID();
    ssm_gp_phases(F, in, 0, bar);
    ssm_gp_phases(F, in, 1, bar);
    moe_phases(F, in, 1, bar);

#endif
#ifndef SKIP_L2
#if defined(PROBE_MEM2)
    for (int rep = 0; rep < 2; ++rep) {
#endif
    phase_norm1(F, in, 2);
#if defined(PROBE_MEM2)
    __syncthreads(); }
#endif
    SYNC_GRID();
    { bf16* WM = (bf16*)(ws + WS_WMIX + wofs(2)); bf16* Qm = (bf16*)scr; bf16* Km = (bf16*)(scr + 34 * MiB); bf16* Vm = (bf16*)(scr + 68 * MiB); bf16* Om = (bf16*)(scr + 136 * MiB); float* Gt = (float*)(scr + 204 * MiB);
      bf16* Hf = (bf16*)scr2; bf16* Hbw = H;
      { pg8::Gemm g{H, 1024, 1024, 1 << 30}; pg8::StaticOrder S; S.init(M, 3328, GRID, (int)blockIdx.x, WM, 1024);
        EpiMlIn E{Qm, Km, Vm, Om, Gt, in[27]};
        pg8::gemm_phase(F.lds, g, S, E);
#if defined(PROBE_GEMM2)
        __syncthreads(); pg8::gemm_phase(F.lds, g, S, E);
#endif
        }
      SYNC_GRID();
#if defined(ML_VALU)
      phase_mlstm_scan(F, Qm, Km, Vm, Gt, Hf, Hbw);
#else
      phase_mlstm_scan_mfma(F, Qm, Km, Vm, Gt, Hf, Hbw);
#if defined(PROBE_MLM2)
      __syncthreads(); phase_mlstm_scan_mfma(F, Qm, Km, Vm, Gt, Hf, Hbw);
#endif
#endif
      SYNC_GRID();
#if defined(PROBE_GN2)
      phase_mlstm_gnorm(F, in, Hf, Hbw, Om, Qm); __syncthreads();
#endif
      phase_mlstm_gnorm(F, in, Hf, Hbw, Om, Om);
      SYNC_GRID();
      outproj_phase(F, in, Om, WM + 4 * MiB, 1024, 1024, 2, 3);
      SYNC_GRID(); }
    moe_phases(F, in, 2, bar);

#endif
#ifndef SKIP_L3
#if defined(PROBE_MEM2)
    for (int rep = 0; rep < 2; ++rep) {
#endif
    phase_norm1(F, in, 3);
#if defined(PROBE_MEM2)
    __syncthreads(); }
#endif
    SYNC_GRID();
    { bf16* WM = (bf16*)(ws + WS_WMIX + wofs(3)); bf16* CQ = (bf16*)scr; bf16* CKV = (bf16*)(scr + 17 * MiB); float* SSQ = (float*)(scr + 34 * MiB); bf16* KF = (bf16*)(scr + 36 * MiB); bf16* V3 = (bf16*)(scr + 138 * MiB);
      bf16* Q3 = (bf16*)scr2; bf16* O3 = H; const f32x2* tabm = (const f32x2*)(ws + WS_TABM);
      { pg8::Gemm g{H, 1024, 1024, 1 << 30}; pg8::StaticOrder S; S.init(M, 768, GRID, (int)blockIdx.x, WM, 1024);
        EpiMlaIn E{CQ, CKV, KF, SSQ, tabm};
        pg8::gemm_phase(F.lds, g, S, E);
#if defined(PROBE_GEMM2)
        __syncthreads(); pg8::gemm_phase(F.lds, g, S, E);
#endif
        }
      SYNC_GRID();
      { pg8::Gemm g{CQ, 256, 256, 1 << 30}; pg8::StaticOrder S; S.init(M, 1536, GRID, (int)blockIdx.x, WM + 1 * MiB, 256);
        EpiMlaQ E{Q3, SSQ, tabm, 0.10206207261596577f * LOG2E};
        pg8::gemm_phase(F.lds, g, S, E);
#if defined(PROBE_GEMM2)
        __syncthreads(); pg8::gemm_phase(F.lds, g, S, E);
#endif
        }
      { pg8::Gemm g{CKV, 256, 256, 1 << 30}; pg8::StaticOrder S; S.init(M, 2048, GRID, ((int)blockIdx.x + 192) & 255, WM + 2 * MiB, 256);
        EpiMlaKV E{KF, V3, SSQ};
        pg8::gemm_phase(F.lds, g, S, E);
#if defined(PROBE_GEMM2)
        __syncthreads(); pg8::gemm_phase(F.lds, g, S, E);
#endif
        }
      SYNC_GRID();
      phase_attn_mla(F, Q3, KF, V3, O3);
#if defined(PROBE_MLA2)
      __syncthreads(); phase_attn_mla(F, Q3, KF, V3, O3);
#endif
      SYNC_GRID();
      outproj_phase(F, in, O3, WM + 3 * MiB, 1024, 1024, 3, -1);
      SYNC_GRID(); }
    moe_phases(F, in, 3, bar);

#endif
    const bool poison = __hip_atomic_load(F.ctl + CW_BAR + XB_TMO, RLX_AGENT) != 0u || __hip_atomic_load(F.ctl + CW_POISON, RLX_AGENT) != 0u;
    phase_final(F, in, poison);
#if defined(PROBE_MEM2)
    phase_final(F, in, poison);
#endif
}

extern "C" void kernel_launch(void* const* d_in, const int* in_sizes, int n_in, void* d_out, int out_size, void* d_ws, size_t ws_size, hipStream_t stream) {
    static int ready = 0;
    if (ready == 0) {
        ready = -1;
        if (n_in != 37 || in_sizes[0] != NB * SEQ * D || out_size != NB * SEQ * D || ws_size < WS_END) { fprintf(stderr, "kernel_launch: unexpected problem shape (n_in %d, in0 %d, out %d, ws %zu)\n", n_in, n_in > 0 ? in_sizes[0] : -1, out_size, ws_size); return; }
        int dev = 0, cus = 0;
        if (hipGetDevice(&dev) != hipSuccess || hipDeviceGetAttribute(&cus, hipDeviceAttributeMultiprocessorCount, dev) != hipSuccess) { fprintf(stderr, "kernel_launch: device query failed\n"); return; }
        if (cus < GRID) { fprintf(stderr, "kernel_launch: needs %d CUs, device has %d\n", GRID, cus); return; }
        if (hipFuncSetAttribute((const void*)fwd_kernel, hipFuncAttributeMaxDynamicSharedMemorySize, LDS_BYTES) != hipSuccess) { fprintf(stderr, "kernel_launch: hipFuncSetAttribute failed\n"); return; }
        int per_cu = 0;
        if (hipOccupancyMaxActiveBlocksPerMultiprocessor(&per_cu, (const void*)fwd_kernel, NTHR, LDS_BYTES) != hipSuccess || per_cu < 1) { fprintf(stderr, "kernel_launch: occupancy query reports %d blocks per CU\n", per_cu); }
        (void)hipGetLastError();
        ready = 1;
    }
    if (ready < 0) return;
    if (hipMemsetAsync((char*)d_ws + WS_CTL, 0, CTL_ZERO_BYTES, stream) != hipSuccess) { fprintf(stderr, "kernel_launch: memset failed\n"); return; }
    Args a{};
    for (int i = 0; i < 37; ++i) a.in[i] = (const float*)d_in[i];
    a.out = (float*)d_out; a.ws = (unsigned char*)d_ws;
    hipLaunchKernelGGL(fwd_kernel, dim3(GRID), dim3(NTHR), LDS_BYTES, stream, a);
    const hipError_t le = hipPeekAtLastError();
    if (le != hipSuccess) fprintf(stderr, "kernel_launch: launch failed: %s\n", hipGetErrorName(le));
}
```
